# Optimizing an MI355X kernel written in HIP

```python
import jax, jax.numpy as jnp
from jax import lax
import numpy as np

D_MODEL = 1024
BATCH = 2
SEQ = 8192
DEPTH = 1

CHUNK = 64
MIX_WIDTH = D_MODEL
LRU_WIDTH = MIX_WIDTH // 2
LRU_BLOCKS = 8
LRU_BLOCK = LRU_WIDTH // LRU_BLOCKS
CONV_WIDTH = 4
LRU_C = 8.0
ATT_WIDTH = MIX_WIDTH - LRU_WIDTH
ATT_HEADS = 8
ATT_HEAD_DIM = ATT_WIDTH // ATT_HEADS
LEFT_CHUNKS = 8
BAND_CHUNKS = LEFT_CHUNKS + 1
REL_CLIP = 128
MEM_LEN = 256
MEM_HEADS = 4
MEM_HEAD_DIM = D_MODEL // MEM_HEADS
PEER_HEADS = 8
N_KEYS = 128
N_EXPERTS = N_KEYS * N_KEYS
PEER_TOPK = 16
PEER_KEY_DIM = 128
PEER_QUERY_DIM = 2 * PEER_KEY_DIM
PEER_BLOCK = 128
IN_WIDTH = 2 * LRU_WIDTH + 3 * ATT_WIDTH
EPS = 1e-6
NEG_INF = -1e30

kernel_name = "hybrid_rglru_chunkattn_peer_block"


def _rmsnorm(x, g):
    xf = x.astype(jnp.float32)
    y = xf * lax.rsqrt(jnp.mean(xf * xf, axis=-1, keepdims=True) + EPS)
    return (y * g.astype(jnp.float32)).astype(x.dtype)


def _rg_lru(xr, conv_w, conv_b, gate_a_w, gate_a_b, gate_x_w, gate_x_b, lru_lambda):
    B, S, _ = xr.shape
    xc = lax.conv_general_dilated(
        xr, conv_w[:, None, :], window_strides=(1,), padding=[(CONV_WIDTH - 1, 0)],
        dimension_numbers=('NWC', 'WIO', 'NWC'), feature_group_count=LRU_WIDTH) + conv_b
    xb = xc.reshape(B, S, LRU_BLOCKS, LRU_BLOCK)
    r = jax.nn.sigmoid((jnp.einsum('bshi,hij->bshj', xb, gate_a_w).reshape(B, S, LRU_WIDTH)
                        + gate_a_b).astype(jnp.float32))
    i = jax.nn.sigmoid((jnp.einsum('bshi,hij->bshj', xb, gate_x_w).reshape(B, S, LRU_WIDTH)
                        + gate_x_b).astype(jnp.float32))
    log_a = -LRU_C * r * jax.nn.softplus(-lru_lambda.astype(jnp.float32))
    a = jnp.exp(log_a)
    mult = jnp.sqrt(jnp.maximum(-jnp.expm1(2.0 * log_a), 0.0))
    b = mult * i * xc.astype(jnp.float32)

    def combine(left, right):
        a1, b1 = left
        a2, b2 = right
        return a1 * a2, a2 * b1 + b2

    _, h = lax.associative_scan(combine, (a, b), axis=1)
    return h.astype(xr.dtype)


def _chunk_attention(q, k, v, rel_bias):
    B, S, _ = q.shape
    nc = S // CHUNK
    band = BAND_CHUNKS * CHUNK

    def split(t):
        return t.reshape(B, nc, CHUNK, ATT_HEADS, ATT_HEAD_DIM)

    q, k, v = split(q), split(k), split(v)
    pad = ((0, 0), (LEFT_CHUNKS, 0), (0, 0), (0, 0), (0, 0))
    kp, vp = jnp.pad(k, pad), jnp.pad(v, pad)
    k_band = jnp.concatenate([kp[:, j:j + nc] for j in range(BAND_CHUNKS)], axis=2)
    v_band = jnp.concatenate([vp[:, j:j + nc] for j in range(BAND_CHUNKS)], axis=2)
    s = jnp.einsum('bnqhd,bnkhd->bnhqk', q, k_band).astype(jnp.float32) * (ATT_HEAD_DIM ** -0.5)
    rel = LEFT_CHUNKS * CHUNK + np.arange(CHUNK)[:, None] - np.arange(band)[None, :]
    rel_idx = np.clip(rel, -REL_CLIP, REL_CLIP) + REL_CLIP
    bias = rel_bias[:, rel_idx].astype(jnp.float32)
    key_chunk = (np.arange(nc)[:, None] - LEFT_CHUNKS
                 + (np.arange(band) // CHUNK)[None, :])
    valid = key_chunk >= 0
    s = jnp.where(valid[None, :, None, None, :], s + bias[None, None], NEG_INF)
    p = jax.nn.softmax(s, axis=-1).astype(v.dtype)
    o = jnp.einsum('bnhqk,bnkhd->bnqhd', p, v_band)
    return o.reshape(B, S, ATT_WIDTH)


def _memory_cross_attention(h, mem_n, w_q, w_kv, w_o):
    B, S, D = h.shape
    M = mem_n.shape[1]
    q = (h @ w_q).reshape(B, S, MEM_HEADS, MEM_HEAD_DIM)
    kv = (mem_n @ w_kv).reshape(B, M, 2, MEM_HEADS, MEM_HEAD_DIM)
    k, v = kv[:, :, 0], kv[:, :, 1]
    s = jnp.einsum('bshd,bmhd->bhsm', q, k).astype(jnp.float32) * (MEM_HEAD_DIM ** -0.5)
    p = jax.nn.softmax(s, axis=-1).astype(h.dtype)
    o = jnp.einsum('bhsm,bmhd->bshd', p, v).reshape(B, S, D)
    return o @ w_o


def _peer(h, w_query, sub_keys, expert_u, expert_v):
    B, S, D = h.shape
    q = (h @ w_query).reshape(B, S, PEER_HEADS, 2, PEER_KEY_DIM)
    sc = jnp.einsum('bshpk,hpnk->bshpn', q, sub_keys).astype(jnp.float32)
    v1, i1 = lax.top_k(sc[..., 0, :], PEER_TOPK)
    v2, i2 = lax.top_k(sc[..., 1, :], PEER_TOPK)
    n_cand = PEER_TOPK * PEER_TOPK
    cand = (v1[..., :, None] + v2[..., None, :]).reshape(B, S, PEER_HEADS, n_cand)
    cand_idx = (i1[..., :, None] * N_KEYS + i2[..., None, :]).reshape(B, S, PEER_HEADS, n_cand)
    top_s, pos = lax.top_k(cand, PEER_TOPK)
    idx = jnp.take_along_axis(cand_idx, pos, axis=-1)
    g = jax.nn.softmax(top_s, axis=-1).astype(h.dtype)
    n_sel = PEER_HEADS * PEER_TOPK
    nb = (B * S) // PEER_BLOCK
    hb = h.reshape(nb, PEER_BLOCK, D)
    ib = idx.reshape(nb, PEER_BLOCK, n_sel)
    gb = g.reshape(nb, PEER_BLOCK, n_sel)

    def block(args):
        xt, it, gt = args
        u = expert_u[it]
        act = jax.nn.gelu(jnp.einsum('td,tkd->tk', xt, u))
        return jnp.einsum('tk,tkd->td', gt * act, expert_v[it])

    out = lax.map(block, (hb, ib, gb))
    return out.reshape(B, S, D)


def setup_inputs(seed: int = 0) -> dict:
    key = jax.random.key(seed)
    ks = jax.random.split(key, 32)
    f32 = jnp.float32
    L = DEPTH

    def nrm(k, shape, scale):
        return jax.random.normal(k, shape, f32) * scale

    def gain(k, n):
        return 1.0 + 0.02 * jax.random.normal(k, (L, n), f32)

    a8 = jax.random.uniform(ks[10], (L, LRU_WIDTH), f32, 0.9, 0.999)
    s = a8 ** (1.0 / LRU_C)
    lru_lambda = jnp.log(s) - jnp.log1p(-s)
    return {
        "x": nrm(ks[0], (BATCH, SEQ, D_MODEL), 1.0),
        "mem": nrm(ks[1], (BATCH, MEM_LEN, D_MODEL), 1.0),
        "norm_mix": gain(ks[2], D_MODEL),
        "w_in": nrm(ks[3], (L, D_MODEL, IN_WIDTH), D_MODEL ** -0.5),
        "conv_w": nrm(ks[4], (L, CONV_WIDTH, LRU_WIDTH), CONV_WIDTH ** -0.5),
        "conv_b": nrm(ks[5], (L, LRU_WIDTH), 0.01),
        "gate_a_w": nrm(ks[6], (L, LRU_BLOCKS, LRU_BLOCK, LRU_BLOCK), LRU_BLOCK ** -0.5),
        "gate_a_b": nrm(ks[7], (L, LRU_WIDTH), 0.01),
        "gate_x_w": nrm(ks[8], (L, LRU_BLOCKS, LRU_BLOCK, LRU_BLOCK), LRU_BLOCK ** -0.5),
        "gate_x_b": nrm(ks[9], (L, LRU_WIDTH), 0.01),
        "lru_lambda": lru_lambda,
        "rel_bias": nrm(ks[11], (L, ATT_HEADS, 2 * REL_CLIP + 1), 0.5),
        "norm_grp_a": gain(ks[12], LRU_WIDTH),
        "norm_grp_b": gain(ks[13], ATT_WIDTH),
        "w_out": nrm(ks[14], (L, MIX_WIDTH, D_MODEL), MIX_WIDTH ** -0.5),
        "norm_cross": gain(ks[15], D_MODEL),
        "norm_mem": gain(ks[16], D_MODEL),
        "w_q_mem": nrm(ks[17], (L, D_MODEL, D_MODEL), D_MODEL ** -0.5),
        "w_kv_mem": nrm(ks[18], (L, D_MODEL, 2 * D_MODEL), D_MODEL ** -0.5),
        "w_o_mem": nrm(ks[19], (L, D_MODEL, D_MODEL), D_MODEL ** -0.5),
        "norm_ffn": gain(ks[20], D_MODEL),
        "w_query": nrm(ks[21], (L, D_MODEL, PEER_HEADS * PEER_QUERY_DIM), D_MODEL ** -0.5),
        "sub_keys": nrm(ks[22], (L, PEER_HEADS, 2, N_KEYS, PEER_KEY_DIM), PEER_KEY_DIM ** -0.5),
        "expert_u": nrm(ks[23], (L, N_EXPERTS, D_MODEL), D_MODEL ** -0.5),
        "expert_v": nrm(ks[24], (L, N_EXPERTS, D_MODEL), PEER_HEADS ** -0.5),
        "norm_final": 1.0 + 0.02 * jax.random.normal(ks[25], (D_MODEL,), f32),
    }


def reference(x, mem, norm_mix, w_in, conv_w, conv_b, gate_a_w, gate_a_b, gate_x_w, gate_x_b,
              lru_lambda, rel_bias, norm_grp_a, norm_grp_b, w_out, norm_cross, norm_mem,
              w_q_mem, w_kv_mem, w_o_mem, norm_ffn, w_query, sub_keys, expert_u, expert_v,
              norm_final):
    splits = [LRU_WIDTH, 2 * LRU_WIDTH, 2 * LRU_WIDTH + ATT_WIDTH, 2 * LRU_WIDTH + 2 * ATT_WIDTH]
    for l in range(DEPTH):
        hn = _rmsnorm(x, norm_mix[l])
        z = hn @ w_in[l]
        x_lru, gate, q, k, v = jnp.split(z, splits, axis=-1)
        y_a = _rg_lru(x_lru, conv_w[l], conv_b[l], gate_a_w[l], gate_a_b[l],
                      gate_x_w[l], gate_x_b[l], lru_lambda[l]) * jax.nn.gelu(gate)
        y_b = _chunk_attention(q, k, v, rel_bias[l])
        y = jnp.concatenate([_rmsnorm(y_a, norm_grp_a[l]), _rmsnorm(y_b, norm_grp_b[l])], axis=-1)
        x = x + y @ w_out[l]
        x = x + _memory_cross_attention(_rmsnorm(x, norm_cross[l]), _rmsnorm(mem, norm_mem[l]),
                                        w_q_mem[l], w_kv_mem[l], w_o_mem[l])
        x = x + _peer(_rmsnorm(x, norm_ffn[l]), w_query[l], sub_keys[l], expert_u[l], expert_v[l])
    return _rmsnorm(x, norm_final)
```

```cpp
#include <hip/hip_runtime.h>
#include <cstdio>
#include <cstdint>
namespace pg8 {
#define PG8_LAS __attribute__((address_space(3)))
typedef unsigned short bf16_t;
typedef short bf16x8 __attribute__((ext_vector_type(8)));
typedef float f32x4 __attribute__((ext_vector_type(4)));
typedef unsigned u32x4 __attribute__((ext_vector_type(4)));
constexpr int BM = 256, BK = 64, HALF = 128, HTB = HALF * BK * 2  , STAGE_BYTES = 8 * HTB, NXCD = 8, WGM = 8;

__host__ __device__ __forceinline__ int lds_byte(int r, int c) { const int st = (r >> 4) * 2 + (c >> 5), rr = r & 15, cc = c & 31, ob = rr * 64 + cc * 2; return st * 1024 + (ob ^ (((ob >> 9) & 1) << 5)); }
__host__ __device__ __forceinline__ void stage_rc(int b, int& R, int& C) { const int st = b / 1024, sb = b % 1024, swz = sb ^ (((sb >> 9) & 1) << 5); R = (st >> 1) * 16 + swz / 64; C = (st & 1) * 32 + (swz % 64) / 2; }
__host__ __device__ __forceinline__ int perm32(int rho) { const int n = rho >> 4, i = rho & 15; return 8 * (i >> 2) + 4 * n + (i & 3); }

struct Unit { int pm, pn; };
struct Gemm { const bf16_t* A; const bf16_t* Bt; int M, N, K; };

struct StaticOrder {
    int nM, nN, nwg, G, c;
    __host__ __device__ void init(int M, int N, int G_, int c_) { nM = M / BM; nN = N / BM; nwg = nM * nN; G = G_; c = c_; }
    __host__ __device__ bool next(int i, Unit& u) const {
        const long L = (long)i * G + c; if (L >= nwg) return false;
        int wgid = (int)L; { const int q = nwg / NXCD, r = nwg % NXCD, xcd = wgid % NXCD, off = wgid / NXCD; wgid = (xcd < r ? xcd * (q + 1) : r * (q + 1) + (xcd - r) * q) + off; }
        const int nig = WGM * nN, gid = wgid / nig, fm = gid * WGM, gsz = (nM - fm) < WGM ? (nM - fm) : WGM;
        u.pm = fm + ((wgid % nig) % gsz); u.pn = (wgid % nig) / gsz; return true;
    }
    __device__ __forceinline__ void a_ready(const Unit&) const {}
    __device__ __forceinline__ void done(const Unit&) const {}
};

typedef float f32x2 __attribute__((ext_vector_type(2)));
typedef __bf16 bf16x2_t __attribute__((ext_vector_type(2)));
__device__ __forceinline__ unsigned cvt_pk_bf16(float lo, float hi) { f32x2 v = {lo, hi}; bf16x2_t b = __builtin_convertvector(v, bf16x2_t); return __builtin_bit_cast(unsigned, b); }
__device__ __forceinline__ bf16_t cvt_bf16(float x) { return (bf16_t)(cvt_pk_bf16(x, 0.f) & 0xffffu); }

struct EpiSplitT {
    static constexpr bool PERM = true, AFTER_DRAIN = false;
    bf16_t* O; int ldc; int ncols_rm; bf16_t* T; int NT; int rpb;
    __device__ __forceinline__ void operator()(const f32x4 (&acc)[2][2][4][2], const Unit& u, int wr, int wc, int fr, int fq) const {
        const int row0 = u.pm * BM + wr * 64 + fr; const int colt = u.pn * BM;
        if (colt < ncols_rm) {
            const int col0 = colt + wc * 32 + 8 * fq;
#pragma unroll
            for (int ai = 0; ai < 2; ++ai)
#pragma unroll
                for (int m = 0; m < 4; ++m) { bf16_t* rowp = O + (size_t)(row0 + ai * HALF + m * 16) * ldc + col0;
#pragma unroll
                    for (int bj = 0; bj < 2; ++bj) { const f32x4 v0 = acc[ai][bj][m][0], v1 = acc[ai][bj][m][1];
                        u32x4 w; w.x = cvt_pk_bf16(v0[0], v0[1]); w.y = cvt_pk_bf16(v0[2], v0[3]); w.z = cvt_pk_bf16(v1[0], v1[1]); w.w = cvt_pk_bf16(v1[2], v1[3]);
                        *(u32x4*)(rowp + bj * HALF) = w; } }
        } else {
            const int c0 = colt - ncols_rm + wc * 32 + 8 * fq;
#pragma unroll
            for (int ai = 0; ai < 2; ++ai)
#pragma unroll
                for (int m = 0; m < 4; ++m) { const int row = row0 + ai * HALF + m * 16; const int b = row / rpb, t = row - b * rpb; bf16_t* base = T + (size_t)b * NT * rpb + t;
#pragma unroll
                    for (int bj = 0; bj < 2; ++bj)
#pragma unroll
                        for (int n = 0; n < 2; ++n)
#pragma unroll
                            for (int e = 0; e < 4; ++e) base[(size_t)(c0 + bj * HALF + 4 * n + e) * rpb] = cvt_bf16(acc[ai][bj][m][n][e]); }
        }
    }
};
struct EpiResid {
    static constexpr bool PERM = true, AFTER_DRAIN = false;
    const float* base; float* out; bf16_t* xb; float* ssq; int ldc;
    __device__ __forceinline__ void operator()(const f32x4 (&acc)[2][2][4][2], const Unit& u, int wr, int wc, int fr, int fq) const {
        const int row0 = u.pm * BM + wr * 64 + fr; const int col0 = u.pn * BM + wc * 32 + 8 * fq;
#pragma unroll
        for (int ai = 0; ai < 2; ++ai)
#pragma unroll
            for (int m = 0; m < 4; ++m) { const int row = row0 + ai * HALF + m * 16; float s = 0.f;
#pragma unroll
                for (int bj = 0; bj < 2; ++bj) { const size_t off = (size_t)row * ldc + col0 + bj * HALF;
                    const f32x4 b0 = *(const f32x4*)(base + off), b1 = *(const f32x4*)(base + off + 4);
                    const f32x4 v0 = acc[ai][bj][m][0] + b0, v1 = acc[ai][bj][m][1] + b1;
                    *(f32x4*)(out + off) = v0; *(f32x4*)(out + off + 4) = v1;
                    s += (v0[0] * v0[0] + v0[1] * v0[1]) + (v0[2] * v0[2] + v0[3] * v0[3]) + (v1[0] * v1[0] + v1[1] * v1[1]) + (v1[2] * v1[2] + v1[3] * v1[3]);
                    u32x4 w; w.x = cvt_pk_bf16(v0[0], v0[1]); w.y = cvt_pk_bf16(v0[2], v0[3]); w.z = cvt_pk_bf16(v1[0], v1[1]); w.w = cvt_pk_bf16(v1[2], v1[3]);
                    *(u32x4*)(xb + off) = w; }
                s += __shfl_xor(s, 16); s += __shfl_xor(s, 32);
                if (fq == 0) ssq[(size_t)row * 16 + u.pn * 4 + wc] = s; }
    }
};
struct EpiRowScale {
    static constexpr bool PERM = true, AFTER_DRAIN = false;
    bf16_t* O; int ldc; const float* ssq; float inv_n, eps;
    __device__ __forceinline__ void operator()(const f32x4 (&acc)[2][2][4][2], const Unit& u, int wr, int wc, int fr, int fq) const {
        const int row0 = u.pm * BM + wr * 64 + fr; const int col0 = u.pn * BM + wc * 32 + 8 * fq;
#pragma unroll
        for (int ai = 0; ai < 2; ++ai)
#pragma unroll
            for (int m = 0; m < 4; ++m) { const int row = row0 + ai * HALF + m * 16; const f32x4* sp = (const f32x4*)(ssq + (size_t)row * 16);
                const f32x4 s0 = sp[0], s1 = sp[1], s2 = sp[2], s3 = sp[3]; const f32x4 st = (s0 + s1) + (s2 + s3);
                const float r = 1.0f / sqrtf(((st[0] + st[1]) + (st[2] + st[3])) * inv_n + eps);
                bf16_t* rowp = O + (size_t)row * ldc + col0;
#pragma unroll
                for (int bj = 0; bj < 2; ++bj) { const f32x4 v0 = acc[ai][bj][m][0] * r, v1 = acc[ai][bj][m][1] * r;
                    u32x4 w; w.x = cvt_pk_bf16(v0[0], v0[1]); w.y = cvt_pk_bf16(v0[2], v0[3]); w.z = cvt_pk_bf16(v1[0], v1[1]); w.w = cvt_pk_bf16(v1[2], v1[3]);
                    *(u32x4*)(rowp + bj * HALF) = w; } }
    }
};
struct OneUnit {
    int idx, nM, nN;
    __device__ __forceinline__ bool next(int i, Unit& u) const { if (i > 0 || idx < 0 || idx >= nM * nN) return false; u.pm = idx % nM; u.pn = idx / nM; return true; }
    __device__ __forceinline__ void a_ready(const Unit&) const {}
    __device__ __forceinline__ void done(const Unit&) const {}
};

template <class Epi, class Sched, bool ALIGN_EPI = false, bool SP2 = false>
__device__ __forceinline__ void gemm_phase(PG8_LAS unsigned char* lds, const Gemm g, const Sched& S, const Epi& E) {
    const int tid = threadIdx.x, wid = __builtin_amdgcn_readfirstlane(tid >> 6), lane = tid & 63, wr = wid >> 2, wc = wid & 3, fr = lane & 15, fq = lane >> 4;
    const int K = g.K, nt = K / BK;
    unsigned voffA[2], voffB[2];
#pragma unroll
    for (int i = 0; i < 2; ++i) { int R, C; stage_rc(tid * 16 + i * 8192, R, C); const int Rb = Epi::PERM ? ((R & ~31) + perm32(R & 31)) : R;
        voffA[i] = (unsigned)(R * K + C) * 2u; voffB[i] = (unsigned)(Rb * K + C) * 2u; }
    const size_t kstep = (size_t)(BK * 2);
    const size_t hstep = (size_t)HALF * K * 2;
    const size_t tstep = 2 * hstep;
    const unsigned ldsw = (unsigned)wid * 1024u;
    const int aoff = lds_byte(wr * 64 + fr, fq * 8), boff = lds_byte(wc * 32 + fr, fq * 8);
#define PG8_SA(b, h) (((b) * 2 + (h)) * HTB)
#define PG8_SB(b, h) ((4 + (b) * 2 + (h)) * HTB)
#define PG8_STAGE(bufoff, gbase, voff) do { _Pragma("unroll") for (int _i = 0; _i < 2; ++_i) \
        __builtin_amdgcn_global_load_lds((const unsigned*)((const char*)(gbase) + (voff)[_i]), (PG8_LAS unsigned*)(lds + (bufoff) + ldsw + _i * 8192), 16, 0, 0); } while (0)
#define PG8_LDA(dst, b, h) do { _Pragma("unroll") for (int m = 0; m < 4; ++m) _Pragma("unroll") for (int k = 0; k < 2; ++k) dst[m][k] = *(const PG8_LAS bf16x8*)(lds + PG8_SA(b, h) + aoff + m * 2048 + k * 1024); } while (0)
#define PG8_LDB(dst, b, h) do { _Pragma("unroll") for (int n = 0; n < 2; ++n) _Pragma("unroll") for (int k = 0; k < 2; ++k) dst[n][k] = *(const PG8_LAS bf16x8*)(lds + PG8_SB(b, h) + boff + n * 2048 + k * 1024); } while (0)
#define PG8_MMA(ai, bj, At, Bt) do { __builtin_amdgcn_s_setprio(1); _Pragma("unroll") for (int m = 0; m < 4; ++m) _Pragma("unroll") for (int n = 0; n < 2; ++n) _Pragma("unroll") for (int k = 0; k < 2; ++k) \
        acc[ai][bj][m][n] = __builtin_amdgcn_mfma_f32_16x16x32_bf16(Bt[n][k], At[m][k], acc[ai][bj][m][n], 0, 0, 0); __builtin_amdgcn_s_setprio(0); } while (0)
#define PG8_WAIT_V(n) asm volatile("s_waitcnt vmcnt(" #n ")" ::: "memory")
#define PG8_WAIT_L(n) asm volatile("s_waitcnt lgkmcnt(" #n ")" ::: "memory")
#define PG8_BAR __builtin_amdgcn_s_barrier()
#define PG8_SCHED __builtin_amdgcn_sched_barrier(0)
    Unit cur, nxt; int ui = 0;
    if (!S.next(0, cur)) return;
    f32x4 acc[2][2][4][2];
#pragma unroll
    for (int a = 0; a < 2; ++a)
#pragma unroll
        for (int b = 0; b < 2; ++b)
#pragma unroll
            for (int m = 0; m < 4; ++m)
#pragma unroll
                for (int n = 0; n < 2; ++n) acc[a][b][m][n] = (f32x4){0.f, 0.f, 0.f, 0.f};
    bf16x8 At[4][2], B0[2][2], B1[2][2];
    const char* cA = (const char*)g.A + (size_t)cur.pm * tstep; const char* cB = (const char*)g.Bt + (size_t)cur.pn * tstep;
    S.a_ready(cur);
    if constexpr (SP2) {
        PG8_STAGE(PG8_SB(0, 0), cB, voffB); PG8_STAGE(PG8_SB(0, 1), cB + hstep, voffB); PG8_STAGE(PG8_SA(0, 0), cA, voffA); PG8_STAGE(PG8_SA(0, 1), cA + hstep, voffA);
        if (wr == 1) PG8_BAR;
        PG8_WAIT_V(2); PG8_BAR;
        PG8_STAGE(PG8_SB(1, 0), cB + kstep, voffB); PG8_STAGE(PG8_SA(1, 0), cA + kstep, voffA); PG8_STAGE(PG8_SB(1, 1), cB + hstep + kstep, voffB);
        PG8_WAIT_V(6); PG8_BAR;
    } else {
        PG8_STAGE(PG8_SB(0, 0), cB, voffB); PG8_STAGE(PG8_SA(0, 0), cA, voffA); PG8_STAGE(PG8_SB(0, 1), cB + hstep, voffB); PG8_STAGE(PG8_SA(0, 1), cA + hstep, voffA);
        if (wr == 1) PG8_BAR;
        PG8_WAIT_V(4); PG8_BAR;
        PG8_STAGE(PG8_SB(1, 0), cB + kstep, voffB); PG8_STAGE(PG8_SA(1, 0), cA + kstep, voffA); PG8_STAGE(PG8_SB(1, 1), cB + hstep + kstep, voffB);
        PG8_WAIT_V(6); PG8_BAR;
    }
    for (;;) {
        const bool has_next = S.next(ui + 1, nxt);
        const char* nA = has_next ? (const char*)g.A + (size_t)nxt.pm * tstep : cA; const char* nB = has_next ? (const char*)g.Bt + (size_t)nxt.pn * tstep : cB;
        for (int t = 0; t < nt; t += 2) {
            const bool last = (t == nt - 2);
            const char* a1 = cA + (size_t)(t + 1) * kstep;
            const char* a2 = last ? nA : cA + (size_t)(t + 2) * kstep; const char* b2 = last ? nB : cB + (size_t)(t + 2) * kstep;
            const char* a3 = a2 + kstep; const char* b3 = b2 + kstep;
            if (last && has_next) S.a_ready(nxt);
            if constexpr (SP2) {
            PG8_LDB(B0, 0, 0); PG8_LDB(B1, 0, 1); PG8_SCHED; PG8_LDA(At, 0, 0); PG8_STAGE(PG8_SA(1, 1), a1 + hstep, voffA);
            PG8_WAIT_V(8); PG8_WAIT_L(0); PG8_BAR; PG8_MMA(0, 0, At, B0); PG8_MMA(0, 1, At, B1); PG8_BAR; PG8_SCHED;
            PG8_LDA(At, 0, 1); PG8_STAGE(PG8_SB(0, 0), b2, voffB); PG8_STAGE(PG8_SB(0, 1), b2 + hstep, voffB); PG8_STAGE(PG8_SA(0, 0), a2, voffA);
            PG8_WAIT_V(8); PG8_WAIT_L(0); PG8_BAR; PG8_MMA(1, 0, At, B0); PG8_MMA(1, 1, At, B1); PG8_BAR; PG8_SCHED;
            PG8_LDB(B0, 1, 0); PG8_LDB(B1, 1, 1); PG8_SCHED; PG8_LDA(At, 1, 0); PG8_STAGE(PG8_SA(0, 1), a2 + hstep, voffA);
            PG8_WAIT_V(8); PG8_WAIT_L(0); PG8_BAR; PG8_MMA(0, 0, At, B0); PG8_MMA(0, 1, At, B1); PG8_BAR; PG8_SCHED;
            PG8_LDA(At, 1, 1); PG8_STAGE(PG8_SB(1, 0), b3, voffB); PG8_STAGE(PG8_SB(1, 1), b3 + hstep, voffB); PG8_STAGE(PG8_SA(1, 0), a3, voffA);
            PG8_WAIT_V(8); PG8_WAIT_L(0); PG8_BAR; PG8_MMA(1, 0, At, B0); PG8_MMA(1, 1, At, B1); PG8_BAR; PG8_SCHED;
            } else {
            PG8_LDB(B0, 0, 0); PG8_SCHED; PG8_LDA(At, 0, 0); PG8_STAGE(PG8_SA(1, 1), a1 + hstep, voffA);
            PG8_WAIT_L(8); PG8_BAR; PG8_WAIT_L(0); PG8_MMA(0, 0, At, B0); PG8_BAR; PG8_SCHED;
            PG8_LDB(B1, 0, 1); PG8_STAGE(PG8_SB(0, 0), b2, voffB);
            PG8_BAR; PG8_WAIT_L(0); PG8_MMA(0, 1, At, B1); PG8_BAR;
            PG8_LDA(At, 0, 1); PG8_STAGE(PG8_SA(0, 0), a2, voffA);
            PG8_BAR; PG8_WAIT_L(0); PG8_MMA(1, 0, At, B0); PG8_BAR; PG8_SCHED;
            PG8_STAGE(PG8_SB(0, 1), b2 + hstep, voffB);
            PG8_WAIT_V(6); PG8_BAR; PG8_MMA(1, 1, At, B1); PG8_BAR;
            PG8_LDB(B0, 1, 0); PG8_SCHED; PG8_LDA(At, 1, 0); PG8_STAGE(PG8_SA(0, 1), a2 + hstep, voffA);
            PG8_WAIT_L(8); PG8_BAR; PG8_WAIT_L(0); PG8_MMA(0, 0, At, B0); PG8_BAR; PG8_SCHED;
            PG8_LDB(B1, 1, 1); PG8_STAGE(PG8_SB(1, 0), b3, voffB);
            PG8_BAR; PG8_WAIT_L(0); PG8_MMA(0, 1, At, B1); PG8_BAR;
            PG8_LDA(At, 1, 1); PG8_STAGE(PG8_SA(1, 0), a3, voffA);
            PG8_BAR; PG8_WAIT_L(0); PG8_MMA(1, 0, At, B0); PG8_BAR; PG8_SCHED;
            PG8_STAGE(PG8_SB(1, 1), b3 + hstep, voffB);
            PG8_WAIT_V(6); PG8_BAR; PG8_MMA(1, 1, At, B1); PG8_BAR;
            }
        }
        if constexpr (ALIGN_EPI) { if (wr == 0) PG8_BAR; }
        if constexpr (!Epi::AFTER_DRAIN) { E(acc, cur, wr, wc, fr, fq); S.done(cur); }
        if (!has_next) break;
#pragma unroll
        for (int a = 0; a < 2; ++a)
#pragma unroll
            for (int b = 0; b < 2; ++b)
#pragma unroll
                for (int m = 0; m < 4; ++m)
#pragma unroll
                    for (int n = 0; n < 2; ++n) acc[a][b][m][n] = (f32x4){0.f, 0.f, 0.f, 0.f};
        cur = nxt; cA = nA; cB = nB; ++ui;
        if constexpr (ALIGN_EPI) { if (wr == 1) PG8_BAR; }
    }
    PG8_WAIT_V(0);
    if constexpr (!ALIGN_EPI) { if (wr == 0) PG8_BAR; }
    PG8_BAR;
    if constexpr (Epi::AFTER_DRAIN) { E.fused(acc, cur, wr, wc, fr, fq, lds, wid, lane); S.done(cur); }
#undef PG8_SA
#undef PG8_SB
#undef PG8_STAGE
#undef PG8_LDA
#undef PG8_LDB
#undef PG8_MMA
#undef PG8_WAIT_V
#undef PG8_WAIT_L
#undef PG8_BAR
#undef PG8_SCHED
}
}

#ifndef PG8_SP2
#define PG8_SP2 true
#endif
#ifndef PG8_ALIGN
#define PG8_ALIGN true
#endif
constexpr int NWAVES = 8;
constexpr int NBATCH = 2, SEQ = 8192, DM = 1024, M = NBATCH * SEQ;
constexpr int INW = 2560, ZW = 2048;
constexpr int LRUW = 512, ATTW = 512, NCHUNK = SEQ / 64;
constexpr int NEXP = 16384, PEER_H = 8, NSEL = 128;
constexpr float EPS = 1e-6f;
constexpr float LOG2E = 1.4426950408889634f;

constexpr size_t MiB = 1u << 20;
constexpr size_t WS_CTL = 0, CTL_ZERO_BYTES = 1 * MiB;
constexpr size_t WS_WIN = 1 * MiB, WS_WOUT = 6 * MiB, WS_WQ = 8 * MiB, WS_WKV = 10 * MiB, WS_WO = 14 * MiB, WS_WQRY = 16 * MiB;
constexpr size_t WS_SUBK = 20 * MiB, WS_GATEW = 20 * MiB + 512 * 1024, WS_MEMN = 21 * MiB, WS_KM = 22 * MiB, WS_VMT = 23 * MiB, WS_AGG = 24 * MiB, WS_SSQ1 = 25 * MiB, WS_SSQ2 = 26 * MiB;
constexpr size_t WS_EU = 28 * MiB, WS_EV = 60 * MiB, WS_XN = 92 * MiB, WS_Z = 124 * MiB, WS_VT = 188 * MiB, WS_Y = 204 * MiB, WS_END = 236 * MiB;
constexpr size_t WS_QC = WS_Z, WS_OC = WS_Z + 32 * MiB, WS_QP = WS_Z, WS_IDX = WS_VT, WS_G = WS_VT + 8 * MiB;
constexpr int CW_BAR = 4096;

constexpr int RING_BYTES = 135168;
constexpr int LDSCTL_OFF = RING_BYTES, MISC_OFF = LDSCTL_OFF + 320;
constexpr int LDS_BYTES = 147456;

#define GAS __attribute__((address_space(1)))
#define LAS __attribute__((address_space(3)))
typedef unsigned short bf16;
typedef unsigned v4u __attribute__((ext_vector_type(4)));
typedef unsigned v2u __attribute__((ext_vector_type(2)));
typedef float f32x4 __attribute__((ext_vector_type(4)));
typedef float f32x2 __attribute__((ext_vector_type(2)));
typedef float f32x16 __attribute__((ext_vector_type(16)));
typedef short bf16x8 __attribute__((ext_vector_type(8)));
typedef __bf16 bf16x2_t __attribute__((ext_vector_type(2)));
typedef GAS unsigned gu32;
#define RLX_AGENT __ATOMIC_RELAXED, __HIP_MEMORY_SCOPE_AGENT
#define LDS_WAIT() asm volatile("s_waitcnt lgkmcnt(0)" ::: "memory")
#define VM_WAIT() asm volatile("s_waitcnt vmcnt(0)" ::: "memory")
#define MFMA32(a, b, c) __builtin_amdgcn_mfma_f32_32x32x16_bf16((a), (b), (c), 0, 0, 0)
#define DI __device__ __forceinline__

DI unsigned pk2(float lo, float hi) { f32x2 v = {lo, hi}; bf16x2_t b = __builtin_convertvector(v, bf16x2_t); return __builtin_bit_cast(unsigned, b); }
DI bf16 f2bf(float x) { return (bf16)(pk2(x, 0.f) & 0xffffu); }
DI float bf2f(bf16 x) { return __uint_as_float((unsigned)x << 16); }
DI float bflo(unsigned p) { return __uint_as_float(p << 16); }
DI float bfhi(unsigned p) { return __uint_as_float(p & 0xffff0000u); }
DI int crow(int reg, int hh) { return (reg & 3) + 8 * (reg >> 2) + 4 * hh; }
DI float swap32_partner(float x, int hh) { auto rr = __builtin_amdgcn_permlane32_swap(__float_as_uint(x), __float_as_uint(x), false, false); return __uint_as_float(hh ? rr[0] : rr[1]); }
DI float dpp_xor1(float x) { return __int_as_float(__builtin_amdgcn_update_dpp(0, __float_as_int(x), 0xB1, 0xf, 0xf, true)); }
DI float dpp_xor2(float x) { return __int_as_float(__builtin_amdgcn_update_dpp(0, __float_as_int(x), 0x4E, 0xf, 0xf, true)); }
DI float dpp_hmir(float x) { return __int_as_float(__builtin_amdgcn_update_dpp(0, __float_as_int(x), 0x141, 0xf, 0xf, true)); }
DI float dpp_mir(float x)  { return __int_as_float(__builtin_amdgcn_update_dpp(0, __float_as_int(x), 0x140, 0xf, 0xf, true)); }
DI float sum16(float x) { x += dpp_xor1(x); x += dpp_xor2(x); x += dpp_hmir(x); x += dpp_mir(x); return x; }
DI float sum32(float x) { x = sum16(x); auto rr = __builtin_amdgcn_permlane16_swap(__float_as_uint(x), __float_as_uint(x), false, false); return __uint_as_float(rr[0]) + __uint_as_float(rr[1]); }
DI float sum64(float x) { x = sum32(x); auto rr = __builtin_amdgcn_permlane32_swap(__float_as_uint(x), __float_as_uint(x), false, false); return __uint_as_float(rr[0]) + __uint_as_float(rr[1]); }
DI float rcp_(float x) { return __builtin_amdgcn_rcpf(x); }
DI float rsq_(float x) { return __builtin_amdgcn_rsqf(x); }
DI float exp2_(float x) { return __builtin_amdgcn_exp2f(x); }
DI float gelu_tanh(float x) { const float u = x * (1.5957691216057308f + 0.07135481627159768f * x * x); return x * rcp_(1.0f + exp2_(-LOG2E * u)); }
DI float sigmoidf_(float x) { return rcp_(1.0f + exp2_(-LOG2E * x)); }
#define XB_TMO      128
#define XB_XCNT(j)  (256  + 64 * (j))
#define XB_XSUB(j)  (1280 + 64 * (j))
#define XB_XGEN(j)  (2304 + 64 * (j))
#define XB_TOP      3328
#define XB_TOPGEN   3392
#define XCD_BAR_WORDS 3456
#define XB_SPIN_CAP (1u << 18)

__device__ __forceinline__ unsigned xb_ld(unsigned* p)              { return __hip_atomic_load(p, __ATOMIC_RELAXED, __HIP_MEMORY_SCOPE_AGENT); }
__device__ __forceinline__ unsigned xb_add(unsigned* p, unsigned v) { return __hip_atomic_fetch_add(p, v, __ATOMIC_RELAXED, __HIP_MEMORY_SCOPE_AGENT); }
__device__ __forceinline__ unsigned xb_xcc_id() { return (unsigned)__builtin_amdgcn_s_getreg((3 << 11) | 20) & 0xFu; }
#define XB_SPIN(cond, bar) do { unsigned _sp = 0; while (cond) { __builtin_amdgcn_s_sleep(1); \
    if ((++_sp & 255u) == 0u) { if (xb_ld(&(bar)[XB_TMO])) break; if (_sp > XB_SPIN_CAP) { atomicAdd(&(bar)[XB_TMO], 1u); break; } } } } while (0)

struct XcdBarrier {
    unsigned* bar; unsigned x;
    volatile LAS unsigned* st;
};

__device__ __forceinline__ XcdBarrier xcd_barrier_post(unsigned* bar, volatile LAS unsigned* st) {
    XcdBarrier b; b.bar = bar; b.x = xb_xcc_id(); b.st = st;
    if (threadIdx.x == 0) (void)xb_add(&bar[XB_XCNT(b.x)], 1u);
    return b;
}
__device__ __forceinline__ void xcd_barrier_complete(unsigned* bar, unsigned x, unsigned& nloc, unsigned& nx) {
    const unsigned G = gridDim.x * gridDim.y * gridDim.z;
    unsigned sum, cnt, mine, sp = 0u;
    for (;;) {
        sum = 0u; cnt = 0u; mine = 0u;
#pragma unroll
        for (unsigned j = 0; j < 16; ++j) { const unsigned c = xb_ld(&bar[XB_XCNT(j)]); sum += c; cnt += (c > 0u) ? 1u : 0u; mine = (j == x) ? c : mine; }
        if (sum == G) break;
        __builtin_amdgcn_s_sleep(1);
        if ((++sp & 255u) == 0u) { if (xb_ld(&bar[XB_TMO])) break; if (sp > XB_SPIN_CAP) { atomicAdd(&bar[XB_TMO], 1u); break; } }
    }
    nloc = mine > 0u ? mine : 1u; nx = cnt > 0u ? cnt : 1u;
}

__device__ __forceinline__ void xcd_barrier(const XcdBarrier& b) {
    asm volatile("s_waitcnt vmcnt(0)" ::: "memory");
    __syncthreads();
    if (threadIdx.x == 0) {
        unsigned* bar = b.bar;
        __builtin_amdgcn_s_waitcnt(0);
        unsigned nloc = b.st[0], nx = b.st[1];
        if (nloc == 0u) { xcd_barrier_complete(bar, b.x, nloc, nx); b.st[0] = nloc; b.st[1] = nx; }
        const unsigned old = xb_add(&bar[XB_XSUB(b.x)], 1u);
        const unsigned gen = old / nloc;
        if (old + 1u == (gen + 1u) * nloc) {
            __builtin_amdgcn_fence(__ATOMIC_RELEASE, "agent");
            asm volatile("s_waitcnt vmcnt(0)" ::: "memory");
            const unsigned og = xb_add(&bar[XB_TOP], 1u);
            const unsigned tg = og / nx;
            if (og + 1u == (tg + 1u) * nx) xb_add(&bar[XB_TOPGEN], 1u);
            else XB_SPIN(xb_ld(&bar[XB_TOPGEN]) == tg, bar);
            __builtin_amdgcn_fence(__ATOMIC_ACQUIRE, "agent");
            xb_add(&bar[XB_XGEN(b.x)], 1u);
            asm volatile("s_waitcnt vmcnt(0)" ::: "memory");
        } else {
            XB_SPIN(xb_ld(&bar[XB_XGEN(b.x)]) == gen, bar);
            __builtin_amdgcn_fence(__ATOMIC_ACQUIRE, "agent");
            asm volatile("s_waitcnt vmcnt(0)" ::: "memory");
        }
    }
    __syncthreads();
}
struct Args { const float* in[26]; float* out; unsigned char* ws; int ph_lo, ph_hi, li, pad; };
struct Frame {
    LAS unsigned char* lds;
    volatile LAS unsigned* MISC;
    gu32* ctl;
    int tid, lane, wave, vcu, G;
    const Args* A; float* out; unsigned char* ws;
    DI const float* in(int k) const { return A->in[k]; }
    template <class T> DI T* wsp(size_t off) const { return (T*)(ws + off); }
};

DI void p0_transpose_item(const float* W, int K, int N, bf16* WT, LAS float* scr, int item, int lane, const float* g0, const float* g1, int gsplit) {
    const int nblk = N / 32, kb = item / nblk, nb = item % nblk, k0 = 64 * kb, n0 = 32 * nb;
#pragma unroll 8
    for (int i = 0; i < 32; ++i) { const int kk = 2 * i + (lane >> 5); const int k = k0 + kk;
        float g = 1.f; if (g0) g = (k < gsplit) ? g0[k] : g1[k - gsplit];
        scr[kk * 33 + (lane & 31)] = W[(size_t)k * N + n0 + (lane & 31)] * g; }
    LDS_WAIT(); asm volatile("" ::: "memory");
    const int c = lane & 7;
#pragma unroll
    for (int j = 0; j < 4; ++j) { const int n = (lane >> 3) + 8 * j; const LAS float* s = scr + (8 * c) * 33 + n;
        v4u o; o.x = pk2(s[0 * 33], s[1 * 33]); o.y = pk2(s[2 * 33], s[3 * 33]); o.z = pk2(s[4 * 33], s[5 * 33]); o.w = pk2(s[6 * 33], s[7 * 33]);
        *(GAS v4u*)(WT + (size_t)(n0 + n) * K + k0 + 8 * c) = o; }
    LDS_WAIT(); asm volatile("" ::: "memory");
}
template <bool NORM> DI void row_to_bf16(const float* xrow, bf16* orow, const float* gain, int lane) {
    const GAS f32x4* xr = (const GAS f32x4*)xrow + lane;
    f32x4 v[4]; float s = 0.f;
#pragma unroll
    for (int j = 0; j < 4; ++j) { v[j] = xr[64 * j]; s += (v[j].x * v[j].x + v[j].y * v[j].y) + (v[j].z * v[j].z + v[j].w * v[j].w); }
    float rstd = 1.f;
    if (NORM) rstd = 1.0f / sqrtf(sum64(s) * (1.f / 1024.f) + EPS);
    GAS v2u* o8 = (GAS v2u*)orow + lane;
#pragma unroll
    for (int j = 0; j < 4; ++j) { f32x4 w = v[j] * rstd; if (gain) w = w * ((const GAS f32x4*)gain)[64 * j + lane];
        v2u o; o.x = pk2(w.x, w.y); o.y = pk2(w.z, w.w); o8[64 * j] = o; }
}
DI void p0_prologue(Frame& F) {
    LAS float* scr = (LAS float*)(F.lds + F.wave * 16384);
    const int gw = F.vcu * NWAVES + F.wave, NGW = F.G * NWAVES, lane = F.lane;
    constexpr int I_IN = 16 * (INW / 32), I_D = 16 * (DM / 32), I_2D = 16 * (2 * DM / 32);
    constexpr int NITEMS = I_IN + 3 * I_D + 2 * I_2D;
    for (int it = gw; it < NITEMS; it += NGW) {
        int r = it;
        if (r < I_IN) { p0_transpose_item(F.in(3), DM, INW, F.wsp<bf16>(WS_WIN), scr, r, lane, F.in(2), F.in(2), DM); continue; } r -= I_IN;
        if (r < I_D) { p0_transpose_item(F.in(14), DM, DM, F.wsp<bf16>(WS_WOUT), scr, r, lane, F.in(12), F.in(13), LRUW); continue; } r -= I_D;
        if (r < I_D) { p0_transpose_item(F.in(17), DM, DM, F.wsp<bf16>(WS_WQ), scr, r, lane, F.in(15), F.in(15), DM); continue; } r -= I_D;
        if (r < I_2D) { p0_transpose_item(F.in(18), DM, 2 * DM, F.wsp<bf16>(WS_WKV), scr, r, lane, nullptr, nullptr, 0); continue; } r -= I_2D;
        if (r < I_D) { p0_transpose_item(F.in(19), DM, DM, F.wsp<bf16>(WS_WO), scr, r, lane, nullptr, nullptr, 0); continue; } r -= I_D;
        p0_transpose_item(F.in(21), DM, 2 * DM, F.wsp<bf16>(WS_WQRY), scr, r, lane, F.in(20), F.in(20), DM);
    }
    for (int m = gw; m < M; m += NGW) row_to_bf16<true>(F.in(0) + (size_t)m * DM, F.wsp<bf16>(WS_XN) + (size_t)m * DM, nullptr, lane);
    for (int m = gw; m < NBATCH * 256; m += NGW) row_to_bf16<true>(F.in(1) + (size_t)m * DM, F.wsp<bf16>(WS_MEMN) + (size_t)m * DM, F.in(16), lane);
    for (int m = gw; m < NEXP; m += NGW) { row_to_bf16<false>(F.in(23) + (size_t)m * DM, F.wsp<bf16>(WS_EU) + (size_t)m * DM, F.in(20), lane);
                                            row_to_bf16<false>(F.in(24) + (size_t)m * DM, F.wsp<bf16>(WS_EV) + (size_t)m * DM, nullptr, lane); }
    { const int gt = gw * 64 + lane, NT = NGW * 64;
      for (int i = gt; i < 8 * 2 * 128 * 128 / 4; i += NT) { const f32x4 v = ((const GAS f32x4*)F.in(22))[i]; v2u o; o.x = pk2(v.x, v.y); o.y = pk2(v.z, v.w); ((GAS v2u*)F.wsp<bf16>(WS_SUBK))[i] = o; }
      for (int o = gt; o < 2 * 8 * 64 * 64; o += NT) { const int i = o & 63, j = (o >> 6) & 63, h = (o >> 12) & 7, g = o >> 15;
          const float* W = g ? F.in(8) : F.in(6); F.wsp<bf16>(WS_GATEW)[o] = f2bf(W[(h * 64 + i) * 64 + j]); } }
}
struct LruState { float ba[2], bx[2], sp[2], S[2], Ap[2]; };
template <bool PASS2>
DI void lru_prep(const Frame& F, int b, int chunk, int h, int lane, LAS unsigned char* xcs  , LruState& st) {
    const int r = lane & 31, hh = lane >> 5;
    const size_t row0 = (size_t)b * SEQ + (size_t)chunk * 64;
    {
        const int c2 = h * 64 + 2 * r;
        const f32x2 w0 = *(const f32x2*)(F.in(4) + c2), w1 = *(const f32x2*)(F.in(4) + LRUW + c2), w2 = *(const f32x2*)(F.in(4) + 2 * LRUW + c2), w3 = *(const f32x2*)(F.in(4) + 3 * LRUW + c2);
        const f32x2 cb = *(const f32x2*)(F.in(5) + c2);
        const int tl0 = 32 * hh;
        const bf16* zp = F.wsp<bf16>(WS_Z) + (row0 + tl0) * ZW + c2;
        const bool first = (chunk == 0 && hh == 0);
        unsigned p0 = first ? 0u : *(const unsigned*)(zp - 3 * ZW), p1 = first ? 0u : *(const unsigned*)(zp - 2 * ZW), p2 = first ? 0u : *(const unsigned*)(zp - ZW);
#pragma unroll 8
        for (int t = 0; t < 32; ++t) { const unsigned p3 = *(const unsigned*)(zp + (size_t)t * ZW);
            const float lo = cb.x + bflo(p0) * w0.x + bflo(p1) * w1.x + bflo(p2) * w2.x + bflo(p3) * w3.x;
            const float hi = cb.y + bfhi(p0) * w0.y + bfhi(p1) * w1.y + bfhi(p2) * w2.y + bfhi(p3) * w3.y;
            *(LAS unsigned*)(xcs + (tl0 + t) * 144 + 4 * r) = pk2(lo, hi);
            p0 = p1; p1 = p2; p2 = p3; }
        LDS_WAIT();
    }
#pragma unroll
    for (int nt = 0; nt < 2; ++nt) { const int c = h * 64 + 32 * nt + r; st.ba[nt] = F.in(7)[c]; st.bx[nt] = F.in(9)[c];
        const float nl = -F.in(10)[c]; st.sp[nt] = fmaxf(nl, 0.f) + log1pf(__expf(-fabsf(nl))); st.S[nt] = 0.f; st.Ap[nt] = 1.f; }
    if (PASS2) {
        float s = 0.f; const float* ag = F.wsp<float>(WS_AGG) + ((size_t)b * NCHUNK * LRUW + h * 64 + lane) * 2;
#pragma unroll 8
        for (int c = 0; c < chunk; ++c) { const f32x2 ab = *(const f32x2*)(ag + (size_t)c * LRUW * 2); s = ab.x * s + ab.y; }
        st.S[0] = __shfl(s, r); st.S[1] = __shfl(s, 32 + r);
    }
}
template <bool PASS2>
DI void lru_tile(const Frame& F, int b, int chunk, int mt, int h, int lane, LAS unsigned char* xcs, LAS unsigned char* gim  , LruState& st, float (&ssq)[16]) {
    const int r = lane & 31, hh = lane >> 5;
    const size_t row0 = (size_t)b * SEQ + (size_t)chunk * 64;
    const bf16* gw = F.wsp<bf16>(WS_GATEW) + (size_t)h * 4096;
    bf16x8 af[4];
#pragma unroll
    for (int s = 0; s < 4; ++s) af[s] = *(const LAS bf16x8*)(xcs + (32 * mt + r) * 144 + (16 * s + 8 * hh) * 2);
    float ssl[16];
#pragma unroll
    for (int i = 0; i < 16; ++i) ssl[i] = 0.f;
    if (PASS2) {
#pragma unroll
        for (int i = 0; i < 4; ++i) { const int row = (lane >> 3) + 8 * i, c = lane & 7;
            *(LAS v4u*)(gim + row * 144 + c * 16) = *(const v4u*)(F.wsp<bf16>(WS_Z) + (row0 + 32 * mt + row) * ZW + LRUW + h * 64 + 8 * c); }
        LDS_WAIT();
    }
#pragma unroll
    for (int nt = 0; nt < 2; ++nt) {
        asm volatile("" ::: "memory");
        f32x16 aa = {}, ax = {};
#pragma unroll
        for (int s = 0; s < 4; ++s) {
            const bf16x8 wa = *(const bf16x8*)(gw + (size_t)(32 * nt + r) * 64 + 16 * s + 8 * hh);
            const bf16x8 wx = *(const bf16x8*)(gw + 32768 + (size_t)(32 * nt + r) * 64 + 16 * s + 8 * hh);
            aa = MFMA32(af[s], wa, aa); ax = MFMA32(af[s], wx, ax);
        }
        float gt[16];
        if (PASS2) {
#pragma unroll
            for (int i = 0; i < 16; ++i) gt[i] = bf2f(*(const LAS bf16*)(gim + crow(i, hh) * 144 + (32 * nt + r) * 2));
        }
#pragma unroll
        for (int i = 0; i < 16; ++i) {
            const float rg = sigmoidf_(aa[i] + st.ba[nt]), ig = sigmoidf_(ax[i] + st.bx[nt]);
            const float la = -8.0f * rg * st.sp[nt];
            const float a = exp2_(LOG2E * la);
            const float mult = __builtin_amdgcn_sqrtf(fmaxf(1.0f - a * a, 0.f));
            const float xc = bf2f(*(const LAS bf16*)(xcs + (32 * mt + crow(i, hh)) * 144 + (32 * nt + r) * 2));
            aa[i] = a; ax[i] = mult * ig * xc;
        }
        float Ao[4], Bo[4], Aq[4], Bq[4], Sin[4];
#pragma unroll
        for (int q = 0; q < 4; ++q) { const float a0 = aa[4 * q], a1 = aa[4 * q + 1], a2 = aa[4 * q + 2], a3 = aa[4 * q + 3];
            Ao[q] = (a0 * a1) * (a2 * a3); Bo[q] = ((ax[4 * q] * a1 + ax[4 * q + 1]) * a2 + ax[4 * q + 2]) * a3 + ax[4 * q + 3];
            Aq[q] = swap32_partner(Ao[q], hh); Bq[q] = swap32_partner(Bo[q], hh); }
        float s_ = st.S[nt];
#pragma unroll
        for (int q = 0; q < 4; ++q) { const float A1 = hh ? Aq[q] : Ao[q], B1 = hh ? Bq[q] : Bo[q], A2 = hh ? Ao[q] : Aq[q], B2 = hh ? Bo[q] : Bq[q];
            const float smid = A1 * s_ + B1; Sin[q] = hh ? smid : s_; s_ = A2 * smid + B2; st.Ap[nt] *= A1 * A2; }
        st.S[nt] = s_;
        if (PASS2) {
#pragma unroll
            for (int q = 0; q < 4; ++q) { float hp = Sin[q];
#pragma unroll
                for (int e = 0; e < 4; ++e) { const int i = 4 * q + e; hp = aa[i] * hp + ax[i];
                    const float y = hp * gelu_tanh(gt[i]); ssl[i] += y * y;
                    *(LAS bf16*)(xcs + (32 * mt + crow(i, hh)) * 144 + (32 * nt + r) * 2) = f2bf(y); } }
        }
    }
    if (PASS2) {
#pragma unroll
        for (int i = 0; i < 16; ++i) ssq[i] = sum32(ssl[i]);
    }
}
DI void attn_wave(const Frame& F, int b, int n, int qt, int h, int lane, const LAS float* tab, f32x16 (&o)[2]) {
    const int r = lane & 31, hh = lane >> 5;
    const size_t row0 = (size_t)b * SEQ + (size_t)n * 64;
    const float SC = 0.125f * LOG2E;
    bf16x8 qf[4];
#pragma unroll
    for (int s = 0; s < 4; ++s) qf[s] = *(const bf16x8*)(F.wsp<bf16>(WS_Z) + (row0 + 32 * qt + r) * ZW + 2 * LRUW + h * 64 + 16 * s + 8 * hh);
    float mrun = -1e30f, lrun = 0.f;
#pragma unroll
    for (int dt = 0; dt < 2; ++dt) o[dt] = f32x16{};
    const float bfar = tab[256];
    const bf16* vtb = F.wsp<bf16>(WS_VT) + ((size_t)(b * 8 + h) * 64 + r) * SEQ + 4 * hh;
    for (int kc = (n >= 8 ? n - 8 : 0); kc <= n; ++kc) {
        const size_t krow0 = (size_t)b * SEQ + (size_t)kc * 64;
        const int dd = n - kc;
        bf16x8 kf[2][4];
#pragma unroll
        for (int kt = 0; kt < 2; ++kt)
#pragma unroll
            for (int s = 0; s < 4; ++s) kf[kt][s] = *(const bf16x8*)(F.wsp<bf16>(WS_Z) + (krow0 + 32 * kt + r) * ZW + 2 * LRUW + ATTW + h * 64 + 16 * s + 8 * hh);
        bf16x8 vf[2][2][2];
#pragma unroll
        for (int dt = 0; dt < 2; ++dt)
#pragma unroll
            for (int kt = 0; kt < 2; ++kt)
#pragma unroll
                for (int s2 = 0; s2 < 2; ++s2) { const bf16* p = vtb + (size_t)(32 * dt) * SEQ + kc * 64 + 32 * kt + 16 * s2;
                    const v2u lo = *(const v2u*)p, hi = *(const v2u*)(p + 8); v4u w; w.x = lo.x; w.y = lo.y; w.z = hi.x; w.w = hi.y; vf[dt][kt][s2] = __builtin_bit_cast(bf16x8, w); }
        f32x16 sc[2];
#pragma unroll
        for (int kt = 0; kt < 2; ++kt) { sc[kt] = f32x16{};
#pragma unroll
            for (int s = 0; s < 4; ++s) sc[kt] = MFMA32(kf[kt][s], qf[s], sc[kt]); }
        if (dd >= 3) {
#pragma unroll
            for (int kt = 0; kt < 2; ++kt)
#pragma unroll
                for (int i = 0; i < 16; ++i) sc[kt][i] = sc[kt][i] * SC + bfar;
        } else {
            const int base = 64 * dd + 32 * qt + r + 128;
#pragma unroll
            for (int kt = 0; kt < 2; ++kt)
#pragma unroll
                for (int i = 0; i < 16; ++i) { int idx = base - (32 * kt + crow(i, hh)); idx = idx > 256 ? 256 : idx; sc[kt][i] = sc[kt][i] * SC + tab[idx]; }
        }
        float mx = sc[0][0];
#pragma unroll
        for (int kt = 0; kt < 2; ++kt)
#pragma unroll
            for (int i = 0; i < 16; ++i) mx = fmaxf(mx, sc[kt][i]);
        mx = fmaxf(mx, swap32_partner(mx, hh));
        const float mnew = fmaxf(mrun, mx), alpha = exp2_(mrun - mnew);
        float ls = 0.f;
#pragma unroll
        for (int kt = 0; kt < 2; ++kt)
#pragma unroll
            for (int i = 0; i < 16; ++i) { const float p = exp2_(sc[kt][i] - mnew); sc[kt][i] = p; ls += p; }
        lrun = lrun * alpha + ls; mrun = mnew;
#pragma unroll
        for (int dt = 0; dt < 2; ++dt)
#pragma unroll
            for (int i = 0; i < 16; ++i) o[dt][i] *= alpha;
#pragma unroll
        for (int kt = 0; kt < 2; ++kt)
#pragma unroll
            for (int s2 = 0; s2 < 2; ++s2) { v4u w; w.x = pk2(sc[kt][8 * s2], sc[kt][8 * s2 + 1]); w.y = pk2(sc[kt][8 * s2 + 2], sc[kt][8 * s2 + 3]); w.z = pk2(sc[kt][8 * s2 + 4], sc[kt][8 * s2 + 5]); w.w = pk2(sc[kt][8 * s2 + 6], sc[kt][8 * s2 + 7]);
                const bf16x8 pf = __builtin_bit_cast(bf16x8, w);
#pragma unroll
                for (int dt = 0; dt < 2; ++dt) o[dt] = MFMA32(vf[dt][kt][s2], pf, o[dt]); }
    }
    const float lt = lrun + swap32_partner(lrun, hh); const float inv = rcp_(lt);
#pragma unroll
    for (int dt = 0; dt < 2; ++dt)
#pragma unroll
        for (int i = 0; i < 16; ++i) o[dt][i] *= inv;
}

DI void p2_lru_aggregates(Frame& F) {
    const int lane = F.lane, r = lane & 31, hh = lane >> 5, h = F.wave;
    LAS unsigned char* xcs = F.lds + 20480 + h * 13824;
    for (int u = F.vcu; u < NBATCH * NCHUNK; u += F.G) {
        const int b = u / NCHUNK, n = u % NCHUNK;
        LruState st; float ssq[16];
        lru_prep<false>(F, b, n, h, lane, xcs, st);
#pragma unroll 1
        for (int mt = 0; mt < 2; ++mt) lru_tile<false>(F, b, n, mt, h, lane, xcs, xcs + 9216, st, ssq);
        if (hh == 0) {
#pragma unroll
            for (int nt = 0; nt < 2; ++nt) *(f32x2*)(F.wsp<float>(WS_AGG) + (((size_t)b * NCHUNK + n) * LRUW + h * 64 + 32 * nt + r) * 2) = (f32x2){st.Ap[nt], st.S[nt]};
        }
        LDS_WAIT();
    }
}
DI void p3_mixer(Frame& F) {
    const int lane = F.lane, r = lane & 31, hh = lane >> 5, h = F.wave;
    LAS float* ssx = (LAS float*)(F.lds);
    LAS float* tab = (LAS float*)(F.lds + 4096 + h * 2048);
    LAS unsigned* stg = (LAS unsigned*)(F.lds + 20480 + h * 13824);
    for (int i = lane; i < 257; i += 64) tab[i] = F.in(11)[h * 257 + i] * LOG2E;
    LDS_WAIT();
    for (int u = F.vcu; u < NBATCH * NCHUNK; u += F.G) {
        const int b = u / NCHUNK, n = u % NCHUNK; const size_t row0 = (size_t)b * SEQ + (size_t)n * 64;
#ifndef MIX_PARTS
#define MIX_PARTS 3
#endif
        if (MIX_PARTS & 1) {
            LruState st;
            lru_prep<true>(F, b, n, h, lane, (LAS unsigned char*)stg, st);
#pragma unroll 1
            for (int mt = 0; mt < 2; ++mt) {
                float ssq[16];
                lru_tile<true>(F, b, n, mt, h, lane, (LAS unsigned char*)stg, (LAS unsigned char*)stg + 9216, st, ssq);
                if (r == 0) {
#pragma unroll
                    for (int i = 0; i < 16; ++i) ssx[crow(i, hh) * 8 + h] = ssq[i];
                }
                __syncthreads();
                const LAS unsigned char* yst = (const LAS unsigned char*)stg + 32 * mt * 144;
#pragma unroll
                for (int i = 0; i < 4; ++i) { const int row = (lane >> 3) + 8 * i, c = lane & 7;
                    const f32x4 s0 = *(const LAS f32x4*)(ssx + row * 8), s1 = *(const LAS f32x4*)(ssx + row * 8 + 4);
                    const float rs = rsq_(((s0.x + s0.y) + (s0.z + s0.w) + (s1.x + s1.y) + (s1.z + s1.w)) * (1.f / 512.f) + EPS);
                    const v4u v = *(const LAS v4u*)(yst + row * 144 + c * 16);
                    v4u o; o.x = pk2(bflo(v.x) * rs, bfhi(v.x) * rs); o.y = pk2(bflo(v.y) * rs, bfhi(v.y) * rs); o.z = pk2(bflo(v.z) * rs, bfhi(v.z) * rs); o.w = pk2(bflo(v.w) * rs, bfhi(v.w) * rs);
                    *(v4u*)(F.wsp<bf16>(WS_Y) + (row0 + 32 * mt + row) * DM + h * 64 + 8 * c) = o; }
                __syncthreads();
            }
        }
    }
    for (int u = F.vcu; u < NBATCH * NCHUNK; u += F.G) {
        const int b = u / NCHUNK, n = u % NCHUNK; const size_t row0 = (size_t)b * SEQ + (size_t)n * 64;
#pragma unroll 1
        for (int qt = 0; qt < ((MIX_PARTS & 2) ? 2 : 0); ++qt) {
            f32x16 o[2];
            attn_wave(F, b, n, qt, h, lane, tab, o);
            float s = 0.f;
#pragma unroll
            for (int dt = 0; dt < 2; ++dt)
#pragma unroll
                for (int i = 0; i < 16; ++i) s += o[dt][i] * o[dt][i];
            s += swap32_partner(s, hh);
            if (hh == 0) ssx[r * 8 + h] = s;
            __syncthreads();
            { const f32x4 s0 = *(const LAS f32x4*)(ssx + r * 8), s1 = *(const LAS f32x4*)(ssx + r * 8 + 4);
              const float rs = rsq_(((s0.x + s0.y) + (s0.z + s0.w) + (s1.x + s1.y) + (s1.z + s1.w)) * (1.f / 512.f) + EPS);
#pragma unroll
              for (int dt = 0; dt < 2; ++dt)
#pragma unroll
                  for (int i = 0; i < 16; i += 2) stg[r * 33 + ((32 * dt + crow(i, hh)) >> 1)] = pk2(o[dt][i] * rs, o[dt][i + 1] * rs); }
            LDS_WAIT();
#pragma unroll 4
            for (int i = 0; i < 16; ++i) { const int row = 2 * i + hh; const unsigned v = stg[row * 33 + r];
                *(GAS unsigned*)(F.wsp<bf16>(WS_Y) + (row0 + 32 * qt + row) * DM + LRUW + h * 64 + 2 * r) = v; }
            __syncthreads();
        }
    }
}
DI void p5_cross(Frame& F) {
    const int lane = F.lane, r = lane & 31, hh = lane >> 5, w = F.wave, tid = F.tid;
    constexpr int KST = 528, VST = 520;
    const float SC = 0.0625f * LOG2E;
    for (int u = F.vcu; u < NBATCH * 4 * 32; u += F.G) {
        const int b = u >> 7, hm = (u >> 5) & 3, qb = u & 31;
        const size_t qrow = (size_t)b * SEQ + (size_t)qb * 256 + 32 * w + r;
        { const bf16* src = F.wsp<bf16>(WS_KM) + (size_t)(b * 256) * DM + hm * 256;
#pragma unroll 4
          for (int i = 0; i < 16; ++i) { const int c = i * 512 + tid, row = c >> 5, ch = c & 31;
              *(LAS v4u*)(F.lds + row * KST + ch * 16) = *(const v4u*)(src + (size_t)row * DM + ch * 8); } }
        __syncthreads();
        f32x16 sc[8];
#pragma unroll
        for (int kt = 0; kt < 8; ++kt) sc[kt] = f32x16{};
#pragma unroll 2
        for (int s = 0; s < 16; ++s) {
            const bf16x8 qf = *(const bf16x8*)(F.wsp<bf16>(WS_QC) + qrow * DM + hm * 256 + 16 * s + 8 * hh);
#pragma unroll
            for (int kt = 0; kt < 8; ++kt) { const bf16x8 kf = *(const LAS bf16x8*)(F.lds + (32 * kt + r) * KST + (16 * s + 8 * hh) * 2); sc[kt] = MFMA32(kf, qf, sc[kt]); }
        }
        float mx = sc[0][0];
#pragma unroll
        for (int kt = 0; kt < 8; ++kt)
#pragma unroll
            for (int i = 0; i < 16; ++i) mx = fmaxf(mx, sc[kt][i]);
        mx = fmaxf(mx, swap32_partner(mx, hh));
        float ls = 0.f; const float mo = mx * SC;
        bf16x8 pf[8][2];
#pragma unroll
        for (int kt = 0; kt < 8; ++kt) {
#pragma unroll
            for (int i = 0; i < 16; ++i) { const float p = exp2_(sc[kt][i] * SC - mo); sc[kt][i] = p; ls += p; }
#pragma unroll
            for (int s2 = 0; s2 < 2; ++s2) { v4u wv; wv.x = pk2(sc[kt][8 * s2], sc[kt][8 * s2 + 1]); wv.y = pk2(sc[kt][8 * s2 + 2], sc[kt][8 * s2 + 3]); wv.z = pk2(sc[kt][8 * s2 + 4], sc[kt][8 * s2 + 5]); wv.w = pk2(sc[kt][8 * s2 + 6], sc[kt][8 * s2 + 7]);
                pf[kt][s2] = __builtin_bit_cast(bf16x8, wv); }
        }
        ls += swap32_partner(ls, hh);
        const float inv = 1.0f / ls;
        __syncthreads();
        { const bf16* src = F.wsp<bf16>(WS_VMT) + (size_t)((b * 4 + hm) * 256) * 256;
#pragma unroll 4
          for (int i = 0; i < 16; ++i) { const int c = i * 512 + tid, row = c >> 5, ch = c & 31; const v4u v = *(const v4u*)(src + (size_t)row * 256 + ch * 8);
              LAS v2u* d = (LAS v2u*)(F.lds + row * VST + ch * 16); d[0] = (v2u){v.x, v.y}; d[1] = (v2u){v.z, v.w}; } }
        __syncthreads();
        LAS unsigned* stg = (LAS unsigned*)(F.lds) ;
#pragma unroll
        for (int half = 0; half < 2; ++half) {
            f32x16 o[4];
#pragma unroll
            for (int dt = 0; dt < 4; ++dt) o[dt] = f32x16{};
#pragma unroll
            for (int kt = 0; kt < 8; ++kt)
#pragma unroll
                for (int s2 = 0; s2 < 2; ++s2)
#pragma unroll
                    for (int dt = 0; dt < 4; ++dt) { const LAS unsigned char* p = F.lds + (128 * half + 32 * dt + r) * VST + (32 * kt + 16 * s2 + 4 * hh) * 2;
                        const v2u lo = *(const LAS v2u*)p, hi = *(const LAS v2u*)(p + 16); v4u wv; wv.x = lo.x; wv.y = lo.y; wv.z = hi.x; wv.w = hi.y;
                        o[dt] = MFMA32(__builtin_bit_cast(bf16x8, wv), pf[kt][s2], o[dt]); }
            if (half == 1) __syncthreads();
            else {   }
            if (half == 0) {
#pragma unroll
                for (int dt = 0; dt < 4; ++dt)
#pragma unroll
                    for (int i = 0; i < 16; i += 2) { const unsigned pv = pk2(o[dt][i] * inv, o[dt][i + 1] * inv); sc[dt][i >> 1] = __uint_as_float(pv); }
            } else {
                LAS unsigned* sw = (LAS unsigned*)(F.lds + w * 16512);
#pragma unroll
                for (int dt = 0; dt < 4; ++dt)
#pragma unroll
                    for (int i = 0; i < 16; i += 2) { sw[r * 129 + ((32 * dt + crow(i, hh)) >> 1)] = __float_as_uint(sc[dt][i >> 1]);
                        sw[r * 129 + 64 + ((32 * dt + crow(i, hh)) >> 1)] = pk2(o[dt][i] * inv, o[dt][i + 1] * inv); }
                LDS_WAIT();
#pragma unroll 4
                for (int i = 0; i < 32; ++i) { const unsigned v0 = sw[i * 129 + lane], v1 = sw[i * 129 + 64 + lane];
                    GAS unsigned* dst = (GAS unsigned*)(F.wsp<bf16>(WS_OC) + ((size_t)b * SEQ + (size_t)qb * 256 + 32 * w + i) * DM + hm * 256);
                    dst[lane] = v0; dst[64 + lane] = v1; }
            }
        }
        (void)stg;
        __syncthreads();
    }
}
template <int N> DI void ce_desc(float (&a)[N], int i, int l) { const float hi = fmaxf(a[i], a[l]), lo = fminf(a[i], a[l]); a[i] = hi; a[l] = lo; }
template <int N, int OFF> DI void bitonic_sort16_desc(float (&a)[N]) {
#pragma unroll
    for (int k = 2; k <= 16; k <<= 1)
#pragma unroll
        for (int j = k >> 1; j > 0; j >>= 1)
#pragma unroll
            for (int i = 0; i < 16; ++i) { const int l = i ^ j; if (l > i) { const bool desc = ((i & k) == 0) || (k == 16);
                if (desc) ce_desc<N>(a, OFF + i, OFF + l); else ce_desc<N>(a, OFF + l, OFF + i); } }
}
template <int N, int OFF> DI void bitonic_merge16_desc(float (&a)[N]) {
#pragma unroll
    for (int j = 8; j > 0; j >>= 1)
#pragma unroll
        for (int i = 0; i < 16; ++i) { const int l = i ^ j; if (l > i) ce_desc<N>(a, OFF + i, OFF + l); }
}
template <bool SORTED> DI void top16_of_64(float (&a)[64]) {
    bitonic_sort16_desc<64, 0>(a); bitonic_sort16_desc<64, 16>(a); bitonic_sort16_desc<64, 32>(a); bitonic_sort16_desc<64, 48>(a);
#pragma unroll
    for (int i = 0; i < 16; ++i) { a[i] = fmaxf(a[i], a[31 - i]); a[32 + i] = fmaxf(a[32 + i], a[63 - i]); }
    bitonic_merge16_desc<64, 0>(a); bitonic_merge16_desc<64, 32>(a);
#pragma unroll
    for (int i = 0; i < 16; ++i) a[i] = fmaxf(a[i], a[47 - i]);
    if (SORTED) bitonic_merge16_desc<64, 0>(a);
}
DI void p8a_topk(Frame& F) {
    const int lane = F.lane, r = lane & 31, hh = lane >> 5, w = F.wave;
    LAS float* tbl = (LAS float*)(F.lds + w * 8192);
    const int gw = F.vcu * NWAVES + w, NGW = F.G * NWAVES;
    for (int task = gw; task < (M / 32) * PEER_H; task += NGW) {
        const int h = task & 7, tt = task >> 3; const size_t tok = (size_t)tt * 32 + r;
        float v[2][16];
#pragma unroll
        for (int p = 0; p < 2; ++p) {
            f32x16 sc[4];
#pragma unroll
            for (int nt = 0; nt < 4; ++nt) sc[nt] = f32x16{};
            const bf16* sk = F.wsp<bf16>(WS_SUBK) + (size_t)((h * 2 + p) * 128) * 128;
#pragma unroll 2
            for (int s = 0; s < 8; ++s) { const bf16x8 qf = *(const bf16x8*)(F.wsp<bf16>(WS_QP) + tok * 2048 + h * 256 + p * 128 + 16 * s + 8 * hh);
#pragma unroll
                for (int nt = 0; nt < 4; ++nt) { const bf16x8 kf = *(const bf16x8*)(sk + (size_t)(32 * nt + r) * 128 + 16 * s + 8 * hh); sc[nt] = MFMA32(kf, qf, sc[nt]); } }
            float a[64];
#pragma unroll
            for (int nt = 0; nt < 4; ++nt)
#pragma unroll
                for (int i = 0; i < 16; ++i) a[nt * 16 + i] = __uint_as_float((__float_as_uint(sc[nt][i]) & ~127u) | (unsigned)(32 * nt + crow(i, hh)));
            top16_of_64<true>(a);
            float m[16];
#pragma unroll
            for (int i = 0; i < 16; ++i) m[i] = fmaxf(a[i], swap32_partner(a[15 - i], hh));
            bitonic_merge16_desc<16, 0>(m);
#pragma unroll
            for (int i = 0; i < 16; ++i) v[p][i] = m[i];
        }
        float c[64]; int n = 0;
#pragma unroll
        for (int i = 0; i < 16; ++i)
#pragma unroll
            for (int j = 0; j < 16; ++j) if ((i + 1) * (j + 1) <= 16) { c[n] = __uint_as_float((__float_as_uint(v[0][i] + v[1][j]) & ~255u) | (unsigned)((i << 4) | j)); ++n; }
#pragma unroll
        for (int k = 50; k < 64; ++k) c[k] = -3.0e38f;
        top16_of_64<false>(c);
#pragma unroll
        for (int i = 0; i < 16; ++i) { tbl[i * 64 + lane] = v[0][i]; tbl[(16 + i) * 64 + lane] = v[1][i]; }
        LDS_WAIT();
        float sv[16]; int ev[16]; float mx = -3.0e38f;
#pragma unroll
        for (int k = 0; k < 16; ++k) { const unsigned pl = __float_as_uint(c[k]) & 255u; const float a1 = tbl[(pl >> 4) * 64 + lane], a2 = tbl[(16 + (pl & 15)) * 64 + lane];
            sv[k] = a1 + a2; ev[k] = (int)(((__float_as_uint(a1) & 127u) << 7) | (__float_as_uint(a2) & 127u)); mx = fmaxf(mx, sv[k]); }
        float sum = 0.f;
#pragma unroll
        for (int k = 0; k < 16; ++k) { sv[k] = __expf(sv[k] - mx); sum += sv[k]; }
        const float inv = 1.0f / sum;
        if (hh == 0) {
#pragma unroll
            for (int k = 0; k < 16; k += 4) *(v4u*)(F.wsp<int>(WS_IDX) + tok * NSEL + h * 16 + k) = (v4u){(unsigned)ev[k], (unsigned)ev[k + 1], (unsigned)ev[k + 2], (unsigned)ev[k + 3]};
        } else {
#pragma unroll
            for (int k = 0; k < 16; k += 4) *(f32x4*)(F.wsp<float>(WS_G) + tok * NSEL + h * 16 + k) = (f32x4){sv[k] * inv, sv[k + 1] * inv, sv[k + 2] * inv, sv[k + 3] * inv};
        }
        LDS_WAIT();
    }
}
DI float dot2_(unsigned a, unsigned b, float s) { return __builtin_amdgcn_fdot2_f32_bf16(__builtin_bit_cast(bf16x2_t, a), __builtin_bit_cast(bf16x2_t, b), s, false); }
DI float dot16(const v4u& a0, const v4u& a1, const v4u& b0, const v4u& b1) {
    float s = 0.f;
    s = dot2_(a0.x, b0.x, s); s = dot2_(a0.y, b0.y, s); s = dot2_(a0.z, b0.z, s); s = dot2_(a0.w, b0.w, s);
    s = dot2_(a1.x, b1.x, s); s = dot2_(a1.y, b1.y, s); s = dot2_(a1.z, b1.z, s); s = dot2_(a1.w, b1.w, s);
    return s;
}
DI void axpy16(float (&o)[16], float w, const v4u& v0, const v4u& v1) {
    o[0] += w * bflo(v0.x); o[1] += w * bfhi(v0.x); o[2] += w * bflo(v0.y); o[3] += w * bfhi(v0.y); o[4] += w * bflo(v0.z); o[5] += w * bfhi(v0.z); o[6] += w * bflo(v0.w); o[7] += w * bfhi(v0.w);
    o[8] += w * bflo(v1.x); o[9] += w * bfhi(v1.x); o[10] += w * bflo(v1.y); o[11] += w * bfhi(v1.y); o[12] += w * bflo(v1.z); o[13] += w * bfhi(v1.z); o[14] += w * bflo(v1.w); o[15] += w * bfhi(v1.w);
}
DI void p8b_peer(Frame& F) {
    const int lane = F.lane;
    const int gw = F.vcu * NWAVES + F.wave, NGW = F.G * NWAVES;
    for (int tok = gw; tok < M; tok += NGW) {
        const v4u x0 = *(const v4u*)(F.wsp<bf16>(WS_XN) + (size_t)tok * DM + 8 * lane), x1 = *(const v4u*)(F.wsp<bf16>(WS_XN) + (size_t)tok * DM + 512 + 8 * lane);
        float rstd; { const f32x4* sp = (const f32x4*)(F.wsp<float>(WS_SSQ2) + (size_t)tok * 16); const f32x4 st = (sp[0] + sp[1]) + (sp[2] + sp[3]); rstd = 1.0f / sqrtf(((st.x + st.y) + (st.z + st.w)) * (1.f / 1024.f) + EPS); }
        const int e0 = F.wsp<int>(WS_IDX)[(size_t)tok * NSEL + lane], e1 = F.wsp<int>(WS_IDX)[(size_t)tok * NSEL + 64 + lane];
        const float g0 = F.wsp<float>(WS_G)[(size_t)tok * NSEL + lane], g1 = F.wsp<float>(WS_G)[(size_t)tok * NSEL + 64 + lane];
        float o[16];
#pragma unroll
        for (int i = 0; i < 16; ++i) o[i] = 0.f;
#ifdef DBG_PEER_F32
        {
            const float* xr_ = F.out + (size_t)tok * DM; const float* gf = F.in(20);
            float xf[16], ss_ = 0.f;
#pragma unroll
            for (int i = 0; i < 8; ++i) { xf[i] = xr_[8 * lane + i]; xf[8 + i] = xr_[512 + 8 * lane + i]; }
#pragma unroll
            for (int i = 0; i < 16; ++i) ss_ += xf[i] * xf[i];
            const float rs_ = 1.0f / sqrtf(sum64(ss_) * (1.f / 1024.f) + EPS);
#ifdef DBG_BF16_TABLES
            for (int i = 0; i < 8; ++i) { xf[i] *= rs_; xf[8 + i] *= rs_; } (void)gf;
#else
            for (int i = 0; i < 8; ++i) { xf[i] *= rs_ * gf[8 * lane + i]; xf[8 + i] *= rs_ * gf[512 + 8 * lane + i]; }
#endif
            for (int kk = 0; kk < 128; ++kk) {
                const int e = __shfl(kk < 64 ? e0 : e1, kk & 63); const float g = __shfl(kk < 64 ? g0 : g1, kk & 63);
                const float* ur = F.in(23) + (size_t)e * DM; const float* vr = F.in(24) + (size_t)e * DM;
                float d_ = 0.f;
#ifdef DBG_BF16_TABLES
                const bf16* ub = F.wsp<bf16>(WS_EU) + (size_t)e * DM; const bf16* vb = F.wsp<bf16>(WS_EV) + (size_t)e * DM; (void)ur; (void)vr;
#pragma unroll
                for (int i = 0; i < 8; ++i) { d_ += xf[i] * bf2f(ub[8 * lane + i]); d_ += xf[8 + i] * bf2f(ub[512 + 8 * lane + i]); }
#else
#pragma unroll
                for (int i = 0; i < 8; ++i) { d_ += xf[i] * ur[8 * lane + i]; d_ += xf[8 + i] * ur[512 + 8 * lane + i]; }
#endif
                d_ = sum64(d_);
                const float wgt = g * gelu_tanh(d_);
#ifdef DBG_BF16_TABLES
#pragma unroll
                for (int i = 0; i < 8; ++i) { o[i] += wgt * bf2f(vb[8 * lane + i]); o[8 + i] += wgt * bf2f(vb[512 + 8 * lane + i]); }
#else
#pragma unroll
                for (int i = 0; i < 8; ++i) { o[i] += wgt * vr[8 * lane + i]; o[8 + i] += wgt * vr[512 + 8 * lane + i]; }
#endif
            }
        }
#else
#pragma unroll
        for (int grp = 0; grp < 8; ++grp) {
            float d[16];
#pragma unroll
            for (int k = 0; k < 16; ++k) { const int kk = grp * 16 + k; const int e = __builtin_amdgcn_readlane(kk < 64 ? e0 : e1, kk & 63);
                const bf16* ur = F.wsp<bf16>(WS_EU) + (size_t)e * DM;
                const v4u u0 = *(const v4u*)(ur + 8 * lane), u1 = *(const v4u*)(ur + 512 + 8 * lane);
                d[k] = dot16(x0, x1, u0, u1); }
#pragma unroll
            for (int k = 0; k < 16; ++k) d[k] = sum64(d[k]);
#pragma unroll
            for (int k = 0; k < 16; ++k) { const int kk = grp * 16 + k; const int e = __builtin_amdgcn_readlane(kk < 64 ? e0 : e1, kk & 63);
                const float g = __builtin_bit_cast(float, __builtin_amdgcn_readlane(__builtin_bit_cast(int, kk < 64 ? g0 : g1), kk & 63));
                #ifdef DBG_UNIFORM_G
                const float wgt = (1.f / 16.f) * gelu_tanh(d[k] * rstd); (void)g;
#else
                const float wgt = g * gelu_tanh(d[k] * rstd);
#endif
                const bf16* vr = F.wsp<bf16>(WS_EV) + (size_t)e * DM;
                const v4u v0 = *(const v4u*)(vr + 8 * lane), v1 = *(const v4u*)(vr + 512 + 8 * lane);
                axpy16(o, wgt, v0, v1); }
        }
#endif
#ifdef DBG_PEER_SCALE
#pragma unroll
        for (int i = 0; i < 16; ++i) o[i] *= (float)(DBG_PEER_SCALE);
#endif
        float* xr = F.out + (size_t)tok * DM;
        f32x4 a[4]; a[0] = *(const f32x4*)(xr + 8 * lane); a[1] = *(const f32x4*)(xr + 8 * lane + 4); a[2] = *(const f32x4*)(xr + 512 + 8 * lane); a[3] = *(const f32x4*)(xr + 512 + 8 * lane + 4);
        float ss = 0.f;
#pragma unroll
        for (int j = 0; j < 4; ++j) { a[j].x += o[4 * j]; a[j].y += o[4 * j + 1]; a[j].z += o[4 * j + 2]; a[j].w += o[4 * j + 3]; ss += (a[j].x * a[j].x + a[j].y * a[j].y) + (a[j].z * a[j].z + a[j].w * a[j].w); }
        const float rf = 1.0f / sqrtf(sum64(ss) * (1.f / 1024.f) + EPS);
        const f32x4 n0 = *(const f32x4*)(F.in(25) + 8 * lane), n1 = *(const f32x4*)(F.in(25) + 8 * lane + 4), n2 = *(const f32x4*)(F.in(25) + 512 + 8 * lane), n3 = *(const f32x4*)(F.in(25) + 512 + 8 * lane + 4);
        *(f32x4*)(xr + 8 * lane) = a[0] * rf * n0; *(f32x4*)(xr + 8 * lane + 4) = a[1] * rf * n1; *(f32x4*)(xr + 512 + 8 * lane) = a[2] * rf * n2; *(f32x4*)(xr + 512 + 8 * lane + 4) = a[3] * rf * n3;
    }
}
constexpr int N_PHASES = 11;
__global__ void __launch_bounds__(NWAVES * 64, 2) fwd_kernel(Args args) {
    extern __shared__ __attribute__((aligned(16))) unsigned char lds[];
    Frame F;
    F.lds = (LAS unsigned char*)lds;
    F.MISC = (volatile LAS unsigned*)(F.lds + MISC_OFF);
    F.tid = threadIdx.x; F.lane = F.tid & 63; F.wave = __builtin_amdgcn_readfirstlane(F.tid >> 6);
    F.G = gridDim.x; { const int bx = blockIdx.x; F.vcu = (F.G % 8 == 0) ? (bx % 8) * (F.G / 8) + bx / 8 : bx; }
    F.A = &args; F.ws = args.ws; F.out = args.out;
    F.ctl = (gu32*)(args.ws + WS_CTL);
    for (int u = F.tid; u < (LDS_BYTES - LDSCTL_OFF) / 4; u += NWAVES * 64) ((LAS unsigned*)(F.lds + LDSCTL_OFF))[u] = 0u;
    __syncthreads();
    const bool multi = (args.ph_hi - args.ph_lo) > 1;
    XcdBarrier bar; bar.bar = (unsigned*)(F.ctl + CW_BAR) + args.li * XCD_BAR_WORDS; bar.x = 0; bar.st = nullptr;
    if (multi) bar = xcd_barrier_post((unsigned*)(F.ctl + CW_BAR) + args.li * XCD_BAR_WORDS, F.MISC + 8);
    const int lo = args.ph_lo, hi = args.ph_hi;
#ifndef PHASE_MASK
#define PHASE_MASK 0x7ff
#endif
#define IN(k) (((PHASE_MASK >> (k)) & 1) && lo <= (k) && (k) < hi)
#define SEAM(k) do { asm volatile("; ===SEAM " #k ::: "memory"); if (IN(k) && IN((k) + 1)) xcd_barrier(bar); } while (0)
    const int c = (int)blockIdx.x;

    if (IN(0)) { p0_prologue(F); } SEAM(0);
    if (IN(1)) {
        { pg8::Gemm g{F.wsp<bf16>(WS_XN), F.wsp<bf16>(WS_WIN), M, INW, DM}; pg8::StaticOrder S; S.init(M, INW, F.G, c);
          pg8::EpiSplitT E{F.wsp<bf16>(WS_Z), ZW, ZW, F.wsp<bf16>(WS_VT), ATTW, SEQ};
          pg8::gemm_phase<pg8::EpiSplitT, pg8::StaticOrder, true, true>(F.lds, g, S, E); }
        { const int nw3 = (M / 256) * (INW / 256) - 2 * F.G;
          int idx = -1; if (nw3 >= 0 && nw3 + 16 <= F.G) idx = c - nw3; else idx = (c < 16 && F.G >= 16) ? c : -1;
          if (F.G < 16) idx = -1;
          pg8::Gemm g{F.wsp<bf16>(WS_MEMN), F.wsp<bf16>(WS_WKV), NBATCH * 256, 2 * DM, DM};
          if (F.G >= 16) { pg8::OneUnit S{idx, 2, 8}; pg8::EpiSplitT E{F.wsp<bf16>(WS_KM), DM, DM, F.wsp<bf16>(WS_VMT), DM, 256};
              pg8::gemm_phase<pg8::EpiSplitT, pg8::OneUnit, false, true>(F.lds, g, S, E); }
          else { pg8::StaticOrder S; S.init(NBATCH * 256, 2 * DM, F.G, c); pg8::EpiSplitT E{F.wsp<bf16>(WS_KM), DM, DM, F.wsp<bf16>(WS_VMT), DM, 256};
              pg8::gemm_phase<pg8::EpiSplitT, pg8::StaticOrder, false, true>(F.lds, g, S, E); } }
    } SEAM(1);
    if (IN(2)) { p2_lru_aggregates(F); } SEAM(2);
    if (IN(3)) { p3_mixer(F); } SEAM(3);
    if (IN(4)) {
        pg8::Gemm g{F.wsp<bf16>(WS_Y), F.wsp<bf16>(WS_WOUT), M, DM, DM}; pg8::StaticOrder S; S.init(M, DM, F.G, c);
        pg8::EpiResid E{F.in(0), F.out, F.wsp<bf16>(WS_XN), F.wsp<float>(WS_SSQ1), DM};
        pg8::gemm_phase<pg8::EpiResid, pg8::StaticOrder, true, true>(F.lds, g, S, E);
    } SEAM(4);
    if (IN(5)) {
        pg8::Gemm g{F.wsp<bf16>(WS_XN), F.wsp<bf16>(WS_WQ), M, DM, DM}; pg8::StaticOrder S; S.init(M, DM, F.G, c);
        pg8::EpiRowScale E{F.wsp<bf16>(WS_QC), DM, F.wsp<float>(WS_SSQ1), 1.f / 1024.f, EPS};
        pg8::gemm_phase<pg8::EpiRowScale, pg8::StaticOrder, true, true>(F.lds, g, S, E);
    } SEAM(5);
    if (IN(6)) { p5_cross(F); } SEAM(6);
    if (IN(7)) {
        pg8::Gemm g{F.wsp<bf16>(WS_OC), F.wsp<bf16>(WS_WO), M, DM, DM}; pg8::StaticOrder S; S.init(M, DM, F.G, c);
        pg8::EpiResid E{F.out, F.out, F.wsp<bf16>(WS_XN), F.wsp<float>(WS_SSQ2), DM};
        pg8::gemm_phase<pg8::EpiResid, pg8::StaticOrder, true, true>(F.lds, g, S, E);
    } SEAM(7);
    if (IN(8)) {
        pg8::Gemm g{F.wsp<bf16>(WS_XN), F.wsp<bf16>(WS_WQRY), M, 2 * DM, DM}; pg8::StaticOrder S; S.init(M, 2 * DM, F.G, c);
        pg8::EpiRowScale E{F.wsp<bf16>(WS_QP), 2 * DM, F.wsp<float>(WS_SSQ2), 1.f / 1024.f, EPS};
        pg8::gemm_phase<pg8::EpiRowScale, pg8::StaticOrder, true, true>(F.lds, g, S, E);
    } SEAM(8);
    if (IN(9)) { p8a_topk(F); } SEAM(9);
    if (IN(10)) { p8b_peer(F); }
#undef IN
#undef SEAM
}

#ifndef N_LAUNCH_MODE
#define N_LAUNCH_MODE 1
#endif
extern "C" void kernel_launch(void* const* d_in, const int* in_sizes, int n_in, void* d_out, int out_size, void* d_ws, size_t ws_size, hipStream_t stream) {
    static int grid = 0;
    if (grid == 0) {
        if (n_in != 26 || out_size != M * DM || ws_size < WS_END) { fprintf(stderr, "kernel_launch: unexpected shapes (n_in %d, out %d, ws %zu)\n", n_in, out_size, ws_size); grid = -1; return; }
        int dev = 0, cus = 0, per_cu = 0;
        if (hipGetDevice(&dev) != hipSuccess || hipDeviceGetAttribute(&cus, hipDeviceAttributeMultiprocessorCount, dev) != hipSuccess) { grid = -1; return; }
        if (hipFuncSetAttribute((const void*)fwd_kernel, hipFuncAttributeMaxDynamicSharedMemorySize, LDS_BYTES) != hipSuccess) { fprintf(stderr, "kernel_launch: hipFuncSetAttribute failed\n"); grid = -1; return; }
        if (hipOccupancyMaxActiveBlocksPerMultiprocessor(&per_cu, (const void*)fwd_kernel, NWAVES * 64, LDS_BYTES) != hipSuccess || per_cu < 1) { fprintf(stderr, "kernel_launch: occupancy query says %d blocks per CU\n", per_cu); (void)hipGetLastError(); grid = -1; return; }
        grid = cus;
    }
    if (grid < 0) return;
    (void)hipMemsetAsync((char*)d_ws + WS_CTL, 0, CTL_ZERO_BYTES, stream);
    Args a{};
    for (int i = 0; i < 26; ++i) a.in[i] = (const float*)d_in[i];
    a.out = (float*)d_out; a.ws = (unsigned char*)d_ws;
    if (N_LAUNCH_MODE == 1) { a.ph_lo = 0; a.ph_hi = N_PHASES; a.li = 0; hipLaunchKernelGGL(fwd_kernel, dim3(grid), dim3(NWAVES * 64), LDS_BYTES, stream, a); }
    else { for (int p = 0; p < N_PHASES; ++p) { a.ph_lo = p; a.ph_hi = p + 1; a.li = 0; hipLaunchKernelGGL(fwd_kernel, dim3(grid), dim3(NWAVES * 64), LDS_BYTES, stream, a); } }
}
```

```cpp
#include <hip/hip_runtime.h>
#include <cstdio>
#include <cstdint>
namespace pg8 {
#define PG8_LAS __attribute__((address_space(3)))
typedef unsigned short bf16_t;
typedef short bf16x8 __attribute__((ext_vector_type(8)));
typedef float f32x4 __attribute__((ext_vector_type(4)));
typedef unsigned u32x4 __attribute__((ext_vector_type(4)));
constexpr int BM = 256, BK = 64, HALF = 128, HTB = HALF * BK * 2  , STAGE_BYTES = 8 * HTB, NXCD = 8, WGM = 8;

__host__ __device__ __forceinline__ int lds_byte(int r, int c) { const int st = (r >> 4) * 2 + (c >> 5), rr = r & 15, cc = c & 31, ob = rr * 64 + cc * 2; return st * 1024 + (ob ^ (((ob >> 9) & 1) << 5)); }
__host__ __device__ __forceinline__ void stage_rc(int b, int& R, int& C) { const int st = b / 1024, sb = b % 1024, swz = sb ^ (((sb >> 9) & 1) << 5); R = (st >> 1) * 16 + swz / 64; C = (st & 1) * 32 + (swz % 64) / 2; }
__host__ __device__ __forceinline__ int perm32(int rho) { const int n = rho >> 4, i = rho & 15; return 8 * (i >> 2) + 4 * n + (i & 3); }

struct Unit { int pm, pn; };
struct Gemm { const bf16_t* A; const bf16_t* Bt; int M, N, K; };

struct StaticOrder {
    int nM, nN, nwg, G, c;
    __host__ __device__ void init(int M, int N, int G_, int c_) { nM = M / BM; nN = N / BM; nwg = nM * nN; G = G_; c = c_; }
    __host__ __device__ bool next(int i, Unit& u) const {
        const long L = (long)i * G + c; if (L >= nwg) return false;
        int wgid = (int)L; { const int q = nwg / NXCD, r = nwg % NXCD, xcd = wgid % NXCD, off = wgid / NXCD; wgid = (xcd < r ? xcd * (q + 1) : r * (q + 1) + (xcd - r) * q) + off; }
        const int nig = WGM * nN, gid = wgid / nig, fm = gid * WGM, gsz = (nM - fm) < WGM ? (nM - fm) : WGM;
        u.pm = fm + ((wgid % nig) % gsz); u.pn = (wgid % nig) / gsz; return true;
    }
    __device__ __forceinline__ void a_ready(const Unit&) const {}
    __device__ __forceinline__ void done(const Unit&) const {}
};

typedef float f32x2 __attribute__((ext_vector_type(2)));
typedef __bf16 bf16x2_t __attribute__((ext_vector_type(2)));
__device__ __forceinline__ unsigned cvt_pk_bf16(float lo, float hi) { f32x2 v = {lo, hi}; bf16x2_t b = __builtin_convertvector(v, bf16x2_t); return __builtin_bit_cast(unsigned, b); }
__device__ __forceinline__ bf16_t cvt_bf16(float x) { return (bf16_t)(cvt_pk_bf16(x, 0.f) & 0xffffu); }

struct EpiSplitT {
    static constexpr bool PERM = true, AFTER_DRAIN = false;
    bf16_t* O; int ldc; int ncols_rm; bf16_t* T; int NT; int rpb;
    __device__ __forceinline__ void operator()(const f32x4 (&acc)[2][2][4][2], const Unit& u, int wr, int wc, int fr, int fq) const {
        const int row0 = u.pm * BM + wr * 64 + fr; const int colt = u.pn * BM;
        if (colt < ncols_rm) {
            const int col0 = colt + wc * 32 + 8 * fq;
#pragma unroll
            for (int ai = 0; ai < 2; ++ai)
#pragma unroll
                for (int m = 0; m < 4; ++m) { bf16_t* rowp = O + (size_t)(row0 + ai * HALF + m * 16) * ldc + col0;
#pragma unroll
                    for (int bj = 0; bj < 2; ++bj) { const f32x4 v0 = acc[ai][bj][m][0], v1 = acc[ai][bj][m][1];
                        u32x4 w; w.x = cvt_pk_bf16(v0[0], v0[1]); w.y = cvt_pk_bf16(v0[2], v0[3]); w.z = cvt_pk_bf16(v1[0], v1[1]); w.w = cvt_pk_bf16(v1[2], v1[3]);
                        *(u32x4*)(rowp + bj * HALF) = w; } }
        } else {
            const int c0 = colt - ncols_rm + wc * 32 + 8 * fq;
#pragma unroll
            for (int ai = 0; ai < 2; ++ai)
#pragma unroll
                for (int m = 0; m < 4; ++m) { const int row = row0 + ai * HALF + m * 16; const int b = row / rpb, t = row - b * rpb; bf16_t* base = T + (size_t)b * NT * rpb + t;
#pragma unroll
                    for (int bj = 0; bj < 2; ++bj)
#pragma unroll
                        for (int n = 0; n < 2; ++n)
#pragma unroll
                            for (int e = 0; e < 4; ++e) base[(size_t)(c0 + bj * HALF + 4 * n + e) * rpb] = cvt_bf16(acc[ai][bj][m][n][e]); }
        }
    }
};
struct EpiResid {
    static constexpr bool PERM = true, AFTER_DRAIN = false;
    const float* base; float* out; bf16_t* xb; float* ssq; int ldc;
    __device__ __forceinline__ void operator()(const f32x4 (&acc)[2][2][4][2], const Unit& u, int wr, int wc, int fr, int fq) const {
        const int row0 = u.pm * BM + wr * 64 + fr; const int col0 = u.pn * BM + wc * 32 + 8 * fq;
#pragma unroll
        for (int ai = 0; ai < 2; ++ai)
#pragma unroll
            for (int m = 0; m < 4; ++m) { const int row = row0 + ai * HALF + m * 16; float s = 0.f;
#pragma unroll
                for (int bj = 0; bj < 2; ++bj) { const size_t off = (size_t)row * ldc + col0 + bj * HALF;
                    const f32x4 b0 = *(const f32x4*)(base + off), b1 = *(const f32x4*)(base + off + 4);
                    const f32x4 v0 = acc[ai][bj][m][0] + b0, v1 = acc[ai][bj][m][1] + b1;
                    *(f32x4*)(out + off) = v0; *(f32x4*)(out + off + 4) = v1;
                    s += (v0[0] * v0[0] + v0[1] * v0[1]) + (v0[2] * v0[2] + v0[3] * v0[3]) + (v1[0] * v1[0] + v1[1] * v1[1]) + (v1[2] * v1[2] + v1[3] * v1[3]);
                    u32x4 w; w.x = cvt_pk_bf16(v0[0], v0[1]); w.y = cvt_pk_bf16(v0[2], v0[3]); w.z = cvt_pk_bf16(v1[0], v1[1]); w.w = cvt_pk_bf16(v1[2], v1[3]);
                    *(u32x4*)(xb + off) = w; }
                s += __shfl_xor(s, 16); s += __shfl_xor(s, 32);
                if (fq == 0) ssq[(size_t)row * 16 + u.pn * 4 + wc] = s; }
    }
};
struct EpiRowScale {
    static constexpr bool PERM = true, AFTER_DRAIN = false;
    bf16_t* O; int ldc; const float* ssq; float inv_n, eps;
    __device__ __forceinline__ void operator()(const f32x4 (&acc)[2][2][4][2], const Unit& u, int wr, int wc, int fr, int fq) const {
        const int row0 = u.pm * BM + wr * 64 + fr; const int col0 = u.pn * BM + wc * 32 + 8 * fq;
#pragma unroll
        for (int ai = 0; ai < 2; ++ai)
#pragma unroll
            for (int m = 0; m < 4; ++m) { const int row = row0 + ai * HALF + m * 16; const f32x4* sp = (const f32x4*)(ssq + (size_t)row * 16);
                const f32x4 s0 = sp[0], s1 = sp[1], s2 = sp[2], s3 = sp[3]; const f32x4 st = (s0 + s1) + (s2 + s3);
                const float r = 1.0f / sqrtf(((st[0] + st[1]) + (st[2] + st[3])) * inv_n + eps);
                bf16_t* rowp = O + (size_t)row * ldc + col0;
#pragma unroll
                for (int bj = 0; bj < 2; ++bj) { const f32x4 v0 = acc[ai][bj][m][0] * r, v1 = acc[ai][bj][m][1] * r;
                    u32x4 w; w.x = cvt_pk_bf16(v0[0], v0[1]); w.y = cvt_pk_bf16(v0[2], v0[3]); w.z = cvt_pk_bf16(v1[0], v1[1]); w.w = cvt_pk_bf16(v1[2], v1[3]);
                    *(u32x4*)(rowp + bj * HALF) = w; } }
    }
};
struct OneUnit {
    int idx, nM, nN;
    __device__ __forceinline__ bool next(int i, Unit& u) const { if (i > 0 || idx < 0 || idx >= nM * nN) return false; u.pm = idx % nM; u.pn = idx / nM; return true; }
    __device__ __forceinline__ void a_ready(const Unit&) const {}
    __device__ __forceinline__ void done(const Unit&) const {}
};

template <class Epi, class Sched, bool ALIGN_EPI = false, bool SP2 = false>
__device__ __forceinline__ void gemm_phase(PG8_LAS unsigned char* lds, const Gemm g, const Sched& S, const Epi& E) {
    const int tid = threadIdx.x, wid = __builtin_amdgcn_readfirstlane(tid >> 6), lane = tid & 63, wr = wid >> 2, wc = wid & 3, fr = lane & 15, fq = lane >> 4;
    const int K = g.K, nt = K / BK;
    unsigned voffA[2], voffB[2];
#pragma unroll
    for (int i = 0; i < 2; ++i) { int R, C; stage_rc(tid * 16 + i * 8192, R, C); const int Rb = Epi::PERM ? ((R & ~31) + perm32(R & 31)) : R;
        voffA[i] = (unsigned)(R * K + C) * 2u; voffB[i] = (unsigned)(Rb * K + C) * 2u; }
    const size_t kstep = (size_t)(BK * 2);
    const size_t hstep = (size_t)HALF * K * 2;
    const size_t tstep = 2 * hstep;
    const unsigned ldsw = (unsigned)wid * 1024u;
    const int aoff = lds_byte(wr * 64 + fr, fq * 8), boff = lds_byte(wc * 32 + fr, fq * 8);
#define PG8_SA(b, h) (((b) * 2 + (h)) * HTB)
#define PG8_SB(b, h) ((4 + (b) * 2 + (h)) * HTB)
#define PG8_STAGE(bufoff, gbase, voff) do { _Pragma("unroll") for (int _i = 0; _i < 2; ++_i) \
        __builtin_amdgcn_global_load_lds((const unsigned*)((const char*)(gbase) + (voff)[_i]), (PG8_LAS unsigned*)(lds + (bufoff) + ldsw + _i * 8192), 16, 0, 0); } while (0)
#define PG8_LDA(dst, b, h) do { _Pragma("unroll") for (int m = 0; m < 4; ++m) _Pragma("unroll") for (int k = 0; k < 2; ++k) dst[m][k] = *(const PG8_LAS bf16x8*)(lds + PG8_SA(b, h) + aoff + m * 2048 + k * 1024); } while (0)
#define PG8_LDB(dst, b, h) do { _Pragma("unroll") for (int n = 0; n < 2; ++n) _Pragma("unroll") for (int k = 0; k < 2; ++k) dst[n][k] = *(const PG8_LAS bf16x8*)(lds + PG8_SB(b, h) + boff + n * 2048 + k * 1024); } while (0)
#define PG8_MMA(ai, bj, At, Bt) do { __builtin_amdgcn_s_setprio(1); _Pragma("unroll") for (int m = 0; m < 4; ++m) _Pragma("unroll") for (int n = 0; n < 2; ++n) _Pragma("unroll") for (int k = 0; k < 2; ++k) \
        acc[ai][bj][m][n] = __builtin_amdgcn_mfma_f32_16x16x32_bf16(Bt[n][k], At[m][k], acc[ai][bj][m][n], 0, 0, 0); __builtin_amdgcn_s_setprio(0); } while (0)
#define PG8_WAIT_V(n) asm volatile("s_waitcnt vmcnt(" #n ")" ::: "memory")
#define PG8_WAIT_L(n) asm volatile("s_waitcnt lgkmcnt(" #n ")" ::: "memory")
#define PG8_BAR __builtin_amdgcn_s_barrier()
#define PG8_SCHED __builtin_amdgcn_sched_barrier(0)
    Unit cur, nxt; int ui = 0;
    if (!S.next(0, cur)) return;
    f32x4 acc[2][2][4][2];
#pragma unroll
    for (int a = 0; a < 2; ++a)
#pragma unroll
        for (int b = 0; b < 2; ++b)
#pragma unroll
            for (int m = 0; m < 4; ++m)
#pragma unroll
                for (int n = 0; n < 2; ++n) acc[a][b][m][n] = (f32x4){0.f, 0.f, 0.f, 0.f};
    bf16x8 At[4][2], B0[2][2], B1[2][2];
    const char* cA = (const char*)g.A + (size_t)cur.pm * tstep; const char* cB = (const char*)g.Bt + (size_t)cur.pn * tstep;
    S.a_ready(cur);
    if constexpr (SP2) {
        PG8_STAGE(PG8_SB(0, 0), cB, voffB); PG8_STAGE(PG8_SB(0, 1), cB + hstep, voffB); PG8_STAGE(PG8_SA(0, 0), cA, voffA); PG8_STAGE(PG8_SA(0, 1), cA + hstep, voffA);
        if (wr == 1) PG8_BAR;
        PG8_WAIT_V(2); PG8_BAR;
        PG8_STAGE(PG8_SB(1, 0), cB + kstep, voffB); PG8_STAGE(PG8_SA(1, 0), cA + kstep, voffA); PG8_STAGE(PG8_SB(1, 1), cB + hstep + kstep, voffB);
        PG8_WAIT_V(6); PG8_BAR;
    } else {
        PG8_STAGE(PG8_SB(0, 0), cB, voffB); PG8_STAGE(PG8_SA(0, 0), cA, voffA); PG8_STAGE(PG8_SB(0, 1), cB + hstep, voffB); PG8_STAGE(PG8_SA(0, 1), cA + hstep, voffA);
        if (wr == 1) PG8_BAR;
        PG8_WAIT_V(4); PG8_BAR;
        PG8_STAGE(PG8_SB(1, 0), cB + kstep, voffB); PG8_STAGE(PG8_SA(1, 0), cA + kstep, voffA); PG8_STAGE(PG8_SB(1, 1), cB + hstep + kstep, voffB);
        PG8_WAIT_V(6); PG8_BAR;
    }
    for (;;) {
        const bool has_next = S.next(ui + 1, nxt);
        const char* nA = has_next ? (const char*)g.A + (size_t)nxt.pm * tstep : cA; const char* nB = has_next ? (const char*)g.Bt + (size_t)nxt.pn * tstep : cB;
        for (int t = 0; t < nt; t += 2) {
            const bool last = (t == nt - 2);
            const char* a1 = cA + (size_t)(t + 1) * kstep;
            const char* a2 = last ? nA : cA + (size_t)(t + 2) * kstep; const char* b2 = last ? nB : cB + (size_t)(t + 2) * kstep;
            const char* a3 = a2 + kstep; const char* b3 = b2 + kstep;
            if (last && has_next) S.a_ready(nxt);
            if constexpr (SP2) {
            PG8_LDB(B0, 0, 0); PG8_LDB(B1, 0, 1); PG8_SCHED; PG8_LDA(At, 0, 0); PG8_STAGE(PG8_SA(1, 1), a1 + hstep, voffA);
            PG8_WAIT_V(8); PG8_WAIT_L(0); PG8_BAR; PG8_MMA(0, 0, At, B0); PG8_MMA(0, 1, At, B1); PG8_BAR; PG8_SCHED;
            PG8_LDA(At, 0, 1); PG8_STAGE(PG8_SB(0, 0), b2, voffB); PG8_STAGE(PG8_SB(0, 1), b2 + hstep, voffB); PG8_STAGE(PG8_SA(0, 0), a2, voffA);
            PG8_WAIT_V(8); PG8_WAIT_L(0); PG8_BAR; PG8_MMA(1, 0, At, B0); PG8_MMA(1, 1, At, B1); PG8_BAR; PG8_SCHED;
            PG8_LDB(B0, 1, 0); PG8_LDB(B1, 1, 1); PG8_SCHED; PG8_LDA(At, 1, 0); PG8_STAGE(PG8_SA(0, 1), a2 + hstep, voffA);
            PG8_WAIT_V(8); PG8_WAIT_L(0); PG8_BAR; PG8_MMA(0, 0, At, B0); PG8_MMA(0, 1, At, B1); PG8_BAR; PG8_SCHED;
            PG8_LDA(At, 1, 1); PG8_STAGE(PG8_SB(1, 0), b3, voffB); PG8_STAGE(PG8_SB(1, 1), b3 + hstep, voffB); PG8_STAGE(PG8_SA(1, 0), a3, voffA);
            PG8_WAIT_V(8); PG8_WAIT_L(0); PG8_BAR; PG8_MMA(1, 0, At, B0); PG8_MMA(1, 1, At, B1); PG8_BAR; PG8_SCHED;
            } else {
            PG8_LDB(B0, 0, 0); PG8_SCHED; PG8_LDA(At, 0, 0); PG8_STAGE(PG8_SA(1, 1), a1 + hstep, voffA);
            PG8_WAIT_L(8); PG8_BAR; PG8_WAIT_L(0); PG8_MMA(0, 0, At, B0); PG8_BAR; PG8_SCHED;
            PG8_LDB(B1, 0, 1); PG8_STAGE(PG8_SB(0, 0), b2, voffB);
            PG8_BAR; PG8_WAIT_L(0); PG8_MMA(0, 1, At, B1); PG8_BAR;
            PG8_LDA(At, 0, 1); PG8_STAGE(PG8_SA(0, 0), a2, voffA);
            PG8_BAR; PG8_WAIT_L(0); PG8_MMA(1, 0, At, B0); PG8_BAR; PG8_SCHED;
            PG8_STAGE(PG8_SB(0, 1), b2 + hstep, voffB);
            PG8_WAIT_V(6); PG8_BAR; PG8_MMA(1, 1, At, B1); PG8_BAR;
            PG8_LDB(B0, 1, 0); PG8_SCHED; PG8_LDA(At, 1, 0); PG8_STAGE(PG8_SA(0, 1), a2 + hstep, voffA);
            PG8_WAIT_L(8); PG8_BAR; PG8_WAIT_L(0); PG8_MMA(0, 0, At, B0); PG8_BAR; PG8_SCHED;
            PG8_LDB(B1, 1, 1); PG8_STAGE(PG8_SB(1, 0), b3, voffB);
            PG8_BAR; PG8_WAIT_L(0); PG8_MMA(0, 1, At, B1); PG8_BAR;
            PG8_LDA(At, 1, 1); PG8_STAGE(PG8_SA(1, 0), a3, voffA);
            PG8_BAR; PG8_WAIT_L(0); PG8_MMA(1, 0, At, B0); PG8_BAR; PG8_SCHED;
            PG8_STAGE(PG8_SB(1, 1), b3 + hstep, voffB);
            PG8_WAIT_V(6); PG8_BAR; PG8_MMA(1, 1, At, B1); PG8_BAR;
            }
        }
        if constexpr (ALIGN_EPI) { if (wr == 0) PG8_BAR; }
        if constexpr (!Epi::AFTER_DRAIN) { E(acc, cur, wr, wc, fr, fq); S.done(cur); }
        if (!has_next) break;
#pragma unroll
        for (int a = 0; a < 2; ++a)
#pragma unroll
            for (int b = 0; b < 2; ++b)
#pragma unroll
                for (int m = 0; m < 4; ++m)
#pragma unroll
                    for (int n = 0; n < 2; ++n) acc[a][b][m][n] = (f32x4){0.f, 0.f, 0.f, 0.f};
        cur = nxt; cA = nA; cB = nB; ++ui;
        if constexpr (ALIGN_EPI) { if (wr == 1) PG8_BAR; }
    }
    PG8_WAIT_V(0);
    if constexpr (!ALIGN_EPI) { if (wr == 0) PG8_BAR; }
    PG8_BAR;
    if constexpr (Epi::AFTER_DRAIN) { E.fused(acc, cur, wr, wc, fr, fq, lds, wid, lane); S.done(cur); }
#undef PG8_SA
#undef PG8_SB
#undef PG8_STAGE
#undef PG8_LDA
#undef PG8_LDB
#undef PG8_MMA
#undef PG8_WAIT_V
#undef PG8_WAIT_L
#undef PG8_BAR
#undef PG8_SCHED
}
}

#ifndef PG8_SP2
#define PG8_SP2 true
#endif
#ifndef PG8_ALIGN
#define PG8_ALIGN true
#endif
constexpr int NWAVES = 8;
constexpr int NBATCH = 2, SEQ = 8192, DM = 1024, M = NBATCH * SEQ;
constexpr int INW = 2560, ZW = 2048;
constexpr int LRUW = 512, ATTW = 512, NCHUNK = SEQ / 64;
constexpr int NEXP = 16384, PEER_H = 8, NSEL = 128;
constexpr float EPS = 1e-6f;
constexpr float LOG2E = 1.4426950408889634f;

constexpr size_t MiB = 1u << 20;
constexpr size_t WS_CTL = 0, CTL_ZERO_BYTES = 1 * MiB;
constexpr size_t WS_WIN = 1 * MiB, WS_WOUT = 6 * MiB, WS_WQ = 8 * MiB, WS_WKV = 10 * MiB, WS_WO = 14 * MiB, WS_WQRY = 16 * MiB;
constexpr size_t WS_SUBK = 20 * MiB, WS_GATEW = 20 * MiB + 512 * 1024, WS_MEMN = 21 * MiB, WS_KM = 22 * MiB, WS_VMT = 23 * MiB, WS_AGG = 24 * MiB, WS_SSQ1 = 25 * MiB, WS_SSQ2 = 26 * MiB;
constexpr size_t WS_EU = 28 * MiB, WS_EV = 60 * MiB, WS_XN = 92 * MiB, WS_Z = 124 * MiB, WS_VT = 188 * MiB, WS_Y = 204 * MiB, WS_END = 236 * MiB;
constexpr size_t WS_QC = WS_Z, WS_OC = WS_Z + 32 * MiB, WS_QP = WS_Z, WS_IDX = WS_VT, WS_G = WS_VT + 8 * MiB;
constexpr int CW_BAR = 4096;

constexpr int RING_BYTES = 135168;
constexpr int LDSCTL_OFF = RING_BYTES, MISC_OFF = LDSCTL_OFF + 320;
constexpr int LDS_BYTES = 147456;

#define GAS __attribute__((address_space(1)))
#define LAS __attribute__((address_space(3)))
typedef unsigned short bf16;
typedef unsigned v4u __attribute__((ext_vector_type(4)));
typedef unsigned v2u __attribute__((ext_vector_type(2)));
typedef float f32x4 __attribute__((ext_vector_type(4)));
typedef float f32x2 __attribute__((ext_vector_type(2)));
typedef float f32x16 __attribute__((ext_vector_type(16)));
typedef short bf16x8 __attribute__((ext_vector_type(8)));
typedef __bf16 bf16x2_t __attribute__((ext_vector_type(2)));
typedef GAS unsigned gu32;
#define RLX_AGENT __ATOMIC_RELAXED, __HIP_MEMORY_SCOPE_AGENT
#define LDS_WAIT() asm volatile("s_waitcnt lgkmcnt(0)" ::: "memory")
#define VM_WAIT() asm volatile("s_waitcnt vmcnt(0)" ::: "memory")
#define MFMA32(a, b, c) __builtin_amdgcn_mfma_f32_32x32x16_bf16((a), (b), (c), 0, 0, 0)
#define DI __device__ __forceinline__

DI unsigned pk2(float lo, float hi) { f32x2 v = {lo, hi}; bf16x2_t b = __builtin_convertvector(v, bf16x2_t); return __builtin_bit_cast(unsigned, b); }
DI bf16 f2bf(float x) { return (bf16)(pk2(x, 0.f) & 0xffffu); }
DI float bf2f(bf16 x) { return __uint_as_float((unsigned)x << 16); }
DI float bflo(unsigned p) { return __uint_as_float(p << 16); }
DI float bfhi(unsigned p) { return __uint_as_float(p & 0xffff0000u); }
DI int crow(int reg, int hh) { return (reg & 3) + 8 * (reg >> 2) + 4 * hh; }
DI float swap32_partner(float x, int hh) { auto rr = __builtin_amdgcn_permlane32_swap(__float_as_uint(x), __float_as_uint(x), false, false); return __uint_as_float(hh ? rr[0] : rr[1]); }
DI float dpp_xor1(float x) { return __int_as_float(__builtin_amdgcn_update_dpp(0, __float_as_int(x), 0xB1, 0xf, 0xf, true)); }
DI float dpp_xor2(float x) { return __int_as_float(__builtin_amdgcn_update_dpp(0, __float_as_int(x), 0x4E, 0xf, 0xf, true)); }
DI float dpp_hmir(float x) { return __int_as_float(__builtin_amdgcn_update_dpp(0, __float_as_int(x), 0x141, 0xf, 0xf, true)); }
DI float dpp_mir(float x)  { return __int_as_float(__builtin_amdgcn_update_dpp(0, __float_as_int(x), 0x140, 0xf, 0xf, true)); }
DI float sum16(float x) { x += dpp_xor1(x); x += dpp_xor2(x); x += dpp_hmir(x); x += dpp_mir(x); return x; }
DI float sum32(float x) { x = sum16(x); auto rr = __builtin_amdgcn_permlane16_swap(__float_as_uint(x), __float_as_uint(x), false, false); return __uint_as_float(rr[0]) + __uint_as_float(rr[1]); }
DI float sum64(float x) { x = sum32(x); auto rr = __builtin_amdgcn_permlane32_swap(__float_as_uint(x), __float_as_uint(x), false, false); return __uint_as_float(rr[0]) + __uint_as_float(rr[1]); }
DI float rcp_(float x) { return __builtin_amdgcn_rcpf(x); }
DI float rsq_(float x) { return __builtin_amdgcn_rsqf(x); }
DI float exp2_(float x) { return __builtin_amdgcn_exp2f(x); }
DI float gelu_tanh(float x) { const float u = x * (1.5957691216057308f + 0.07135481627159768f * x * x); return x * rcp_(1.0f + exp2_(-LOG2E * u)); }
DI float sigmoidf_(float x) { return rcp_(1.0f + exp2_(-LOG2E * x)); }
#define XB_TMO      128
#define XB_XCNT(j)  (256  + 64 * (j))
#define XB_XSUB(j)  (1280 + 64 * (j))
#define XB_XGEN(j)  (2304 + 64 * (j))
#define XB_TOP      3328
#define XB_TOPGEN   3392
#define XCD_BAR_WORDS 3456
#define XB_SPIN_CAP (1u << 18)

__device__ __forceinline__ unsigned xb_ld(unsigned* p)              { return __hip_atomic_load(p, __ATOMIC_RELAXED, __HIP_MEMORY_SCOPE_AGENT); }
__device__ __forceinline__ unsigned xb_add(unsigned* p, unsigned v) { return __hip_atomic_fetch_add(p, v, __ATOMIC_RELAXED, __HIP_MEMORY_SCOPE_AGENT); }
__device__ __forceinline__ unsigned xb_xcc_id() { return (unsigned)__builtin_amdgcn_s_getreg((3 << 11) | 20) & 0xFu; }
#define XB_SPIN(cond, bar) do { unsigned _sp = 0; while (cond) { __builtin_amdgcn_s_sleep(1); \
    if ((++_sp & 255u) == 0u) { if (xb_ld(&(bar)[XB_TMO])) break; if (_sp > XB_SPIN_CAP) { atomicAdd(&(bar)[XB_TMO], 1u); break; } } } } while (0)

struct XcdBarrier {
    unsigned* bar; unsigned x;
    volatile LAS unsigned* st;
};

__device__ __forceinline__ XcdBarrier xcd_barrier_post(unsigned* bar, volatile LAS unsigned* st) {
    XcdBarrier b; b.bar = bar; b.x = xb_xcc_id(); b.st = st;
    if (threadIdx.x == 0) (void)xb_add(&bar[XB_XCNT(b.x)], 1u);
    return b;
}
__device__ __forceinline__ void xcd_barrier_complete(unsigned* bar, unsigned x, unsigned& nloc, unsigned& nx) {
    const unsigned G = gridDim.x * gridDim.y * gridDim.z;
    unsigned sum, cnt, mine, sp = 0u;
    for (;;) {
        sum = 0u; cnt = 0u; mine = 0u;
#pragma unroll
        for (unsigned j = 0; j < 16; ++j) { const unsigned c = xb_ld(&bar[XB_XCNT(j)]); sum += c; cnt += (c > 0u) ? 1u : 0u; mine = (j == x) ? c : mine; }
        if (sum == G) break;
        __builtin_amdgcn_s_sleep(1);
        if ((++sp & 255u) == 0u) { if (xb_ld(&bar[XB_TMO])) break; if (sp > XB_SPIN_CAP) { atomicAdd(&bar[XB_TMO], 1u); break; } }
    }
    nloc = mine > 0u ? mine : 1u; nx = cnt > 0u ? cnt : 1u;
}

__device__ __forceinline__ void xcd_barrier(const XcdBarrier& b) {
    asm volatile("s_waitcnt vmcnt(0)" ::: "memory");
    __syncthreads();
    if (threadIdx.x == 0) {
        unsigned* bar = b.bar;
        __builtin_amdgcn_s_waitcnt(0);
        unsigned nloc = b.st[0], nx = b.st[1];
        if (nloc == 0u) { xcd_barrier_complete(bar, b.x, nloc, nx); b.st[0] = nloc; b.st[1] = nx; }
        const unsigned old = xb_add(&bar[XB_XSUB(b.x)], 1u);
        const unsigned gen = old / nloc;
        if (old + 1u == (gen + 1u) * nloc) {
            __builtin_amdgcn_fence(__ATOMIC_RELEASE, "agent");
            asm volatile("s_waitcnt vmcnt(0)" ::: "memory");
            const unsigned og = xb_add(&bar[XB_TOP], 1u);
            const unsigned tg = og / nx;
            if (og + 1u == (tg + 1u) * nx) xb_add(&bar[XB_TOPGEN], 1u);
            else XB_SPIN(xb_ld(&bar[XB_TOPGEN]) == tg, bar);
            __builtin_amdgcn_fence(__ATOMIC_ACQUIRE, "agent");
            xb_add(&bar[XB_XGEN(b.x)], 1u);
            asm volatile("s_waitcnt vmcnt(0)" ::: "memory");
        } else {
            XB_SPIN(xb_ld(&bar[XB_XGEN(b.x)]) == gen, bar);
            __builtin_amdgcn_fence(__ATOMIC_ACQUIRE, "agent");
            asm volatile("s_waitcnt vmcnt(0)" ::: "memory");
        }
    }
    __syncthreads();
}
struct Args { const float* in[26]; float* out; unsigned char* ws; int ph_lo, ph_hi, li, pad; };
struct Frame {
    LAS unsigned char* lds;
    volatile LAS unsigned* MISC;
    gu32* ctl;
    int tid, lane, wave, vcu, G;
    const Args* A; float* out; unsigned char* ws;
    DI const float* in(int k) const { return A->in[k]; }
    template <class T> DI T* wsp(size_t off) const { return (T*)(ws + off); }
};

DI void p0_transpose_item(const float* W, int K, int N, bf16* WT, LAS float* scr, int item, int lane, const float* g0, const float* g1, int gsplit) {
    const int nblk = N / 32, kb = item / nblk, nb = item % nblk, k0 = 64 * kb, n0 = 32 * nb;
#pragma unroll 8
    for (int i = 0; i < 32; ++i) { const int kk = 2 * i + (lane >> 5); const int k = k0 + kk;
        float g = 1.f; if (g0) g = (k < gsplit) ? g0[k] : g1[k - gsplit];
        scr[kk * 33 + (lane & 31)] = W[(size_t)k * N + n0 + (lane & 31)] * g; }
    LDS_WAIT(); asm volatile("" ::: "memory");
    const int c = lane & 7;
#pragma unroll
    for (int j = 0; j < 4; ++j) { const int n = (lane >> 3) + 8 * j; const LAS float* s = scr + (8 * c) * 33 + n;
        v4u o; o.x = pk2(s[0 * 33], s[1 * 33]); o.y = pk2(s[2 * 33], s[3 * 33]); o.z = pk2(s[4 * 33], s[5 * 33]); o.w = pk2(s[6 * 33], s[7 * 33]);
        *(GAS v4u*)(WT + (size_t)(n0 + n) * K + k0 + 8 * c) = o; }
    LDS_WAIT(); asm volatile("" ::: "memory");
}
template <bool NORM> DI void row_to_bf16(const float* xrow, bf16* orow, const float* gain, int lane) {
    const GAS f32x4* xr = (const GAS f32x4*)xrow + lane;
    f32x4 v[4]; float s = 0.f;
#pragma unroll
    for (int j = 0; j < 4; ++j) { v[j] = xr[64 * j]; s += (v[j].x * v[j].x + v[j].y * v[j].y) + (v[j].z * v[j].z + v[j].w * v[j].w); }
    float rstd = 1.f;
    if (NORM) rstd = 1.0f / sqrtf(sum64(s) * (1.f / 1024.f) + EPS);
    GAS v2u* o8 = (GAS v2u*)orow + lane;
#pragma unroll
    for (int j = 0; j < 4; ++j) { f32x4 w = v[j] * rstd; if (gain) w = w * ((const GAS f32x4*)gain)[64 * j + lane];
        v2u o; o.x = pk2(w.x, w.y); o.y = pk2(w.z, w.w); o8[64 * j] = o; }
}
constexpr float U_SCALE = 128.f, V_SCALE = 16.f;
DI void row_to_fp8(const float* src, unsigned char* dst, const float* gain, float scale, int lane) {
#pragma unroll
    for (int j = 0; j < 4; ++j) { f32x4 v = ((const GAS f32x4*)src)[64 * j + lane] * scale; if (gain) v = v * ((const GAS f32x4*)gain)[64 * j + lane];
        unsigned w = 0u; w = __builtin_amdgcn_cvt_pk_fp8_f32(v.x, v.y, w, false); w = __builtin_amdgcn_cvt_pk_fp8_f32(v.z, v.w, w, true);
        ((GAS unsigned*)dst)[64 * j + lane] = w; }
}
DI void p0_prologue(Frame& F) {
    LAS float* scr = (LAS float*)(F.lds + F.wave * 16384);
    const int gw = F.vcu * NWAVES + F.wave, NGW = F.G * NWAVES, lane = F.lane;
    constexpr int I_IN = 16 * (INW / 32), I_D = 16 * (DM / 32), I_2D = 16 * (2 * DM / 32);
    constexpr int NITEMS = I_IN + 3 * I_D + 2 * I_2D;
    for (int it = gw; it < NITEMS; it += NGW) {
        int r = it;
        if (r < I_IN) { p0_transpose_item(F.in(3), DM, INW, F.wsp<bf16>(WS_WIN), scr, r, lane, F.in(2), F.in(2), DM); continue; } r -= I_IN;
        if (r < I_D) { p0_transpose_item(F.in(14), DM, DM, F.wsp<bf16>(WS_WOUT), scr, r, lane, F.in(12), F.in(13), LRUW); continue; } r -= I_D;
        if (r < I_D) { p0_transpose_item(F.in(17), DM, DM, F.wsp<bf16>(WS_WQ), scr, r, lane, F.in(15), F.in(15), DM); continue; } r -= I_D;
        if (r < I_2D) { p0_transpose_item(F.in(18), DM, 2 * DM, F.wsp<bf16>(WS_WKV), scr, r, lane, nullptr, nullptr, 0); continue; } r -= I_2D;
        if (r < I_D) { p0_transpose_item(F.in(19), DM, DM, F.wsp<bf16>(WS_WO), scr, r, lane, nullptr, nullptr, 0); continue; } r -= I_D;
        p0_transpose_item(F.in(21), DM, 2 * DM, F.wsp<bf16>(WS_WQRY), scr, r, lane, F.in(20), F.in(20), DM);
    }
    for (int m = gw; m < M; m += NGW) row_to_bf16<true>(F.in(0) + (size_t)m * DM, F.wsp<bf16>(WS_XN) + (size_t)m * DM, nullptr, lane);
    for (int m = gw; m < NBATCH * 256; m += NGW) row_to_bf16<true>(F.in(1) + (size_t)m * DM, F.wsp<bf16>(WS_MEMN) + (size_t)m * DM, F.in(16), lane);
    for (int m = gw; m < NEXP; m += NGW) { row_to_fp8(F.in(23) + (size_t)m * DM, F.wsp<unsigned char>(WS_EU) + (size_t)m * DM, F.in(20), U_SCALE, lane);
                                            row_to_fp8(F.in(24) + (size_t)m * DM, F.wsp<unsigned char>(WS_EV) + (size_t)m * DM, nullptr, V_SCALE, lane); }
    { const int gt = gw * 64 + lane, NT = NGW * 64;
      for (int i = gt; i < 8 * 2 * 128 * 128 / 4; i += NT) { const f32x4 v = ((const GAS f32x4*)F.in(22))[i]; v2u o; o.x = pk2(v.x, v.y); o.y = pk2(v.z, v.w); ((GAS v2u*)F.wsp<bf16>(WS_SUBK))[i] = o; }
      for (int o = gt; o < 2 * 8 * 64 * 64; o += NT) { const int i = o & 63, j = (o >> 6) & 63, h = (o >> 12) & 7, g = o >> 15;
          const float* W = g ? F.in(8) : F.in(6); F.wsp<bf16>(WS_GATEW)[o] = f2bf(W[(h * 64 + i) * 64 + j]); } }
}
struct LruState { float ba[2], bx[2], sp[2], S[2], Ap[2]; };
template <bool PASS2>
DI void lru_prep(const Frame& F, int b, int chunk, int h, int lane, LAS unsigned char* xcs  , LruState& st) {
    const int r = lane & 31, hh = lane >> 5;
    const size_t row0 = (size_t)b * SEQ + (size_t)chunk * 64;
    {
        const int c2 = h * 64 + 2 * r;
        const f32x2 w0 = *(const f32x2*)(F.in(4) + c2), w1 = *(const f32x2*)(F.in(4) + LRUW + c2), w2 = *(const f32x2*)(F.in(4) + 2 * LRUW + c2), w3 = *(const f32x2*)(F.in(4) + 3 * LRUW + c2);
        const f32x2 cb = *(const f32x2*)(F.in(5) + c2);
        const int tl0 = 32 * hh;
        const bf16* zp = F.wsp<bf16>(WS_Z) + (row0 + tl0) * ZW + c2;
        const bool first = (chunk == 0 && hh == 0);
        unsigned p0 = first ? 0u : *(const unsigned*)(zp - 3 * ZW), p1 = first ? 0u : *(const unsigned*)(zp - 2 * ZW), p2 = first ? 0u : *(const unsigned*)(zp - ZW);
#pragma unroll 8
        for (int t = 0; t < 32; ++t) { const unsigned p3 = *(const unsigned*)(zp + (size_t)t * ZW);
            const float lo = cb.x + bflo(p0) * w0.x + bflo(p1) * w1.x + bflo(p2) * w2.x + bflo(p3) * w3.x;
            const float hi = cb.y + bfhi(p0) * w0.y + bfhi(p1) * w1.y + bfhi(p2) * w2.y + bfhi(p3) * w3.y;
            *(LAS unsigned*)(xcs + (tl0 + t) * 144 + 4 * r) = pk2(lo, hi);
            p0 = p1; p1 = p2; p2 = p3; }
        LDS_WAIT();
    }
#pragma unroll
    for (int nt = 0; nt < 2; ++nt) { const int c = h * 64 + 32 * nt + r; st.ba[nt] = F.in(7)[c]; st.bx[nt] = F.in(9)[c];
        const float nl = -F.in(10)[c]; st.sp[nt] = fmaxf(nl, 0.f) + log1pf(__expf(-fabsf(nl))); st.S[nt] = 0.f; st.Ap[nt] = 1.f; }
    if (PASS2) {
        float s = 0.f; const float* ag = F.wsp<float>(WS_AGG) + ((size_t)b * NCHUNK * LRUW + h * 64 + lane) * 2;
#pragma unroll 8
        for (int c = 0; c < chunk; ++c) { const f32x2 ab = *(const f32x2*)(ag + (size_t)c * LRUW * 2); s = ab.x * s + ab.y; }
        st.S[0] = __shfl(s, r); st.S[1] = __shfl(s, 32 + r);
    }
}
template <bool PASS2>
DI void lru_tile(const Frame& F, int b, int chunk, int mt, int h, int lane, LAS unsigned char* xcs, LAS unsigned char* gim  , LruState& st, float (&ssq)[16]) {
    const int r = lane & 31, hh = lane >> 5;
    const size_t row0 = (size_t)b * SEQ + (size_t)chunk * 64;
    const bf16* gw = F.wsp<bf16>(WS_GATEW) + (size_t)h * 4096;
    bf16x8 af[4];
#pragma unroll
    for (int s = 0; s < 4; ++s) af[s] = *(const LAS bf16x8*)(xcs + (32 * mt + r) * 144 + (16 * s + 8 * hh) * 2);
    float ssl[16];
#pragma unroll
    for (int i = 0; i < 16; ++i) ssl[i] = 0.f;
    if (PASS2) {
#pragma unroll
        for (int i = 0; i < 4; ++i) { const int row = (lane >> 3) + 8 * i, c = lane & 7;
            *(LAS v4u*)(gim + row * 144 + c * 16) = *(const v4u*)(F.wsp<bf16>(WS_Z) + (row0 + 32 * mt + row) * ZW + LRUW + h * 64 + 8 * c); }
        LDS_WAIT();
    }
#pragma unroll
    for (int nt = 0; nt < 2; ++nt) {
        asm volatile("" ::: "memory");
        f32x16 aa = {}, ax = {};
#pragma unroll
        for (int s = 0; s < 4; ++s) {
            const bf16x8 wa = *(const bf16x8*)(gw + (size_t)(32 * nt + r) * 64 + 16 * s + 8 * hh);
            const bf16x8 wx = *(const bf16x8*)(gw + 32768 + (size_t)(32 * nt + r) * 64 + 16 * s + 8 * hh);
            aa = MFMA32(af[s], wa, aa); ax = MFMA32(af[s], wx, ax);
        }
        float gt[16];
        if (PASS2) {
#pragma unroll
            for (int i = 0; i < 16; ++i) gt[i] = bf2f(*(const LAS bf16*)(gim + crow(i, hh) * 144 + (32 * nt + r) * 2));
        }
#pragma unroll
        for (int i = 0; i < 16; ++i) {
            const float rg = sigmoidf_(aa[i] + st.ba[nt]), ig = sigmoidf_(ax[i] + st.bx[nt]);
            const float la = -8.0f * rg * st.sp[nt];
            const float a = exp2_(LOG2E * la);
            const float mult = __builtin_amdgcn_sqrtf(fmaxf(1.0f - a * a, 0.f));
            const float xc = bf2f(*(const LAS bf16*)(xcs + (32 * mt + crow(i, hh)) * 144 + (32 * nt + r) * 2));
            aa[i] = a; ax[i] = mult * ig * xc;
        }
        float Ao[4], Bo[4], Aq[4], Bq[4], Sin[4];
#pragma unroll
        for (int q = 0; q < 4; ++q) { const float a0 = aa[4 * q], a1 = aa[4 * q + 1], a2 = aa[4 * q + 2], a3 = aa[4 * q + 3];
            Ao[q] = (a0 * a1) * (a2 * a3); Bo[q] = ((ax[4 * q] * a1 + ax[4 * q + 1]) * a2 + ax[4 * q + 2]) * a3 + ax[4 * q + 3];
            Aq[q] = swap32_partner(Ao[q], hh); Bq[q] = swap32_partner(Bo[q], hh); }
        float s_ = st.S[nt];
#pragma unroll
        for (int q = 0; q < 4; ++q) { const float A1 = hh ? Aq[q] : Ao[q], B1 = hh ? Bq[q] : Bo[q], A2 = hh ? Ao[q] : Aq[q], B2 = hh ? Bo[q] : Bq[q];
            const float smid = A1 * s_ + B1; Sin[q] = hh ? smid : s_; s_ = A2 * smid + B2; st.Ap[nt] *= A1 * A2; }
        st.S[nt] = s_;
        if (PASS2) {
#pragma unroll
            for (int q = 0; q < 4; ++q) { float hp = Sin[q];
#pragma unroll
                for (int e = 0; e < 4; ++e) { const int i = 4 * q + e; hp = aa[i] * hp + ax[i];
                    const float y = hp * gelu_tanh(gt[i]); ssl[i] += y * y;
                    *(LAS bf16*)(xcs + (32 * mt + crow(i, hh)) * 144 + (32 * nt + r) * 2) = f2bf(y); } }
        }
    }
    if (PASS2) {
#pragma unroll
        for (int i = 0; i < 16; ++i) ssq[i] = sum32(ssl[i]);
    }
}
DI void attn_wave(const Frame& F, int b, int n, int qt, int h, int lane, const LAS float* tab, f32x16 (&o)[2]) {
    const int r = lane & 31, hh = lane >> 5;
    const size_t row0 = (size_t)b * SEQ + (size_t)n * 64;
    const float SC = 0.125f * LOG2E;
    bf16x8 qf[4];
#pragma unroll
    for (int s = 0; s < 4; ++s) qf[s] = *(const bf16x8*)(F.wsp<bf16>(WS_Z) + (row0 + 32 * qt + r) * ZW + 2 * LRUW + h * 64 + 16 * s + 8 * hh);
    float mrun = -1e30f, lrun = 0.f;
#pragma unroll
    for (int dt = 0; dt < 2; ++dt) o[dt] = f32x16{};
    const float bfar = tab[256];
    const bf16* vtb = F.wsp<bf16>(WS_VT) + ((size_t)(b * 8 + h) * 64 + r) * SEQ + 4 * hh;
    for (int kc = (n >= 8 ? n - 8 : 0); kc <= n; ++kc) {
        const size_t krow0 = (size_t)b * SEQ + (size_t)kc * 64;
        const int dd = n - kc;
        bf16x8 kf[2][4];
#pragma unroll
        for (int kt = 0; kt < 2; ++kt)
#pragma unroll
            for (int s = 0; s < 4; ++s) kf[kt][s] = *(const bf16x8*)(F.wsp<bf16>(WS_Z) + (krow0 + 32 * kt + r) * ZW + 2 * LRUW + ATTW + h * 64 + 16 * s + 8 * hh);
        bf16x8 vf[2][2][2];
#pragma unroll
        for (int dt = 0; dt < 2; ++dt)
#pragma unroll
            for (int kt = 0; kt < 2; ++kt)
#pragma unroll
                for (int s2 = 0; s2 < 2; ++s2) { const bf16* p = vtb + (size_t)(32 * dt) * SEQ + kc * 64 + 32 * kt + 16 * s2;
                    const v2u lo = *(const v2u*)p, hi = *(const v2u*)(p + 8); v4u w; w.x = lo.x; w.y = lo.y; w.z = hi.x; w.w = hi.y; vf[dt][kt][s2] = __builtin_bit_cast(bf16x8, w); }
        f32x16 sc[2];
#pragma unroll
        for (int kt = 0; kt < 2; ++kt) { sc[kt] = f32x16{};
#pragma unroll
            for (int s = 0; s < 4; ++s) sc[kt] = MFMA32(kf[kt][s], qf[s], sc[kt]); }
        if (dd >= 3) {
#pragma unroll
            for (int kt = 0; kt < 2; ++kt)
#pragma unroll
                for (int i = 0; i < 16; ++i) sc[kt][i] = sc[kt][i] * SC + bfar;
        } else {
            const int base = 64 * dd + 32 * qt + r + 128;
#pragma unroll
            for (int kt = 0; kt < 2; ++kt)
#pragma unroll
                for (int i = 0; i < 16; ++i) { int idx = base - (32 * kt + crow(i, hh)); idx = idx > 256 ? 256 : idx; sc[kt][i] = sc[kt][i] * SC + tab[idx]; }
        }
        float mx = sc[0][0];
#pragma unroll
        for (int kt = 0; kt < 2; ++kt)
#pragma unroll
            for (int i = 0; i < 16; ++i) mx = fmaxf(mx, sc[kt][i]);
        mx = fmaxf(mx, swap32_partner(mx, hh));
        const float mnew = fmaxf(mrun, mx), alpha = exp2_(mrun - mnew);
        float ls = 0.f;
#pragma unroll
        for (int kt = 0; kt < 2; ++kt)
#pragma unroll
            for (int i = 0; i < 16; ++i) { const float p = exp2_(sc[kt][i] - mnew); sc[kt][i] = p; ls += p; }
        lrun = lrun * alpha + ls; mrun = mnew;
#pragma unroll
        for (int dt = 0; dt < 2; ++dt)
#pragma unroll
            for (int i = 0; i < 16; ++i) o[dt][i] *= alpha;
#pragma unroll
        for (int kt = 0; kt < 2; ++kt)
#pragma unroll
            for (int s2 = 0; s2 < 2; ++s2) { v4u w; w.x = pk2(sc[kt][8 * s2], sc[kt][8 * s2 + 1]); w.y = pk2(sc[kt][8 * s2 + 2], sc[kt][8 * s2 + 3]); w.z = pk2(sc[kt][8 * s2 + 4], sc[kt][8 * s2 + 5]); w.w = pk2(sc[kt][8 * s2 + 6], sc[kt][8 * s2 + 7]);
                const bf16x8 pf = __builtin_bit_cast(bf16x8, w);
#pragma unroll
                for (int dt = 0; dt < 2; ++dt) o[dt] = MFMA32(vf[dt][kt][s2], pf, o[dt]); }
    }
    const float lt = lrun + swap32_partner(lrun, hh); const float inv = rcp_(lt);
#pragma unroll
    for (int dt = 0; dt < 2; ++dt)
#pragma unroll
        for (int i = 0; i < 16; ++i) o[dt][i] *= inv;
}

DI void p2_lru_aggregates(Frame& F) {
    const int lane = F.lane, r = lane & 31, hh = lane >> 5, h = F.wave;
    LAS unsigned char* xcs = F.lds + 20480 + h * 13824;
    for (int u = F.vcu; u < NBATCH * NCHUNK; u += F.G) {
        const int b = u / NCHUNK, n = u % NCHUNK;
        LruState st; float ssq[16];
        lru_prep<false>(F, b, n, h, lane, xcs, st);
#pragma unroll 1
        for (int mt = 0; mt < 2; ++mt) lru_tile<false>(F, b, n, mt, h, lane, xcs, xcs + 9216, st, ssq);
        if (hh == 0) {
#pragma unroll
            for (int nt = 0; nt < 2; ++nt) *(f32x2*)(F.wsp<float>(WS_AGG) + (((size_t)b * NCHUNK + n) * LRUW + h * 64 + 32 * nt + r) * 2) = (f32x2){st.Ap[nt], st.S[nt]};
        }
        LDS_WAIT();
    }
}
DI void p3_mixer(Frame& F) {
    const int lane = F.lane, r = lane & 31, hh = lane >> 5, h = F.wave;
    LAS float* ssx = (LAS float*)(F.lds);
    LAS float* tab = (LAS float*)(F.lds + 4096 + h * 2048);
    LAS unsigned* stg = (LAS unsigned*)(F.lds + 20480 + h * 13824);
    for (int i = lane; i < 257; i += 64) tab[i] = F.in(11)[h * 257 + i] * LOG2E;
    LDS_WAIT();
    for (int u = F.vcu; u < NBATCH * NCHUNK; u += F.G) {
        const int b = u / NCHUNK, n = u % NCHUNK; const size_t row0 = (size_t)b * SEQ + (size_t)n * 64;
#ifndef MIX_PARTS
#define MIX_PARTS 3
#endif
        if (MIX_PARTS & 1) {
            LruState st;
            lru_prep<true>(F, b, n, h, lane, (LAS unsigned char*)stg, st);
#pragma unroll 1
            for (int mt = 0; mt < 2; ++mt) {
                float ssq[16];
                lru_tile<true>(F, b, n, mt, h, lane, (LAS unsigned char*)stg, (LAS unsigned char*)stg + 9216, st, ssq);
                if (r == 0) {
#pragma unroll
                    for (int i = 0; i < 16; ++i) ssx[crow(i, hh) * 8 + h] = ssq[i];
                }
                __syncthreads();
                const LAS unsigned char* yst = (const LAS unsigned char*)stg + 32 * mt * 144;
#pragma unroll
                for (int i = 0; i < 4; ++i) { const int row = (lane >> 3) + 8 * i, c = lane & 7;
                    const f32x4 s0 = *(const LAS f32x4*)(ssx + row * 8), s1 = *(const LAS f32x4*)(ssx + row * 8 + 4);
                    const float rs = rsq_(((s0.x + s0.y) + (s0.z + s0.w) + (s1.x + s1.y) + (s1.z + s1.w)) * (1.f / 512.f) + EPS);
                    const v4u v = *(const LAS v4u*)(yst + row * 144 + c * 16);
                    v4u o; o.x = pk2(bflo(v.x) * rs, bfhi(v.x) * rs); o.y = pk2(bflo(v.y) * rs, bfhi(v.y) * rs); o.z = pk2(bflo(v.z) * rs, bfhi(v.z) * rs); o.w = pk2(bflo(v.w) * rs, bfhi(v.w) * rs);
                    *(v4u*)(F.wsp<bf16>(WS_Y) + (row0 + 32 * mt + row) * DM + h * 64 + 8 * c) = o; }
                __syncthreads();
            }
        }
    }
    for (int u = F.vcu; u < NBATCH * NCHUNK; u += F.G) {
        const int b = u / NCHUNK, n = u % NCHUNK; const size_t row0 = (size_t)b * SEQ + (size_t)n * 64;
#pragma unroll 1
        for (int qt = 0; qt < ((MIX_PARTS & 2) ? 2 : 0); ++qt) {
            f32x16 o[2];
            attn_wave(F, b, n, qt, h, lane, tab, o);
            float s = 0.f;
#pragma unroll
            for (int dt = 0; dt < 2; ++dt)
#pragma unroll
                for (int i = 0; i < 16; ++i) s += o[dt][i] * o[dt][i];
            s += swap32_partner(s, hh);
            if (hh == 0) ssx[r * 8 + h] = s;
            __syncthreads();
            { const f32x4 s0 = *(const LAS f32x4*)(ssx + r * 8), s1 = *(const LAS f32x4*)(ssx + r * 8 + 4);
              const float rs = rsq_(((s0.x + s0.y) + (s0.z + s0.w) + (s1.x + s1.y) + (s1.z + s1.w)) * (1.f / 512.f) + EPS);
#pragma unroll
              for (int dt = 0; dt < 2; ++dt)
#pragma unroll
                  for (int i = 0; i < 16; i += 2) stg[r * 33 + ((32 * dt + crow(i, hh)) >> 1)] = pk2(o[dt][i] * rs, o[dt][i + 1] * rs); }
            LDS_WAIT();
#pragma unroll 4
            for (int i = 0; i < 16; ++i) { const int row = 2 * i + hh; const unsigned v = stg[row * 33 + r];
                *(GAS unsigned*)(F.wsp<bf16>(WS_Y) + (row0 + 32 * qt + row) * DM + LRUW + h * 64 + 2 * r) = v; }
            __syncthreads();
        }
    }
}
DI void p5_cross(Frame& F) {
    const int lane = F.lane, r = lane & 31, hh = lane >> 5, w = F.wave, tid = F.tid;
    constexpr int KST = 528, VST = 520;
    const float SC = 0.0625f * LOG2E;
    for (int u = F.vcu; u < NBATCH * 4 * 32; u += F.G) {
        const int b = u >> 7, hm = (u >> 5) & 3, qb = u & 31;
        const size_t qrow = (size_t)b * SEQ + (size_t)qb * 256 + 32 * w + r;
        { const bf16* src = F.wsp<bf16>(WS_KM) + (size_t)(b * 256) * DM + hm * 256;
#pragma unroll 4
          for (int i = 0; i < 16; ++i) { const int c = i * 512 + tid, row = c >> 5, ch = c & 31;
              *(LAS v4u*)(F.lds + row * KST + ch * 16) = *(const v4u*)(src + (size_t)row * DM + ch * 8); } }
        __syncthreads();
        f32x16 sc[8];
#pragma unroll
        for (int kt = 0; kt < 8; ++kt) sc[kt] = f32x16{};
#pragma unroll 2
        for (int s = 0; s < 16; ++s) {
            const bf16x8 qf = *(const bf16x8*)(F.wsp<bf16>(WS_QC) + qrow * DM + hm * 256 + 16 * s + 8 * hh);
#pragma unroll
            for (int kt = 0; kt < 8; ++kt) { const bf16x8 kf = *(const LAS bf16x8*)(F.lds + (32 * kt + r) * KST + (16 * s + 8 * hh) * 2); sc[kt] = MFMA32(kf, qf, sc[kt]); }
        }
        float mx = sc[0][0];
#pragma unroll
        for (int kt = 0; kt < 8; ++kt)
#pragma unroll
            for (int i = 0; i < 16; ++i) mx = fmaxf(mx, sc[kt][i]);
        mx = fmaxf(mx, swap32_partner(mx, hh));
        float ls = 0.f; const float mo = mx * SC;
        bf16x8 pf[8][2];
#pragma unroll
        for (int kt = 0; kt < 8; ++kt) {
#pragma unroll
            for (int i = 0; i < 16; ++i) { const float p = exp2_(sc[kt][i] * SC - mo); sc[kt][i] = p; ls += p; }
#pragma unroll
            for (int s2 = 0; s2 < 2; ++s2) { v4u wv; wv.x = pk2(sc[kt][8 * s2], sc[kt][8 * s2 + 1]); wv.y = pk2(sc[kt][8 * s2 + 2], sc[kt][8 * s2 + 3]); wv.z = pk2(sc[kt][8 * s2 + 4], sc[kt][8 * s2 + 5]); wv.w = pk2(sc[kt][8 * s2 + 6], sc[kt][8 * s2 + 7]);
                pf[kt][s2] = __builtin_bit_cast(bf16x8, wv); }
        }
        ls += swap32_partner(ls, hh);
        const float inv = 1.0f / ls;
        __syncthreads();
        { const bf16* src = F.wsp<bf16>(WS_VMT) + (size_t)((b * 4 + hm) * 256) * 256;
#pragma unroll 4
          for (int i = 0; i < 16; ++i) { const int c = i * 512 + tid, row = c >> 5, ch = c & 31; const v4u v = *(const v4u*)(src + (size_t)row * 256 + ch * 8);
              LAS v2u* d = (LAS v2u*)(F.lds + row * VST + ch * 16); d[0] = (v2u){v.x, v.y}; d[1] = (v2u){v.z, v.w}; } }
        __syncthreads();
        LAS unsigned* stg = (LAS unsigned*)(F.lds) ;
#pragma unroll
        for (int half = 0; half < 2; ++half) {
            f32x16 o[4];
#pragma unroll
            for (int dt = 0; dt < 4; ++dt) o[dt] = f32x16{};
#pragma unroll
            for (int kt = 0; kt < 8; ++kt)
#pragma unroll
                for (int s2 = 0; s2 < 2; ++s2)
#pragma unroll
                    for (int dt = 0; dt < 4; ++dt) { const LAS unsigned char* p = F.lds + (128 * half + 32 * dt + r) * VST + (32 * kt + 16 * s2 + 4 * hh) * 2;
                        const v2u lo = *(const LAS v2u*)p, hi = *(const LAS v2u*)(p + 16); v4u wv; wv.x = lo.x; wv.y = lo.y; wv.z = hi.x; wv.w = hi.y;
                        o[dt] = MFMA32(__builtin_bit_cast(bf16x8, wv), pf[kt][s2], o[dt]); }
            if (half == 1) __syncthreads();
            else {   }
            if (half == 0) {
#pragma unroll
                for (int dt = 0; dt < 4; ++dt)
#pragma unroll
                    for (int i = 0; i < 16; i += 2) { const unsigned pv = pk2(o[dt][i] * inv, o[dt][i + 1] * inv); sc[dt][i >> 1] = __uint_as_float(pv); }
            } else {
                LAS unsigned* sw = (LAS unsigned*)(F.lds + w * 16512);
#pragma unroll
                for (int dt = 0; dt < 4; ++dt)
#pragma unroll
                    for (int i = 0; i < 16; i += 2) { sw[r * 129 + ((32 * dt + crow(i, hh)) >> 1)] = __float_as_uint(sc[dt][i >> 1]);
                        sw[r * 129 + 64 + ((32 * dt + crow(i, hh)) >> 1)] = pk2(o[dt][i] * inv, o[dt][i + 1] * inv); }
                LDS_WAIT();
#pragma unroll 4
                for (int i = 0; i < 32; ++i) { const unsigned v0 = sw[i * 129 + lane], v1 = sw[i * 129 + 64 + lane];
                    GAS unsigned* dst = (GAS unsigned*)(F.wsp<bf16>(WS_OC) + ((size_t)b * SEQ + (size_t)qb * 256 + 32 * w + i) * DM + hm * 256);
                    dst[lane] = v0; dst[64 + lane] = v1; }
            }
        }
        (void)stg;
        __syncthreads();
    }
}
template <int N> DI void ce_desc(float (&a)[N], int i, int l) { const float hi = fmaxf(a[i], a[l]), lo = fminf(a[i], a[l]); a[i] = hi; a[l] = lo; }
template <int N, int OFF> DI void bitonic_sort16_desc(float (&a)[N]) {
#pragma unroll
    for (int k = 2; k <= 16; k <<= 1)
#pragma unroll
        for (int j = k >> 1; j > 0; j >>= 1)
#pragma unroll
            for (int i = 0; i < 16; ++i) { const int l = i ^ j; if (l > i) { const bool desc = ((i & k) == 0) || (k == 16);
                if (desc) ce_desc<N>(a, OFF + i, OFF + l); else ce_desc<N>(a, OFF + l, OFF + i); } }
}
template <int N, int OFF> DI void bitonic_merge16_desc(float (&a)[N]) {
#pragma unroll
    for (int j = 8; j > 0; j >>= 1)
#pragma unroll
        for (int i = 0; i < 16; ++i) { const int l = i ^ j; if (l > i) ce_desc<N>(a, OFF + i, OFF + l); }
}
template <bool SORTED> DI void top16_of_64(float (&a)[64]) {
    bitonic_sort16_desc<64, 0>(a); bitonic_sort16_desc<64, 16>(a); bitonic_sort16_desc<64, 32>(a); bitonic_sort16_desc<64, 48>(a);
#pragma unroll
    for (int i = 0; i < 16; ++i) { a[i] = fmaxf(a[i], a[31 - i]); a[32 + i] = fmaxf(a[32 + i], a[63 - i]); }
    bitonic_merge16_desc<64, 0>(a); bitonic_merge16_desc<64, 32>(a);
#pragma unroll
    for (int i = 0; i < 16; ++i) a[i] = fmaxf(a[i], a[47 - i]);
    if (SORTED) bitonic_merge16_desc<64, 0>(a);
}
DI void p8a_topk(Frame& F) {
    const int lane = F.lane, r = lane & 31, hh = lane >> 5, w = F.wave;
    LAS float* tbl = (LAS float*)(F.lds + w * 8192);
    const int gw = F.vcu * NWAVES + w, NGW = F.G * NWAVES;
    for (int task = gw; task < (M / 32) * PEER_H; task += NGW) {
        const int h = task & 7, tt = task >> 3; const size_t tok = (size_t)tt * 32 + r;
        float v[2][16];
#pragma unroll
        for (int p = 0; p < 2; ++p) {
            f32x16 sc[4];
#pragma unroll
            for (int nt = 0; nt < 4; ++nt) sc[nt] = f32x16{};
            const bf16* sk = F.wsp<bf16>(WS_SUBK) + (size_t)((h * 2 + p) * 128) * 128;
#pragma unroll 2
            for (int s = 0; s < 8; ++s) { const bf16x8 qf = *(const bf16x8*)(F.wsp<bf16>(WS_QP) + tok * 2048 + h * 256 + p * 128 + 16 * s + 8 * hh);
#pragma unroll
                for (int nt = 0; nt < 4; ++nt) { const bf16x8 kf = *(const bf16x8*)(sk + (size_t)(32 * nt + r) * 128 + 16 * s + 8 * hh); sc[nt] = MFMA32(kf, qf, sc[nt]); } }
            float a[64];
#pragma unroll
            for (int nt = 0; nt < 4; ++nt)
#pragma unroll
                for (int i = 0; i < 16; ++i) a[nt * 16 + i] = __uint_as_float((__float_as_uint(sc[nt][i]) & ~127u) | (unsigned)(32 * nt + crow(i, hh)));
            top16_of_64<true>(a);
            float m[16];
#pragma unroll
            for (int i = 0; i < 16; ++i) m[i] = fmaxf(a[i], swap32_partner(a[15 - i], hh));
            bitonic_merge16_desc<16, 0>(m);
#pragma unroll
            for (int i = 0; i < 16; ++i) v[p][i] = m[i];
        }
        float c[64]; int n = 0;
#pragma unroll
        for (int i = 0; i < 16; ++i)
#pragma unroll
            for (int j = 0; j < 16; ++j) if ((i + 1) * (j + 1) <= 16) { c[n] = __uint_as_float((__float_as_uint(v[0][i] + v[1][j]) & ~255u) | (unsigned)((i << 4) | j)); ++n; }
#pragma unroll
        for (int k = 50; k < 64; ++k) c[k] = -3.0e38f;
        top16_of_64<false>(c);
#pragma unroll
        for (int i = 0; i < 16; ++i) { tbl[i * 64 + lane] = v[0][i]; tbl[(16 + i) * 64 + lane] = v[1][i]; }
        LDS_WAIT();
        float sv[16]; int ev[16]; float mx = -3.0e38f;
#pragma unroll
        for (int k = 0; k < 16; ++k) { const unsigned pl = __float_as_uint(c[k]) & 255u; const float a1 = tbl[(pl >> 4) * 64 + lane], a2 = tbl[(16 + (pl & 15)) * 64 + lane];
            sv[k] = a1 + a2; ev[k] = (int)(((__float_as_uint(a1) & 127u) << 7) | (__float_as_uint(a2) & 127u)); mx = fmaxf(mx, sv[k]); }
        float sum = 0.f;
#pragma unroll
        for (int k = 0; k < 16; ++k) { sv[k] = __expf(sv[k] - mx); sum += sv[k]; }
        const float inv = 1.0f / sum;
        if (hh == 0) {
#pragma unroll
            for (int k = 0; k < 16; k += 4) *(v4u*)(F.wsp<int>(WS_IDX) + tok * NSEL + h * 16 + k) = (v4u){(unsigned)ev[k], (unsigned)ev[k + 1], (unsigned)ev[k + 2], (unsigned)ev[k + 3]};
        } else {
#pragma unroll
            for (int k = 0; k < 16; k += 4) *(f32x4*)(F.wsp<float>(WS_G) + tok * NSEL + h * 16 + k) = (f32x4){sv[k] * inv, sv[k + 1] * inv, sv[k + 2] * inv, sv[k + 3] * inv};
        }
        LDS_WAIT();
    }
}
DI f32x2 fp8lo(unsigned w) { return __builtin_amdgcn_cvt_pk_f32_fp8(w, false); }
DI f32x2 fp8hi(unsigned w) { return __builtin_amdgcn_cvt_pk_f32_fp8(w, true); }
DI float dot16_fp8(const v4u& u, const f32x2 (&x)[8]) {
    f32x2 a = {0.f, 0.f};
    a = __builtin_elementwise_fma(fp8lo(u.x), x[0], a); a = __builtin_elementwise_fma(fp8hi(u.x), x[1], a);
    a = __builtin_elementwise_fma(fp8lo(u.y), x[2], a); a = __builtin_elementwise_fma(fp8hi(u.y), x[3], a);
    a = __builtin_elementwise_fma(fp8lo(u.z), x[4], a); a = __builtin_elementwise_fma(fp8hi(u.z), x[5], a);
    a = __builtin_elementwise_fma(fp8lo(u.w), x[6], a); a = __builtin_elementwise_fma(fp8hi(u.w), x[7], a);
    return a.x + a.y;
}
DI void axpy16_fp8(f32x2 (&o)[8], float w, const v4u& v) {
    const f32x2 w2 = {w, w};
    o[0] = __builtin_elementwise_fma(fp8lo(v.x), w2, o[0]); o[1] = __builtin_elementwise_fma(fp8hi(v.x), w2, o[1]);
    o[2] = __builtin_elementwise_fma(fp8lo(v.y), w2, o[2]); o[3] = __builtin_elementwise_fma(fp8hi(v.y), w2, o[3]);
    o[4] = __builtin_elementwise_fma(fp8lo(v.z), w2, o[4]); o[5] = __builtin_elementwise_fma(fp8hi(v.z), w2, o[5]);
    o[6] = __builtin_elementwise_fma(fp8lo(v.w), w2, o[6]); o[7] = __builtin_elementwise_fma(fp8hi(v.w), w2, o[7]);
}
DI void p8b_peer(Frame& F) {
    const int lane = F.lane;
    const int gw = F.vcu * NWAVES + F.wave, NGW = F.G * NWAVES;
    const unsigned char* EU8 = F.wsp<unsigned char>(WS_EU); const unsigned char* EV8 = F.wsp<unsigned char>(WS_EV);
    for (int tok = gw; tok < M; tok += NGW) {
        float rstd; { const f32x4* sp = (const f32x4*)(F.wsp<float>(WS_SSQ2) + (size_t)tok * 16); const f32x4 st = (sp[0] + sp[1]) + (sp[2] + sp[3]); rstd = rsq_(((st.x + st.y) + (st.z + st.w)) * (1.f / 1024.f) + EPS); }
        f32x2 x[8];
        { const v4u x0 = *(const v4u*)(F.wsp<bf16>(WS_XN) + (size_t)tok * DM + 16 * lane), x1 = *(const v4u*)(F.wsp<bf16>(WS_XN) + (size_t)tok * DM + 16 * lane + 8);
          const float s = rstd * (1.f / U_SCALE);
          x[0] = (f32x2){bflo(x0.x) * s, bfhi(x0.x) * s}; x[1] = (f32x2){bflo(x0.y) * s, bfhi(x0.y) * s}; x[2] = (f32x2){bflo(x0.z) * s, bfhi(x0.z) * s}; x[3] = (f32x2){bflo(x0.w) * s, bfhi(x0.w) * s};
          x[4] = (f32x2){bflo(x1.x) * s, bfhi(x1.x) * s}; x[5] = (f32x2){bflo(x1.y) * s, bfhi(x1.y) * s}; x[6] = (f32x2){bflo(x1.z) * s, bfhi(x1.z) * s}; x[7] = (f32x2){bflo(x1.w) * s, bfhi(x1.w) * s}; }
        const int e0 = F.wsp<int>(WS_IDX)[(size_t)tok * NSEL + lane], e1 = F.wsp<int>(WS_IDX)[(size_t)tok * NSEL + 64 + lane];
        const float g0 = F.wsp<float>(WS_G)[(size_t)tok * NSEL + lane] * (1.f / V_SCALE), g1 = F.wsp<float>(WS_G)[(size_t)tok * NSEL + 64 + lane] * (1.f / V_SCALE);
        f32x2 o[8];
#pragma unroll
        for (int i = 0; i < 8; ++i) o[i] = (f32x2){0.f, 0.f};
#pragma unroll
        for (int grp = 0; grp < 8; ++grp) {
            float d[16]; v4u vv[16];
#pragma unroll
            for (int k = 0; k < 16; ++k) { const int kk = grp * 16 + k; const int e = __builtin_amdgcn_readlane(kk < 64 ? e0 : e1, kk & 63);
                const v4u u = *(const v4u*)(EU8 + (size_t)e * DM + 16 * lane);
                vv[k] = *(const v4u*)(EV8 + (size_t)e * DM + 16 * lane);
                d[k] = dot16_fp8(u, x); }
#pragma unroll
            for (int k = 0; k < 16; ++k) d[k] = sum64(d[k]);
#pragma unroll
            for (int k = 0; k < 16; ++k) { const int kk = grp * 16 + k;
                const float g = __builtin_bit_cast(float, __builtin_amdgcn_readlane(__builtin_bit_cast(int, kk < 64 ? g0 : g1), kk & 63));
                axpy16_fp8(o, g * gelu_tanh(d[k]), vv[k]); }
        }
        float* xr = F.out + (size_t)tok * DM + 16 * lane;
        f32x4 a[4]; float ss = 0.f;
#pragma unroll
        for (int j = 0; j < 4; ++j) { a[j] = *(const f32x4*)(xr + 4 * j); a[j].x += o[2 * j].x; a[j].y += o[2 * j].y; a[j].z += o[2 * j + 1].x; a[j].w += o[2 * j + 1].y;
            ss += (a[j].x * a[j].x + a[j].y * a[j].y) + (a[j].z * a[j].z + a[j].w * a[j].w); }
        const float rf = rsq_(sum64(ss) * (1.f / 1024.f) + EPS);
#pragma unroll
        for (int j = 0; j < 4; ++j) *(f32x4*)(xr + 4 * j) = a[j] * rf * *(const f32x4*)(F.in(25) + 16 * lane + 4 * j);
    }
}
constexpr int N_PHASES = 11;
__global__ void __launch_bounds__(NWAVES * 64, 2) fwd_kernel(Args args) {
    extern __shared__ __attribute__((aligned(16))) unsigned char lds[];
    Frame F;
    F.lds = (LAS unsigned char*)lds;
    F.MISC = (volatile LAS unsigned*)(F.lds + MISC_OFF);
    F.tid = threadIdx.x; F.lane = F.tid & 63; F.wave = __builtin_amdgcn_readfirstlane(F.tid >> 6);
    F.G = gridDim.x; { const int bx = blockIdx.x; F.vcu = (F.G % 8 == 0) ? (bx % 8) * (F.G / 8) + bx / 8 : bx; }
    F.A = &args; F.ws = args.ws; F.out = args.out;
    F.ctl = (gu32*)(args.ws + WS_CTL);
    for (int u = F.tid; u < (LDS_BYTES - LDSCTL_OFF) / 4; u += NWAVES * 64) ((LAS unsigned*)(F.lds + LDSCTL_OFF))[u] = 0u;
    __syncthreads();
    const bool multi = (args.ph_hi - args.ph_lo) > 1;
    XcdBarrier bar; bar.bar = (unsigned*)(F.ctl + CW_BAR) + args.li * XCD_BAR_WORDS; bar.x = 0; bar.st = nullptr;
    if (multi) bar = xcd_barrier_post((unsigned*)(F.ctl + CW_BAR) + args.li * XCD_BAR_WORDS, F.MISC + 8);
    const int lo = args.ph_lo, hi = args.ph_hi;
#ifndef PHASE_MASK
#define PHASE_MASK 0x7ff
#endif
#define IN(k) (((PHASE_MASK >> (k)) & 1) && lo <= (k) && (k) < hi)
#define SEAM(k) do { asm volatile("; ===SEAM " #k ::: "memory"); if (IN(k) && IN((k) + 1)) xcd_barrier(bar); } while (0)
    const int c = (int)blockIdx.x;

    if (IN(0)) { p0_prologue(F); } SEAM(0);
    if (IN(1)) {
        { pg8::Gemm g{F.wsp<bf16>(WS_XN), F.wsp<bf16>(WS_WIN), M, INW, DM}; pg8::StaticOrder S; S.init(M, INW, F.G, c);
          pg8::EpiSplitT E{F.wsp<bf16>(WS_Z), ZW, ZW, F.wsp<bf16>(WS_VT), ATTW, SEQ};
          pg8::gemm_phase<pg8::EpiSplitT, pg8::StaticOrder, true, true>(F.lds, g, S, E); }
        { const int nw3 = (M / 256) * (INW / 256) - 2 * F.G;
          int idx = -1; if (nw3 >= 0 && nw3 + 16 <= F.G) idx = c - nw3; else idx = (c < 16 && F.G >= 16) ? c : -1;
          if (F.G < 16) idx = -1;
          pg8::Gemm g{F.wsp<bf16>(WS_MEMN), F.wsp<bf16>(WS_WKV), NBATCH * 256, 2 * DM, DM};
          if (F.G >= 16) { pg8::OneUnit S{idx, 2, 8}; pg8::EpiSplitT E{F.wsp<bf16>(WS_KM), DM, DM, F.wsp<bf16>(WS_VMT), DM, 256};
              pg8::gemm_phase<pg8::EpiSplitT, pg8::OneUnit, false, true>(F.lds, g, S, E); }
          else { pg8::StaticOrder S; S.init(NBATCH * 256, 2 * DM, F.G, c); pg8::EpiSplitT E{F.wsp<bf16>(WS_KM), DM, DM, F.wsp<bf16>(WS_VMT), DM, 256};
              pg8::gemm_phase<pg8::EpiSplitT, pg8::StaticOrder, false, true>(F.lds, g, S, E); } }
    } SEAM(1);
    if (IN(2)) { p2_lru_aggregates(F); } SEAM(2);
    if (IN(3)) { p3_mixer(F); } SEAM(3);
    if (IN(4)) {
        pg8::Gemm g{F.wsp<bf16>(WS_Y), F.wsp<bf16>(WS_WOUT), M, DM, DM}; pg8::StaticOrder S; S.init(M, DM, F.G, c);
        pg8::EpiResid E{F.in(0), F.out, F.wsp<bf16>(WS_XN), F.wsp<float>(WS_SSQ1), DM};
        pg8::gemm_phase<pg8::EpiResid, pg8::StaticOrder, true, true>(F.lds, g, S, E);
    } SEAM(4);
    if (IN(5)) {
        pg8::Gemm g{F.wsp<bf16>(WS_XN), F.wsp<bf16>(WS_WQ), M, DM, DM}; pg8::StaticOrder S; S.init(M, DM, F.G, c);
        pg8::EpiRowScale E{F.wsp<bf16>(WS_QC), DM, F.wsp<float>(WS_SSQ1), 1.f / 1024.f, EPS};
        pg8::gemm_phase<pg8::EpiRowScale, pg8::StaticOrder, true, true>(F.lds, g, S, E);
    } SEAM(5);
    if (IN(6)) { p5_cross(F); } SEAM(6);
    if (IN(7)) {
        pg8::Gemm g{F.wsp<bf16>(WS_OC), F.wsp<bf16>(WS_WO), M, DM, DM}; pg8::StaticOrder S; S.init(M, DM, F.G, c);
        pg8::EpiResid E{F.out, F.out, F.wsp<bf16>(WS_XN), F.wsp<float>(WS_SSQ2), DM};
        pg8::gemm_phase<pg8::EpiResid, pg8::StaticOrder, true, true>(F.lds, g, S, E);
    } SEAM(7);
    if (IN(8)) {
        pg8::Gemm g{F.wsp<bf16>(WS_XN), F.wsp<bf16>(WS_WQRY), M, 2 * DM, DM}; pg8::StaticOrder S; S.init(M, 2 * DM, F.G, c);
        pg8::EpiRowScale E{F.wsp<bf16>(WS_QP), 2 * DM, F.wsp<float>(WS_SSQ2), 1.f / 1024.f, EPS};
        pg8::gemm_phase<pg8::EpiRowScale, pg8::StaticOrder, true, true>(F.lds, g, S, E);
    } SEAM(8);
    if (IN(9)) { p8a_topk(F); } SEAM(9);
    if (IN(10)) { p8b_peer(F); }
#undef IN
#undef SEAM
}

#ifndef N_LAUNCH_MODE
#define N_LAUNCH_MODE 1
#endif
extern "C" void kernel_launch(void* const* d_in, const int* in_sizes, int n_in, void* d_out, int out_size, void* d_ws, size_t ws_size, hipStream_t stream) {
    static int grid = 0;
    if (grid == 0) {
        if (n_in != 26 || out_size != M * DM || ws_size < WS_END) { fprintf(stderr, "kernel_launch: unexpected shapes (n_in %d, out %d, ws %zu)\n", n_in, out_size, ws_size); grid = -1; return; }
        int dev = 0, cus = 0, per_cu = 0;
        if (hipGetDevice(&dev) != hipSuccess || hipDeviceGetAttribute(&cus, hipDeviceAttributeMultiprocessorCount, dev) != hipSuccess) { grid = -1; return; }
        if (hipFuncSetAttribute((const void*)fwd_kernel, hipFuncAttributeMaxDynamicSharedMemorySize, LDS_BYTES) != hipSuccess) { fprintf(stderr, "kernel_launch: hipFuncSetAttribute failed\n"); grid = -1; return; }
        if (hipOccupancyMaxActiveBlocksPerMultiprocessor(&per_cu, (const void*)fwd_kernel, NWAVES * 64, LDS_BYTES) != hipSuccess || per_cu < 1) { fprintf(stderr, "kernel_launch: occupancy query says %d blocks per CU\n", per_cu); (void)hipGetLastError(); grid = -1; return; }
        grid = cus;
    }
    if (grid < 0) return;
    (void)hipMemsetAsync((char*)d_ws + WS_CTL, 0, CTL_ZERO_BYTES, stream);
    Args a{};
    for (int i = 0; i < 26; ++i) a.in[i] = (const float*)d_in[i];
    a.out = (float*)d_out; a.ws = (unsigned char*)d_ws;
    if (N_LAUNCH_MODE == 1) { a.ph_lo = 0; a.ph_hi = N_PHASES; a.li = 0; hipLaunchKernelGGL(fwd_kernel, dim3(grid), dim3(NWAVES * 64), LDS_BYTES, stream, a); }
    else { for (int p = 0; p < N_PHASES; ++p) { a.ph_lo = p; a.ph_hi = p + 1; a.li = 0; hipLaunchKernelGGL(fwd_kernel, dim3(grid), dim3(NWAVES * 64), LDS_BYTES, stream, a); } }
}
```

```cpp
#include <hip/hip_runtime.h>
#include <cstdio>
#include <cstdint>
namespace pg8 {
#define PG8_LAS __attribute__((address_space(3)))
typedef unsigned short bf16_t;
typedef short bf16x8 __attribute__((ext_vector_type(8)));
typedef float f32x4 __attribute__((ext_vector_type(4)));
typedef unsigned u32x4 __attribute__((ext_vector_type(4)));
constexpr int BM = 256, BK = 64, HALF = 128, HTB = HALF * BK * 2  , STAGE_BYTES = 8 * HTB, NXCD = 8, WGM = 8;

__host__ __device__ __forceinline__ int lds_byte(int r, int c) { const int st = (r >> 4) * 2 + (c >> 5), rr = r & 15, cc = c & 31, ob = rr * 64 + cc * 2; return st * 1024 + (ob ^ (((ob >> 9) & 1) << 5)); }
__host__ __device__ __forceinline__ void stage_rc(int b, int& R, int& C) { const int st = b / 1024, sb = b % 1024, swz = sb ^ (((sb >> 9) & 1) << 5); R = (st >> 1) * 16 + swz / 64; C = (st & 1) * 32 + (swz % 64) / 2; }
__host__ __device__ __forceinline__ int perm32(int rho) { const int n = rho >> 4, i = rho & 15; return 8 * (i >> 2) + 4 * n + (i & 3); }

struct Unit { int pm, pn; };
struct Gemm { const bf16_t* A; const bf16_t* Bt; int M, N, K; };

struct StaticOrder {
    int nM, nN, nwg, G, c;
    __host__ __device__ void init(int M, int N, int G_, int c_) { nM = M / BM; nN = N / BM; nwg = nM * nN; G = G_; c = c_; }
    __host__ __device__ bool next(int i, Unit& u) const {
        const long L = (long)i * G + c; if (L >= nwg) return false;
        int wgid = (int)L; { const int q = nwg / NXCD, r = nwg % NXCD, xcd = wgid % NXCD, off = wgid / NXCD; wgid = (xcd < r ? xcd * (q + 1) : r * (q + 1) + (xcd - r) * q) + off; }
        const int nig = WGM * nN, gid = wgid / nig, fm = gid * WGM, gsz = (nM - fm) < WGM ? (nM - fm) : WGM;
        u.pm = fm + ((wgid % nig) % gsz); u.pn = (wgid % nig) / gsz; return true;
    }
    __device__ __forceinline__ void a_ready(const Unit&) const {}
    __device__ __forceinline__ void done(const Unit&) const {}
};

typedef float f32x2 __attribute__((ext_vector_type(2)));
typedef __bf16 bf16x2_t __attribute__((ext_vector_type(2)));
__device__ __forceinline__ unsigned cvt_pk_bf16(float lo, float hi) { f32x2 v = {lo, hi}; bf16x2_t b = __builtin_convertvector(v, bf16x2_t); return __builtin_bit_cast(unsigned, b); }
__device__ __forceinline__ bf16_t cvt_bf16(float x) { return (bf16_t)(cvt_pk_bf16(x, 0.f) & 0xffffu); }

struct EpiSplitT {
    static constexpr bool PERM = true, AFTER_DRAIN = false;
    bf16_t* O; int ldc; int ncols_rm; bf16_t* T; int NT; int rpb;
    __device__ __forceinline__ void operator()(const f32x4 (&acc)[2][2][4][2], const Unit& u, int wr, int wc, int fr, int fq) const {
        const int row0 = u.pm * BM + wr * 64 + fr; const int colt = u.pn * BM;
        if (colt < ncols_rm) {
            const int col0 = colt + wc * 32 + 8 * fq;
#pragma unroll
            for (int ai = 0; ai < 2; ++ai)
#pragma unroll
                for (int m = 0; m < 4; ++m) { bf16_t* rowp = O + (size_t)(row0 + ai * HALF + m * 16) * ldc + col0;
#pragma unroll
                    for (int bj = 0; bj < 2; ++bj) { const f32x4 v0 = acc[ai][bj][m][0], v1 = acc[ai][bj][m][1];
                        u32x4 w; w.x = cvt_pk_bf16(v0[0], v0[1]); w.y = cvt_pk_bf16(v0[2], v0[3]); w.z = cvt_pk_bf16(v1[0], v1[1]); w.w = cvt_pk_bf16(v1[2], v1[3]);
                        *(u32x4*)(rowp + bj * HALF) = w; } }
        } else {
            const int c0 = colt - ncols_rm + wc * 32 + 8 * fq;
#pragma unroll
            for (int ai = 0; ai < 2; ++ai)
#pragma unroll
                for (int m = 0; m < 4; ++m) { const int row = row0 + ai * HALF + m * 16; const int b = row / rpb, t = row - b * rpb; bf16_t* base = T + (size_t)b * NT * rpb + t;
#pragma unroll
                    for (int bj = 0; bj < 2; ++bj)
#pragma unroll
                        for (int n = 0; n < 2; ++n)
#pragma unroll
                            for (int e = 0; e < 4; ++e) base[(size_t)(c0 + bj * HALF + 4 * n + e) * rpb] = cvt_bf16(acc[ai][bj][m][n][e]); }
        }
    }
};
struct EpiResid {
    static constexpr bool PERM = true, AFTER_DRAIN = false;
    const float* base; float* out; bf16_t* xb; float* ssq; int ldc;
    __device__ __forceinline__ void operator()(const f32x4 (&acc)[2][2][4][2], const Unit& u, int wr, int wc, int fr, int fq) const {
        const int row0 = u.pm * BM + wr * 64 + fr; const int col0 = u.pn * BM + wc * 32 + 8 * fq;
#pragma unroll
        for (int ai = 0; ai < 2; ++ai)
#pragma unroll
            for (int m = 0; m < 4; ++m) { const int row = row0 + ai * HALF + m * 16; float s = 0.f;
#pragma unroll
                for (int bj = 0; bj < 2; ++bj) { const size_t off = (size_t)row * ldc + col0 + bj * HALF;
                    const f32x4 b0 = *(const f32x4*)(base + off), b1 = *(const f32x4*)(base + off + 4);
                    const f32x4 v0 = acc[ai][bj][m][0] + b0, v1 = acc[ai][bj][m][1] + b1;
                    *(f32x4*)(out + off) = v0; *(f32x4*)(out + off + 4) = v1;
                    s += (v0[0] * v0[0] + v0[1] * v0[1]) + (v0[2] * v0[2] + v0[3] * v0[3]) + (v1[0] * v1[0] + v1[1] * v1[1]) + (v1[2] * v1[2] + v1[3] * v1[3]);
                    u32x4 w; w.x = cvt_pk_bf16(v0[0], v0[1]); w.y = cvt_pk_bf16(v0[2], v0[3]); w.z = cvt_pk_bf16(v1[0], v1[1]); w.w = cvt_pk_bf16(v1[2], v1[3]);
                    *(u32x4*)(xb + off) = w; }
                s += __shfl_xor(s, 16); s += __shfl_xor(s, 32);
                if (fq == 0) ssq[(size_t)row * 16 + u.pn * 4 + wc] = s; }
    }
};
struct EpiRowScale {
    static constexpr bool PERM = true, AFTER_DRAIN = false;
    bf16_t* O; int ldc; const float* ssq; float inv_n, eps;
    __device__ __forceinline__ void operator()(const f32x4 (&acc)[2][2][4][2], const Unit& u, int wr, int wc, int fr, int fq) const {
        const int row0 = u.pm * BM + wr * 64 + fr; const int col0 = u.pn * BM + wc * 32 + 8 * fq;
#pragma unroll
        for (int ai = 0; ai < 2; ++ai)
#pragma unroll
            for (int m = 0; m < 4; ++m) { const int row = row0 + ai * HALF + m * 16; const f32x4* sp = (const f32x4*)(ssq + (size_t)row * 16);
                const f32x4 s0 = sp[0], s1 = sp[1], s2 = sp[2], s3 = sp[3]; const f32x4 st = (s0 + s1) + (s2 + s3);
                const float r = 1.0f / sqrtf(((st[0] + st[1]) + (st[2] + st[3])) * inv_n + eps);
                bf16_t* rowp = O + (size_t)row * ldc + col0;
#pragma unroll
                for (int bj = 0; bj < 2; ++bj) { const f32x4 v0 = acc[ai][bj][m][0] * r, v1 = acc[ai][bj][m][1] * r;
                    u32x4 w; w.x = cvt_pk_bf16(v0[0], v0[1]); w.y = cvt_pk_bf16(v0[2], v0[3]); w.z = cvt_pk_bf16(v1[0], v1[1]); w.w = cvt_pk_bf16(v1[2], v1[3]);
                    *(u32x4*)(rowp + bj * HALF) = w; } }
    }
};
struct OneUnit {
    int idx, nM, nN;
    __device__ __forceinline__ bool next(int i, Unit& u) const { if (i > 0 || idx < 0 || idx >= nM * nN) return false; u.pm = idx % nM; u.pn = idx / nM; return true; }
    __device__ __forceinline__ void a_ready(const Unit&) const {}
    __device__ __forceinline__ void done(const Unit&) const {}
};

template <class Epi, class Sched, bool ALIGN_EPI = false, bool SP2 = false>
__device__ __forceinline__ void gemm_phase(PG8_LAS unsigned char* lds, const Gemm g, const Sched& S, const Epi& E) {
    const int tid = threadIdx.x, wid = __builtin_amdgcn_readfirstlane(tid >> 6), lane = tid & 63, wr = wid >> 2, wc = wid & 3, fr = lane & 15, fq = lane >> 4;
    const int K = g.K, nt = K / BK;
    unsigned voffA[2], voffB[2];
#pragma unroll
    for (int i = 0; i < 2; ++i) { int R, C; stage_rc(tid * 16 + i * 8192, R, C); const int Rb = Epi::PERM ? ((R & ~31) + perm32(R & 31)) : R;
        voffA[i] = (unsigned)(R * K + C) * 2u; voffB[i] = (unsigned)(Rb * K + C) * 2u; }
    const size_t kstep = (size_t)(BK * 2);
    const size_t hstep = (size_t)HALF * K * 2;
    const size_t tstep = 2 * hstep;
    const unsigned ldsw = (unsigned)wid * 1024u;
    const int aoff = lds_byte(wr * 64 + fr, fq * 8), boff = lds_byte(wc * 32 + fr, fq * 8);
#define PG8_SA(b, h) (((b) * 2 + (h)) * HTB)
#define PG8_SB(b, h) ((4 + (b) * 2 + (h)) * HTB)
#define PG8_STAGE(bufoff, gbase, voff) do { _Pragma("unroll") for (int _i = 0; _i < 2; ++_i) \
        __builtin_amdgcn_global_load_lds((const unsigned*)((const char*)(gbase) + (voff)[_i]), (PG8_LAS unsigned*)(lds + (bufoff) + ldsw + _i * 8192), 16, 0, 0); } while (0)
#define PG8_LDA(dst, b, h) do { _Pragma("unroll") for (int m = 0; m < 4; ++m) _Pragma("unroll") for (int k = 0; k < 2; ++k) dst[m][k] = *(const PG8_LAS bf16x8*)(lds + PG8_SA(b, h) + aoff + m * 2048 + k * 1024); } while (0)
#define PG8_LDB(dst, b, h) do { _Pragma("unroll") for (int n = 0; n < 2; ++n) _Pragma("unroll") for (int k = 0; k < 2; ++k) dst[n][k] = *(const PG8_LAS bf16x8*)(lds + PG8_SB(b, h) + boff + n * 2048 + k * 1024); } while (0)
#define PG8_MMA(ai, bj, At, Bt) do { __builtin_amdgcn_s_setprio(1); _Pragma("unroll") for (int m = 0; m < 4; ++m) _Pragma("unroll") for (int n = 0; n < 2; ++n) _Pragma("unroll") for (int k = 0; k < 2; ++k) \
        acc[ai][bj][m][n] = __builtin_amdgcn_mfma_f32_16x16x32_bf16(Bt[n][k], At[m][k], acc[ai][bj][m][n], 0, 0, 0); __builtin_amdgcn_s_setprio(0); } while (0)
#define PG8_WAIT_V(n) asm volatile("s_waitcnt vmcnt(" #n ")" ::: "memory")
#define PG8_WAIT_L(n) asm volatile("s_waitcnt lgkmcnt(" #n ")" ::: "memory")
#define PG8_BAR __builtin_amdgcn_s_barrier()
#define PG8_SCHED __builtin_amdgcn_sched_barrier(0)
    Unit cur, nxt; int ui = 0;
    if (!S.next(0, cur)) return;
    f32x4 acc[2][2][4][2];
#pragma unroll
    for (int a = 0; a < 2; ++a)
#pragma unroll
        for (int b = 0; b < 2; ++b)
#pragma unroll
            for (int m = 0; m < 4; ++m)
#pragma unroll
                for (int n = 0; n < 2; ++n) acc[a][b][m][n] = (f32x4){0.f, 0.f, 0.f, 0.f};
    bf16x8 At[4][2], B0[2][2], B1[2][2];
    const char* cA = (const char*)g.A + (size_t)cur.pm * tstep; const char* cB = (const char*)g.Bt + (size_t)cur.pn * tstep;
    S.a_ready(cur);
    if constexpr (SP2) {
        PG8_STAGE(PG8_SB(0, 0), cB, voffB); PG8_STAGE(PG8_SB(0, 1), cB + hstep, voffB); PG8_STAGE(PG8_SA(0, 0), cA, voffA); PG8_STAGE(PG8_SA(0, 1), cA + hstep, voffA);
        if (wr == 1) PG8_BAR;
        PG8_WAIT_V(2); PG8_BAR;
        PG8_STAGE(PG8_SB(1, 0), cB + kstep, voffB); PG8_STAGE(PG8_SA(1, 0), cA + kstep, voffA); PG8_STAGE(PG8_SB(1, 1), cB + hstep + kstep, voffB);
        PG8_WAIT_V(6); PG8_BAR;
    } else {
        PG8_STAGE(PG8_SB(0, 0), cB, voffB); PG8_STAGE(PG8_SA(0, 0), cA, voffA); PG8_STAGE(PG8_SB(0, 1), cB + hstep, voffB); PG8_STAGE(PG8_SA(0, 1), cA + hstep, voffA);
        if (wr == 1) PG8_BAR;
        PG8_WAIT_V(4); PG8_BAR;
        PG8_STAGE(PG8_SB(1, 0), cB + kstep, voffB); PG8_STAGE(PG8_SA(1, 0), cA + kstep, voffA); PG8_STAGE(PG8_SB(1, 1), cB + hstep + kstep, voffB);
        PG8_WAIT_V(6); PG8_BAR;
    }
    for (;;) {
        const bool has_next = S.next(ui + 1, nxt);
        const char* nA = has_next ? (const char*)g.A + (size_t)nxt.pm * tstep : cA; const char* nB = has_next ? (const char*)g.Bt + (size_t)nxt.pn * tstep : cB;
        for (int t = 0; t < nt; t += 2) {
            const bool last = (t == nt - 2);
            const char* a1 = cA + (size_t)(t + 1) * kstep;
            const char* a2 = last ? nA : cA + (size_t)(t + 2) * kstep; const char* b2 = last ? nB : cB + (size_t)(t + 2) * kstep;
            const char* a3 = a2 + kstep; const char* b3 = b2 + kstep;
            if (last && has_next) S.a_ready(nxt);
            if constexpr (SP2) {
            PG8_LDB(B0, 0, 0); PG8_LDB(B1, 0, 1); PG8_SCHED; PG8_LDA(At, 0, 0); PG8_STAGE(PG8_SA(1, 1), a1 + hstep, voffA);
            PG8_WAIT_V(8); PG8_WAIT_L(0); PG8_BAR; PG8_MMA(0, 0, At, B0); PG8_MMA(0, 1, At, B1); PG8_BAR; PG8_SCHED;
            PG8_LDA(At, 0, 1); PG8_STAGE(PG8_SB(0, 0), b2, voffB); PG8_STAGE(PG8_SB(0, 1), b2 + hstep, voffB); PG8_STAGE(PG8_SA(0, 0), a2, voffA);
            PG8_WAIT_V(8); PG8_WAIT_L(0); PG8_BAR; PG8_MMA(1, 0, At, B0); PG8_MMA(1, 1, At, B1); PG8_BAR; PG8_SCHED;
            PG8_LDB(B0, 1, 0); PG8_LDB(B1, 1, 1); PG8_SCHED; PG8_LDA(At, 1, 0); PG8_STAGE(PG8_SA(0, 1), a2 + hstep, voffA);
            PG8_WAIT_V(8); PG8_WAIT_L(0); PG8_BAR; PG8_MMA(0, 0, At, B0); PG8_MMA(0, 1, At, B1); PG8_BAR; PG8_SCHED;
            PG8_LDA(At, 1, 1); PG8_STAGE(PG8_SB(1, 0), b3, voffB); PG8_STAGE(PG8_SB(1, 1), b3 + hstep, voffB); PG8_STAGE(PG8_SA(1, 0), a3, voffA);
            PG8_WAIT_V(8); PG8_WAIT_L(0); PG8_BAR; PG8_MMA(1, 0, At, B0); PG8_MMA(1, 1, At, B1); PG8_BAR; PG8_SCHED;
            } else {
            PG8_LDB(B0, 0, 0); PG8_SCHED; PG8_LDA(At, 0, 0); PG8_STAGE(PG8_SA(1, 1), a1 + hstep, voffA);
            PG8_WAIT_L(8); PG8_BAR; PG8_WAIT_L(0); PG8_MMA(0, 0, At, B0); PG8_BAR; PG8_SCHED;
            PG8_LDB(B1, 0, 1); PG8_STAGE(PG8_SB(0, 0), b2, voffB);
            PG8_BAR; PG8_WAIT_L(0); PG8_MMA(0, 1, At, B1); PG8_BAR;
            PG8_LDA(At, 0, 1); PG8_STAGE(PG8_SA(0, 0), a2, voffA);
            PG8_BAR; PG8_WAIT_L(0); PG8_MMA(1, 0, At, B0); PG8_BAR; PG8_SCHED;
            PG8_STAGE(PG8_SB(0, 1), b2 + hstep, voffB);
            PG8_WAIT_V(6); PG8_BAR; PG8_MMA(1, 1, At, B1); PG8_BAR;
            PG8_LDB(B0, 1, 0); PG8_SCHED; PG8_LDA(At, 1, 0); PG8_STAGE(PG8_SA(0, 1), a2 + hstep, voffA);
            PG8_WAIT_L(8); PG8_BAR; PG8_WAIT_L(0); PG8_MMA(0, 0, At, B0); PG8_BAR; PG8_SCHED;
            PG8_LDB(B1, 1, 1); PG8_STAGE(PG8_SB(1, 0), b3, voffB);
            PG8_BAR; PG8_WAIT_L(0); PG8_MMA(0, 1, At, B1); PG8_BAR;
            PG8_LDA(At, 1, 1); PG8_STAGE(PG8_SA(1, 0), a3, voffA);
            PG8_BAR; PG8_WAIT_L(0); PG8_MMA(1, 0, At, B0); PG8_BAR; PG8_SCHED;
            PG8_STAGE(PG8_SB(1, 1), b3 + hstep, voffB);
            PG8_WAIT_V(6); PG8_BAR; PG8_MMA(1, 1, At, B1); PG8_BAR;
            }
        }
        if constexpr (ALIGN_EPI) { if (wr == 0) PG8_BAR; }
        if constexpr (!Epi::AFTER_DRAIN) { E(acc, cur, wr, wc, fr, fq); S.done(cur); }
        if (!has_next) break;
#pragma unroll
        for (int a = 0; a < 2; ++a)
#pragma unroll
            for (int b = 0; b < 2; ++b)
#pragma unroll
                for (int m = 0; m < 4; ++m)
#pragma unroll
                    for (int n = 0; n < 2; ++n) acc[a][b][m][n] = (f32x4){0.f, 0.f, 0.f, 0.f};
        cur = nxt; cA = nA; cB = nB; ++ui;
        if constexpr (ALIGN_EPI) { if (wr == 1) PG8_BAR; }
    }
    PG8_WAIT_V(0);
    if constexpr (!ALIGN_EPI) { if (wr == 0) PG8_BAR; }
    PG8_BAR;
    if constexpr (Epi::AFTER_DRAIN) { E.fused(acc, cur, wr, wc, fr, fq, lds, wid, lane); S.done(cur); }
#undef PG8_SA
#undef PG8_SB
#undef PG8_STAGE
#undef PG8_LDA
#undef PG8_LDB
#undef PG8_MMA
#undef PG8_WAIT_V
#undef PG8_WAIT_L
#undef PG8_BAR
#undef PG8_SCHED
}
}

#ifndef PG8_SP2
#define PG8_SP2 true
#endif
#ifndef PG8_ALIGN
#define PG8_ALIGN true
#endif
constexpr int NWAVES = 8;
constexpr int NBATCH = 2, SEQ = 8192, DM = 1024, M = NBATCH * SEQ;
constexpr int INW = 2560, ZW = 2048;
constexpr int LRUW = 512, ATTW = 512, NCHUNK = SEQ / 64;
constexpr int NEXP = 16384, PEER_H = 8, NSEL = 128;
constexpr float EPS = 1e-6f;
constexpr float LOG2E = 1.4426950408889634f;

constexpr size_t MiB = 1u << 20;
constexpr size_t WS_CTL = 0, CTL_ZERO_BYTES = 1 * MiB;
constexpr size_t WS_WIN = 1 * MiB, WS_WOUT = 6 * MiB, WS_WQ = 8 * MiB, WS_WKV = 10 * MiB, WS_WO = 14 * MiB, WS_WQRY = 16 * MiB;
constexpr size_t WS_SUBK = 20 * MiB, WS_GATEW = 20 * MiB + 512 * 1024, WS_MEMN = 21 * MiB, WS_KM = 22 * MiB, WS_VMT = 23 * MiB, WS_AGG = 24 * MiB, WS_SSQ1 = 25 * MiB, WS_SSQ2 = 26 * MiB;
constexpr size_t WS_EU = 28 * MiB, WS_EV = 60 * MiB, WS_XN = 92 * MiB, WS_Z = 124 * MiB, WS_VT = 188 * MiB, WS_Y = 204 * MiB, WS_END = 236 * MiB;
constexpr size_t WS_QC = WS_Z, WS_OC = WS_Z + 32 * MiB, WS_QP = WS_Z, WS_IDX = WS_VT, WS_G = WS_VT + 8 * MiB;
constexpr int CW_BAR = 4096;

constexpr int RING_BYTES = 135168;
constexpr int LDSCTL_OFF = RING_BYTES, MISC_OFF = LDSCTL_OFF + 320;
constexpr int LDS_BYTES = 147456;

#define GAS __attribute__((address_space(1)))
#define LAS __attribute__((address_space(3)))
typedef unsigned short bf16;
typedef unsigned v4u __attribute__((ext_vector_type(4)));
typedef unsigned v2u __attribute__((ext_vector_type(2)));
typedef float f32x4 __attribute__((ext_vector_type(4)));
typedef float f32x2 __attribute__((ext_vector_type(2)));
typedef float f32x16 __attribute__((ext_vector_type(16)));
typedef short bf16x8 __attribute__((ext_vector_type(8)));
typedef __bf16 bf16x2_t __attribute__((ext_vector_type(2)));
typedef GAS unsigned gu32;
#define RLX_AGENT __ATOMIC_RELAXED, __HIP_MEMORY_SCOPE_AGENT
#define LDS_WAIT() asm volatile("s_waitcnt lgkmcnt(0)" ::: "memory")
#define VM_WAIT() asm volatile("s_waitcnt vmcnt(0)" ::: "memory")
#define MFMA32(a, b, c) __builtin_amdgcn_mfma_f32_32x32x16_bf16((a), (b), (c), 0, 0, 0)
#define DI __device__ __forceinline__

DI unsigned pk2(float lo, float hi) { f32x2 v = {lo, hi}; bf16x2_t b = __builtin_convertvector(v, bf16x2_t); return __builtin_bit_cast(unsigned, b); }
DI bf16 f2bf(float x) { return (bf16)(pk2(x, 0.f) & 0xffffu); }
DI float bf2f(bf16 x) { return __uint_as_float((unsigned)x << 16); }
DI float bflo(unsigned p) { return __uint_as_float(p << 16); }
DI float bfhi(unsigned p) { return __uint_as_float(p & 0xffff0000u); }
DI int crow(int reg, int hh) { return (reg & 3) + 8 * (reg >> 2) + 4 * hh; }
DI float swap32_partner(float x, int hh) { auto rr = __builtin_amdgcn_permlane32_swap(__float_as_uint(x), __float_as_uint(x), false, false); return __uint_as_float(hh ? rr[0] : rr[1]); }
DI float dpp_xor1(float x) { return __int_as_float(__builtin_amdgcn_update_dpp(0, __float_as_int(x), 0xB1, 0xf, 0xf, true)); }
DI float dpp_xor2(float x) { return __int_as_float(__builtin_amdgcn_update_dpp(0, __float_as_int(x), 0x4E, 0xf, 0xf, true)); }
DI float dpp_hmir(float x) { return __int_as_float(__builtin_amdgcn_update_dpp(0, __float_as_int(x), 0x141, 0xf, 0xf, true)); }
DI float dpp_mir(float x)  { return __int_as_float(__builtin_amdgcn_update_dpp(0, __float_as_int(x), 0x140, 0xf, 0xf, true)); }
DI float sum16(float x) { x += dpp_xor1(x); x += dpp_xor2(x); x += dpp_hmir(x); x += dpp_mir(x); return x; }
DI float sum32(float x) { x = sum16(x); auto rr = __builtin_amdgcn_permlane16_swap(__float_as_uint(x), __float_as_uint(x), false, false); return __uint_as_float(rr[0]) + __uint_as_float(rr[1]); }
DI float sum64(float x) { x = sum32(x); auto rr = __builtin_amdgcn_permlane32_swap(__float_as_uint(x), __float_as_uint(x), false, false); return __uint_as_float(rr[0]) + __uint_as_float(rr[1]); }
DI float rcp_(float x) { return __builtin_amdgcn_rcpf(x); }
DI float rsq_(float x) { return __builtin_amdgcn_rsqf(x); }
DI float exp2_(float x) { return __builtin_amdgcn_exp2f(x); }
DI float gelu_tanh(float x) { const float u = x * (1.5957691216057308f + 0.07135481627159768f * x * x); return x * rcp_(1.0f + exp2_(-LOG2E * u)); }
DI float sigmoidf_(float x) { return rcp_(1.0f + exp2_(-LOG2E * x)); }
#define XB_TMO      128
#define XB_XCNT(j)  (256  + 64 * (j))
#define XB_XSUB(j)  (1280 + 64 * (j))
#define XB_XGEN(j)  (2304 + 64 * (j))
#define XB_TOP      3328
#define XB_TOPGEN   3392
#define XCD_BAR_WORDS 3456
#define XB_SPIN_CAP (1u << 18)

__device__ __forceinline__ unsigned xb_ld(unsigned* p)              { return __hip_atomic_load(p, __ATOMIC_RELAXED, __HIP_MEMORY_SCOPE_AGENT); }
__device__ __forceinline__ unsigned xb_add(unsigned* p, unsigned v) { return __hip_atomic_fetch_add(p, v, __ATOMIC_RELAXED, __HIP_MEMORY_SCOPE_AGENT); }
__device__ __forceinline__ unsigned xb_xcc_id() { return (unsigned)__builtin_amdgcn_s_getreg((3 << 11) | 20) & 0xFu; }
#define XB_SPIN(cond, bar) do { unsigned _sp = 0; while (cond) { __builtin_amdgcn_s_sleep(1); \
    if ((++_sp & 255u) == 0u) { if (xb_ld(&(bar)[XB_TMO])) break; if (_sp > XB_SPIN_CAP) { atomicAdd(&(bar)[XB_TMO], 1u); break; } } } } while (0)

struct XcdBarrier {
    unsigned* bar; unsigned x;
    volatile LAS unsigned* st;
};

__device__ __forceinline__ XcdBarrier xcd_barrier_post(unsigned* bar, volatile LAS unsigned* st) {
    XcdBarrier b; b.bar = bar; b.x = xb_xcc_id(); b.st = st;
    if (threadIdx.x == 0) (void)xb_add(&bar[XB_XCNT(b.x)], 1u);
    return b;
}
__device__ __forceinline__ void xcd_barrier_complete(unsigned* bar, unsigned x, unsigned& nloc, unsigned& nx) {
    const unsigned G = gridDim.x * gridDim.y * gridDim.z;
    unsigned sum, cnt, mine, sp = 0u;
    for (;;) {
        sum = 0u; cnt = 0u; mine = 0u;
#pragma unroll
        for (unsigned j = 0; j < 16; ++j) { const unsigned c = xb_ld(&bar[XB_XCNT(j)]); sum += c; cnt += (c > 0u) ? 1u : 0u; mine = (j == x) ? c : mine; }
        if (sum == G) break;
        __builtin_amdgcn_s_sleep(1);
        if ((++sp & 255u) == 0u) { if (xb_ld(&bar[XB_TMO])) break; if (sp > XB_SPIN_CAP) { atomicAdd(&bar[XB_TMO], 1u); break; } }
    }
    nloc = mine > 0u ? mine : 1u; nx = cnt > 0u ? cnt : 1u;
}

__device__ __forceinline__ void xcd_barrier(const XcdBarrier& b) {
    asm volatile("s_waitcnt vmcnt(0)" ::: "memory");
    __syncthreads();
    if (threadIdx.x == 0) {
        unsigned* bar = b.bar;
        __builtin_amdgcn_s_waitcnt(0);
        unsigned nloc = b.st[0], nx = b.st[1];
        if (nloc == 0u) { xcd_barrier_complete(bar, b.x, nloc, nx); b.st[0] = nloc; b.st[1] = nx; }
        const unsigned old = xb_add(&bar[XB_XSUB(b.x)], 1u);
        const unsigned gen = old / nloc;
        if (old + 1u == (gen + 1u) * nloc) {
            __builtin_amdgcn_fence(__ATOMIC_RELEASE, "agent");
            asm volatile("s_waitcnt vmcnt(0)" ::: "memory");
            const unsigned og = xb_add(&bar[XB_TOP], 1u);
            const unsigned tg = og / nx;
            if (og + 1u == (tg + 1u) * nx) xb_add(&bar[XB_TOPGEN], 1u);
            else XB_SPIN(xb_ld(&bar[XB_TOPGEN]) == tg, bar);
            __builtin_amdgcn_fence(__ATOMIC_ACQUIRE, "agent");
            xb_add(&bar[XB_XGEN(b.x)], 1u);
            asm volatile("s_waitcnt vmcnt(0)" ::: "memory");
        } else {
            XB_SPIN(xb_ld(&bar[XB_XGEN(b.x)]) == gen, bar);
            __builtin_amdgcn_fence(__ATOMIC_ACQUIRE, "agent");
            asm volatile("s_waitcnt vmcnt(0)" ::: "memory");
        }
    }
    __syncthreads();
}
struct Args { const float* in[26]; float* out; unsigned char* ws; int ph_lo, ph_hi, li, pad; };
struct Frame {
    LAS unsigned char* lds;
    volatile LAS unsigned* MISC;
    gu32* ctl;
    int tid, lane, wave, vcu, G;
    const Args* A; float* out; unsigned char* ws;
    DI const float* in(int k) const { return A->in[k]; }
    template <class T> DI T* wsp(size_t off) const { return (T*)(ws + off); }
};

DI void p0_transpose_item(const float* W, int K, int N, bf16* WT, LAS float* scr, int item, int lane, const float* g0, const float* g1, int gsplit) {
    const int nblk = N / 32, kb = item / nblk, nb = item % nblk, k0 = 64 * kb, n0 = 32 * nb;
#pragma unroll 8
    for (int i = 0; i < 32; ++i) { const int kk = 2 * i + (lane >> 5); const int k = k0 + kk;
        float g = 1.f; if (g0) g = (k < gsplit) ? g0[k] : g1[k - gsplit];
        scr[kk * 33 + (lane & 31)] = W[(size_t)k * N + n0 + (lane & 31)] * g; }
    LDS_WAIT(); asm volatile("" ::: "memory");
    const int c = lane & 7;
#pragma unroll
    for (int j = 0; j < 4; ++j) { const int n = (lane >> 3) + 8 * j; const LAS float* s = scr + (8 * c) * 33 + n;
        v4u o; o.x = pk2(s[0 * 33], s[1 * 33]); o.y = pk2(s[2 * 33], s[3 * 33]); o.z = pk2(s[4 * 33], s[5 * 33]); o.w = pk2(s[6 * 33], s[7 * 33]);
        *(GAS v4u*)(WT + (size_t)(n0 + n) * K + k0 + 8 * c) = o; }
    LDS_WAIT(); asm volatile("" ::: "memory");
}
template <bool NORM> DI void row_to_bf16(const float* xrow, bf16* orow, const float* gain, int lane) {
    const GAS f32x4* xr = (const GAS f32x4*)xrow + lane;
    f32x4 v[4]; float s = 0.f;
#pragma unroll
    for (int j = 0; j < 4; ++j) { v[j] = xr[64 * j]; s += (v[j].x * v[j].x + v[j].y * v[j].y) + (v[j].z * v[j].z + v[j].w * v[j].w); }
    float rstd = 1.f;
    if (NORM) rstd = 1.0f / sqrtf(sum64(s) * (1.f / 1024.f) + EPS);
    GAS v2u* o8 = (GAS v2u*)orow + lane;
#pragma unroll
    for (int j = 0; j < 4; ++j) { f32x4 w = v[j] * rstd; if (gain) w = w * ((const GAS f32x4*)gain)[64 * j + lane];
        v2u o; o.x = pk2(w.x, w.y); o.y = pk2(w.z, w.w); o8[64 * j] = o; }
}
constexpr float U_SCALE = 128.f, V_SCALE = 16.f;
DI void row_to_fp8(const float* src, unsigned char* dst, const float* gain, float scale, int lane) {
#pragma unroll
    for (int j = 0; j < 4; ++j) { f32x4 v = ((const GAS f32x4*)src)[64 * j + lane] * scale; if (gain) v = v * ((const GAS f32x4*)gain)[64 * j + lane];
        unsigned w = 0u; w = __builtin_amdgcn_cvt_pk_fp8_f32(v.x, v.y, w, false); w = __builtin_amdgcn_cvt_pk_fp8_f32(v.z, v.w, w, true);
        ((GAS unsigned*)dst)[64 * j + lane] = w; }
}
DI void p0_prologue(Frame& F) {
    LAS float* scr = (LAS float*)(F.lds + F.wave * 16384);
    const int gw = F.vcu * NWAVES + F.wave, NGW = F.G * NWAVES, lane = F.lane;
    constexpr int I_IN = 16 * (INW / 32), I_D = 16 * (DM / 32), I_2D = 16 * (2 * DM / 32);
    constexpr int NITEMS = I_IN + 3 * I_D + 2 * I_2D;
    for (int it = gw; it < NITEMS; it += NGW) {
        int r = it;
        if (r < I_IN) { p0_transpose_item(F.in(3), DM, INW, F.wsp<bf16>(WS_WIN), scr, r, lane, F.in(2), F.in(2), DM); continue; } r -= I_IN;
        if (r < I_D) { p0_transpose_item(F.in(14), DM, DM, F.wsp<bf16>(WS_WOUT), scr, r, lane, F.in(12), F.in(13), LRUW); continue; } r -= I_D;
        if (r < I_D) { p0_transpose_item(F.in(17), DM, DM, F.wsp<bf16>(WS_WQ), scr, r, lane, F.in(15), F.in(15), DM); continue; } r -= I_D;
        if (r < I_2D) { p0_transpose_item(F.in(18), DM, 2 * DM, F.wsp<bf16>(WS_WKV), scr, r, lane, nullptr, nullptr, 0); continue; } r -= I_2D;
        if (r < I_D) { p0_transpose_item(F.in(19), DM, DM, F.wsp<bf16>(WS_WO), scr, r, lane, nullptr, nullptr, 0); continue; } r -= I_D;
        p0_transpose_item(F.in(21), DM, 2 * DM, F.wsp<bf16>(WS_WQRY), scr, r, lane, F.in(20), F.in(20), DM);
    }
    for (int m = gw; m < M; m += NGW) row_to_bf16<true>(F.in(0) + (size_t)m * DM, F.wsp<bf16>(WS_XN) + (size_t)m * DM, nullptr, lane);
    for (int m = gw; m < NBATCH * 256; m += NGW) row_to_bf16<true>(F.in(1) + (size_t)m * DM, F.wsp<bf16>(WS_MEMN) + (size_t)m * DM, F.in(16), lane);
    for (int m = gw; m < NEXP; m += NGW) { row_to_fp8(F.in(23) + (size_t)m * DM, F.wsp<unsigned char>(WS_EU) + (size_t)m * DM, F.in(20), U_SCALE, lane);
                                            row_to_fp8(F.in(24) + (size_t)m * DM, F.wsp<unsigned char>(WS_EV) + (size_t)m * DM, nullptr, V_SCALE, lane); }
    { const int gt = gw * 64 + lane, NT = NGW * 64;
      for (int i = gt; i < 8 * 2 * 128 * 128 / 4; i += NT) { const f32x4 v = ((const GAS f32x4*)F.in(22))[i]; v2u o; o.x = pk2(v.x, v.y); o.y = pk2(v.z, v.w); ((GAS v2u*)F.wsp<bf16>(WS_SUBK))[i] = o; }
      for (int o = gt; o < 2 * 8 * 64 * 64; o += NT) { const int i = o & 63, j = (o >> 6) & 63, h = (o >> 12) & 7, g = o >> 15;
          const float* W = g ? F.in(8) : F.in(6); F.wsp<bf16>(WS_GATEW)[o] = f2bf(W[(h * 64 + i) * 64 + j]); } }
}
struct LruState { float ba[2], bx[2], sp[2], S[2], Ap[2]; };
template <bool PASS2>
DI void lru_prep(const Frame& F, int b, int chunk, int h, int lane, LAS unsigned char* xcs  , LruState& st) {
    const int r = lane & 31, hh = lane >> 5;
    const size_t row0 = (size_t)b * SEQ + (size_t)chunk * 64;
    {
        const int c2 = h * 64 + 2 * r;
        const f32x2 w0 = *(const f32x2*)(F.in(4) + c2), w1 = *(const f32x2*)(F.in(4) + LRUW + c2), w2 = *(const f32x2*)(F.in(4) + 2 * LRUW + c2), w3 = *(const f32x2*)(F.in(4) + 3 * LRUW + c2);
        const f32x2 cb = *(const f32x2*)(F.in(5) + c2);
        const int tl0 = 32 * hh;
        const bf16* zp = F.wsp<bf16>(WS_Z) + (row0 + tl0) * ZW + c2;
        const bool first = (chunk == 0 && hh == 0);
        unsigned p0 = first ? 0u : *(const unsigned*)(zp - 3 * ZW), p1 = first ? 0u : *(const unsigned*)(zp - 2 * ZW), p2 = first ? 0u : *(const unsigned*)(zp - ZW);
#pragma unroll 8
        for (int t = 0; t < 32; ++t) { const unsigned p3 = *(const unsigned*)(zp + (size_t)t * ZW);
            const float lo = cb.x + bflo(p0) * w0.x + bflo(p1) * w1.x + bflo(p2) * w2.x + bflo(p3) * w3.x;
            const float hi = cb.y + bfhi(p0) * w0.y + bfhi(p1) * w1.y + bfhi(p2) * w2.y + bfhi(p3) * w3.y;
            *(LAS unsigned*)(xcs + (tl0 + t) * 144 + 4 * r) = pk2(lo, hi);
            p0 = p1; p1 = p2; p2 = p3; }
        LDS_WAIT();
    }
#pragma unroll
    for (int nt = 0; nt < 2; ++nt) { const int c = h * 64 + 32 * nt + r; st.ba[nt] = F.in(7)[c]; st.bx[nt] = F.in(9)[c];
        const float nl = -F.in(10)[c]; st.sp[nt] = fmaxf(nl, 0.f) + log1pf(__expf(-fabsf(nl))); st.S[nt] = 0.f; st.Ap[nt] = 1.f; }
    if (PASS2) {
        float s = 0.f; const float* ag = F.wsp<float>(WS_AGG) + ((size_t)b * NCHUNK * LRUW + h * 64 + lane) * 2;
#pragma unroll 8
        for (int c = 0; c < chunk; ++c) { const f32x2 ab = *(const f32x2*)(ag + (size_t)c * LRUW * 2); s = ab.x * s + ab.y; }
        st.S[0] = __shfl(s, r); st.S[1] = __shfl(s, 32 + r);
    }
}
template <bool PASS2>
DI void lru_tile(const Frame& F, int b, int chunk, int mt, int h, int lane, LAS unsigned char* xcs, LAS unsigned char* gim  , LruState& st, float (&ssq)[16]) {
    const int r = lane & 31, hh = lane >> 5;
    const size_t row0 = (size_t)b * SEQ + (size_t)chunk * 64;
    const bf16* gw = F.wsp<bf16>(WS_GATEW) + (size_t)h * 4096;
    bf16x8 af[4];
#pragma unroll
    for (int s = 0; s < 4; ++s) af[s] = *(const LAS bf16x8*)(xcs + (32 * mt + r) * 144 + (16 * s + 8 * hh) * 2);
    float ssl[16];
#pragma unroll
    for (int i = 0; i < 16; ++i) ssl[i] = 0.f;
    if (PASS2) {
#pragma unroll
        for (int i = 0; i < 4; ++i) { const int row = (lane >> 3) + 8 * i, c = lane & 7;
            *(LAS v4u*)(gim + row * 144 + c * 16) = *(const v4u*)(F.wsp<bf16>(WS_Z) + (row0 + 32 * mt + row) * ZW + LRUW + h * 64 + 8 * c); }
        LDS_WAIT();
    }
#pragma unroll
    for (int nt = 0; nt < 2; ++nt) {
        asm volatile("" ::: "memory");
        f32x16 aa = {}, ax = {};
#pragma unroll
        for (int s = 0; s < 4; ++s) {
            const bf16x8 wa = *(const bf16x8*)(gw + (size_t)(32 * nt + r) * 64 + 16 * s + 8 * hh);
            const bf16x8 wx = *(const bf16x8*)(gw + 32768 + (size_t)(32 * nt + r) * 64 + 16 * s + 8 * hh);
            aa = MFMA32(af[s], wa, aa); ax = MFMA32(af[s], wx, ax);
        }
        float gt[16];
        if (PASS2) {
#pragma unroll
            for (int i = 0; i < 16; ++i) gt[i] = bf2f(*(const LAS bf16*)(gim + crow(i, hh) * 144 + (32 * nt + r) * 2));
        }
#pragma unroll
        for (int i = 0; i < 16; ++i) {
            const float rg = sigmoidf_(aa[i] + st.ba[nt]), ig = sigmoidf_(ax[i] + st.bx[nt]);
            const float la = -8.0f * rg * st.sp[nt];
            const float a = exp2_(LOG2E * la);
            const float mult = __builtin_amdgcn_sqrtf(fmaxf(1.0f - a * a, 0.f));
            const float xc = bf2f(*(const LAS bf16*)(xcs + (32 * mt + crow(i, hh)) * 144 + (32 * nt + r) * 2));
            aa[i] = a; ax[i] = mult * ig * xc;
        }
        float Ao[4], Bo[4], Aq[4], Bq[4], Sin[4];
#pragma unroll
        for (int q = 0; q < 4; ++q) { const float a0 = aa[4 * q], a1 = aa[4 * q + 1], a2 = aa[4 * q + 2], a3 = aa[4 * q + 3];
            Ao[q] = (a0 * a1) * (a2 * a3); Bo[q] = ((ax[4 * q] * a1 + ax[4 * q + 1]) * a2 + ax[4 * q + 2]) * a3 + ax[4 * q + 3];
            Aq[q] = swap32_partner(Ao[q], hh); Bq[q] = swap32_partner(Bo[q], hh); }
        float s_ = st.S[nt];
#pragma unroll
        for (int q = 0; q < 4; ++q) { const float A1 = hh ? Aq[q] : Ao[q], B1 = hh ? Bq[q] : Bo[q], A2 = hh ? Ao[q] : Aq[q], B2 = hh ? Bo[q] : Bq[q];
            const float smid = A1 * s_ + B1; Sin[q] = hh ? smid : s_; s_ = A2 * smid + B2; st.Ap[nt] *= A1 * A2; }
        st.S[nt] = s_;
        if (PASS2) {
#pragma unroll
            for (int q = 0; q < 4; ++q) { float hp = Sin[q];
#pragma unroll
                for (int e = 0; e < 4; ++e) { const int i = 4 * q + e; hp = aa[i] * hp + ax[i];
                    const float y = hp * gelu_tanh(gt[i]); ssl[i] += y * y;
                    *(LAS bf16*)(xcs + (32 * mt + crow(i, hh)) * 144 + (32 * nt + r) * 2) = f2bf(y); } }
        }
    }
    if (PASS2) {
#pragma unroll
        for (int i = 0; i < 16; ++i) ssq[i] = sum32(ssl[i]);
    }
}
DI void attn_wave(const Frame& F, int b, int n, int qt, int h, int lane, const LAS float* tab, f32x16 (&o)[2]) {
    const int r = lane & 31, hh = lane >> 5;
    const size_t row0 = (size_t)b * SEQ + (size_t)n * 64;
    const float SC = 0.125f * LOG2E;
    bf16x8 qf[4];
#pragma unroll
    for (int s = 0; s < 4; ++s) qf[s] = *(const bf16x8*)(F.wsp<bf16>(WS_Z) + (row0 + 32 * qt + r) * ZW + 2 * LRUW + h * 64 + 16 * s + 8 * hh);
    float mrun = -1e30f, lrun = 0.f;
#pragma unroll
    for (int dt = 0; dt < 2; ++dt) o[dt] = f32x16{};
    const float bfar = tab[256];
    const bf16* vtb = F.wsp<bf16>(WS_VT) + ((size_t)(b * 8 + h) * 64 + r) * SEQ + 4 * hh;
    for (int kc = (n >= 8 ? n - 8 : 0); kc <= n; ++kc) {
        const size_t krow0 = (size_t)b * SEQ + (size_t)kc * 64;
        const int dd = n - kc;
        bf16x8 kf[2][4];
#pragma unroll
        for (int kt = 0; kt < 2; ++kt)
#pragma unroll
            for (int s = 0; s < 4; ++s) kf[kt][s] = *(const bf16x8*)(F.wsp<bf16>(WS_Z) + (krow0 + 32 * kt + r) * ZW + 2 * LRUW + ATTW + h * 64 + 16 * s + 8 * hh);
        bf16x8 vf[2][2][2];
#pragma unroll
        for (int dt = 0; dt < 2; ++dt)
#pragma unroll
            for (int kt = 0; kt < 2; ++kt)
#pragma unroll
                for (int s2 = 0; s2 < 2; ++s2) { const bf16* p = vtb + (size_t)(32 * dt) * SEQ + kc * 64 + 32 * kt + 16 * s2;
                    const v2u lo = *(const v2u*)p, hi = *(const v2u*)(p + 8); v4u w; w.x = lo.x; w.y = lo.y; w.z = hi.x; w.w = hi.y; vf[dt][kt][s2] = __builtin_bit_cast(bf16x8, w); }
        f32x16 sc[2];
#pragma unroll
        for (int kt = 0; kt < 2; ++kt) { sc[kt] = f32x16{};
#pragma unroll
            for (int s = 0; s < 4; ++s) sc[kt] = MFMA32(kf[kt][s], qf[s], sc[kt]); }
        if (dd >= 3) {
#pragma unroll
            for (int kt = 0; kt < 2; ++kt)
#pragma unroll
                for (int i = 0; i < 16; ++i) sc[kt][i] = sc[kt][i] * SC + bfar;
        } else {
            const int base = 64 * dd + 32 * qt + r + 128;
#pragma unroll
            for (int kt = 0; kt < 2; ++kt)
#pragma unroll
                for (int i = 0; i < 16; ++i) { int idx = base - (32 * kt + crow(i, hh)); idx = idx > 256 ? 256 : idx; sc[kt][i] = sc[kt][i] * SC + tab[idx]; }
        }
        float mx = sc[0][0];
#pragma unroll
        for (int kt = 0; kt < 2; ++kt)
#pragma unroll
            for (int i = 0; i < 16; ++i) mx = fmaxf(mx, sc[kt][i]);
        mx = fmaxf(mx, swap32_partner(mx, hh));
        const float mnew = fmaxf(mrun, mx), alpha = exp2_(mrun - mnew);
        float ls = 0.f;
#pragma unroll
        for (int kt = 0; kt < 2; ++kt)
#pragma unroll
            for (int i = 0; i < 16; ++i) { const float p = exp2_(sc[kt][i] - mnew); sc[kt][i] = p; ls += p; }
        lrun = lrun * alpha + ls; mrun = mnew;
#pragma unroll
        for (int dt = 0; dt < 2; ++dt)
#pragma unroll
            for (int i = 0; i < 16; ++i) o[dt][i] *= alpha;
#pragma unroll
        for (int kt = 0; kt < 2; ++kt)
#pragma unroll
            for (int s2 = 0; s2 < 2; ++s2) { v4u w; w.x = pk2(sc[kt][8 * s2], sc[kt][8 * s2 + 1]); w.y = pk2(sc[kt][8 * s2 + 2], sc[kt][8 * s2 + 3]); w.z = pk2(sc[kt][8 * s2 + 4], sc[kt][8 * s2 + 5]); w.w = pk2(sc[kt][8 * s2 + 6], sc[kt][8 * s2 + 7]);
                const bf16x8 pf = __builtin_bit_cast(bf16x8, w);
#pragma unroll
                for (int dt = 0; dt < 2; ++dt) o[dt] = MFMA32(vf[dt][kt][s2], pf, o[dt]); }
    }
    const float lt = lrun + swap32_partner(lrun, hh); const float inv = rcp_(lt);
#pragma unroll
    for (int dt = 0; dt < 2; ++dt)
#pragma unroll
        for (int i = 0; i < 16; ++i) o[dt][i] *= inv;
}

DI void p2_lru_aggregates(Frame& F) {
    const int lane = F.lane, r = lane & 31, hh = lane >> 5, h = F.wave;
    LAS unsigned char* xcs = F.lds + 20480 + h * 13824;
    for (int u = F.vcu; u < NBATCH * NCHUNK; u += F.G) {
        const int b = u / NCHUNK, n = u % NCHUNK;
        LruState st; float ssq[16];
        lru_prep<false>(F, b, n, h, lane, xcs, st);
#pragma unroll 1
        for (int mt = 0; mt < 2; ++mt) lru_tile<false>(F, b, n, mt, h, lane, xcs, xcs + 9216, st, ssq);
        if (hh == 0) {
#pragma unroll
            for (int nt = 0; nt < 2; ++nt) *(f32x2*)(F.wsp<float>(WS_AGG) + (((size_t)b * NCHUNK + n) * LRUW + h * 64 + 32 * nt + r) * 2) = (f32x2){st.Ap[nt], st.S[nt]};
        }
        LDS_WAIT();
    }
}
DI void p3_mixer(Frame& F) {
    const int lane = F.lane, r = lane & 31, hh = lane >> 5, h = F.wave;
    LAS float* ssx = (LAS float*)(F.lds);
    LAS float* tab = (LAS float*)(F.lds + 4096 + h * 2048);
    LAS unsigned* stg = (LAS unsigned*)(F.lds + 20480 + h * 13824);
    for (int i = lane; i < 257; i += 64) tab[i] = F.in(11)[h * 257 + i] * LOG2E;
    LDS_WAIT();
    for (int u = F.vcu; u < NBATCH * NCHUNK; u += F.G) {
        const int b = u / NCHUNK, n = u % NCHUNK; const size_t row0 = (size_t)b * SEQ + (size_t)n * 64;
#ifndef MIX_PARTS
#define MIX_PARTS 3
#endif
        if (MIX_PARTS & 1) {
            LruState st;
            lru_prep<true>(F, b, n, h, lane, (LAS unsigned char*)stg, st);
#pragma unroll 1
            for (int mt = 0; mt < 2; ++mt) {
                float ssq[16];
                lru_tile<true>(F, b, n, mt, h, lane, (LAS unsigned char*)stg, (LAS unsigned char*)stg + 9216, st, ssq);
                if (r == 0) {
#pragma unroll
                    for (int i = 0; i < 16; ++i) ssx[crow(i, hh) * 8 + h] = ssq[i];
                }
                __syncthreads();
                const LAS unsigned char* yst = (const LAS unsigned char*)stg + 32 * mt * 144;
#pragma unroll
                for (int i = 0; i < 4; ++i) { const int row = (lane >> 3) + 8 * i, c = lane & 7;
                    const f32x4 s0 = *(const LAS f32x4*)(ssx + row * 8), s1 = *(const LAS f32x4*)(ssx + row * 8 + 4);
                    const float rs = rsq_(((s0.x + s0.y) + (s0.z + s0.w) + (s1.x + s1.y) + (s1.z + s1.w)) * (1.f / 512.f) + EPS);
                    const v4u v = *(const LAS v4u*)(yst + row * 144 + c * 16);
                    v4u o; o.x = pk2(bflo(v.x) * rs, bfhi(v.x) * rs); o.y = pk2(bflo(v.y) * rs, bfhi(v.y) * rs); o.z = pk2(bflo(v.z) * rs, bfhi(v.z) * rs); o.w = pk2(bflo(v.w) * rs, bfhi(v.w) * rs);
                    *(v4u*)(F.wsp<bf16>(WS_Y) + (row0 + 32 * mt + row) * DM + h * 64 + 8 * c) = o; }
                __syncthreads();
            }
        }
    }
    for (int u = F.vcu; u < NBATCH * NCHUNK; u += F.G) {
        const int b = u / NCHUNK, n = u % NCHUNK; const size_t row0 = (size_t)b * SEQ + (size_t)n * 64;
#pragma unroll 1
        for (int qt = 0; qt < ((MIX_PARTS & 2) ? 2 : 0); ++qt) {
            f32x16 o[2];
            attn_wave(F, b, n, qt, h, lane, tab, o);
            float s = 0.f;
#pragma unroll
            for (int dt = 0; dt < 2; ++dt)
#pragma unroll
                for (int i = 0; i < 16; ++i) s += o[dt][i] * o[dt][i];
            s += swap32_partner(s, hh);
            if (hh == 0) ssx[r * 8 + h] = s;
            __syncthreads();
            { const f32x4 s0 = *(const LAS f32x4*)(ssx + r * 8), s1 = *(const LAS f32x4*)(ssx + r * 8 + 4);
              const float rs = rsq_(((s0.x + s0.y) + (s0.z + s0.w) + (s1.x + s1.y) + (s1.z + s1.w)) * (1.f / 512.f) + EPS);
#pragma unroll
              for (int dt = 0; dt < 2; ++dt)
#pragma unroll
                  for (int i = 0; i < 16; i += 2) stg[r * 33 + ((32 * dt + crow(i, hh)) >> 1)] = pk2(o[dt][i] * rs, o[dt][i + 1] * rs); }
            LDS_WAIT();
#pragma unroll 4
            for (int i = 0; i < 16; ++i) { const int row = 2 * i + hh; const unsigned v = stg[row * 33 + r];
                *(GAS unsigned*)(F.wsp<bf16>(WS_Y) + (row0 + 32 * qt + row) * DM + LRUW + h * 64 + 2 * r) = v; }
            __syncthreads();
        }
    }
}
DI void p5_cross(Frame& F) {
    const int lane = F.lane, r = lane & 31, hh = lane >> 5, w = F.wave, tid = F.tid;
    constexpr int KST = 528, VST = 520;
    const float SC = 0.0625f * LOG2E;
    for (int u = F.vcu; u < NBATCH * 4 * 32; u += F.G) {
        const int b = u >> 7, hm = (u >> 5) & 3, qb = u & 31;
        const size_t qrow = (size_t)b * SEQ + (size_t)qb * 256 + 32 * w + r;
        { const bf16* src = F.wsp<bf16>(WS_KM) + (size_t)(b * 256) * DM + hm * 256;
#pragma unroll 4
          for (int i = 0; i < 16; ++i) { const int c = i * 512 + tid, row = c >> 5, ch = c & 31;
              *(LAS v4u*)(F.lds + row * KST + ch * 16) = *(const v4u*)(src + (size_t)row * DM + ch * 8); } }
        __syncthreads();
        f32x16 sc[8];
#pragma unroll
        for (int kt = 0; kt < 8; ++kt) sc[kt] = f32x16{};
#pragma unroll 2
        for (int s = 0; s < 16; ++s) {
            const bf16x8 qf = *(const bf16x8*)(F.wsp<bf16>(WS_QC) + qrow * DM + hm * 256 + 16 * s + 8 * hh);
#pragma unroll
            for (int kt = 0; kt < 8; ++kt) { const bf16x8 kf = *(const LAS bf16x8*)(F.lds + (32 * kt + r) * KST + (16 * s + 8 * hh) * 2); sc[kt] = MFMA32(kf, qf, sc[kt]); }
        }
        float mx = sc[0][0];
#pragma unroll
        for (int kt = 0; kt < 8; ++kt)
#pragma unroll
            for (int i = 0; i < 16; ++i) mx = fmaxf(mx, sc[kt][i]);
        mx = fmaxf(mx, swap32_partner(mx, hh));
        float ls = 0.f; const float mo = mx * SC;
        bf16x8 pf[8][2];
#pragma unroll
        for (int kt = 0; kt < 8; ++kt) {
#pragma unroll
            for (int i = 0; i < 16; ++i) { const float p = exp2_(sc[kt][i] * SC - mo); sc[kt][i] = p; ls += p; }
#pragma unroll
            for (int s2 = 0; s2 < 2; ++s2) { v4u wv; wv.x = pk2(sc[kt][8 * s2], sc[kt][8 * s2 + 1]); wv.y = pk2(sc[kt][8 * s2 + 2], sc[kt][8 * s2 + 3]); wv.z = pk2(sc[kt][8 * s2 + 4], sc[kt][8 * s2 + 5]); wv.w = pk2(sc[kt][8 * s2 + 6], sc[kt][8 * s2 + 7]);
                pf[kt][s2] = __builtin_bit_cast(bf16x8, wv); }
        }
        ls += swap32_partner(ls, hh);
        const float inv = 1.0f / ls;
        __syncthreads();
        { const bf16* src = F.wsp<bf16>(WS_VMT) + (size_t)((b * 4 + hm) * 256) * 256;
#pragma unroll 4
          for (int i = 0; i < 16; ++i) { const int c = i * 512 + tid, row = c >> 5, ch = c & 31; const v4u v = *(const v4u*)(src + (size_t)row * 256 + ch * 8);
              LAS v2u* d = (LAS v2u*)(F.lds + row * VST + ch * 16); d[0] = (v2u){v.x, v.y}; d[1] = (v2u){v.z, v.w}; } }
        __syncthreads();
        LAS unsigned* stg = (LAS unsigned*)(F.lds) ;
#pragma unroll
        for (int half = 0; half < 2; ++half) {
            f32x16 o[4];
#pragma unroll
            for (int dt = 0; dt < 4; ++dt) o[dt] = f32x16{};
#pragma unroll
            for (int kt = 0; kt < 8; ++kt)
#pragma unroll
                for (int s2 = 0; s2 < 2; ++s2)
#pragma unroll
                    for (int dt = 0; dt < 4; ++dt) { const LAS unsigned char* p = F.lds + (128 * half + 32 * dt + r) * VST + (32 * kt + 16 * s2 + 4 * hh) * 2;
                        const v2u lo = *(const LAS v2u*)p, hi = *(const LAS v2u*)(p + 16); v4u wv; wv.x = lo.x; wv.y = lo.y; wv.z = hi.x; wv.w = hi.y;
                        o[dt] = MFMA32(__builtin_bit_cast(bf16x8, wv), pf[kt][s2], o[dt]); }
            if (half == 1) __syncthreads();
            else {   }
            if (half == 0) {
#pragma unroll
                for (int dt = 0; dt < 4; ++dt)
#pragma unroll
                    for (int i = 0; i < 16; i += 2) { const unsigned pv = pk2(o[dt][i] * inv, o[dt][i + 1] * inv); sc[dt][i >> 1] = __uint_as_float(pv); }
            } else {
                LAS unsigned* sw = (LAS unsigned*)(F.lds + w * 16512);
#pragma unroll
                for (int dt = 0; dt < 4; ++dt)
#pragma unroll
                    for (int i = 0; i < 16; i += 2) { sw[r * 129 + ((32 * dt + crow(i, hh)) >> 1)] = __float_as_uint(sc[dt][i >> 1]);
                        sw[r * 129 + 64 + ((32 * dt + crow(i, hh)) >> 1)] = pk2(o[dt][i] * inv, o[dt][i + 1] * inv); }
                LDS_WAIT();
#pragma unroll 4
                for (int i = 0; i < 32; ++i) { const unsigned v0 = sw[i * 129 + lane], v1 = sw[i * 129 + 64 + lane];
                    GAS unsigned* dst = (GAS unsigned*)(F.wsp<bf16>(WS_OC) + ((size_t)b * SEQ + (size_t)qb * 256 + 32 * w + i) * DM + hm * 256);
                    dst[lane] = v0; dst[64 + lane] = v1; }
            }
        }
        (void)stg;
        __syncthreads();
    }
}
template <int N> DI void ce_desc(float (&a)[N], int i, int l) { const float hi = fmaxf(a[i], a[l]), lo = fminf(a[i], a[l]); a[i] = hi; a[l] = lo; }
template <int N, int OFF> DI void bitonic_sort16_desc(float (&a)[N]) {
#pragma unroll
    for (int k = 2; k <= 16; k <<= 1)
#pragma unroll
        for (int j = k >> 1; j > 0; j >>= 1)
#pragma unroll
            for (int i = 0; i < 16; ++i) { const int l = i ^ j; if (l > i) { const bool desc = ((i & k) == 0) || (k == 16);
                if (desc) ce_desc<N>(a, OFF + i, OFF + l); else ce_desc<N>(a, OFF + l, OFF + i); } }
}
template <int N, int OFF> DI void bitonic_merge16_desc(float (&a)[N]) {
#pragma unroll
    for (int j = 8; j > 0; j >>= 1)
#pragma unroll
        for (int i = 0; i < 16; ++i) { const int l = i ^ j; if (l > i) ce_desc<N>(a, OFF + i, OFF + l); }
}
template <bool SORTED> DI void top16_of_64(float (&a)[64]) {
    bitonic_sort16_desc<64, 0>(a); bitonic_sort16_desc<64, 16>(a); bitonic_sort16_desc<64, 32>(a); bitonic_sort16_desc<64, 48>(a);
#pragma unroll
    for (int i = 0; i < 16; ++i) { a[i] = fmaxf(a[i], a[31 - i]); a[32 + i] = fmaxf(a[32 + i], a[63 - i]); }
    bitonic_merge16_desc<64, 0>(a); bitonic_merge16_desc<64, 32>(a);
#pragma unroll
    for (int i = 0; i < 16; ++i) a[i] = fmaxf(a[i], a[47 - i]);
    if (SORTED) bitonic_merge16_desc<64, 0>(a);
}
DI void p8a_topk(Frame& F) {
    const int lane = F.lane, r = lane & 31, hh = lane >> 5, w = F.wave;
    LAS float* tbl = (LAS float*)(F.lds + w * 8192);
    const int gw = F.vcu * NWAVES + w, NGW = F.G * NWAVES;
    for (int task = gw; task < (M / 32) * PEER_H; task += NGW) {
        const int h = task & 7, tt = task >> 3; const size_t tok = (size_t)tt * 32 + r;
        float v[2][16];
#pragma unroll
        for (int p = 0; p < 2; ++p) {
            f32x16 sc[4];
#pragma unroll
            for (int nt = 0; nt < 4; ++nt) sc[nt] = f32x16{};
            const bf16* sk = F.wsp<bf16>(WS_SUBK) + (size_t)((h * 2 + p) * 128) * 128;
#pragma unroll 2
            for (int s = 0; s < 8; ++s) { const bf16x8 qf = *(const bf16x8*)(F.wsp<bf16>(WS_QP) + tok * 2048 + h * 256 + p * 128 + 16 * s + 8 * hh);
#pragma unroll
                for (int nt = 0; nt < 4; ++nt) { const bf16x8 kf = *(const bf16x8*)(sk + (size_t)(32 * nt + r) * 128 + 16 * s + 8 * hh); sc[nt] = MFMA32(kf, qf, sc[nt]); } }
            float a[64];
#pragma unroll
            for (int nt = 0; nt < 4; ++nt)
#pragma unroll
                for (int i = 0; i < 16; ++i) a[nt * 16 + i] = __uint_as_float((__float_as_uint(sc[nt][i]) & ~127u) | (unsigned)(32 * nt + crow(i, hh)));
            top16_of_64<true>(a);
            float m[16];
#pragma unroll
            for (int i = 0; i < 16; ++i) m[i] = fmaxf(a[i], swap32_partner(a[15 - i], hh));
            bitonic_merge16_desc<16, 0>(m);
#pragma unroll
            for (int i = 0; i < 16; ++i) v[p][i] = m[i];
        }
        float c[64]; int n = 0;
#pragma unroll
        for (int i = 0; i < 16; ++i)
#pragma unroll
            for (int j = 0; j < 16; ++j) if ((i + 1) * (j + 1) <= 16) { c[n] = __uint_as_float((__float_as_uint(v[0][i] + v[1][j]) & ~255u) | (unsigned)((i << 4) | j)); ++n; }
#pragma unroll
        for (int k = 50; k < 64; ++k) c[k] = -3.0e38f;
        top16_of_64<false>(c);
#pragma unroll
        for (int i = 0; i < 16; ++i) { tbl[i * 64 + lane] = v[0][i]; tbl[(16 + i) * 64 + lane] = v[1][i]; }
        LDS_WAIT();
        float sv[16]; int ev[16]; float mx = -3.0e38f;
#pragma unroll
        for (int k = 0; k < 16; ++k) { const unsigned pl = __float_as_uint(c[k]) & 255u; const float a1 = tbl[(pl >> 4) * 64 + lane], a2 = tbl[(16 + (pl & 15)) * 64 + lane];
            sv[k] = a1 + a2; ev[k] = (int)(((__float_as_uint(a1) & 127u) << 7) | (__float_as_uint(a2) & 127u)); mx = fmaxf(mx, sv[k]); }
        float sum = 0.f;
#pragma unroll
        for (int k = 0; k < 16; ++k) { sv[k] = __expf(sv[k] - mx); sum += sv[k]; }
        const float inv = 1.0f / sum;
        if (hh == 0) {
#pragma unroll
            for (int k = 0; k < 16; k += 4) *(v4u*)(F.wsp<int>(WS_IDX) + tok * NSEL + h * 16 + k) = (v4u){(unsigned)ev[k], (unsigned)ev[k + 1], (unsigned)ev[k + 2], (unsigned)ev[k + 3]};
        } else {
#pragma unroll
            for (int k = 0; k < 16; k += 4) *(f32x4*)(F.wsp<float>(WS_G) + tok * NSEL + h * 16 + k) = (f32x4){sv[k] * inv, sv[k + 1] * inv, sv[k + 2] * inv, sv[k + 3] * inv};
        }
        LDS_WAIT();
    }
}
DI f32x2 fp8lo(unsigned w) { return __builtin_amdgcn_cvt_pk_f32_fp8(w, false); }
DI f32x2 fp8hi(unsigned w) { return __builtin_amdgcn_cvt_pk_f32_fp8(w, true); }
DI float dot16_fp8(const v4u& u, const f32x2 (&x)[8]) {
    f32x2 a = {0.f, 0.f};
    a = __builtin_elementwise_fma(fp8lo(u.x), x[0], a); a = __builtin_elementwise_fma(fp8hi(u.x), x[1], a);
    a = __builtin_elementwise_fma(fp8lo(u.y), x[2], a); a = __builtin_elementwise_fma(fp8hi(u.y), x[3], a);
    a = __builtin_elementwise_fma(fp8lo(u.z), x[4], a); a = __builtin_elementwise_fma(fp8hi(u.z), x[5], a);
    a = __builtin_elementwise_fma(fp8lo(u.w), x[6], a); a = __builtin_elementwise_fma(fp8hi(u.w), x[7], a);
    return a.x + a.y;
}
DI void axpy16_fp8(f32x2 (&o)[8], float w, const v4u& v) {
    const f32x2 w2 = {w, w};
    o[0] = __builtin_elementwise_fma(fp8lo(v.x), w2, o[0]); o[1] = __builtin_elementwise_fma(fp8hi(v.x), w2, o[1]);
    o[2] = __builtin_elementwise_fma(fp8lo(v.y), w2, o[2]); o[3] = __builtin_elementwise_fma(fp8hi(v.y), w2, o[3]);
    o[4] = __builtin_elementwise_fma(fp8lo(v.z), w2, o[4]); o[5] = __builtin_elementwise_fma(fp8hi(v.z), w2, o[5]);
    o[6] = __builtin_elementwise_fma(fp8lo(v.w), w2, o[6]); o[7] = __builtin_elementwise_fma(fp8hi(v.w), w2, o[7]);
}
constexpr int TPW = 4, NSLICE = 16, SLICE_SHIFT = 10;
DI void p8b_peer(Frame& F) {
    const int lane = F.lane, w = F.wave;
    const int gw = F.vcu * NWAVES + w, NGW = F.G * NWAVES;
    const unsigned char* EU8 = F.wsp<unsigned char>(WS_EU); const unsigned char* EV8 = F.wsp<unsigned char>(WS_EV);
    LAS unsigned char* xl = F.lds + w * (TPW * 2048 + 1024);
    LAS unsigned* srt = (LAS unsigned*)(xl + TPW * 2048);
    for (int t0 = gw * TPW; t0 < M; t0 += NGW * TPW) {
        unsigned pl[TPW][2], offs[TPW];
#pragma unroll
        for (int j = 0; j < TPW; ++j) { const size_t tok = (size_t)t0 + j;
            float rstd; { const f32x4* sp = (const f32x4*)(F.wsp<float>(WS_SSQ2) + tok * 16); const f32x4 st = (sp[0] + sp[1]) + (sp[2] + sp[3]); rstd = rsq_(((st.x + st.y) + (st.z + st.w)) * (1.f / 1024.f) + EPS); }
            { const v4u x0 = *(const v4u*)(F.wsp<bf16>(WS_XN) + tok * DM + 16 * lane), x1 = *(const v4u*)(F.wsp<bf16>(WS_XN) + tok * DM + 16 * lane + 8);
              const float s = rstd * (1.f / U_SCALE); v4u y0, y1;
              y0.x = pk2(bflo(x0.x) * s, bfhi(x0.x) * s); y0.y = pk2(bflo(x0.y) * s, bfhi(x0.y) * s); y0.z = pk2(bflo(x0.z) * s, bfhi(x0.z) * s); y0.w = pk2(bflo(x0.w) * s, bfhi(x0.w) * s);
              y1.x = pk2(bflo(x1.x) * s, bfhi(x1.x) * s); y1.y = pk2(bflo(x1.y) * s, bfhi(x1.y) * s); y1.z = pk2(bflo(x1.z) * s, bfhi(x1.z) * s); y1.w = pk2(bflo(x1.w) * s, bfhi(x1.w) * s);
              *(LAS v4u*)(xl + j * 2048 + 32 * lane) = y0; *(LAS v4u*)(xl + j * 2048 + 32 * lane + 16) = y1; }
            const int ea = F.wsp<int>(WS_IDX)[tok * NSEL + lane], eb = F.wsp<int>(WS_IDX)[tok * NSEL + 64 + lane];
            const float ga = F.wsp<float>(WS_G)[tok * NSEL + lane] * (1.f / V_SCALE), gb = F.wsp<float>(WS_G)[tok * NSEL + 64 + lane] * (1.f / V_SCALE);
            const int sa = ea >> SLICE_SHIFT, sb = eb >> SLICE_SHIFT;
            int run = 0, posa = 0, posb = 0; unsigned myoff = 0;
#pragma unroll
            for (int bk = 0; bk < NSLICE; ++bk) { const unsigned long long ma = __ballot(sa == bk), mb = __ballot(sb == bk);
                const int ca = __popcll(ma), cb = __popcll(mb);
                const int ra = __builtin_amdgcn_mbcnt_hi((unsigned)(ma >> 32), __builtin_amdgcn_mbcnt_lo((unsigned)ma, 0)), rb = __builtin_amdgcn_mbcnt_hi((unsigned)(mb >> 32), __builtin_amdgcn_mbcnt_lo((unsigned)mb, 0));
                if (sa == bk) posa = run + ra; if (sb == bk) posb = run + ca + rb;
                if (lane == bk) myoff = (unsigned)run; run += ca + cb; }
            if (lane == NSLICE) myoff = 128u;
            offs[j] = myoff;
            srt[posa] = (unsigned)ea | (pk2(0.f, ga) & 0xffff0000u); srt[posb] = (unsigned)eb | (pk2(0.f, gb) & 0xffff0000u);
            LDS_WAIT();
            pl[j][0] = srt[lane]; pl[j][1] = srt[64 + lane];
            LDS_WAIT();
        }
        f32x2 o[TPW][8];
#pragma unroll
        for (int j = 0; j < TPW; ++j)
#pragma unroll
            for (int i = 0; i < 8; ++i) o[j][i] = (f32x2){0.f, 0.f};
#pragma unroll 1
        for (int s = 0; s < NSLICE; ++s) {
#pragma unroll
            for (int j = 0; j < TPW; ++j) {
                const int b0 = __builtin_amdgcn_readlane((int)offs[j], s), b1 = __builtin_amdgcn_readlane((int)offs[j], s + 1);
                if (b1 > b0) {
                    f32x2 x[8];
                    { const v4u y0 = *(const LAS v4u*)(xl + j * 2048 + 32 * lane), y1 = *(const LAS v4u*)(xl + j * 2048 + 32 * lane + 16);
                      x[0] = (f32x2){bflo(y0.x), bfhi(y0.x)}; x[1] = (f32x2){bflo(y0.y), bfhi(y0.y)}; x[2] = (f32x2){bflo(y0.z), bfhi(y0.z)}; x[3] = (f32x2){bflo(y0.w), bfhi(y0.w)};
                      x[4] = (f32x2){bflo(y1.x), bfhi(y1.x)}; x[5] = (f32x2){bflo(y1.y), bfhi(y1.y)}; x[6] = (f32x2){bflo(y1.z), bfhi(y1.z)}; x[7] = (f32x2){bflo(y1.w), bfhi(y1.w)}; }
                    for (int base = b0; base < b1; base += 4) {
                        v4u uu[4], vv[4]; float gg[4];
#pragma unroll
                        for (int k = 0; k < 4; ++k) { const int p = (base + k < b1) ? base + k : b1 - 1;
                            const unsigned ent = (unsigned)((p < 64) ? __builtin_amdgcn_readlane((int)pl[j][0], p) : __builtin_amdgcn_readlane((int)pl[j][1], p - 64));
                            const unsigned e = ent & 0x3fffu; gg[k] = (base + k < b1) ? __uint_as_float(ent & 0xffff0000u) : 0.f;
                            uu[k] = *(const v4u*)(EU8 + (size_t)e * DM + 16 * lane); vv[k] = *(const v4u*)(EV8 + (size_t)e * DM + 16 * lane); }
#pragma unroll
                        for (int k = 0; k < 4; ++k) { const float d = sum64(dot16_fp8(uu[k], x)); axpy16_fp8(o[j], gg[k] * gelu_tanh(d), vv[k]); }
                    }
                }
            }
        }
#pragma unroll
        for (int j = 0; j < TPW; ++j) {
            float* xr = F.out + ((size_t)t0 + j) * DM + 16 * lane;
            f32x4 a[4]; float ss = 0.f;
#pragma unroll
            for (int q = 0; q < 4; ++q) { a[q] = *(const f32x4*)(xr + 4 * q); a[q].x += o[j][2 * q].x; a[q].y += o[j][2 * q].y; a[q].z += o[j][2 * q + 1].x; a[q].w += o[j][2 * q + 1].y;
                ss += (a[q].x * a[q].x + a[q].y * a[q].y) + (a[q].z * a[q].z + a[q].w * a[q].w); }
            const float rf = rsq_(sum64(ss) * (1.f / 1024.f) + EPS);
#pragma unroll
            for (int q = 0; q < 4; ++q) *(f32x4*)(xr + 4 * q) = a[q] * rf * *(const f32x4*)(F.in(25) + 16 * lane + 4 * q);
        }
    }
}
constexpr int N_PHASES = 11;
__global__ void __launch_bounds__(NWAVES * 64, 2) fwd_kernel(Args args) {
    extern __shared__ __attribute__((aligned(16))) unsigned char lds[];
    Frame F;
    F.lds = (LAS unsigned char*)lds;
    F.MISC = (volatile LAS unsigned*)(F.lds + MISC_OFF);
    F.tid = threadIdx.x; F.lane = F.tid & 63; F.wave = __builtin_amdgcn_readfirstlane(F.tid >> 6);
    F.G = gridDim.x; { const int bx = blockIdx.x; F.vcu = (F.G % 8 == 0) ? (bx % 8) * (F.G / 8) + bx / 8 : bx; }
    F.A = &args; F.ws = args.ws; F.out = args.out;
    F.ctl = (gu32*)(args.ws + WS_CTL);
    for (int u = F.tid; u < (LDS_BYTES - LDSCTL_OFF) / 4; u += NWAVES * 64) ((LAS unsigned*)(F.lds + LDSCTL_OFF))[u] = 0u;
    __syncthreads();
    const bool multi = (args.ph_hi - args.ph_lo) > 1;
    XcdBarrier bar; bar.bar = (unsigned*)(F.ctl + CW_BAR) + args.li * XCD_BAR_WORDS; bar.x = 0; bar.st = nullptr;
    if (multi) bar = xcd_barrier_post((unsigned*)(F.ctl + CW_BAR) + args.li * XCD_BAR_WORDS, F.MISC + 8);
    const int lo = args.ph_lo, hi = args.ph_hi;
#ifndef PHASE_REPEAT
#define PHASE_REPEAT 0
#endif
#define REP(k) for (int rep_ = 0; rep_ < (((PHASE_REPEAT >> (k)) & 1) ? 2 : 1); ++rep_)
#ifndef PHASE_MASK
#define PHASE_MASK 0x7ff
#endif
#define IN(k) (((PHASE_MASK >> (k)) & 1) && lo <= (k) && (k) < hi)
#define SEAM(k) do { asm volatile("; ===SEAM " #k ::: "memory"); if (IN(k) && IN((k) + 1)) xcd_barrier(bar); } while (0)
    const int c = (int)blockIdx.x;

    if (IN(0)) REP(0) { p0_prologue(F); } SEAM(0);
    if (IN(1)) REP(1) {
        { pg8::Gemm g{F.wsp<bf16>(WS_XN), F.wsp<bf16>(WS_WIN), M, INW, DM}; pg8::StaticOrder S; S.init(M, INW, F.G, c);
          pg8::EpiSplitT E{F.wsp<bf16>(WS_Z), ZW, ZW, F.wsp<bf16>(WS_VT), ATTW, SEQ};
          pg8::gemm_phase<pg8::EpiSplitT, pg8::StaticOrder, true, true>(F.lds, g, S, E); }
        { const int nw3 = (M / 256) * (INW / 256) - 2 * F.G;
          int idx = -1; if (nw3 >= 0 && nw3 + 16 <= F.G) idx = c - nw3; else idx = (c < 16 && F.G >= 16) ? c : -1;
          if (F.G < 16) idx = -1;
          pg8::Gemm g{F.wsp<bf16>(WS_MEMN), F.wsp<bf16>(WS_WKV), NBATCH * 256, 2 * DM, DM};
          if (F.G >= 16) { pg8::OneUnit S{idx, 2, 8}; pg8::EpiSplitT E{F.wsp<bf16>(WS_KM), DM, DM, F.wsp<bf16>(WS_VMT), DM, 256};
              pg8::gemm_phase<pg8::EpiSplitT, pg8::OneUnit, false, true>(F.lds, g, S, E); }
          else { pg8::StaticOrder S; S.init(NBATCH * 256, 2 * DM, F.G, c); pg8::EpiSplitT E{F.wsp<bf16>(WS_KM), DM, DM, F.wsp<bf16>(WS_VMT), DM, 256};
              pg8::gemm_phase<pg8::EpiSplitT, pg8::StaticOrder, false, true>(F.lds, g, S, E); } }
    } SEAM(1);
    if (IN(2)) REP(2) { p2_lru_aggregates(F); } SEAM(2);
    if (IN(3)) REP(3) { p3_mixer(F); } SEAM(3);
    if (IN(4)) REP(4) {
        pg8::Gemm g{F.wsp<bf16>(WS_Y), F.wsp<bf16>(WS_WOUT), M, DM, DM}; pg8::StaticOrder S; S.init(M, DM, F.G, c);
        pg8::EpiResid E{F.in(0), F.out, F.wsp<bf16>(WS_XN), F.wsp<float>(WS_SSQ1), DM};
        pg8::gemm_phase<pg8::EpiResid, pg8::StaticOrder, true, true>(F.lds, g, S, E);
    } SEAM(4);
    if (IN(5)) REP(5) {
        pg8::Gemm g{F.wsp<bf16>(WS_XN), F.wsp<bf16>(WS_WQ), M, DM, DM}; pg8::StaticOrder S; S.init(M, DM, F.G, c);
        pg8::EpiRowScale E{F.wsp<bf16>(WS_QC), DM, F.wsp<float>(WS_SSQ1), 1.f / 1024.f, EPS};
        pg8::gemm_phase<pg8::EpiRowScale, pg8::StaticOrder, true, true>(F.lds, g, S, E);
    } SEAM(5);
    if (IN(6)) REP(6) { p5_cross(F); } SEAM(6);
    if (IN(7)) {
        pg8::Gemm g{F.wsp<bf16>(WS_OC), F.wsp<bf16>(WS_WO), M, DM, DM}; pg8::StaticOrder S; S.init(M, DM, F.G, c);
        pg8::EpiResid E{F.out, F.out, F.wsp<bf16>(WS_XN), F.wsp<float>(WS_SSQ2), DM};
        pg8::gemm_phase<pg8::EpiResid, pg8::StaticOrder, true, true>(F.lds, g, S, E);
    } SEAM(7);
    if (IN(8)) REP(8) {
        pg8::Gemm g{F.wsp<bf16>(WS_XN), F.wsp<bf16>(WS_WQRY), M, 2 * DM, DM}; pg8::StaticOrder S; S.init(M, 2 * DM, F.G, c);
        pg8::EpiRowScale E{F.wsp<bf16>(WS_QP), 2 * DM, F.wsp<float>(WS_SSQ2), 1.f / 1024.f, EPS};
        pg8::gemm_phase<pg8::EpiRowScale, pg8::StaticOrder, true, true>(F.lds, g, S, E);
    } SEAM(8);
    if (IN(9)) REP(9) { p8a_topk(F); } SEAM(9);
    if (IN(10)) { p8b_peer(F); }
#undef IN
#undef SEAM
}

#ifndef N_LAUNCH_MODE
#define N_LAUNCH_MODE 1
#endif
extern "C" void kernel_launch(void* const* d_in, const int* in_sizes, int n_in, void* d_out, int out_size, void* d_ws, size_t ws_size, hipStream_t stream) {
    static int grid = 0;
    if (grid == 0) {
        if (n_in != 26 || out_size != M * DM || ws_size < WS_END) { fprintf(stderr, "kernel_launch: unexpected shapes (n_in %d, out %d, ws %zu)\n", n_in, out_size, ws_size); grid = -1; return; }
        int dev = 0, cus = 0, per_cu = 0;
        if (hipGetDevice(&dev) != hipSuccess || hipDeviceGetAttribute(&cus, hipDeviceAttributeMultiprocessorCount, dev) != hipSuccess) { grid = -1; return; }
        if (hipFuncSetAttribute((const void*)fwd_kernel, hipFuncAttributeMaxDynamicSharedMemorySize, LDS_BYTES) != hipSuccess) { fprintf(stderr, "kernel_launch: hipFuncSetAttribute failed\n"); grid = -1; return; }
        if (hipOccupancyMaxActiveBlocksPerMultiprocessor(&per_cu, (const void*)fwd_kernel, NWAVES * 64, LDS_BYTES) != hipSuccess || per_cu < 1) { fprintf(stderr, "kernel_launch: occupancy query says %d blocks per CU\n", per_cu); (void)hipGetLastError(); grid = -1; return; }
        grid = cus;
    }
    if (grid < 0) return;
    (void)hipMemsetAsync((char*)d_ws + WS_CTL, 0, CTL_ZERO_BYTES, stream);
    Args a{};
    for (int i = 0; i < 26; ++i) a.in[i] = (const float*)d_in[i];
    a.out = (float*)d_out; a.ws = (unsigned char*)d_ws;
    if (N_LAUNCH_MODE == 1) { a.ph_lo = 0; a.ph_hi = N_PHASES; a.li = 0; hipLaunchKernelGGL(fwd_kernel, dim3(grid), dim3(NWAVES * 64), LDS_BYTES, stream, a); }
    else { for (int p = 0; p < N_PHASES; ++p) { a.ph_lo = p; a.ph_hi = p + 1; a.li = 0; hipLaunchKernelGGL(fwd_kernel, dim3(grid), dim3(NWAVES * 64), LDS_BYTES, stream, a); } }
}
```

```cpp
#include <hip/hip_runtime.h>
#include <cstdio>
#include <cstdint>
namespace pg8 {
#define PG8_LAS __attribute__((address_space(3)))
typedef unsigned short bf16_t;
typedef short bf16x8 __attribute__((ext_vector_type(8)));
typedef float f32x4 __attribute__((ext_vector_type(4)));
typedef unsigned u32x4 __attribute__((ext_vector_type(4)));
constexpr int BM = 256, BK = 64, HALF = 128, HTB = HALF * BK * 2  , STAGE_BYTES = 8 * HTB, NXCD = 8, WGM = 8;

__host__ __device__ __forceinline__ int lds_byte(int r, int c) { const int st = (r >> 4) * 2 + (c >> 5), rr = r & 15, cc = c & 31, ob = rr * 64 + cc * 2; return st * 1024 + (ob ^ (((ob >> 9) & 1) << 5)); }
__host__ __device__ __forceinline__ void stage_rc(int b, int& R, int& C) { const int st = b / 1024, sb = b % 1024, swz = sb ^ (((sb >> 9) & 1) << 5); R = (st >> 1) * 16 + swz / 64; C = (st & 1) * 32 + (swz % 64) / 2; }
__host__ __device__ __forceinline__ int perm32(int rho) { const int n = rho >> 4, i = rho & 15; return 8 * (i >> 2) + 4 * n + (i & 3); }

struct Unit { int pm, pn; };
struct Gemm { const bf16_t* A; const bf16_t* Bt; int M, N, K; };

struct StaticOrder {
    int nM, nN, nwg, G, c;
    __host__ __device__ void init(int M, int N, int G_, int c_) { nM = M / BM; nN = N / BM; nwg = nM * nN; G = G_; c = c_; }
    __host__ __device__ bool next(int i, Unit& u) const {
        const long L = (long)i * G + c; if (L >= nwg) return false;
        int wgid = (int)L; { const int q = nwg / NXCD, r = nwg % NXCD, xcd = wgid % NXCD, off = wgid / NXCD; wgid = (xcd < r ? xcd * (q + 1) : r * (q + 1) + (xcd - r) * q) + off; }
        const int nig = WGM * nN, gid = wgid / nig, fm = gid * WGM, gsz = (nM - fm) < WGM ? (nM - fm) : WGM;
        u.pm = fm + ((wgid % nig) % gsz); u.pn = (wgid % nig) / gsz; return true;
    }
    __device__ __forceinline__ void a_ready(const Unit&) const {}
    __device__ __forceinline__ void done(const Unit&) const {}
};

typedef float f32x2 __attribute__((ext_vector_type(2)));
typedef __bf16 bf16x2_t __attribute__((ext_vector_type(2)));
__device__ __forceinline__ unsigned cvt_pk_bf16(float lo, float hi) { f32x2 v = {lo, hi}; bf16x2_t b = __builtin_convertvector(v, bf16x2_t); return __builtin_bit_cast(unsigned, b); }
__device__ __forceinline__ bf16_t cvt_bf16(float x) { return (bf16_t)(cvt_pk_bf16(x, 0.f) & 0xffffu); }

struct EpiSplitT {
    static constexpr bool PERM = true, AFTER_DRAIN = false;
    bf16_t* O; int ldc; int ncols_rm; bf16_t* T; int NT; int rpb;
    __device__ __forceinline__ void operator()(const f32x4 (&acc)[2][2][4][2], const Unit& u, int wr, int wc, int fr, int fq) const {
        const int row0 = u.pm * BM + wr * 64 + fr; const int colt = u.pn * BM;
        if (colt < ncols_rm) {
            const int col0 = colt + wc * 32 + 8 * fq;
#pragma unroll
            for (int ai = 0; ai < 2; ++ai)
#pragma unroll
                for (int m = 0; m < 4; ++m) { bf16_t* rowp = O + (size_t)(row0 + ai * HALF + m * 16) * ldc + col0;
#pragma unroll
                    for (int bj = 0; bj < 2; ++bj) { const f32x4 v0 = acc[ai][bj][m][0], v1 = acc[ai][bj][m][1];
                        u32x4 w; w.x = cvt_pk_bf16(v0[0], v0[1]); w.y = cvt_pk_bf16(v0[2], v0[3]); w.z = cvt_pk_bf16(v1[0], v1[1]); w.w = cvt_pk_bf16(v1[2], v1[3]);
                        *(u32x4*)(rowp + bj * HALF) = w; } }
        } else {
            const int c0 = colt - ncols_rm + wc * 32 + 8 * fq;
#pragma unroll
            for (int ai = 0; ai < 2; ++ai)
#pragma unroll
                for (int m = 0; m < 4; ++m) { const int row = row0 + ai * HALF + m * 16; const int b = row / rpb, t = row - b * rpb; bf16_t* base = T + (size_t)b * NT * rpb + t;
#pragma unroll
                    for (int bj = 0; bj < 2; ++bj)
#pragma unroll
                        for (int n = 0; n < 2; ++n)
#pragma unroll
                            for (int e = 0; e < 4; ++e) base[(size_t)(c0 + bj * HALF + 4 * n + e) * rpb] = cvt_bf16(acc[ai][bj][m][n][e]); }
        }
    }
};
struct EpiResid {
    static constexpr bool PERM = true, AFTER_DRAIN = false;
    const float* base; float* out; bf16_t* xb; float* ssq; int ldc;
    __device__ __forceinline__ void operator()(const f32x4 (&acc)[2][2][4][2], const Unit& u, int wr, int wc, int fr, int fq) const {
        const int row0 = u.pm * BM + wr * 64 + fr; const int col0 = u.pn * BM + wc * 32 + 8 * fq;
#pragma unroll
        for (int ai = 0; ai < 2; ++ai)
#pragma unroll
            for (int m = 0; m < 4; ++m) { const int row = row0 + ai * HALF + m * 16; float s = 0.f;
#pragma unroll
                for (int bj = 0; bj < 2; ++bj) { const size_t off = (size_t)row * ldc + col0 + bj * HALF;
                    const f32x4 b0 = *(const f32x4*)(base + off), b1 = *(const f32x4*)(base + off + 4);
                    const f32x4 v0 = acc[ai][bj][m][0] + b0, v1 = acc[ai][bj][m][1] + b1;
                    *(f32x4*)(out + off) = v0; *(f32x4*)(out + off + 4) = v1;
                    s += (v0[0] * v0[0] + v0[1] * v0[1]) + (v0[2] * v0[2] + v0[3] * v0[3]) + (v1[0] * v1[0] + v1[1] * v1[1]) + (v1[2] * v1[2] + v1[3] * v1[3]);
                    u32x4 w; w.x = cvt_pk_bf16(v0[0], v0[1]); w.y = cvt_pk_bf16(v0[2], v0[3]); w.z = cvt_pk_bf16(v1[0], v1[1]); w.w = cvt_pk_bf16(v1[2], v1[3]);
                    *(u32x4*)(xb + off) = w; }
                s += __shfl_xor(s, 16); s += __shfl_xor(s, 32);
                if (fq == 0) ssq[(size_t)row * 16 + u.pn * 4 + wc] = s; }
    }
};
struct EpiRowScale {
    static constexpr bool PERM = true, AFTER_DRAIN = false;
    bf16_t* O; int ldc; const float* ssq; float inv_n, eps;
    __device__ __forceinline__ void operator()(const f32x4 (&acc)[2][2][4][2], const Unit& u, int wr, int wc, int fr, int fq) const {
        const int row0 = u.pm * BM + wr * 64 + fr; const int col0 = u.pn * BM + wc * 32 + 8 * fq;
#pragma unroll
        for (int ai = 0; ai < 2; ++ai)
#pragma unroll
            for (int m = 0; m < 4; ++m) { const int row = row0 + ai * HALF + m * 16; const f32x4* sp = (const f32x4*)(ssq + (size_t)row * 16);
                const f32x4 s0 = sp[0], s1 = sp[1], s2 = sp[2], s3 = sp[3]; const f32x4 st = (s0 + s1) + (s2 + s3);
                const float r = 1.0f / sqrtf(((st[0] + st[1]) + (st[2] + st[3])) * inv_n + eps);
                bf16_t* rowp = O + (size_t)row * ldc + col0;
#pragma unroll
                for (int bj = 0; bj < 2; ++bj) { const f32x4 v0 = acc[ai][bj][m][0] * r, v1 = acc[ai][bj][m][1] * r;
                    u32x4 w; w.x = cvt_pk_bf16(v0[0], v0[1]); w.y = cvt_pk_bf16(v0[2], v0[3]); w.z = cvt_pk_bf16(v1[0], v1[1]); w.w = cvt_pk_bf16(v1[2], v1[3]);
                    *(u32x4*)(rowp + bj * HALF) = w; } }
    }
};
struct OneUnit {
    int idx, nM, nN;
    __device__ __forceinline__ bool next(int i, Unit& u) const { if (i > 0 || idx < 0 || idx >= nM * nN) return false; u.pm = idx % nM; u.pn = idx / nM; return true; }
    __device__ __forceinline__ void a_ready(const Unit&) const {}
    __device__ __forceinline__ void done(const Unit&) const {}
};

template <class Epi, class Sched, bool ALIGN_EPI = false, bool SP2 = false>
__device__ __forceinline__ void gemm_phase(PG8_LAS unsigned char* lds, const Gemm g, const Sched& S, const Epi& E) {
    const int tid = threadIdx.x, wid = __builtin_amdgcn_readfirstlane(tid >> 6), lane = tid & 63, wr = wid >> 2, wc = wid & 3, fr = lane & 15, fq = lane >> 4;
    const int K = g.K, nt = K / BK;
    unsigned voffA[2], voffB[2];
#pragma unroll
    for (int i = 0; i < 2; ++i) { int R, C; stage_rc(tid * 16 + i * 8192, R, C); const int Rb = Epi::PERM ? ((R & ~31) + perm32(R & 31)) : R;
        voffA[i] = (unsigned)(R * K + C) * 2u; voffB[i] = (unsigned)(Rb * K + C) * 2u; }
    const size_t kstep = (size_t)(BK * 2);
    const size_t hstep = (size_t)HALF * K * 2;
    const size_t tstep = 2 * hstep;
    const unsigned ldsw = (unsigned)wid * 1024u;
    const int aoff = lds_byte(wr * 64 + fr, fq * 8), boff = lds_byte(wc * 32 + fr, fq * 8);
#define PG8_SA(b, h) (((b) * 2 + (h)) * HTB)
#define PG8_SB(b, h) ((4 + (b) * 2 + (h)) * HTB)
#define PG8_STAGE(bufoff, gbase, voff) do { _Pragma("unroll") for (int _i = 0; _i < 2; ++_i) \
        __builtin_amdgcn_global_load_lds((const unsigned*)((const char*)(gbase) + (voff)[_i]), (PG8_LAS unsigned*)(lds + (bufoff) + ldsw + _i * 8192), 16, 0, 0); } while (0)
#define PG8_LDA(dst, b, h) do { _Pragma("unroll") for (int m = 0; m < 4; ++m) _Pragma("unroll") for (int k = 0; k < 2; ++k) dst[m][k] = *(const PG8_LAS bf16x8*)(lds + PG8_SA(b, h) + aoff + m * 2048 + k * 1024); } while (0)
#define PG8_LDB(dst, b, h) do { _Pragma("unroll") for (int n = 0; n < 2; ++n) _Pragma("unroll") for (int k = 0; k < 2; ++k) dst[n][k] = *(const PG8_LAS bf16x8*)(lds + PG8_SB(b, h) + boff + n * 2048 + k * 1024); } while (0)
#define PG8_MMA(ai, bj, At, Bt) do { __builtin_amdgcn_s_setprio(1); _Pragma("unroll") for (int m = 0; m < 4; ++m) _Pragma("unroll") for (int n = 0; n < 2; ++n) _Pragma("unroll") for (int k = 0; k < 2; ++k) \
        acc[ai][bj][m][n] = __builtin_amdgcn_mfma_f32_16x16x32_bf16(Bt[n][k], At[m][k], acc[ai][bj][m][n], 0, 0, 0); __builtin_amdgcn_s_setprio(0); } while (0)
#define PG8_WAIT_V(n) asm volatile("s_waitcnt vmcnt(" #n ")" ::: "memory")
#define PG8_WAIT_L(n) asm volatile("s_waitcnt lgkmcnt(" #n ")" ::: "memory")
#define PG8_BAR __builtin_amdgcn_s_barrier()
#define PG8_SCHED __builtin_amdgcn_sched_barrier(0)
    Unit cur, nxt; int ui = 0;
    if (!S.next(0, cur)) return;
    f32x4 acc[2][2][4][2];
#pragma unroll
    for (int a = 0; a < 2; ++a)
#pragma unroll
        for (int b = 0; b < 2; ++b)
#pragma unroll
            for (int m = 0; m < 4; ++m)
#pragma unroll
                for (int n = 0; n < 2; ++n) acc[a][b][m][n] = (f32x4){0.f, 0.f, 0.f, 0.f};
    bf16x8 At[4][2], B0[2][2], B1[2][2];
    const char* cA = (const char*)g.A + (size_t)cur.pm * tstep; const char* cB = (const char*)g.Bt + (size_t)cur.pn * tstep;
    S.a_ready(cur);
    if constexpr (SP2) {
        PG8_STAGE(PG8_SB(0, 0), cB, voffB); PG8_STAGE(PG8_SB(0, 1), cB + hstep, voffB); PG8_STAGE(PG8_SA(0, 0), cA, voffA); PG8_STAGE(PG8_SA(0, 1), cA + hstep, voffA);
        if (wr == 1) PG8_BAR;
        PG8_WAIT_V(2); PG8_BAR;
        PG8_STAGE(PG8_SB(1, 0), cB + kstep, voffB); PG8_STAGE(PG8_SA(1, 0), cA + kstep, voffA); PG8_STAGE(PG8_SB(1, 1), cB + hstep + kstep, voffB);
        PG8_WAIT_V(6); PG8_BAR;
    } else {
        PG8_STAGE(PG8_SB(0, 0), cB, voffB); PG8_STAGE(PG8_SA(0, 0), cA, voffA); PG8_STAGE(PG8_SB(0, 1), cB + hstep, voffB); PG8_STAGE(PG8_SA(0, 1), cA + hstep, voffA);
        if (wr == 1) PG8_BAR;
        PG8_WAIT_V(4); PG8_BAR;
        PG8_STAGE(PG8_SB(1, 0), cB + kstep, voffB); PG8_STAGE(PG8_SA(1, 0), cA + kstep, voffA); PG8_STAGE(PG8_SB(1, 1), cB + hstep + kstep, voffB);
        PG8_WAIT_V(6); PG8_BAR;
    }
    for (;;) {
        const bool has_next = S.next(ui + 1, nxt);
        const char* nA = has_next ? (const char*)g.A + (size_t)nxt.pm * tstep : cA; const char* nB = has_next ? (const char*)g.Bt + (size_t)nxt.pn * tstep : cB;
        for (int t = 0; t < nt; t += 2) {
            const bool last = (t == nt - 2);
            const char* a1 = cA + (size_t)(t + 1) * kstep;
            const char* a2 = last ? nA : cA + (size_t)(t + 2) * kstep; const char* b2 = last ? nB : cB + (size_t)(t + 2) * kstep;
            const char* a3 = a2 + kstep; const char* b3 = b2 + kstep;
            if (last && has_next) S.a_ready(nxt);
            if constexpr (SP2) {
            PG8_LDB(B0, 0, 0); PG8_LDB(B1, 0, 1); PG8_SCHED; PG8_LDA(At, 0, 0); PG8_STAGE(PG8_SA(1, 1), a1 + hstep, voffA);
            PG8_WAIT_V(8); PG8_WAIT_L(0); PG8_BAR; PG8_MMA(0, 0, At, B0); PG8_MMA(0, 1, At, B1); PG8_BAR; PG8_SCHED;
            PG8_LDA(At, 0, 1); PG8_STAGE(PG8_SB(0, 0), b2, voffB); PG8_STAGE(PG8_SB(0, 1), b2 + hstep, voffB); PG8_STAGE(PG8_SA(0, 0), a2, voffA);
            PG8_WAIT_V(8); PG8_WAIT_L(0); PG8_BAR; PG8_MMA(1, 0, At, B0); PG8_MMA(1, 1, At, B1); PG8_BAR; PG8_SCHED;
            PG8_LDB(B0, 1, 0); PG8_LDB(B1, 1, 1); PG8_SCHED; PG8_LDA(At, 1, 0); PG8_STAGE(PG8_SA(0, 1), a2 + hstep, voffA);
            PG8_WAIT_V(8); PG8_WAIT_L(0); PG8_BAR; PG8_MMA(0, 0, At, B0); PG8_MMA(0, 1, At, B1); PG8_BAR; PG8_SCHED;
            PG8_LDA(At, 1, 1); PG8_STAGE(PG8_SB(1, 0), b3, voffB); PG8_STAGE(PG8_SB(1, 1), b3 + hstep, voffB); PG8_STAGE(PG8_SA(1, 0), a3, voffA);
            PG8_WAIT_V(8); PG8_WAIT_L(0); PG8_BAR; PG8_MMA(1, 0, At, B0); PG8_MMA(1, 1, At, B1); PG8_BAR; PG8_SCHED;
            } else {
            PG8_LDB(B0, 0, 0); PG8_SCHED; PG8_LDA(At, 0, 0); PG8_STAGE(PG8_SA(1, 1), a1 + hstep, voffA);
            PG8_WAIT_L(8); PG8_BAR; PG8_WAIT_L(0); PG8_MMA(0, 0, At, B0); PG8_BAR; PG8_SCHED;
            PG8_LDB(B1, 0, 1); PG8_STAGE(PG8_SB(0, 0), b2, voffB);
            PG8_BAR; PG8_WAIT_L(0); PG8_MMA(0, 1, At, B1); PG8_BAR;
            PG8_LDA(At, 0, 1); PG8_STAGE(PG8_SA(0, 0), a2, voffA);
            PG8_BAR; PG8_WAIT_L(0); PG8_MMA(1, 0, At, B0); PG8_BAR; PG8_SCHED;
            PG8_STAGE(PG8_SB(0, 1), b2 + hstep, voffB);
            PG8_WAIT_V(6); PG8_BAR; PG8_MMA(1, 1, At, B1); PG8_BAR;
            PG8_LDB(B0, 1, 0); PG8_SCHED; PG8_LDA(At, 1, 0); PG8_STAGE(PG8_SA(0, 1), a2 + hstep, voffA);
            PG8_WAIT_L(8); PG8_BAR; PG8_WAIT_L(0); PG8_MMA(0, 0, At, B0); PG8_BAR; PG8_SCHED;
            PG8_LDB(B1, 1, 1); PG8_STAGE(PG8_SB(1, 0), b3, voffB);
            PG8_BAR; PG8_WAIT_L(0); PG8_MMA(0, 1, At, B1); PG8_BAR;
            PG8_LDA(At, 1, 1); PG8_STAGE(PG8_SA(1, 0), a3, voffA);
            PG8_BAR; PG8_WAIT_L(0); PG8_MMA(1, 0, At, B0); PG8_BAR; PG8_SCHED;
            PG8_STAGE(PG8_SB(1, 1), b3 + hstep, voffB);
            PG8_WAIT_V(6); PG8_BAR; PG8_MMA(1, 1, At, B1); PG8_BAR;
            }
        }
        if constexpr (ALIGN_EPI) { if (wr == 0) PG8_BAR; }
        if constexpr (!Epi::AFTER_DRAIN) { E(acc, cur, wr, wc, fr, fq); S.done(cur); }
        if (!has_next) break;
#pragma unroll
        for (int a = 0; a < 2; ++a)
#pragma unroll
            for (int b = 0; b < 2; ++b)
#pragma unroll
                for (int m = 0; m < 4; ++m)
#pragma unroll
                    for (int n = 0; n < 2; ++n) acc[a][b][m][n] = (f32x4){0.f, 0.f, 0.f, 0.f};
        cur = nxt; cA = nA; cB = nB; ++ui;
        if constexpr (ALIGN_EPI) { if (wr == 1) PG8_BAR; }
    }
    PG8_WAIT_V(0);
    if constexpr (!ALIGN_EPI) { if (wr == 0) PG8_BAR; }
    PG8_BAR;
    if constexpr (Epi::AFTER_DRAIN) { E.fused(acc, cur, wr, wc, fr, fq, lds, wid, lane); S.done(cur); }
#undef PG8_SA
#undef PG8_SB
#undef PG8_STAGE
#undef PG8_LDA
#undef PG8_LDB
#undef PG8_MMA
#undef PG8_WAIT_V
#undef PG8_WAIT_L
#undef PG8_BAR
#undef PG8_SCHED
}
}

#ifndef PG8_SP2
#define PG8_SP2 true
#endif
#ifndef PG8_ALIGN
#define PG8_ALIGN true
#endif
constexpr int NWAVES = 8;
constexpr int NBATCH = 2, SEQ = 8192, DM = 1024, M = NBATCH * SEQ;
constexpr int INW = 2560, ZW = 2048;
constexpr int LRUW = 512, ATTW = 512, NCHUNK = SEQ / 64;
constexpr int NEXP = 16384, PEER_H = 8, NSEL = 128;
constexpr float EPS = 1e-6f;
constexpr float LOG2E = 1.4426950408889634f;

constexpr size_t MiB = 1u << 20;
constexpr size_t WS_CTL = 0, CTL_ZERO_BYTES = 1 * MiB;
constexpr size_t WS_WIN = 1 * MiB, WS_WOUT = 6 * MiB, WS_WQ = 8 * MiB, WS_WKV = 10 * MiB, WS_WO = 14 * MiB, WS_WQRY = 16 * MiB;
constexpr size_t WS_SUBK = 20 * MiB, WS_GATEW = 20 * MiB + 512 * 1024, WS_MEMN = 21 * MiB, WS_KM = 22 * MiB, WS_VMT = 23 * MiB, WS_AGG = 24 * MiB, WS_SSQ1 = 25 * MiB, WS_SSQ2 = 26 * MiB;
constexpr size_t WS_EU = 28 * MiB, WS_EV = 60 * MiB, WS_XN = 92 * MiB, WS_Z = 124 * MiB, WS_VT = 188 * MiB, WS_Y = 204 * MiB, WS_END = 236 * MiB;
constexpr size_t WS_QC = WS_Z, WS_OC = WS_Z + 32 * MiB, WS_QP = WS_Z, WS_IDX = WS_VT, WS_G = WS_VT + 8 * MiB;
constexpr int CW_BAR = 4096;

constexpr int RING_BYTES = 155648;
constexpr int LDSCTL_OFF = RING_BYTES, MISC_OFF = LDSCTL_OFF + 320;
constexpr int LDS_BYTES = 163840;

#define GAS __attribute__((address_space(1)))
#define LAS __attribute__((address_space(3)))
typedef unsigned short bf16;
typedef unsigned v4u __attribute__((ext_vector_type(4)));
typedef unsigned v2u __attribute__((ext_vector_type(2)));
typedef float f32x4 __attribute__((ext_vector_type(4)));
typedef float f32x2 __attribute__((ext_vector_type(2)));
typedef float f32x16 __attribute__((ext_vector_type(16)));
typedef short bf16x8 __attribute__((ext_vector_type(8)));
typedef __bf16 bf16x2_t __attribute__((ext_vector_type(2)));
typedef GAS unsigned gu32;
#define RLX_AGENT __ATOMIC_RELAXED, __HIP_MEMORY_SCOPE_AGENT
#define LDS_WAIT() asm volatile("s_waitcnt lgkmcnt(0)" ::: "memory")
#define VM_WAIT() asm volatile("s_waitcnt vmcnt(0)" ::: "memory")
#define MFMA32(a, b, c) __builtin_amdgcn_mfma_f32_32x32x16_bf16((a), (b), (c), 0, 0, 0)
#define DI __device__ __forceinline__

DI unsigned pk2(float lo, float hi) { f32x2 v = {lo, hi}; bf16x2_t b = __builtin_convertvector(v, bf16x2_t); return __builtin_bit_cast(unsigned, b); }
DI bf16 f2bf(float x) { return (bf16)(pk2(x, 0.f) & 0xffffu); }
DI float bf2f(bf16 x) { return __uint_as_float((unsigned)x << 16); }
DI float bflo(unsigned p) { return __uint_as_float(p << 16); }
DI float bfhi(unsigned p) { return __uint_as_float(p & 0xffff0000u); }
DI int crow(int reg, int hh) { return (reg & 3) + 8 * (reg >> 2) + 4 * hh; }
DI float swap32_partner(float x, int hh) { auto rr = __builtin_amdgcn_permlane32_swap(__float_as_uint(x), __float_as_uint(x), false, false); return __uint_as_float(hh ? rr[0] : rr[1]); }
DI float dpp_xor1(float x) { return __int_as_float(__builtin_amdgcn_update_dpp(0, __float_as_int(x), 0xB1, 0xf, 0xf, true)); }
DI float dpp_xor2(float x) { return __int_as_float(__builtin_amdgcn_update_dpp(0, __float_as_int(x), 0x4E, 0xf, 0xf, true)); }
DI float dpp_hmir(float x) { return __int_as_float(__builtin_amdgcn_update_dpp(0, __float_as_int(x), 0x141, 0xf, 0xf, true)); }
DI float dpp_mir(float x)  { return __int_as_float(__builtin_amdgcn_update_dpp(0, __float_as_int(x), 0x140, 0xf, 0xf, true)); }
DI float sum16(float x) { x += dpp_xor1(x); x += dpp_xor2(x); x += dpp_hmir(x); x += dpp_mir(x); return x; }
DI float sum32(float x) { x = sum16(x); auto rr = __builtin_amdgcn_permlane16_swap(__float_as_uint(x), __float_as_uint(x), false, false); return __uint_as_float(rr[0]) + __uint_as_float(rr[1]); }
DI float sum64(float x) { x = sum32(x); auto rr = __builtin_amdgcn_permlane32_swap(__float_as_uint(x), __float_as_uint(x), false, false); return __uint_as_float(rr[0]) + __uint_as_float(rr[1]); }
DI float rcp_(float x) { return __builtin_amdgcn_rcpf(x); }
DI float rsq_(float x) { return __builtin_amdgcn_rsqf(x); }
DI float exp2_(float x) { return __builtin_amdgcn_exp2f(x); }
DI float gelu_tanh(float x) { const float u = x * (1.5957691216057308f + 0.07135481627159768f * x * x); return x * rcp_(1.0f + exp2_(-LOG2E * u)); }
DI float sigmoidf_(float x) { return rcp_(1.0f + exp2_(-LOG2E * x)); }
#define XB_TMO      128
#define XB_XCNT(j)  (256  + 64 * (j))
#define XB_XSUB(j)  (1280 + 64 * (j))
#define XB_XGEN(j)  (2304 + 64 * (j))
#define XB_TOP      3328
#define XB_TOPGEN   3392
#define XCD_BAR_WORDS 3456
#define XB_SPIN_CAP (1u << 18)

__device__ __forceinline__ unsigned xb_ld(unsigned* p)              { return __hip_atomic_load(p, __ATOMIC_RELAXED, __HIP_MEMORY_SCOPE_AGENT); }
__device__ __forceinline__ unsigned xb_add(unsigned* p, unsigned v) { return __hip_atomic_fetch_add(p, v, __ATOMIC_RELAXED, __HIP_MEMORY_SCOPE_AGENT); }
__device__ __forceinline__ unsigned xb_xcc_id() { return (unsigned)__builtin_amdgcn_s_getreg((3 << 11) | 20) & 0xFu; }
#define XB_SPIN(cond, bar) do { unsigned _sp = 0; while (cond) { __builtin_amdgcn_s_sleep(1); \
    if ((++_sp & 255u) == 0u) { if (xb_ld(&(bar)[XB_TMO])) break; if (_sp > XB_SPIN_CAP) { atomicAdd(&(bar)[XB_TMO], 1u); break; } } } } while (0)

struct XcdBarrier {
    unsigned* bar; unsigned x;
    volatile LAS unsigned* st;
};

__device__ __forceinline__ XcdBarrier xcd_barrier_post(unsigned* bar, volatile LAS unsigned* st) {
    XcdBarrier b; b.bar = bar; b.x = xb_xcc_id(); b.st = st;
    if (threadIdx.x == 0) (void)xb_add(&bar[XB_XCNT(b.x)], 1u);
    return b;
}
__device__ __forceinline__ void xcd_barrier_complete(unsigned* bar, unsigned x, unsigned& nloc, unsigned& nx) {
    const unsigned G = gridDim.x * gridDim.y * gridDim.z;
    unsigned sum, cnt, mine, sp = 0u;
    for (;;) {
        sum = 0u; cnt = 0u; mine = 0u;
#pragma unroll
        for (unsigned j = 0; j < 16; ++j) { const unsigned c = xb_ld(&bar[XB_XCNT(j)]); sum += c; cnt += (c > 0u) ? 1u : 0u; mine = (j == x) ? c : mine; }
        if (sum == G) break;
        __builtin_amdgcn_s_sleep(1);
        if ((++sp & 255u) == 0u) { if (xb_ld(&bar[XB_TMO])) break; if (sp > XB_SPIN_CAP) { atomicAdd(&bar[XB_TMO], 1u); break; } }
    }
    nloc = mine > 0u ? mine : 1u; nx = cnt > 0u ? cnt : 1u;
}

__device__ __forceinline__ void xcd_barrier(const XcdBarrier& b) {
    asm volatile("s_waitcnt vmcnt(0)" ::: "memory");
    __syncthreads();
    if (threadIdx.x == 0) {
        unsigned* bar = b.bar;
        __builtin_amdgcn_s_waitcnt(0);
        unsigned nloc = b.st[0], nx = b.st[1];
        if (nloc == 0u) { xcd_barrier_complete(bar, b.x, nloc, nx); b.st[0] = nloc; b.st[1] = nx; }
        const unsigned old = xb_add(&bar[XB_XSUB(b.x)], 1u);
        const unsigned gen = old / nloc;
        if (old + 1u == (gen + 1u) * nloc) {
            __builtin_amdgcn_fence(__ATOMIC_RELEASE, "agent");
            asm volatile("s_waitcnt vmcnt(0)" ::: "memory");
            const unsigned og = xb_add(&bar[XB_TOP], 1u);
            const unsigned tg = og / nx;
            if (og + 1u == (tg + 1u) * nx) xb_add(&bar[XB_TOPGEN], 1u);
            else XB_SPIN(xb_ld(&bar[XB_TOPGEN]) == tg, bar);
            __builtin_amdgcn_fence(__ATOMIC_ACQUIRE, "agent");
            xb_add(&bar[XB_XGEN(b.x)], 1u);
            asm volatile("s_waitcnt vmcnt(0)" ::: "memory");
        } else {
            XB_SPIN(xb_ld(&bar[XB_XGEN(b.x)]) == gen, bar);
            __builtin_amdgcn_fence(__ATOMIC_ACQUIRE, "agent");
            asm volatile("s_waitcnt vmcnt(0)" ::: "memory");
        }
    }
    __syncthreads();
}
struct Args { const float* in[26]; float* out; unsigned char* ws; int ph_lo, ph_hi, li, pad; };
struct Frame {
    LAS unsigned char* lds;
    volatile LAS unsigned* MISC;
    gu32* ctl;
    int tid, lane, wave, vcu, G;
    const Args* A; float* out; unsigned char* ws;
    DI const float* in(int k) const { return A->in[k]; }
    template <class T> DI T* wsp(size_t off) const { return (T*)(ws + off); }
};

DI void p0_transpose_item(const float* W, int K, int N, bf16* WT, LAS float* scr, int item, int lane, const float* g0, const float* g1, int gsplit) {
    const int nblk = N / 32, kb = item / nblk, nb = item % nblk, k0 = 64 * kb, n0 = 32 * nb;
#pragma unroll 8
    for (int i = 0; i < 32; ++i) { const int kk = 2 * i + (lane >> 5); const int k = k0 + kk;
        float g = 1.f; if (g0) g = (k < gsplit) ? g0[k] : g1[k - gsplit];
        scr[kk * 33 + (lane & 31)] = W[(size_t)k * N + n0 + (lane & 31)] * g; }
    LDS_WAIT(); asm volatile("" ::: "memory");
    const int c = lane & 7;
#pragma unroll
    for (int j = 0; j < 4; ++j) { const int n = (lane >> 3) + 8 * j; const LAS float* s = scr + (8 * c) * 33 + n;
        v4u o; o.x = pk2(s[0 * 33], s[1 * 33]); o.y = pk2(s[2 * 33], s[3 * 33]); o.z = pk2(s[4 * 33], s[5 * 33]); o.w = pk2(s[6 * 33], s[7 * 33]);
        *(GAS v4u*)(WT + (size_t)(n0 + n) * K + k0 + 8 * c) = o; }
    LDS_WAIT(); asm volatile("" ::: "memory");
}
template <bool NORM> DI void row_to_bf16(const float* xrow, bf16* orow, const float* gain, int lane) {
    const GAS f32x4* xr = (const GAS f32x4*)xrow + lane;
    f32x4 v[4]; float s = 0.f;
#pragma unroll
    for (int j = 0; j < 4; ++j) { v[j] = xr[64 * j]; s += (v[j].x * v[j].x + v[j].y * v[j].y) + (v[j].z * v[j].z + v[j].w * v[j].w); }
    float rstd = 1.f;
    if (NORM) rstd = 1.0f / sqrtf(sum64(s) * (1.f / 1024.f) + EPS);
    GAS v2u* o8 = (GAS v2u*)orow + lane;
#pragma unroll
    for (int j = 0; j < 4; ++j) { f32x4 w = v[j] * rstd; if (gain) w = w * ((const GAS f32x4*)gain)[64 * j + lane];
        v2u o; o.x = pk2(w.x, w.y); o.y = pk2(w.z, w.w); o8[64 * j] = o; }
}
constexpr float U_SCALE = 128.f, V_SCALE = 16.f;
DI void row_to_fp8(const float* src, unsigned char* dst, const float* gain, float scale, int lane) {
#pragma unroll
    for (int j = 0; j < 4; ++j) { f32x4 v = ((const GAS f32x4*)src)[64 * j + lane] * scale; if (gain) v = v * ((const GAS f32x4*)gain)[64 * j + lane];
        unsigned w = 0u; w = __builtin_amdgcn_cvt_pk_fp8_f32(v.x, v.y, w, false); w = __builtin_amdgcn_cvt_pk_fp8_f32(v.z, v.w, w, true);
        ((GAS unsigned*)dst)[64 * j + lane] = w; }
}
DI void p0_prologue(Frame& F) {
    LAS float* scr = (LAS float*)(F.lds + F.wave * 16384);
    const int gw = F.vcu * NWAVES + F.wave, NGW = F.G * NWAVES, lane = F.lane;
    constexpr int I_IN = 16 * (INW / 32), I_D = 16 * (DM / 32), I_2D = 16 * (2 * DM / 32);
    constexpr int NITEMS = I_IN + 3 * I_D + 2 * I_2D;
    for (int it = gw; it < NITEMS; it += NGW) {
        int r = it;
        if (r < I_IN) { p0_transpose_item(F.in(3), DM, INW, F.wsp<bf16>(WS_WIN), scr, r, lane, F.in(2), F.in(2), DM); continue; } r -= I_IN;
        if (r < I_D) { p0_transpose_item(F.in(14), DM, DM, F.wsp<bf16>(WS_WOUT), scr, r, lane, F.in(12), F.in(13), LRUW); continue; } r -= I_D;
        if (r < I_D) { p0_transpose_item(F.in(17), DM, DM, F.wsp<bf16>(WS_WQ), scr, r, lane, F.in(15), F.in(15), DM); continue; } r -= I_D;
        if (r < I_2D) { p0_transpose_item(F.in(18), DM, 2 * DM, F.wsp<bf16>(WS_WKV), scr, r, lane, nullptr, nullptr, 0); continue; } r -= I_2D;
        if (r < I_D) { p0_transpose_item(F.in(19), DM, DM, F.wsp<bf16>(WS_WO), scr, r, lane, nullptr, nullptr, 0); continue; } r -= I_D;
        p0_transpose_item(F.in(21), DM, 2 * DM, F.wsp<bf16>(WS_WQRY), scr, r, lane, F.in(20), F.in(20), DM);
    }
    for (int m = gw; m < M; m += NGW) row_to_bf16<true>(F.in(0) + (size_t)m * DM, F.wsp<bf16>(WS_XN) + (size_t)m * DM, nullptr, lane);
    for (int m = gw; m < NBATCH * 256; m += NGW) row_to_bf16<true>(F.in(1) + (size_t)m * DM, F.wsp<bf16>(WS_MEMN) + (size_t)m * DM, F.in(16), lane);
    for (int m = gw; m < NEXP; m += NGW) { row_to_fp8(F.in(23) + (size_t)m * DM, F.wsp<unsigned char>(WS_EU) + (size_t)m * DM, F.in(20), U_SCALE, lane);
                                            row_to_fp8(F.in(24) + (size_t)m * DM, F.wsp<unsigned char>(WS_EV) + (size_t)m * DM, nullptr, V_SCALE, lane); }
    { const int gt = gw * 64 + lane, NT = NGW * 64;
      for (int i = gt; i < 8 * 2 * 128 * 128 / 4; i += NT) { const f32x4 v = ((const GAS f32x4*)F.in(22))[i]; v2u o; o.x = pk2(v.x, v.y); o.y = pk2(v.z, v.w); ((GAS v2u*)F.wsp<bf16>(WS_SUBK))[i] = o; }
      for (int o = gt; o < 2 * 8 * 64 * 64; o += NT) { const int i = o & 63, j = (o >> 6) & 63, h = (o >> 12) & 7, g = o >> 15;
          const float* W = g ? F.in(8) : F.in(6); F.wsp<bf16>(WS_GATEW)[o] = f2bf(W[(h * 64 + i) * 64 + j]); } }
}
struct LruState { float ba[2], bx[2], sp[2], S[2], Ap[2]; };
template <bool PASS2>
DI void lru_prep(const Frame& F, int b, int chunk, int h, int lane, LAS unsigned char* xcs  , LruState& st) {
    const int r = lane & 31, hh = lane >> 5;
    const size_t row0 = (size_t)b * SEQ + (size_t)chunk * 64;
    {
        const int c2 = h * 64 + 2 * r;
        const f32x2 w0 = *(const f32x2*)(F.in(4) + c2), w1 = *(const f32x2*)(F.in(4) + LRUW + c2), w2 = *(const f32x2*)(F.in(4) + 2 * LRUW + c2), w3 = *(const f32x2*)(F.in(4) + 3 * LRUW + c2);
        const f32x2 cb = *(const f32x2*)(F.in(5) + c2);
        const int tl0 = 32 * hh;
        const bf16* zp = F.wsp<bf16>(WS_Z) + (row0 + tl0) * ZW + c2;
        const bool first = (chunk == 0 && hh == 0);
        unsigned p0 = first ? 0u : *(const unsigned*)(zp - 3 * ZW), p1 = first ? 0u : *(const unsigned*)(zp - 2 * ZW), p2 = first ? 0u : *(const unsigned*)(zp - ZW);
#pragma unroll 8
        for (int t = 0; t < 32; ++t) { const unsigned p3 = *(const unsigned*)(zp + (size_t)t * ZW);
            const float lo = cb.x + bflo(p0) * w0.x + bflo(p1) * w1.x + bflo(p2) * w2.x + bflo(p3) * w3.x;
            const float hi = cb.y + bfhi(p0) * w0.y + bfhi(p1) * w1.y + bfhi(p2) * w2.y + bfhi(p3) * w3.y;
            *(LAS unsigned*)(xcs + (tl0 + t) * 144 + 4 * r) = pk2(lo, hi);
            p0 = p1; p1 = p2; p2 = p3; }
        LDS_WAIT();
    }
#pragma unroll
    for (int nt = 0; nt < 2; ++nt) { const int c = h * 64 + 32 * nt + r; st.ba[nt] = F.in(7)[c]; st.bx[nt] = F.in(9)[c];
        const float nl = -F.in(10)[c]; st.sp[nt] = fmaxf(nl, 0.f) + log1pf(__expf(-fabsf(nl))); st.S[nt] = 0.f; st.Ap[nt] = 1.f; }
    if (PASS2) {
        float s = 0.f; const float* ag = F.wsp<float>(WS_AGG) + ((size_t)b * NCHUNK * LRUW + h * 64 + lane) * 2;
#pragma unroll 8
        for (int c = 0; c < chunk; ++c) { const f32x2 ab = *(const f32x2*)(ag + (size_t)c * LRUW * 2); s = ab.x * s + ab.y; }
        st.S[0] = __shfl(s, r); st.S[1] = __shfl(s, 32 + r);
    }
}
template <bool PASS2>
DI void lru_tile(const Frame& F, int b, int chunk, int mt, int h, int lane, LAS unsigned char* xcs, LAS unsigned char* gim  , LruState& st, float (&ssq)[16]) {
    const int r = lane & 31, hh = lane >> 5;
    const size_t row0 = (size_t)b * SEQ + (size_t)chunk * 64;
    const bf16* gw = F.wsp<bf16>(WS_GATEW) + (size_t)h * 4096;
    bf16x8 af[4];
#pragma unroll
    for (int s = 0; s < 4; ++s) af[s] = *(const LAS bf16x8*)(xcs + (32 * mt + r) * 144 + (16 * s + 8 * hh) * 2);
    float ssl[16];
#pragma unroll
    for (int i = 0; i < 16; ++i) ssl[i] = 0.f;
    if (PASS2) {
#pragma unroll
        for (int i = 0; i < 4; ++i) { const int row = (lane >> 3) + 8 * i, c = lane & 7;
            *(LAS v4u*)(gim + row * 144 + c * 16) = *(const v4u*)(F.wsp<bf16>(WS_Z) + (row0 + 32 * mt + row) * ZW + LRUW + h * 64 + 8 * c); }
        LDS_WAIT();
    }
#pragma unroll
    for (int nt = 0; nt < 2; ++nt) {
        asm volatile("" ::: "memory");
        f32x16 aa = {}, ax = {};
#pragma unroll
        for (int s = 0; s < 4; ++s) {
            const bf16x8 wa = *(const bf16x8*)(gw + (size_t)(32 * nt + r) * 64 + 16 * s + 8 * hh);
            const bf16x8 wx = *(const bf16x8*)(gw + 32768 + (size_t)(32 * nt + r) * 64 + 16 * s + 8 * hh);
            aa = MFMA32(af[s], wa, aa); ax = MFMA32(af[s], wx, ax);
        }
        float gt[16];
        if (PASS2) {
#pragma unroll
            for (int i = 0; i < 16; ++i) gt[i] = bf2f(*(const LAS bf16*)(gim + crow(i, hh) * 144 + (32 * nt + r) * 2));
        }
#pragma unroll
        for (int i = 0; i < 16; ++i) {
            const float rg = sigmoidf_(aa[i] + st.ba[nt]), ig = sigmoidf_(ax[i] + st.bx[nt]);
            const float la = -8.0f * rg * st.sp[nt];
            const float a = exp2_(LOG2E * la);
            const float mult = __builtin_amdgcn_sqrtf(fmaxf(1.0f - a * a, 0.f));
            const float xc = bf2f(*(const LAS bf16*)(xcs + (32 * mt + crow(i, hh)) * 144 + (32 * nt + r) * 2));
            aa[i] = a; ax[i] = mult * ig * xc;
        }
        float Ao[4], Bo[4], Aq[4], Bq[4], Sin[4];
#pragma unroll
        for (int q = 0; q < 4; ++q) { const float a0 = aa[4 * q], a1 = aa[4 * q + 1], a2 = aa[4 * q + 2], a3 = aa[4 * q + 3];
            Ao[q] = (a0 * a1) * (a2 * a3); Bo[q] = ((ax[4 * q] * a1 + ax[4 * q + 1]) * a2 + ax[4 * q + 2]) * a3 + ax[4 * q + 3];
            Aq[q] = swap32_partner(Ao[q], hh); Bq[q] = swap32_partner(Bo[q], hh); }
        float s_ = st.S[nt];
#pragma unroll
        for (int q = 0; q < 4; ++q) { const float A1 = hh ? Aq[q] : Ao[q], B1 = hh ? Bq[q] : Bo[q], A2 = hh ? Ao[q] : Aq[q], B2 = hh ? Bo[q] : Bq[q];
            const float smid = A1 * s_ + B1; Sin[q] = hh ? smid : s_; s_ = A2 * smid + B2; st.Ap[nt] *= A1 * A2; }
        st.S[nt] = s_;
        if (PASS2) {
#pragma unroll
            for (int q = 0; q < 4; ++q) { float hp = Sin[q];
#pragma unroll
                for (int e = 0; e < 4; ++e) { const int i = 4 * q + e; hp = aa[i] * hp + ax[i];
                    const float y = hp * gelu_tanh(gt[i]); ssl[i] += y * y;
                    *(LAS bf16*)(xcs + (32 * mt + crow(i, hh)) * 144 + (32 * nt + r) * 2) = f2bf(y); } }
        }
    }
    if (PASS2) {
#pragma unroll
        for (int i = 0; i < 16; ++i) ssq[i] = sum32(ssl[i]);
    }
}
DI void attn_wave(const Frame& F, int b, int n, int qt, int h, int lane, const LAS float* tab, f32x16 (&o)[2]) {
    const int r = lane & 31, hh = lane >> 5;
    const size_t row0 = (size_t)b * SEQ + (size_t)n * 64;
    const float SC = 0.125f * LOG2E;
    bf16x8 qf[4];
#pragma unroll
    for (int s = 0; s < 4; ++s) qf[s] = *(const bf16x8*)(F.wsp<bf16>(WS_Z) + (row0 + 32 * qt + r) * ZW + 2 * LRUW + h * 64 + 16 * s + 8 * hh);
    float mrun = -1e30f, lrun = 0.f;
#pragma unroll
    for (int dt = 0; dt < 2; ++dt) o[dt] = f32x16{};
    const float bfar = tab[256];
    const bf16* vtb = F.wsp<bf16>(WS_VT) + ((size_t)(b * 8 + h) * 64 + r) * SEQ + 4 * hh;
    for (int kc = (n >= 8 ? n - 8 : 0); kc <= n; ++kc) {
        const size_t krow0 = (size_t)b * SEQ + (size_t)kc * 64;
        const int dd = n - kc;
        bf16x8 kf[2][4];
#pragma unroll
        for (int kt = 0; kt < 2; ++kt)
#pragma unroll
            for (int s = 0; s < 4; ++s) kf[kt][s] = *(const bf16x8*)(F.wsp<bf16>(WS_Z) + (krow0 + 32 * kt + r) * ZW + 2 * LRUW + ATTW + h * 64 + 16 * s + 8 * hh);
        bf16x8 vf[2][2][2];
#pragma unroll
        for (int dt = 0; dt < 2; ++dt)
#pragma unroll
            for (int kt = 0; kt < 2; ++kt)
#pragma unroll
                for (int s2 = 0; s2 < 2; ++s2) { const bf16* p = vtb + (size_t)(32 * dt) * SEQ + kc * 64 + 32 * kt + 16 * s2;
                    const v2u lo = *(const v2u*)p, hi = *(const v2u*)(p + 8); v4u w; w.x = lo.x; w.y = lo.y; w.z = hi.x; w.w = hi.y; vf[dt][kt][s2] = __builtin_bit_cast(bf16x8, w); }
        f32x16 sc[2];
#pragma unroll
        for (int kt = 0; kt < 2; ++kt) { sc[kt] = f32x16{};
#pragma unroll
            for (int s = 0; s < 4; ++s) sc[kt] = MFMA32(kf[kt][s], qf[s], sc[kt]); }
        if (dd >= 3) {
#pragma unroll
            for (int kt = 0; kt < 2; ++kt)
#pragma unroll
                for (int i = 0; i < 16; ++i) sc[kt][i] = sc[kt][i] * SC + bfar;
        } else {
            const int base = 64 * dd + 32 * qt + r + 128;
#pragma unroll
            for (int kt = 0; kt < 2; ++kt)
#pragma unroll
                for (int i = 0; i < 16; ++i) { int idx = base - (32 * kt + crow(i, hh)); idx = idx > 256 ? 256 : idx; sc[kt][i] = sc[kt][i] * SC + tab[idx]; }
        }
        float mx = sc[0][0];
#pragma unroll
        for (int kt = 0; kt < 2; ++kt)
#pragma unroll
            for (int i = 0; i < 16; ++i) mx = fmaxf(mx, sc[kt][i]);
        mx = fmaxf(mx, swap32_partner(mx, hh));
        const float mnew = fmaxf(mrun, mx), alpha = exp2_(mrun - mnew);
        float ls = 0.f;
#pragma unroll
        for (int kt = 0; kt < 2; ++kt)
#pragma unroll
            for (int i = 0; i < 16; ++i) { const float p = exp2_(sc[kt][i] - mnew); sc[kt][i] = p; ls += p; }
        lrun = lrun * alpha + ls; mrun = mnew;
#pragma unroll
        for (int dt = 0; dt < 2; ++dt)
#pragma unroll
            for (int i = 0; i < 16; ++i) o[dt][i] *= alpha;
#pragma unroll
        for (int kt = 0; kt < 2; ++kt)
#pragma unroll
            for (int s2 = 0; s2 < 2; ++s2) { v4u w; w.x = pk2(sc[kt][8 * s2], sc[kt][8 * s2 + 1]); w.y = pk2(sc[kt][8 * s2 + 2], sc[kt][8 * s2 + 3]); w.z = pk2(sc[kt][8 * s2 + 4], sc[kt][8 * s2 + 5]); w.w = pk2(sc[kt][8 * s2 + 6], sc[kt][8 * s2 + 7]);
                const bf16x8 pf = __builtin_bit_cast(bf16x8, w);
#pragma unroll
                for (int dt = 0; dt < 2; ++dt) o[dt] = MFMA32(vf[dt][kt][s2], pf, o[dt]); }
    }
    const float lt = lrun + swap32_partner(lrun, hh); const float inv = rcp_(lt);
#pragma unroll
    for (int dt = 0; dt < 2; ++dt)
#pragma unroll
        for (int i = 0; i < 16; ++i) o[dt][i] *= inv;
}

DI void p2_lru_aggregates(Frame& F) {
    const int lane = F.lane, r = lane & 31, hh = lane >> 5, h = F.wave;
    LAS unsigned char* xcs = F.lds + 20480 + h * 13824;
    for (int u = F.vcu; u < NBATCH * NCHUNK; u += F.G) {
        const int b = u / NCHUNK, n = u % NCHUNK;
        LruState st; float ssq[16];
        lru_prep<false>(F, b, n, h, lane, xcs, st);
#pragma unroll 1
        for (int mt = 0; mt < 2; ++mt) lru_tile<false>(F, b, n, mt, h, lane, xcs, xcs + 9216, st, ssq);
        if (hh == 0) {
#pragma unroll
            for (int nt = 0; nt < 2; ++nt) *(f32x2*)(F.wsp<float>(WS_AGG) + (((size_t)b * NCHUNK + n) * LRUW + h * 64 + 32 * nt + r) * 2) = (f32x2){st.Ap[nt], st.S[nt]};
        }
        LDS_WAIT();
    }
}
DI void p3_mixer(Frame& F) {
    const int lane = F.lane, r = lane & 31, hh = lane >> 5, h = F.wave;
    LAS float* ssx = (LAS float*)(F.lds);
    LAS float* tab = (LAS float*)(F.lds + 4096 + h * 2048);
    LAS unsigned* stg = (LAS unsigned*)(F.lds + 20480 + h * 13824);
    for (int i = lane; i < 257; i += 64) tab[i] = F.in(11)[h * 257 + i] * LOG2E;
    LDS_WAIT();
    for (int u = F.vcu; u < NBATCH * NCHUNK; u += F.G) {
        const int b = u / NCHUNK, n = u % NCHUNK; const size_t row0 = (size_t)b * SEQ + (size_t)n * 64;
#ifndef MIX_PARTS
#define MIX_PARTS 3
#endif
        if (MIX_PARTS & 1) {
            LruState st;
            lru_prep<true>(F, b, n, h, lane, (LAS unsigned char*)stg, st);
#pragma unroll 1
            for (int mt = 0; mt < 2; ++mt) {
                float ssq[16];
                lru_tile<true>(F, b, n, mt, h, lane, (LAS unsigned char*)stg, (LAS unsigned char*)stg + 9216, st, ssq);
                if (r == 0) {
#pragma unroll
                    for (int i = 0; i < 16; ++i) ssx[crow(i, hh) * 8 + h] = ssq[i];
                }
                __syncthreads();
                const LAS unsigned char* yst = (const LAS unsigned char*)stg + 32 * mt * 144;
#pragma unroll
                for (int i = 0; i < 4; ++i) { const int row = (lane >> 3) + 8 * i, c = lane & 7;
                    const f32x4 s0 = *(const LAS f32x4*)(ssx + row * 8), s1 = *(const LAS f32x4*)(ssx + row * 8 + 4);
                    const float rs = rsq_(((s0.x + s0.y) + (s0.z + s0.w) + (s1.x + s1.y) + (s1.z + s1.w)) * (1.f / 512.f) + EPS);
                    const v4u v = *(const LAS v4u*)(yst + row * 144 + c * 16);
                    v4u o; o.x = pk2(bflo(v.x) * rs, bfhi(v.x) * rs); o.y = pk2(bflo(v.y) * rs, bfhi(v.y) * rs); o.z = pk2(bflo(v.z) * rs, bfhi(v.z) * rs); o.w = pk2(bflo(v.w) * rs, bfhi(v.w) * rs);
                    *(v4u*)(F.wsp<bf16>(WS_Y) + (row0 + 32 * mt + row) * DM + h * 64 + 8 * c) = o; }
                __syncthreads();
            }
        }
    }
    for (int u = F.vcu; u < NBATCH * NCHUNK; u += F.G) {
        const int b = u / NCHUNK, n = u % NCHUNK; const size_t row0 = (size_t)b * SEQ + (size_t)n * 64;
#pragma unroll 1
        for (int qt = 0; qt < ((MIX_PARTS & 2) ? 2 : 0); ++qt) {
            f32x16 o[2];
            attn_wave(F, b, n, qt, h, lane, tab, o);
            float s = 0.f;
#pragma unroll
            for (int dt = 0; dt < 2; ++dt)
#pragma unroll
                for (int i = 0; i < 16; ++i) s += o[dt][i] * o[dt][i];
            s += swap32_partner(s, hh);
            if (hh == 0) ssx[r * 8 + h] = s;
            __syncthreads();
            { const f32x4 s0 = *(const LAS f32x4*)(ssx + r * 8), s1 = *(const LAS f32x4*)(ssx + r * 8 + 4);
              const float rs = rsq_(((s0.x + s0.y) + (s0.z + s0.w) + (s1.x + s1.y) + (s1.z + s1.w)) * (1.f / 512.f) + EPS);
#pragma unroll
              for (int dt = 0; dt < 2; ++dt)
#pragma unroll
                  for (int i = 0; i < 16; i += 2) stg[r * 33 + ((32 * dt + crow(i, hh)) >> 1)] = pk2(o[dt][i] * rs, o[dt][i + 1] * rs); }
            LDS_WAIT();
#pragma unroll 4
            for (int i = 0; i < 16; ++i) { const int row = 2 * i + hh; const unsigned v = stg[row * 33 + r];
                *(GAS unsigned*)(F.wsp<bf16>(WS_Y) + (row0 + 32 * qt + row) * DM + LRUW + h * 64 + 2 * r) = v; }
            __syncthreads();
        }
    }
}
DI void p5_cross(Frame& F) {
    const int lane = F.lane, r = lane & 31, hh = lane >> 5, w = F.wave, tid = F.tid;
    constexpr int KST = 528, VST = 520;
    const float SC = 0.0625f * LOG2E;
    for (int u = F.vcu; u < NBATCH * 4 * 32; u += F.G) {
        const int b = u >> 7, hm = (u >> 5) & 3, qb = u & 31;
        const size_t qrow = (size_t)b * SEQ + (size_t)qb * 256 + 32 * w + r;
        { const bf16* src = F.wsp<bf16>(WS_KM) + (size_t)(b * 256) * DM + hm * 256;
#pragma unroll 4
          for (int i = 0; i < 16; ++i) { const int c = i * 512 + tid, row = c >> 5, ch = c & 31;
              *(LAS v4u*)(F.lds + row * KST + ch * 16) = *(const v4u*)(src + (size_t)row * DM + ch * 8); } }
        __syncthreads();
        f32x16 sc[8];
#pragma unroll
        for (int kt = 0; kt < 8; ++kt) sc[kt] = f32x16{};
#pragma unroll 2
        for (int s = 0; s < 16; ++s) {
            const bf16x8 qf = *(const bf16x8*)(F.wsp<bf16>(WS_QC) + qrow * DM + hm * 256 + 16 * s + 8 * hh);
#pragma unroll
            for (int kt = 0; kt < 8; ++kt) { const bf16x8 kf = *(const LAS bf16x8*)(F.lds + (32 * kt + r) * KST + (16 * s + 8 * hh) * 2); sc[kt] = MFMA32(kf, qf, sc[kt]); }
        }
        float mx = sc[0][0];
#pragma unroll
        for (int kt = 0; kt < 8; ++kt)
#pragma unroll
            for (int i = 0; i < 16; ++i) mx = fmaxf(mx, sc[kt][i]);
        mx = fmaxf(mx, swap32_partner(mx, hh));
        float ls = 0.f; const float mo = mx * SC;
        bf16x8 pf[8][2];
#pragma unroll
        for (int kt = 0; kt < 8; ++kt) {
#pragma unroll
            for (int i = 0; i < 16; ++i) { const float p = exp2_(sc[kt][i] * SC - mo); sc[kt][i] = p; ls += p; }
#pragma unroll
            for (int s2 = 0; s2 < 2; ++s2) { v4u wv; wv.x = pk2(sc[kt][8 * s2], sc[kt][8 * s2 + 1]); wv.y = pk2(sc[kt][8 * s2 + 2], sc[kt][8 * s2 + 3]); wv.z = pk2(sc[kt][8 * s2 + 4], sc[kt][8 * s2 + 5]); wv.w = pk2(sc[kt][8 * s2 + 6], sc[kt][8 * s2 + 7]);
                pf[kt][s2] = __builtin_bit_cast(bf16x8, wv); }
        }
        ls += swap32_partner(ls, hh);
        const float inv = 1.0f / ls;
        __syncthreads();
        { const bf16* src = F.wsp<bf16>(WS_VMT) + (size_t)((b * 4 + hm) * 256) * 256;
#pragma unroll 4
          for (int i = 0; i < 16; ++i) { const int c = i * 512 + tid, row = c >> 5, ch = c & 31; const v4u v = *(const v4u*)(src + (size_t)row * 256 + ch * 8);
              LAS v2u* d = (LAS v2u*)(F.lds + row * VST + ch * 16); d[0] = (v2u){v.x, v.y}; d[1] = (v2u){v.z, v.w}; } }
        __syncthreads();
        LAS unsigned* stg = (LAS unsigned*)(F.lds) ;
#pragma unroll
        for (int half = 0; half < 2; ++half) {
            f32x16 o[4];
#pragma unroll
            for (int dt = 0; dt < 4; ++dt) o[dt] = f32x16{};
#pragma unroll
            for (int kt = 0; kt < 8; ++kt)
#pragma unroll
                for (int s2 = 0; s2 < 2; ++s2)
#pragma unroll
                    for (int dt = 0; dt < 4; ++dt) { const LAS unsigned char* p = F.lds + (128 * half + 32 * dt + r) * VST + (32 * kt + 16 * s2 + 4 * hh) * 2;
                        const v2u lo = *(const LAS v2u*)p, hi = *(const LAS v2u*)(p + 16); v4u wv; wv.x = lo.x; wv.y = lo.y; wv.z = hi.x; wv.w = hi.y;
                        o[dt] = MFMA32(__builtin_bit_cast(bf16x8, wv), pf[kt][s2], o[dt]); }
            if (half == 1) __syncthreads();
            else {   }
            if (half == 0) {
#pragma unroll
                for (int dt = 0; dt < 4; ++dt)
#pragma unroll
                    for (int i = 0; i < 16; i += 2) { const unsigned pv = pk2(o[dt][i] * inv, o[dt][i + 1] * inv); sc[dt][i >> 1] = __uint_as_float(pv); }
            } else {
                LAS unsigned* sw = (LAS unsigned*)(F.lds + w * 16512);
#pragma unroll
                for (int dt = 0; dt < 4; ++dt)
#pragma unroll
                    for (int i = 0; i < 16; i += 2) { sw[r * 129 + ((32 * dt + crow(i, hh)) >> 1)] = __float_as_uint(sc[dt][i >> 1]);
                        sw[r * 129 + 64 + ((32 * dt + crow(i, hh)) >> 1)] = pk2(o[dt][i] * inv, o[dt][i + 1] * inv); }
                LDS_WAIT();
#pragma unroll 4
                for (int i = 0; i < 32; ++i) { const unsigned v0 = sw[i * 129 + lane], v1 = sw[i * 129 + 64 + lane];
                    GAS unsigned* dst = (GAS unsigned*)(F.wsp<bf16>(WS_OC) + ((size_t)b * SEQ + (size_t)qb * 256 + 32 * w + i) * DM + hm * 256);
                    dst[lane] = v0; dst[64 + lane] = v1; }
            }
        }
        (void)stg;
        __syncthreads();
    }
}
template <int N> DI void ce_desc(float (&a)[N], int i, int l) { const float hi = fmaxf(a[i], a[l]), lo = fminf(a[i], a[l]); a[i] = hi; a[l] = lo; }
template <int N, int OFF> DI void bitonic_sort16_desc(float (&a)[N]) {
#pragma unroll
    for (int k = 2; k <= 16; k <<= 1)
#pragma unroll
        for (int j = k >> 1; j > 0; j >>= 1)
#pragma unroll
            for (int i = 0; i < 16; ++i) { const int l = i ^ j; if (l > i) { const bool desc = ((i & k) == 0) || (k == 16);
                if (desc) ce_desc<N>(a, OFF + i, OFF + l); else ce_desc<N>(a, OFF + l, OFF + i); } }
}
template <int N, int OFF> DI void bitonic_merge16_desc(float (&a)[N]) {
#pragma unroll
    for (int j = 8; j > 0; j >>= 1)
#pragma unroll
        for (int i = 0; i < 16; ++i) { const int l = i ^ j; if (l > i) ce_desc<N>(a, OFF + i, OFF + l); }
}
template <bool SORTED> DI void top16_of_64(float (&a)[64]) {
    bitonic_sort16_desc<64, 0>(a); bitonic_sort16_desc<64, 16>(a); bitonic_sort16_desc<64, 32>(a); bitonic_sort16_desc<64, 48>(a);
#pragma unroll
    for (int i = 0; i < 16; ++i) { a[i] = fmaxf(a[i], a[31 - i]); a[32 + i] = fmaxf(a[32 + i], a[63 - i]); }
    bitonic_merge16_desc<64, 0>(a); bitonic_merge16_desc<64, 32>(a);
#pragma unroll
    for (int i = 0; i < 16; ++i) a[i] = fmaxf(a[i], a[47 - i]);
    if (SORTED) bitonic_merge16_desc<64, 0>(a);
}
DI void p8a_topk(Frame& F) {
    const int lane = F.lane, r = lane & 31, hh = lane >> 5, w = F.wave;
    LAS float* tbl = (LAS float*)(F.lds + w * 8192);
    const int gw = F.vcu * NWAVES + w, NGW = F.G * NWAVES;
    for (int task = gw; task < (M / 32) * PEER_H; task += NGW) {
        const int h = task & 7, tt = task >> 3; const size_t tok = (size_t)tt * 32 + r;
        float v[2][16];
#pragma unroll
        for (int p = 0; p < 2; ++p) {
            f32x16 sc[4];
#pragma unroll
            for (int nt = 0; nt < 4; ++nt) sc[nt] = f32x16{};
            const bf16* sk = F.wsp<bf16>(WS_SUBK) + (size_t)((h * 2 + p) * 128) * 128;
#pragma unroll 2
            for (int s = 0; s < 8; ++s) { const bf16x8 qf = *(const bf16x8*)(F.wsp<bf16>(WS_QP) + tok * 2048 + h * 256 + p * 128 + 16 * s + 8 * hh);
#pragma unroll
                for (int nt = 0; nt < 4; ++nt) { const bf16x8 kf = *(const bf16x8*)(sk + (size_t)(32 * nt + r) * 128 + 16 * s + 8 * hh); sc[nt] = MFMA32(kf, qf, sc[nt]); } }
            float a[64];
#pragma unroll
            for (int nt = 0; nt < 4; ++nt)
#pragma unroll
                for (int i = 0; i < 16; ++i) a[nt * 16 + i] = __uint_as_float((__float_as_uint(sc[nt][i]) & ~127u) | (unsigned)(32 * nt + crow(i, hh)));
            top16_of_64<true>(a);
            float m[16];
#pragma unroll
            for (int i = 0; i < 16; ++i) m[i] = fmaxf(a[i], swap32_partner(a[15 - i], hh));
            bitonic_merge16_desc<16, 0>(m);
#pragma unroll
            for (int i = 0; i < 16; ++i) v[p][i] = m[i];
        }
        float c[64]; int n = 0;
#pragma unroll
        for (int i = 0; i < 16; ++i)
#pragma unroll
            for (int j = 0; j < 16; ++j) if ((i + 1) * (j + 1) <= 16) { c[n] = __uint_as_float((__float_as_uint(v[0][i] + v[1][j]) & ~255u) | (unsigned)((i << 4) | j)); ++n; }
#pragma unroll
        for (int k = 50; k < 64; ++k) c[k] = -3.0e38f;
        top16_of_64<false>(c);
#pragma unroll
        for (int i = 0; i < 16; ++i) { tbl[i * 64 + lane] = v[0][i]; tbl[(16 + i) * 64 + lane] = v[1][i]; }
        LDS_WAIT();
        float sv[16]; int ev[16]; float mx = -3.0e38f;
#pragma unroll
        for (int k = 0; k < 16; ++k) { const unsigned pl = __float_as_uint(c[k]) & 255u; const float a1 = tbl[(pl >> 4) * 64 + lane], a2 = tbl[(16 + (pl & 15)) * 64 + lane];
            sv[k] = a1 + a2; ev[k] = (int)(((__float_as_uint(a1) & 127u) << 7) | (__float_as_uint(a2) & 127u)); mx = fmaxf(mx, sv[k]); }
        float sum = 0.f;
#pragma unroll
        for (int k = 0; k < 16; ++k) { sv[k] = __expf(sv[k] - mx); sum += sv[k]; }
        const float inv = 1.0f / sum;
        if (hh == 0) {
#pragma unroll
            for (int k = 0; k < 16; k += 4) *(v4u*)(F.wsp<int>(WS_IDX) + tok * NSEL + h * 16 + k) = (v4u){(unsigned)ev[k], (unsigned)ev[k + 1], (unsigned)ev[k + 2], (unsigned)ev[k + 3]};
        } else {
#pragma unroll
            for (int k = 0; k < 16; k += 4) *(f32x4*)(F.wsp<float>(WS_G) + tok * NSEL + h * 16 + k) = (f32x4){sv[k] * inv, sv[k + 1] * inv, sv[k + 2] * inv, sv[k + 3] * inv};
        }
        LDS_WAIT();
    }
}
typedef _Float16 f16x2_t __attribute__((ext_vector_type(2)));
constexpr float U_UNSCALE = 1.f / 128.f, V_UNSCALE = 1.f / 16.f;
DI float dot2_(bf16x2_t a, unsigned b, float s) { return __builtin_amdgcn_fdot2_f32_bf16(a, __builtin_bit_cast(bf16x2_t, b), s, false); }
DI float dot16_u8(const v4u& u, const unsigned (&x)[8]) {
    const unsigned u0 = u.x, u1 = u.y, u2 = u.z, u3 = u.w;
    float a = 0.f, b = 0.f;
    a = dot2_(__builtin_amdgcn_cvt_scalef32_pk_bf16_fp8(u0, U_UNSCALE, false), x[0], a); b = dot2_(__builtin_amdgcn_cvt_scalef32_pk_bf16_fp8(u0, U_UNSCALE, true), x[1], b);
    a = dot2_(__builtin_amdgcn_cvt_scalef32_pk_bf16_fp8(u1, U_UNSCALE, false), x[2], a); b = dot2_(__builtin_amdgcn_cvt_scalef32_pk_bf16_fp8(u1, U_UNSCALE, true), x[3], b);
    a = dot2_(__builtin_amdgcn_cvt_scalef32_pk_bf16_fp8(u2, U_UNSCALE, false), x[4], a); b = dot2_(__builtin_amdgcn_cvt_scalef32_pk_bf16_fp8(u2, U_UNSCALE, true), x[5], b);
    a = dot2_(__builtin_amdgcn_cvt_scalef32_pk_bf16_fp8(u3, U_UNSCALE, false), x[6], a); b = dot2_(__builtin_amdgcn_cvt_scalef32_pk_bf16_fp8(u3, U_UNSCALE, true), x[7], b);
    return a + b;
}
DI f16x2_t cvt_f16x2_fp8(unsigned v, float scale, bool hi) { return hi ? __builtin_bit_cast(f16x2_t, __builtin_amdgcn_cvt_scalef32_pk_f16_fp8(v, scale, true)) : __builtin_bit_cast(f16x2_t, __builtin_amdgcn_cvt_scalef32_pk_f16_fp8(v, scale, false)); }
DI void axpy16_v8(f16x2_t (&o)[8], float w, const v4u& v) {
    const unsigned v0 = v.x, v1 = v.y, v2 = v.z, v3 = v.w;
    const f16x2_t w2 = {(_Float16)w, (_Float16)w};
    o[0] = __builtin_elementwise_fma(cvt_f16x2_fp8(v0, V_UNSCALE, false), w2, o[0]); o[1] = __builtin_elementwise_fma(cvt_f16x2_fp8(v0, V_UNSCALE, true), w2, o[1]);
    o[2] = __builtin_elementwise_fma(cvt_f16x2_fp8(v1, V_UNSCALE, false), w2, o[2]); o[3] = __builtin_elementwise_fma(cvt_f16x2_fp8(v1, V_UNSCALE, true), w2, o[3]);
    o[4] = __builtin_elementwise_fma(cvt_f16x2_fp8(v2, V_UNSCALE, false), w2, o[4]); o[5] = __builtin_elementwise_fma(cvt_f16x2_fp8(v2, V_UNSCALE, true), w2, o[5]);
    o[6] = __builtin_elementwise_fma(cvt_f16x2_fp8(v3, V_UNSCALE, false), w2, o[6]); o[7] = __builtin_elementwise_fma(cvt_f16x2_fp8(v3, V_UNSCALE, true), w2, o[7]);
}
constexpr int TPW = 4, NSLICE = 16, SLICE_SHIFT = 10, NPAIR = TPW * NSEL, NPAIR_PAD = NPAIR + 3 * TPW * NSLICE + 32;
constexpr int PEER_LDS_PER_WAVE = TPW * 2048 + TPW * 2048 + NPAIR_PAD * 4;
static_assert(PEER_LDS_PER_WAVE * NWAVES <= RING_BYTES, "PEER LDS");
DI int incl_scan64(int v, int lane) {
    int s = v;
#pragma unroll
    for (int d = 1; d < 64; d <<= 1) { const int t = __shfl_up(s, d); if (lane >= d) s += t; }
    return s;
}
struct PeerBatch { v4u uu[4], vv[4]; unsigned ent[4]; };
DI void peer_load_batch(PeerBatch& B, const LAS unsigned* ml, int i, const unsigned char* EU8, const unsigned char* EV8, int lane, unsigned emask = 0x3fffu) {
    const v4u e4 = *(const LAS v4u*)(ml + i);
    B.ent[0] = (unsigned)__builtin_amdgcn_readfirstlane((int)e4.x); B.ent[1] = (unsigned)__builtin_amdgcn_readfirstlane((int)e4.y);
    B.ent[2] = (unsigned)__builtin_amdgcn_readfirstlane((int)e4.z); B.ent[3] = (unsigned)__builtin_amdgcn_readfirstlane((int)e4.w);
#pragma unroll
    for (int k = 0; k < 4; ++k) { const size_t off = (size_t)(B.ent[k] & emask) * DM + 16 * lane; B.uu[k] = *(const v4u*)(EU8 + off); B.vv[k] = *(const v4u*)(EV8 + off); }
}
struct PeerState { unsigned x[8]; f16x2_t oc[8]; int curj; };
DI void peer_flush(PeerState& S, LAS unsigned char* ol, int lane) {
    LAS v4u* r = (LAS v4u*)(ol + S.curj * 2048) + lane;
#pragma unroll
    for (int c = 0; c < 2; ++c) { const v4u v = r[64 * c]; v4u o;
        o.x = __builtin_bit_cast(unsigned, __builtin_bit_cast(f16x2_t, (unsigned)v.x) + S.oc[4 * c]); o.y = __builtin_bit_cast(unsigned, __builtin_bit_cast(f16x2_t, (unsigned)v.y) + S.oc[4 * c + 1]);
        o.z = __builtin_bit_cast(unsigned, __builtin_bit_cast(f16x2_t, (unsigned)v.z) + S.oc[4 * c + 2]); o.w = __builtin_bit_cast(unsigned, __builtin_bit_cast(f16x2_t, (unsigned)v.w) + S.oc[4 * c + 3]);
        r[64 * c] = o; }
#pragma unroll
    for (int i = 0; i < 8; ++i) S.oc[i] = (f16x2_t){(_Float16)0.f, (_Float16)0.f};
}
DI void peer_compute_batch(const PeerBatch& B, PeerState& S, LAS unsigned char* ol, const LAS unsigned char* xl, int lane) {
    const int j = (int)((B.ent[0] >> 14) & 3u);
    if (j != S.curj) {
        if (S.curj >= 0) peer_flush(S, ol, lane);
        S.curj = j;
        const v4u y0 = ((const LAS v4u*)(xl + j * 2048))[lane], y1 = ((const LAS v4u*)(xl + j * 2048))[64 + lane];
        S.x[0] = y0.x; S.x[1] = y0.y; S.x[2] = y0.z; S.x[3] = y0.w; S.x[4] = y1.x; S.x[5] = y1.y; S.x[6] = y1.z; S.x[7] = y1.w; }
    const float d0 = dot16_u8(B.uu[0], S.x), d1 = dot16_u8(B.uu[1], S.x), d2 = dot16_u8(B.uu[2], S.x), d3 = dot16_u8(B.uu[3], S.x);
    const bool b0 = lane & 1, b1 = lane & 2;
    const float r0 = (b0 ? d1 : d0) + dpp_xor1(b0 ? d0 : d1), r1 = (b0 ? d3 : d2) + dpp_xor1(b0 ? d2 : d3);
    float t = (b1 ? r1 : r0) + dpp_xor2(b1 ? r0 : r1);
    t += __int_as_float(__builtin_amdgcn_update_dpp(0, __float_as_int(t), 0x124, 0xf, 0xf, true));
    t += __int_as_float(__builtin_amdgcn_update_dpp(0, __float_as_int(t), 0x128, 0xf, 0xf, true));
    { auto rr = __builtin_amdgcn_permlane16_swap(__float_as_uint(t), __float_as_uint(t), false, false); t = __uint_as_float(rr[0]) + __uint_as_float(rr[1]); }
    { auto rr = __builtin_amdgcn_permlane32_swap(__float_as_uint(t), __float_as_uint(t), false, false); t = __uint_as_float(rr[0]) + __uint_as_float(rr[1]); }
    const float act = gelu_tanh(t);
#pragma unroll
    for (int k = 0; k < 4; ++k) { const float a = __builtin_bit_cast(float, __builtin_amdgcn_readlane(__builtin_bit_cast(int, act), k));
        axpy16_v8(S.oc, __uint_as_float(B.ent[k] & 0xffff0000u) * a, B.vv[k]); }
}
DI void p8b_peer(Frame& F, float* outp, unsigned emask = 0x3fffu) {
    const int lane = F.lane, w = F.wave;
    const int gw = F.vcu * NWAVES + w, NGW = F.G * NWAVES;
    const unsigned char* EU8 = F.wsp<unsigned char>(WS_EU); const unsigned char* EV8 = F.wsp<unsigned char>(WS_EV);
    LAS unsigned char* xl = F.lds + w * PEER_LDS_PER_WAVE;
    LAS unsigned char* ol = xl + TPW * 2048;
    LAS unsigned* ml = (LAS unsigned*)(ol + TPW * 2048);
    for (int t0 = gw * TPW; t0 < M; t0 += NGW * TPW) {
        unsigned enta[TPW], entb[TPW]; int posa[TPW], posb[TPW], sla[TPW], slb[TPW], offs[TPW];
#pragma unroll
        for (int j = 0; j < TPW; ++j) { const size_t tok = (size_t)t0 + j;
            float rstd; { const f32x4* sp = (const f32x4*)(F.wsp<float>(WS_SSQ2) + tok * 16); const f32x4 st = (sp[0] + sp[1]) + (sp[2] + sp[3]); rstd = rsq_(((st.x + st.y) + (st.z + st.w)) * (1.f / 1024.f) + EPS); }
            { const bf16* xs = F.wsp<bf16>(WS_XN) + tok * DM + 16 * lane;
              const v4u x0 = *(const v4u*)xs, x1 = *(const v4u*)(xs + 8);
              const float s = rstd; v4u y0, y1;
              y0.x = pk2(bflo(x0.x) * s, bfhi(x0.x) * s); y0.y = pk2(bflo(x0.y) * s, bfhi(x0.y) * s); y0.z = pk2(bflo(x0.z) * s, bfhi(x0.z) * s); y0.w = pk2(bflo(x0.w) * s, bfhi(x0.w) * s);
              y1.x = pk2(bflo(x1.x) * s, bfhi(x1.x) * s); y1.y = pk2(bflo(x1.y) * s, bfhi(x1.y) * s); y1.z = pk2(bflo(x1.z) * s, bfhi(x1.z) * s); y1.w = pk2(bflo(x1.w) * s, bfhi(x1.w) * s);
              ((LAS v4u*)(xl + j * 2048))[lane] = y0; ((LAS v4u*)(xl + j * 2048))[64 + lane] = y1;
              ((LAS v4u*)(ol + j * 2048))[lane] = (v4u){0u, 0u, 0u, 0u}; ((LAS v4u*)(ol + j * 2048))[64 + lane] = (v4u){0u, 0u, 0u, 0u}; }
            const int ea = F.wsp<int>(WS_IDX)[tok * NSEL + lane], eb = F.wsp<int>(WS_IDX)[tok * NSEL + 64 + lane];
            const float ga = F.wsp<float>(WS_G)[tok * NSEL + lane], gb = F.wsp<float>(WS_G)[tok * NSEL + 64 + lane];
            const int sa = ea >> SLICE_SHIFT, sb = eb >> SLICE_SHIFT;
            int pa = 0, pb = 0, myoff = 0;
#pragma unroll
            for (int bk = 0; bk < NSLICE; ++bk) { const unsigned long long ma = __ballot(sa == bk), mb = __ballot(sb == bk);
                const int ca = __popcll(ma), cb = __popcll(mb);
                const int ra = __builtin_amdgcn_mbcnt_hi((unsigned)(ma >> 32), __builtin_amdgcn_mbcnt_lo((unsigned)ma, 0)), rb = __builtin_amdgcn_mbcnt_hi((unsigned)(mb >> 32), __builtin_amdgcn_mbcnt_lo((unsigned)mb, 0));
                pa = (sa == bk) ? ra : pa; pb = (sb == bk) ? ca + rb : pb;
                myoff = (lane == bk) ? ca + cb : myoff; }
            enta[j] = (unsigned)ea | ((unsigned)j << 14) | (pk2(0.f, ga) & 0xffff0000u); entb[j] = (unsigned)eb | ((unsigned)j << 14) | (pk2(0.f, gb) & 0xffff0000u);
            posa[j] = pa; posb[j] = pb; sla[j] = sa; slb[j] = sb; offs[j] = myoff;
        }
        int cnt = 0;
#pragma unroll
        for (int j = 0; j < TPW; ++j) { const int c = __shfl(offs[j], lane >> 2); cnt = ((lane & 3) == j) ? c : cnt; }
        const int cpad = (cnt + 3) & ~3;
        const int bend = incl_scan64(cpad, lane), bstart = bend - cpad;
        const int npad = __builtin_amdgcn_readlane(bend, 63);
#pragma unroll
        for (int j = 0; j < TPW; ++j) { const int ba = __shfl(bstart, 4 * sla[j] + j), bb = __shfl(bstart, 4 * slb[j] + j);
            ml[ba + posa[j]] = enta[j]; ml[bb + posb[j]] = entb[j]; }
        { const unsigned pad = (unsigned)((lane >> 2) << SLICE_SHIFT) | ((unsigned)(lane & 3) << 14);
#pragma unroll
          for (int q = 0; q < 3; ++q) if (cnt + q < cpad) ml[bstart + cnt + q] = pad; }
        if (lane < 28) ml[npad + lane] = (unsigned)((NSLICE - 1) << SLICE_SHIFT) | (3u << 14);
        LDS_WAIT();
        PeerState S;
#pragma unroll
        for (int i = 0; i < 8; ++i) { S.x[i] = 0u; S.oc[i] = (f16x2_t){(_Float16)0.f, (_Float16)0.f}; }
        S.curj = -1;
        PeerBatch A, B, C, D;
        peer_load_batch(A, ml, 0, EU8, EV8, lane, emask); peer_load_batch(B, ml, 4, EU8, EV8, lane, emask); peer_load_batch(C, ml, 8, EU8, EV8, lane, emask);
#pragma unroll 1
        for (int i = 0; i < npad; i += 16) {
            peer_load_batch(D, ml, i + 12, EU8, EV8, lane, emask); peer_compute_batch(A, S, ol, xl, lane);
            peer_load_batch(A, ml, i + 16, EU8, EV8, lane, emask); peer_compute_batch(B, S, ol, xl, lane);
            peer_load_batch(B, ml, i + 20, EU8, EV8, lane, emask); peer_compute_batch(C, S, ol, xl, lane);
            peer_load_batch(C, ml, i + 24, EU8, EV8, lane, emask); peer_compute_batch(D, S, ol, xl, lane);
        }
        peer_flush(S, ol, lane);
        LDS_WAIT();
#pragma unroll
        for (int j = 0; j < TPW; ++j) {
            const float* xr = F.out + ((size_t)t0 + j) * DM + 16 * lane; float* orow = outp + ((size_t)t0 + j) * DM + 16 * lane;
            f32x4 a[4]; float ss = 0.f;
            const v4u h0 = ((const LAS v4u*)(ol + j * 2048))[lane], h1 = ((const LAS v4u*)(ol + j * 2048))[64 + lane];
            const unsigned hw[8] = {h0.x, h0.y, h0.z, h0.w, h1.x, h1.y, h1.z, h1.w};
#pragma unroll
            for (int q = 0; q < 4; ++q) { const f16x2_t p0 = __builtin_bit_cast(f16x2_t, hw[2 * q]), p1 = __builtin_bit_cast(f16x2_t, hw[2 * q + 1]);
                a[q] = *(const f32x4*)(xr + 4 * q) + (f32x4){(float)p0.x, (float)p0.y, (float)p1.x, (float)p1.y};
                ss += (a[q].x * a[q].x + a[q].y * a[q].y) + (a[q].z * a[q].z + a[q].w * a[q].w); }
            const float rf = rsq_(sum64(ss) * (1.f / 1024.f) + EPS);
#pragma unroll
            for (int q = 0; q < 4; ++q) *(f32x4*)(orow + 4 * q) = a[q] * rf * *(const f32x4*)(F.in(25) + 16 * lane + 4 * q);
        }
        LDS_WAIT();
    }
}
constexpr int N_PHASES = 11;
__global__ void __launch_bounds__(NWAVES * 64, 2) fwd_kernel(Args args) {
    extern __shared__ __attribute__((aligned(16))) unsigned char lds[];
    Frame F;
    F.lds = (LAS unsigned char*)lds;
    F.MISC = (volatile LAS unsigned*)(F.lds + MISC_OFF);
    F.tid = threadIdx.x; F.lane = F.tid & 63; F.wave = __builtin_amdgcn_readfirstlane(F.tid >> 6);
    F.G = gridDim.x; { const int bx = blockIdx.x; F.vcu = (F.G % 8 == 0) ? (bx % 8) * (F.G / 8) + bx / 8 : bx; }
    F.A = &args; F.ws = args.ws; F.out = args.out;
    F.ctl = (gu32*)(args.ws + WS_CTL);
    for (int u = F.tid; u < (LDS_BYTES - LDSCTL_OFF) / 4; u += NWAVES * 64) ((LAS unsigned*)(F.lds + LDSCTL_OFF))[u] = 0u;
    __syncthreads();
    const bool multi = (args.ph_hi - args.ph_lo) > 1;
    XcdBarrier bar; bar.bar = (unsigned*)(F.ctl + CW_BAR) + args.li * XCD_BAR_WORDS; bar.x = 0; bar.st = nullptr;
    if (multi) bar = xcd_barrier_post((unsigned*)(F.ctl + CW_BAR) + args.li * XCD_BAR_WORDS, F.MISC + 8);
    const int lo = args.ph_lo, hi = args.ph_hi;
#ifndef PROBE_EMASK
#define PROBE_EMASK 0x3fffu
#endif
#ifndef PHASE_REPEAT
#define PHASE_REPEAT 0
#endif
#define REP(k) for (int rep_ = 0; rep_ < (((PHASE_REPEAT >> (k)) & 1) ? 2 : 1); ++rep_)
#ifndef PHASE_MASK
#define PHASE_MASK 0x7ff
#endif
#define IN(k) (((PHASE_MASK >> (k)) & 1) && lo <= (k) && (k) < hi)
#define SEAM(k) do { asm volatile("; ===SEAM " #k ::: "memory"); if (IN(k) && IN((k) + 1)) xcd_barrier(bar); } while (0)
    const int c = (int)blockIdx.x;

    if (IN(0)) REP(0) { p0_prologue(F); } SEAM(0);
    if (IN(1)) REP(1) {
        { pg8::Gemm g{F.wsp<bf16>(WS_XN), F.wsp<bf16>(WS_WIN), M, INW, DM}; pg8::StaticOrder S; S.init(M, INW, F.G, c);
          pg8::EpiSplitT E{F.wsp<bf16>(WS_Z), ZW, ZW, F.wsp<bf16>(WS_VT), ATTW, SEQ};
          pg8::gemm_phase<pg8::EpiSplitT, pg8::StaticOrder, true, true>(F.lds, g, S, E); }
        { const int nw3 = (M / 256) * (INW / 256) - 2 * F.G;
          int idx = -1; if (nw3 >= 0 && nw3 + 16 <= F.G) idx = c - nw3; else idx = (c < 16 && F.G >= 16) ? c : -1;
          if (F.G < 16) idx = -1;
          pg8::Gemm g{F.wsp<bf16>(WS_MEMN), F.wsp<bf16>(WS_WKV), NBATCH * 256, 2 * DM, DM};
          if (F.G >= 16) { pg8::OneUnit S{idx, 2, 8}; pg8::EpiSplitT E{F.wsp<bf16>(WS_KM), DM, DM, F.wsp<bf16>(WS_VMT), DM, 256};
              pg8::gemm_phase<pg8::EpiSplitT, pg8::OneUnit, false, true>(F.lds, g, S, E); }
          else { pg8::StaticOrder S; S.init(NBATCH * 256, 2 * DM, F.G, c); pg8::EpiSplitT E{F.wsp<bf16>(WS_KM), DM, DM, F.wsp<bf16>(WS_VMT), DM, 256};
              pg8::gemm_phase<pg8::EpiSplitT, pg8::StaticOrder, false, true>(F.lds, g, S, E); } }
    } SEAM(1);
    if (IN(2)) REP(2) { p2_lru_aggregates(F); } SEAM(2);
    if (IN(3)) REP(3) { p3_mixer(F); } SEAM(3);
    if (IN(4)) REP(4) {
        pg8::Gemm g{F.wsp<bf16>(WS_Y), F.wsp<bf16>(WS_WOUT), M, DM, DM}; pg8::StaticOrder S; S.init(M, DM, F.G, c);
        pg8::EpiResid E{F.in(0), F.out, F.wsp<bf16>(WS_XN), F.wsp<float>(WS_SSQ1), DM};
        pg8::gemm_phase<pg8::EpiResid, pg8::StaticOrder, true, true>(F.lds, g, S, E);
    } SEAM(4);
    if (IN(5)) REP(5) {
        pg8::Gemm g{F.wsp<bf16>(WS_XN), F.wsp<bf16>(WS_WQ), M, DM, DM}; pg8::StaticOrder S; S.init(M, DM, F.G, c);
        pg8::EpiRowScale E{F.wsp<bf16>(WS_QC), DM, F.wsp<float>(WS_SSQ1), 1.f / 1024.f, EPS};
        pg8::gemm_phase<pg8::EpiRowScale, pg8::StaticOrder, true, true>(F.lds, g, S, E);
    } SEAM(5);
    if (IN(6)) REP(6) { p5_cross(F); } SEAM(6);
    if (IN(7)) {
        pg8::Gemm g{F.wsp<bf16>(WS_OC), F.wsp<bf16>(WS_WO), M, DM, DM}; pg8::StaticOrder S; S.init(M, DM, F.G, c);
        pg8::EpiResid E{F.out, F.out, F.wsp<bf16>(WS_XN), F.wsp<float>(WS_SSQ2), DM};
        pg8::gemm_phase<pg8::EpiResid, pg8::StaticOrder, true, true>(F.lds, g, S, E);
    } SEAM(7);
    if (IN(8)) REP(8) {
        pg8::Gemm g{F.wsp<bf16>(WS_XN), F.wsp<bf16>(WS_WQRY), M, 2 * DM, DM}; pg8::StaticOrder S; S.init(M, 2 * DM, F.G, c);
        pg8::EpiRowScale E{F.wsp<bf16>(WS_QP), 2 * DM, F.wsp<float>(WS_SSQ2), 1.f / 1024.f, EPS};
        pg8::gemm_phase<pg8::EpiRowScale, pg8::StaticOrder, true, true>(F.lds, g, S, E);
    } SEAM(8);
    if (IN(9)) REP(9) { p8a_topk(F); } SEAM(9);
    if (IN(10)) { if ((PHASE_REPEAT >> 10) & 1) { p8b_peer(F, F.wsp<float>(WS_Z), PROBE_EMASK); } p8b_peer(F, F.out); }
#undef IN
#undef SEAM
}

#ifndef N_LAUNCH_MODE
#define N_LAUNCH_MODE 1
#endif
extern "C" void kernel_launch(void* const* d_in, const int* in_sizes, int n_in, void* d_out, int out_size, void* d_ws, size_t ws_size, hipStream_t stream) {
    static int grid = 0;
    if (grid == 0) {
        if (n_in != 26 || out_size != M * DM || ws_size < WS_END) { fprintf(stderr, "kernel_launch: unexpected shapes (n_in %d, out %d, ws %zu)\n", n_in, out_size, ws_size); grid = -1; return; }
        int dev = 0, cus = 0, per_cu = 0;
        if (hipGetDevice(&dev) != hipSuccess || hipDeviceGetAttribute(&cus, hipDeviceAttributeMultiprocessorCount, dev) != hipSuccess) { grid = -1; return; }
        if (hipFuncSetAttribute((const void*)fwd_kernel, hipFuncAttributeMaxDynamicSharedMemorySize, LDS_BYTES) != hipSuccess) { fprintf(stderr, "kernel_launch: hipFuncSetAttribute failed\n"); grid = -1; return; }
        if (hipOccupancyMaxActiveBlocksPerMultiprocessor(&per_cu, (const void*)fwd_kernel, NWAVES * 64, LDS_BYTES) != hipSuccess || per_cu < 1) { fprintf(stderr, "kernel_launch: occupancy query says %d blocks per CU\n", per_cu); (void)hipGetLastError(); grid = -1; return; }
        grid = cus;
    }
    if (grid < 0) return;
    (void)hipMemsetAsync((char*)d_ws + WS_CTL, 0, CTL_ZERO_BYTES, stream);
    Args a{};
    for (int i = 0; i < 26; ++i) a.in[i] = (const float*)d_in[i];
    a.out = (float*)d_out; a.ws = (unsigned char*)d_ws;
    if (N_LAUNCH_MODE == 1) { a.ph_lo = 0; a.ph_hi = N_PHASES; a.li = 0; hipLaunchKernelGGL(fwd_kernel, dim3(grid), dim3(NWAVES * 64), LDS_BYTES, stream, a); }
    else { for (int p = 0; p < N_PHASES; ++p) { a.ph_lo = p; a.ph_hi = p + 1; a.li = 0; hipLaunchKernelGGL(fwd_kernel, dim3(grid), dim3(NWAVES * 64), LDS_BYTES, stream, a); } }
}
```

```cpp
#include <hip/hip_runtime.h>
#include <cstdio>
#include <cstdint>
namespace pg8 {
#define PG8_LAS __attribute__((address_space(3)))
typedef unsigned short bf16_t;
typedef short bf16x8 __attribute__((ext_vector_type(8)));
typedef float f32x4 __attribute__((ext_vector_type(4)));
typedef unsigned u32x4 __attribute__((ext_vector_type(4)));
constexpr int BM = 256, BK = 64, HALF = 128, HTB = HALF * BK * 2  , STAGE_BYTES = 8 * HTB, NXCD = 8, WGM = 8;

__host__ __device__ __forceinline__ int lds_byte(int r, int c) { const int st = (r >> 4) * 2 + (c >> 5), rr = r & 15, cc = c & 31, ob = rr * 64 + cc * 2; return st * 1024 + (ob ^ (((ob >> 9) & 1) << 5)); }
__host__ __device__ __forceinline__ void stage_rc(int b, int& R, int& C) { const int st = b / 1024, sb = b % 1024, swz = sb ^ (((sb >> 9) & 1) << 5); R = (st >> 1) * 16 + swz / 64; C = (st & 1) * 32 + (swz % 64) / 2; }
__host__ __device__ __forceinline__ int perm32(int rho) { const int n = rho >> 4, i = rho & 15; return 8 * (i >> 2) + 4 * n + (i & 3); }

struct Unit { int pm, pn; };
struct Gemm { const bf16_t* A; const bf16_t* Bt; int M, N, K; };

struct StaticOrder {
    int nM, nN, nwg, G, c;
    __host__ __device__ void init(int M, int N, int G_, int c_) { nM = M / BM; nN = N / BM; nwg = nM * nN; G = G_; c = c_; }
    __host__ __device__ bool next(int i, Unit& u) const {
        const long L = (long)i * G + c; if (L >= nwg) return false;
        int wgid = (int)L; { const int q = nwg / NXCD, r = nwg % NXCD, xcd = wgid % NXCD, off = wgid / NXCD; wgid = (xcd < r ? xcd * (q + 1) : r * (q + 1) + (xcd - r) * q) + off; }
        const int nig = WGM * nN, gid = wgid / nig, fm = gid * WGM, gsz = (nM - fm) < WGM ? (nM - fm) : WGM;
        u.pm = fm + ((wgid % nig) % gsz); u.pn = (wgid % nig) / gsz; return true;
    }
    __device__ __forceinline__ void a_ready(const Unit&) const {}
    __device__ __forceinline__ void done(const Unit&) const {}
};

typedef float f32x2 __attribute__((ext_vector_type(2)));
typedef __bf16 bf16x2_t __attribute__((ext_vector_type(2)));
__device__ __forceinline__ unsigned cvt_pk_bf16(float lo, float hi) { f32x2 v = {lo, hi}; bf16x2_t b = __builtin_convertvector(v, bf16x2_t); return __builtin_bit_cast(unsigned, b); }
__device__ __forceinline__ bf16_t cvt_bf16(float x) { return (bf16_t)(cvt_pk_bf16(x, 0.f) & 0xffffu); }

struct EpiSplitT {
    static constexpr bool PERM = true, AFTER_DRAIN = false;
    bf16_t* O; int ldc; int ncols_rm; bf16_t* T; int NT; int rpb;
    __device__ __forceinline__ void operator()(const f32x4 (&acc)[2][2][4][2], const Unit& u, int wr, int wc, int fr, int fq) const {
        const int row0 = u.pm * BM + wr * 64 + fr; const int colt = u.pn * BM;
        if (colt < ncols_rm) {
            const int col0 = colt + wc * 32 + 8 * fq;
#pragma unroll
            for (int ai = 0; ai < 2; ++ai)
#pragma unroll
                for (int m = 0; m < 4; ++m) { bf16_t* rowp = O + (size_t)(row0 + ai * HALF + m * 16) * ldc + col0;
#pragma unroll
                    for (int bj = 0; bj < 2; ++bj) { const f32x4 v0 = acc[ai][bj][m][0], v1 = acc[ai][bj][m][1];
                        u32x4 w; w.x = cvt_pk_bf16(v0[0], v0[1]); w.y = cvt_pk_bf16(v0[2], v0[3]); w.z = cvt_pk_bf16(v1[0], v1[1]); w.w = cvt_pk_bf16(v1[2], v1[3]);
                        *(u32x4*)(rowp + bj * HALF) = w; } }
        } else {
            const int c0 = colt - ncols_rm + wc * 32 + 8 * fq;
#pragma unroll
            for (int ai = 0; ai < 2; ++ai)
#pragma unroll
                for (int m = 0; m < 4; ++m) { const int row = row0 + ai * HALF + m * 16; const int b = row / rpb, t = row - b * rpb; bf16_t* base = T + (size_t)b * NT * rpb + t;
#pragma unroll
                    for (int bj = 0; bj < 2; ++bj)
#pragma unroll
                        for (int n = 0; n < 2; ++n)
#pragma unroll
                            for (int e = 0; e < 4; ++e) base[(size_t)(c0 + bj * HALF + 4 * n + e) * rpb] = cvt_bf16(acc[ai][bj][m][n][e]); }
        }
    }
};
struct EpiResid {
    static constexpr bool PERM = true, AFTER_DRAIN = false;
    const float* base; float* out; bf16_t* xb; float* ssq; int ldc;
    __device__ __forceinline__ void operator()(const f32x4 (&acc)[2][2][4][2], const Unit& u, int wr, int wc, int fr, int fq) const {
        const int row0 = u.pm * BM + wr * 64 + fr; const int col0 = u.pn * BM + wc * 32 + 8 * fq;
#pragma unroll
        for (int ai = 0; ai < 2; ++ai)
#pragma unroll
            for (int m = 0; m < 4; ++m) { const int row = row0 + ai * HALF + m * 16; float s = 0.f;
#pragma unroll
                for (int bj = 0; bj < 2; ++bj) { const size_t off = (size_t)row * ldc + col0 + bj * HALF;
                    const f32x4 b0 = *(const f32x4*)(base + off), b1 = *(const f32x4*)(base + off + 4);
                    const f32x4 v0 = acc[ai][bj][m][0] + b0, v1 = acc[ai][bj][m][1] + b1;
                    *(f32x4*)(out + off) = v0; *(f32x4*)(out + off + 4) = v1;
                    s += (v0[0] * v0[0] + v0[1] * v0[1]) + (v0[2] * v0[2] + v0[3] * v0[3]) + (v1[0] * v1[0] + v1[1] * v1[1]) + (v1[2] * v1[2] + v1[3] * v1[3]);
                    u32x4 w; w.x = cvt_pk_bf16(v0[0], v0[1]); w.y = cvt_pk_bf16(v0[2], v0[3]); w.z = cvt_pk_bf16(v1[0], v1[1]); w.w = cvt_pk_bf16(v1[2], v1[3]);
                    *(u32x4*)(xb + off) = w; }
                s += __shfl_xor(s, 16); s += __shfl_xor(s, 32);
                if (fq == 0) ssq[(size_t)row * 16 + u.pn * 4 + wc] = s; }
    }
};
struct EpiRowScale {
    static constexpr bool PERM = true, AFTER_DRAIN = false;
    bf16_t* O; int ldc; const float* ssq; float inv_n, eps;
    __device__ __forceinline__ void operator()(const f32x4 (&acc)[2][2][4][2], const Unit& u, int wr, int wc, int fr, int fq) const {
        const int row0 = u.pm * BM + wr * 64 + fr; const int col0 = u.pn * BM + wc * 32 + 8 * fq;
#pragma unroll
        for (int ai = 0; ai < 2; ++ai)
#pragma unroll
            for (int m = 0; m < 4; ++m) { const int row = row0 + ai * HALF + m * 16; const f32x4* sp = (const f32x4*)(ssq + (size_t)row * 16);
                const f32x4 s0 = sp[0], s1 = sp[1], s2 = sp[2], s3 = sp[3]; const f32x4 st = (s0 + s1) + (s2 + s3);
                const float r = 1.0f / sqrtf(((st[0] + st[1]) + (st[2] + st[3])) * inv_n + eps);
                bf16_t* rowp = O + (size_t)row * ldc + col0;
#pragma unroll
                for (int bj = 0; bj < 2; ++bj) { const f32x4 v0 = acc[ai][bj][m][0] * r, v1 = acc[ai][bj][m][1] * r;
                    u32x4 w; w.x = cvt_pk_bf16(v0[0], v0[1]); w.y = cvt_pk_bf16(v0[2], v0[3]); w.z = cvt_pk_bf16(v1[0], v1[1]); w.w = cvt_pk_bf16(v1[2], v1[3]);
                    *(u32x4*)(rowp + bj * HALF) = w; } }
    }
};
struct OneUnit {
    int idx, nM, nN;
    __device__ __forceinline__ bool next(int i, Unit& u) const { if (i > 0 || idx < 0 || idx >= nM * nN) return false; u.pm = idx % nM; u.pn = idx / nM; return true; }
    __device__ __forceinline__ void a_ready(const Unit&) const {}
    __device__ __forceinline__ void done(const Unit&) const {}
};

template <class Epi, class Sched, bool ALIGN_EPI = false, bool SP2 = false>
__device__ __forceinline__ void gemm_phase(PG8_LAS unsigned char* lds, const Gemm g, const Sched& S, const Epi& E) {
    const int tid = threadIdx.x, wid = __builtin_amdgcn_readfirstlane(tid >> 6), lane = tid & 63, wr = wid >> 2, wc = wid & 3, fr = lane & 15, fq = lane >> 4;
    const int K = g.K, nt = K / BK;
    unsigned voffA[2], voffB[2];
#pragma unroll
    for (int i = 0; i < 2; ++i) { int R, C; stage_rc(tid * 16 + i * 8192, R, C); const int Rb = Epi::PERM ? ((R & ~31) + perm32(R & 31)) : R;
        voffA[i] = (unsigned)(R * K + C) * 2u; voffB[i] = (unsigned)(Rb * K + C) * 2u; }
    const size_t kstep = (size_t)(BK * 2);
    const size_t hstep = (size_t)HALF * K * 2;
    const size_t tstep = 2 * hstep;
    const unsigned ldsw = (unsigned)wid * 1024u;
    const int aoff = lds_byte(wr * 64 + fr, fq * 8), boff = lds_byte(wc * 32 + fr, fq * 8);
#define PG8_SA(b, h) (((b) * 2 + (h)) * HTB)
#define PG8_SB(b, h) ((4 + (b) * 2 + (h)) * HTB)
#define PG8_STAGE(bufoff, gbase, voff) do { _Pragma("unroll") for (int _i = 0; _i < 2; ++_i) \
        __builtin_amdgcn_global_load_lds((const unsigned*)((const char*)(gbase) + (voff)[_i]), (PG8_LAS unsigned*)(lds + (bufoff) + ldsw + _i * 8192), 16, 0, 0); } while (0)
#define PG8_LDA(dst, b, h) do { _Pragma("unroll") for (int m = 0; m < 4; ++m) _Pragma("unroll") for (int k = 0; k < 2; ++k) dst[m][k] = *(const PG8_LAS bf16x8*)(lds + PG8_SA(b, h) + aoff + m * 2048 + k * 1024); } while (0)
#define PG8_LDB(dst, b, h) do { _Pragma("unroll") for (int n = 0; n < 2; ++n) _Pragma("unroll") for (int k = 0; k < 2; ++k) dst[n][k] = *(const PG8_LAS bf16x8*)(lds + PG8_SB(b, h) + boff + n * 2048 + k * 1024); } while (0)
#define PG8_MMA(ai, bj, At, Bt) do { __builtin_amdgcn_s_setprio(1); _Pragma("unroll") for (int m = 0; m < 4; ++m) _Pragma("unroll") for (int n = 0; n < 2; ++n) _Pragma("unroll") for (int k = 0; k < 2; ++k) \
        acc[ai][bj][m][n] = __builtin_amdgcn_mfma_f32_16x16x32_bf16(Bt[n][k], At[m][k], acc[ai][bj][m][n], 0, 0, 0); __builtin_amdgcn_s_setprio(0); } while (0)
#define PG8_WAIT_V(n) asm volatile("s_waitcnt vmcnt(" #n ")" ::: "memory")
#define PG8_WAIT_L(n) asm volatile("s_waitcnt lgkmcnt(" #n ")" ::: "memory")
#define PG8_BAR __builtin_amdgcn_s_barrier()
#define PG8_SCHED __builtin_amdgcn_sched_barrier(0)
    Unit cur, nxt; int ui = 0;
    if (!S.next(0, cur)) return;
    f32x4 acc[2][2][4][2];
#pragma unroll
    for (int a = 0; a < 2; ++a)
#pragma unroll
        for (int b = 0; b < 2; ++b)
#pragma unroll
            for (int m = 0; m < 4; ++m)
#pragma unroll
                for (int n = 0; n < 2; ++n) acc[a][b][m][n] = (f32x4){0.f, 0.f, 0.f, 0.f};
    bf16x8 At[4][2], B0[2][2], B1[2][2];
    const char* cA = (const char*)g.A + (size_t)cur.pm * tstep; const char* cB = (const char*)g.Bt + (size_t)cur.pn * tstep;
    S.a_ready(cur);
    if constexpr (SP2) {
        PG8_STAGE(PG8_SB(0, 0), cB, voffB); PG8_STAGE(PG8_SB(0, 1), cB + hstep, voffB); PG8_STAGE(PG8_SA(0, 0), cA, voffA); PG8_STAGE(PG8_SA(0, 1), cA + hstep, voffA);
        if (wr == 1) PG8_BAR;
        PG8_WAIT_V(2); PG8_BAR;
        PG8_STAGE(PG8_SB(1, 0), cB + kstep, voffB); PG8_STAGE(PG8_SA(1, 0), cA + kstep, voffA); PG8_STAGE(PG8_SB(1, 1), cB + hstep + kstep, voffB);
        PG8_WAIT_V(6); PG8_BAR;
    } else {
        PG8_STAGE(PG8_SB(0, 0), cB, voffB); PG8_STAGE(PG8_SA(0, 0), cA, voffA); PG8_STAGE(PG8_SB(0, 1), cB + hstep, voffB); PG8_STAGE(PG8_SA(0, 1), cA + hstep, voffA);
        if (wr == 1) PG8_BAR;
        PG8_WAIT_V(4); PG8_BAR;
        PG8_STAGE(PG8_SB(1, 0), cB + kstep, voffB); PG8_STAGE(PG8_SA(1, 0), cA + kstep, voffA); PG8_STAGE(PG8_SB(1, 1), cB + hstep + kstep, voffB);
        PG8_WAIT_V(6); PG8_BAR;
    }
    for (;;) {
        const bool has_next = S.next(ui + 1, nxt);
        const char* nA = has_next ? (const char*)g.A + (size_t)nxt.pm * tstep : cA; const char* nB = has_next ? (const char*)g.Bt + (size_t)nxt.pn * tstep : cB;
        for (int t = 0; t < nt; t += 2) {
            const bool last = (t == nt - 2);
            const char* a1 = cA + (size_t)(t + 1) * kstep;
            const char* a2 = last ? nA : cA + (size_t)(t + 2) * kstep; const char* b2 = last ? nB : cB + (size_t)(t + 2) * kstep;
            const char* a3 = a2 + kstep; const char* b3 = b2 + kstep;
            if (last && has_next) S.a_ready(nxt);
            if constexpr (SP2) {
            PG8_LDB(B0, 0, 0); PG8_LDB(B1, 0, 1); PG8_SCHED; PG8_LDA(At, 0, 0); PG8_STAGE(PG8_SA(1, 1), a1 + hstep, voffA);
            PG8_WAIT_V(8); PG8_WAIT_L(0); PG8_BAR; PG8_MMA(0, 0, At, B0); PG8_MMA(0, 1, At, B1); PG8_BAR; PG8_SCHED;
            PG8_LDA(At, 0, 1); PG8_STAGE(PG8_SB(0, 0), b2, voffB); PG8_STAGE(PG8_SB(0, 1), b2 + hstep, voffB); PG8_STAGE(PG8_SA(0, 0), a2, voffA);
            PG8_WAIT_V(8); PG8_WAIT_L(0); PG8_BAR; PG8_MMA(1, 0, At, B0); PG8_MMA(1, 1, At, B1); PG8_BAR; PG8_SCHED;
            PG8_LDB(B0, 1, 0); PG8_LDB(B1, 1, 1); PG8_SCHED; PG8_LDA(At, 1, 0); PG8_STAGE(PG8_SA(0, 1), a2 + hstep, voffA);
            PG8_WAIT_V(8); PG8_WAIT_L(0); PG8_BAR; PG8_MMA(0, 0, At, B0); PG8_MMA(0, 1, At, B1); PG8_BAR; PG8_SCHED;
            PG8_LDA(At, 1, 1); PG8_STAGE(PG8_SB(1, 0), b3, voffB); PG8_STAGE(PG8_SB(1, 1), b3 + hstep, voffB); PG8_STAGE(PG8_SA(1, 0), a3, voffA);
            PG8_WAIT_V(8); PG8_WAIT_L(0); PG8_BAR; PG8_MMA(1, 0, At, B0); PG8_MMA(1, 1, At, B1); PG8_BAR; PG8_SCHED;
            } else {
            PG8_LDB(B0, 0, 0); PG8_SCHED; PG8_LDA(At, 0, 0); PG8_STAGE(PG8_SA(1, 1), a1 + hstep, voffA);
            PG8_WAIT_L(8); PG8_BAR; PG8_WAIT_L(0); PG8_MMA(0, 0, At, B0); PG8_BAR; PG8_SCHED;
            PG8_LDB(B1, 0, 1); PG8_STAGE(PG8_SB(0, 0), b2, voffB);
            PG8_BAR; PG8_WAIT_L(0); PG8_MMA(0, 1, At, B1); PG8_BAR;
            PG8_LDA(At, 0, 1); PG8_STAGE(PG8_SA(0, 0), a2, voffA);
            PG8_BAR; PG8_WAIT_L(0); PG8_MMA(1, 0, At, B0); PG8_BAR; PG8_SCHED;
            PG8_STAGE(PG8_SB(0, 1), b2 + hstep, voffB);
            PG8_WAIT_V(6); PG8_BAR; PG8_MMA(1, 1, At, B1); PG8_BAR;
            PG8_LDB(B0, 1, 0); PG8_SCHED; PG8_LDA(At, 1, 0); PG8_STAGE(PG8_SA(0, 1), a2 + hstep, voffA);
            PG8_WAIT_L(8); PG8_BAR; PG8_WAIT_L(0); PG8_MMA(0, 0, At, B0); PG8_BAR; PG8_SCHED;
            PG8_LDB(B1, 1, 1); PG8_STAGE(PG8_SB(1, 0), b3, voffB);
            PG8_BAR; PG8_WAIT_L(0); PG8_MMA(0, 1, At, B1); PG8_BAR;
            PG8_LDA(At, 1, 1); PG8_STAGE(PG8_SA(1, 0), a3, voffA);
            PG8_BAR; PG8_WAIT_L(0); PG8_MMA(1, 0, At, B0); PG8_BAR; PG8_SCHED;
            PG8_STAGE(PG8_SB(1, 1), b3 + hstep, voffB);
            PG8_WAIT_V(6); PG8_BAR; PG8_MMA(1, 1, At, B1); PG8_BAR;
            }
        }
        if constexpr (ALIGN_EPI) { if (wr == 0) PG8_BAR; }
        if constexpr (!Epi::AFTER_DRAIN) { E(acc, cur, wr, wc, fr, fq); S.done(cur); }
        if (!has_next) break;
#pragma unroll
        for (int a = 0; a < 2; ++a)
#pragma unroll
            for (int b = 0; b < 2; ++b)
#pragma unroll
                for (int m = 0; m < 4; ++m)
#pragma unroll
                    for (int n = 0; n < 2; ++n) acc[a][b][m][n] = (f32x4){0.f, 0.f, 0.f, 0.f};
        cur = nxt; cA = nA; cB = nB; ++ui;
        if constexpr (ALIGN_EPI) { if (wr == 1) PG8_BAR; }
    }
    PG8_WAIT_V(0);
    if constexpr (!ALIGN_EPI) { if (wr == 0) PG8_BAR; }
    PG8_BAR;
    if constexpr (Epi::AFTER_DRAIN) { E.fused(acc, cur, wr, wc, fr, fq, lds, wid, lane); S.done(cur); }
#undef PG8_SA
#undef PG8_SB
#undef PG8_STAGE
#undef PG8_LDA
#undef PG8_LDB
#undef PG8_MMA
#undef PG8_WAIT_V
#undef PG8_WAIT_L
#undef PG8_BAR
#undef PG8_SCHED
}
}

#ifndef PG8_SP2
#define PG8_SP2 true
#endif
#ifndef PG8_ALIGN
#define PG8_ALIGN true
#endif
constexpr int NWAVES = 8;
constexpr int NBATCH = 2, SEQ = 8192, DM = 1024, M = NBATCH * SEQ;
constexpr int INW = 2560, ZW = 2048;
constexpr int LRUW = 512, ATTW = 512, NCHUNK = SEQ / 64;
constexpr int NEXP = 16384, PEER_H = 8, NSEL = 128;
constexpr float EPS = 1e-6f;
constexpr float LOG2E = 1.4426950408889634f;

constexpr size_t MiB = 1u << 20;
constexpr size_t WS_CTL = 0, CTL_ZERO_BYTES = 1 * MiB;
constexpr size_t WS_WIN = 1 * MiB, WS_WOUT = 6 * MiB, WS_WQ = 8 * MiB, WS_WKV = 10 * MiB, WS_WO = 14 * MiB, WS_WQRY = 16 * MiB;
constexpr size_t WS_SUBK = 20 * MiB, WS_GATEW = 20 * MiB + 512 * 1024, WS_MEMN = 21 * MiB, WS_KM = 22 * MiB, WS_VMT = 23 * MiB, WS_AGG = 24 * MiB, WS_SSQ1 = 25 * MiB, WS_SSQ2 = 26 * MiB, WS_SU = 27 * MiB;
constexpr size_t WS_EU = 28 * MiB, WS_EV = 60 * MiB, WS_XN = 92 * MiB, WS_Z = 124 * MiB, WS_VT = 188 * MiB, WS_Y = 204 * MiB, WS_END = 236 * MiB;
constexpr size_t WS_QC = WS_Z, WS_OC = WS_Z + 32 * MiB, WS_QP = WS_Z, WS_IDX = WS_VT, WS_G = WS_VT + 8 * MiB;
constexpr int CW_BAR = 4096;

constexpr int RING_BYTES = 155648;
constexpr int LDSCTL_OFF = RING_BYTES, MISC_OFF = LDSCTL_OFF + 320;
constexpr int LDS_BYTES = 163840;

#define GAS __attribute__((address_space(1)))
#define LAS __attribute__((address_space(3)))
typedef unsigned short bf16;
typedef unsigned v4u __attribute__((ext_vector_type(4)));
typedef unsigned v2u __attribute__((ext_vector_type(2)));
typedef float f32x4 __attribute__((ext_vector_type(4)));
typedef float f32x2 __attribute__((ext_vector_type(2)));
typedef float f32x16 __attribute__((ext_vector_type(16)));
typedef short bf16x8 __attribute__((ext_vector_type(8)));
typedef __bf16 bf16x2_t __attribute__((ext_vector_type(2)));
typedef GAS unsigned gu32;
#define RLX_AGENT __ATOMIC_RELAXED, __HIP_MEMORY_SCOPE_AGENT
#define LDS_WAIT() asm volatile("s_waitcnt lgkmcnt(0)" ::: "memory")
#define VM_WAIT() asm volatile("s_waitcnt vmcnt(0)" ::: "memory")
#define MFMA32(a, b, c) __builtin_amdgcn_mfma_f32_32x32x16_bf16((a), (b), (c), 0, 0, 0)
#define DI __device__ __forceinline__

DI unsigned pk2(float lo, float hi) { f32x2 v = {lo, hi}; bf16x2_t b = __builtin_convertvector(v, bf16x2_t); return __builtin_bit_cast(unsigned, b); }
DI bf16 f2bf(float x) { return (bf16)(pk2(x, 0.f) & 0xffffu); }
DI float bf2f(bf16 x) { return __uint_as_float((unsigned)x << 16); }
DI float bflo(unsigned p) { return __uint_as_float(p << 16); }
DI float bfhi(unsigned p) { return __uint_as_float(p & 0xffff0000u); }
DI int crow(int reg, int hh) { return (reg & 3) + 8 * (reg >> 2) + 4 * hh; }
DI float swap32_partner(float x, int hh) { auto rr = __builtin_amdgcn_permlane32_swap(__float_as_uint(x), __float_as_uint(x), false, false); return __uint_as_float(hh ? rr[0] : rr[1]); }
DI float dpp_xor1(float x) { return __int_as_float(__builtin_amdgcn_update_dpp(0, __float_as_int(x), 0xB1, 0xf, 0xf, true)); }
DI float dpp_xor2(float x) { return __int_as_float(__builtin_amdgcn_update_dpp(0, __float_as_int(x), 0x4E, 0xf, 0xf, true)); }
DI float dpp_hmir(float x) { return __int_as_float(__builtin_amdgcn_update_dpp(0, __float_as_int(x), 0x141, 0xf, 0xf, true)); }
DI float dpp_mir(float x)  { return __int_as_float(__builtin_amdgcn_update_dpp(0, __float_as_int(x), 0x140, 0xf, 0xf, true)); }
DI float sum16(float x) { x += dpp_xor1(x); x += dpp_xor2(x); x += dpp_hmir(x); x += dpp_mir(x); return x; }
DI float sum32(float x) { x = sum16(x); auto rr = __builtin_amdgcn_permlane16_swap(__float_as_uint(x), __float_as_uint(x), false, false); return __uint_as_float(rr[0]) + __uint_as_float(rr[1]); }
DI float max16(float x) { x = fmaxf(x, dpp_xor1(x)); x = fmaxf(x, dpp_xor2(x)); x = fmaxf(x, dpp_hmir(x)); x = fmaxf(x, dpp_mir(x)); return x; }
DI float max64(float x) { x = max16(x); { auto rr = __builtin_amdgcn_permlane16_swap(__float_as_uint(x), __float_as_uint(x), false, false); x = fmaxf(__uint_as_float(rr[0]), __uint_as_float(rr[1])); }
    { auto rr = __builtin_amdgcn_permlane32_swap(__float_as_uint(x), __float_as_uint(x), false, false); x = fmaxf(__uint_as_float(rr[0]), __uint_as_float(rr[1])); } return x; }
DI unsigned pack_i8x4(float a, float b, float c, float d) { const int ia = (int)__builtin_rintf(a), ib = (int)__builtin_rintf(b), ic = (int)__builtin_rintf(c), id = (int)__builtin_rintf(d);
    return (unsigned)(ia & 255) | ((unsigned)(ib & 255) << 8) | ((unsigned)(ic & 255) << 16) | ((unsigned)id << 24); }
DI float sum64(float x) { x = sum32(x); auto rr = __builtin_amdgcn_permlane32_swap(__float_as_uint(x), __float_as_uint(x), false, false); return __uint_as_float(rr[0]) + __uint_as_float(rr[1]); }
DI float rcp_(float x) { return __builtin_amdgcn_rcpf(x); }
DI float rsq_(float x) { return __builtin_amdgcn_rsqf(x); }
DI float exp2_(float x) { return __builtin_amdgcn_exp2f(x); }
DI float gelu_tanh(float x) { const float u = x * (1.5957691216057308f + 0.07135481627159768f * x * x); return x * rcp_(1.0f + exp2_(-LOG2E * u)); }
DI float sigmoidf_(float x) { return rcp_(1.0f + exp2_(-LOG2E * x)); }
#define XB_TMO      128
#define XB_XCNT(j)  (256  + 64 * (j))
#define XB_XSUB(j)  (1280 + 64 * (j))
#define XB_XGEN(j)  (2304 + 64 * (j))
#define XB_TOP      3328
#define XB_TOPGEN   3392
#define XCD_BAR_WORDS 3456
#define XB_SPIN_CAP (1u << 18)

__device__ __forceinline__ unsigned xb_ld(unsigned* p)              { return __hip_atomic_load(p, __ATOMIC_RELAXED, __HIP_MEMORY_SCOPE_AGENT); }
__device__ __forceinline__ unsigned xb_add(unsigned* p, unsigned v) { return __hip_atomic_fetch_add(p, v, __ATOMIC_RELAXED, __HIP_MEMORY_SCOPE_AGENT); }
__device__ __forceinline__ unsigned xb_xcc_id() { return (unsigned)__builtin_amdgcn_s_getreg((3 << 11) | 20) & 0xFu; }
#define XB_SPIN(cond, bar) do { unsigned _sp = 0; while (cond) { __builtin_amdgcn_s_sleep(1); \
    if ((++_sp & 255u) == 0u) { if (xb_ld(&(bar)[XB_TMO])) break; if (_sp > XB_SPIN_CAP) { atomicAdd(&(bar)[XB_TMO], 1u); break; } } } } while (0)

struct XcdBarrier {
    unsigned* bar; unsigned x;
    volatile LAS unsigned* st;
};

__device__ __forceinline__ XcdBarrier xcd_barrier_post(unsigned* bar, volatile LAS unsigned* st) {
    XcdBarrier b; b.bar = bar; b.x = xb_xcc_id(); b.st = st;
    if (threadIdx.x == 0) (void)xb_add(&bar[XB_XCNT(b.x)], 1u);
    return b;
}
__device__ __forceinline__ void xcd_barrier_complete(unsigned* bar, unsigned x, unsigned& nloc, unsigned& nx) {
    const unsigned G = gridDim.x * gridDim.y * gridDim.z;
    unsigned sum, cnt, mine, sp = 0u;
    for (;;) {
        sum = 0u; cnt = 0u; mine = 0u;
#pragma unroll
        for (unsigned j = 0; j < 16; ++j) { const unsigned c = xb_ld(&bar[XB_XCNT(j)]); sum += c; cnt += (c > 0u) ? 1u : 0u; mine = (j == x) ? c : mine; }
        if (sum == G) break;
        __builtin_amdgcn_s_sleep(1);
        if ((++sp & 255u) == 0u) { if (xb_ld(&bar[XB_TMO])) break; if (sp > XB_SPIN_CAP) { atomicAdd(&bar[XB_TMO], 1u); break; } }
    }
    nloc = mine > 0u ? mine : 1u; nx = cnt > 0u ? cnt : 1u;
}

__device__ __forceinline__ void xcd_barrier(const XcdBarrier& b) {
    asm volatile("s_waitcnt vmcnt(0)" ::: "memory");
    __syncthreads();
    if (threadIdx.x == 0) {
        unsigned* bar = b.bar;
        __builtin_amdgcn_s_waitcnt(0);
        unsigned nloc = b.st[0], nx = b.st[1];
        if (nloc == 0u) { xcd_barrier_complete(bar, b.x, nloc, nx); b.st[0] = nloc; b.st[1] = nx; }
        const unsigned old = xb_add(&bar[XB_XSUB(b.x)], 1u);
        const unsigned gen = old / nloc;
        if (old + 1u == (gen + 1u) * nloc) {
            __builtin_amdgcn_fence(__ATOMIC_RELEASE, "agent");
            asm volatile("s_waitcnt vmcnt(0)" ::: "memory");
            const unsigned og = xb_add(&bar[XB_TOP], 1u);
            const unsigned tg = og / nx;
            if (og + 1u == (tg + 1u) * nx) xb_add(&bar[XB_TOPGEN], 1u);
            else XB_SPIN(xb_ld(&bar[XB_TOPGEN]) == tg, bar);
            __builtin_amdgcn_fence(__ATOMIC_ACQUIRE, "agent");
            xb_add(&bar[XB_XGEN(b.x)], 1u);
            asm volatile("s_waitcnt vmcnt(0)" ::: "memory");
        } else {
            XB_SPIN(xb_ld(&bar[XB_XGEN(b.x)]) == gen, bar);
            __builtin_amdgcn_fence(__ATOMIC_ACQUIRE, "agent");
            asm volatile("s_waitcnt vmcnt(0)" ::: "memory");
        }
    }
    __syncthreads();
}
struct Args { const float* in[26]; float* out; unsigned char* ws; int ph_lo, ph_hi, li, pad; };
struct Frame {
    LAS unsigned char* lds;
    volatile LAS unsigned* MISC;
    gu32* ctl;
    int tid, lane, wave, vcu, G;
    const Args* A; float* out; unsigned char* ws;
    DI const float* in(int k) const { return A->in[k]; }
    template <class T> DI T* wsp(size_t off) const { return (T*)(ws + off); }
};

DI void p0_transpose_item(const float* W, int K, int N, bf16* WT, LAS float* scr, int item, int lane, const float* g0, const float* g1, int gsplit) {
    const int nblk = N / 32, kb = item / nblk, nb = item % nblk, k0 = 64 * kb, n0 = 32 * nb;
#pragma unroll 8
    for (int i = 0; i < 32; ++i) { const int kk = 2 * i + (lane >> 5); const int k = k0 + kk;
        float g = 1.f; if (g0) g = (k < gsplit) ? g0[k] : g1[k - gsplit];
        scr[kk * 33 + (lane & 31)] = W[(size_t)k * N + n0 + (lane & 31)] * g; }
    LDS_WAIT(); asm volatile("" ::: "memory");
    const int c = lane & 7;
#pragma unroll
    for (int j = 0; j < 4; ++j) { const int n = (lane >> 3) + 8 * j; const LAS float* s = scr + (8 * c) * 33 + n;
        v4u o; o.x = pk2(s[0 * 33], s[1 * 33]); o.y = pk2(s[2 * 33], s[3 * 33]); o.z = pk2(s[4 * 33], s[5 * 33]); o.w = pk2(s[6 * 33], s[7 * 33]);
        *(GAS v4u*)(WT + (size_t)(n0 + n) * K + k0 + 8 * c) = o; }
    LDS_WAIT(); asm volatile("" ::: "memory");
}
template <bool NORM> DI void row_to_bf16(const float* xrow, bf16* orow, const float* gain, int lane) {
    const GAS f32x4* xr = (const GAS f32x4*)xrow + lane;
    f32x4 v[4]; float s = 0.f;
#pragma unroll
    for (int j = 0; j < 4; ++j) { v[j] = xr[64 * j]; s += (v[j].x * v[j].x + v[j].y * v[j].y) + (v[j].z * v[j].z + v[j].w * v[j].w); }
    float rstd = 1.f;
    if (NORM) rstd = 1.0f / sqrtf(sum64(s) * (1.f / 1024.f) + EPS);
    GAS v2u* o8 = (GAS v2u*)orow + lane;
#pragma unroll
    for (int j = 0; j < 4; ++j) { f32x4 w = v[j] * rstd; if (gain) w = w * ((const GAS f32x4*)gain)[64 * j + lane];
        v2u o; o.x = pk2(w.x, w.y); o.y = pk2(w.z, w.w); o8[64 * j] = o; }
}
constexpr float U_SCALE = 128.f, V_SCALE = 16.f;
DI void row_to_fp8(const float* src, unsigned char* dst, const float* gain, float scale, int lane) {
#pragma unroll
    for (int j = 0; j < 4; ++j) { f32x4 v = ((const GAS f32x4*)src)[64 * j + lane] * scale; if (gain) v = v * ((const GAS f32x4*)gain)[64 * j + lane];
        unsigned w = 0u; w = __builtin_amdgcn_cvt_pk_fp8_f32(v.x, v.y, w, false); w = __builtin_amdgcn_cvt_pk_fp8_f32(v.z, v.w, w, true);
        ((GAS unsigned*)dst)[64 * j + lane] = w; }
}
DI void row_to_i8(const float* src, unsigned char* dst, const float* gain, float* scale_out, int lane) {
    f32x4 v[4]; float mx = 0.f;
#pragma unroll
    for (int j = 0; j < 4; ++j) { v[j] = ((const GAS f32x4*)src)[64 * j + lane] * ((const GAS f32x4*)gain)[64 * j + lane];
        mx = fmaxf(fmaxf(mx, fmaxf(fabsf(v[j].x), fabsf(v[j].y))), fmaxf(fabsf(v[j].z), fabsf(v[j].w))); }
    mx = fmaxf(max64(mx), 1e-30f);
    const float inv = 127.0f / mx;
#pragma unroll
    for (int j = 0; j < 4; ++j) ((GAS unsigned*)dst)[64 * j + lane] = pack_i8x4(v[j].x * inv, v[j].y * inv, v[j].z * inv, v[j].w * inv);
    if (lane == 0) *scale_out = mx * (1.0f / 127.0f);
}
DI void p0_prologue(Frame& F) {
    LAS float* scr = (LAS float*)(F.lds + F.wave * 16384);
    const int gw = F.vcu * NWAVES + F.wave, NGW = F.G * NWAVES, lane = F.lane;
    constexpr int I_IN = 16 * (INW / 32), I_D = 16 * (DM / 32), I_2D = 16 * (2 * DM / 32);
    constexpr int NITEMS = I_IN + 3 * I_D + 2 * I_2D;
    for (int it = gw; it < NITEMS; it += NGW) {
        int r = it;
        if (r < I_IN) { p0_transpose_item(F.in(3), DM, INW, F.wsp<bf16>(WS_WIN), scr, r, lane, F.in(2), F.in(2), DM); continue; } r -= I_IN;
        if (r < I_D) { p0_transpose_item(F.in(14), DM, DM, F.wsp<bf16>(WS_WOUT), scr, r, lane, F.in(12), F.in(13), LRUW); continue; } r -= I_D;
        if (r < I_D) { p0_transpose_item(F.in(17), DM, DM, F.wsp<bf16>(WS_WQ), scr, r, lane, F.in(15), F.in(15), DM); continue; } r -= I_D;
        if (r < I_2D) { p0_transpose_item(F.in(18), DM, 2 * DM, F.wsp<bf16>(WS_WKV), scr, r, lane, nullptr, nullptr, 0); continue; } r -= I_2D;
        if (r < I_D) { p0_transpose_item(F.in(19), DM, DM, F.wsp<bf16>(WS_WO), scr, r, lane, nullptr, nullptr, 0); continue; } r -= I_D;
        p0_transpose_item(F.in(21), DM, 2 * DM, F.wsp<bf16>(WS_WQRY), scr, r, lane, F.in(20), F.in(20), DM);
    }
    for (int m = gw; m < M; m += NGW) row_to_bf16<true>(F.in(0) + (size_t)m * DM, F.wsp<bf16>(WS_XN) + (size_t)m * DM, nullptr, lane);
    for (int m = gw; m < NBATCH * 256; m += NGW) row_to_bf16<true>(F.in(1) + (size_t)m * DM, F.wsp<bf16>(WS_MEMN) + (size_t)m * DM, F.in(16), lane);
    for (int m = gw; m < NEXP; m += NGW) { row_to_i8(F.in(23) + (size_t)m * DM, F.wsp<unsigned char>(WS_EU) + (size_t)m * DM, F.in(20), F.wsp<float>(WS_SU) + m, lane);
                                            row_to_fp8(F.in(24) + (size_t)m * DM, F.wsp<unsigned char>(WS_EV) + (size_t)m * DM, nullptr, V_SCALE, lane); }
    { const int gt = gw * 64 + lane, NT = NGW * 64;
      for (int i = gt; i < 8 * 2 * 128 * 128 / 4; i += NT) { const f32x4 v = ((const GAS f32x4*)F.in(22))[i]; v2u o; o.x = pk2(v.x, v.y); o.y = pk2(v.z, v.w); ((GAS v2u*)F.wsp<bf16>(WS_SUBK))[i] = o; }
      for (int o = gt; o < 2 * 8 * 64 * 64; o += NT) { const int i = o & 63, j = (o >> 6) & 63, h = (o >> 12) & 7, g = o >> 15;
          const float* W = g ? F.in(8) : F.in(6); F.wsp<bf16>(WS_GATEW)[o] = f2bf(W[(h * 64 + i) * 64 + j]); } }
}
struct LruState { float ba[2], bx[2], sp[2], S[2], Ap[2]; };
template <bool PASS2>
DI void lru_prep(const Frame& F, int b, int chunk, int h, int lane, LAS unsigned char* xcs  , LruState& st) {
    const int r = lane & 31, hh = lane >> 5;
    const size_t row0 = (size_t)b * SEQ + (size_t)chunk * 64;
    {
        const int c2 = h * 64 + 2 * r;
        const f32x2 w0 = *(const f32x2*)(F.in(4) + c2), w1 = *(const f32x2*)(F.in(4) + LRUW + c2), w2 = *(const f32x2*)(F.in(4) + 2 * LRUW + c2), w3 = *(const f32x2*)(F.in(4) + 3 * LRUW + c2);
        const f32x2 cb = *(const f32x2*)(F.in(5) + c2);
        const int tl0 = 32 * hh;
        const bf16* zp = F.wsp<bf16>(WS_Z) + (row0 + tl0) * ZW + c2;
        const bool first = (chunk == 0 && hh == 0);
        unsigned p0 = first ? 0u : *(const unsigned*)(zp - 3 * ZW), p1 = first ? 0u : *(const unsigned*)(zp - 2 * ZW), p2 = first ? 0u : *(const unsigned*)(zp - ZW);
#pragma unroll 8
        for (int t = 0; t < 32; ++t) { const unsigned p3 = *(const unsigned*)(zp + (size_t)t * ZW);
            const float lo = cb.x + bflo(p0) * w0.x + bflo(p1) * w1.x + bflo(p2) * w2.x + bflo(p3) * w3.x;
            const float hi = cb.y + bfhi(p0) * w0.y + bfhi(p1) * w1.y + bfhi(p2) * w2.y + bfhi(p3) * w3.y;
            *(LAS unsigned*)(xcs + (tl0 + t) * 144 + 4 * r) = pk2(lo, hi);
            p0 = p1; p1 = p2; p2 = p3; }
        LDS_WAIT();
    }
#pragma unroll
    for (int nt = 0; nt < 2; ++nt) { const int c = h * 64 + 32 * nt + r; st.ba[nt] = F.in(7)[c]; st.bx[nt] = F.in(9)[c];
        const float nl = -F.in(10)[c]; st.sp[nt] = fmaxf(nl, 0.f) + log1pf(__expf(-fabsf(nl))); st.S[nt] = 0.f; st.Ap[nt] = 1.f; }
    if (PASS2) {
        float s = 0.f; const float* ag = F.wsp<float>(WS_AGG) + ((size_t)b * NCHUNK * LRUW + h * 64 + lane) * 2;
#pragma unroll 8
        for (int c = 0; c < chunk; ++c) { const f32x2 ab = *(const f32x2*)(ag + (size_t)c * LRUW * 2); s = ab.x * s + ab.y; }
        st.S[0] = __shfl(s, r); st.S[1] = __shfl(s, 32 + r);
    }
}
template <bool PASS2>
DI void lru_tile(const Frame& F, int b, int chunk, int mt, int h, int lane, LAS unsigned char* xcs, LAS unsigned char* gim  , LruState& st, float (&ssq)[16]) {
    const int r = lane & 31, hh = lane >> 5;
    const size_t row0 = (size_t)b * SEQ + (size_t)chunk * 64;
    const bf16* gw = F.wsp<bf16>(WS_GATEW) + (size_t)h * 4096;
    bf16x8 af[4];
#pragma unroll
    for (int s = 0; s < 4; ++s) af[s] = *(const LAS bf16x8*)(xcs + (32 * mt + r) * 144 + (16 * s + 8 * hh) * 2);
    float ssl[16];
#pragma unroll
    for (int i = 0; i < 16; ++i) ssl[i] = 0.f;
    if (PASS2) {
#pragma unroll
        for (int i = 0; i < 4; ++i) { const int row = (lane >> 3) + 8 * i, c = lane & 7;
            *(LAS v4u*)(gim + row * 144 + c * 16) = *(const v4u*)(F.wsp<bf16>(WS_Z) + (row0 + 32 * mt + row) * ZW + LRUW + h * 64 + 8 * c); }
        LDS_WAIT();
    }
#pragma unroll
    for (int nt = 0; nt < 2; ++nt) {
        asm volatile("" ::: "memory");
        f32x16 aa = {}, ax = {};
#pragma unroll
        for (int s = 0; s < 4; ++s) {
            const bf16x8 wa = *(const bf16x8*)(gw + (size_t)(32 * nt + r) * 64 + 16 * s + 8 * hh);
            const bf16x8 wx = *(const bf16x8*)(gw + 32768 + (size_t)(32 * nt + r) * 64 + 16 * s + 8 * hh);
            aa = MFMA32(af[s], wa, aa); ax = MFMA32(af[s], wx, ax);
        }
        float gt[16];
        if (PASS2) {
#pragma unroll
            for (int i = 0; i < 16; ++i) gt[i] = bf2f(*(const LAS bf16*)(gim + crow(i, hh) * 144 + (32 * nt + r) * 2));
        }
#pragma unroll
        for (int i = 0; i < 16; ++i) {
            const float rg = sigmoidf_(aa[i] + st.ba[nt]), ig = sigmoidf_(ax[i] + st.bx[nt]);
            const float la = -8.0f * rg * st.sp[nt];
            const float a = exp2_(LOG2E * la);
            const float mult = __builtin_amdgcn_sqrtf(fmaxf(1.0f - a * a, 0.f));
            const float xc = bf2f(*(const LAS bf16*)(xcs + (32 * mt + crow(i, hh)) * 144 + (32 * nt + r) * 2));
            aa[i] = a; ax[i] = mult * ig * xc;
        }
        float Ao[4], Bo[4], Aq[4], Bq[4], Sin[4];
#pragma unroll
        for (int q = 0; q < 4; ++q) { const float a0 = aa[4 * q], a1 = aa[4 * q + 1], a2 = aa[4 * q + 2], a3 = aa[4 * q + 3];
            Ao[q] = (a0 * a1) * (a2 * a3); Bo[q] = ((ax[4 * q] * a1 + ax[4 * q + 1]) * a2 + ax[4 * q + 2]) * a3 + ax[4 * q + 3];
            Aq[q] = swap32_partner(Ao[q], hh); Bq[q] = swap32_partner(Bo[q], hh); }
        float s_ = st.S[nt];
#pragma unroll
        for (int q = 0; q < 4; ++q) { const float A1 = hh ? Aq[q] : Ao[q], B1 = hh ? Bq[q] : Bo[q], A2 = hh ? Ao[q] : Aq[q], B2 = hh ? Bo[q] : Bq[q];
            const float smid = A1 * s_ + B1; Sin[q] = hh ? smid : s_; s_ = A2 * smid + B2; st.Ap[nt] *= A1 * A2; }
        st.S[nt] = s_;
        if (PASS2) {
#pragma unroll
            for (int q = 0; q < 4; ++q) { float hp = Sin[q];
#pragma unroll
                for (int e = 0; e < 4; ++e) { const int i = 4 * q + e; hp = aa[i] * hp + ax[i];
                    const float y = hp * gelu_tanh(gt[i]); ssl[i] += y * y;
                    *(LAS bf16*)(xcs + (32 * mt + crow(i, hh)) * 144 + (32 * nt + r) * 2) = f2bf(y); } }
        }
    }
    if (PASS2) {
#pragma unroll
        for (int i = 0; i < 16; ++i) ssq[i] = sum32(ssl[i]);
    }
}
DI void attn_wave(const Frame& F, int b, int n, int qt, int h, int lane, const LAS float* tab, f32x16 (&o)[2]) {
    const int r = lane & 31, hh = lane >> 5;
    const size_t row0 = (size_t)b * SEQ + (size_t)n * 64;
    const float SC = 0.125f * LOG2E;
    bf16x8 qf[4];
#pragma unroll
    for (int s = 0; s < 4; ++s) qf[s] = *(const bf16x8*)(F.wsp<bf16>(WS_Z) + (row0 + 32 * qt + r) * ZW + 2 * LRUW + h * 64 + 16 * s + 8 * hh);
    float mrun = -1e30f, lrun = 0.f;
#pragma unroll
    for (int dt = 0; dt < 2; ++dt) o[dt] = f32x16{};
    const float bfar = tab[256];
    const bf16* vtb = F.wsp<bf16>(WS_VT) + ((size_t)(b * 8 + h) * 64 + r) * SEQ + 4 * hh;
    for (int kc = (n >= 8 ? n - 8 : 0); kc <= n; ++kc) {
        const size_t krow0 = (size_t)b * SEQ + (size_t)kc * 64;
        const int dd = n - kc;
        bf16x8 kf[2][4];
#pragma unroll
        for (int kt = 0; kt < 2; ++kt)
#pragma unroll
            for (int s = 0; s < 4; ++s) kf[kt][s] = *(const bf16x8*)(F.wsp<bf16>(WS_Z) + (krow0 + 32 * kt + r) * ZW + 2 * LRUW + ATTW + h * 64 + 16 * s + 8 * hh);
        bf16x8 vf[2][2][2];
#pragma unroll
        for (int dt = 0; dt < 2; ++dt)
#pragma unroll
            for (int kt = 0; kt < 2; ++kt)
#pragma unroll
                for (int s2 = 0; s2 < 2; ++s2) { const bf16* p = vtb + (size_t)(32 * dt) * SEQ + kc * 64 + 32 * kt + 16 * s2;
                    const v2u lo = *(const v2u*)p, hi = *(const v2u*)(p + 8); v4u w; w.x = lo.x; w.y = lo.y; w.z = hi.x; w.w = hi.y; vf[dt][kt][s2] = __builtin_bit_cast(bf16x8, w); }
        f32x16 sc[2];
#pragma unroll
        for (int kt = 0; kt < 2; ++kt) { sc[kt] = f32x16{};
#pragma unroll
            for (int s = 0; s < 4; ++s) sc[kt] = MFMA32(kf[kt][s], qf[s], sc[kt]); }
        if (dd >= 3) {
#pragma unroll
            for (int kt = 0; kt < 2; ++kt)
#pragma unroll
                for (int i = 0; i < 16; ++i) sc[kt][i] = sc[kt][i] * SC + bfar;
        } else {
            const int base = 64 * dd + 32 * qt + r + 128;
#pragma unroll
            for (int kt = 0; kt < 2; ++kt)
#pragma unroll
                for (int i = 0; i < 16; ++i) { int idx = base - (32 * kt + crow(i, hh)); idx = idx > 256 ? 256 : idx; sc[kt][i] = sc[kt][i] * SC + tab[idx]; }
        }
        float mx = sc[0][0];
#pragma unroll
        for (int kt = 0; kt < 2; ++kt)
#pragma unroll
            for (int i = 0; i < 16; ++i) mx = fmaxf(mx, sc[kt][i]);
        mx = fmaxf(mx, swap32_partner(mx, hh));
        const float mnew = fmaxf(mrun, mx), alpha = exp2_(mrun - mnew);
        float ls = 0.f;
#pragma unroll
        for (int kt = 0; kt < 2; ++kt)
#pragma unroll
            for (int i = 0; i < 16; ++i) { const float p = exp2_(sc[kt][i] - mnew); sc[kt][i] = p; ls += p; }
        lrun = lrun * alpha + ls; mrun = mnew;
#pragma unroll
        for (int dt = 0; dt < 2; ++dt)
#pragma unroll
            for (int i = 0; i < 16; ++i) o[dt][i] *= alpha;
#pragma unroll
        for (int kt = 0; kt < 2; ++kt)
#pragma unroll
            for (int s2 = 0; s2 < 2; ++s2) { v4u w; w.x = pk2(sc[kt][8 * s2], sc[kt][8 * s2 + 1]); w.y = pk2(sc[kt][8 * s2 + 2], sc[kt][8 * s2 + 3]); w.z = pk2(sc[kt][8 * s2 + 4], sc[kt][8 * s2 + 5]); w.w = pk2(sc[kt][8 * s2 + 6], sc[kt][8 * s2 + 7]);
                const bf16x8 pf = __builtin_bit_cast(bf16x8, w);
#pragma unroll
                for (int dt = 0; dt < 2; ++dt) o[dt] = MFMA32(vf[dt][kt][s2], pf, o[dt]); }
    }
    const float lt = lrun + swap32_partner(lrun, hh); const float inv = rcp_(lt);
#pragma unroll
    for (int dt = 0; dt < 2; ++dt)
#pragma unroll
        for (int i = 0; i < 16; ++i) o[dt][i] *= inv;
}

DI void p2_lru_aggregates(Frame& F) {
    const int lane = F.lane, r = lane & 31, hh = lane >> 5, h = F.wave;
    LAS unsigned char* xcs = F.lds + 20480 + h * 13824;
    for (int u = F.vcu; u < NBATCH * NCHUNK; u += F.G) {
        const int b = u / NCHUNK, n = u % NCHUNK;
        LruState st; float ssq[16];
        lru_prep<false>(F, b, n, h, lane, xcs, st);
#pragma unroll 1
        for (int mt = 0; mt < 2; ++mt) lru_tile<false>(F, b, n, mt, h, lane, xcs, xcs + 9216, st, ssq);
        if (hh == 0) {
#pragma unroll
            for (int nt = 0; nt < 2; ++nt) *(f32x2*)(F.wsp<float>(WS_AGG) + (((size_t)b * NCHUNK + n) * LRUW + h * 64 + 32 * nt + r) * 2) = (f32x2){st.Ap[nt], st.S[nt]};
        }
        LDS_WAIT();
    }
}
DI void p3_mixer(Frame& F) {
    const int lane = F.lane, r = lane & 31, hh = lane >> 5, h = F.wave;
    LAS float* ssx = (LAS float*)(F.lds);
    LAS float* tab = (LAS float*)(F.lds + 4096 + h * 2048);
    LAS unsigned* stg = (LAS unsigned*)(F.lds + 20480 + h * 13824);
    for (int i = lane; i < 257; i += 64) tab[i] = F.in(11)[h * 257 + i] * LOG2E;
    LDS_WAIT();
    for (int u = F.vcu; u < NBATCH * NCHUNK; u += F.G) {
        const int b = u / NCHUNK, n = u % NCHUNK; const size_t row0 = (size_t)b * SEQ + (size_t)n * 64;
#ifndef MIX_PARTS
#define MIX_PARTS 3
#endif
        if (MIX_PARTS & 1) {
            LruState st;
            lru_prep<true>(F, b, n, h, lane, (LAS unsigned char*)stg, st);
#pragma unroll 1
            for (int mt = 0; mt < 2; ++mt) {
                float ssq[16];
                lru_tile<true>(F, b, n, mt, h, lane, (LAS unsigned char*)stg, (LAS unsigned char*)stg + 9216, st, ssq);
                if (r == 0) {
#pragma unroll
                    for (int i = 0; i < 16; ++i) ssx[crow(i, hh) * 8 + h] = ssq[i];
                }
                __syncthreads();
                const LAS unsigned char* yst = (const LAS unsigned char*)stg + 32 * mt * 144;
#pragma unroll
                for (int i = 0; i < 4; ++i) { const int row = (lane >> 3) + 8 * i, c = lane & 7;
                    const f32x4 s0 = *(const LAS f32x4*)(ssx + row * 8), s1 = *(const LAS f32x4*)(ssx + row * 8 + 4);
                    const float rs = rsq_(((s0.x + s0.y) + (s0.z + s0.w) + (s1.x + s1.y) + (s1.z + s1.w)) * (1.f / 512.f) + EPS);
                    const v4u v = *(const LAS v4u*)(yst + row * 144 + c * 16);
                    v4u o; o.x = pk2(bflo(v.x) * rs, bfhi(v.x) * rs); o.y = pk2(bflo(v.y) * rs, bfhi(v.y) * rs); o.z = pk2(bflo(v.z) * rs, bfhi(v.z) * rs); o.w = pk2(bflo(v.w) * rs, bfhi(v.w) * rs);
                    *(v4u*)(F.wsp<bf16>(WS_Y) + (row0 + 32 * mt + row) * DM + h * 64 + 8 * c) = o; }
                __syncthreads();
            }
        }
    }
    for (int u = F.vcu; u < NBATCH * NCHUNK; u += F.G) {
        const int b = u / NCHUNK, n = u % NCHUNK; const size_t row0 = (size_t)b * SEQ + (size_t)n * 64;
#pragma unroll 1
        for (int qt = 0; qt < ((MIX_PARTS & 2) ? 2 : 0); ++qt) {
            f32x16 o[2];
            attn_wave(F, b, n, qt, h, lane, tab, o);
            float s = 0.f;
#pragma unroll
            for (int dt = 0; dt < 2; ++dt)
#pragma unroll
                for (int i = 0; i < 16; ++i) s += o[dt][i] * o[dt][i];
            s += swap32_partner(s, hh);
            if (hh == 0) ssx[r * 8 + h] = s;
            __syncthreads();
            { const f32x4 s0 = *(const LAS f32x4*)(ssx + r * 8), s1 = *(const LAS f32x4*)(ssx + r * 8 + 4);
              const float rs = rsq_(((s0.x + s0.y) + (s0.z + s0.w) + (s1.x + s1.y) + (s1.z + s1.w)) * (1.f / 512.f) + EPS);
#pragma unroll
              for (int dt = 0; dt < 2; ++dt)
#pragma unroll
                  for (int i = 0; i < 16; i += 2) stg[r * 33 + ((32 * dt + crow(i, hh)) >> 1)] = pk2(o[dt][i] * rs, o[dt][i + 1] * rs); }
            LDS_WAIT();
#pragma unroll 4
            for (int i = 0; i < 16; ++i) { const int row = 2 * i + hh; const unsigned v = stg[row * 33 + r];
                *(GAS unsigned*)(F.wsp<bf16>(WS_Y) + (row0 + 32 * qt + row) * DM + LRUW + h * 64 + 2 * r) = v; }
            __syncthreads();
        }
    }
}
DI void p5_cross(Frame& F) {
    const int lane = F.lane, r = lane & 31, hh = lane >> 5, w = F.wave, tid = F.tid;
    constexpr int KST = 528, VST = 520;
    const float SC = 0.0625f * LOG2E;
    for (int u = F.vcu; u < NBATCH * 4 * 32; u += F.G) {
        const int b = u >> 7, hm = (u >> 5) & 3, qb = u & 31;
        const size_t qrow = (size_t)b * SEQ + (size_t)qb * 256 + 32 * w + r;
        { const bf16* src = F.wsp<bf16>(WS_KM) + (size_t)(b * 256) * DM + hm * 256;
#pragma unroll 4
          for (int i = 0; i < 16; ++i) { const int c = i * 512 + tid, row = c >> 5, ch = c & 31;
              *(LAS v4u*)(F.lds + row * KST + ch * 16) = *(const v4u*)(src + (size_t)row * DM + ch * 8); } }
        __syncthreads();
        f32x16 sc[8];
#pragma unroll
        for (int kt = 0; kt < 8; ++kt) sc[kt] = f32x16{};
#pragma unroll 2
        for (int s = 0; s < 16; ++s) {
            const bf16x8 qf = *(const bf16x8*)(F.wsp<bf16>(WS_QC) + qrow * DM + hm * 256 + 16 * s + 8 * hh);
#pragma unroll
            for (int kt = 0; kt < 8; ++kt) { const bf16x8 kf = *(const LAS bf16x8*)(F.lds + (32 * kt + r) * KST + (16 * s + 8 * hh) * 2); sc[kt] = MFMA32(kf, qf, sc[kt]); }
        }
        float mx = sc[0][0];
#pragma unroll
        for (int kt = 0; kt < 8; ++kt)
#pragma unroll
            for (int i = 0; i < 16; ++i) mx = fmaxf(mx, sc[kt][i]);
        mx = fmaxf(mx, swap32_partner(mx, hh));
        float ls = 0.f; const float mo = mx * SC;
        bf16x8 pf[8][2];
#pragma unroll
        for (int kt = 0; kt < 8; ++kt) {
#pragma unroll
            for (int i = 0; i < 16; ++i) { const float p = exp2_(sc[kt][i] * SC - mo); sc[kt][i] = p; ls += p; }
#pragma unroll
            for (int s2 = 0; s2 < 2; ++s2) { v4u wv; wv.x = pk2(sc[kt][8 * s2], sc[kt][8 * s2 + 1]); wv.y = pk2(sc[kt][8 * s2 + 2], sc[kt][8 * s2 + 3]); wv.z = pk2(sc[kt][8 * s2 + 4], sc[kt][8 * s2 + 5]); wv.w = pk2(sc[kt][8 * s2 + 6], sc[kt][8 * s2 + 7]);
                pf[kt][s2] = __builtin_bit_cast(bf16x8, wv); }
        }
        ls += swap32_partner(ls, hh);
        const float inv = 1.0f / ls;
        __syncthreads();
        { const bf16* src = F.wsp<bf16>(WS_VMT) + (size_t)((b * 4 + hm) * 256) * 256;
#pragma unroll 4
          for (int i = 0; i < 16; ++i) { const int c = i * 512 + tid, row = c >> 5, ch = c & 31; const v4u v = *(const v4u*)(src + (size_t)row * 256 + ch * 8);
              LAS v2u* d = (LAS v2u*)(F.lds + row * VST + ch * 16); d[0] = (v2u){v.x, v.y}; d[1] = (v2u){v.z, v.w}; } }
        __syncthreads();
        LAS unsigned* stg = (LAS unsigned*)(F.lds) ;
#pragma unroll
        for (int half = 0; half < 2; ++half) {
            f32x16 o[4];
#pragma unroll
            for (int dt = 0; dt < 4; ++dt) o[dt] = f32x16{};
#pragma unroll
            for (int kt = 0; kt < 8; ++kt)
#pragma unroll
                for (int s2 = 0; s2 < 2; ++s2)
#pragma unroll
                    for (int dt = 0; dt < 4; ++dt) { const LAS unsigned char* p = F.lds + (128 * half + 32 * dt + r) * VST + (32 * kt + 16 * s2 + 4 * hh) * 2;
                        const v2u lo = *(const LAS v2u*)p, hi = *(const LAS v2u*)(p + 16); v4u wv; wv.x = lo.x; wv.y = lo.y; wv.z = hi.x; wv.w = hi.y;
                        o[dt] = MFMA32(__builtin_bit_cast(bf16x8, wv), pf[kt][s2], o[dt]); }
            if (half == 1) __syncthreads();
            else {   }
            if (half == 0) {
#pragma unroll
                for (int dt = 0; dt < 4; ++dt)
#pragma unroll
                    for (int i = 0; i < 16; i += 2) { const unsigned pv = pk2(o[dt][i] * inv, o[dt][i + 1] * inv); sc[dt][i >> 1] = __uint_as_float(pv); }
            } else {
                LAS unsigned* sw = (LAS unsigned*)(F.lds + w * 16512);
#pragma unroll
                for (int dt = 0; dt < 4; ++dt)
#pragma unroll
                    for (int i = 0; i < 16; i += 2) { sw[r * 129 + ((32 * dt + crow(i, hh)) >> 1)] = __float_as_uint(sc[dt][i >> 1]);
                        sw[r * 129 + 64 + ((32 * dt + crow(i, hh)) >> 1)] = pk2(o[dt][i] * inv, o[dt][i + 1] * inv); }
                LDS_WAIT();
#pragma unroll 4
                for (int i = 0; i < 32; ++i) { const unsigned v0 = sw[i * 129 + lane], v1 = sw[i * 129 + 64 + lane];
                    GAS unsigned* dst = (GAS unsigned*)(F.wsp<bf16>(WS_OC) + ((size_t)b * SEQ + (size_t)qb * 256 + 32 * w + i) * DM + hm * 256);
                    dst[lane] = v0; dst[64 + lane] = v1; }
            }
        }
        (void)stg;
        __syncthreads();
    }
}
template <int N> DI void ce_desc(float (&a)[N], int i, int l) { const float hi = fmaxf(a[i], a[l]), lo = fminf(a[i], a[l]); a[i] = hi; a[l] = lo; }
template <int N, int OFF> DI void bitonic_sort16_desc(float (&a)[N]) {
#pragma unroll
    for (int k = 2; k <= 16; k <<= 1)
#pragma unroll
        for (int j = k >> 1; j > 0; j >>= 1)
#pragma unroll
            for (int i = 0; i < 16; ++i) { const int l = i ^ j; if (l > i) { const bool desc = ((i & k) == 0) || (k == 16);
                if (desc) ce_desc<N>(a, OFF + i, OFF + l); else ce_desc<N>(a, OFF + l, OFF + i); } }
}
template <int N, int OFF> DI void bitonic_merge16_desc(float (&a)[N]) {
#pragma unroll
    for (int j = 8; j > 0; j >>= 1)
#pragma unroll
        for (int i = 0; i < 16; ++i) { const int l = i ^ j; if (l > i) ce_desc<N>(a, OFF + i, OFF + l); }
}
template <bool SORTED> DI void top16_of_64(float (&a)[64]) {
    bitonic_sort16_desc<64, 0>(a); bitonic_sort16_desc<64, 16>(a); bitonic_sort16_desc<64, 32>(a); bitonic_sort16_desc<64, 48>(a);
#pragma unroll
    for (int i = 0; i < 16; ++i) { a[i] = fmaxf(a[i], a[31 - i]); a[32 + i] = fmaxf(a[32 + i], a[63 - i]); }
    bitonic_merge16_desc<64, 0>(a); bitonic_merge16_desc<64, 32>(a);
#pragma unroll
    for (int i = 0; i < 16; ++i) a[i] = fmaxf(a[i], a[47 - i]);
    if (SORTED) bitonic_merge16_desc<64, 0>(a);
}
DI void p8a_topk(Frame& F) {
    const int lane = F.lane, r = lane & 31, hh = lane >> 5, w = F.wave;
    LAS float* tbl = (LAS float*)(F.lds + w * 8192);
    const int gw = F.vcu * NWAVES + w, NGW = F.G * NWAVES;
    for (int task = gw; task < (M / 32) * PEER_H; task += NGW) {
        const int h = task & 7, tt = task >> 3; const size_t tok = (size_t)tt * 32 + r;
        float v[2][16];
#pragma unroll
        for (int p = 0; p < 2; ++p) {
            f32x16 sc[4];
#pragma unroll
            for (int nt = 0; nt < 4; ++nt) sc[nt] = f32x16{};
            const bf16* sk = F.wsp<bf16>(WS_SUBK) + (size_t)((h * 2 + p) * 128) * 128;
#pragma unroll 2
            for (int s = 0; s < 8; ++s) { const bf16x8 qf = *(const bf16x8*)(F.wsp<bf16>(WS_QP) + tok * 2048 + h * 256 + p * 128 + 16 * s + 8 * hh);
#pragma unroll
                for (int nt = 0; nt < 4; ++nt) { const bf16x8 kf = *(const bf16x8*)(sk + (size_t)(32 * nt + r) * 128 + 16 * s + 8 * hh); sc[nt] = MFMA32(kf, qf, sc[nt]); } }
            float a[64];
#pragma unroll
            for (int nt = 0; nt < 4; ++nt)
#pragma unroll
                for (int i = 0; i < 16; ++i) a[nt * 16 + i] = __uint_as_float((__float_as_uint(sc[nt][i]) & ~127u) | (unsigned)(32 * nt + crow(i, hh)));
            top16_of_64<true>(a);
            float m[16];
#pragma unroll
            for (int i = 0; i < 16; ++i) m[i] = fmaxf(a[i], swap32_partner(a[15 - i], hh));
            bitonic_merge16_desc<16, 0>(m);
#pragma unroll
            for (int i = 0; i < 16; ++i) v[p][i] = m[i];
        }
        float c[64]; int n = 0;
#pragma unroll
        for (int i = 0; i < 16; ++i)
#pragma unroll
            for (int j = 0; j < 16; ++j) if ((i + 1) * (j + 1) <= 16) { c[n] = __uint_as_float((__float_as_uint(v[0][i] + v[1][j]) & ~255u) | (unsigned)((i << 4) | j)); ++n; }
#pragma unroll
        for (int k = 50; k < 64; ++k) c[k] = -3.0e38f;
        top16_of_64<false>(c);
#pragma unroll
        for (int i = 0; i < 16; ++i) { tbl[i * 64 + lane] = v[0][i]; tbl[(16 + i) * 64 + lane] = v[1][i]; }
        LDS_WAIT();
        float sv[16]; int ev[16]; float mx = -3.0e38f;
#pragma unroll
        for (int k = 0; k < 16; ++k) { const unsigned pl = __float_as_uint(c[k]) & 255u; const float a1 = tbl[(pl >> 4) * 64 + lane], a2 = tbl[(16 + (pl & 15)) * 64 + lane];
            sv[k] = a1 + a2; ev[k] = (int)(((__float_as_uint(a1) & 127u) << 7) | (__float_as_uint(a2) & 127u)); mx = fmaxf(mx, sv[k]); }
        float sum = 0.f;
#pragma unroll
        for (int k = 0; k < 16; ++k) { sv[k] = __expf(sv[k] - mx); sum += sv[k]; }
        const float inv = 1.0f / sum;
        if (hh == 0) {
#pragma unroll
            for (int k = 0; k < 16; k += 4) *(v4u*)(F.wsp<int>(WS_IDX) + tok * NSEL + h * 16 + k) = (v4u){(unsigned)ev[k], (unsigned)ev[k + 1], (unsigned)ev[k + 2], (unsigned)ev[k + 3]};
        } else {
#pragma unroll
            for (int k = 0; k < 16; k += 4) *(f32x4*)(F.wsp<float>(WS_G) + tok * NSEL + h * 16 + k) = (f32x4){sv[k] * inv, sv[k + 1] * inv, sv[k + 2] * inv, sv[k + 3] * inv};
        }
        LDS_WAIT();
    }
}
typedef _Float16 f16x2_t __attribute__((ext_vector_type(2)));
constexpr float V_UNSCALE = 1.f / 16.f;
DI int dot16_i8(const v4u& u, const unsigned (&x)[4]) {
    const unsigned u0 = u.x, u1 = u.y, u2 = u.z, u3 = u.w;
    int a = 0;
    a = __builtin_amdgcn_sdot4((int)u0, (int)x[0], a, false); a = __builtin_amdgcn_sdot4((int)u1, (int)x[1], a, false);
    a = __builtin_amdgcn_sdot4((int)u2, (int)x[2], a, false); a = __builtin_amdgcn_sdot4((int)u3, (int)x[3], a, false);
    return a;
}
DI f16x2_t cvt_f16x2_fp8(unsigned v, float scale, bool hi) { return hi ? __builtin_bit_cast(f16x2_t, __builtin_amdgcn_cvt_scalef32_pk_f16_fp8(v, scale, true)) : __builtin_bit_cast(f16x2_t, __builtin_amdgcn_cvt_scalef32_pk_f16_fp8(v, scale, false)); }
DI void axpy16_v8(f16x2_t (&o)[8], float w, const v4u& v) {
    const unsigned v0 = v.x, v1 = v.y, v2 = v.z, v3 = v.w;
    const f16x2_t w2 = {(_Float16)w, (_Float16)w};
    o[0] = __builtin_elementwise_fma(cvt_f16x2_fp8(v0, V_UNSCALE, false), w2, o[0]); o[1] = __builtin_elementwise_fma(cvt_f16x2_fp8(v0, V_UNSCALE, true), w2, o[1]);
    o[2] = __builtin_elementwise_fma(cvt_f16x2_fp8(v1, V_UNSCALE, false), w2, o[2]); o[3] = __builtin_elementwise_fma(cvt_f16x2_fp8(v1, V_UNSCALE, true), w2, o[3]);
    o[4] = __builtin_elementwise_fma(cvt_f16x2_fp8(v2, V_UNSCALE, false), w2, o[4]); o[5] = __builtin_elementwise_fma(cvt_f16x2_fp8(v2, V_UNSCALE, true), w2, o[5]);
    o[6] = __builtin_elementwise_fma(cvt_f16x2_fp8(v3, V_UNSCALE, false), w2, o[6]); o[7] = __builtin_elementwise_fma(cvt_f16x2_fp8(v3, V_UNSCALE, true), w2, o[7]);
}
constexpr int TPW = 4, NSLICE = 16, SLICE_SHIFT = 10, NPAIR = TPW * NSEL, NPAIR_PAD = NPAIR + 3 * TPW * NSLICE + 32;
constexpr int PEER_LDS_PER_WAVE = TPW * 1024 + 64 + TPW * 2048 + NPAIR_PAD * 4;
static_assert(PEER_LDS_PER_WAVE * NWAVES <= RING_BYTES, "PEER LDS");
DI int incl_scan64(int v, int lane) {
    int s = v;
#pragma unroll
    for (int d = 1; d < 64; d <<= 1) { const int t = __shfl_up(s, d); if (lane >= d) s += t; }
    return s;
}
struct PeerBatch { v4u uu[4], vv[4]; unsigned ent[4]; float su[4]; };
DI void peer_load_batch(PeerBatch& B, const LAS unsigned* ml, int i, const unsigned char* EU8, const unsigned char* EV8, const float* SU, int lane, unsigned emask = 0x3fffu) {
    const v4u e4 = *(const LAS v4u*)(ml + i);
    B.ent[0] = (unsigned)__builtin_amdgcn_readfirstlane((int)e4.x); B.ent[1] = (unsigned)__builtin_amdgcn_readfirstlane((int)e4.y);
    B.ent[2] = (unsigned)__builtin_amdgcn_readfirstlane((int)e4.z); B.ent[3] = (unsigned)__builtin_amdgcn_readfirstlane((int)e4.w);
#pragma unroll
    for (int k = 0; k < 4; ++k) { const unsigned e = B.ent[k] & emask; const unsigned char* ur = EU8 + (size_t)e * DM; const unsigned char* vr = EV8 + (size_t)e * DM;
        B.uu[k] = *(const v4u*)(ur + (unsigned)(16 * lane)); B.vv[k] = *(const v4u*)(vr + (unsigned)(16 * lane)); B.su[k] = SU[e]; }
}
struct PeerState { unsigned x[4]; float sx; f16x2_t oc[8]; int curj; };
DI void peer_flush(PeerState& S, LAS unsigned char* ol, int lane) {
    LAS v4u* r = (LAS v4u*)(ol + S.curj * 2048) + lane;
#pragma unroll
    for (int c = 0; c < 2; ++c) { const v4u v = r[64 * c]; v4u o;
        o.x = __builtin_bit_cast(unsigned, __builtin_bit_cast(f16x2_t, (unsigned)v.x) + S.oc[4 * c]); o.y = __builtin_bit_cast(unsigned, __builtin_bit_cast(f16x2_t, (unsigned)v.y) + S.oc[4 * c + 1]);
        o.z = __builtin_bit_cast(unsigned, __builtin_bit_cast(f16x2_t, (unsigned)v.z) + S.oc[4 * c + 2]); o.w = __builtin_bit_cast(unsigned, __builtin_bit_cast(f16x2_t, (unsigned)v.w) + S.oc[4 * c + 3]);
        r[64 * c] = o; }
#pragma unroll
    for (int i = 0; i < 8; ++i) S.oc[i] = (f16x2_t){(_Float16)0.f, (_Float16)0.f};
}
DI void peer_compute_batch(const PeerBatch& B, PeerState& S, LAS unsigned char* ol, const LAS unsigned char* xl, int lane) {
    const int j = (int)((B.ent[0] >> 14) & 3u);
    if (j != S.curj) {
        if (S.curj >= 0) peer_flush(S, ol, lane);
        S.curj = j;
        const v4u y0 = ((const LAS v4u*)(xl + j * 1024))[lane];
        S.x[0] = y0.x; S.x[1] = y0.y; S.x[2] = y0.z; S.x[3] = y0.w; S.sx = ((const LAS float*)(xl + TPW * 1024))[j]; }
    const float d0 = (float)dot16_i8(B.uu[0], S.x) * B.su[0], d1 = (float)dot16_i8(B.uu[1], S.x) * B.su[1], d2 = (float)dot16_i8(B.uu[2], S.x) * B.su[2], d3 = (float)dot16_i8(B.uu[3], S.x) * B.su[3];
    const bool b0 = lane & 1, b1 = lane & 2;
    const float r0 = (b0 ? d1 : d0) + dpp_xor1(b0 ? d0 : d1), r1 = (b0 ? d3 : d2) + dpp_xor1(b0 ? d2 : d3);
    float t = (b1 ? r1 : r0) + dpp_xor2(b1 ? r0 : r1);
    t += __int_as_float(__builtin_amdgcn_update_dpp(0, __float_as_int(t), 0x124, 0xf, 0xf, true));
    t += __int_as_float(__builtin_amdgcn_update_dpp(0, __float_as_int(t), 0x128, 0xf, 0xf, true));
    { auto rr = __builtin_amdgcn_permlane16_swap(__float_as_uint(t), __float_as_uint(t), false, false); t = __uint_as_float(rr[0]) + __uint_as_float(rr[1]); }
    { auto rr = __builtin_amdgcn_permlane32_swap(__float_as_uint(t), __float_as_uint(t), false, false); t = __uint_as_float(rr[0]) + __uint_as_float(rr[1]); }
    const float act = gelu_tanh(t * S.sx);
#pragma unroll
    for (int k = 0; k < 4; ++k) { const float a = __builtin_bit_cast(float, __builtin_amdgcn_readlane(__builtin_bit_cast(int, act), k));
        axpy16_v8(S.oc, __uint_as_float(B.ent[k] & 0xffff0000u) * a, B.vv[k]); }
}
DI void p8b_peer(Frame& F, float* outp, unsigned emask = 0x3fffu) {
    const int lane = F.lane, w = F.wave;
    const int gw = F.vcu * NWAVES + w, NGW = F.G * NWAVES;
    const unsigned char* EU8 = F.wsp<unsigned char>(WS_EU); const unsigned char* EV8 = F.wsp<unsigned char>(WS_EV); const float* SU = F.wsp<float>(WS_SU);
    LAS unsigned char* xl = F.lds + w * PEER_LDS_PER_WAVE;
    LAS unsigned char* ol = xl + TPW * 1024 + 64;
    LAS unsigned* ml = (LAS unsigned*)(ol + TPW * 2048);
    for (int t0 = gw * TPW; t0 < M; t0 += NGW * TPW) {
        unsigned enta[TPW], entb[TPW]; int posa[TPW], posb[TPW], sla[TPW], slb[TPW], offs[TPW];
#pragma unroll
        for (int j = 0; j < TPW; ++j) { const size_t tok = (size_t)t0 + j;
            float rstd; { const f32x4* sp = (const f32x4*)(F.wsp<float>(WS_SSQ2) + tok * 16); const f32x4 st = (sp[0] + sp[1]) + (sp[2] + sp[3]); rstd = rsq_(((st.x + st.y) + (st.z + st.w)) * (1.f / 1024.f) + EPS); }
            { const bf16* xs = F.wsp<bf16>(WS_XN) + tok * DM + 16 * lane;
              const v4u x0 = *(const v4u*)xs, x1 = *(const v4u*)(xs + 8);
              float xf[16] = {bflo(x0.x), bfhi(x0.x), bflo(x0.y), bfhi(x0.y), bflo(x0.z), bfhi(x0.z), bflo(x0.w), bfhi(x0.w), bflo(x1.x), bfhi(x1.x), bflo(x1.y), bfhi(x1.y), bflo(x1.z), bfhi(x1.z), bflo(x1.w), bfhi(x1.w)};
              float mx = 0.f;
#pragma unroll
              for (int i = 0; i < 16; ++i) mx = fmaxf(mx, fabsf(xf[i]));
              mx = fmaxf(max64(mx), 1e-30f); const float inv = 127.0f / mx;
              v4u y; y.x = pack_i8x4(xf[0] * inv, xf[1] * inv, xf[2] * inv, xf[3] * inv); y.y = pack_i8x4(xf[4] * inv, xf[5] * inv, xf[6] * inv, xf[7] * inv);
              y.z = pack_i8x4(xf[8] * inv, xf[9] * inv, xf[10] * inv, xf[11] * inv); y.w = pack_i8x4(xf[12] * inv, xf[13] * inv, xf[14] * inv, xf[15] * inv);
              ((LAS v4u*)(xl + j * 1024))[lane] = y; if (lane == 0) ((LAS float*)(xl + TPW * 1024))[j] = mx * rstd * (1.0f / 127.0f);
              ((LAS v4u*)(ol + j * 2048))[lane] = (v4u){0u, 0u, 0u, 0u}; ((LAS v4u*)(ol + j * 2048))[64 + lane] = (v4u){0u, 0u, 0u, 0u}; }
            const int ea = F.wsp<int>(WS_IDX)[tok * NSEL + lane], eb = F.wsp<int>(WS_IDX)[tok * NSEL + 64 + lane];
            const float ga = F.wsp<float>(WS_G)[tok * NSEL + lane], gb = F.wsp<float>(WS_G)[tok * NSEL + 64 + lane];
            const int sa = ea >> SLICE_SHIFT, sb = eb >> SLICE_SHIFT;
            int pa = 0, pb = 0, myoff = 0;
#pragma unroll
            for (int bk = 0; bk < NSLICE; ++bk) { const unsigned long long ma = __ballot(sa == bk), mb = __ballot(sb == bk);
                const int ca = __popcll(ma), cb = __popcll(mb);
                const int ra = __builtin_amdgcn_mbcnt_hi((unsigned)(ma >> 32), __builtin_amdgcn_mbcnt_lo((unsigned)ma, 0)), rb = __builtin_amdgcn_mbcnt_hi((unsigned)(mb >> 32), __builtin_amdgcn_mbcnt_lo((unsigned)mb, 0));
                pa = (sa == bk) ? ra : pa; pb = (sb == bk) ? ca + rb : pb;
                myoff = (lane == bk) ? ca + cb : myoff; }
            enta[j] = (unsigned)ea | ((unsigned)j << 14) | (pk2(0.f, ga) & 0xffff0000u); entb[j] = (unsigned)eb | ((unsigned)j << 14) | (pk2(0.f, gb) & 0xffff0000u);
            posa[j] = pa; posb[j] = pb; sla[j] = sa; slb[j] = sb; offs[j] = myoff;
        }
        int cnt = 0;
#pragma unroll
        for (int j = 0; j < TPW; ++j) { const int c = __shfl(offs[j], lane >> 2); cnt = ((lane & 3) == j) ? c : cnt; }
        const int cpad = (cnt + 3) & ~3;
        const int bend = incl_scan64(cpad, lane), bstart = bend - cpad;
        const int npad = __builtin_amdgcn_readlane(bend, 63);
#pragma unroll
        for (int j = 0; j < TPW; ++j) { const int ba = __shfl(bstart, 4 * sla[j] + j), bb = __shfl(bstart, 4 * slb[j] + j);
            ml[ba + posa[j]] = enta[j]; ml[bb + posb[j]] = entb[j]; }
        { const unsigned pad = (unsigned)((lane >> 2) << SLICE_SHIFT) | ((unsigned)(lane & 3) << 14);
#pragma unroll
          for (int q = 0; q < 3; ++q) if (cnt + q < cpad) ml[bstart + cnt + q] = pad; }
        if (lane < 28) ml[npad + lane] = (unsigned)((NSLICE - 1) << SLICE_SHIFT) | (3u << 14);
        LDS_WAIT();
        PeerState S;
#pragma unroll
        for (int i = 0; i < 8; ++i) { S.x[i] = 0u; S.oc[i] = (f16x2_t){(_Float16)0.f, (_Float16)0.f}; }
        S.curj = -1;
        PeerBatch A, B, C, D;
        peer_load_batch(A, ml, 0, EU8, EV8, SU, lane, emask); peer_load_batch(B, ml, 4, EU8, EV8, SU, lane, emask); peer_load_batch(C, ml, 8, EU8, EV8, SU, lane, emask);
#pragma unroll 1
        for (int i = 0; i < npad; i += 16) {
            peer_load_batch(D, ml, i + 12, EU8, EV8, SU, lane, emask); peer_compute_batch(A, S, ol, xl, lane);
            peer_load_batch(A, ml, i + 16, EU8, EV8, SU, lane, emask); peer_compute_batch(B, S, ol, xl, lane);
            peer_load_batch(B, ml, i + 20, EU8, EV8, SU, lane, emask); peer_compute_batch(C, S, ol, xl, lane);
            peer_load_batch(C, ml, i + 24, EU8, EV8, SU, lane, emask); peer_compute_batch(D, S, ol, xl, lane);
        }
        peer_flush(S, ol, lane);
        LDS_WAIT();
#pragma unroll
        for (int j = 0; j < TPW; ++j) {
            const float* xr = F.out + ((size_t)t0 + j) * DM + 16 * lane; float* orow = outp + ((size_t)t0 + j) * DM + 16 * lane;
            f32x4 a[4]; float ss = 0.f;
            const v4u h0 = ((const LAS v4u*)(ol + j * 2048))[lane], h1 = ((const LAS v4u*)(ol + j * 2048))[64 + lane];
            const unsigned hw[8] = {h0.x, h0.y, h0.z, h0.w, h1.x, h1.y, h1.z, h1.w};
#pragma unroll
            for (int q = 0; q < 4; ++q) { const f16x2_t p0 = __builtin_bit_cast(f16x2_t, hw[2 * q]), p1 = __builtin_bit_cast(f16x2_t, hw[2 * q + 1]);
                a[q] = *(const f32x4*)(xr + 4 * q) + (f32x4){(float)p0.x, (float)p0.y, (float)p1.x, (float)p1.y};
                ss += (a[q].x * a[q].x + a[q].y * a[q].y) + (a[q].z * a[q].z + a[q].w * a[q].w); }
            const float rf = rsq_(sum64(ss) * (1.f / 1024.f) + EPS);
#pragma unroll
            for (int q = 0; q < 4; ++q) *(f32x4*)(orow + 4 * q) = a[q] * rf * *(const f32x4*)(F.in(25) + 16 * lane + 4 * q);
        }
        LDS_WAIT();
    }
}
constexpr int N_PHASES = 11;
__global__ void __launch_bounds__(NWAVES * 64, 2) fwd_kernel(Args args) {
    extern __shared__ __attribute__((aligned(16))) unsigned char lds[];
    Frame F;
    F.lds = (LAS unsigned char*)lds;
    F.MISC = (volatile LAS unsigned*)(F.lds + MISC_OFF);
    F.tid = threadIdx.x; F.lane = F.tid & 63; F.wave = __builtin_amdgcn_readfirstlane(F.tid >> 6);
    F.G = gridDim.x; { const int bx = blockIdx.x; F.vcu = (F.G % 8 == 0) ? (bx % 8) * (F.G / 8) + bx / 8 : bx; }
    F.A = &args; F.ws = args.ws; F.out = args.out;
    F.ctl = (gu32*)(args.ws + WS_CTL);
    for (int u = F.tid; u < (LDS_BYTES - LDSCTL_OFF) / 4; u += NWAVES * 64) ((LAS unsigned*)(F.lds + LDSCTL_OFF))[u] = 0u;
    __syncthreads();
    const bool multi = (args.ph_hi - args.ph_lo) > 1;
    XcdBarrier bar; bar.bar = (unsigned*)(F.ctl + CW_BAR) + args.li * XCD_BAR_WORDS; bar.x = 0; bar.st = nullptr;
    if (multi) bar = xcd_barrier_post((unsigned*)(F.ctl + CW_BAR) + args.li * XCD_BAR_WORDS, F.MISC + 8);
    const int lo = args.ph_lo, hi = args.ph_hi;
#ifndef PROBE_EMASK
#define PROBE_EMASK 0x3fffu
#endif
#ifndef PHASE_REPEAT
#define PHASE_REPEAT 0
#endif
#define REP(k) for (int rep_ = 0; rep_ < (((PHASE_REPEAT >> (k)) & 1) ? 2 : 1); ++rep_)
#ifndef PHASE_MASK
#define PHASE_MASK 0x7ff
#endif
#define IN(k) (((PHASE_MASK >> (k)) & 1) && lo <= (k) && (k) < hi)
#define SEAM(k) do { asm volatile("; ===SEAM " #k ::: "memory"); if (IN(k) && IN((k) + 1)) xcd_barrier(bar); } while (0)
    const int c = (int)blockIdx.x;

    if (IN(0)) REP(0) { p0_prologue(F); } SEAM(0);
    if (IN(1)) REP(1) {
        { pg8::Gemm g{F.wsp<bf16>(WS_XN), F.wsp<bf16>(WS_WIN), M, INW, DM}; pg8::StaticOrder S; S.init(M, INW, F.G, c);
          pg8::EpiSplitT E{F.wsp<bf16>(WS_Z), ZW, ZW, F.wsp<bf16>(WS_VT), ATTW, SEQ};
          pg8::gemm_phase<pg8::EpiSplitT, pg8::StaticOrder, true, true>(F.lds, g, S, E); }
        { const int nw3 = (M / 256) * (INW / 256) - 2 * F.G;
          int idx = -1; if (nw3 >= 0 && nw3 + 16 <= F.G) idx = c - nw3; else idx = (c < 16 && F.G >= 16) ? c : -1;
          if (F.G < 16) idx = -1;
          pg8::Gemm g{F.wsp<bf16>(WS_MEMN), F.wsp<bf16>(WS_WKV), NBATCH * 256, 2 * DM, DM};
          if (F.G >= 16) { pg8::OneUnit S{idx, 2, 8}; pg8::EpiSplitT E{F.wsp<bf16>(WS_KM), DM, DM, F.wsp<bf16>(WS_VMT), DM, 256};
              pg8::gemm_phase<pg8::EpiSplitT, pg8::OneUnit, false, true>(F.lds, g, S, E); }
          else { pg8::StaticOrder S; S.init(NBATCH * 256, 2 * DM, F.G, c); pg8::EpiSplitT E{F.wsp<bf16>(WS_KM), DM, DM, F.wsp<bf16>(WS_VMT), DM, 256};
              pg8::gemm_phase<pg8::EpiSplitT, pg8::StaticOrder, false, true>(F.lds, g, S, E); } }
    } SEAM(1);
    if (IN(2)) REP(2) { p2_lru_aggregates(F); } SEAM(2);
    if (IN(3)) REP(3) { p3_mixer(F); } SEAM(3);
    if (IN(4)) REP(4) {
        pg8::Gemm g{F.wsp<bf16>(WS_Y), F.wsp<bf16>(WS_WOUT), M, DM, DM}; pg8::StaticOrder S; S.init(M, DM, F.G, c);
        pg8::EpiResid E{F.in(0), F.out, F.wsp<bf16>(WS_XN), F.wsp<float>(WS_SSQ1), DM};
        pg8::gemm_phase<pg8::EpiResid, pg8::StaticOrder, true, true>(F.lds, g, S, E);
    } SEAM(4);
    if (IN(5)) REP(5) {
        pg8::Gemm g{F.wsp<bf16>(WS_XN), F.wsp<bf16>(WS_WQ), M, DM, DM}; pg8::StaticOrder S; S.init(M, DM, F.G, c);
        pg8::EpiRowScale E{F.wsp<bf16>(WS_QC), DM, F.wsp<float>(WS_SSQ1), 1.f / 1024.f, EPS};
        pg8::gemm_phase<pg8::EpiRowScale, pg8::StaticOrder, true, true>(F.lds, g, S, E);
    } SEAM(5);
    if (IN(6)) REP(6) { p5_cross(F); } SEAM(6);
    if (IN(7)) {
        pg8::Gemm g{F.wsp<bf16>(WS_OC), F.wsp<bf16>(WS_WO), M, DM, DM}; pg8::StaticOrder S; S.init(M, DM, F.G, c);
        pg8::EpiResid E{F.out, F.out, F.wsp<bf16>(WS_XN), F.wsp<float>(WS_SSQ2), DM};
        pg8::gemm_phase<pg8::EpiResid, pg8::StaticOrder, true, true>(F.lds, g, S, E);
    } SEAM(7);
    if (IN(8)) REP(8) {
        pg8::Gemm g{F.wsp<bf16>(WS_XN), F.wsp<bf16>(WS_WQRY), M, 2 * DM, DM}; pg8::StaticOrder S; S.init(M, 2 * DM, F.G, c);
        pg8::EpiRowScale E{F.wsp<bf16>(WS_QP), 2 * DM, F.wsp<float>(WS_SSQ2), 1.f / 1024.f, EPS};
        pg8::gemm_phase<pg8::EpiRowScale, pg8::StaticOrder, true, true>(F.lds, g, S, E);
    } SEAM(8);
    if (IN(9)) REP(9) { p8a_topk(F); } SEAM(9);
    if (IN(10)) { if ((PHASE_REPEAT >> 10) & 1) { p8b_peer(F, F.wsp<float>(WS_Z), PROBE_EMASK); } p8b_peer(F, F.out); }
#undef IN
#undef SEAM
}

#ifndef N_LAUNCH_MODE
#define N_LAUNCH_MODE 1
#endif
extern "C" void kernel_launch(void* const* d_in, const int* in_sizes, int n_in, void* d_out, int out_size, void* d_ws, size_t ws_size, hipStream_t stream) {
    static int grid = 0;
    if (grid == 0) {
        if (n_in != 26 || out_size != M * DM || ws_size < WS_END) { fprintf(stderr, "kernel_launch: unexpected shapes (n_in %d, out %d, ws %zu)\n", n_in, out_size, ws_size); grid = -1; return; }
        int dev = 0, cus = 0, per_cu = 0;
        if (hipGetDevice(&dev) != hipSuccess || hipDeviceGetAttribute(&cus, hipDeviceAttributeMultiprocessorCount, dev) != hipSuccess) { grid = -1; return; }
        if (hipFuncSetAttribute((const void*)fwd_kernel, hipFuncAttributeMaxDynamicSharedMemorySize, LDS_BYTES) != hipSuccess) { fprintf(stderr, "kernel_launch: hipFuncSetAttribute failed\n"); grid = -1; return; }
        if (hipOccupancyMaxActiveBlocksPerMultiprocessor(&per_cu, (const void*)fwd_kernel, NWAVES * 64, LDS_BYTES) != hipSuccess || per_cu < 1) { fprintf(stderr, "kernel_launch: occupancy query says %d blocks per CU\n", per_cu); (void)hipGetLastError(); grid = -1; return; }
        grid = cus;
    }
    if (grid < 0) return;
    (void)hipMemsetAsync((char*)d_ws + WS_CTL, 0, CTL_ZERO_BYTES, stream);
    Args a{};
    for (int i = 0; i < 26; ++i) a.in[i] = (const float*)d_in[i];
    a.out = (float*)d_out; a.ws = (unsigned char*)d_ws;
    if (N_LAUNCH_MODE == 1) { a.ph_lo = 0; a.ph_hi = N_PHASES; a.li = 0; hipLaunchKernelGGL(fwd_kernel, dim3(grid), dim3(NWAVES * 64), LDS_BYTES, stream, a); }
    else { for (int p = 0; p < N_PHASES; ++p) { a.ph_lo = p; a.ph_hi = p + 1; a.li = 0; hipLaunchKernelGGL(fwd_kernel, dim3(grid), dim3(NWAVES * 64), LDS_BYTES, stream, a); } }
}
```

```cpp
#include <hip/hip_runtime.h>
#include <cstdio>
#include <cstdint>
namespace pg8 {
#define PG8_LAS __attribute__((address_space(3)))
typedef unsigned short bf16_t;
typedef short bf16x8 __attribute__((ext_vector_type(8)));
typedef float f32x4 __attribute__((ext_vector_type(4)));
typedef unsigned u32x4 __attribute__((ext_vector_type(4)));
constexpr int BM = 256, BK = 64, HALF = 128, HTB = HALF * BK * 2  , STAGE_BYTES = 8 * HTB, NXCD = 8, WGM = 8;

__host__ __device__ __forceinline__ int lds_byte(int r, int c) { const int st = (r >> 4) * 2 + (c >> 5), rr = r & 15, cc = c & 31, ob = rr * 64 + cc * 2; return st * 1024 + (ob ^ (((ob >> 9) & 1) << 5)); }
__host__ __device__ __forceinline__ void stage_rc(int b, int& R, int& C) { const int st = b / 1024, sb = b % 1024, swz = sb ^ (((sb >> 9) & 1) << 5); R = (st >> 1) * 16 + swz / 64; C = (st & 1) * 32 + (swz % 64) / 2; }
__host__ __device__ __forceinline__ int perm32(int rho) { const int n = rho >> 4, i = rho & 15; return 8 * (i >> 2) + 4 * n + (i & 3); }

struct Unit { int pm, pn; };
struct Gemm { const bf16_t* A; const bf16_t* Bt; int M, N, K; };

struct StaticOrder {
    int nM, nN, nwg, G, c;
    __host__ __device__ void init(int M, int N, int G_, int c_) { nM = M / BM; nN = N / BM; nwg = nM * nN; G = G_; c = c_; }
    __host__ __device__ bool next(int i, Unit& u) const {
        const long L = (long)i * G + c; if (L >= nwg) return false;
        int wgid = (int)L; { const int q = nwg / NXCD, r = nwg % NXCD, xcd = wgid % NXCD, off = wgid / NXCD; wgid = (xcd < r ? xcd * (q + 1) : r * (q + 1) + (xcd - r) * q) + off; }
        const int nig = WGM * nN, gid = wgid / nig, fm = gid * WGM, gsz = (nM - fm) < WGM ? (nM - fm) : WGM;
        u.pm = fm + ((wgid % nig) % gsz); u.pn = (wgid % nig) / gsz; return true;
    }
    __device__ __forceinline__ void a_ready(const Unit&) const {}
    __device__ __forceinline__ void done(const Unit&) const {}
};

typedef float f32x2 __attribute__((ext_vector_type(2)));
typedef __bf16 bf16x2_t __attribute__((ext_vector_type(2)));
__device__ __forceinline__ unsigned cvt_pk_bf16(float lo, float hi) { f32x2 v = {lo, hi}; bf16x2_t b = __builtin_convertvector(v, bf16x2_t); return __builtin_bit_cast(unsigned, b); }
__device__ __forceinline__ bf16_t cvt_bf16(float x) { return (bf16_t)(cvt_pk_bf16(x, 0.f) & 0xffffu); }

struct EpiSplitT {
    static constexpr bool PERM = true, AFTER_DRAIN = false;
    bf16_t* O; int ldc; int ncols_rm; bf16_t* T; int NT; int rpb;
    __device__ __forceinline__ void operator()(const f32x4 (&acc)[2][2][4][2], const Unit& u, int wr, int wc, int fr, int fq) const {
        const int row0 = u.pm * BM + wr * 64 + fr; const int colt = u.pn * BM;
        if (colt < ncols_rm) {
            const int col0 = colt + wc * 32 + 8 * fq;
#pragma unroll
            for (int ai = 0; ai < 2; ++ai)
#pragma unroll
                for (int m = 0; m < 4; ++m) { bf16_t* rowp = O + (size_t)(row0 + ai * HALF + m * 16) * ldc + col0;
#pragma unroll
                    for (int bj = 0; bj < 2; ++bj) { const f32x4 v0 = acc[ai][bj][m][0], v1 = acc[ai][bj][m][1];
                        u32x4 w; w.x = cvt_pk_bf16(v0[0], v0[1]); w.y = cvt_pk_bf16(v0[2], v0[3]); w.z = cvt_pk_bf16(v1[0], v1[1]); w.w = cvt_pk_bf16(v1[2], v1[3]);
                        *(u32x4*)(rowp + bj * HALF) = w; } }
        } else {
            const int c0 = colt - ncols_rm + wc * 32 + 8 * fq;
#pragma unroll
            for (int ai = 0; ai < 2; ++ai)
#pragma unroll
                for (int m = 0; m < 4; ++m) { const int row = row0 + ai * HALF + m * 16; const int b = row / rpb, t = row - b * rpb; bf16_t* base = T + (size_t)b * NT * rpb + t;
#pragma unroll
                    for (int bj = 0; bj < 2; ++bj)
#pragma unroll
                        for (int n = 0; n < 2; ++n)
#pragma unroll
                            for (int e = 0; e < 4; ++e) base[(size_t)(c0 + bj * HALF + 4 * n + e) * rpb] = cvt_bf16(acc[ai][bj][m][n][e]); }
        }
    }
};
struct EpiResid {
    static constexpr bool PERM = true, AFTER_DRAIN = false;
    const float* base; float* out; bf16_t* xb; float* ssq; int ldc;
    __device__ __forceinline__ void operator()(const f32x4 (&acc)[2][2][4][2], const Unit& u, int wr, int wc, int fr, int fq) const {
        const int row0 = u.pm * BM + wr * 64 + fr; const int col0 = u.pn * BM + wc * 32 + 8 * fq;
#pragma unroll
        for (int ai = 0; ai < 2; ++ai)
#pragma unroll
            for (int m = 0; m < 4; ++m) { const int row = row0 + ai * HALF + m * 16; float s = 0.f;
#pragma unroll
                for (int bj = 0; bj < 2; ++bj) { const size_t off = (size_t)row * ldc + col0 + bj * HALF;
                    const f32x4 b0 = *(const f32x4*)(base + off), b1 = *(const f32x4*)(base + off + 4);
                    const f32x4 v0 = acc[ai][bj][m][0] + b0, v1 = acc[ai][bj][m][1] + b1;
                    *(f32x4*)(out + off) = v0; *(f32x4*)(out + off + 4) = v1;
                    s += (v0[0] * v0[0] + v0[1] * v0[1]) + (v0[2] * v0[2] + v0[3] * v0[3]) + (v1[0] * v1[0] + v1[1] * v1[1]) + (v1[2] * v1[2] + v1[3] * v1[3]);
                    u32x4 w; w.x = cvt_pk_bf16(v0[0], v0[1]); w.y = cvt_pk_bf16(v0[2], v0[3]); w.z = cvt_pk_bf16(v1[0], v1[1]); w.w = cvt_pk_bf16(v1[2], v1[3]);
                    *(u32x4*)(xb + off) = w; }
                s += __shfl_xor(s, 16); s += __shfl_xor(s, 32);
                if (fq == 0) ssq[(size_t)row * 16 + u.pn * 4 + wc] = s; }
    }
};
struct EpiRowScale {
    static constexpr bool PERM = true, AFTER_DRAIN = false;
    bf16_t* O; int ldc; const float* ssq; float inv_n, eps;
    __device__ __forceinline__ void operator()(const f32x4 (&acc)[2][2][4][2], const Unit& u, int wr, int wc, int fr, int fq) const {
        const int row0 = u.pm * BM + wr * 64 + fr; const int col0 = u.pn * BM + wc * 32 + 8 * fq;
#pragma unroll
        for (int ai = 0; ai < 2; ++ai)
#pragma unroll
            for (int m = 0; m < 4; ++m) { const int row = row0 + ai * HALF + m * 16; const f32x4* sp = (const f32x4*)(ssq + (size_t)row * 16);
                const f32x4 s0 = sp[0], s1 = sp[1], s2 = sp[2], s3 = sp[3]; const f32x4 st = (s0 + s1) + (s2 + s3);
                const float r = 1.0f / sqrtf(((st[0] + st[1]) + (st[2] + st[3])) * inv_n + eps);
                bf16_t* rowp = O + (size_t)row * ldc + col0;
#pragma unroll
                for (int bj = 0; bj < 2; ++bj) { const f32x4 v0 = acc[ai][bj][m][0] * r, v1 = acc[ai][bj][m][1] * r;
                    u32x4 w; w.x = cvt_pk_bf16(v0[0], v0[1]); w.y = cvt_pk_bf16(v0[2], v0[3]); w.z = cvt_pk_bf16(v1[0], v1[1]); w.w = cvt_pk_bf16(v1[2], v1[3]);
                    *(u32x4*)(rowp + bj * HALF) = w; } }
    }
};
struct OneUnit {
    int idx, nM, nN;
    __device__ __forceinline__ bool next(int i, Unit& u) const { if (i > 0 || idx < 0 || idx >= nM * nN) return false; u.pm = idx % nM; u.pn = idx / nM; return true; }
    __device__ __forceinline__ void a_ready(const Unit&) const {}
    __device__ __forceinline__ void done(const Unit&) const {}
};

template <class Epi, class Sched, bool ALIGN_EPI = false, bool SP2 = false>
__device__ __forceinline__ void gemm_phase(PG8_LAS unsigned char* lds, const Gemm g, const Sched& S, const Epi& E) {
    const int tid = threadIdx.x, wid = __builtin_amdgcn_readfirstlane(tid >> 6), lane = tid & 63, wr = wid >> 2, wc = wid & 3, fr = lane & 15, fq = lane >> 4;
    const int K = g.K, nt = K / BK;
    unsigned voffA[2], voffB[2];
#pragma unroll
    for (int i = 0; i < 2; ++i) { int R, C; stage_rc(tid * 16 + i * 8192, R, C); const int Rb = Epi::PERM ? ((R & ~31) + perm32(R & 31)) : R;
        voffA[i] = (unsigned)(R * K + C) * 2u; voffB[i] = (unsigned)(Rb * K + C) * 2u; }
    const size_t kstep = (size_t)(BK * 2);
    const size_t hstep = (size_t)HALF * K * 2;
    const size_t tstep = 2 * hstep;
    const unsigned ldsw = (unsigned)wid * 1024u;
    const int aoff = lds_byte(wr * 64 + fr, fq * 8), boff = lds_byte(wc * 32 + fr, fq * 8);
#define PG8_SA(b, h) (((b) * 2 + (h)) * HTB)
#define PG8_SB(b, h) ((4 + (b) * 2 + (h)) * HTB)
#define PG8_STAGE(bufoff, gbase, voff) do { _Pragma("unroll") for (int _i = 0; _i < 2; ++_i) \
        __builtin_amdgcn_global_load_lds((const unsigned*)((const char*)(gbase) + (voff)[_i]), (PG8_LAS unsigned*)(lds + (bufoff) + ldsw + _i * 8192), 16, 0, 0); } while (0)
#define PG8_LDA(dst, b, h) do { _Pragma("unroll") for (int m = 0; m < 4; ++m) _Pragma("unroll") for (int k = 0; k < 2; ++k) dst[m][k] = *(const PG8_LAS bf16x8*)(lds + PG8_SA(b, h) + aoff + m * 2048 + k * 1024); } while (0)
#define PG8_LDB(dst, b, h) do { _Pragma("unroll") for (int n = 0; n < 2; ++n) _Pragma("unroll") for (int k = 0; k < 2; ++k) dst[n][k] = *(const PG8_LAS bf16x8*)(lds + PG8_SB(b, h) + boff + n * 2048 + k * 1024); } while (0)
#define PG8_MMA(ai, bj, At, Bt) do { __builtin_amdgcn_s_setprio(1); _Pragma("unroll") for (int m = 0; m < 4; ++m) _Pragma("unroll") for (int n = 0; n < 2; ++n) _Pragma("unroll") for (int k = 0; k < 2; ++k) \
        acc[ai][bj][m][n] = __builtin_amdgcn_mfma_f32_16x16x32_bf16(Bt[n][k], At[m][k], acc[ai][bj][m][n], 0, 0, 0); __builtin_amdgcn_s_setprio(0); } while (0)
#define PG8_WAIT_V(n) asm volatile("s_waitcnt vmcnt(" #n ")" ::: "memory")
#define PG8_WAIT_L(n) asm volatile("s_waitcnt lgkmcnt(" #n ")" ::: "memory")
#define PG8_BAR __builtin_amdgcn_s_barrier()
#define PG8_SCHED __builtin_amdgcn_sched_barrier(0)
    Unit cur, nxt; int ui = 0;
    if (!S.next(0, cur)) return;
    f32x4 acc[2][2][4][2];
#pragma unroll
    for (int a = 0; a < 2; ++a)
#pragma unroll
        for (int b = 0; b < 2; ++b)
#pragma unroll
            for (int m = 0; m < 4; ++m)
#pragma unroll
                for (int n = 0; n < 2; ++n) acc[a][b][m][n] = (f32x4){0.f, 0.f, 0.f, 0.f};
    bf16x8 At[4][2], B0[2][2], B1[2][2];
    const char* cA = (const char*)g.A + (size_t)cur.pm * tstep; const char* cB = (const char*)g.Bt + (size_t)cur.pn * tstep;
    S.a_ready(cur);
    if constexpr (SP2) {
        PG8_STAGE(PG8_SB(0, 0), cB, voffB); PG8_STAGE(PG8_SB(0, 1), cB + hstep, voffB); PG8_STAGE(PG8_SA(0, 0), cA, voffA); PG8_STAGE(PG8_SA(0, 1), cA + hstep, voffA);
        if (wr == 1) PG8_BAR;
        PG8_WAIT_V(2); PG8_BAR;
        PG8_STAGE(PG8_SB(1, 0), cB + kstep, voffB); PG8_STAGE(PG8_SA(1, 0), cA + kstep, voffA); PG8_STAGE(PG8_SB(1, 1), cB + hstep + kstep, voffB);
        PG8_WAIT_V(6); PG8_BAR;
    } else {
        PG8_STAGE(PG8_SB(0, 0), cB, voffB); PG8_STAGE(PG8_SA(0, 0), cA, voffA); PG8_STAGE(PG8_SB(0, 1), cB + hstep, voffB); PG8_STAGE(PG8_SA(0, 1), cA + hstep, voffA);
        if (wr == 1) PG8_BAR;
        PG8_WAIT_V(4); PG8_BAR;
        PG8_STAGE(PG8_SB(1, 0), cB + kstep, voffB); PG8_STAGE(PG8_SA(1, 0), cA + kstep, voffA); PG8_STAGE(PG8_SB(1, 1), cB + hstep + kstep, voffB);
        PG8_WAIT_V(6); PG8_BAR;
    }
    for (;;) {
        const bool has_next = S.next(ui + 1, nxt);
        const char* nA = has_next ? (const char*)g.A + (size_t)nxt.pm * tstep : cA; const char* nB = has_next ? (const char*)g.Bt + (size_t)nxt.pn * tstep : cB;
        for (int t = 0; t < nt; t += 2) {
            const bool last = (t == nt - 2);
            const char* a1 = cA + (size_t)(t + 1) * kstep;
            const char* a2 = last ? nA : cA + (size_t)(t + 2) * kstep; const char* b2 = last ? nB : cB + (size_t)(t + 2) * kstep;
            const char* a3 = a2 + kstep; const char* b3 = b2 + kstep;
            if (last && has_next) S.a_ready(nxt);
            if constexpr (SP2) {
            PG8_LDB(B0, 0, 0); PG8_LDB(B1, 0, 1); PG8_SCHED; PG8_LDA(At, 0, 0); PG8_STAGE(PG8_SA(1, 1), a1 + hstep, voffA);
            PG8_WAIT_V(8); PG8_WAIT_L(0); PG8_BAR; PG8_MMA(0, 0, At, B0); PG8_MMA(0, 1, At, B1); PG8_BAR; PG8_SCHED;
            PG8_LDA(At, 0, 1); PG8_STAGE(PG8_SB(0, 0), b2, voffB); PG8_STAGE(PG8_SB(0, 1), b2 + hstep, voffB); PG8_STAGE(PG8_SA(0, 0), a2, voffA);
            PG8_WAIT_V(8); PG8_WAIT_L(0); PG8_BAR; PG8_MMA(1, 0, At, B0); PG8_MMA(1, 1, At, B1); PG8_BAR; PG8_SCHED;
            PG8_LDB(B0, 1, 0); PG8_LDB(B1, 1, 1); PG8_SCHED; PG8_LDA(At, 1, 0); PG8_STAGE(PG8_SA(0, 1), a2 + hstep, voffA);
            PG8_WAIT_V(8); PG8_WAIT_L(0); PG8_BAR; PG8_MMA(0, 0, At, B0); PG8_MMA(0, 1, At, B1); PG8_BAR; PG8_SCHED;
            PG8_LDA(At, 1, 1); PG8_STAGE(PG8_SB(1, 0), b3, voffB); PG8_STAGE(PG8_SB(1, 1), b3 + hstep, voffB); PG8_STAGE(PG8_SA(1, 0), a3, voffA);
            PG8_WAIT_V(8); PG8_WAIT_L(0); PG8_BAR; PG8_MMA(1, 0, At, B0); PG8_MMA(1, 1, At, B1); PG8_BAR; PG8_SCHED;
            } else {
            PG8_LDB(B0, 0, 0); PG8_SCHED; PG8_LDA(At, 0, 0); PG8_STAGE(PG8_SA(1, 1), a1 + hstep, voffA);
            PG8_WAIT_L(8); PG8_BAR; PG8_WAIT_L(0); PG8_MMA(0, 0, At, B0); PG8_BAR; PG8_SCHED;
            PG8_LDB(B1, 0, 1); PG8_STAGE(PG8_SB(0, 0), b2, voffB);
            PG8_BAR; PG8_WAIT_L(0); PG8_MMA(0, 1, At, B1); PG8_BAR;
            PG8_LDA(At, 0, 1); PG8_STAGE(PG8_SA(0, 0), a2, voffA);
            PG8_BAR; PG8_WAIT_L(0); PG8_MMA(1, 0, At, B0); PG8_BAR; PG8_SCHED;
            PG8_STAGE(PG8_SB(0, 1), b2 + hstep, voffB);
            PG8_WAIT_V(6); PG8_BAR; PG8_MMA(1, 1, At, B1); PG8_BAR;
            PG8_LDB(B0, 1, 0); PG8_SCHED; PG8_LDA(At, 1, 0); PG8_STAGE(PG8_SA(0, 1), a2 + hstep, voffA);
            PG8_WAIT_L(8); PG8_BAR; PG8_WAIT_L(0); PG8_MMA(0, 0, At, B0); PG8_BAR; PG8_SCHED;
            PG8_LDB(B1, 1, 1); PG8_STAGE(PG8_SB(1, 0), b3, voffB);
            PG8_BAR; PG8_WAIT_L(0); PG8_MMA(0, 1, At, B1); PG8_BAR;
            PG8_LDA(At, 1, 1); PG8_STAGE(PG8_SA(1, 0), a3, voffA);
            PG8_BAR; PG8_WAIT_L(0); PG8_MMA(1, 0, At, B0); PG8_BAR; PG8_SCHED;
            PG8_STAGE(PG8_SB(1, 1), b3 + hstep, voffB);
            PG8_WAIT_V(6); PG8_BAR; PG8_MMA(1, 1, At, B1); PG8_BAR;
            }
        }
        if constexpr (ALIGN_EPI) { if (wr == 0) PG8_BAR; }
        if constexpr (!Epi::AFTER_DRAIN) { E(acc, cur, wr, wc, fr, fq); S.done(cur); }
        if (!has_next) break;
#pragma unroll
        for (int a = 0; a < 2; ++a)
#pragma unroll
            for (int b = 0; b < 2; ++b)
#pragma unroll
                for (int m = 0; m < 4; ++m)
#pragma unroll
                    for (int n = 0; n < 2; ++n) acc[a][b][m][n] = (f32x4){0.f, 0.f, 0.f, 0.f};
        cur = nxt; cA = nA; cB = nB; ++ui;
        if constexpr (ALIGN_EPI) { if (wr == 1) PG8_BAR; }
    }
    PG8_WAIT_V(0);
    if constexpr (!ALIGN_EPI) { if (wr == 0) PG8_BAR; }
    PG8_BAR;
    if constexpr (Epi::AFTER_DRAIN) { E.fused(acc, cur, wr, wc, fr, fq, lds, wid, lane); S.done(cur); }
#undef PG8_SA
#undef PG8_SB
#undef PG8_STAGE
#undef PG8_LDA
#undef PG8_LDB
#undef PG8_MMA
#undef PG8_WAIT_V
#undef PG8_WAIT_L
#undef PG8_BAR
#undef PG8_SCHED
}
}

#ifndef PG8_SP2
#define PG8_SP2 true
#endif
#ifndef PG8_ALIGN
#define PG8_ALIGN true
#endif
constexpr int NWAVES = 8;
constexpr int NBATCH = 2, SEQ = 8192, DM = 1024, M = NBATCH * SEQ;
constexpr int INW = 2560, ZW = 2048;
constexpr int LRUW = 512, ATTW = 512, NCHUNK = SEQ / 64;
constexpr int NEXP = 16384, PEER_H = 8, NSEL = 128;
constexpr float EPS = 1e-6f;
constexpr float LOG2E = 1.4426950408889634f;

constexpr size_t MiB = 1u << 20;
constexpr size_t WS_CTL = 0, CTL_ZERO_BYTES = 1 * MiB;
constexpr size_t WS_WIN = 1 * MiB, WS_WOUT = 6 * MiB, WS_WQ = 8 * MiB, WS_WKV = 10 * MiB, WS_WO = 14 * MiB, WS_WQRY = 16 * MiB;
constexpr size_t WS_SUBK = 20 * MiB, WS_GATEW = 20 * MiB + 512 * 1024, WS_MEMN = 21 * MiB, WS_KM = 22 * MiB, WS_VMT = 23 * MiB, WS_AGG = 24 * MiB, WS_SSQ1 = 25 * MiB, WS_SSQ2 = 26 * MiB, WS_SU = 27 * MiB;
constexpr size_t WS_EU = 28 * MiB, WS_EV = 60 * MiB, WS_XN = 92 * MiB, WS_Z = 124 * MiB, WS_VT = 188 * MiB, WS_Y = 204 * MiB, WS_END = 236 * MiB;
constexpr size_t WS_QC = WS_Z, WS_OC = WS_Z + 32 * MiB, WS_QP = WS_Z, WS_IDX = WS_VT, WS_G = WS_VT + 8 * MiB;
constexpr int CW_BAR = 4096;

constexpr int RING_BYTES = 155648;
constexpr int LDSCTL_OFF = RING_BYTES, MISC_OFF = LDSCTL_OFF + 320;
constexpr int LDS_BYTES = 163840;

#define GAS __attribute__((address_space(1)))
#define LAS __attribute__((address_space(3)))
typedef unsigned short bf16;
typedef unsigned v4u __attribute__((ext_vector_type(4)));
typedef unsigned v2u __attribute__((ext_vector_type(2)));
typedef float f32x4 __attribute__((ext_vector_type(4)));
typedef float f32x2 __attribute__((ext_vector_type(2)));
typedef float f32x16 __attribute__((ext_vector_type(16)));
typedef short bf16x8 __attribute__((ext_vector_type(8)));
typedef __bf16 bf16x2_t __attribute__((ext_vector_type(2)));
typedef GAS unsigned gu32;
#define RLX_AGENT __ATOMIC_RELAXED, __HIP_MEMORY_SCOPE_AGENT
#define LDS_WAIT() asm volatile("s_waitcnt lgkmcnt(0)" ::: "memory")
#define VM_WAIT() asm volatile("s_waitcnt vmcnt(0)" ::: "memory")
#define MFMA32(a, b, c) __builtin_amdgcn_mfma_f32_32x32x16_bf16((a), (b), (c), 0, 0, 0)
#define DI __device__ __forceinline__

DI unsigned pk2(float lo, float hi) { f32x2 v = {lo, hi}; bf16x2_t b = __builtin_convertvector(v, bf16x2_t); return __builtin_bit_cast(unsigned, b); }
DI bf16 f2bf(float x) { return (bf16)(pk2(x, 0.f) & 0xffffu); }
DI float bf2f(bf16 x) { return __uint_as_float((unsigned)x << 16); }
DI float bflo(unsigned p) { return __uint_as_float(p << 16); }
DI float bfhi(unsigned p) { return __uint_as_float(p & 0xffff0000u); }
DI int crow(int reg, int hh) { return (reg & 3) + 8 * (reg >> 2) + 4 * hh; }
DI float swap32_partner(float x, int hh) { auto rr = __builtin_amdgcn_permlane32_swap(__float_as_uint(x), __float_as_uint(x), false, false); return __uint_as_float(hh ? rr[0] : rr[1]); }
DI float dpp_xor1(float x) { return __int_as_float(__builtin_amdgcn_update_dpp(0, __float_as_int(x), 0xB1, 0xf, 0xf, true)); }
DI float dpp_xor2(float x) { return __int_as_float(__builtin_amdgcn_update_dpp(0, __float_as_int(x), 0x4E, 0xf, 0xf, true)); }
DI float dpp_hmir(float x) { return __int_as_float(__builtin_amdgcn_update_dpp(0, __float_as_int(x), 0x141, 0xf, 0xf, true)); }
DI float dpp_mir(float x)  { return __int_as_float(__builtin_amdgcn_update_dpp(0, __float_as_int(x), 0x140, 0xf, 0xf, true)); }
DI float sum16(float x) { x += dpp_xor1(x); x += dpp_xor2(x); x += dpp_hmir(x); x += dpp_mir(x); return x; }
DI float sum32(float x) { x = sum16(x); auto rr = __builtin_amdgcn_permlane16_swap(__float_as_uint(x), __float_as_uint(x), false, false); return __uint_as_float(rr[0]) + __uint_as_float(rr[1]); }
DI float max16(float x) { x = fmaxf(x, dpp_xor1(x)); x = fmaxf(x, dpp_xor2(x)); x = fmaxf(x, dpp_hmir(x)); x = fmaxf(x, dpp_mir(x)); return x; }
DI float max64(float x) { x = max16(x); { auto rr = __builtin_amdgcn_permlane16_swap(__float_as_uint(x), __float_as_uint(x), false, false); x = fmaxf(__uint_as_float(rr[0]), __uint_as_float(rr[1])); }
    { auto rr = __builtin_amdgcn_permlane32_swap(__float_as_uint(x), __float_as_uint(x), false, false); x = fmaxf(__uint_as_float(rr[0]), __uint_as_float(rr[1])); } return x; }
DI unsigned pack_i8x4(float a, float b, float c, float d) { const int ia = (int)__builtin_rintf(a), ib = (int)__builtin_rintf(b), ic = (int)__builtin_rintf(c), id = (int)__builtin_rintf(d);
    return (unsigned)(ia & 255) | ((unsigned)(ib & 255) << 8) | ((unsigned)(ic & 255) << 16) | ((unsigned)id << 24); }
DI float sum64(float x) { x = sum32(x); auto rr = __builtin_amdgcn_permlane32_swap(__float_as_uint(x), __float_as_uint(x), false, false); return __uint_as_float(rr[0]) + __uint_as_float(rr[1]); }
DI float rcp_(float x) { return __builtin_amdgcn_rcpf(x); }
DI float rsq_(float x) { return __builtin_amdgcn_rsqf(x); }
DI float exp2_(float x) { return __builtin_amdgcn_exp2f(x); }
DI float gelu_tanh(float x) { const float u = x * (1.5957691216057308f + 0.07135481627159768f * x * x); return x * rcp_(1.0f + exp2_(-LOG2E * u)); }
DI float sigmoidf_(float x) { return rcp_(1.0f + exp2_(-LOG2E * x)); }
#define XB_TMO      128
#define XB_XCNT(j)  (256  + 64 * (j))
#define XB_XSUB(j)  (1280 + 64 * (j))
#define XB_XGEN(j)  (2304 + 64 * (j))
#define XB_TOP      3328
#define XB_TOPGEN   3392
#define XCD_BAR_WORDS 3456
#define XB_SPIN_CAP (1u << 18)

__device__ __forceinline__ unsigned xb_ld(unsigned* p)              { return __hip_atomic_load(p, __ATOMIC_RELAXED, __HIP_MEMORY_SCOPE_AGENT); }
__device__ __forceinline__ unsigned xb_add(unsigned* p, unsigned v) { return __hip_atomic_fetch_add(p, v, __ATOMIC_RELAXED, __HIP_MEMORY_SCOPE_AGENT); }
__device__ __forceinline__ unsigned xb_xcc_id() { return (unsigned)__builtin_amdgcn_s_getreg((3 << 11) | 20) & 0xFu; }
#define XB_SPIN(cond, bar) do { unsigned _sp = 0; while (cond) { __builtin_amdgcn_s_sleep(1); \
    if ((++_sp & 255u) == 0u) { if (xb_ld(&(bar)[XB_TMO])) break; if (_sp > XB_SPIN_CAP) { atomicAdd(&(bar)[XB_TMO], 1u); break; } } } } while (0)

struct XcdBarrier {
    unsigned* bar; unsigned x;
    volatile LAS unsigned* st;
};

__device__ __forceinline__ XcdBarrier xcd_barrier_post(unsigned* bar, volatile LAS unsigned* st) {
    XcdBarrier b; b.bar = bar; b.x = xb_xcc_id(); b.st = st;
    if (threadIdx.x == 0) (void)xb_add(&bar[XB_XCNT(b.x)], 1u);
    return b;
}
__device__ __forceinline__ void xcd_barrier_complete(unsigned* bar, unsigned x, unsigned& nloc, unsigned& nx) {
    const unsigned G = gridDim.x * gridDim.y * gridDim.z;
    unsigned sum, cnt, mine, sp = 0u;
    for (;;) {
        sum = 0u; cnt = 0u; mine = 0u;
#pragma unroll
        for (unsigned j = 0; j < 16; ++j) { const unsigned c = xb_ld(&bar[XB_XCNT(j)]); sum += c; cnt += (c > 0u) ? 1u : 0u; mine = (j == x) ? c : mine; }
        if (sum == G) break;
        __builtin_amdgcn_s_sleep(1);
        if ((++sp & 255u) == 0u) { if (xb_ld(&bar[XB_TMO])) break; if (sp > XB_SPIN_CAP) { atomicAdd(&bar[XB_TMO], 1u); break; } }
    }
    nloc = mine > 0u ? mine : 1u; nx = cnt > 0u ? cnt : 1u;
}

__device__ __forceinline__ void xcd_barrier(const XcdBarrier& b) {
    asm volatile("s_waitcnt vmcnt(0)" ::: "memory");
    __syncthreads();
    if (threadIdx.x == 0) {
        unsigned* bar = b.bar;
        __builtin_amdgcn_s_waitcnt(0);
        unsigned nloc = b.st[0], nx = b.st[1];
        if (nloc == 0u) { xcd_barrier_complete(bar, b.x, nloc, nx); b.st[0] = nloc; b.st[1] = nx; }
        const unsigned old = xb_add(&bar[XB_XSUB(b.x)], 1u);
        const unsigned gen = old / nloc;
        if (old + 1u == (gen + 1u) * nloc) {
            __builtin_amdgcn_fence(__ATOMIC_RELEASE, "agent");
            asm volatile("s_waitcnt vmcnt(0)" ::: "memory");
            const unsigned og = xb_add(&bar[XB_TOP], 1u);
            const unsigned tg = og / nx;
            if (og + 1u == (tg + 1u) * nx) xb_add(&bar[XB_TOPGEN], 1u);
            else XB_SPIN(xb_ld(&bar[XB_TOPGEN]) == tg, bar);
            __builtin_amdgcn_fence(__ATOMIC_ACQUIRE, "agent");
            xb_add(&bar[XB_XGEN(b.x)], 1u);
            asm volatile("s_waitcnt vmcnt(0)" ::: "memory");
        } else {
            XB_SPIN(xb_ld(&bar[XB_XGEN(b.x)]) == gen, bar);
            __builtin_amdgcn_fence(__ATOMIC_ACQUIRE, "agent");
            asm volatile("s_waitcnt vmcnt(0)" ::: "memory");
        }
    }
    __syncthreads();
}
struct Args { const float* in[26]; float* out; unsigned char* ws; int ph_lo, ph_hi, li, pad; };
struct Frame {
    LAS unsigned char* lds;
    volatile LAS unsigned* MISC;
    gu32* ctl;
    int tid, lane, wave, vcu, G;
    const Args* A; float* out; unsigned char* ws;
    DI const float* in(int k) const { return A->in[k]; }
    template <class T> DI T* wsp(size_t off) const { return (T*)(ws + off); }
};

DI void p0_transpose_item(const float* W, int K, int N, bf16* WT, LAS float* scr, int item, int lane, const float* g0, const float* g1, int gsplit) {
    const int nblk = N / 32, kb = item / nblk, nb = item % nblk, k0 = 64 * kb, n0 = 32 * nb;
#pragma unroll 8
    for (int i = 0; i < 32; ++i) { const int kk = 2 * i + (lane >> 5); const int k = k0 + kk;
        float g = 1.f; if (g0) g = (k < gsplit) ? g0[k] : g1[k - gsplit];
        scr[kk * 33 + (lane & 31)] = W[(size_t)k * N + n0 + (lane & 31)] * g; }
    LDS_WAIT(); asm volatile("" ::: "memory");
    const int c = lane & 7;
#pragma unroll
    for (int j = 0; j < 4; ++j) { const int n = (lane >> 3) + 8 * j; const LAS float* s = scr + (8 * c) * 33 + n;
        v4u o; o.x = pk2(s[0 * 33], s[1 * 33]); o.y = pk2(s[2 * 33], s[3 * 33]); o.z = pk2(s[4 * 33], s[5 * 33]); o.w = pk2(s[6 * 33], s[7 * 33]);
        *(GAS v4u*)(WT + (size_t)(n0 + n) * K + k0 + 8 * c) = o; }
    LDS_WAIT(); asm volatile("" ::: "memory");
}
template <bool NORM> DI void row_to_bf16(const float* xrow, bf16* orow, const float* gain, int lane) {
    const GAS f32x4* xr = (const GAS f32x4*)xrow + lane;
    f32x4 v[4]; float s = 0.f;
#pragma unroll
    for (int j = 0; j < 4; ++j) { v[j] = xr[64 * j]; s += (v[j].x * v[j].x + v[j].y * v[j].y) + (v[j].z * v[j].z + v[j].w * v[j].w); }
    float rstd = 1.f;
    if (NORM) rstd = 1.0f / sqrtf(sum64(s) * (1.f / 1024.f) + EPS);
    GAS v2u* o8 = (GAS v2u*)orow + lane;
#pragma unroll
    for (int j = 0; j < 4; ++j) { f32x4 w = v[j] * rstd; if (gain) w = w * ((const GAS f32x4*)gain)[64 * j + lane];
        v2u o; o.x = pk2(w.x, w.y); o.y = pk2(w.z, w.w); o8[64 * j] = o; }
}
constexpr float U_SCALE = 128.f, V_SCALE = 16.f;
DI void row_to_fp8(const float* src, unsigned char* dst, const float* gain, float scale, int lane) {
#pragma unroll
    for (int j = 0; j < 4; ++j) { f32x4 v = ((const GAS f32x4*)src)[64 * j + lane] * scale; if (gain) v = v * ((const GAS f32x4*)gain)[64 * j + lane];
        unsigned w = 0u; w = __builtin_amdgcn_cvt_pk_fp8_f32(v.x, v.y, w, false); w = __builtin_amdgcn_cvt_pk_fp8_f32(v.z, v.w, w, true);
        ((GAS unsigned*)dst)[64 * j + lane] = w; }
}
DI void row_to_i8(const float* src, unsigned char* dst, const float* gain, float* scale_out, int lane) {
    f32x4 v[4]; float mx = 0.f;
#pragma unroll
    for (int j = 0; j < 4; ++j) { v[j] = ((const GAS f32x4*)src)[64 * j + lane] * ((const GAS f32x4*)gain)[64 * j + lane];
        mx = fmaxf(fmaxf(mx, fmaxf(fabsf(v[j].x), fabsf(v[j].y))), fmaxf(fabsf(v[j].z), fabsf(v[j].w))); }
    mx = fmaxf(max64(mx), 1e-30f);
    const float inv = 127.0f / mx;
#pragma unroll
    for (int j = 0; j < 4; ++j) ((GAS unsigned*)dst)[64 * j + lane] = pack_i8x4(v[j].x * inv, v[j].y * inv, v[j].z * inv, v[j].w * inv);
    if (lane == 0) *scale_out = mx * (1.0f / 127.0f);
}
DI void p0_prologue(Frame& F) {
    LAS float* scr = (LAS float*)(F.lds + F.wave * 16384);
    const int gw = F.vcu * NWAVES + F.wave, NGW = F.G * NWAVES, lane = F.lane;
    constexpr int I_IN = 16 * (INW / 32), I_D = 16 * (DM / 32), I_2D = 16 * (2 * DM / 32);
    constexpr int NITEMS = I_IN + 3 * I_D + 2 * I_2D;
    for (int it = gw; it < NITEMS; it += NGW) {
        int r = it;
        if (r < I_IN) { p0_transpose_item(F.in(3), DM, INW, F.wsp<bf16>(WS_WIN), scr, r, lane, F.in(2), F.in(2), DM); continue; } r -= I_IN;
        if (r < I_D) { p0_transpose_item(F.in(14), DM, DM, F.wsp<bf16>(WS_WOUT), scr, r, lane, F.in(12), F.in(13), LRUW); continue; } r -= I_D;
        if (r < I_D) { p0_transpose_item(F.in(17), DM, DM, F.wsp<bf16>(WS_WQ), scr, r, lane, F.in(15), F.in(15), DM); continue; } r -= I_D;
        if (r < I_2D) { p0_transpose_item(F.in(18), DM, 2 * DM, F.wsp<bf16>(WS_WKV), scr, r, lane, nullptr, nullptr, 0); continue; } r -= I_2D;
        if (r < I_D) { p0_transpose_item(F.in(19), DM, DM, F.wsp<bf16>(WS_WO), scr, r, lane, nullptr, nullptr, 0); continue; } r -= I_D;
        p0_transpose_item(F.in(21), DM, 2 * DM, F.wsp<bf16>(WS_WQRY), scr, r, lane, F.in(20), F.in(20), DM);
    }
    for (int m = gw; m < M; m += NGW) row_to_bf16<true>(F.in(0) + (size_t)m * DM, F.wsp<bf16>(WS_XN) + (size_t)m * DM, nullptr, lane);
    for (int m = gw; m < NBATCH * 256; m += NGW) row_to_bf16<true>(F.in(1) + (size_t)m * DM, F.wsp<bf16>(WS_MEMN) + (size_t)m * DM, F.in(16), lane);
    for (int m = gw; m < NEXP; m += NGW) { row_to_i8(F.in(23) + (size_t)m * DM, F.wsp<unsigned char>(WS_EU) + (size_t)m * DM, F.in(20), F.wsp<float>(WS_SU) + m, lane);
                                            row_to_fp8(F.in(24) + (size_t)m * DM, F.wsp<unsigned char>(WS_EV) + (size_t)m * DM, nullptr, V_SCALE, lane); }
    { const int gt = gw * 64 + lane, NT = NGW * 64;
      for (int i = gt; i < 8 * 2 * 128 * 128 / 4; i += NT) { const f32x4 v = ((const GAS f32x4*)F.in(22))[i]; v2u o; o.x = pk2(v.x, v.y); o.y = pk2(v.z, v.w); ((GAS v2u*)F.wsp<bf16>(WS_SUBK))[i] = o; }
      for (int o = gt; o < 2 * 8 * 64 * 64; o += NT) { const int i = o & 63, j = (o >> 6) & 63, h = (o >> 12) & 7, g = o >> 15;
          const float* W = g ? F.in(8) : F.in(6); F.wsp<bf16>(WS_GATEW)[o] = f2bf(W[(h * 64 + i) * 64 + j]); } }
}
struct LruState { float ba[2], bx[2], sp[2], S[2], Ap[2]; };
template <bool PASS2>
DI void lru_prep(const Frame& F, int b, int chunk, int h, int lane, LAS unsigned char* xcs  , LruState& st) {
    const int r = lane & 31, hh = lane >> 5;
    const size_t row0 = (size_t)b * SEQ + (size_t)chunk * 64;
    {
        const int c2 = h * 64 + 2 * r;
        const f32x2 w0 = *(const f32x2*)(F.in(4) + c2), w1 = *(const f32x2*)(F.in(4) + LRUW + c2), w2 = *(const f32x2*)(F.in(4) + 2 * LRUW + c2), w3 = *(const f32x2*)(F.in(4) + 3 * LRUW + c2);
        const f32x2 cb = *(const f32x2*)(F.in(5) + c2);
        const int tl0 = 32 * hh;
        const bf16* zp = F.wsp<bf16>(WS_Z) + (row0 + tl0) * ZW + c2;
        const bool first = (chunk == 0 && hh == 0);
        unsigned p0 = first ? 0u : *(const unsigned*)(zp - 3 * ZW), p1 = first ? 0u : *(const unsigned*)(zp - 2 * ZW), p2 = first ? 0u : *(const unsigned*)(zp - ZW);
#pragma unroll 8
        for (int t = 0; t < 32; ++t) { const unsigned p3 = *(const unsigned*)(zp + (size_t)t * ZW);
            const float lo = cb.x + bflo(p0) * w0.x + bflo(p1) * w1.x + bflo(p2) * w2.x + bflo(p3) * w3.x;
            const float hi = cb.y + bfhi(p0) * w0.y + bfhi(p1) * w1.y + bfhi(p2) * w2.y + bfhi(p3) * w3.y;
            *(LAS unsigned*)(xcs + (tl0 + t) * 144 + 4 * r) = pk2(lo, hi);
            p0 = p1; p1 = p2; p2 = p3; }
        LDS_WAIT();
    }
#pragma unroll
    for (int nt = 0; nt < 2; ++nt) { const int c = h * 64 + 32 * nt + r; st.ba[nt] = F.in(7)[c]; st.bx[nt] = F.in(9)[c];
        const float nl = -F.in(10)[c]; st.sp[nt] = fmaxf(nl, 0.f) + log1pf(__expf(-fabsf(nl))); st.S[nt] = 0.f; st.Ap[nt] = 1.f; }
    if (PASS2) {
        float s = 0.f; const float* ag = F.wsp<float>(WS_AGG) + ((size_t)b * NCHUNK * LRUW + h * 64 + lane) * 2;
#pragma unroll 8
        for (int c = 0; c < chunk; ++c) { const f32x2 ab = *(const f32x2*)(ag + (size_t)c * LRUW * 2); s = ab.x * s + ab.y; }
        st.S[0] = __shfl(s, r); st.S[1] = __shfl(s, 32 + r);
    }
}
template <bool PASS2>
DI void lru_tile(const Frame& F, int b, int chunk, int mt, int h, int lane, LAS unsigned char* xcs, LAS unsigned char* gim  , LruState& st, float (&ssq)[16]) {
    const int r = lane & 31, hh = lane >> 5;
    const size_t row0 = (size_t)b * SEQ + (size_t)chunk * 64;
    const bf16* gw = F.wsp<bf16>(WS_GATEW) + (size_t)h * 4096;
    bf16x8 af[4];
#pragma unroll
    for (int s = 0; s < 4; ++s) af[s] = *(const LAS bf16x8*)(xcs + (32 * mt + r) * 144 + (16 * s + 8 * hh) * 2);
    float ssl[16];
#pragma unroll
    for (int i = 0; i < 16; ++i) ssl[i] = 0.f;
    if (PASS2) {
#pragma unroll
        for (int i = 0; i < 4; ++i) { const int row = (lane >> 3) + 8 * i, c = lane & 7;
            *(LAS v4u*)(gim + row * 144 + c * 16) = *(const v4u*)(F.wsp<bf16>(WS_Z) + (row0 + 32 * mt + row) * ZW + LRUW + h * 64 + 8 * c); }
        LDS_WAIT();
    }
#pragma unroll
    for (int nt = 0; nt < 2; ++nt) {
        asm volatile("" ::: "memory");
        f32x16 aa = {}, ax = {};
#pragma unroll
        for (int s = 0; s < 4; ++s) {
            const bf16x8 wa = *(const bf16x8*)(gw + (size_t)(32 * nt + r) * 64 + 16 * s + 8 * hh);
            const bf16x8 wx = *(const bf16x8*)(gw + 32768 + (size_t)(32 * nt + r) * 64 + 16 * s + 8 * hh);
            aa = MFMA32(af[s], wa, aa); ax = MFMA32(af[s], wx, ax);
        }
#pragma unroll
        for (int i = 0; i < 16; ++i) {
            const float rg = sigmoidf_(aa[i] + st.ba[nt]), ig = sigmoidf_(ax[i] + st.bx[nt]);
            const float la = -8.0f * rg * st.sp[nt];
            const float a = exp2_(LOG2E * la);
            const float mult = __builtin_amdgcn_sqrtf(fmaxf(1.0f - a * a, 0.f));
            const float xc = bf2f(*(const LAS bf16*)(xcs + (32 * mt + crow(i, hh)) * 144 + (32 * nt + r) * 2));
            aa[i] = a; ax[i] = mult * ig * xc;
        }
        float Ao[4], Bo[4], Aq[4], Bq[4], Sin[4];
#pragma unroll
        for (int q = 0; q < 4; ++q) { const float a0 = aa[4 * q], a1 = aa[4 * q + 1], a2 = aa[4 * q + 2], a3 = aa[4 * q + 3];
            Ao[q] = (a0 * a1) * (a2 * a3); Bo[q] = ((ax[4 * q] * a1 + ax[4 * q + 1]) * a2 + ax[4 * q + 2]) * a3 + ax[4 * q + 3];
            Aq[q] = swap32_partner(Ao[q], hh); Bq[q] = swap32_partner(Bo[q], hh); }
        float s_ = st.S[nt];
#pragma unroll
        for (int q = 0; q < 4; ++q) { const float A1 = hh ? Aq[q] : Ao[q], B1 = hh ? Bq[q] : Bo[q], A2 = hh ? Ao[q] : Aq[q], B2 = hh ? Bo[q] : Bq[q];
            const float smid = A1 * s_ + B1; Sin[q] = hh ? smid : s_; s_ = A2 * smid + B2; st.Ap[nt] *= A1 * A2; }
        st.S[nt] = s_;
        if (PASS2) {
#pragma unroll
            for (int q = 0; q < 4; ++q) { float hp = Sin[q];
#pragma unroll
                for (int e = 0; e < 4; ++e) { const int i = 4 * q + e; hp = aa[i] * hp + ax[i];
                    const float gt = bf2f(*(const LAS bf16*)(gim + crow(i, hh) * 144 + (32 * nt + r) * 2));
                    const float y = hp * gelu_tanh(gt); ssl[i] += y * y;
                    *(LAS bf16*)(xcs + (32 * mt + crow(i, hh)) * 144 + (32 * nt + r) * 2) = f2bf(y); } }
        }
    }
    if (PASS2) {
#pragma unroll
        for (int i = 0; i < 16; ++i) ssq[i] = sum32(ssl[i]);
    }
}
constexpr int ATT_KST = 144, ATT_VST = 136, ATT_KBYTES = 64 * ATT_KST, ATT_VBYTES = 64 * ATT_VST;
DI void attn_wave(const Frame& F, int b, int n, int qt, int h, int lane, const LAS float* tab, LAS unsigned char* kl  , f32x16 (&o)[2]) {
    const int r = lane & 31, hh = lane >> 5;
    LAS unsigned char* vl = kl + ATT_KBYTES;
    const size_t row0 = (size_t)b * SEQ + (size_t)n * 64;
    const float SC = 0.125f * LOG2E;
    bf16x8 qf[4];
#pragma unroll
    for (int s = 0; s < 4; ++s) qf[s] = *(const bf16x8*)(F.wsp<bf16>(WS_Z) + (row0 + 32 * qt + r) * ZW + 2 * LRUW + h * 64 + 16 * s + 8 * hh);
    float mrun = -1e30f, lrun = 0.f;
#pragma unroll
    for (int dt = 0; dt < 2; ++dt) o[dt] = f32x16{};
    const float bfar = tab[256];
    const int srow = lane >> 3, sc8 = lane & 7;
    const int kc0 = (n >= 8 ? n - 8 : 0);
    const char* kg = (const char*)(F.wsp<bf16>(WS_Z) + (size_t)b * SEQ * ZW + 2 * LRUW + ATTW + h * 64);
    const char* vg = (const char*)(F.wsp<bf16>(WS_VT) + (size_t)(b * 8 + h) * 64 * SEQ);
    const unsigned kof = (unsigned)(srow * ZW + 8 * sc8) * 2u, vof = (unsigned)(srow * SEQ + 8 * sc8) * 2u;
    v4u kreg[8];
#pragma unroll
    for (int i = 0; i < 8; ++i) kreg[i] = *(const v4u*)(kg + ((size_t)kc0 * 64 + 8 * i) * ZW * 2 + kof);
    for (int kc = kc0; kc <= n; ++kc) {
        const int dd = n - kc;
        v4u vreg[8];
#pragma unroll
        for (int i = 0; i < 8; ++i) { *(LAS v4u*)(kl + (srow + 8 * i) * ATT_KST + sc8 * 16) = kreg[i]; vreg[i] = *(const v4u*)(vg + ((size_t)(8 * i) * SEQ + kc * 64) * 2 + vof); }
        f32x16 sc[2];
#pragma unroll
        for (int kt = 0; kt < 2; ++kt) { sc[kt] = f32x16{};
#pragma unroll
            for (int s = 0; s < 4; ++s) { const bf16x8 kf = *(const LAS bf16x8*)(kl + (32 * kt + r) * ATT_KST + (16 * s + 8 * hh) * 2); sc[kt] = MFMA32(kf, qf[s], sc[kt]); } }
        if (dd >= 3) {
#pragma unroll
            for (int kt = 0; kt < 2; ++kt)
#pragma unroll
                for (int i = 0; i < 16; ++i) sc[kt][i] = sc[kt][i] * SC + bfar;
        } else {
            const int base = 64 * dd + 32 * qt + r + 128;
#pragma unroll
            for (int kt = 0; kt < 2; ++kt)
#pragma unroll
                for (int i = 0; i < 16; ++i) { int idx = base - (32 * kt + crow(i, hh)); idx = idx > 256 ? 256 : idx; sc[kt][i] = sc[kt][i] * SC + tab[idx]; }
        }
        float mx = sc[0][0];
#pragma unroll
        for (int kt = 0; kt < 2; ++kt)
#pragma unroll
            for (int i = 0; i < 16; ++i) mx = fmaxf(mx, sc[kt][i]);
        mx = fmaxf(mx, swap32_partner(mx, hh));
        const float mnew = fmaxf(mrun, mx), alpha = exp2_(mrun - mnew);
        float ls = 0.f;
#pragma unroll
        for (int kt = 0; kt < 2; ++kt)
#pragma unroll
            for (int i = 0; i < 16; ++i) { const float p = exp2_(sc[kt][i] - mnew); sc[kt][i] = p; ls += p; }
        lrun = lrun * alpha + ls; mrun = mnew;
#pragma unroll
        for (int dt = 0; dt < 2; ++dt)
#pragma unroll
            for (int i = 0; i < 16; ++i) o[dt][i] *= alpha;
#pragma unroll
        for (int i = 0; i < 8; ++i) { LAS v2u* vd = (LAS v2u*)(vl + (srow + 8 * i) * ATT_VST + sc8 * 16); vd[0] = (v2u){vreg[i].x, vreg[i].y}; vd[1] = (v2u){vreg[i].z, vreg[i].w}; }
        if (kc < n) {
#pragma unroll
            for (int i = 0; i < 8; ++i) kreg[i] = *(const v4u*)(kg + ((size_t)(kc + 1) * 64 + 8 * i) * ZW * 2 + kof);
        }
#pragma unroll
        for (int kt = 0; kt < 2; ++kt)
#pragma unroll
            for (int s2 = 0; s2 < 2; ++s2) { v4u w; w.x = pk2(sc[kt][8 * s2], sc[kt][8 * s2 + 1]); w.y = pk2(sc[kt][8 * s2 + 2], sc[kt][8 * s2 + 3]); w.z = pk2(sc[kt][8 * s2 + 4], sc[kt][8 * s2 + 5]); w.w = pk2(sc[kt][8 * s2 + 6], sc[kt][8 * s2 + 7]);
                const bf16x8 pf = __builtin_bit_cast(bf16x8, w);
#pragma unroll
                for (int dt = 0; dt < 2; ++dt) { const LAS unsigned char* vp = vl + (32 * dt + r) * ATT_VST + (32 * kt + 16 * s2 + 4 * hh) * 2;
                    const v2u lo = *(const LAS v2u*)vp, hi = *(const LAS v2u*)(vp + 16); v4u vw; vw.x = lo.x; vw.y = lo.y; vw.z = hi.x; vw.w = hi.y;
                    o[dt] = MFMA32(__builtin_bit_cast(bf16x8, vw), pf, o[dt]); } }
    }
    const float lt = lrun + swap32_partner(lrun, hh); const float inv = rcp_(lt);
#pragma unroll
    for (int dt = 0; dt < 2; ++dt)
#pragma unroll
        for (int i = 0; i < 16; ++i) o[dt][i] *= inv;
}

DI void p2_lru_aggregates(Frame& F) {
    const int lane = F.lane, r = lane & 31, hh = lane >> 5, h = F.wave;
    LAS unsigned char* xcs = F.lds + 12288 + h * 17920;
    for (int u = F.vcu; u < NBATCH * NCHUNK; u += F.G) {
        const int b = u / NCHUNK, n = u % NCHUNK;
        LruState st; float ssq[16];
        lru_prep<false>(F, b, n, h, lane, xcs, st);
#pragma unroll 1
        for (int mt = 0; mt < 2; ++mt) lru_tile<false>(F, b, n, mt, h, lane, xcs, xcs + 9216, st, ssq);
        if (hh == 0) {
#pragma unroll
            for (int nt = 0; nt < 2; ++nt) *(f32x2*)(F.wsp<float>(WS_AGG) + (((size_t)b * NCHUNK + n) * LRUW + h * 64 + 32 * nt + r) * 2) = (f32x2){st.Ap[nt], st.S[nt]};
        }
        LDS_WAIT();
    }
}
DI void p3_mixer(Frame& F) {
    const int lane = F.lane, r = lane & 31, hh = lane >> 5, h = F.wave;
    LAS float* ssx = (LAS float*)(F.lds);
    LAS float* tab = (LAS float*)(F.lds + 2048 + h * 1280);
    LAS unsigned* stg = (LAS unsigned*)(F.lds + 12288 + h * 17920);
    for (int i = lane; i < 257; i += 64) tab[i] = F.in(11)[h * 257 + i] * LOG2E;
    LDS_WAIT();
    for (int u = F.vcu; u < NBATCH * NCHUNK; u += F.G) {
        const int b = u / NCHUNK, n = u % NCHUNK; const size_t row0 = (size_t)b * SEQ + (size_t)n * 64;
#ifndef MIX_PARTS
#define MIX_PARTS 3
#endif
        if (MIX_PARTS & 1) {
            LruState st;
            lru_prep<true>(F, b, n, h, lane, (LAS unsigned char*)stg, st);
#pragma unroll 1
            for (int mt = 0; mt < 2; ++mt) {
                float ssq[16];
                lru_tile<true>(F, b, n, mt, h, lane, (LAS unsigned char*)stg, (LAS unsigned char*)stg + 9216, st, ssq);
                if (r == 0) {
#pragma unroll
                    for (int i = 0; i < 16; ++i) ssx[crow(i, hh) * 8 + h] = ssq[i];
                }
                __syncthreads();
                const LAS unsigned char* yst = (const LAS unsigned char*)stg + 32 * mt * 144;
#pragma unroll
                for (int i = 0; i < 4; ++i) { const int row = (lane >> 3) + 8 * i, c = lane & 7;
                    const f32x4 s0 = *(const LAS f32x4*)(ssx + row * 8), s1 = *(const LAS f32x4*)(ssx + row * 8 + 4);
                    const float rs = rsq_(((s0.x + s0.y) + (s0.z + s0.w) + (s1.x + s1.y) + (s1.z + s1.w)) * (1.f / 512.f) + EPS);
                    const v4u v = *(const LAS v4u*)(yst + row * 144 + c * 16);
                    v4u o; o.x = pk2(bflo(v.x) * rs, bfhi(v.x) * rs); o.y = pk2(bflo(v.y) * rs, bfhi(v.y) * rs); o.z = pk2(bflo(v.z) * rs, bfhi(v.z) * rs); o.w = pk2(bflo(v.w) * rs, bfhi(v.w) * rs);
                    *(v4u*)(F.wsp<bf16>(WS_Y) + (row0 + 32 * mt + row) * DM + h * 64 + 8 * c) = o; }
                __syncthreads();
            }
        }
    }
    for (int u = F.vcu; u < NBATCH * NCHUNK; u += F.G) {
        const int b = u / NCHUNK, n = u % NCHUNK; const size_t row0 = (size_t)b * SEQ + (size_t)n * 64;
#pragma unroll 1
        for (int qt = 0; qt < ((MIX_PARTS & 2) ? 2 : 0); ++qt) {
            f32x16 o[2];
            attn_wave(F, b, n, qt, h, lane, tab, (LAS unsigned char*)stg, o);
            float s = 0.f;
#pragma unroll
            for (int dt = 0; dt < 2; ++dt)
#pragma unroll
                for (int i = 0; i < 16; ++i) s += o[dt][i] * o[dt][i];
            s += swap32_partner(s, hh);
            if (hh == 0) ssx[r * 8 + h] = s;
            __syncthreads();
            { const f32x4 s0 = *(const LAS f32x4*)(ssx + r * 8), s1 = *(const LAS f32x4*)(ssx + r * 8 + 4);
              const float rs = rsq_(((s0.x + s0.y) + (s0.z + s0.w) + (s1.x + s1.y) + (s1.z + s1.w)) * (1.f / 512.f) + EPS);
#pragma unroll
              for (int dt = 0; dt < 2; ++dt)
#pragma unroll
                  for (int i = 0; i < 16; i += 2) stg[r * 33 + ((32 * dt + crow(i, hh)) >> 1)] = pk2(o[dt][i] * rs, o[dt][i + 1] * rs); }
            LDS_WAIT();
#pragma unroll 4
            for (int i = 0; i < 16; ++i) { const int row = 2 * i + hh; const unsigned v = stg[row * 33 + r];
                *(GAS unsigned*)(F.wsp<bf16>(WS_Y) + (row0 + 32 * qt + row) * DM + LRUW + h * 64 + 2 * r) = v; }
            __syncthreads();
        }
    }
}
DI void p5_cross(Frame& F) {
    const int lane = F.lane, r = lane & 31, hh = lane >> 5, w = F.wave, tid = F.tid;
    constexpr int KST = 528, VST = 520;
    const float SC = 0.0625f * LOG2E;
    for (int u = F.vcu; u < NBATCH * 4 * 32; u += F.G) {
        const int b = u >> 7, hm = (u >> 5) & 3, qb = u & 31;
        const size_t qrow = (size_t)b * SEQ + (size_t)qb * 256 + 32 * w + r;
        { const bf16* src = F.wsp<bf16>(WS_KM) + (size_t)(b * 256) * DM + hm * 256;
#pragma unroll 4
          for (int i = 0; i < 16; ++i) { const int c = i * 512 + tid, row = c >> 5, ch = c & 31;
              *(LAS v4u*)(F.lds + row * KST + ch * 16) = *(const v4u*)(src + (size_t)row * DM + ch * 8); } }
        __syncthreads();
        f32x16 sc[8];
#pragma unroll
        for (int kt = 0; kt < 8; ++kt) sc[kt] = f32x16{};
#pragma unroll 2
        for (int s = 0; s < 16; ++s) {
            const bf16x8 qf = *(const bf16x8*)(F.wsp<bf16>(WS_QC) + qrow * DM + hm * 256 + 16 * s + 8 * hh);
#pragma unroll
            for (int kt = 0; kt < 8; ++kt) { const bf16x8 kf = *(const LAS bf16x8*)(F.lds + (32 * kt + r) * KST + (16 * s + 8 * hh) * 2); sc[kt] = MFMA32(kf, qf, sc[kt]); }
        }
        float mx = sc[0][0];
#pragma unroll
        for (int kt = 0; kt < 8; ++kt)
#pragma unroll
            for (int i = 0; i < 16; ++i) mx = fmaxf(mx, sc[kt][i]);
        mx = fmaxf(mx, swap32_partner(mx, hh));
        float ls = 0.f; const float mo = mx * SC;
        bf16x8 pf[8][2];
#pragma unroll
        for (int kt = 0; kt < 8; ++kt) {
#pragma unroll
            for (int i = 0; i < 16; ++i) { const float p = exp2_(sc[kt][i] * SC - mo); sc[kt][i] = p; ls += p; }
#pragma unroll
            for (int s2 = 0; s2 < 2; ++s2) { v4u wv; wv.x = pk2(sc[kt][8 * s2], sc[kt][8 * s2 + 1]); wv.y = pk2(sc[kt][8 * s2 + 2], sc[kt][8 * s2 + 3]); wv.z = pk2(sc[kt][8 * s2 + 4], sc[kt][8 * s2 + 5]); wv.w = pk2(sc[kt][8 * s2 + 6], sc[kt][8 * s2 + 7]);
                pf[kt][s2] = __builtin_bit_cast(bf16x8, wv); }
        }
        ls += swap32_partner(ls, hh);
        const float inv = 1.0f / ls;
        __syncthreads();
        { const bf16* src = F.wsp<bf16>(WS_VMT) + (size_t)((b * 4 + hm) * 256) * 256;
#pragma unroll 4
          for (int i = 0; i < 16; ++i) { const int c = i * 512 + tid, row = c >> 5, ch = c & 31; const v4u v = *(const v4u*)(src + (size_t)row * 256 + ch * 8);
              LAS v2u* d = (LAS v2u*)(F.lds + row * VST + ch * 16); d[0] = (v2u){v.x, v.y}; d[1] = (v2u){v.z, v.w}; } }
        __syncthreads();
        LAS unsigned* stg = (LAS unsigned*)(F.lds) ;
#pragma unroll
        for (int half = 0; half < 2; ++half) {
            f32x16 o[4];
#pragma unroll
            for (int dt = 0; dt < 4; ++dt) o[dt] = f32x16{};
#pragma unroll
            for (int kt = 0; kt < 8; ++kt)
#pragma unroll
                for (int s2 = 0; s2 < 2; ++s2)
#pragma unroll
                    for (int dt = 0; dt < 4; ++dt) { const LAS unsigned char* p = F.lds + (128 * half + 32 * dt + r) * VST + (32 * kt + 16 * s2 + 4 * hh) * 2;
                        const v2u lo = *(const LAS v2u*)p, hi = *(const LAS v2u*)(p + 16); v4u wv; wv.x = lo.x; wv.y = lo.y; wv.z = hi.x; wv.w = hi.y;
                        o[dt] = MFMA32(__builtin_bit_cast(bf16x8, wv), pf[kt][s2], o[dt]); }
            if (half == 1) __syncthreads();
            else {   }
            if (half == 0) {
#pragma unroll
                for (int dt = 0; dt < 4; ++dt)
#pragma unroll
                    for (int i = 0; i < 16; i += 2) { const unsigned pv = pk2(o[dt][i] * inv, o[dt][i + 1] * inv); sc[dt][i >> 1] = __uint_as_float(pv); }
            } else {
                LAS unsigned* sw = (LAS unsigned*)(F.lds + w * 16512);
#pragma unroll
                for (int dt = 0; dt < 4; ++dt)
#pragma unroll
                    for (int i = 0; i < 16; i += 2) { sw[r * 129 + ((32 * dt + crow(i, hh)) >> 1)] = __float_as_uint(sc[dt][i >> 1]);
                        sw[r * 129 + 64 + ((32 * dt + crow(i, hh)) >> 1)] = pk2(o[dt][i] * inv, o[dt][i + 1] * inv); }
                LDS_WAIT();
#pragma unroll 4
                for (int i = 0; i < 32; ++i) { const unsigned v0 = sw[i * 129 + lane], v1 = sw[i * 129 + 64 + lane];
                    GAS unsigned* dst = (GAS unsigned*)(F.wsp<bf16>(WS_OC) + ((size_t)b * SEQ + (size_t)qb * 256 + 32 * w + i) * DM + hm * 256);
                    dst[lane] = v0; dst[64 + lane] = v1; }
            }
        }
        (void)stg;
        __syncthreads();
    }
}
template <int N> DI void ce_desc(float (&a)[N], int i, int l) { const float hi = fmaxf(a[i], a[l]), lo = fminf(a[i], a[l]); a[i] = hi; a[l] = lo; }
template <int N, int OFF> DI void bitonic_sort16_desc(float (&a)[N]) {
#pragma unroll
    for (int k = 2; k <= 16; k <<= 1)
#pragma unroll
        for (int j = k >> 1; j > 0; j >>= 1)
#pragma unroll
            for (int i = 0; i < 16; ++i) { const int l = i ^ j; if (l > i) { const bool desc = ((i & k) == 0) || (k == 16);
                if (desc) ce_desc<N>(a, OFF + i, OFF + l); else ce_desc<N>(a, OFF + l, OFF + i); } }
}
template <int N, int OFF> DI void bitonic_merge16_desc(float (&a)[N]) {
#pragma unroll
    for (int j = 8; j > 0; j >>= 1)
#pragma unroll
        for (int i = 0; i < 16; ++i) { const int l = i ^ j; if (l > i) ce_desc<N>(a, OFF + i, OFF + l); }
}
template <bool SORTED> DI void top16_of_64(float (&a)[64]) {
    bitonic_sort16_desc<64, 0>(a); bitonic_sort16_desc<64, 16>(a); bitonic_sort16_desc<64, 32>(a); bitonic_sort16_desc<64, 48>(a);
#pragma unroll
    for (int i = 0; i < 16; ++i) { a[i] = fmaxf(a[i], a[31 - i]); a[32 + i] = fmaxf(a[32 + i], a[63 - i]); }
    bitonic_merge16_desc<64, 0>(a); bitonic_merge16_desc<64, 32>(a);
#pragma unroll
    for (int i = 0; i < 16; ++i) a[i] = fmaxf(a[i], a[47 - i]);
    if (SORTED) bitonic_merge16_desc<64, 0>(a);
}
DI void p8a_topk(Frame& F) {
    const int lane = F.lane, r = lane & 31, hh = lane >> 5, w = F.wave;
    LAS float* tbl = (LAS float*)(F.lds + w * 8192);
    const int gw = F.vcu * NWAVES + w, NGW = F.G * NWAVES;
    for (int task = gw; task < (M / 32) * PEER_H; task += NGW) {
        const int h = task & 7, tt = task >> 3; const size_t tok = (size_t)tt * 32 + r;
        float v[2][16];
#pragma unroll
        for (int p = 0; p < 2; ++p) {
            f32x16 sc[4];
#pragma unroll
            for (int nt = 0; nt < 4; ++nt) sc[nt] = f32x16{};
            const bf16* sk = F.wsp<bf16>(WS_SUBK) + (size_t)((h * 2 + p) * 128) * 128;
#pragma unroll 2
            for (int s = 0; s < 8; ++s) { const bf16x8 qf = *(const bf16x8*)(F.wsp<bf16>(WS_QP) + tok * 2048 + h * 256 + p * 128 + 16 * s + 8 * hh);
#pragma unroll
                for (int nt = 0; nt < 4; ++nt) { const bf16x8 kf = *(const bf16x8*)(sk + (size_t)(32 * nt + r) * 128 + 16 * s + 8 * hh); sc[nt] = MFMA32(kf, qf, sc[nt]); } }
            float a[64];
#pragma unroll
            for (int nt = 0; nt < 4; ++nt)
#pragma unroll
                for (int i = 0; i < 16; ++i) a[nt * 16 + i] = __uint_as_float((__float_as_uint(sc[nt][i]) & ~127u) | (unsigned)(32 * nt + crow(i, hh)));
            top16_of_64<true>(a);
            float m[16];
#pragma unroll
            for (int i = 0; i < 16; ++i) m[i] = fmaxf(a[i], swap32_partner(a[15 - i], hh));
            bitonic_merge16_desc<16, 0>(m);
#pragma unroll
            for (int i = 0; i < 16; ++i) v[p][i] = m[i];
        }
        float c[64]; int n = 0;
#pragma unroll
        for (int i = 0; i < 16; ++i)
#pragma unroll
            for (int j = 0; j < 16; ++j) if ((i + 1) * (j + 1) <= 16) { c[n] = __uint_as_float((__float_as_uint(v[0][i] + v[1][j]) & ~255u) | (unsigned)((i << 4) | j)); ++n; }
#pragma unroll
        for (int k = 50; k < 64; ++k) c[k] = -3.0e38f;
        top16_of_64<false>(c);
#pragma unroll
        for (int i = 0; i < 16; ++i) { tbl[i * 64 + lane] = v[0][i]; tbl[(16 + i) * 64 + lane] = v[1][i]; }
        LDS_WAIT();
        float sv[16]; int ev[16]; float mx = -3.0e38f;
#pragma unroll
        for (int k = 0; k < 16; ++k) { const unsigned pl = __float_as_uint(c[k]) & 255u; const float a1 = tbl[(pl >> 4) * 64 + lane], a2 = tbl[(16 + (pl & 15)) * 64 + lane];
            sv[k] = a1 + a2; ev[k] = (int)(((__float_as_uint(a1) & 127u) << 7) | (__float_as_uint(a2) & 127u)); mx = fmaxf(mx, sv[k]); }
        float sum = 0.f;
#pragma unroll
        for (int k = 0; k < 16; ++k) { sv[k] = __expf(sv[k] - mx); sum += sv[k]; }
        const float inv = 1.0f / sum;
        if (hh == 0) {
#pragma unroll
            for (int k = 0; k < 16; k += 4) *(v4u*)(F.wsp<int>(WS_IDX) + tok * NSEL + h * 16 + k) = (v4u){(unsigned)ev[k], (unsigned)ev[k + 1], (unsigned)ev[k + 2], (unsigned)ev[k + 3]};
        } else {
#pragma unroll
            for (int k = 0; k < 16; k += 4) *(f32x4*)(F.wsp<float>(WS_G) + tok * NSEL + h * 16 + k) = (f32x4){sv[k] * inv, sv[k + 1] * inv, sv[k + 2] * inv, sv[k + 3] * inv};
        }
        LDS_WAIT();
    }
}
typedef _Float16 f16x2_t __attribute__((ext_vector_type(2)));
constexpr float V_UNSCALE = 1.f / 16.f;
DI int dot16_i8(const v4u& u, const unsigned (&x)[4]) {
    const unsigned u0 = u.x, u1 = u.y, u2 = u.z, u3 = u.w;
    int a = 0;
    a = __builtin_amdgcn_sdot4((int)u0, (int)x[0], a, false); a = __builtin_amdgcn_sdot4((int)u1, (int)x[1], a, false);
    a = __builtin_amdgcn_sdot4((int)u2, (int)x[2], a, false); a = __builtin_amdgcn_sdot4((int)u3, (int)x[3], a, false);
    return a;
}
DI f16x2_t cvt_f16x2_fp8(unsigned v, float scale, bool hi) { return hi ? __builtin_bit_cast(f16x2_t, __builtin_amdgcn_cvt_scalef32_pk_f16_fp8(v, scale, true)) : __builtin_bit_cast(f16x2_t, __builtin_amdgcn_cvt_scalef32_pk_f16_fp8(v, scale, false)); }
DI void axpy16_v8(f16x2_t (&o)[8], float w, const v4u& v) {
    const unsigned v0 = v.x, v1 = v.y, v2 = v.z, v3 = v.w;
    const f16x2_t w2 = {(_Float16)w, (_Float16)w};
    o[0] = __builtin_elementwise_fma(cvt_f16x2_fp8(v0, V_UNSCALE, false), w2, o[0]); o[1] = __builtin_elementwise_fma(cvt_f16x2_fp8(v0, V_UNSCALE, true), w2, o[1]);
    o[2] = __builtin_elementwise_fma(cvt_f16x2_fp8(v1, V_UNSCALE, false), w2, o[2]); o[3] = __builtin_elementwise_fma(cvt_f16x2_fp8(v1, V_UNSCALE, true), w2, o[3]);
    o[4] = __builtin_elementwise_fma(cvt_f16x2_fp8(v2, V_UNSCALE, false), w2, o[4]); o[5] = __builtin_elementwise_fma(cvt_f16x2_fp8(v2, V_UNSCALE, true), w2, o[5]);
    o[6] = __builtin_elementwise_fma(cvt_f16x2_fp8(v3, V_UNSCALE, false), w2, o[6]); o[7] = __builtin_elementwise_fma(cvt_f16x2_fp8(v3, V_UNSCALE, true), w2, o[7]);
}
constexpr int TPW = 4, NSLICE = 16, SLICE_SHIFT = 10, NPAIR = TPW * NSEL, NPAIR_PAD = NPAIR + 3 * TPW * NSLICE + 32;
constexpr int PEER_LDS_PER_WAVE = TPW * 1024 + 64 + TPW * 2048 + NPAIR_PAD * 4;
static_assert(PEER_LDS_PER_WAVE * NWAVES <= RING_BYTES, "PEER LDS");
DI int incl_scan64(int v, int lane) {
    int s = v;
#pragma unroll
    for (int d = 1; d < 64; d <<= 1) { const int t = __shfl_up(s, d); if (lane >= d) s += t; }
    return s;
}
struct PeerBatch { v4u uu[4], vv[4]; unsigned ent[4]; float su[4]; };
DI void peer_load_batch(PeerBatch& B, const LAS unsigned* ml, int i, const unsigned char* EU8, const unsigned char* EV8, const float* SU, int lane, unsigned emask = 0x3fffu) {
    const v4u e4 = *(const LAS v4u*)(ml + i);
    B.ent[0] = (unsigned)__builtin_amdgcn_readfirstlane((int)e4.x); B.ent[1] = (unsigned)__builtin_amdgcn_readfirstlane((int)e4.y);
    B.ent[2] = (unsigned)__builtin_amdgcn_readfirstlane((int)e4.z); B.ent[3] = (unsigned)__builtin_amdgcn_readfirstlane((int)e4.w);
#pragma unroll
    for (int k = 0; k < 4; ++k) { const unsigned e = B.ent[k] & emask; const unsigned char* ur = EU8 + (size_t)e * DM; const unsigned char* vr = EV8 + (size_t)e * DM;
        B.uu[k] = *(const v4u*)(ur + (unsigned)(16 * lane)); B.vv[k] = *(const v4u*)(vr + (unsigned)(16 * lane)); B.su[k] = SU[e]; }
}
struct PeerState { unsigned x[4]; float sx; f16x2_t oc[8]; int curj; };
DI void peer_flush(PeerState& S, LAS unsigned char* ol, int lane) {
    LAS v4u* r = (LAS v4u*)(ol + S.curj * 2048) + lane;
#pragma unroll
    for (int c = 0; c < 2; ++c) { const v4u v = r[64 * c]; v4u o;
        o.x = __builtin_bit_cast(unsigned, __builtin_bit_cast(f16x2_t, (unsigned)v.x) + S.oc[4 * c]); o.y = __builtin_bit_cast(unsigned, __builtin_bit_cast(f16x2_t, (unsigned)v.y) + S.oc[4 * c + 1]);
        o.z = __builtin_bit_cast(unsigned, __builtin_bit_cast(f16x2_t, (unsigned)v.z) + S.oc[4 * c + 2]); o.w = __builtin_bit_cast(unsigned, __builtin_bit_cast(f16x2_t, (unsigned)v.w) + S.oc[4 * c + 3]);
        r[64 * c] = o; }
#pragma unroll
    for (int i = 0; i < 8; ++i) S.oc[i] = (f16x2_t){(_Float16)0.f, (_Float16)0.f};
}
DI void peer_compute_batch(const PeerBatch& B, PeerState& S, LAS unsigned char* ol, const LAS unsigned char* xl, int lane) {
    const int j = (int)((B.ent[0] >> 14) & 3u);
    if (j != S.curj) {
        if (S.curj >= 0) peer_flush(S, ol, lane);
        S.curj = j;
        const v4u y0 = ((const LAS v4u*)(xl + j * 1024))[lane];
        S.x[0] = y0.x; S.x[1] = y0.y; S.x[2] = y0.z; S.x[3] = y0.w; S.sx = ((const LAS float*)(xl + TPW * 1024))[j]; }
    const float d0 = (float)dot16_i8(B.uu[0], S.x) * B.su[0], d1 = (float)dot16_i8(B.uu[1], S.x) * B.su[1], d2 = (float)dot16_i8(B.uu[2], S.x) * B.su[2], d3 = (float)dot16_i8(B.uu[3], S.x) * B.su[3];
    const bool b0 = lane & 1, b1 = lane & 2;
    const float r0 = (b0 ? d1 : d0) + dpp_xor1(b0 ? d0 : d1), r1 = (b0 ? d3 : d2) + dpp_xor1(b0 ? d2 : d3);
    float t = (b1 ? r1 : r0) + dpp_xor2(b1 ? r0 : r1);
    t += __int_as_float(__builtin_amdgcn_update_dpp(0, __float_as_int(t), 0x124, 0xf, 0xf, true));
    t += __int_as_float(__builtin_amdgcn_update_dpp(0, __float_as_int(t), 0x128, 0xf, 0xf, true));
    { auto rr = __builtin_amdgcn_permlane16_swap(__float_as_uint(t), __float_as_uint(t), false, false); t = __uint_as_float(rr[0]) + __uint_as_float(rr[1]); }
    { auto rr = __builtin_amdgcn_permlane32_swap(__float_as_uint(t), __float_as_uint(t), false, false); t = __uint_as_float(rr[0]) + __uint_as_float(rr[1]); }
    const float act = gelu_tanh(t * S.sx);
#pragma unroll
    for (int k = 0; k < 4; ++k) { const float a = __builtin_bit_cast(float, __builtin_amdgcn_readlane(__builtin_bit_cast(int, act), k));
        axpy16_v8(S.oc, __uint_as_float(B.ent[k] & 0xffff0000u) * a, B.vv[k]); }
}
DI void p8b_peer(Frame& F, float* outp, unsigned emask = 0x3fffu) {
    const int lane = F.lane, w = F.wave;
    const int gw = F.vcu * NWAVES + w, NGW = F.G * NWAVES;
    const unsigned char* EU8 = F.wsp<unsigned char>(WS_EU); const unsigned char* EV8 = F.wsp<unsigned char>(WS_EV); const float* SU = F.wsp<float>(WS_SU);
    LAS unsigned char* xl = F.lds + w * PEER_LDS_PER_WAVE;
    LAS unsigned char* ol = xl + TPW * 1024 + 64;
    LAS unsigned* ml = (LAS unsigned*)(ol + TPW * 2048);
    for (int t0 = gw * TPW; t0 < M; t0 += NGW * TPW) {
        unsigned enta[TPW], entb[TPW]; int posa[TPW], posb[TPW], sla[TPW], slb[TPW], offs[TPW];
#pragma unroll
        for (int j = 0; j < TPW; ++j) { const size_t tok = (size_t)t0 + j;
            float rstd; { const f32x4* sp = (const f32x4*)(F.wsp<float>(WS_SSQ2) + tok * 16); const f32x4 st = (sp[0] + sp[1]) + (sp[2] + sp[3]); rstd = rsq_(((st.x + st.y) + (st.z + st.w)) * (1.f / 1024.f) + EPS); }
            { const bf16* xs = F.wsp<bf16>(WS_XN) + tok * DM + 16 * lane;
              const v4u x0 = *(const v4u*)xs, x1 = *(const v4u*)(xs + 8);
              float xf[16] = {bflo(x0.x), bfhi(x0.x), bflo(x0.y), bfhi(x0.y), bflo(x0.z), bfhi(x0.z), bflo(x0.w), bfhi(x0.w), bflo(x1.x), bfhi(x1.x), bflo(x1.y), bfhi(x1.y), bflo(x1.z), bfhi(x1.z), bflo(x1.w), bfhi(x1.w)};
              float mx = 0.f;
#pragma unroll
              for (int i = 0; i < 16; ++i) mx = fmaxf(mx, fabsf(xf[i]));
              mx = fmaxf(max64(mx), 1e-30f); const float inv = 127.0f / mx;
              v4u y; y.x = pack_i8x4(xf[0] * inv, xf[1] * inv, xf[2] * inv, xf[3] * inv); y.y = pack_i8x4(xf[4] * inv, xf[5] * inv, xf[6] * inv, xf[7] * inv);
              y.z = pack_i8x4(xf[8] * inv, xf[9] * inv, xf[10] * inv, xf[11] * inv); y.w = pack_i8x4(xf[12] * inv, xf[13] * inv, xf[14] * inv, xf[15] * inv);
              ((LAS v4u*)(xl + j * 1024))[lane] = y; if (lane == 0) ((LAS float*)(xl + TPW * 1024))[j] = mx * rstd * (1.0f / 127.0f);
              ((LAS v4u*)(ol + j * 2048))[lane] = (v4u){0u, 0u, 0u, 0u}; ((LAS v4u*)(ol + j * 2048))[64 + lane] = (v4u){0u, 0u, 0u, 0u}; }
            const int ea = F.wsp<int>(WS_IDX)[tok * NSEL + lane], eb = F.wsp<int>(WS_IDX)[tok * NSEL + 64 + lane];
            const float ga = F.wsp<float>(WS_G)[tok * NSEL + lane], gb = F.wsp<float>(WS_G)[tok * NSEL + 64 + lane];
            const int sa = ea >> SLICE_SHIFT, sb = eb >> SLICE_SHIFT;
            int pa = 0, pb = 0, myoff = 0;
#pragma unroll
            for (int bk = 0; bk < NSLICE; ++bk) { const unsigned long long ma = __ballot(sa == bk), mb = __ballot(sb == bk);
                const int ca = __popcll(ma), cb = __popcll(mb);
                const int ra = __builtin_amdgcn_mbcnt_hi((unsigned)(ma >> 32), __builtin_amdgcn_mbcnt_lo((unsigned)ma, 0)), rb = __builtin_amdgcn_mbcnt_hi((unsigned)(mb >> 32), __builtin_amdgcn_mbcnt_lo((unsigned)mb, 0));
                pa = (sa == bk) ? ra : pa; pb = (sb == bk) ? ca + rb : pb;
                myoff = (lane == bk) ? ca + cb : myoff; }
            enta[j] = (unsigned)ea | ((unsigned)j << 14) | (pk2(0.f, ga) & 0xffff0000u); entb[j] = (unsigned)eb | ((unsigned)j << 14) | (pk2(0.f, gb) & 0xffff0000u);
            posa[j] = pa; posb[j] = pb; sla[j] = sa; slb[j] = sb; offs[j] = myoff;
        }
        int cnt = 0;
#pragma unroll
        for (int j = 0; j < TPW; ++j) { const int c = __shfl(offs[j], lane >> 2); cnt = ((lane & 3) == j) ? c : cnt; }
        const int cpad = (cnt + 3) & ~3;
        const int bend = incl_scan64(cpad, lane), bstart = bend - cpad;
        const int npad = __builtin_amdgcn_readlane(bend, 63);
#pragma unroll
        for (int j = 0; j < TPW; ++j) { const int ba = __shfl(bstart, 4 * sla[j] + j), bb = __shfl(bstart, 4 * slb[j] + j);
            ml[ba + posa[j]] = enta[j]; ml[bb + posb[j]] = entb[j]; }
        { const unsigned pad = (unsigned)((lane >> 2) << SLICE_SHIFT) | ((unsigned)(lane & 3) << 14);
#pragma unroll
          for (int q = 0; q < 3; ++q) if (cnt + q < cpad) ml[bstart + cnt + q] = pad; }
        if (lane < 28) ml[npad + lane] = (unsigned)((NSLICE - 1) << SLICE_SHIFT) | (3u << 14);
        LDS_WAIT();
        PeerState S;
#pragma unroll
        for (int i = 0; i < 8; ++i) { S.x[i] = 0u; S.oc[i] = (f16x2_t){(_Float16)0.f, (_Float16)0.f}; }
        S.curj = -1;
        PeerBatch A, B, C, D;
        peer_load_batch(A, ml, 0, EU8, EV8, SU, lane, emask); peer_load_batch(B, ml, 4, EU8, EV8, SU, lane, emask); peer_load_batch(C, ml, 8, EU8, EV8, SU, lane, emask);
#pragma unroll 1
        for (int i = 0; i < npad; i += 16) {
            peer_load_batch(D, ml, i + 12, EU8, EV8, SU, lane, emask); peer_compute_batch(A, S, ol, xl, lane);
            peer_load_batch(A, ml, i + 16, EU8, EV8, SU, lane, emask); peer_compute_batch(B, S, ol, xl, lane);
            peer_load_batch(B, ml, i + 20, EU8, EV8, SU, lane, emask); peer_compute_batch(C, S, ol, xl, lane);
            peer_load_batch(C, ml, i + 24, EU8, EV8, SU, lane, emask); peer_compute_batch(D, S, ol, xl, lane);
        }
        peer_flush(S, ol, lane);
        LDS_WAIT();
#pragma unroll
        for (int j = 0; j < TPW; ++j) {
            const float* xr = F.out + ((size_t)t0 + j) * DM + 16 * lane; float* orow = outp + ((size_t)t0 + j) * DM + 16 * lane;
            f32x4 a[4]; float ss = 0.f;
            const v4u h0 = ((const LAS v4u*)(ol + j * 2048))[lane], h1 = ((const LAS v4u*)(ol + j * 2048))[64 + lane];
            const unsigned hw[8] = {h0.x, h0.y, h0.z, h0.w, h1.x, h1.y, h1.z, h1.w};
#pragma unroll
            for (int q = 0; q < 4; ++q) { const f16x2_t p0 = __builtin_bit_cast(f16x2_t, hw[2 * q]), p1 = __builtin_bit_cast(f16x2_t, hw[2 * q + 1]);
                a[q] = *(const f32x4*)(xr + 4 * q) + (f32x4){(float)p0.x, (float)p0.y, (float)p1.x, (float)p1.y};
                ss += (a[q].x * a[q].x + a[q].y * a[q].y) + (a[q].z * a[q].z + a[q].w * a[q].w); }
            const float rf = rsq_(sum64(ss) * (1.f / 1024.f) + EPS);
#pragma unroll
            for (int q = 0; q < 4; ++q) *(f32x4*)(orow + 4 * q) = a[q] * rf * *(const f32x4*)(F.in(25) + 16 * lane + 4 * q);
        }
        LDS_WAIT();
    }
}
constexpr int N_PHASES = 11;
__global__ void __launch_bounds__(NWAVES * 64, 2) fwd_kernel(Args args) {
    extern __shared__ __attribute__((aligned(16))) unsigned char lds[];
    Frame F;
    F.lds = (LAS unsigned char*)lds;
    F.MISC = (volatile LAS unsigned*)(F.lds + MISC_OFF);
    F.tid = threadIdx.x; F.lane = F.tid & 63; F.wave = __builtin_amdgcn_readfirstlane(F.tid >> 6);
    F.G = gridDim.x; { const int bx = blockIdx.x; F.vcu = (F.G % 8 == 0) ? (bx % 8) * (F.G / 8) + bx / 8 : bx; }
    F.A = &args; F.ws = args.ws; F.out = args.out;
    F.ctl = (gu32*)(args.ws + WS_CTL);
    for (int u = F.tid; u < (LDS_BYTES - LDSCTL_OFF) / 4; u += NWAVES * 64) ((LAS unsigned*)(F.lds + LDSCTL_OFF))[u] = 0u;
    __syncthreads();
    const bool multi = (args.ph_hi - args.ph_lo) > 1;
    XcdBarrier bar; bar.bar = (unsigned*)(F.ctl + CW_BAR) + args.li * XCD_BAR_WORDS; bar.x = 0; bar.st = nullptr;
    if (multi) bar = xcd_barrier_post((unsigned*)(F.ctl + CW_BAR) + args.li * XCD_BAR_WORDS, F.MISC + 8);
    const int lo = args.ph_lo, hi = args.ph_hi;
#ifndef PROBE_EMASK
#define PROBE_EMASK 0x3fffu
#endif
#ifndef PHASE_REPEAT
#define PHASE_REPEAT 0
#endif
#define REP(k) for (int rep_ = 0; rep_ < (((PHASE_REPEAT >> (k)) & 1) ? 2 : 1); ++rep_)
#ifndef PHASE_MASK
#define PHASE_MASK 0x7ff
#endif
#define IN(k) (((PHASE_MASK >> (k)) & 1) && lo <= (k) && (k) < hi)
#define SEAM(k) do { asm volatile("; ===SEAM " #k ::: "memory"); if (IN(k) && IN((k) + 1)) xcd_barrier(bar); } while (0)
    const int c = (int)blockIdx.x;

    if (IN(0)) REP(0) { p0_prologue(F); } SEAM(0);
    if (IN(1)) REP(1) {
        { pg8::Gemm g{F.wsp<bf16>(WS_XN), F.wsp<bf16>(WS_WIN), M, INW, DM}; pg8::StaticOrder S; S.init(M, INW, F.G, c);
          pg8::EpiSplitT E{F.wsp<bf16>(WS_Z), ZW, ZW, F.wsp<bf16>(WS_VT), ATTW, SEQ};
          pg8::gemm_phase<pg8::EpiSplitT, pg8::StaticOrder, true, true>(F.lds, g, S, E); }
        { const int nw3 = (M / 256) * (INW / 256) - 2 * F.G;
          int idx = -1; if (nw3 >= 0 && nw3 + 16 <= F.G) idx = c - nw3; else idx = (c < 16 && F.G >= 16) ? c : -1;
          if (F.G < 16) idx = -1;
          pg8::Gemm g{F.wsp<bf16>(WS_MEMN), F.wsp<bf16>(WS_WKV), NBATCH * 256, 2 * DM, DM};
          if (F.G >= 16) { pg8::OneUnit S{idx, 2, 8}; pg8::EpiSplitT E{F.wsp<bf16>(WS_KM), DM, DM, F.wsp<bf16>(WS_VMT), DM, 256};
              pg8::gemm_phase<pg8::EpiSplitT, pg8::OneUnit, false, true>(F.lds, g, S, E); }
          else { pg8::StaticOrder S; S.init(NBATCH * 256, 2 * DM, F.G, c); pg8::EpiSplitT E{F.wsp<bf16>(WS_KM), DM, DM, F.wsp<bf16>(WS_VMT), DM, 256};
              pg8::gemm_phase<pg8::EpiSplitT, pg8::StaticOrder, false, true>(F.lds, g, S, E); } }
    } SEAM(1);
    if (IN(2)) REP(2) { p2_lru_aggregates(F); } SEAM(2);
    if (IN(3)) REP(3) { p3_mixer(F); } SEAM(3);
    if (IN(4)) REP(4) {
        pg8::Gemm g{F.wsp<bf16>(WS_Y), F.wsp<bf16>(WS_WOUT), M, DM, DM}; pg8::StaticOrder S; S.init(M, DM, F.G, c);
        pg8::EpiResid E{F.in(0), F.out, F.wsp<bf16>(WS_XN), F.wsp<float>(WS_SSQ1), DM};
        pg8::gemm_phase<pg8::EpiResid, pg8::StaticOrder, true, true>(F.lds, g, S, E);
    } SEAM(4);
    if (IN(5)) REP(5) {
        pg8::Gemm g{F.wsp<bf16>(WS_XN), F.wsp<bf16>(WS_WQ), M, DM, DM}; pg8::StaticOrder S; S.init(M, DM, F.G, c);
        pg8::EpiRowScale E{F.wsp<bf16>(WS_QC), DM, F.wsp<float>(WS_SSQ1), 1.f / 1024.f, EPS};
        pg8::gemm_phase<pg8::EpiRowScale, pg8::StaticOrder, true, true>(F.lds, g, S, E);
    } SEAM(5);
    if (IN(6)) REP(6) { p5_cross(F); } SEAM(6);
    if (IN(7)) {
        pg8::Gemm g{F.wsp<bf16>(WS_OC), F.wsp<bf16>(WS_WO), M, DM, DM}; pg8::StaticOrder S; S.init(M, DM, F.G, c);
        pg8::EpiResid E{F.out, F.out, F.wsp<bf16>(WS_XN), F.wsp<float>(WS_SSQ2), DM};
        pg8::gemm_phase<pg8::EpiResid, pg8::StaticOrder, true, true>(F.lds, g, S, E);
    } SEAM(7);
    if (IN(8)) REP(8) {
        pg8::Gemm g{F.wsp<bf16>(WS_XN), F.wsp<bf16>(WS_WQRY), M, 2 * DM, DM}; pg8::StaticOrder S; S.init(M, 2 * DM, F.G, c);
        pg8::EpiRowScale E{F.wsp<bf16>(WS_QP), 2 * DM, F.wsp<float>(WS_SSQ2), 1.f / 1024.f, EPS};
        pg8::gemm_phase<pg8::EpiRowScale, pg8::StaticOrder, true, true>(F.lds, g, S, E);
    } SEAM(8);
    if (IN(9)) REP(9) { p8a_topk(F); } SEAM(9);
    if (IN(10)) { if ((PHASE_REPEAT >> 10) & 1) { p8b_peer(F, F.wsp<float>(WS_Z), PROBE_EMASK); } p8b_peer(F, F.out); }
#undef IN
#undef SEAM
}

#ifndef N_LAUNCH_MODE
#define N_LAUNCH_MODE 1
#endif
extern "C" void kernel_launch(void* const* d_in, const int* in_sizes, int n_in, void* d_out, int out_size, void* d_ws, size_t ws_size, hipStream_t stream) {
    static int grid = 0;
    if (grid == 0) {
        if (n_in != 26 || out_size != M * DM || ws_size < WS_END) { fprintf(stderr, "kernel_launch: unexpected shapes (n_in %d, out %d, ws %zu)\n", n_in, out_size, ws_size); grid = -1; return; }
        int dev = 0, cus = 0, per_cu = 0;
        if (hipGetDevice(&dev) != hipSuccess || hipDeviceGetAttribute(&cus, hipDeviceAttributeMultiprocessorCount, dev) != hipSuccess) { grid = -1; return; }
        if (hipFuncSetAttribute((const void*)fwd_kernel, hipFuncAttributeMaxDynamicSharedMemorySize, LDS_BYTES) != hipSuccess) { fprintf(stderr, "kernel_launch: hipFuncSetAttribute failed\n"); grid = -1; return; }
        if (hipOccupancyMaxActiveBlocksPerMultiprocessor(&per_cu, (const void*)fwd_kernel, NWAVES * 64, LDS_BYTES) != hipSuccess || per_cu < 1) { fprintf(stderr, "kernel_launch: occupancy query says %d blocks per CU\n", per_cu); (void)hipGetLastError(); grid = -1; return; }
        grid = cus;
    }
    if (grid < 0) return;
    (void)hipMemsetAsync((char*)d_ws + WS_CTL, 0, CTL_ZERO_BYTES, stream);
    Args a{};
    for (int i = 0; i < 26; ++i) a.in[i] = (const float*)d_in[i];
    a.out = (float*)d_out; a.ws = (unsigned char*)d_ws;
    if (N_LAUNCH_MODE == 1) { a.ph_lo = 0; a.ph_hi = N_PHASES; a.li = 0; hipLaunchKernelGGL(fwd_kernel, dim3(grid), dim3(NWAVES * 64), LDS_BYTES, stream, a); }
    else { for (int p = 0; p < N_PHASES; ++p) { a.ph_lo = p; a.ph_hi = p + 1; a.li = 0; hipLaunchKernelGGL(fwd_kernel, dim3(grid), dim3(NWAVES * 64), LDS_BYTES, stream, a); } }
}
```

```cpp
#include <hip/hip_runtime.h>
#include <cstdio>
#include <cstdint>
namespace pg8 {
#define PG8_LAS __attribute__((address_space(3)))
typedef unsigned short bf16_t;
typedef short bf16x8 __attribute__((ext_vector_type(8)));
typedef float f32x4 __attribute__((ext_vector_type(4)));
typedef unsigned u32x4 __attribute__((ext_vector_type(4)));
constexpr int BM = 256, BK = 64, HALF = 128, HTB = HALF * BK * 2  , STAGE_BYTES = 8 * HTB, NXCD = 8, WGM = 8;

__host__ __device__ __forceinline__ int lds_byte(int r, int c) { const int st = (r >> 4) * 2 + (c >> 5), rr = r & 15, cc = c & 31, ob = rr * 64 + cc * 2; return st * 1024 + (ob ^ (((ob >> 9) & 1) << 5)); }
__host__ __device__ __forceinline__ void stage_rc(int b, int& R, int& C) { const int st = b / 1024, sb = b % 1024, swz = sb ^ (((sb >> 9) & 1) << 5); R = (st >> 1) * 16 + swz / 64; C = (st & 1) * 32 + (swz % 64) / 2; }
__host__ __device__ __forceinline__ int perm32(int rho) { const int n = rho >> 4, i = rho & 15; return 8 * (i >> 2) + 4 * n + (i & 3); }

struct Unit { int pm, pn; };
struct Gemm { const bf16_t* A; const bf16_t* Bt; int M, N, K; };

struct StaticOrder {
    int nM, nN, nwg, G, c;
    __host__ __device__ void init(int M, int N, int G_, int c_) { nM = M / BM; nN = N / BM; nwg = nM * nN; G = G_; c = c_; }
    __host__ __device__ bool next(int i, Unit& u) const {
        const long L = (long)i * G + c; if (L >= nwg) return false;
        int wgid = (int)L; { const int q = nwg / NXCD, r = nwg % NXCD, xcd = wgid % NXCD, off = wgid / NXCD; wgid = (xcd < r ? xcd * (q + 1) : r * (q + 1) + (xcd - r) * q) + off; }
        const int nig = WGM * nN, gid = wgid / nig, fm = gid * WGM, gsz = (nM - fm) < WGM ? (nM - fm) : WGM;
        u.pm = fm + ((wgid % nig) % gsz); u.pn = (wgid % nig) / gsz; return true;
    }
    __device__ __forceinline__ void a_ready(const Unit&) const {}
    __device__ __forceinline__ void done(const Unit&) const {}
};

typedef float f32x2 __attribute__((ext_vector_type(2)));
typedef __bf16 bf16x2_t __attribute__((ext_vector_type(2)));
__device__ __forceinline__ unsigned cvt_pk_bf16(float lo, float hi) { f32x2 v = {lo, hi}; bf16x2_t b = __builtin_convertvector(v, bf16x2_t); return __builtin_bit_cast(unsigned, b); }
__device__ __forceinline__ bf16_t cvt_bf16(float x) { return (bf16_t)(cvt_pk_bf16(x, 0.f) & 0xffffu); }

struct EpiSplitT {
    static constexpr bool PERM = true, AFTER_DRAIN = false;
    bf16_t* O; int ldc; int ncols_rm; bf16_t* T; int NT; int rpb;
    __device__ __forceinline__ void operator()(const f32x4 (&acc)[2][2][4][2], const Unit& u, int wr, int wc, int fr, int fq) const {
        const int row0 = u.pm * BM + wr * 64 + fr; const int colt = u.pn * BM;
        if (colt < ncols_rm) {
            const int col0 = colt + wc * 32 + 8 * fq;
#pragma unroll
            for (int ai = 0; ai < 2; ++ai)
#pragma unroll
                for (int m = 0; m < 4; ++m) { bf16_t* rowp = O + (size_t)(row0 + ai * HALF + m * 16) * ldc + col0;
#pragma unroll
                    for (int bj = 0; bj < 2; ++bj) { const f32x4 v0 = acc[ai][bj][m][0], v1 = acc[ai][bj][m][1];
                        u32x4 w; w.x = cvt_pk_bf16(v0[0], v0[1]); w.y = cvt_pk_bf16(v0[2], v0[3]); w.z = cvt_pk_bf16(v1[0], v1[1]); w.w = cvt_pk_bf16(v1[2], v1[3]);
                        *(u32x4*)(rowp + bj * HALF) = w; } }
        } else {
            const int c0 = colt - ncols_rm + wc * 32 + 8 * fq;
#pragma unroll
            for (int ai = 0; ai < 2; ++ai)
#pragma unroll
                for (int m = 0; m < 4; ++m) { const int row = row0 + ai * HALF + m * 16; const int b = row / rpb, t = row - b * rpb; bf16_t* base = T + (size_t)b * NT * rpb + t;
#pragma unroll
                    for (int bj = 0; bj < 2; ++bj)
#pragma unroll
                        for (int n = 0; n < 2; ++n)
#pragma unroll
                            for (int e = 0; e < 4; ++e) base[(size_t)(c0 + bj * HALF + 4 * n + e) * rpb] = cvt_bf16(acc[ai][bj][m][n][e]); }
        }
    }
};
template <bool BASE_BF16> struct EpiResid {
    static constexpr bool PERM = true, AFTER_DRAIN = false;
    const void* base; bf16_t* xb; float* ssq; int ldc;
    __device__ __forceinline__ void operator()(const f32x4 (&acc)[2][2][4][2], const Unit& u, int wr, int wc, int fr, int fq) const {
        const int row0 = u.pm * BM + wr * 64 + fr; const int col0 = u.pn * BM + wc * 32 + 8 * fq;
#pragma unroll
        for (int ai = 0; ai < 2; ++ai)
#pragma unroll
            for (int m = 0; m < 4; ++m) { const int row = row0 + ai * HALF + m * 16; float s = 0.f;
#pragma unroll
                for (int bj = 0; bj < 2; ++bj) { const size_t off = (size_t)row * ldc + col0 + bj * HALF;
                    f32x4 b0, b1;
                    if (BASE_BF16) { const u32x4 w = *(const u32x4*)((const bf16_t*)base + off);
                        b0 = (f32x4){__uint_as_float(w.x << 16), __uint_as_float(w.x & 0xffff0000u), __uint_as_float(w.y << 16), __uint_as_float(w.y & 0xffff0000u)};
                        b1 = (f32x4){__uint_as_float(w.z << 16), __uint_as_float(w.z & 0xffff0000u), __uint_as_float(w.w << 16), __uint_as_float(w.w & 0xffff0000u)}; }
                    else { b0 = *(const f32x4*)((const float*)base + off); b1 = *(const f32x4*)((const float*)base + off + 4); }
                    const f32x4 v0 = acc[ai][bj][m][0] + b0, v1 = acc[ai][bj][m][1] + b1;
                    s += (v0[0] * v0[0] + v0[1] * v0[1]) + (v0[2] * v0[2] + v0[3] * v0[3]) + (v1[0] * v1[0] + v1[1] * v1[1]) + (v1[2] * v1[2] + v1[3] * v1[3]);
                    u32x4 w; w.x = cvt_pk_bf16(v0[0], v0[1]); w.y = cvt_pk_bf16(v0[2], v0[3]); w.z = cvt_pk_bf16(v1[0], v1[1]); w.w = cvt_pk_bf16(v1[2], v1[3]);
                    *(u32x4*)(xb + off) = w; }
                s += __shfl_xor(s, 16); s += __shfl_xor(s, 32);
                if (fq == 0) ssq[(size_t)row * 16 + u.pn * 4 + wc] = s; }
    }
};
struct EpiRowScale {
    static constexpr bool PERM = true, AFTER_DRAIN = false;
    bf16_t* O; int ldc; const float* ssq; float inv_n, eps;
    __device__ __forceinline__ void operator()(const f32x4 (&acc)[2][2][4][2], const Unit& u, int wr, int wc, int fr, int fq) const {
        const int row0 = u.pm * BM + wr * 64 + fr; const int col0 = u.pn * BM + wc * 32 + 8 * fq;
#pragma unroll
        for (int ai = 0; ai < 2; ++ai)
#pragma unroll
            for (int m = 0; m < 4; ++m) { const int row = row0 + ai * HALF + m * 16; const f32x4* sp = (const f32x4*)(ssq + (size_t)row * 16);
                const f32x4 s0 = sp[0], s1 = sp[1], s2 = sp[2], s3 = sp[3]; const f32x4 st = (s0 + s1) + (s2 + s3);
                const float r = 1.0f / sqrtf(((st[0] + st[1]) + (st[2] + st[3])) * inv_n + eps);
                bf16_t* rowp = O + (size_t)row * ldc + col0;
#pragma unroll
                for (int bj = 0; bj < 2; ++bj) { const f32x4 v0 = acc[ai][bj][m][0] * r, v1 = acc[ai][bj][m][1] * r;
                    u32x4 w; w.x = cvt_pk_bf16(v0[0], v0[1]); w.y = cvt_pk_bf16(v0[2], v0[3]); w.z = cvt_pk_bf16(v1[0], v1[1]); w.w = cvt_pk_bf16(v1[2], v1[3]);
                    *(u32x4*)(rowp + bj * HALF) = w; } }
    }
};
struct OneUnit {
    int idx, nM, nN;
    __device__ __forceinline__ bool next(int i, Unit& u) const { if (i > 0 || idx < 0 || idx >= nM * nN) return false; u.pm = idx % nM; u.pn = idx / nM; return true; }
    __device__ __forceinline__ void a_ready(const Unit&) const {}
    __device__ __forceinline__ void done(const Unit&) const {}
};

template <class Epi, class Sched, bool ALIGN_EPI = false, bool SP2 = false>
__device__ __forceinline__ void gemm_phase(PG8_LAS unsigned char* lds, const Gemm g, const Sched& S, const Epi& E) {
    const int tid = threadIdx.x, wid = __builtin_amdgcn_readfirstlane(tid >> 6), lane = tid & 63, wr = wid >> 2, wc = wid & 3, fr = lane & 15, fq = lane >> 4;
    const int K = g.K, nt = K / BK;
    unsigned voffA[2], voffB[2];
#pragma unroll
    for (int i = 0; i < 2; ++i) { int R, C; stage_rc(tid * 16 + i * 8192, R, C); const int Rb = Epi::PERM ? ((R & ~31) + perm32(R & 31)) : R;
        voffA[i] = (unsigned)(R * K + C) * 2u; voffB[i] = (unsigned)(Rb * K + C) * 2u; }
    const size_t kstep = (size_t)(BK * 2);
    const size_t hstep = (size_t)HALF * K * 2;
    const size_t tstep = 2 * hstep;
    const unsigned ldsw = (unsigned)wid * 1024u;
    const int aoff = lds_byte(wr * 64 + fr, fq * 8), boff = lds_byte(wc * 32 + fr, fq * 8);
#define PG8_SA(b, h) (((b) * 2 + (h)) * HTB)
#define PG8_SB(b, h) ((4 + (b) * 2 + (h)) * HTB)
#define PG8_STAGE(bufoff, gbase, voff) do { _Pragma("unroll") for (int _i = 0; _i < 2; ++_i) \
        __builtin_amdgcn_global_load_lds((const unsigned*)((const char*)(gbase) + (voff)[_i]), (PG8_LAS unsigned*)(lds + (bufoff) + ldsw + _i * 8192), 16, 0, 0); } while (0)
#define PG8_LDA(dst, b, h) do { _Pragma("unroll") for (int m = 0; m < 4; ++m) _Pragma("unroll") for (int k = 0; k < 2; ++k) dst[m][k] = *(const PG8_LAS bf16x8*)(lds + PG8_SA(b, h) + aoff + m * 2048 + k * 1024); } while (0)
#define PG8_LDB(dst, b, h) do { _Pragma("unroll") for (int n = 0; n < 2; ++n) _Pragma("unroll") for (int k = 0; k < 2; ++k) dst[n][k] = *(const PG8_LAS bf16x8*)(lds + PG8_SB(b, h) + boff + n * 2048 + k * 1024); } while (0)
#define PG8_MMA(ai, bj, At, Bt) do { __builtin_amdgcn_s_setprio(1); _Pragma("unroll") for (int m = 0; m < 4; ++m) _Pragma("unroll") for (int n = 0; n < 2; ++n) _Pragma("unroll") for (int k = 0; k < 2; ++k) \
        acc[ai][bj][m][n] = __builtin_amdgcn_mfma_f32_16x16x32_bf16(Bt[n][k], At[m][k], acc[ai][bj][m][n], 0, 0, 0); __builtin_amdgcn_s_setprio(0); } while (0)
#define PG8_WAIT_V(n) asm volatile("s_waitcnt vmcnt(" #n ")" ::: "memory")
#define PG8_WAIT_L(n) asm volatile("s_waitcnt lgkmcnt(" #n ")" ::: "memory")
#define PG8_BAR __builtin_amdgcn_s_barrier()
#define PG8_SCHED __builtin_amdgcn_sched_barrier(0)
    Unit cur, nxt; int ui = 0;
    if (!S.next(0, cur)) return;
    f32x4 acc[2][2][4][2];
#pragma unroll
    for (int a = 0; a < 2; ++a)
#pragma unroll
        for (int b = 0; b < 2; ++b)
#pragma unroll
            for (int m = 0; m < 4; ++m)
#pragma unroll
                for (int n = 0; n < 2; ++n) acc[a][b][m][n] = (f32x4){0.f, 0.f, 0.f, 0.f};
    bf16x8 At[4][2], B0[2][2], B1[2][2];
    const char* cA = (const char*)g.A + (size_t)cur.pm * tstep; const char* cB = (const char*)g.Bt + (size_t)cur.pn * tstep;
    S.a_ready(cur);
    if constexpr (SP2) {
        PG8_STAGE(PG8_SB(0, 0), cB, voffB); PG8_STAGE(PG8_SB(0, 1), cB + hstep, voffB); PG8_STAGE(PG8_SA(0, 0), cA, voffA); PG8_STAGE(PG8_SA(0, 1), cA + hstep, voffA);
        if (wr == 1) PG8_BAR;
        PG8_WAIT_V(2); PG8_BAR;
        PG8_STAGE(PG8_SB(1, 0), cB + kstep, voffB); PG8_STAGE(PG8_SA(1, 0), cA + kstep, voffA); PG8_STAGE(PG8_SB(1, 1), cB + hstep + kstep, voffB);
        PG8_WAIT_V(6); PG8_BAR;
    } else {
        PG8_STAGE(PG8_SB(0, 0), cB, voffB); PG8_STAGE(PG8_SA(0, 0), cA, voffA); PG8_STAGE(PG8_SB(0, 1), cB + hstep, voffB); PG8_STAGE(PG8_SA(0, 1), cA + hstep, voffA);
        if (wr == 1) PG8_BAR;
        PG8_WAIT_V(4); PG8_BAR;
        PG8_STAGE(PG8_SB(1, 0), cB + kstep, voffB); PG8_STAGE(PG8_SA(1, 0), cA + kstep, voffA); PG8_STAGE(PG8_SB(1, 1), cB + hstep + kstep, voffB);
        PG8_WAIT_V(6); PG8_BAR;
    }
    for (;;) {
        const bool has_next = S.next(ui + 1, nxt);
        const char* nA = has_next ? (const char*)g.A + (size_t)nxt.pm * tstep : cA; const char* nB = has_next ? (const char*)g.Bt + (size_t)nxt.pn * tstep : cB;
        for (int t = 0; t < nt; t += 2) {
            const bool last = (t == nt - 2);
            const char* a1 = cA + (size_t)(t + 1) * kstep;
            const char* a2 = last ? nA : cA + (size_t)(t + 2) * kstep; const char* b2 = last ? nB : cB + (size_t)(t + 2) * kstep;
            const char* a3 = a2 + kstep; const char* b3 = b2 + kstep;
            if (last && has_next) S.a_ready(nxt);
            if constexpr (SP2) {
            PG8_LDB(B0, 0, 0); PG8_LDB(B1, 0, 1); PG8_SCHED; PG8_LDA(At, 0, 0); PG8_STAGE(PG8_SA(1, 1), a1 + hstep, voffA);
            PG8_WAIT_V(8); PG8_WAIT_L(0); PG8_BAR; PG8_MMA(0, 0, At, B0); PG8_MMA(0, 1, At, B1); PG8_BAR; PG8_SCHED;
            PG8_LDA(At, 0, 1); PG8_STAGE(PG8_SB(0, 0), b2, voffB); PG8_STAGE(PG8_SB(0, 1), b2 + hstep, voffB); PG8_STAGE(PG8_SA(0, 0), a2, voffA);
            PG8_WAIT_V(8); PG8_WAIT_L(0); PG8_BAR; PG8_MMA(1, 0, At, B0); PG8_MMA(1, 1, At, B1); PG8_BAR; PG8_SCHED;
            PG8_LDB(B0, 1, 0); PG8_LDB(B1, 1, 1); PG8_SCHED; PG8_LDA(At, 1, 0); PG8_STAGE(PG8_SA(0, 1), a2 + hstep, voffA);
            PG8_WAIT_V(8); PG8_WAIT_L(0); PG8_BAR; PG8_MMA(0, 0, At, B0); PG8_MMA(0, 1, At, B1); PG8_BAR; PG8_SCHED;
            PG8_LDA(At, 1, 1); PG8_STAGE(PG8_SB(1, 0), b3, voffB); PG8_STAGE(PG8_SB(1, 1), b3 + hstep, voffB); PG8_STAGE(PG8_SA(1, 0), a3, voffA);
            PG8_WAIT_V(8); PG8_WAIT_L(0); PG8_BAR; PG8_MMA(1, 0, At, B0); PG8_MMA(1, 1, At, B1); PG8_BAR; PG8_SCHED;
            } else {
            PG8_LDB(B0, 0, 0); PG8_SCHED; PG8_LDA(At, 0, 0); PG8_STAGE(PG8_SA(1, 1), a1 + hstep, voffA);
            PG8_WAIT_L(8); PG8_BAR; PG8_WAIT_L(0); PG8_MMA(0, 0, At, B0); PG8_BAR; PG8_SCHED;
            PG8_LDB(B1, 0, 1); PG8_STAGE(PG8_SB(0, 0), b2, voffB);
            PG8_BAR; PG8_WAIT_L(0); PG8_MMA(0, 1, At, B1); PG8_BAR;
            PG8_LDA(At, 0, 1); PG8_STAGE(PG8_SA(0, 0), a2, voffA);
            PG8_BAR; PG8_WAIT_L(0); PG8_MMA(1, 0, At, B0); PG8_BAR; PG8_SCHED;
            PG8_STAGE(PG8_SB(0, 1), b2 + hstep, voffB);
            PG8_WAIT_V(6); PG8_BAR; PG8_MMA(1, 1, At, B1); PG8_BAR;
            PG8_LDB(B0, 1, 0); PG8_SCHED; PG8_LDA(At, 1, 0); PG8_STAGE(PG8_SA(0, 1), a2 + hstep, voffA);
            PG8_WAIT_L(8); PG8_BAR; PG8_WAIT_L(0); PG8_MMA(0, 0, At, B0); PG8_BAR; PG8_SCHED;
            PG8_LDB(B1, 1, 1); PG8_STAGE(PG8_SB(1, 0), b3, voffB);
            PG8_BAR; PG8_WAIT_L(0); PG8_MMA(0, 1, At, B1); PG8_BAR;
            PG8_LDA(At, 1, 1); PG8_STAGE(PG8_SA(1, 0), a3, voffA);
            PG8_BAR; PG8_WAIT_L(0); PG8_MMA(1, 0, At, B0); PG8_BAR; PG8_SCHED;
            PG8_STAGE(PG8_SB(1, 1), b3 + hstep, voffB);
            PG8_WAIT_V(6); PG8_BAR; PG8_MMA(1, 1, At, B1); PG8_BAR;
            }
        }
        if constexpr (ALIGN_EPI) { if (wr == 0) PG8_BAR; }
        if constexpr (!Epi::AFTER_DRAIN) { E(acc, cur, wr, wc, fr, fq); S.done(cur); }
        if (!has_next) break;
#pragma unroll
        for (int a = 0; a < 2; ++a)
#pragma unroll
            for (int b = 0; b < 2; ++b)
#pragma unroll
                for (int m = 0; m < 4; ++m)
#pragma unroll
                    for (int n = 0; n < 2; ++n) acc[a][b][m][n] = (f32x4){0.f, 0.f, 0.f, 0.f};
        cur = nxt; cA = nA; cB = nB; ++ui;
        if constexpr (ALIGN_EPI) { if (wr == 1) PG8_BAR; }
    }
    PG8_WAIT_V(0);
    if constexpr (!ALIGN_EPI) { if (wr == 0) PG8_BAR; }
    PG8_BAR;
    if constexpr (Epi::AFTER_DRAIN) { E.fused(acc, cur, wr, wc, fr, fq, lds, wid, lane); S.done(cur); }
#undef PG8_SA
#undef PG8_SB
#undef PG8_STAGE
#undef PG8_LDA
#undef PG8_LDB
#undef PG8_MMA
#undef PG8_WAIT_V
#undef PG8_WAIT_L
#undef PG8_BAR
#undef PG8_SCHED
}
}

#ifndef PG8_SP2
#define PG8_SP2 true
#endif
#ifndef PG8_ALIGN
#define PG8_ALIGN true
#endif
constexpr int NWAVES = 8;
constexpr int NBATCH = 2, SEQ = 8192, DM = 1024, M = NBATCH * SEQ;
constexpr int INW = 2560, ZW = 2048;
constexpr int LRUW = 512, ATTW = 512, NCHUNK = SEQ / 64;
constexpr int NEXP = 16384, PEER_H = 8, NSEL = 128;
constexpr float EPS = 1e-6f;
constexpr float LOG2E = 1.4426950408889634f;

constexpr size_t MiB = 1u << 20;
constexpr size_t WS_CTL = 0, CTL_ZERO_BYTES = 1 * MiB;
constexpr size_t WS_WIN = 1 * MiB, WS_WOUT = 6 * MiB, WS_WQ = 8 * MiB, WS_WKV = 10 * MiB, WS_WO = 14 * MiB, WS_WQRY = 16 * MiB;
constexpr size_t WS_SUBK = 20 * MiB, WS_GATEW = 20 * MiB + 512 * 1024, WS_MEMN = 21 * MiB, WS_KM = 22 * MiB, WS_VMT = 23 * MiB, WS_AGG = 24 * MiB, WS_SSQ1 = 25 * MiB, WS_SSQ2 = 26 * MiB, WS_SU = 27 * MiB;
constexpr size_t WS_EU = 28 * MiB, WS_EV = 60 * MiB, WS_XN = 92 * MiB, WS_Z = 124 * MiB, WS_VT = 188 * MiB, WS_Y = 204 * MiB, WS_END = 236 * MiB;
constexpr size_t WS_QC = WS_Z, WS_OC = WS_Z + 32 * MiB, WS_QP = WS_Z, WS_IDX = WS_VT, WS_G = WS_VT + 8 * MiB;
constexpr int CW_BAR = 4096;

constexpr int RING_BYTES = 155648;
constexpr int LDSCTL_OFF = RING_BYTES, MISC_OFF = LDSCTL_OFF + 320;
constexpr int LDS_BYTES = 163840;

#define GAS __attribute__((address_space(1)))
#define LAS __attribute__((address_space(3)))
typedef unsigned short bf16;
typedef unsigned v4u __attribute__((ext_vector_type(4)));
typedef unsigned v2u __attribute__((ext_vector_type(2)));
typedef float f32x4 __attribute__((ext_vector_type(4)));
typedef float f32x2 __attribute__((ext_vector_type(2)));
typedef float f32x16 __attribute__((ext_vector_type(16)));
typedef short bf16x8 __attribute__((ext_vector_type(8)));
typedef __bf16 bf16x2_t __attribute__((ext_vector_type(2)));
typedef GAS unsigned gu32;
#define RLX_AGENT __ATOMIC_RELAXED, __HIP_MEMORY_SCOPE_AGENT
#define LDS_WAIT() asm volatile("s_waitcnt lgkmcnt(0)" ::: "memory")
#define VM_WAIT() asm volatile("s_waitcnt vmcnt(0)" ::: "memory")
#define MFMA32(a, b, c) __builtin_amdgcn_mfma_f32_32x32x16_bf16((a), (b), (c), 0, 0, 0)
#define DI __device__ __forceinline__

DI unsigned pk2(float lo, float hi) { f32x2 v = {lo, hi}; bf16x2_t b = __builtin_convertvector(v, bf16x2_t); return __builtin_bit_cast(unsigned, b); }
DI bf16 f2bf(float x) { return (bf16)(pk2(x, 0.f) & 0xffffu); }
DI float bf2f(bf16 x) { return __uint_as_float((unsigned)x << 16); }
DI float bflo(unsigned p) { return __uint_as_float(p << 16); }
DI float bfhi(unsigned p) { return __uint_as_float(p & 0xffff0000u); }
DI int crow(int reg, int hh) { return (reg & 3) + 8 * (reg >> 2) + 4 * hh; }
DI float swap32_partner(float x, int hh) { auto rr = __builtin_amdgcn_permlane32_swap(__float_as_uint(x), __float_as_uint(x), false, false); return __uint_as_float(hh ? rr[0] : rr[1]); }
DI float dpp_xor1(float x) { return __int_as_float(__builtin_amdgcn_update_dpp(0, __float_as_int(x), 0xB1, 0xf, 0xf, true)); }
DI float dpp_xor2(float x) { return __int_as_float(__builtin_amdgcn_update_dpp(0, __float_as_int(x), 0x4E, 0xf, 0xf, true)); }
DI float dpp_hmir(float x) { return __int_as_float(__builtin_amdgcn_update_dpp(0, __float_as_int(x), 0x141, 0xf, 0xf, true)); }
DI float dpp_mir(float x)  { return __int_as_float(__builtin_amdgcn_update_dpp(0, __float_as_int(x), 0x140, 0xf, 0xf, true)); }
DI float sum16(float x) { x += dpp_xor1(x); x += dpp_xor2(x); x += dpp_hmir(x); x += dpp_mir(x); return x; }
DI float sum32(float x) { x = sum16(x); auto rr = __builtin_amdgcn_permlane16_swap(__float_as_uint(x), __float_as_uint(x), false, false); return __uint_as_float(rr[0]) + __uint_as_float(rr[1]); }
DI float max16(float x) { x = fmaxf(x, dpp_xor1(x)); x = fmaxf(x, dpp_xor2(x)); x = fmaxf(x, dpp_hmir(x)); x = fmaxf(x, dpp_mir(x)); return x; }
DI float max64(float x) { x = max16(x); { auto rr = __builtin_amdgcn_permlane16_swap(__float_as_uint(x), __float_as_uint(x), false, false); x = fmaxf(__uint_as_float(rr[0]), __uint_as_float(rr[1])); }
    { auto rr = __builtin_amdgcn_permlane32_swap(__float_as_uint(x), __float_as_uint(x), false, false); x = fmaxf(__uint_as_float(rr[0]), __uint_as_float(rr[1])); } return x; }
DI unsigned pack_i8x4(float a, float b, float c, float d) { const int ia = (int)__builtin_rintf(a), ib = (int)__builtin_rintf(b), ic = (int)__builtin_rintf(c), id = (int)__builtin_rintf(d);
    return (unsigned)(ia & 255) | ((unsigned)(ib & 255) << 8) | ((unsigned)(ic & 255) << 16) | ((unsigned)id << 24); }
DI float sum64(float x) { x = sum32(x); auto rr = __builtin_amdgcn_permlane32_swap(__float_as_uint(x), __float_as_uint(x), false, false); return __uint_as_float(rr[0]) + __uint_as_float(rr[1]); }
DI float rcp_(float x) { return __builtin_amdgcn_rcpf(x); }
DI float rsq_(float x) { return __builtin_amdgcn_rsqf(x); }
DI float exp2_(float x) { return __builtin_amdgcn_exp2f(x); }
DI float gelu_tanh(float x) { const float u = x * (1.5957691216057308f + 0.07135481627159768f * x * x); return x * rcp_(1.0f + exp2_(-LOG2E * u)); }
DI float sigmoidf_(float x) { return rcp_(1.0f + exp2_(-LOG2E * x)); }
#define XB_TMO      128
#define XB_XCNT(j)  (256  + 64 * (j))
#define XB_XSUB(j)  (1280 + 64 * (j))
#define XB_XGEN(j)  (2304 + 64 * (j))
#define XB_TOP      3328
#define XB_TOPGEN   3392
#define XCD_BAR_WORDS 3456
#define XB_SPIN_CAP (1u << 18)

__device__ __forceinline__ unsigned xb_ld(unsigned* p)              { return __hip_atomic_load(p, __ATOMIC_RELAXED, __HIP_MEMORY_SCOPE_AGENT); }
__device__ __forceinline__ unsigned xb_add(unsigned* p, unsigned v) { return __hip_atomic_fetch_add(p, v, __ATOMIC_RELAXED, __HIP_MEMORY_SCOPE_AGENT); }
__device__ __forceinline__ unsigned xb_xcc_id() { return (unsigned)__builtin_amdgcn_s_getreg((3 << 11) | 20) & 0xFu; }
#define XB_SPIN(cond, bar) do { unsigned _sp = 0; while (cond) { __builtin_amdgcn_s_sleep(1); \
    if ((++_sp & 255u) == 0u) { if (xb_ld(&(bar)[XB_TMO])) break; if (_sp > XB_SPIN_CAP) { atomicAdd(&(bar)[XB_TMO], 1u); break; } } } } while (0)

struct XcdBarrier {
    unsigned* bar; unsigned x;
    volatile LAS unsigned* st;
};

__device__ __forceinline__ XcdBarrier xcd_barrier_post(unsigned* bar, volatile LAS unsigned* st) {
    XcdBarrier b; b.bar = bar; b.x = xb_xcc_id(); b.st = st;
    if (threadIdx.x == 0) (void)xb_add(&bar[XB_XCNT(b.x)], 1u);
    return b;
}
__device__ __forceinline__ void xcd_barrier_complete(unsigned* bar, unsigned x, unsigned& nloc, unsigned& nx) {
    const unsigned G = gridDim.x * gridDim.y * gridDim.z;
    unsigned sum, cnt, mine, sp = 0u;
    for (;;) {
        sum = 0u; cnt = 0u; mine = 0u;
#pragma unroll
        for (unsigned j = 0; j < 16; ++j) { const unsigned c = xb_ld(&bar[XB_XCNT(j)]); sum += c; cnt += (c > 0u) ? 1u : 0u; mine = (j == x) ? c : mine; }
        if (sum == G) break;
        __builtin_amdgcn_s_sleep(1);
        if ((++sp & 255u) == 0u) { if (xb_ld(&bar[XB_TMO])) break; if (sp > XB_SPIN_CAP) { atomicAdd(&bar[XB_TMO], 1u); break; } }
    }
    nloc = mine > 0u ? mine : 1u; nx = cnt > 0u ? cnt : 1u;
}

__device__ __forceinline__ void xcd_barrier(const XcdBarrier& b) {
    asm volatile("s_waitcnt vmcnt(0)" ::: "memory");
    __syncthreads();
    if (threadIdx.x == 0) {
        unsigned* bar = b.bar;
        __builtin_amdgcn_s_waitcnt(0);
        unsigned nloc = b.st[0], nx = b.st[1];
        if (nloc == 0u) { xcd_barrier_complete(bar, b.x, nloc, nx); b.st[0] = nloc; b.st[1] = nx; }
        const unsigned old = xb_add(&bar[XB_XSUB(b.x)], 1u);
        const unsigned gen = old / nloc;
        if (old + 1u == (gen + 1u) * nloc) {
            __builtin_amdgcn_fence(__ATOMIC_RELEASE, "agent");
            asm volatile("s_waitcnt vmcnt(0)" ::: "memory");
            const unsigned og = xb_add(&bar[XB_TOP], 1u);
            const unsigned tg = og / nx;
            if (og + 1u == (tg + 1u) * nx) xb_add(&bar[XB_TOPGEN], 1u);
            else XB_SPIN(xb_ld(&bar[XB_TOPGEN]) == tg, bar);
            __builtin_amdgcn_fence(__ATOMIC_ACQUIRE, "agent");
            xb_add(&bar[XB_XGEN(b.x)], 1u);
            asm volatile("s_waitcnt vmcnt(0)" ::: "memory");
        } else {
            XB_SPIN(xb_ld(&bar[XB_XGEN(b.x)]) == gen, bar);
            __builtin_amdgcn_fence(__ATOMIC_ACQUIRE, "agent");
            asm volatile("s_waitcnt vmcnt(0)" ::: "memory");
        }
    }
    __syncthreads();
}
struct Args { const float* in[26]; float* out; unsigned char* ws; int ph_lo, ph_hi, li, pad; };
struct Frame {
    LAS unsigned char* lds;
    volatile LAS unsigned* MISC;
    gu32* ctl;
    int tid, lane, wave, vcu, G;
    const Args* A; float* out; unsigned char* ws;
    DI const float* in(int k) const { return A->in[k]; }
    template <class T> DI T* wsp(size_t off) const { return (T*)(ws + off); }
};

DI void p0_transpose_item(const float* W, int K, int N, bf16* WT, LAS float* scr, int item, int lane, const float* g0, const float* g1, int gsplit) {
    const int nblk = N / 32, kb = item / nblk, nb = item % nblk, k0 = 64 * kb, n0 = 32 * nb;
#pragma unroll 8
    for (int i = 0; i < 32; ++i) { const int kk = 2 * i + (lane >> 5); const int k = k0 + kk;
        float g = 1.f; if (g0) g = (k < gsplit) ? g0[k] : g1[k - gsplit];
        scr[kk * 33 + (lane & 31)] = W[(size_t)k * N + n0 + (lane & 31)] * g; }
    LDS_WAIT(); asm volatile("" ::: "memory");
    const int c = lane & 7;
#pragma unroll
    for (int j = 0; j < 4; ++j) { const int n = (lane >> 3) + 8 * j; const LAS float* s = scr + (8 * c) * 33 + n;
        v4u o; o.x = pk2(s[0 * 33], s[1 * 33]); o.y = pk2(s[2 * 33], s[3 * 33]); o.z = pk2(s[4 * 33], s[5 * 33]); o.w = pk2(s[6 * 33], s[7 * 33]);
        *(GAS v4u*)(WT + (size_t)(n0 + n) * K + k0 + 8 * c) = o; }
    LDS_WAIT(); asm volatile("" ::: "memory");
}
template <bool NORM> DI void row_to_bf16(const float* xrow, bf16* orow, const float* gain, int lane) {
    const GAS f32x4* xr = (const GAS f32x4*)xrow + lane;
    f32x4 v[4]; float s = 0.f;
#pragma unroll
    for (int j = 0; j < 4; ++j) { v[j] = xr[64 * j]; s += (v[j].x * v[j].x + v[j].y * v[j].y) + (v[j].z * v[j].z + v[j].w * v[j].w); }
    float rstd = 1.f;
    if (NORM) rstd = 1.0f / sqrtf(sum64(s) * (1.f / 1024.f) + EPS);
    GAS v2u* o8 = (GAS v2u*)orow + lane;
#pragma unroll
    for (int j = 0; j < 4; ++j) { f32x4 w = v[j] * rstd; if (gain) w = w * ((const GAS f32x4*)gain)[64 * j + lane];
        v2u o; o.x = pk2(w.x, w.y); o.y = pk2(w.z, w.w); o8[64 * j] = o; }
}
constexpr float U_SCALE = 128.f, V_SCALE = 16.f;
template <bool NORM, int NB> DI void rows_to_bf16(const float* xrow, bf16* orow, size_t row_stride, const float* gain, int lane) {
    f32x4 v[NB][4];
#pragma unroll
    for (int b = 0; b < NB; ++b)
#pragma unroll
        for (int j = 0; j < 4; ++j) v[b][j] = ((const GAS f32x4*)(xrow + b * row_stride))[64 * j + lane];
#pragma unroll
    for (int b = 0; b < NB; ++b) { float s = 0.f;
#pragma unroll
        for (int j = 0; j < 4; ++j) s += (v[b][j].x * v[b][j].x + v[b][j].y * v[b][j].y) + (v[b][j].z * v[b][j].z + v[b][j].w * v[b][j].w);
        float rstd = 1.f; if (NORM) rstd = rsq_(sum64(s) * (1.f / 1024.f) + EPS);
        GAS v2u* o8 = (GAS v2u*)(orow + b * row_stride) + lane;
#pragma unroll
        for (int j = 0; j < 4; ++j) { f32x4 w = v[b][j] * rstd; if (gain) w = w * ((const GAS f32x4*)gain)[64 * j + lane];
            v2u o; o.x = pk2(w.x, w.y); o.y = pk2(w.z, w.w); o8[64 * j] = o; } }
}
DI void row_to_fp8(const float* src, unsigned char* dst, const float* gain, float scale, int lane) {
#pragma unroll
    for (int j = 0; j < 4; ++j) { f32x4 v = ((const GAS f32x4*)src)[64 * j + lane] * scale; if (gain) v = v * ((const GAS f32x4*)gain)[64 * j + lane];
        unsigned w = 0u; w = __builtin_amdgcn_cvt_pk_fp8_f32(v.x, v.y, w, false); w = __builtin_amdgcn_cvt_pk_fp8_f32(v.z, v.w, w, true);
        ((GAS unsigned*)dst)[64 * j + lane] = w; }
}
DI void row_to_i8(const float* src, unsigned char* dst, const float* gain, float* scale_out, int lane) {
    f32x4 v[4]; float mx = 0.f;
#pragma unroll
    for (int j = 0; j < 4; ++j) { v[j] = ((const GAS f32x4*)src)[64 * j + lane] * ((const GAS f32x4*)gain)[64 * j + lane];
        mx = fmaxf(fmaxf(mx, fmaxf(fabsf(v[j].x), fabsf(v[j].y))), fmaxf(fabsf(v[j].z), fabsf(v[j].w))); }
    mx = fmaxf(max64(mx), 1e-30f);
    const float inv = 127.0f / mx;
#pragma unroll
    for (int j = 0; j < 4; ++j) ((GAS unsigned*)dst)[64 * j + lane] = pack_i8x4(v[j].x * inv, v[j].y * inv, v[j].z * inv, v[j].w * inv);
    if (lane == 0) *scale_out = mx * (1.0f / 127.0f);
}
DI void convert_experts(Frame& F, int wv, int nwv) {
    const int lane = F.lane;
    for (int m = wv * 2; m < NEXP; m += nwv * 2) {
        f32x4 u[2][4], v[2][4];
#pragma unroll
        for (int b = 0; b < 2; ++b)
#pragma unroll
            for (int j = 0; j < 4; ++j) { u[b][j] = ((const GAS f32x4*)(F.in(23) + (size_t)(m + b) * DM))[64 * j + lane]; v[b][j] = ((const GAS f32x4*)(F.in(24) + (size_t)(m + b) * DM))[64 * j + lane]; }
#pragma unroll
        for (int b = 0; b < 2; ++b) {
            float mx = 0.f;
#pragma unroll
            for (int j = 0; j < 4; ++j) { u[b][j] = u[b][j] * ((const GAS f32x4*)F.in(20))[64 * j + lane];
                mx = fmaxf(fmaxf(mx, fmaxf(fabsf(u[b][j].x), fabsf(u[b][j].y))), fmaxf(fabsf(u[b][j].z), fabsf(u[b][j].w))); }
            mx = fmaxf(max64(mx), 1e-30f);
            const float inv = 127.0f / mx;
#pragma unroll
            for (int j = 0; j < 4; ++j) { ((GAS unsigned*)(F.wsp<unsigned char>(WS_EU) + (size_t)(m + b) * DM))[64 * j + lane] = pack_i8x4(u[b][j].x * inv, u[b][j].y * inv, u[b][j].z * inv, u[b][j].w * inv);
                const f32x4 q = v[b][j] * V_SCALE; unsigned w = 0u; w = __builtin_amdgcn_cvt_pk_fp8_f32(q.x, q.y, w, false); w = __builtin_amdgcn_cvt_pk_fp8_f32(q.z, q.w, w, true);
                ((GAS unsigned*)(F.wsp<unsigned char>(WS_EV) + (size_t)(m + b) * DM))[64 * j + lane] = w; }
            if (lane == 0) F.wsp<float>(WS_SU)[m + b] = mx * (1.0f / 127.0f);
        }
    }
}
DI void p0_prologue(Frame& F) {
    LAS float* scr = (LAS float*)(F.lds + F.wave * 16384);
    const int gw = F.vcu * NWAVES + F.wave, NGW = F.G * NWAVES, lane = F.lane;
    constexpr int I_IN = 16 * (INW / 32), I_D = 16 * (DM / 32), I_2D = 16 * (2 * DM / 32);
    constexpr int NITEMS = I_IN + 3 * I_D + 2 * I_2D;
    for (int it = gw; it < NITEMS; it += NGW) {
        int r = it;
        if (r < I_IN) { p0_transpose_item(F.in(3), DM, INW, F.wsp<bf16>(WS_WIN), scr, r, lane, F.in(2), F.in(2), DM); continue; } r -= I_IN;
        if (r < I_D) { p0_transpose_item(F.in(14), DM, DM, F.wsp<bf16>(WS_WOUT), scr, r, lane, F.in(12), F.in(13), LRUW); continue; } r -= I_D;
        if (r < I_D) { p0_transpose_item(F.in(17), DM, DM, F.wsp<bf16>(WS_WQ), scr, r, lane, F.in(15), F.in(15), DM); continue; } r -= I_D;
        if (r < I_2D) { p0_transpose_item(F.in(18), DM, 2 * DM, F.wsp<bf16>(WS_WKV), scr, r, lane, nullptr, nullptr, 0); continue; } r -= I_2D;
        if (r < I_D) { p0_transpose_item(F.in(19), DM, DM, F.wsp<bf16>(WS_WO), scr, r, lane, nullptr, nullptr, 0); continue; } r -= I_D;
        p0_transpose_item(F.in(21), DM, 2 * DM, F.wsp<bf16>(WS_WQRY), scr, r, lane, F.in(20), F.in(20), DM);
    }
    for (int m = gw * 4; m < M; m += NGW * 4) rows_to_bf16<true, 4>(F.in(0) + (size_t)m * DM, F.wsp<bf16>(WS_XN) + (size_t)m * DM, DM, nullptr, lane);
    for (int m = gw; m < NBATCH * 256; m += NGW) row_to_bf16<true>(F.in(1) + (size_t)m * DM, F.wsp<bf16>(WS_MEMN) + (size_t)m * DM, F.in(16), lane);
    { const int gt = gw * 64 + lane, NT = NGW * 64;
      for (int i = gt; i < 8 * 2 * 128 * 128 / 4; i += NT) { const f32x4 v = ((const GAS f32x4*)F.in(22))[i]; v2u o; o.x = pk2(v.x, v.y); o.y = pk2(v.z, v.w); ((GAS v2u*)F.wsp<bf16>(WS_SUBK))[i] = o; }
      for (int o = gt; o < 2 * 8 * 64 * 64; o += NT) { const int i = o & 63, j = (o >> 6) & 63, h = (o >> 12) & 7, g = o >> 15;
          const float* W = g ? F.in(8) : F.in(6); F.wsp<bf16>(WS_GATEW)[o] = f2bf(W[(h * 64 + i) * 64 + j]); } }
}
struct LruState { float ba[2], bx[2], sp[2], S[2], Ap[2]; };
template <bool PASS2>
DI void lru_prep(const Frame& F, int b, int chunk, int h, int lane, LAS unsigned char* xcs  , LruState& st) {
    const int r = lane & 31, hh = lane >> 5;
    const size_t row0 = (size_t)b * SEQ + (size_t)chunk * 64;
    {
        const int c2 = h * 64 + 2 * r;
        const f32x2 w0 = *(const f32x2*)(F.in(4) + c2), w1 = *(const f32x2*)(F.in(4) + LRUW + c2), w2 = *(const f32x2*)(F.in(4) + 2 * LRUW + c2), w3 = *(const f32x2*)(F.in(4) + 3 * LRUW + c2);
        const f32x2 cb = *(const f32x2*)(F.in(5) + c2);
        const int tl0 = 32 * hh;
        const bf16* zp = F.wsp<bf16>(WS_Z) + (row0 + tl0) * ZW + c2;
        const bool first = (chunk == 0 && hh == 0);
        unsigned p0 = first ? 0u : *(const unsigned*)(zp - 3 * ZW), p1 = first ? 0u : *(const unsigned*)(zp - 2 * ZW), p2 = first ? 0u : *(const unsigned*)(zp - ZW);
#pragma unroll 8
        for (int t = 0; t < 32; ++t) { const unsigned p3 = *(const unsigned*)(zp + (size_t)t * ZW);
            const float lo = cb.x + bflo(p0) * w0.x + bflo(p1) * w1.x + bflo(p2) * w2.x + bflo(p3) * w3.x;
            const float hi = cb.y + bfhi(p0) * w0.y + bfhi(p1) * w1.y + bfhi(p2) * w2.y + bfhi(p3) * w3.y;
            *(LAS unsigned*)(xcs + (tl0 + t) * 144 + 4 * r) = pk2(lo, hi);
            p0 = p1; p1 = p2; p2 = p3; }
        LDS_WAIT();
    }
#pragma unroll
    for (int nt = 0; nt < 2; ++nt) { const int c = h * 64 + 32 * nt + r; st.ba[nt] = F.in(7)[c]; st.bx[nt] = F.in(9)[c];
        const float nl = -F.in(10)[c]; st.sp[nt] = fmaxf(nl, 0.f) + log1pf(__expf(-fabsf(nl))); st.S[nt] = 0.f; st.Ap[nt] = 1.f; }
    if (PASS2) {
        float s = 0.f; const float* ag = F.wsp<float>(WS_AGG) + ((size_t)b * NCHUNK * LRUW + h * 64 + lane) * 2;
#pragma unroll 8
        for (int c = 0; c < chunk; ++c) { const f32x2 ab = *(const f32x2*)(ag + (size_t)c * LRUW * 2); s = ab.x * s + ab.y; }
        st.S[0] = __shfl(s, r); st.S[1] = __shfl(s, 32 + r);
    }
}
template <bool PASS2>
DI void lru_tile(const Frame& F, int b, int chunk, int mt, int h, int lane, LAS unsigned char* xcs, LAS unsigned char* gim  , LruState& st, float (&ssq)[16]) {
    const int r = lane & 31, hh = lane >> 5;
    const size_t row0 = (size_t)b * SEQ + (size_t)chunk * 64;
    const bf16* gw = F.wsp<bf16>(WS_GATEW) + (size_t)h * 4096;
    bf16x8 af[4];
#pragma unroll
    for (int s = 0; s < 4; ++s) af[s] = *(const LAS bf16x8*)(xcs + (32 * mt + r) * 144 + (16 * s + 8 * hh) * 2);
    float ssl[16];
#pragma unroll
    for (int i = 0; i < 16; ++i) ssl[i] = 0.f;
    if (PASS2) {
#pragma unroll
        for (int i = 0; i < 4; ++i) { const int row = (lane >> 3) + 8 * i, c = lane & 7;
            *(LAS v4u*)(gim + row * 144 + c * 16) = *(const v4u*)(F.wsp<bf16>(WS_Z) + (row0 + 32 * mt + row) * ZW + LRUW + h * 64 + 8 * c); }
        LDS_WAIT();
    }
#pragma unroll
    for (int nt = 0; nt < 2; ++nt) {
        asm volatile("" ::: "memory");
        f32x16 aa = {}, ax = {};
#pragma unroll
        for (int s = 0; s < 4; ++s) {
            const bf16x8 wa = *(const bf16x8*)(gw + (size_t)(32 * nt + r) * 64 + 16 * s + 8 * hh);
            const bf16x8 wx = *(const bf16x8*)(gw + 32768 + (size_t)(32 * nt + r) * 64 + 16 * s + 8 * hh);
            aa = MFMA32(af[s], wa, aa); ax = MFMA32(af[s], wx, ax);
        }
#pragma unroll
        for (int i = 0; i < 16; ++i) {
            const float rg = sigmoidf_(aa[i] + st.ba[nt]), ig = sigmoidf_(ax[i] + st.bx[nt]);
            const float la = -8.0f * rg * st.sp[nt];
            const float a = exp2_(LOG2E * la);
            const float mult = __builtin_amdgcn_sqrtf(fmaxf(1.0f - a * a, 0.f));
            const float xc = bf2f(*(const LAS bf16*)(xcs + (32 * mt + crow(i, hh)) * 144 + (32 * nt + r) * 2));
            aa[i] = a; ax[i] = mult * ig * xc;
        }
        float Ao[4], Bo[4], Aq[4], Bq[4], Sin[4];
#pragma unroll
        for (int q = 0; q < 4; ++q) { const float a0 = aa[4 * q], a1 = aa[4 * q + 1], a2 = aa[4 * q + 2], a3 = aa[4 * q + 3];
            Ao[q] = (a0 * a1) * (a2 * a3); Bo[q] = ((ax[4 * q] * a1 + ax[4 * q + 1]) * a2 + ax[4 * q + 2]) * a3 + ax[4 * q + 3];
            Aq[q] = swap32_partner(Ao[q], hh); Bq[q] = swap32_partner(Bo[q], hh); }
        float s_ = st.S[nt];
#pragma unroll
        for (int q = 0; q < 4; ++q) { const float A1 = hh ? Aq[q] : Ao[q], B1 = hh ? Bq[q] : Bo[q], A2 = hh ? Ao[q] : Aq[q], B2 = hh ? Bo[q] : Bq[q];
            const float smid = A1 * s_ + B1; Sin[q] = hh ? smid : s_; s_ = A2 * smid + B2; st.Ap[nt] *= A1 * A2; }
        st.S[nt] = s_;
        if (PASS2) {
#pragma unroll
            for (int q = 0; q < 4; ++q) { float hp = Sin[q];
#pragma unroll
                for (int e = 0; e < 4; ++e) { const int i = 4 * q + e; hp = aa[i] * hp + ax[i];
                    const float gt = bf2f(*(const LAS bf16*)(gim + crow(i, hh) * 144 + (32 * nt + r) * 2));
                    const float y = hp * gelu_tanh(gt); ssl[i] += y * y;
                    *(LAS bf16*)(xcs + (32 * mt + crow(i, hh)) * 144 + (32 * nt + r) * 2) = f2bf(y); } }
        }
    }
    if (PASS2) {
#pragma unroll
        for (int i = 0; i < 16; ++i) ssq[i] = sum32(ssl[i]);
    }
}
constexpr int ATT_KST = 144, ATT_VST = 136, ATT_KBYTES = 64 * ATT_KST, ATT_VBYTES = 64 * ATT_VST;
DI void attn_wave(const Frame& F, int b, int n, int qt, int h, int lane, const LAS float* tab, LAS unsigned char* kl  , f32x16 (&o)[2]) {
    const int r = lane & 31, hh = lane >> 5;
    LAS unsigned char* vl = kl + ATT_KBYTES;
    const size_t row0 = (size_t)b * SEQ + (size_t)n * 64;
    const float SC = 0.125f * LOG2E;
    bf16x8 qf[4];
#pragma unroll
    for (int s = 0; s < 4; ++s) qf[s] = *(const bf16x8*)(F.wsp<bf16>(WS_Z) + (row0 + 32 * qt + r) * ZW + 2 * LRUW + h * 64 + 16 * s + 8 * hh);
    float mrun = -1e30f, lrun = 0.f;
#pragma unroll
    for (int dt = 0; dt < 2; ++dt) o[dt] = f32x16{};
    const float bfar = tab[256];
    const int srow = lane >> 3, sc8 = lane & 7;
    const int kc0 = (n >= 8 ? n - 8 : 0);
    const char* kg = (const char*)(F.wsp<bf16>(WS_Z) + (size_t)b * SEQ * ZW + 2 * LRUW + ATTW + h * 64);
    const char* vg = (const char*)(F.wsp<bf16>(WS_VT) + (size_t)(b * 8 + h) * 64 * SEQ);
    const unsigned kof = (unsigned)(srow * ZW + 8 * sc8) * 2u, vof = (unsigned)(srow * SEQ + 8 * sc8) * 2u;
    v4u kreg[8];
#pragma unroll
    for (int i = 0; i < 8; ++i) kreg[i] = *(const v4u*)(kg + ((size_t)kc0 * 64 + 8 * i) * ZW * 2 + kof);
    for (int kc = kc0; kc <= n; ++kc) {
        const int dd = n - kc;
        v4u vreg[8];
#pragma unroll
        for (int i = 0; i < 8; ++i) { *(LAS v4u*)(kl + (srow + 8 * i) * ATT_KST + sc8 * 16) = kreg[i]; vreg[i] = *(const v4u*)(vg + ((size_t)(8 * i) * SEQ + kc * 64) * 2 + vof); }
        f32x16 sc[2];
#pragma unroll
        for (int kt = 0; kt < 2; ++kt) { sc[kt] = f32x16{};
#pragma unroll
            for (int s = 0; s < 4; ++s) { const bf16x8 kf = *(const LAS bf16x8*)(kl + (32 * kt + r) * ATT_KST + (16 * s + 8 * hh) * 2); sc[kt] = MFMA32(kf, qf[s], sc[kt]); } }
        if (dd >= 3) {
#pragma unroll
            for (int kt = 0; kt < 2; ++kt)
#pragma unroll
                for (int i = 0; i < 16; ++i) sc[kt][i] = sc[kt][i] * SC + bfar;
        } else {
            const int base = 64 * dd + 32 * qt + r + 128;
#pragma unroll
            for (int kt = 0; kt < 2; ++kt)
#pragma unroll
                for (int i = 0; i < 16; ++i) { int idx = base - (32 * kt + crow(i, hh)); idx = idx > 256 ? 256 : idx; sc[kt][i] = sc[kt][i] * SC + tab[idx]; }
        }
        float mx = sc[0][0];
#pragma unroll
        for (int kt = 0; kt < 2; ++kt)
#pragma unroll
            for (int i = 0; i < 16; ++i) mx = fmaxf(mx, sc[kt][i]);
        mx = fmaxf(mx, swap32_partner(mx, hh));
        const float mnew = fmaxf(mrun, mx), alpha = exp2_(mrun - mnew);
        float ls = 0.f;
#pragma unroll
        for (int kt = 0; kt < 2; ++kt)
#pragma unroll
            for (int i = 0; i < 16; ++i) { const float p = exp2_(sc[kt][i] - mnew); sc[kt][i] = p; ls += p; }
        lrun = lrun * alpha + ls; mrun = mnew;
#pragma unroll
        for (int dt = 0; dt < 2; ++dt)
#pragma unroll
            for (int i = 0; i < 16; ++i) o[dt][i] *= alpha;
#pragma unroll
        for (int i = 0; i < 8; ++i) { LAS v2u* vd = (LAS v2u*)(vl + (srow + 8 * i) * ATT_VST + sc8 * 16); vd[0] = (v2u){vreg[i].x, vreg[i].y}; vd[1] = (v2u){vreg[i].z, vreg[i].w}; }
        if (kc < n) {
#pragma unroll
            for (int i = 0; i < 8; ++i) kreg[i] = *(const v4u*)(kg + ((size_t)(kc + 1) * 64 + 8 * i) * ZW * 2 + kof);
        }
#pragma unroll
        for (int kt = 0; kt < 2; ++kt)
#pragma unroll
            for (int s2 = 0; s2 < 2; ++s2) { v4u w; w.x = pk2(sc[kt][8 * s2], sc[kt][8 * s2 + 1]); w.y = pk2(sc[kt][8 * s2 + 2], sc[kt][8 * s2 + 3]); w.z = pk2(sc[kt][8 * s2 + 4], sc[kt][8 * s2 + 5]); w.w = pk2(sc[kt][8 * s2 + 6], sc[kt][8 * s2 + 7]);
                const bf16x8 pf = __builtin_bit_cast(bf16x8, w);
#pragma unroll
                for (int dt = 0; dt < 2; ++dt) { const LAS unsigned char* vp = vl + (32 * dt + r) * ATT_VST + (32 * kt + 16 * s2 + 4 * hh) * 2;
                    const v2u lo = *(const LAS v2u*)vp, hi = *(const LAS v2u*)(vp + 16); v4u vw; vw.x = lo.x; vw.y = lo.y; vw.z = hi.x; vw.w = hi.y;
                    o[dt] = MFMA32(__builtin_bit_cast(bf16x8, vw), pf, o[dt]); } }
    }
    const float lt = lrun + swap32_partner(lrun, hh); const float inv = rcp_(lt);
#pragma unroll
    for (int dt = 0; dt < 2; ++dt)
#pragma unroll
        for (int i = 0; i < 16; ++i) o[dt][i] *= inv;
}

DI void p2_lru_aggregates(Frame& F) {
    const int lane = F.lane, r = lane & 31, hh = lane >> 5, h = F.wave;
    LAS unsigned char* xcs = F.lds + 12288 + h * 17920;
    for (int u = F.vcu; u < NBATCH * NCHUNK; u += F.G) {
        const int b = u / NCHUNK, n = u % NCHUNK;
        LruState st; float ssq[16];
        lru_prep<false>(F, b, n, h, lane, xcs, st);
#pragma unroll 1
        for (int mt = 0; mt < 2; ++mt) lru_tile<false>(F, b, n, mt, h, lane, xcs, xcs + 9216, st, ssq);
        if (hh == 0) {
#pragma unroll
            for (int nt = 0; nt < 2; ++nt) *(f32x2*)(F.wsp<float>(WS_AGG) + (((size_t)b * NCHUNK + n) * LRUW + h * 64 + 32 * nt + r) * 2) = (f32x2){st.Ap[nt], st.S[nt]};
        }
        LDS_WAIT();
    }
}
DI void p3_mixer(Frame& F) {
    const int lane = F.lane, r = lane & 31, hh = lane >> 5, h = F.wave;
    LAS float* ssx = (LAS float*)(F.lds);
    LAS float* tab = (LAS float*)(F.lds + 2048 + h * 1280);
    LAS unsigned* stg = (LAS unsigned*)(F.lds + 12288 + h * 17920);
    for (int i = lane; i < 257; i += 64) tab[i] = F.in(11)[h * 257 + i] * LOG2E;
    LDS_WAIT();
    for (int u = F.vcu; u < NBATCH * NCHUNK; u += F.G) {
        const int b = u / NCHUNK, n = u % NCHUNK; const size_t row0 = (size_t)b * SEQ + (size_t)n * 64;
#ifndef MIX_PARTS
#define MIX_PARTS 3
#endif
        if (MIX_PARTS & 1) {
            LruState st;
            lru_prep<true>(F, b, n, h, lane, (LAS unsigned char*)stg, st);
#pragma unroll 1
            for (int mt = 0; mt < 2; ++mt) {
                float ssq[16];
                lru_tile<true>(F, b, n, mt, h, lane, (LAS unsigned char*)stg, (LAS unsigned char*)stg + 9216, st, ssq);
                if (r == 0) {
#pragma unroll
                    for (int i = 0; i < 16; ++i) ssx[crow(i, hh) * 8 + h] = ssq[i];
                }
                __syncthreads();
                const LAS unsigned char* yst = (const LAS unsigned char*)stg + 32 * mt * 144;
#pragma unroll
                for (int i = 0; i < 4; ++i) { const int row = (lane >> 3) + 8 * i, c = lane & 7;
                    const f32x4 s0 = *(const LAS f32x4*)(ssx + row * 8), s1 = *(const LAS f32x4*)(ssx + row * 8 + 4);
                    const float rs = rsq_(((s0.x + s0.y) + (s0.z + s0.w) + (s1.x + s1.y) + (s1.z + s1.w)) * (1.f / 512.f) + EPS);
                    const v4u v = *(const LAS v4u*)(yst + row * 144 + c * 16);
                    v4u o; o.x = pk2(bflo(v.x) * rs, bfhi(v.x) * rs); o.y = pk2(bflo(v.y) * rs, bfhi(v.y) * rs); o.z = pk2(bflo(v.z) * rs, bfhi(v.z) * rs); o.w = pk2(bflo(v.w) * rs, bfhi(v.w) * rs);
                    *(v4u*)(F.wsp<bf16>(WS_Y) + (row0 + 32 * mt + row) * DM + h * 64 + 8 * c) = o; }
                __syncthreads();
            }
        }
    }
    for (int u = F.vcu; u < NBATCH * NCHUNK; u += F.G) {
        const int b = u / NCHUNK, n = u % NCHUNK; const size_t row0 = (size_t)b * SEQ + (size_t)n * 64;
#pragma unroll 1
        for (int qt = 0; qt < ((MIX_PARTS & 2) ? 2 : 0); ++qt) {
            f32x16 o[2];
            attn_wave(F, b, n, qt, h, lane, tab, (LAS unsigned char*)stg, o);
            float s = 0.f;
#pragma unroll
            for (int dt = 0; dt < 2; ++dt)
#pragma unroll
                for (int i = 0; i < 16; ++i) s += o[dt][i] * o[dt][i];
            s += swap32_partner(s, hh);
            if (hh == 0) ssx[r * 8 + h] = s;
            __syncthreads();
            { const f32x4 s0 = *(const LAS f32x4*)(ssx + r * 8), s1 = *(const LAS f32x4*)(ssx + r * 8 + 4);
              const float rs = rsq_(((s0.x + s0.y) + (s0.z + s0.w) + (s1.x + s1.y) + (s1.z + s1.w)) * (1.f / 512.f) + EPS);
#pragma unroll
              for (int dt = 0; dt < 2; ++dt)
#pragma unroll
                  for (int i = 0; i < 16; i += 2) stg[r * 33 + ((32 * dt + crow(i, hh)) >> 1)] = pk2(o[dt][i] * rs, o[dt][i + 1] * rs); }
            LDS_WAIT();
#pragma unroll 4
            for (int i = 0; i < 16; ++i) { const int row = 2 * i + hh; const unsigned v = stg[row * 33 + r];
                *(GAS unsigned*)(F.wsp<bf16>(WS_Y) + (row0 + 32 * qt + row) * DM + LRUW + h * 64 + 2 * r) = v; }
            __syncthreads();
        }
    }
}
DI void p5_cross(Frame& F, const pg8::StaticOrder& S) {
    const int lane = F.lane, r = lane & 31, hh = lane >> 5, w = F.wave, tid = F.tid;
    constexpr int KST = 528, VST = 520;
    const float SC = 0.0625f * LOG2E;
    pg8::Unit un;
    for (int ui = 0; S.next(ui, un); ++ui) {
        const int b = un.pm >> 5, qb = un.pm & 31, hm = un.pn;
        const size_t qrow = (size_t)b * SEQ + (size_t)qb * 256 + 32 * w + r;
        { const bf16* src = F.wsp<bf16>(WS_KM) + (size_t)(b * 256) * DM + hm * 256;
#pragma unroll 4
          for (int i = 0; i < 16; ++i) { const int c = i * 512 + tid, row = c >> 5, ch = c & 31;
              *(LAS v4u*)(F.lds + row * KST + ch * 16) = *(const v4u*)(src + (size_t)row * DM + ch * 8); } }
        __syncthreads();
        f32x16 sc[8];
#pragma unroll
        for (int kt = 0; kt < 8; ++kt) sc[kt] = f32x16{};
#pragma unroll 2
        for (int s = 0; s < 16; ++s) {
            const bf16x8 qf = *(const bf16x8*)(F.wsp<bf16>(WS_QC) + qrow * DM + hm * 256 + 16 * s + 8 * hh);
#pragma unroll
            for (int kt = 0; kt < 8; ++kt) { const bf16x8 kf = *(const LAS bf16x8*)(F.lds + (32 * kt + r) * KST + (16 * s + 8 * hh) * 2); sc[kt] = MFMA32(kf, qf, sc[kt]); }
        }
        float mx = sc[0][0];
#pragma unroll
        for (int kt = 0; kt < 8; ++kt)
#pragma unroll
            for (int i = 0; i < 16; ++i) mx = fmaxf(mx, sc[kt][i]);
        mx = fmaxf(mx, swap32_partner(mx, hh));
        float ls = 0.f; const float mo = mx * SC;
        bf16x8 pf[8][2];
#pragma unroll
        for (int kt = 0; kt < 8; ++kt) {
#pragma unroll
            for (int i = 0; i < 16; ++i) { const float p = exp2_(sc[kt][i] * SC - mo); sc[kt][i] = p; ls += p; }
#pragma unroll
            for (int s2 = 0; s2 < 2; ++s2) { v4u wv; wv.x = pk2(sc[kt][8 * s2], sc[kt][8 * s2 + 1]); wv.y = pk2(sc[kt][8 * s2 + 2], sc[kt][8 * s2 + 3]); wv.z = pk2(sc[kt][8 * s2 + 4], sc[kt][8 * s2 + 5]); wv.w = pk2(sc[kt][8 * s2 + 6], sc[kt][8 * s2 + 7]);
                pf[kt][s2] = __builtin_bit_cast(bf16x8, wv); }
        }
        ls += swap32_partner(ls, hh);
        const float inv = 1.0f / ls;
        __syncthreads();
        { const bf16* src = F.wsp<bf16>(WS_VMT) + (size_t)((b * 4 + hm) * 256) * 256;
#pragma unroll 4
          for (int i = 0; i < 16; ++i) { const int c = i * 512 + tid, row = c >> 5, ch = c & 31; const v4u v = *(const v4u*)(src + (size_t)row * 256 + ch * 8);
              LAS v2u* d = (LAS v2u*)(F.lds + row * VST + ch * 16); d[0] = (v2u){v.x, v.y}; d[1] = (v2u){v.z, v.w}; } }
        __syncthreads();
        LAS unsigned* stg = (LAS unsigned*)(F.lds) ;
#pragma unroll
        for (int half = 0; half < 2; ++half) {
            f32x16 o[4];
#pragma unroll
            for (int dt = 0; dt < 4; ++dt) o[dt] = f32x16{};
#pragma unroll
            for (int kt = 0; kt < 8; ++kt)
#pragma unroll
                for (int s2 = 0; s2 < 2; ++s2)
#pragma unroll
                    for (int dt = 0; dt < 4; ++dt) { const LAS unsigned char* p = F.lds + (128 * half + 32 * dt + r) * VST + (32 * kt + 16 * s2 + 4 * hh) * 2;
                        const v2u lo = *(const LAS v2u*)p, hi = *(const LAS v2u*)(p + 16); v4u wv; wv.x = lo.x; wv.y = lo.y; wv.z = hi.x; wv.w = hi.y;
                        o[dt] = MFMA32(__builtin_bit_cast(bf16x8, wv), pf[kt][s2], o[dt]); }
            if (half == 1) __syncthreads();
            else {   }
            if (half == 0) {
#pragma unroll
                for (int dt = 0; dt < 4; ++dt)
#pragma unroll
                    for (int i = 0; i < 16; i += 2) { const unsigned pv = pk2(o[dt][i] * inv, o[dt][i + 1] * inv); sc[dt][i >> 1] = __uint_as_float(pv); }
            } else {
                LAS unsigned* sw = (LAS unsigned*)(F.lds + w * 16512);
#pragma unroll
                for (int dt = 0; dt < 4; ++dt)
#pragma unroll
                    for (int i = 0; i < 16; i += 2) { sw[r * 129 + ((32 * dt + crow(i, hh)) >> 1)] = __float_as_uint(sc[dt][i >> 1]);
                        sw[r * 129 + 64 + ((32 * dt + crow(i, hh)) >> 1)] = pk2(o[dt][i] * inv, o[dt][i + 1] * inv); }
                LDS_WAIT();
#pragma unroll 4
                for (int i = 0; i < 32; ++i) { const unsigned v0 = sw[i * 129 + lane], v1 = sw[i * 129 + 64 + lane];
                    GAS unsigned* dst = (GAS unsigned*)(F.wsp<bf16>(WS_OC) + ((size_t)b * SEQ + (size_t)qb * 256 + 32 * w + i) * DM + hm * 256);
                    dst[lane] = v0; dst[64 + lane] = v1; }
            }
        }
        (void)stg;
        __syncthreads();
    }
}
template <int N> DI void ce_desc(float (&a)[N], int i, int l) { const float hi = fmaxf(a[i], a[l]), lo = fminf(a[i], a[l]); a[i] = hi; a[l] = lo; }
template <int N, int OFF> DI void bitonic_sort16_desc(float (&a)[N]) {
#pragma unroll
    for (int k = 2; k <= 16; k <<= 1)
#pragma unroll
        for (int j = k >> 1; j > 0; j >>= 1)
#pragma unroll
            for (int i = 0; i < 16; ++i) { const int l = i ^ j; if (l > i) { const bool desc = ((i & k) == 0) || (k == 16);
                if (desc) ce_desc<N>(a, OFF + i, OFF + l); else ce_desc<N>(a, OFF + l, OFF + i); } }
}
template <int N, int OFF> DI void bitonic_merge16_desc(float (&a)[N]) {
#pragma unroll
    for (int j = 8; j > 0; j >>= 1)
#pragma unroll
        for (int i = 0; i < 16; ++i) { const int l = i ^ j; if (l > i) ce_desc<N>(a, OFF + i, OFF + l); }
}
template <bool SORTED> DI void top16_of_64(float (&a)[64]) {
    bitonic_sort16_desc<64, 0>(a); bitonic_sort16_desc<64, 16>(a); bitonic_sort16_desc<64, 32>(a); bitonic_sort16_desc<64, 48>(a);
#pragma unroll
    for (int i = 0; i < 16; ++i) { a[i] = fmaxf(a[i], a[31 - i]); a[32 + i] = fmaxf(a[32 + i], a[63 - i]); }
    bitonic_merge16_desc<64, 0>(a); bitonic_merge16_desc<64, 32>(a);
#pragma unroll
    for (int i = 0; i < 16; ++i) a[i] = fmaxf(a[i], a[47 - i]);
    if (SORTED) bitonic_merge16_desc<64, 0>(a);
}
DI void p8a_topk(Frame& F, const pg8::StaticOrder& S) {
    const int lane = F.lane, r = lane & 31, hh = lane >> 5, w = F.wave;
    LAS float* tbl = (LAS float*)(F.lds + w * 8192);
    pg8::Unit un;
    for (int ui = 0; S.next(ui, un); ++ui) {
        const int h = un.pn; const size_t tok = (size_t)un.pm * 256 + 32 * w + r;
        float v[2][16];
#pragma unroll
        for (int p = 0; p < 2; ++p) {
            f32x16 sc[4];
#pragma unroll
            for (int nt = 0; nt < 4; ++nt) sc[nt] = f32x16{};
            const bf16* sk = F.wsp<bf16>(WS_SUBK) + (size_t)((h * 2 + p) * 128) * 128;
#pragma unroll 2
            for (int s = 0; s < 8; ++s) { const bf16x8 qf = *(const bf16x8*)(F.wsp<bf16>(WS_QP) + tok * 2048 + h * 256 + p * 128 + 16 * s + 8 * hh);
#pragma unroll
                for (int nt = 0; nt < 4; ++nt) { const bf16x8 kf = *(const bf16x8*)(sk + (size_t)(32 * nt + r) * 128 + 16 * s + 8 * hh); sc[nt] = MFMA32(kf, qf, sc[nt]); } }
            float a[64];
#pragma unroll
            for (int nt = 0; nt < 4; ++nt)
#pragma unroll
                for (int i = 0; i < 16; ++i) a[nt * 16 + i] = __uint_as_float((__float_as_uint(sc[nt][i]) & ~127u) | (unsigned)(32 * nt + crow(i, hh)));
            top16_of_64<true>(a);
            float m[16];
#pragma unroll
            for (int i = 0; i < 16; ++i) m[i] = fmaxf(a[i], swap32_partner(a[15 - i], hh));
            bitonic_merge16_desc<16, 0>(m);
#pragma unroll
            for (int i = 0; i < 16; ++i) v[p][i] = m[i];
        }
        float c[64]; int n = 0;
#pragma unroll
        for (int i = 0; i < 16; ++i)
#pragma unroll
            for (int j = 0; j < 16; ++j) if ((i + 1) * (j + 1) <= 16) { c[n] = __uint_as_float((__float_as_uint(v[0][i] + v[1][j]) & ~255u) | (unsigned)((i << 4) | j)); ++n; }
#pragma unroll
        for (int k = 50; k < 64; ++k) c[k] = -3.0e38f;
        top16_of_64<false>(c);
#pragma unroll
        for (int i = 0; i < 16; ++i) { tbl[i * 64 + lane] = v[0][i]; tbl[(16 + i) * 64 + lane] = v[1][i]; }
        LDS_WAIT();
        float sv[16]; int ev[16]; float mx = -3.0e38f;
#pragma unroll
        for (int k = 0; k < 16; ++k) { const unsigned pl = __float_as_uint(c[k]) & 255u; const float a1 = tbl[(pl >> 4) * 64 + lane], a2 = tbl[(16 + (pl & 15)) * 64 + lane];
            sv[k] = a1 + a2; ev[k] = (int)(((__float_as_uint(a1) & 127u) << 7) | (__float_as_uint(a2) & 127u)); mx = fmaxf(mx, sv[k]); }
        float sum = 0.f;
#pragma unroll
        for (int k = 0; k < 16; ++k) { sv[k] = __expf(sv[k] - mx); sum += sv[k]; }
        const float inv = 1.0f / sum;
        if (hh == 0) {
#pragma unroll
            for (int k = 0; k < 16; k += 4) *(v4u*)(F.wsp<int>(WS_IDX) + tok * NSEL + h * 16 + k) = (v4u){(unsigned)ev[k], (unsigned)ev[k + 1], (unsigned)ev[k + 2], (unsigned)ev[k + 3]};
        } else {
#pragma unroll
            for (int k = 0; k < 16; k += 4) *(f32x4*)(F.wsp<float>(WS_G) + tok * NSEL + h * 16 + k) = (f32x4){sv[k] * inv, sv[k + 1] * inv, sv[k + 2] * inv, sv[k + 3] * inv};
        }
        LDS_WAIT();
    }
}
typedef _Float16 f16x2_t __attribute__((ext_vector_type(2)));
constexpr float V_UNSCALE = 1.f / 16.f;
DI int dot16_i8(const v4u& u, const unsigned (&x)[4]) {
    const unsigned u0 = u.x, u1 = u.y, u2 = u.z, u3 = u.w;
    int a = 0;
    a = __builtin_amdgcn_sdot4((int)u0, (int)x[0], a, false); a = __builtin_amdgcn_sdot4((int)u1, (int)x[1], a, false);
    a = __builtin_amdgcn_sdot4((int)u2, (int)x[2], a, false); a = __builtin_amdgcn_sdot4((int)u3, (int)x[3], a, false);
    return a;
}
DI f16x2_t cvt_f16x2_fp8(unsigned v, float scale, bool hi) { return hi ? __builtin_bit_cast(f16x2_t, __builtin_amdgcn_cvt_scalef32_pk_f16_fp8(v, scale, true)) : __builtin_bit_cast(f16x2_t, __builtin_amdgcn_cvt_scalef32_pk_f16_fp8(v, scale, false)); }
DI void axpy16_v8(f16x2_t (&o)[8], float w, const v4u& v) {
    const unsigned v0 = v.x, v1 = v.y, v2 = v.z, v3 = v.w;
    const f16x2_t w2 = {(_Float16)w, (_Float16)w};
    o[0] = __builtin_elementwise_fma(cvt_f16x2_fp8(v0, V_UNSCALE, false), w2, o[0]); o[1] = __builtin_elementwise_fma(cvt_f16x2_fp8(v0, V_UNSCALE, true), w2, o[1]);
    o[2] = __builtin_elementwise_fma(cvt_f16x2_fp8(v1, V_UNSCALE, false), w2, o[2]); o[3] = __builtin_elementwise_fma(cvt_f16x2_fp8(v1, V_UNSCALE, true), w2, o[3]);
    o[4] = __builtin_elementwise_fma(cvt_f16x2_fp8(v2, V_UNSCALE, false), w2, o[4]); o[5] = __builtin_elementwise_fma(cvt_f16x2_fp8(v2, V_UNSCALE, true), w2, o[5]);
    o[6] = __builtin_elementwise_fma(cvt_f16x2_fp8(v3, V_UNSCALE, false), w2, o[6]); o[7] = __builtin_elementwise_fma(cvt_f16x2_fp8(v3, V_UNSCALE, true), w2, o[7]);
}
constexpr int TPW = 4, NSLICE = 16, SLICE_SHIFT = 10, NPAIR = TPW * NSEL, NPAIR_PAD = NPAIR + 3 * TPW * NSLICE + 32;
constexpr int PEER_LDS_PER_WAVE = TPW * 1024 + 64 + TPW * 2048 + NPAIR_PAD * 4;
static_assert(PEER_LDS_PER_WAVE * NWAVES <= RING_BYTES, "PEER LDS");
DI int incl_scan64(int v, int lane) {
    int s = v;
#pragma unroll
    for (int d = 1; d < 64; d <<= 1) { const int t = __shfl_up(s, d); if (lane >= d) s += t; }
    return s;
}
struct PeerBatch { v4u uu[4], vv[4]; unsigned ent[4]; float su[4]; };
DI void peer_load_batch(PeerBatch& B, const LAS unsigned* ml, int i, const unsigned char* EU8, const unsigned char* EV8, const float* SU, int lane, unsigned emask = 0x3fffu) {
    const v4u e4 = *(const LAS v4u*)(ml + i);
    B.ent[0] = (unsigned)__builtin_amdgcn_readfirstlane((int)e4.x); B.ent[1] = (unsigned)__builtin_amdgcn_readfirstlane((int)e4.y);
    B.ent[2] = (unsigned)__builtin_amdgcn_readfirstlane((int)e4.z); B.ent[3] = (unsigned)__builtin_amdgcn_readfirstlane((int)e4.w);
#pragma unroll
    for (int k = 0; k < 4; ++k) { const unsigned e = B.ent[k] & emask; const unsigned char* ur = EU8 + (size_t)e * DM; const unsigned char* vr = EV8 + (size_t)e * DM;
        B.uu[k] = *(const v4u*)(ur + (unsigned)(16 * lane)); B.vv[k] = *(const v4u*)(vr + (unsigned)(16 * lane)); B.su[k] = SU[e]; }
}
struct PeerState { unsigned x[4]; float sx; f16x2_t oc[8]; int curj; };
DI void peer_flush(PeerState& S, LAS unsigned char* ol, int lane) {
    LAS v4u* r = (LAS v4u*)(ol + S.curj * 2048) + lane;
#pragma unroll
    for (int c = 0; c < 2; ++c) { const v4u v = r[64 * c]; v4u o;
        o.x = __builtin_bit_cast(unsigned, __builtin_bit_cast(f16x2_t, (unsigned)v.x) + S.oc[4 * c]); o.y = __builtin_bit_cast(unsigned, __builtin_bit_cast(f16x2_t, (unsigned)v.y) + S.oc[4 * c + 1]);
        o.z = __builtin_bit_cast(unsigned, __builtin_bit_cast(f16x2_t, (unsigned)v.z) + S.oc[4 * c + 2]); o.w = __builtin_bit_cast(unsigned, __builtin_bit_cast(f16x2_t, (unsigned)v.w) + S.oc[4 * c + 3]);
        r[64 * c] = o; }
#pragma unroll
    for (int i = 0; i < 8; ++i) S.oc[i] = (f16x2_t){(_Float16)0.f, (_Float16)0.f};
}
DI void peer_compute_batch(const PeerBatch& B, PeerState& S, LAS unsigned char* ol, const LAS unsigned char* xl, int lane) {
    const int j = (int)((B.ent[0] >> 14) & 3u);
    if (j != S.curj) {
        if (S.curj >= 0) peer_flush(S, ol, lane);
        S.curj = j;
        const v4u y0 = ((const LAS v4u*)(xl + j * 1024))[lane];
        S.x[0] = y0.x; S.x[1] = y0.y; S.x[2] = y0.z; S.x[3] = y0.w; S.sx = ((const LAS float*)(xl + TPW * 1024))[j]; }
    const float d0 = (float)dot16_i8(B.uu[0], S.x) * B.su[0], d1 = (float)dot16_i8(B.uu[1], S.x) * B.su[1], d2 = (float)dot16_i8(B.uu[2], S.x) * B.su[2], d3 = (float)dot16_i8(B.uu[3], S.x) * B.su[3];
    const bool b0 = lane & 1, b1 = lane & 2;
    const float r0 = (b0 ? d1 : d0) + dpp_xor1(b0 ? d0 : d1), r1 = (b0 ? d3 : d2) + dpp_xor1(b0 ? d2 : d3);
    float t = (b1 ? r1 : r0) + dpp_xor2(b1 ? r0 : r1);
    t += __int_as_float(__builtin_amdgcn_update_dpp(0, __float_as_int(t), 0x124, 0xf, 0xf, true));
    t += __int_as_float(__builtin_amdgcn_update_dpp(0, __float_as_int(t), 0x128, 0xf, 0xf, true));
    { auto rr = __builtin_amdgcn_permlane16_swap(__float_as_uint(t), __float_as_uint(t), false, false); t = __uint_as_float(rr[0]) + __uint_as_float(rr[1]); }
    { auto rr = __builtin_amdgcn_permlane32_swap(__float_as_uint(t), __float_as_uint(t), false, false); t = __uint_as_float(rr[0]) + __uint_as_float(rr[1]); }
    const float act = gelu_tanh(t * S.sx);
#pragma unroll
    for (int k = 0; k < 4; ++k) { const float a = __builtin_bit_cast(float, __builtin_amdgcn_readlane(__builtin_bit_cast(int, act), k));
        axpy16_v8(S.oc, __uint_as_float(B.ent[k] & 0xffff0000u) * a, B.vv[k]); }
}
DI void p8b_peer(Frame& F, float* outp, unsigned emask = 0x3fffu, float oscale = 1.0f) {
    const int lane = F.lane, w = F.wave;
    const int gw = F.vcu * NWAVES + w, NGW = F.G * NWAVES;
    const unsigned char* EU8 = F.wsp<unsigned char>(WS_EU); const unsigned char* EV8 = F.wsp<unsigned char>(WS_EV); const float* SU = F.wsp<float>(WS_SU);
    LAS unsigned char* xl = F.lds + w * PEER_LDS_PER_WAVE;
    LAS unsigned char* ol = xl + TPW * 1024 + 64;
    LAS unsigned* ml = (LAS unsigned*)(ol + TPW * 2048);
    for (int t0 = gw * TPW; t0 < M; t0 += NGW * TPW) {
        unsigned enta[TPW], entb[TPW]; int posa[TPW], posb[TPW], sla[TPW], slb[TPW], offs[TPW];
#pragma unroll
        for (int j = 0; j < TPW; ++j) { const size_t tok = (size_t)t0 + j;
            float rstd; { const f32x4* sp = (const f32x4*)(F.wsp<float>(WS_SSQ2) + tok * 16); const f32x4 st = (sp[0] + sp[1]) + (sp[2] + sp[3]); rstd = rsq_(((st.x + st.y) + (st.z + st.w)) * (1.f / 1024.f) + EPS); }
            { const bf16* xs = F.wsp<bf16>(WS_XN) + tok * DM + 16 * lane;
              const v4u x0 = *(const v4u*)xs, x1 = *(const v4u*)(xs + 8);
              float xf[16] = {bflo(x0.x), bfhi(x0.x), bflo(x0.y), bfhi(x0.y), bflo(x0.z), bfhi(x0.z), bflo(x0.w), bfhi(x0.w), bflo(x1.x), bfhi(x1.x), bflo(x1.y), bfhi(x1.y), bflo(x1.z), bfhi(x1.z), bflo(x1.w), bfhi(x1.w)};
              float mx = 0.f;
#pragma unroll
              for (int i = 0; i < 16; ++i) mx = fmaxf(mx, fabsf(xf[i]));
              mx = fmaxf(max64(mx), 1e-30f); const float inv = 127.0f / mx;
              v4u y; y.x = pack_i8x4(xf[0] * inv, xf[1] * inv, xf[2] * inv, xf[3] * inv); y.y = pack_i8x4(xf[4] * inv, xf[5] * inv, xf[6] * inv, xf[7] * inv);
              y.z = pack_i8x4(xf[8] * inv, xf[9] * inv, xf[10] * inv, xf[11] * inv); y.w = pack_i8x4(xf[12] * inv, xf[13] * inv, xf[14] * inv, xf[15] * inv);
              ((LAS v4u*)(xl + j * 1024))[lane] = y; if (lane == 0) ((LAS float*)(xl + TPW * 1024))[j] = mx * rstd * (1.0f / 127.0f);
              ((LAS v4u*)(ol + j * 2048))[lane] = (v4u){0u, 0u, 0u, 0u}; ((LAS v4u*)(ol + j * 2048))[64 + lane] = (v4u){0u, 0u, 0u, 0u}; }
            const int ea = F.wsp<int>(WS_IDX)[tok * NSEL + lane], eb = F.wsp<int>(WS_IDX)[tok * NSEL + 64 + lane];
            const float ga = F.wsp<float>(WS_G)[tok * NSEL + lane], gb = F.wsp<float>(WS_G)[tok * NSEL + 64 + lane];
            const int sa = ea >> SLICE_SHIFT, sb = eb >> SLICE_SHIFT;
            int pa = 0, pb = 0, myoff = 0;
#pragma unroll
            for (int bk = 0; bk < NSLICE; ++bk) { const unsigned long long ma = __ballot(sa == bk), mb = __ballot(sb == bk);
                const int ca = __popcll(ma), cb = __popcll(mb);
                const int ra = __builtin_amdgcn_mbcnt_hi((unsigned)(ma >> 32), __builtin_amdgcn_mbcnt_lo((unsigned)ma, 0)), rb = __builtin_amdgcn_mbcnt_hi((unsigned)(mb >> 32), __builtin_amdgcn_mbcnt_lo((unsigned)mb, 0));
                pa = (sa == bk) ? ra : pa; pb = (sb == bk) ? ca + rb : pb;
                myoff = (lane == bk) ? ca + cb : myoff; }
            enta[j] = (unsigned)ea | ((unsigned)j << 14) | (pk2(0.f, ga) & 0xffff0000u); entb[j] = (unsigned)eb | ((unsigned)j << 14) | (pk2(0.f, gb) & 0xffff0000u);
            posa[j] = pa; posb[j] = pb; sla[j] = sa; slb[j] = sb; offs[j] = myoff;
        }
        int cnt = 0;
#pragma unroll
        for (int j = 0; j < TPW; ++j) { const int c = __shfl(offs[j], lane >> 2); cnt = ((lane & 3) == j) ? c : cnt; }
        const int cpad = (cnt + 3) & ~3;
        const int bend = incl_scan64(cpad, lane), bstart = bend - cpad;
        const int npad = __builtin_amdgcn_readlane(bend, 63);
#pragma unroll
        for (int j = 0; j < TPW; ++j) { const int ba = __shfl(bstart, 4 * sla[j] + j), bb = __shfl(bstart, 4 * slb[j] + j);
            ml[ba + posa[j]] = enta[j]; ml[bb + posb[j]] = entb[j]; }
        { const unsigned pad = (unsigned)((lane >> 2) << SLICE_SHIFT) | ((unsigned)(lane & 3) << 14);
#pragma unroll
          for (int q = 0; q < 3; ++q) if (cnt + q < cpad) ml[bstart + cnt + q] = pad; }
        if (lane < 28) ml[npad + lane] = (unsigned)((NSLICE - 1) << SLICE_SHIFT) | (3u << 14);
        LDS_WAIT();
        PeerState S;
#pragma unroll
        for (int i = 0; i < 8; ++i) { S.x[i] = 0u; S.oc[i] = (f16x2_t){(_Float16)0.f, (_Float16)0.f}; }
        S.curj = -1;
        PeerBatch A, B, C, D;
        peer_load_batch(A, ml, 0, EU8, EV8, SU, lane, emask); peer_load_batch(B, ml, 4, EU8, EV8, SU, lane, emask); peer_load_batch(C, ml, 8, EU8, EV8, SU, lane, emask);
#pragma unroll 1
        for (int i = 0; i < npad; i += 16) {
            peer_load_batch(D, ml, i + 12, EU8, EV8, SU, lane, emask); peer_compute_batch(A, S, ol, xl, lane);
            peer_load_batch(A, ml, i + 16, EU8, EV8, SU, lane, emask); peer_compute_batch(B, S, ol, xl, lane);
            peer_load_batch(B, ml, i + 20, EU8, EV8, SU, lane, emask); peer_compute_batch(C, S, ol, xl, lane);
            peer_load_batch(C, ml, i + 24, EU8, EV8, SU, lane, emask); peer_compute_batch(D, S, ol, xl, lane);
        }
        peer_flush(S, ol, lane);
        LDS_WAIT();
#pragma unroll
        for (int j = 0; j < TPW; ++j) {
            float* orow = outp + ((size_t)t0 + j) * DM + 16 * lane;
            const v4u xb0 = *(const v4u*)(F.wsp<bf16>(WS_XN) + ((size_t)t0 + j) * DM + 16 * lane), xb1 = *(const v4u*)(F.wsp<bf16>(WS_XN) + ((size_t)t0 + j) * DM + 16 * lane + 8);
            const unsigned xw[8] = {xb0.x, xb0.y, xb0.z, xb0.w, xb1.x, xb1.y, xb1.z, xb1.w};
            f32x4 a[4]; float ss = 0.f;
            const v4u h0 = ((const LAS v4u*)(ol + j * 2048))[lane], h1 = ((const LAS v4u*)(ol + j * 2048))[64 + lane];
            const unsigned hw[8] = {h0.x, h0.y, h0.z, h0.w, h1.x, h1.y, h1.z, h1.w};
#pragma unroll
            for (int q = 0; q < 4; ++q) { const f16x2_t p0 = __builtin_bit_cast(f16x2_t, hw[2 * q]), p1 = __builtin_bit_cast(f16x2_t, hw[2 * q + 1]);
                a[q] = (f32x4){bflo(xw[2 * q]), bfhi(xw[2 * q]), bflo(xw[2 * q + 1]), bfhi(xw[2 * q + 1])} + (f32x4){(float)p0.x, (float)p0.y, (float)p1.x, (float)p1.y};
                ss += (a[q].x * a[q].x + a[q].y * a[q].y) + (a[q].z * a[q].z + a[q].w * a[q].w); }
            const float rf = rsq_(sum64(ss) * (1.f / 1024.f) + EPS) * oscale;
#pragma unroll
            for (int q = 0; q < 4; ++q) *(f32x4*)(orow + 4 * q) = a[q] * rf * *(const f32x4*)(F.in(25) + 16 * lane + 4 * q);
        }
        LDS_WAIT();
    }
}
constexpr int N_PHASES = 11;
__global__ void __launch_bounds__(NWAVES * 64, 2) fwd_kernel(Args args) {
    extern __shared__ __attribute__((aligned(16))) unsigned char lds[];
    Frame F;
    F.lds = (LAS unsigned char*)lds;
    F.MISC = (volatile LAS unsigned*)(F.lds + MISC_OFF);
    F.tid = threadIdx.x; F.lane = F.tid & 63; F.wave = __builtin_amdgcn_readfirstlane(F.tid >> 6);
    F.G = gridDim.x; { const int bx = blockIdx.x; F.vcu = (F.G % 8 == 0) ? (bx % 8) * (F.G / 8) + bx / 8 : bx; }
    F.A = &args; F.ws = args.ws; F.out = args.out;
    F.ctl = (gu32*)(args.ws + WS_CTL);
    for (int u = F.tid; u < (LDS_BYTES - LDSCTL_OFF) / 4; u += NWAVES * 64) ((LAS unsigned*)(F.lds + LDSCTL_OFF))[u] = 0u;
    __syncthreads();
    const bool multi = (args.ph_hi - args.ph_lo) > 1;
    XcdBarrier bar; bar.bar = (unsigned*)(F.ctl + CW_BAR) + args.li * XCD_BAR_WORDS; bar.x = 0; bar.st = nullptr;
    if (multi) bar = xcd_barrier_post((unsigned*)(F.ctl + CW_BAR) + args.li * XCD_BAR_WORDS, F.MISC + 8);
    const int lo = args.ph_lo, hi = args.ph_hi;
#ifndef PROBE_EMASK
#define PROBE_EMASK 0x3fffu
#endif
#ifndef PHASE_REPEAT
#define PHASE_REPEAT 0
#endif
#define REP(k) for (int rep_ = 0; rep_ < (((PHASE_REPEAT >> (k)) & 1) ? 2 : 1); ++rep_)
#ifndef PHASE_MASK
#define PHASE_MASK 0x7ff
#endif
#define IN(k) (((PHASE_MASK >> (k)) & 1) && lo <= (k) && (k) < hi)
#define SEAM(k) do { asm volatile("; ===SEAM " #k ::: "memory"); if (IN(k) && IN((k) + 1)) xcd_barrier(bar); STAMP((k) + 1); } while (0)
    const int c = (int)blockIdx.x;
#define LOCAL_SEAM() do { VM_WAIT(); __syncthreads(); if (F.tid == 0) { __builtin_amdgcn_fence(__ATOMIC_ACQUIRE, "agent"); VM_WAIT(); } __syncthreads(); } while (0)
#ifdef PROBE_PHASE
#define STAMP(i) do { if (blockIdx.x == 0 && F.tid == 0) __hip_atomic_store(F.ctl + 512 + (i), (unsigned)__builtin_amdgcn_s_memrealtime(), RLX_AGENT); } while (0)
#else
#define STAMP(i) do { } while (0)
#endif
    STAMP(0);

    if (IN(0)) REP(0) { p0_prologue(F); } SEAM(0);
    if (IN(1)) REP(1) {
        { pg8::Gemm g{F.wsp<bf16>(WS_XN), F.wsp<bf16>(WS_WIN), M, INW, DM}; pg8::StaticOrder S; S.init(M, INW, F.G, c);
          pg8::EpiSplitT E{F.wsp<bf16>(WS_Z), ZW, ZW, F.wsp<bf16>(WS_VT), ATTW, SEQ};
          pg8::gemm_phase<pg8::EpiSplitT, pg8::StaticOrder, true, true>(F.lds, g, S, E); }
        { const int nw3 = (M / 256) * (INW / 256) - 2 * F.G;
          int idx = -1; if (nw3 >= 0 && nw3 + 16 <= F.G) idx = c - nw3; else idx = (c < 16 && F.G >= 16) ? c : -1;
          if (F.G < 16) idx = -1;
          pg8::Gemm g{F.wsp<bf16>(WS_MEMN), F.wsp<bf16>(WS_WKV), NBATCH * 256, 2 * DM, DM};
          if (F.G >= 16) { pg8::OneUnit S{idx, 2, 8}; pg8::EpiSplitT E{F.wsp<bf16>(WS_KM), DM, DM, F.wsp<bf16>(WS_VMT), DM, 256};
              pg8::gemm_phase<pg8::EpiSplitT, pg8::OneUnit, false, true>(F.lds, g, S, E); }
          else { pg8::StaticOrder S; S.init(NBATCH * 256, 2 * DM, F.G, c); pg8::EpiSplitT E{F.wsp<bf16>(WS_KM), DM, DM, F.wsp<bf16>(WS_VMT), DM, 256};
              pg8::gemm_phase<pg8::EpiSplitT, pg8::StaticOrder, false, true>(F.lds, g, S, E); } }
        { const int first_idle = (M / 256) * (INW / 256) - 2 * F.G + 16;
          if (first_idle > 0 && first_idle < F.G) { if (c >= first_idle) convert_experts(F, (c - first_idle) * NWAVES + F.wave, (F.G - first_idle) * NWAVES); }
          else convert_experts(F, c * NWAVES + F.wave, F.G * NWAVES); }
    } SEAM(1);
    if (IN(2)) REP(2) { p2_lru_aggregates(F); } SEAM(2);
    if (IN(3)) REP(3) { p3_mixer(F); } SEAM(3);
    if (IN(4)) REP(4) {
        pg8::Gemm g{F.wsp<bf16>(WS_Y), F.wsp<bf16>(WS_WOUT), M, DM, DM}; pg8::StaticOrder S; S.init(M, DM, F.G, c);
        pg8::EpiResid<false> E{F.in(0), F.wsp<bf16>(WS_XN), F.wsp<float>(WS_SSQ1), DM};
        pg8::gemm_phase<pg8::EpiResid<false>, pg8::StaticOrder, true, true>(F.lds, g, S, E);
    } SEAM(4);
    if (IN(5)) {
        pg8::Gemm g{F.wsp<bf16>(WS_XN), F.wsp<bf16>(WS_WQ), M, DM, DM}; pg8::StaticOrder S; S.init(M, DM, F.G, c);
        pg8::EpiRowScale E{F.wsp<bf16>(WS_QC), DM, F.wsp<float>(WS_SSQ1), 1.f / 1024.f, EPS};
        pg8::gemm_phase<pg8::EpiRowScale, pg8::StaticOrder, true, true>(F.lds, g, S, E);
        LOCAL_SEAM();
        p5_cross(F, S);
    } SEAM(6);
    if (IN(7)) {
        pg8::Gemm g{F.wsp<bf16>(WS_OC), F.wsp<bf16>(WS_WO), M, DM, DM}; pg8::StaticOrder S; S.init(M, DM, F.G, c);
        pg8::EpiResid<true> E{F.wsp<bf16>(WS_XN), F.wsp<bf16>(WS_XN), F.wsp<float>(WS_SSQ2), DM};
        pg8::gemm_phase<pg8::EpiResid<true>, pg8::StaticOrder, true, true>(F.lds, g, S, E);
    } SEAM(7);
    if (IN(8)) {
        pg8::Gemm g{F.wsp<bf16>(WS_XN), F.wsp<bf16>(WS_WQRY), M, 2 * DM, DM}; pg8::StaticOrder S; S.init(M, 2 * DM, F.G, c);
        pg8::EpiRowScale E{F.wsp<bf16>(WS_QP), 2 * DM, F.wsp<float>(WS_SSQ2), 1.f / 1024.f, EPS};
        pg8::gemm_phase<pg8::EpiRowScale, pg8::StaticOrder, true, true>(F.lds, g, S, E);
        LOCAL_SEAM();
        p8a_topk(F, S);
    } SEAM(9);
    if (IN(10)) { if ((PHASE_REPEAT >> 10) & 1) { p8b_peer(F, F.wsp<float>(WS_Z), PROBE_EMASK); } p8b_peer(F, F.out, 0x3fffu,
#ifdef PROBE_PHASE
        1.0f + (float)(((__hip_atomic_load(F.ctl + 512 + PROBE_PHASE + 1, RLX_AGENT) - __hip_atomic_load(F.ctl + 512 + PROBE_PHASE, RLX_AGENT)) + 500u) / 1000u) * 1e-2f
#else
        1.0f
#endif
        ); }
#undef IN
#undef SEAM
}

#ifndef N_LAUNCH_MODE
#define N_LAUNCH_MODE 1
#endif
extern "C" void kernel_launch(void* const* d_in, const int* in_sizes, int n_in, void* d_out, int out_size, void* d_ws, size_t ws_size, hipStream_t stream) {
    static int grid = 0;
    if (grid == 0) {
        if (n_in != 26 || out_size != M * DM || ws_size < WS_END) { fprintf(stderr, "kernel_launch: unexpected shapes (n_in %d, out %d, ws %zu)\n", n_in, out_size, ws_size); grid = -1; return; }
        int dev = 0, cus = 0, per_cu = 0;
        if (hipGetDevice(&dev) != hipSuccess || hipDeviceGetAttribute(&cus, hipDeviceAttributeMultiprocessorCount, dev) != hipSuccess) { grid = -1; return; }
        if (hipFuncSetAttribute((const void*)fwd_kernel, hipFuncAttributeMaxDynamicSharedMemorySize, LDS_BYTES) != hipSuccess) { fprintf(stderr, "kernel_launch: hipFuncSetAttribute failed\n"); grid = -1; return; }
        if (hipOccupancyMaxActiveBlocksPerMultiprocessor(&per_cu, (const void*)fwd_kernel, NWAVES * 64, LDS_BYTES) != hipSuccess || per_cu < 1) { fprintf(stderr, "kernel_launch: occupancy query says %d blocks per CU\n", per_cu); (void)hipGetLastError(); grid = -1; return; }
        grid = cus;
    }
    if (grid < 0) return;
    (void)hipMemsetAsync((char*)d_ws + WS_CTL, 0, CTL_ZERO_BYTES, stream);
    Args a{};
    for (int i = 0; i < 26; ++i) a.in[i] = (const float*)d_in[i];
    a.out = (float*)d_out; a.ws = (unsigned char*)d_ws;
    if (N_LAUNCH_MODE == 1) { a.ph_lo = 0; a.ph_hi = N_PHASES; a.li = 0; hipLaunchKernelGGL(fwd_kernel, dim3(grid), dim3(NWAVES * 64), LDS_BYTES, stream, a); }
    else { for (int p = 0; p < N_PHASES; ++p) { a.ph_lo = p; a.ph_hi = p + 1; a.li = 0; hipLaunchKernelGGL(fwd_kernel, dim3(grid), dim3(NWAVES * 64), LDS_BYTES, stream, a); } }
}
```

```cpp
#include <hip/hip_runtime.h>
#include <cstdio>
#include <cstdint>
namespace pg8 {
#define PG8_LAS __attribute__((address_space(3)))
typedef unsigned short bf16_t;
typedef short bf16x8 __attribute__((ext_vector_type(8)));
typedef float f32x4 __attribute__((ext_vector_type(4)));
typedef unsigned u32x4 __attribute__((ext_vector_type(4)));
constexpr int BM = 256, BK = 64, HALF = 128, HTB = HALF * BK * 2  , STAGE_BYTES = 8 * HTB, NXCD = 8, WGM = 8;

__host__ __device__ __forceinline__ int lds_byte(int r, int c) { const int st = (r >> 4) * 2 + (c >> 5), rr = r & 15, cc = c & 31, ob = rr * 64 + cc * 2; return st * 1024 + (ob ^ (((ob >> 9) & 1) << 5)); }
__host__ __device__ __forceinline__ void stage_rc(int b, int& R, int& C) { const int st = b / 1024, sb = b % 1024, swz = sb ^ (((sb >> 9) & 1) << 5); R = (st >> 1) * 16 + swz / 64; C = (st & 1) * 32 + (swz % 64) / 2; }
__host__ __device__ __forceinline__ int perm32(int rho) { const int n = rho >> 4, i = rho & 15; return 8 * (i >> 2) + 4 * n + (i & 3); }

struct Unit { int pm, pn; };
struct Gemm { const bf16_t* A; const bf16_t* Bt; int M, N, K; };

struct StaticOrder {
    int nM, nN, nwg, G, c;
    __host__ __device__ void init(int M, int N, int G_, int c_) { nM = M / BM; nN = N / BM; nwg = nM * nN; G = G_; c = c_; }
    __host__ __device__ bool next(int i, Unit& u) const {
        const long L = (long)i * G + c; if (L >= nwg) return false;
        int wgid = (int)L; { const int q = nwg / NXCD, r = nwg % NXCD, xcd = wgid % NXCD, off = wgid / NXCD; wgid = (xcd < r ? xcd * (q + 1) : r * (q + 1) + (xcd - r) * q) + off; }
        const int nig = WGM * nN, gid = wgid / nig, fm = gid * WGM, gsz = (nM - fm) < WGM ? (nM - fm) : WGM;
        u.pm = fm + ((wgid % nig) % gsz); u.pn = (wgid % nig) / gsz; return true;
    }
    __device__ __forceinline__ void a_ready(const Unit&) const {}
    __device__ __forceinline__ void done(const Unit&) const {}
};

typedef float f32x2 __attribute__((ext_vector_type(2)));
typedef __bf16 bf16x2_t __attribute__((ext_vector_type(2)));
__device__ __forceinline__ unsigned cvt_pk_bf16(float lo, float hi) { f32x2 v = {lo, hi}; bf16x2_t b = __builtin_convertvector(v, bf16x2_t); return __builtin_bit_cast(unsigned, b); }
__device__ __forceinline__ bf16_t cvt_bf16(float x) { return (bf16_t)(cvt_pk_bf16(x, 0.f) & 0xffffu); }

struct EpiSplitT {
    static constexpr bool PERM = true, AFTER_DRAIN = false;
    bf16_t* O; int ldc; int ncols_rm; bf16_t* T; int NT; int rpb;
    __device__ __forceinline__ void operator()(const f32x4 (&acc)[2][2][4][2], const Unit& u, int wr, int wc, int fr, int fq) const {
        const int row0 = u.pm * BM + wr * 64 + fr; const int colt = u.pn * BM;
        if (colt < ncols_rm) {
            const int col0 = colt + wc * 32 + 8 * fq;
#pragma unroll
            for (int ai = 0; ai < 2; ++ai)
#pragma unroll
                for (int m = 0; m < 4; ++m) { bf16_t* rowp = O + (size_t)(row0 + ai * HALF + m * 16) * ldc + col0;
#pragma unroll
                    for (int bj = 0; bj < 2; ++bj) { const f32x4 v0 = acc[ai][bj][m][0], v1 = acc[ai][bj][m][1];
                        u32x4 w; w.x = cvt_pk_bf16(v0[0], v0[1]); w.y = cvt_pk_bf16(v0[2], v0[3]); w.z = cvt_pk_bf16(v1[0], v1[1]); w.w = cvt_pk_bf16(v1[2], v1[3]);
                        *(u32x4*)(rowp + bj * HALF) = w; } }
        } else {
            const int c0 = colt - ncols_rm + wc * 32 + 8 * fq;
#pragma unroll
            for (int ai = 0; ai < 2; ++ai)
#pragma unroll
                for (int m = 0; m < 4; ++m) { const int row = row0 + ai * HALF + m * 16; const int b = row / rpb, t = row - b * rpb; bf16_t* base = T + (size_t)b * NT * rpb + t;
#pragma unroll
                    for (int bj = 0; bj < 2; ++bj)
#pragma unroll
                        for (int n = 0; n < 2; ++n)
#pragma unroll
                            for (int e = 0; e < 4; ++e) base[(size_t)(c0 + bj * HALF + 4 * n + e) * rpb] = cvt_bf16(acc[ai][bj][m][n][e]); }
        }
    }
};
template <bool BASE_BF16> struct EpiResid {
    static constexpr bool PERM = true, AFTER_DRAIN = false;
    const void* base; bf16_t* xb; float* ssq; int ldc;
    __device__ __forceinline__ void operator()(const f32x4 (&acc)[2][2][4][2], const Unit& u, int wr, int wc, int fr, int fq) const {
        const int row0 = u.pm * BM + wr * 64 + fr; const int col0 = u.pn * BM + wc * 32 + 8 * fq;
#pragma unroll
        for (int ai = 0; ai < 2; ++ai)
#pragma unroll
            for (int m = 0; m < 4; ++m) { const int row = row0 + ai * HALF + m * 16; float s = 0.f;
#pragma unroll
                for (int bj = 0; bj < 2; ++bj) { const size_t off = (size_t)row * ldc + col0 + bj * HALF;
                    f32x4 b0, b1;
                    if (BASE_BF16) { const u32x4 w = *(const u32x4*)((const bf16_t*)base + off);
                        b0 = (f32x4){__uint_as_float(w.x << 16), __uint_as_float(w.x & 0xffff0000u), __uint_as_float(w.y << 16), __uint_as_float(w.y & 0xffff0000u)};
                        b1 = (f32x4){__uint_as_float(w.z << 16), __uint_as_float(w.z & 0xffff0000u), __uint_as_float(w.w << 16), __uint_as_float(w.w & 0xffff0000u)}; }
                    else { b0 = *(const f32x4*)((const float*)base + off); b1 = *(const f32x4*)((const float*)base + off + 4); }
                    const f32x4 v0 = acc[ai][bj][m][0] + b0, v1 = acc[ai][bj][m][1] + b1;
                    s += (v0[0] * v0[0] + v0[1] * v0[1]) + (v0[2] * v0[2] + v0[3] * v0[3]) + (v1[0] * v1[0] + v1[1] * v1[1]) + (v1[2] * v1[2] + v1[3] * v1[3]);
                    u32x4 w; w.x = cvt_pk_bf16(v0[0], v0[1]); w.y = cvt_pk_bf16(v0[2], v0[3]); w.z = cvt_pk_bf16(v1[0], v1[1]); w.w = cvt_pk_bf16(v1[2], v1[3]);
                    *(u32x4*)(xb + off) = w; }
                s += __shfl_xor(s, 16); s += __shfl_xor(s, 32);
                if (fq == 0) ssq[(size_t)row * 16 + u.pn * 4 + wc] = s; }
    }
};
struct EpiRowScale {
    static constexpr bool PERM = true, AFTER_DRAIN = false;
    bf16_t* O; int ldc; const float* ssq; float inv_n, eps;
    __device__ __forceinline__ void operator()(const f32x4 (&acc)[2][2][4][2], const Unit& u, int wr, int wc, int fr, int fq) const {
        const int row0 = u.pm * BM + wr * 64 + fr; const int col0 = u.pn * BM + wc * 32 + 8 * fq;
#pragma unroll
        for (int ai = 0; ai < 2; ++ai)
#pragma unroll
            for (int m = 0; m < 4; ++m) { const int row = row0 + ai * HALF + m * 16; const f32x4* sp = (const f32x4*)(ssq + (size_t)row * 16);
                const f32x4 s0 = sp[0], s1 = sp[1], s2 = sp[2], s3 = sp[3]; const f32x4 st = (s0 + s1) + (s2 + s3);
                const float r = 1.0f / sqrtf(((st[0] + st[1]) + (st[2] + st[3])) * inv_n + eps);
                bf16_t* rowp = O + (size_t)row * ldc + col0;
#pragma unroll
                for (int bj = 0; bj < 2; ++bj) { const f32x4 v0 = acc[ai][bj][m][0] * r, v1 = acc[ai][bj][m][1] * r;
                    u32x4 w; w.x = cvt_pk_bf16(v0[0], v0[1]); w.y = cvt_pk_bf16(v0[2], v0[3]); w.z = cvt_pk_bf16(v1[0], v1[1]); w.w = cvt_pk_bf16(v1[2], v1[3]);
                    *(u32x4*)(rowp + bj * HALF) = w; } }
    }
};
struct OneUnit {
    int idx, nM, nN;
    __device__ __forceinline__ bool next(int i, Unit& u) const { if (i > 0 || idx < 0 || idx >= nM * nN) return false; u.pm = idx % nM; u.pn = idx / nM; return true; }
    __device__ __forceinline__ void a_ready(const Unit&) const {}
    __device__ __forceinline__ void done(const Unit&) const {}
};

template <class Epi, class Sched, bool ALIGN_EPI = false, bool SP2 = false>
__device__ __forceinline__ void gemm_phase(PG8_LAS unsigned char* lds, const Gemm g, const Sched& S, const Epi& E) {
    const int tid = threadIdx.x, wid = __builtin_amdgcn_readfirstlane(tid >> 6), lane = tid & 63, wr = wid >> 2, wc = wid & 3, fr = lane & 15, fq = lane >> 4;
    const int K = g.K, nt = K / BK;
    unsigned voffA[2], voffB[2];
#pragma unroll
    for (int i = 0; i < 2; ++i) { int R, C; stage_rc(tid * 16 + i * 8192, R, C); const int Rb = Epi::PERM ? ((R & ~31) + perm32(R & 31)) : R;
        voffA[i] = (unsigned)(R * K + C) * 2u; voffB[i] = (unsigned)(Rb * K + C) * 2u; }
    const size_t kstep = (size_t)(BK * 2);
    const size_t hstep = (size_t)HALF * K * 2;
    const size_t tstep = 2 * hstep;
    const unsigned ldsw = (unsigned)wid * 1024u;
    const int aoff = lds_byte(wr * 64 + fr, fq * 8), boff = lds_byte(wc * 32 + fr, fq * 8);
#define PG8_SA(b, h) (((b) * 2 + (h)) * HTB)
#define PG8_SB(b, h) ((4 + (b) * 2 + (h)) * HTB)
#define PG8_STAGE(bufoff, gbase, voff) do { _Pragma("unroll") for (int _i = 0; _i < 2; ++_i) \
        __builtin_amdgcn_global_load_lds((const unsigned*)((const char*)(gbase) + (voff)[_i]), (PG8_LAS unsigned*)(lds + (bufoff) + ldsw + _i * 8192), 16, 0, 0); } while (0)
#define PG8_LDA(dst, b, h) do { _Pragma("unroll") for (int m = 0; m < 4; ++m) _Pragma("unroll") for (int k = 0; k < 2; ++k) dst[m][k] = *(const PG8_LAS bf16x8*)(lds + PG8_SA(b, h) + aoff + m * 2048 + k * 1024); } while (0)
#define PG8_LDB(dst, b, h) do { _Pragma("unroll") for (int n = 0; n < 2; ++n) _Pragma("unroll") for (int k = 0; k < 2; ++k) dst[n][k] = *(const PG8_LAS bf16x8*)(lds + PG8_SB(b, h) + boff + n * 2048 + k * 1024); } while (0)
#define PG8_MMA(ai, bj, At, Bt) do { __builtin_amdgcn_s_setprio(1); _Pragma("unroll") for (int m = 0; m < 4; ++m) _Pragma("unroll") for (int n = 0; n < 2; ++n) _Pragma("unroll") for (int k = 0; k < 2; ++k) \
        acc[ai][bj][m][n] = __builtin_amdgcn_mfma_f32_16x16x32_bf16(Bt[n][k], At[m][k], acc[ai][bj][m][n], 0, 0, 0); __builtin_amdgcn_s_setprio(0); } while (0)
#define PG8_WAIT_V(n) asm volatile("s_waitcnt vmcnt(" #n ")" ::: "memory")
#define PG8_WAIT_L(n) asm volatile("s_waitcnt lgkmcnt(" #n ")" ::: "memory")
#define PG8_BAR __builtin_amdgcn_s_barrier()
#define PG8_SCHED __builtin_amdgcn_sched_barrier(0)
    Unit cur, nxt; int ui = 0;
    if (!S.next(0, cur)) return;
    f32x4 acc[2][2][4][2];
#pragma unroll
    for (int a = 0; a < 2; ++a)
#pragma unroll
        for (int b = 0; b < 2; ++b)
#pragma unroll
            for (int m = 0; m < 4; ++m)
#pragma unroll
                for (int n = 0; n < 2; ++n) acc[a][b][m][n] = (f32x4){0.f, 0.f, 0.f, 0.f};
    bf16x8 At[4][2], B0[2][2], B1[2][2];
    const char* cA = (const char*)g.A + (size_t)cur.pm * tstep; const char* cB = (const char*)g.Bt + (size_t)cur.pn * tstep;
    S.a_ready(cur);
    if constexpr (SP2) {
        PG8_STAGE(PG8_SB(0, 0), cB, voffB); PG8_STAGE(PG8_SB(0, 1), cB + hstep, voffB); PG8_STAGE(PG8_SA(0, 0), cA, voffA); PG8_STAGE(PG8_SA(0, 1), cA + hstep, voffA);
        if (wr == 1) PG8_BAR;
        PG8_WAIT_V(2); PG8_BAR;
        PG8_STAGE(PG8_SB(1, 0), cB + kstep, voffB); PG8_STAGE(PG8_SA(1, 0), cA + kstep, voffA); PG8_STAGE(PG8_SB(1, 1), cB + hstep + kstep, voffB);
        PG8_WAIT_V(6); PG8_BAR;
    } else {
        PG8_STAGE(PG8_SB(0, 0), cB, voffB); PG8_STAGE(PG8_SA(0, 0), cA, voffA); PG8_STAGE(PG8_SB(0, 1), cB + hstep, voffB); PG8_STAGE(PG8_SA(0, 1), cA + hstep, voffA);
        if (wr == 1) PG8_BAR;
        PG8_WAIT_V(4); PG8_BAR;
        PG8_STAGE(PG8_SB(1, 0), cB + kstep, voffB); PG8_STAGE(PG8_SA(1, 0), cA + kstep, voffA); PG8_STAGE(PG8_SB(1, 1), cB + hstep + kstep, voffB);
        PG8_WAIT_V(6); PG8_BAR;
    }
    for (;;) {
        const bool has_next = S.next(ui + 1, nxt);
        const char* nA = has_next ? (const char*)g.A + (size_t)nxt.pm * tstep : cA; const char* nB = has_next ? (const char*)g.Bt + (size_t)nxt.pn * tstep : cB;
        for (int t = 0; t < nt; t += 2) {
            const bool last = (t == nt - 2);
            const char* a1 = cA + (size_t)(t + 1) * kstep;
            const char* a2 = last ? nA : cA + (size_t)(t + 2) * kstep; const char* b2 = last ? nB : cB + (size_t)(t + 2) * kstep;
            const char* a3 = a2 + kstep; const char* b3 = b2 + kstep;
            if (last && has_next) S.a_ready(nxt);
            if constexpr (SP2) {
            PG8_LDB(B0, 0, 0); PG8_LDB(B1, 0, 1); PG8_SCHED; PG8_LDA(At, 0, 0); PG8_STAGE(PG8_SA(1, 1), a1 + hstep, voffA);
            PG8_WAIT_V(8); PG8_WAIT_L(0); PG8_BAR; PG8_MMA(0, 0, At, B0); PG8_MMA(0, 1, At, B1); PG8_BAR; PG8_SCHED;
            PG8_LDA(At, 0, 1); PG8_STAGE(PG8_SB(0, 0), b2, voffB); PG8_STAGE(PG8_SB(0, 1), b2 + hstep, voffB); PG8_STAGE(PG8_SA(0, 0), a2, voffA);
            PG8_WAIT_V(8); PG8_WAIT_L(0); PG8_BAR; PG8_MMA(1, 0, At, B0); PG8_MMA(1, 1, At, B1); PG8_BAR; PG8_SCHED;
            PG8_LDB(B0, 1, 0); PG8_LDB(B1, 1, 1); PG8_SCHED; PG8_LDA(At, 1, 0); PG8_STAGE(PG8_SA(0, 1), a2 + hstep, voffA);
            PG8_WAIT_V(8); PG8_WAIT_L(0); PG8_BAR; PG8_MMA(0, 0, At, B0); PG8_MMA(0, 1, At, B1); PG8_BAR; PG8_SCHED;
            PG8_LDA(At, 1, 1); PG8_STAGE(PG8_SB(1, 0), b3, voffB); PG8_STAGE(PG8_SB(1, 1), b3 + hstep, voffB); PG8_STAGE(PG8_SA(1, 0), a3, voffA);
            PG8_WAIT_V(8); PG8_WAIT_L(0); PG8_BAR; PG8_MMA(1, 0, At, B0); PG8_MMA(1, 1, At, B1); PG8_BAR; PG8_SCHED;
            } else {
            PG8_LDB(B0, 0, 0); PG8_SCHED; PG8_LDA(At, 0, 0); PG8_STAGE(PG8_SA(1, 1), a1 + hstep, voffA);
            PG8_WAIT_L(8); PG8_BAR; PG8_WAIT_L(0); PG8_MMA(0, 0, At, B0); PG8_BAR; PG8_SCHED;
            PG8_LDB(B1, 0, 1); PG8_STAGE(PG8_SB(0, 0), b2, voffB);
            PG8_BAR; PG8_WAIT_L(0); PG8_MMA(0, 1, At, B1); PG8_BAR;
            PG8_LDA(At, 0, 1); PG8_STAGE(PG8_SA(0, 0), a2, voffA);
            PG8_BAR; PG8_WAIT_L(0); PG8_MMA(1, 0, At, B0); PG8_BAR; PG8_SCHED;
            PG8_STAGE(PG8_SB(0, 1), b2 + hstep, voffB);
            PG8_WAIT_V(6); PG8_BAR; PG8_MMA(1, 1, At, B1); PG8_BAR;
            PG8_LDB(B0, 1, 0); PG8_SCHED; PG8_LDA(At, 1, 0); PG8_STAGE(PG8_SA(0, 1), a2 + hstep, voffA);
            PG8_WAIT_L(8); PG8_BAR; PG8_WAIT_L(0); PG8_MMA(0, 0, At, B0); PG8_BAR; PG8_SCHED;
            PG8_LDB(B1, 1, 1); PG8_STAGE(PG8_SB(1, 0), b3, voffB);
            PG8_BAR; PG8_WAIT_L(0); PG8_MMA(0, 1, At, B1); PG8_BAR;
            PG8_LDA(At, 1, 1); PG8_STAGE(PG8_SA(1, 0), a3, voffA);
            PG8_BAR; PG8_WAIT_L(0); PG8_MMA(1, 0, At, B0); PG8_BAR; PG8_SCHED;
            PG8_STAGE(PG8_SB(1, 1), b3 + hstep, voffB);
            PG8_WAIT_V(6); PG8_BAR; PG8_MMA(1, 1, At, B1); PG8_BAR;
            }
        }
        if constexpr (ALIGN_EPI) { if (wr == 0) PG8_BAR; }
        if constexpr (!Epi::AFTER_DRAIN) { E(acc, cur, wr, wc, fr, fq); S.done(cur); }
        if (!has_next) break;
#pragma unroll
        for (int a = 0; a < 2; ++a)
#pragma unroll
            for (int b = 0; b < 2; ++b)
#pragma unroll
                for (int m = 0; m < 4; ++m)
#pragma unroll
                    for (int n = 0; n < 2; ++n) acc[a][b][m][n] = (f32x4){0.f, 0.f, 0.f, 0.f};
        cur = nxt; cA = nA; cB = nB; ++ui;
        if constexpr (ALIGN_EPI) { if (wr == 1) PG8_BAR; }
    }
    PG8_WAIT_V(0);
    if constexpr (!ALIGN_EPI) { if (wr == 0) PG8_BAR; }
    PG8_BAR;
    if constexpr (Epi::AFTER_DRAIN) { E.fused(acc, cur, wr, wc, fr, fq, lds, wid, lane); S.done(cur); }
#undef PG8_SA
#undef PG8_SB
#undef PG8_STAGE
#undef PG8_LDA
#undef PG8_LDB
#undef PG8_MMA
#undef PG8_WAIT_V
#undef PG8_WAIT_L
#undef PG8_BAR
#undef PG8_SCHED
}
}

#ifndef PG8_SP2
#define PG8_SP2 true
#endif
#ifndef PG8_ALIGN
#define PG8_ALIGN true
#endif
constexpr int NWAVES = 8;
constexpr int NBATCH = 2, SEQ = 8192, DM = 1024, M = NBATCH * SEQ;
constexpr int INW = 2560, ZW = 2048;
constexpr int LRUW = 512, ATTW = 512, NCHUNK = SEQ / 64;
constexpr int NEXP = 16384, PEER_H = 8, NSEL = 128;
constexpr float EPS = 1e-6f;
constexpr float LOG2E = 1.4426950408889634f;

constexpr size_t MiB = 1u << 20;
constexpr size_t WS_CTL = 0, CTL_ZERO_BYTES = 1 * MiB;
constexpr size_t WS_WIN = 1 * MiB, WS_WOUT = 6 * MiB, WS_WQ = 8 * MiB, WS_WKV = 10 * MiB, WS_WO = 14 * MiB, WS_WQRY = 16 * MiB;
constexpr size_t WS_SUBK = 20 * MiB, WS_GATEW = 20 * MiB + 512 * 1024, WS_MEMN = 21 * MiB, WS_KM = 22 * MiB, WS_VMT = 23 * MiB, WS_AGG = 24 * MiB, WS_SSQ1 = 25 * MiB, WS_SSQ2 = 26 * MiB, WS_SU = 27 * MiB;
constexpr size_t WS_EU = 28 * MiB, WS_EV = 60 * MiB, WS_XN = 92 * MiB, WS_Z = 124 * MiB, WS_VT = 188 * MiB, WS_Y = 204 * MiB, WS_END = 236 * MiB;
constexpr size_t WS_QC = WS_Z, WS_OC = WS_Z + 32 * MiB, WS_QP = WS_Z, WS_IDX = WS_VT, WS_G = WS_VT + 8 * MiB;
constexpr int CW_BAR = 4096;

constexpr int RING_BYTES = 155648;
constexpr int LDSCTL_OFF = RING_BYTES, MISC_OFF = LDSCTL_OFF + 320;
constexpr int LDS_BYTES = 163840;

#define GAS __attribute__((address_space(1)))
#define LAS __attribute__((address_space(3)))
typedef unsigned short bf16;
typedef unsigned v4u __attribute__((ext_vector_type(4)));
typedef unsigned v2u __attribute__((ext_vector_type(2)));
typedef float f32x4 __attribute__((ext_vector_type(4)));
typedef float f32x2 __attribute__((ext_vector_type(2)));
typedef float f32x16 __attribute__((ext_vector_type(16)));
typedef short bf16x8 __attribute__((ext_vector_type(8)));
typedef __bf16 bf16x2_t __attribute__((ext_vector_type(2)));
typedef GAS unsigned gu32;
typedef _Float16 v32h __attribute__((ext_vector_type(32)));
typedef unsigned v6u __attribute__((ext_vector_type(6)));
typedef _Float16 f16x2_t __attribute__((ext_vector_type(2)));
constexpr int EV_ROW = 768;
#define RLX_AGENT __ATOMIC_RELAXED, __HIP_MEMORY_SCOPE_AGENT
#define LDS_WAIT() asm volatile("s_waitcnt lgkmcnt(0)" ::: "memory")
#define VM_WAIT() asm volatile("s_waitcnt vmcnt(0)" ::: "memory")
#define MFMA32(a, b, c) __builtin_amdgcn_mfma_f32_32x32x16_bf16((a), (b), (c), 0, 0, 0)
#define DI __device__ __forceinline__

DI unsigned pk2(float lo, float hi) { f32x2 v = {lo, hi}; bf16x2_t b = __builtin_convertvector(v, bf16x2_t); return __builtin_bit_cast(unsigned, b); }
DI bf16 f2bf(float x) { return (bf16)(pk2(x, 0.f) & 0xffffu); }
DI float bf2f(bf16 x) { return __uint_as_float((unsigned)x << 16); }
DI float bflo(unsigned p) { return __uint_as_float(p << 16); }
DI float bfhi(unsigned p) { return __uint_as_float(p & 0xffff0000u); }
DI int crow(int reg, int hh) { return (reg & 3) + 8 * (reg >> 2) + 4 * hh; }
DI float swap32_partner(float x, int hh) { auto rr = __builtin_amdgcn_permlane32_swap(__float_as_uint(x), __float_as_uint(x), false, false); return __uint_as_float(hh ? rr[0] : rr[1]); }
DI float dpp_xor1(float x) { return __int_as_float(__builtin_amdgcn_update_dpp(0, __float_as_int(x), 0xB1, 0xf, 0xf, true)); }
DI float dpp_xor2(float x) { return __int_as_float(__builtin_amdgcn_update_dpp(0, __float_as_int(x), 0x4E, 0xf, 0xf, true)); }
DI float dpp_hmir(float x) { return __int_as_float(__builtin_amdgcn_update_dpp(0, __float_as_int(x), 0x141, 0xf, 0xf, true)); }
DI float dpp_mir(float x)  { return __int_as_float(__builtin_amdgcn_update_dpp(0, __float_as_int(x), 0x140, 0xf, 0xf, true)); }
DI float sum16(float x) { x += dpp_xor1(x); x += dpp_xor2(x); x += dpp_hmir(x); x += dpp_mir(x); return x; }
DI float sum32(float x) { x = sum16(x); auto rr = __builtin_amdgcn_permlane16_swap(__float_as_uint(x), __float_as_uint(x), false, false); return __uint_as_float(rr[0]) + __uint_as_float(rr[1]); }
DI float max16(float x) { x = fmaxf(x, dpp_xor1(x)); x = fmaxf(x, dpp_xor2(x)); x = fmaxf(x, dpp_hmir(x)); x = fmaxf(x, dpp_mir(x)); return x; }
DI float max64(float x) { x = max16(x); { auto rr = __builtin_amdgcn_permlane16_swap(__float_as_uint(x), __float_as_uint(x), false, false); x = fmaxf(__uint_as_float(rr[0]), __uint_as_float(rr[1])); }
    { auto rr = __builtin_amdgcn_permlane32_swap(__float_as_uint(x), __float_as_uint(x), false, false); x = fmaxf(__uint_as_float(rr[0]), __uint_as_float(rr[1])); } return x; }
DI unsigned pack_i8x4(float a, float b, float c, float d) { const int ia = (int)__builtin_rintf(a), ib = (int)__builtin_rintf(b), ic = (int)__builtin_rintf(c), id = (int)__builtin_rintf(d);
    return (unsigned)(ia & 255) | ((unsigned)(ib & 255) << 8) | ((unsigned)(ic & 255) << 16) | ((unsigned)id << 24); }
DI float max32(float x) { x = max16(x); auto rr = __builtin_amdgcn_permlane16_swap(__float_as_uint(x), __float_as_uint(x), false, false); return fmaxf(__uint_as_float(rr[0]), __uint_as_float(rr[1])); }
DI float sum64(float x) { x = sum32(x); auto rr = __builtin_amdgcn_permlane32_swap(__float_as_uint(x), __float_as_uint(x), false, false); return __uint_as_float(rr[0]) + __uint_as_float(rr[1]); }
DI float rcp_(float x) { return __builtin_amdgcn_rcpf(x); }
DI float rsq_(float x) { return __builtin_amdgcn_rsqf(x); }
DI float exp2_(float x) { return __builtin_amdgcn_exp2f(x); }
DI float gelu_tanh(float x) { const float u = x * (1.5957691216057308f + 0.07135481627159768f * x * x); return x * rcp_(1.0f + exp2_(-LOG2E * u)); }
DI float sigmoidf_(float x) { return rcp_(1.0f + exp2_(-LOG2E * x)); }
#define XB_TMO      128
#define XB_XCNT(j)  (256  + 64 * (j))
#define XB_XSUB(j)  (1280 + 64 * (j))
#define XB_XGEN(j)  (2304 + 64 * (j))
#define XB_TOP      3328
#define XB_TOPGEN   3392
#define XCD_BAR_WORDS 3456
#define XB_SPIN_CAP (1u << 18)

__device__ __forceinline__ unsigned xb_ld(unsigned* p)              { return __hip_atomic_load(p, __ATOMIC_RELAXED, __HIP_MEMORY_SCOPE_AGENT); }
__device__ __forceinline__ unsigned xb_add(unsigned* p, unsigned v) { return __hip_atomic_fetch_add(p, v, __ATOMIC_RELAXED, __HIP_MEMORY_SCOPE_AGENT); }
__device__ __forceinline__ unsigned xb_xcc_id() { return (unsigned)__builtin_amdgcn_s_getreg((3 << 11) | 20) & 0xFu; }
#define XB_SPIN(cond, bar) do { unsigned _sp = 0; while (cond) { __builtin_amdgcn_s_sleep(1); \
    if ((++_sp & 255u) == 0u) { if (xb_ld(&(bar)[XB_TMO])) break; if (_sp > XB_SPIN_CAP) { atomicAdd(&(bar)[XB_TMO], 1u); break; } } } } while (0)

struct XcdBarrier {
    unsigned* bar; unsigned x;
    volatile LAS unsigned* st;
};

__device__ __forceinline__ XcdBarrier xcd_barrier_post(unsigned* bar, volatile LAS unsigned* st) {
    XcdBarrier b; b.bar = bar; b.x = xb_xcc_id(); b.st = st;
    if (threadIdx.x == 0) (void)xb_add(&bar[XB_XCNT(b.x)], 1u);
    return b;
}
__device__ __forceinline__ void xcd_barrier_complete(unsigned* bar, unsigned x, unsigned& nloc, unsigned& nx) {
    const unsigned G = gridDim.x * gridDim.y * gridDim.z;
    unsigned sum, cnt, mine, sp = 0u;
    for (;;) {
        sum = 0u; cnt = 0u; mine = 0u;
#pragma unroll
        for (unsigned j = 0; j < 16; ++j) { const unsigned c = xb_ld(&bar[XB_XCNT(j)]); sum += c; cnt += (c > 0u) ? 1u : 0u; mine = (j == x) ? c : mine; }
        if (sum == G) break;
        __builtin_amdgcn_s_sleep(1);
        if ((++sp & 255u) == 0u) { if (xb_ld(&bar[XB_TMO])) break; if (sp > XB_SPIN_CAP) { atomicAdd(&bar[XB_TMO], 1u); break; } }
    }
    nloc = mine > 0u ? mine : 1u; nx = cnt > 0u ? cnt : 1u;
}

__device__ __forceinline__ void xcd_barrier(const XcdBarrier& b) {
    asm volatile("s_waitcnt vmcnt(0)" ::: "memory");
    __syncthreads();
    if (threadIdx.x == 0) {
        unsigned* bar = b.bar;
        __builtin_amdgcn_s_waitcnt(0);
        unsigned nloc = b.st[0], nx = b.st[1];
        if (nloc == 0u) { xcd_barrier_complete(bar, b.x, nloc, nx); b.st[0] = nloc; b.st[1] = nx; }
        const unsigned old = xb_add(&bar[XB_XSUB(b.x)], 1u);
        const unsigned gen = old / nloc;
        if (old + 1u == (gen + 1u) * nloc) {
            __builtin_amdgcn_fence(__ATOMIC_RELEASE, "agent");
            asm volatile("s_waitcnt vmcnt(0)" ::: "memory");
            const unsigned og = xb_add(&bar[XB_TOP], 1u);
            const unsigned tg = og / nx;
            if (og + 1u == (tg + 1u) * nx) xb_add(&bar[XB_TOPGEN], 1u);
            else XB_SPIN(xb_ld(&bar[XB_TOPGEN]) == tg, bar);
            __builtin_amdgcn_fence(__ATOMIC_ACQUIRE, "agent");
            xb_add(&bar[XB_XGEN(b.x)], 1u);
            asm volatile("s_waitcnt vmcnt(0)" ::: "memory");
        } else {
            XB_SPIN(xb_ld(&bar[XB_XGEN(b.x)]) == gen, bar);
            __builtin_amdgcn_fence(__ATOMIC_ACQUIRE, "agent");
            asm volatile("s_waitcnt vmcnt(0)" ::: "memory");
        }
    }
    __syncthreads();
}
struct Args { const float* in[26]; float* out; unsigned char* ws; int ph_lo, ph_hi, li, pad; };
struct Frame {
    LAS unsigned char* lds;
    volatile LAS unsigned* MISC;
    gu32* ctl;
    int tid, lane, wave, vcu, G;
    const Args* A; float* out; unsigned char* ws;
    DI const float* in(int k) const { return A->in[k]; }
    template <class T> DI T* wsp(size_t off) const { return (T*)(ws + off); }
};

DI void p0_transpose_item(const float* W, int K, int N, bf16* WT, LAS float* scr, int item, int lane, const float* g0, const float* g1, int gsplit) {
    const int nblk = N / 32, kb = item / nblk, nb = item % nblk, k0 = 64 * kb, n0 = 32 * nb;
#pragma unroll 8
    for (int i = 0; i < 32; ++i) { const int kk = 2 * i + (lane >> 5); const int k = k0 + kk;
        float g = 1.f; if (g0) g = (k < gsplit) ? g0[k] : g1[k - gsplit];
        scr[kk * 33 + (lane & 31)] = W[(size_t)k * N + n0 + (lane & 31)] * g; }
    LDS_WAIT(); asm volatile("" ::: "memory");
    const int c = lane & 7;
#pragma unroll
    for (int j = 0; j < 4; ++j) { const int n = (lane >> 3) + 8 * j; const LAS float* s = scr + (8 * c) * 33 + n;
        v4u o; o.x = pk2(s[0 * 33], s[1 * 33]); o.y = pk2(s[2 * 33], s[3 * 33]); o.z = pk2(s[4 * 33], s[5 * 33]); o.w = pk2(s[6 * 33], s[7 * 33]);
        *(GAS v4u*)(WT + (size_t)(n0 + n) * K + k0 + 8 * c) = o; }
    LDS_WAIT(); asm volatile("" ::: "memory");
}
template <bool NORM> DI void row_to_bf16(const float* xrow, bf16* orow, const float* gain, int lane) {
    const GAS f32x4* xr = (const GAS f32x4*)xrow + lane;
    f32x4 v[4]; float s = 0.f;
#pragma unroll
    for (int j = 0; j < 4; ++j) { v[j] = xr[64 * j]; s += (v[j].x * v[j].x + v[j].y * v[j].y) + (v[j].z * v[j].z + v[j].w * v[j].w); }
    float rstd = 1.f;
    if (NORM) rstd = 1.0f / sqrtf(sum64(s) * (1.f / 1024.f) + EPS);
    GAS v2u* o8 = (GAS v2u*)orow + lane;
#pragma unroll
    for (int j = 0; j < 4; ++j) { f32x4 w = v[j] * rstd; if (gain) w = w * ((const GAS f32x4*)gain)[64 * j + lane];
        v2u o; o.x = pk2(w.x, w.y); o.y = pk2(w.z, w.w); o8[64 * j] = o; }
}
constexpr float U_SCALE = 128.f, V_SCALE = 16.f;
template <bool NORM, int NB> DI void rows_to_bf16(const float* xrow, bf16* orow, size_t row_stride, const float* gain, int lane) {
    f32x4 v[NB][4];
#pragma unroll
    for (int b = 0; b < NB; ++b)
#pragma unroll
        for (int j = 0; j < 4; ++j) v[b][j] = ((const GAS f32x4*)(xrow + b * row_stride))[64 * j + lane];
#pragma unroll
    for (int b = 0; b < NB; ++b) { float s = 0.f;
#pragma unroll
        for (int j = 0; j < 4; ++j) s += (v[b][j].x * v[b][j].x + v[b][j].y * v[b][j].y) + (v[b][j].z * v[b][j].z + v[b][j].w * v[b][j].w);
        float rstd = 1.f; if (NORM) rstd = rsq_(sum64(s) * (1.f / 1024.f) + EPS);
        GAS v2u* o8 = (GAS v2u*)(orow + b * row_stride) + lane;
#pragma unroll
        for (int j = 0; j < 4; ++j) { f32x4 w = v[b][j] * rstd; if (gain) w = w * ((const GAS f32x4*)gain)[64 * j + lane];
            v2u o; o.x = pk2(w.x, w.y); o.y = pk2(w.z, w.w); o8[64 * j] = o; } }
}
DI void row_to_fp8(const float* src, unsigned char* dst, const float* gain, float scale, int lane) {
#pragma unroll
    for (int j = 0; j < 4; ++j) { f32x4 v = ((const GAS f32x4*)src)[64 * j + lane] * scale; if (gain) v = v * ((const GAS f32x4*)gain)[64 * j + lane];
        unsigned w = 0u; w = __builtin_amdgcn_cvt_pk_fp8_f32(v.x, v.y, w, false); w = __builtin_amdgcn_cvt_pk_fp8_f32(v.z, v.w, w, true);
        ((GAS unsigned*)dst)[64 * j + lane] = w; }
}
DI void row_to_i8(const float* src, unsigned char* dst, const float* gain, float* scale_out, int lane) {
    f32x4 v[4]; float mx = 0.f;
#pragma unroll
    for (int j = 0; j < 4; ++j) { v[j] = ((const GAS f32x4*)src)[64 * j + lane] * ((const GAS f32x4*)gain)[64 * j + lane];
        mx = fmaxf(fmaxf(mx, fmaxf(fabsf(v[j].x), fabsf(v[j].y))), fmaxf(fabsf(v[j].z), fabsf(v[j].w))); }
    mx = fmaxf(max64(mx), 1e-30f);
    const float inv = 127.0f / mx;
#pragma unroll
    for (int j = 0; j < 4; ++j) ((GAS unsigned*)dst)[64 * j + lane] = pack_i8x4(v[j].x * inv, v[j].y * inv, v[j].z * inv, v[j].w * inv);
    if (lane == 0) *scale_out = mx * (1.0f / 127.0f);
}
DI void convert_experts(Frame& F, int wv, int nwv) {
    const int lane = F.lane;
    const int l5 = lane & 31, hh = lane >> 5;
    for (int m = wv * 2; m < NEXP; m += nwv * 2) {
        f32x4 u[2][4], v[8];
#pragma unroll
        for (int b = 0; b < 2; ++b)
#pragma unroll
            for (int j = 0; j < 4; ++j) u[b][j] = ((const GAS f32x4*)(F.in(23) + (size_t)(m + b) * DM))[64 * j + lane];
#pragma unroll
        for (int j = 0; j < 8; ++j) v[j] = ((const GAS f32x4*)(F.in(24) + (size_t)(m + hh) * DM))[8 * l5 + j];
#pragma unroll
        for (int b = 0; b < 2; ++b) {
            float mx = 0.f;
#pragma unroll
            for (int j = 0; j < 4; ++j) { u[b][j] = u[b][j] * ((const GAS f32x4*)F.in(20))[64 * j + lane];
                mx = fmaxf(fmaxf(mx, fmaxf(fabsf(u[b][j].x), fabsf(u[b][j].y))), fmaxf(fabsf(u[b][j].z), fabsf(u[b][j].w))); }
            mx = fmaxf(max64(mx), 1e-30f);
            const float inv = 127.0f / mx;
#pragma unroll
            for (int j = 0; j < 4; ++j) ((GAS unsigned*)(F.wsp<unsigned char>(WS_EU) + (size_t)(m + b) * DM))[64 * j + lane] = pack_i8x4(u[b][j].x * inv, u[b][j].y * inv, u[b][j].z * inv, u[b][j].w * inv);
            if (lane == 0) F.wsp<float>(WS_SU)[m + b] = mx * (1.0f / 127.0f);
        }
        {
            float mx = 0.f;
#pragma unroll
            for (int j = 0; j < 8; ++j) mx = fmaxf(fmaxf(mx, fmaxf(fabsf(v[j].x), fabsf(v[j].y))), fmaxf(fabsf(v[j].z), fabsf(v[j].w)));
            mx = fmaxf(max32(mx), 1e-30f);
            const float inv = 7.5f / mx;
            v32h h;
#pragma unroll
            for (int j = 0; j < 8; ++j) { h[4 * j] = (_Float16)(v[j].x * inv); h[4 * j + 1] = (_Float16)(v[j].y * inv); h[4 * j + 2] = (_Float16)(v[j].z * inv); h[4 * j + 3] = (_Float16)(v[j].w * inv); }
            const v6u pk = __builtin_amdgcn_cvt_scalef32_pk32_fp6_f16(h, 1.0f);
            unsigned char* rowp = F.wsp<unsigned char>(WS_EV) + (size_t)(m + hh) * EV_ROW;
            *(GAS v4u*)(rowp + 16 * l5) = (v4u){pk[0], pk[1], pk[2], pk[3]}; *(GAS v2u*)(rowp + 512 + 8 * l5) = (v2u){pk[4], pk[5]};
            if (l5 == 0) F.wsp<float>(WS_SU)[NEXP + m + hh] = mx * (1.0f / 7.5f);
        }
    }
}
DI void p0_prologue(Frame& F) {
    LAS float* scr = (LAS float*)(F.lds + F.wave * 16384);
    const int gw = F.vcu * NWAVES + F.wave, NGW = F.G * NWAVES, lane = F.lane;
    constexpr int I_IN = 16 * (INW / 32), I_D = 16 * (DM / 32), I_2D = 16 * (2 * DM / 32);
    constexpr int NITEMS = I_IN + 3 * I_D + 2 * I_2D;
    for (int it = gw; it < NITEMS; it += NGW) {
        int r = it;
        if (r < I_IN) { p0_transpose_item(F.in(3), DM, INW, F.wsp<bf16>(WS_WIN), scr, r, lane, F.in(2), F.in(2), DM); continue; } r -= I_IN;
        if (r < I_D) { p0_transpose_item(F.in(14), DM, DM, F.wsp<bf16>(WS_WOUT), scr, r, lane, F.in(12), F.in(13), LRUW); continue; } r -= I_D;
        if (r < I_D) { p0_transpose_item(F.in(17), DM, DM, F.wsp<bf16>(WS_WQ), scr, r, lane, F.in(15), F.in(15), DM); continue; } r -= I_D;
        if (r < I_2D) { p0_transpose_item(F.in(18), DM, 2 * DM, F.wsp<bf16>(WS_WKV), scr, r, lane, nullptr, nullptr, 0); continue; } r -= I_2D;
        if (r < I_D) { p0_transpose_item(F.in(19), DM, DM, F.wsp<bf16>(WS_WO), scr, r, lane, nullptr, nullptr, 0); continue; } r -= I_D;
        p0_transpose_item(F.in(21), DM, 2 * DM, F.wsp<bf16>(WS_WQRY), scr, r, lane, F.in(20), F.in(20), DM);
    }
    for (int m = gw * 4; m < M; m += NGW * 4) rows_to_bf16<true, 4>(F.in(0) + (size_t)m * DM, F.wsp<bf16>(WS_XN) + (size_t)m * DM, DM, nullptr, lane);
    for (int m = gw; m < NBATCH * 256; m += NGW) row_to_bf16<true>(F.in(1) + (size_t)m * DM, F.wsp<bf16>(WS_MEMN) + (size_t)m * DM, F.in(16), lane);
    { const int gt = gw * 64 + lane, NT = NGW * 64;
      for (int i = gt; i < 8 * 2 * 128 * 128 / 4; i += NT) { const f32x4 v = ((const GAS f32x4*)F.in(22))[i]; v2u o; o.x = pk2(v.x, v.y); o.y = pk2(v.z, v.w); ((GAS v2u*)F.wsp<bf16>(WS_SUBK))[i] = o; }
      for (int o = gt; o < 2 * 8 * 64 * 64; o += NT) { const int i = o & 63, j = (o >> 6) & 63, h = (o >> 12) & 7, g = o >> 15;
          const float* W = g ? F.in(8) : F.in(6); F.wsp<bf16>(WS_GATEW)[o] = f2bf(W[(h * 64 + i) * 64 + j]); } }
}
struct LruState { float ba[2], bx[2], sp[2], S[2], Ap[2]; };
template <bool PASS2>
DI void lru_prep(const Frame& F, int b, int chunk, int h, int lane, LAS unsigned char* xcs  , LruState& st) {
    const int r = lane & 31, hh = lane >> 5;
    const size_t row0 = (size_t)b * SEQ + (size_t)chunk * 64;
    {
        const int c2 = h * 64 + 2 * r;
        const f32x2 w0 = *(const f32x2*)(F.in(4) + c2), w1 = *(const f32x2*)(F.in(4) + LRUW + c2), w2 = *(const f32x2*)(F.in(4) + 2 * LRUW + c2), w3 = *(const f32x2*)(F.in(4) + 3 * LRUW + c2);
        const f32x2 cb = *(const f32x2*)(F.in(5) + c2);
        const int tl0 = 32 * hh;
        const bf16* zp = F.wsp<bf16>(WS_Z) + (row0 + tl0) * ZW + c2;
        const bool first = (chunk == 0 && hh == 0);
        unsigned p0 = first ? 0u : *(const unsigned*)(zp - 3 * ZW), p1 = first ? 0u : *(const unsigned*)(zp - 2 * ZW), p2 = first ? 0u : *(const unsigned*)(zp - ZW);
#pragma unroll 8
        for (int t = 0; t < 32; ++t) { const unsigned p3 = *(const unsigned*)(zp + (size_t)t * ZW);
            const float lo = cb.x + bflo(p0) * w0.x + bflo(p1) * w1.x + bflo(p2) * w2.x + bflo(p3) * w3.x;
            const float hi = cb.y + bfhi(p0) * w0.y + bfhi(p1) * w1.y + bfhi(p2) * w2.y + bfhi(p3) * w3.y;
            *(LAS unsigned*)(xcs + (tl0 + t) * 144 + 4 * r) = pk2(lo, hi);
            p0 = p1; p1 = p2; p2 = p3; }
        LDS_WAIT();
    }
#pragma unroll
    for (int nt = 0; nt < 2; ++nt) { const int c = h * 64 + 32 * nt + r; st.ba[nt] = F.in(7)[c]; st.bx[nt] = F.in(9)[c];
        const float nl = -F.in(10)[c]; st.sp[nt] = fmaxf(nl, 0.f) + log1pf(__expf(-fabsf(nl))); st.S[nt] = 0.f; st.Ap[nt] = 1.f; }
    if (PASS2) {
        float s = 0.f; const float* ag = F.wsp<float>(WS_AGG) + ((size_t)b * NCHUNK * LRUW + h * 64 + lane) * 2;
#pragma unroll 8
        for (int c = 0; c < chunk; ++c) { const f32x2 ab = *(const f32x2*)(ag + (size_t)c * LRUW * 2); s = ab.x * s + ab.y; }
        st.S[0] = __shfl(s, r); st.S[1] = __shfl(s, 32 + r);
    }
}
template <bool PASS2>
DI void lru_tile(const Frame& F, int b, int chunk, int mt, int h, int lane, LAS unsigned char* xcs, LAS unsigned char* gim  , LruState& st, float (&ssq)[16]) {
    const int r = lane & 31, hh = lane >> 5;
    const size_t row0 = (size_t)b * SEQ + (size_t)chunk * 64;
    const bf16* gw = F.wsp<bf16>(WS_GATEW) + (size_t)h * 4096;
    bf16x8 af[4];
#pragma unroll
    for (int s = 0; s < 4; ++s) af[s] = *(const LAS bf16x8*)(xcs + (32 * mt + r) * 144 + (16 * s + 8 * hh) * 2);
    float ssl[16];
#pragma unroll
    for (int i = 0; i < 16; ++i) ssl[i] = 0.f;
    if (PASS2) {
#pragma unroll
        for (int i = 0; i < 4; ++i) { const int row = (lane >> 3) + 8 * i, c = lane & 7;
            *(LAS v4u*)(gim + row * 144 + c * 16) = *(const v4u*)(F.wsp<bf16>(WS_Z) + (row0 + 32 * mt + row) * ZW + LRUW + h * 64 + 8 * c); }
        LDS_WAIT();
    }
#pragma unroll
    for (int nt = 0; nt < 2; ++nt) {
        asm volatile("" ::: "memory");
        f32x16 aa = {}, ax = {};
#pragma unroll
        for (int s = 0; s < 4; ++s) {
            const bf16x8 wa = *(const bf16x8*)(gw + (size_t)(32 * nt + r) * 64 + 16 * s + 8 * hh);
            const bf16x8 wx = *(const bf16x8*)(gw + 32768 + (size_t)(32 * nt + r) * 64 + 16 * s + 8 * hh);
            aa = MFMA32(af[s], wa, aa); ax = MFMA32(af[s], wx, ax);
        }
#pragma unroll
        for (int i = 0; i < 16; ++i) {
            const float rg = sigmoidf_(aa[i] + st.ba[nt]), ig = sigmoidf_(ax[i] + st.bx[nt]);
            const float la = -8.0f * rg * st.sp[nt];
            const float a = exp2_(LOG2E * la);
            const float mult = __builtin_amdgcn_sqrtf(fmaxf(1.0f - a * a, 0.f));
            const float xc = bf2f(*(const LAS bf16*)(xcs + (32 * mt + crow(i, hh)) * 144 + (32 * nt + r) * 2));
            aa[i] = a; ax[i] = mult * ig * xc;
        }
        float Ao[4], Bo[4], Aq[4], Bq[4], Sin[4];
#pragma unroll
        for (int q = 0; q < 4; ++q) { const float a0 = aa[4 * q], a1 = aa[4 * q + 1], a2 = aa[4 * q + 2], a3 = aa[4 * q + 3];
            Ao[q] = (a0 * a1) * (a2 * a3); Bo[q] = ((ax[4 * q] * a1 + ax[4 * q + 1]) * a2 + ax[4 * q + 2]) * a3 + ax[4 * q + 3];
            Aq[q] = swap32_partner(Ao[q], hh); Bq[q] = swap32_partner(Bo[q], hh); }
        float s_ = st.S[nt];
#pragma unroll
        for (int q = 0; q < 4; ++q) { const float A1 = hh ? Aq[q] : Ao[q], B1 = hh ? Bq[q] : Bo[q], A2 = hh ? Ao[q] : Aq[q], B2 = hh ? Bo[q] : Bq[q];
            const float smid = A1 * s_ + B1; Sin[q] = hh ? smid : s_; s_ = A2 * smid + B2; st.Ap[nt] *= A1 * A2; }
        st.S[nt] = s_;
        if (PASS2) {
#pragma unroll
            for (int q = 0; q < 4; ++q) { float hp = Sin[q];
#pragma unroll
                for (int e = 0; e < 4; ++e) { const int i = 4 * q + e; hp = aa[i] * hp + ax[i];
                    const float gt = bf2f(*(const LAS bf16*)(gim + crow(i, hh) * 144 + (32 * nt + r) * 2));
                    const float y = hp * gelu_tanh(gt); ssl[i] += y * y;
                    *(LAS bf16*)(xcs + (32 * mt + crow(i, hh)) * 144 + (32 * nt + r) * 2) = f2bf(y); } }
        }
    }
    if (PASS2) {
#pragma unroll
        for (int i = 0; i < 16; ++i) ssq[i] = sum32(ssl[i]);
    }
}
constexpr int ATT_KST = 144, ATT_VST = 136, ATT_KBYTES = 64 * ATT_KST, ATT_VBYTES = 64 * ATT_VST;
DI void attn_wave(const Frame& F, int b, int n, int qt, int h, int lane, const LAS float* tab, LAS unsigned char* kl  , f32x16 (&o)[2]) {
    const int r = lane & 31, hh = lane >> 5;
    LAS unsigned char* vl = kl + ATT_KBYTES;
    const size_t row0 = (size_t)b * SEQ + (size_t)n * 64;
    const float SC = 0.125f * LOG2E;
    bf16x8 qf[4];
#pragma unroll
    for (int s = 0; s < 4; ++s) qf[s] = *(const bf16x8*)(F.wsp<bf16>(WS_Z) + (row0 + 32 * qt + r) * ZW + 2 * LRUW + h * 64 + 16 * s + 8 * hh);
    float mrun = -1e30f, lrun = 0.f;
#pragma unroll
    for (int dt = 0; dt < 2; ++dt) o[dt] = f32x16{};
    const float bfar = tab[256];
    const int srow = lane >> 3, sc8 = lane & 7;
    const int kc0 = (n >= 8 ? n - 8 : 0);
    const char* kg = (const char*)(F.wsp<bf16>(WS_Z) + (size_t)b * SEQ * ZW + 2 * LRUW + ATTW + h * 64);
    const char* vg = (const char*)(F.wsp<bf16>(WS_VT) + (size_t)(b * 8 + h) * 64 * SEQ);
    const unsigned kof = (unsigned)(srow * ZW + 8 * sc8) * 2u, vof = (unsigned)(srow * SEQ + 8 * sc8) * 2u;
    v4u kreg[8];
#pragma unroll
    for (int i = 0; i < 8; ++i) kreg[i] = *(const v4u*)(kg + ((size_t)kc0 * 64 + 8 * i) * ZW * 2 + kof);
    for (int kc = kc0; kc <= n; ++kc) {
        const int dd = n - kc;
        v4u vreg[8];
#pragma unroll
        for (int i = 0; i < 8; ++i) { *(LAS v4u*)(kl + (srow + 8 * i) * ATT_KST + sc8 * 16) = kreg[i]; vreg[i] = *(const v4u*)(vg + ((size_t)(8 * i) * SEQ + kc * 64) * 2 + vof); }
        f32x16 sc[2];
#pragma unroll
        for (int kt = 0; kt < 2; ++kt) { sc[kt] = f32x16{};
#pragma unroll
            for (int s = 0; s < 4; ++s) { const bf16x8 kf = *(const LAS bf16x8*)(kl + (32 * kt + r) * ATT_KST + (16 * s + 8 * hh) * 2); sc[kt] = MFMA32(kf, qf[s], sc[kt]); } }
        if (dd >= 3) {
#pragma unroll
            for (int kt = 0; kt < 2; ++kt)
#pragma unroll
                for (int i = 0; i < 16; ++i) sc[kt][i] = sc[kt][i] * SC + bfar;
        } else {
            const int base = 64 * dd + 32 * qt + r + 128;
#pragma unroll
            for (int kt = 0; kt < 2; ++kt)
#pragma unroll
                for (int i = 0; i < 16; ++i) { int idx = base - (32 * kt + crow(i, hh)); idx = idx > 256 ? 256 : idx; sc[kt][i] = sc[kt][i] * SC + tab[idx]; }
        }
        float mx = sc[0][0];
#pragma unroll
        for (int kt = 0; kt < 2; ++kt)
#pragma unroll
            for (int i = 0; i < 16; ++i) mx = fmaxf(mx, sc[kt][i]);
        mx = fmaxf(mx, swap32_partner(mx, hh));
        const float mnew = fmaxf(mrun, mx), alpha = exp2_(mrun - mnew);
        float ls = 0.f;
#pragma unroll
        for (int kt = 0; kt < 2; ++kt)
#pragma unroll
            for (int i = 0; i < 16; ++i) { const float p = exp2_(sc[kt][i] - mnew); sc[kt][i] = p; ls += p; }
        lrun = lrun * alpha + ls; mrun = mnew;
#pragma unroll
        for (int dt = 0; dt < 2; ++dt)
#pragma unroll
            for (int i = 0; i < 16; ++i) o[dt][i] *= alpha;
#pragma unroll
        for (int i = 0; i < 8; ++i) { LAS v2u* vd = (LAS v2u*)(vl + (srow + 8 * i) * ATT_VST + sc8 * 16); vd[0] = (v2u){vreg[i].x, vreg[i].y}; vd[1] = (v2u){vreg[i].z, vreg[i].w}; }
        if (kc < n) {
#pragma unroll
            for (int i = 0; i < 8; ++i) kreg[i] = *(const v4u*)(kg + ((size_t)(kc + 1) * 64 + 8 * i) * ZW * 2 + kof);
        }
#pragma unroll
        for (int kt = 0; kt < 2; ++kt)
#pragma unroll
            for (int s2 = 0; s2 < 2; ++s2) { v4u w; w.x = pk2(sc[kt][8 * s2], sc[kt][8 * s2 + 1]); w.y = pk2(sc[kt][8 * s2 + 2], sc[kt][8 * s2 + 3]); w.z = pk2(sc[kt][8 * s2 + 4], sc[kt][8 * s2 + 5]); w.w = pk2(sc[kt][8 * s2 + 6], sc[kt][8 * s2 + 7]);
                const bf16x8 pf = __builtin_bit_cast(bf16x8, w);
#pragma unroll
                for (int dt = 0; dt < 2; ++dt) { const LAS unsigned char* vp = vl + (32 * dt + r) * ATT_VST + (32 * kt + 16 * s2 + 4 * hh) * 2;
                    const v2u lo = *(const LAS v2u*)vp, hi = *(const LAS v2u*)(vp + 16); v4u vw; vw.x = lo.x; vw.y = lo.y; vw.z = hi.x; vw.w = hi.y;
                    o[dt] = MFMA32(__builtin_bit_cast(bf16x8, vw), pf, o[dt]); } }
    }
    const float lt = lrun + swap32_partner(lrun, hh); const float inv = rcp_(lt);
#pragma unroll
    for (int dt = 0; dt < 2; ++dt)
#pragma unroll
        for (int i = 0; i < 16; ++i) o[dt][i] *= inv;
}

DI void p2_lru_aggregates(Frame& F) {
    const int lane = F.lane, r = lane & 31, hh = lane >> 5, h = F.wave;
    LAS unsigned char* xcs = F.lds + 12288 + h * 17920;
    for (int u = F.vcu; u < NBATCH * NCHUNK; u += F.G) {
        const int b = u / NCHUNK, n = u % NCHUNK;
        LruState st; float ssq[16];
        lru_prep<false>(F, b, n, h, lane, xcs, st);
#pragma unroll 1
        for (int mt = 0; mt < 2; ++mt) lru_tile<false>(F, b, n, mt, h, lane, xcs, xcs + 9216, st, ssq);
        if (hh == 0) {
#pragma unroll
            for (int nt = 0; nt < 2; ++nt) *(f32x2*)(F.wsp<float>(WS_AGG) + (((size_t)b * NCHUNK + n) * LRUW + h * 64 + 32 * nt + r) * 2) = (f32x2){st.Ap[nt], st.S[nt]};
        }
        LDS_WAIT();
    }
}
DI void p3_mixer(Frame& F, int parts = 3) {
    const int lane = F.lane, r = lane & 31, hh = lane >> 5, h = F.wave;
    LAS float* ssx = (LAS float*)(F.lds);
    LAS float* tab = (LAS float*)(F.lds + 2048 + h * 1280);
    LAS unsigned* stg = (LAS unsigned*)(F.lds + 12288 + h * 17920);
    for (int i = lane; i < 257; i += 64) tab[i] = F.in(11)[h * 257 + i] * LOG2E;
    LDS_WAIT();
    for (int u = F.vcu; u < NBATCH * NCHUNK; u += F.G) {
        const int b = u / NCHUNK, n = u % NCHUNK; const size_t row0 = (size_t)b * SEQ + (size_t)n * 64;
#ifndef MIX_PARTS
#define MIX_PARTS 3
#endif
        if (parts & 1) {
            LruState st;
            lru_prep<true>(F, b, n, h, lane, (LAS unsigned char*)stg, st);
#pragma unroll 1
            for (int mt = 0; mt < 2; ++mt) {
                float ssq[16];
                lru_tile<true>(F, b, n, mt, h, lane, (LAS unsigned char*)stg, (LAS unsigned char*)stg + 9216, st, ssq);
                if (r == 0) {
#pragma unroll
                    for (int i = 0; i < 16; ++i) ssx[crow(i, hh) * 8 + h] = ssq[i];
                }
                __syncthreads();
                const LAS unsigned char* yst = (const LAS unsigned char*)stg + 32 * mt * 144;
#pragma unroll
                for (int i = 0; i < 4; ++i) { const int row = (lane >> 3) + 8 * i, c = lane & 7;
                    const f32x4 s0 = *(const LAS f32x4*)(ssx + row * 8), s1 = *(const LAS f32x4*)(ssx + row * 8 + 4);
                    const float rs = rsq_(((s0.x + s0.y) + (s0.z + s0.w) + (s1.x + s1.y) + (s1.z + s1.w)) * (1.f / 512.f) + EPS);
                    const v4u v = *(const LAS v4u*)(yst + row * 144 + c * 16);
                    v4u o; o.x = pk2(bflo(v.x) * rs, bfhi(v.x) * rs); o.y = pk2(bflo(v.y) * rs, bfhi(v.y) * rs); o.z = pk2(bflo(v.z) * rs, bfhi(v.z) * rs); o.w = pk2(bflo(v.w) * rs, bfhi(v.w) * rs);
                    *(v4u*)(F.wsp<bf16>(WS_Y) + (row0 + 32 * mt + row) * DM + h * 64 + 8 * c) = o; }
                __syncthreads();
            }
        }
    }
    for (int u = F.vcu; u < NBATCH * NCHUNK; u += F.G) {
        const int b = u / NCHUNK, n = u % NCHUNK; const size_t row0 = (size_t)b * SEQ + (size_t)n * 64;
#pragma unroll 1
        for (int qt = 0; qt < ((parts & 2) ? 2 : 0); ++qt) {
            f32x16 o[2];
            attn_wave(F, b, n, qt, h, lane, tab, (LAS unsigned char*)stg, o);
            float s = 0.f;
#pragma unroll
            for (int dt = 0; dt < 2; ++dt)
#pragma unroll
                for (int i = 0; i < 16; ++i) s += o[dt][i] * o[dt][i];
            s += swap32_partner(s, hh);
            if (hh == 0) ssx[r * 8 + h] = s;
            __syncthreads();
            { const f32x4 s0 = *(const LAS f32x4*)(ssx + r * 8), s1 = *(const LAS f32x4*)(ssx + r * 8 + 4);
              const float rs = rsq_(((s0.x + s0.y) + (s0.z + s0.w) + (s1.x + s1.y) + (s1.z + s1.w)) * (1.f / 512.f) + EPS);
#pragma unroll
              for (int dt = 0; dt < 2; ++dt)
#pragma unroll
                  for (int i = 0; i < 16; i += 2) stg[r * 33 + ((32 * dt + crow(i, hh)) >> 1)] = pk2(o[dt][i] * rs, o[dt][i + 1] * rs); }
            LDS_WAIT();
#pragma unroll 4
            for (int i = 0; i < 16; ++i) { const int row = 2 * i + hh; const unsigned v = stg[row * 33 + r];
                *(GAS unsigned*)(F.wsp<bf16>(WS_Y) + (row0 + 32 * qt + row) * DM + LRUW + h * 64 + 2 * r) = v; }
            __syncthreads();
        }
    }
}
DI void p5_cross(Frame& F, const pg8::StaticOrder& S) {
    const int lane = F.lane, r = lane & 31, hh = lane >> 5, w = F.wave, tid = F.tid;
    constexpr int KST = 528, VST = 520;
    const float SC = 0.0625f * LOG2E;
    pg8::Unit un;
    for (int ui = 0; S.next(ui, un); ++ui) {
        const int b = un.pm >> 5, qb = un.pm & 31, hm = un.pn;
        const size_t qrow = (size_t)b * SEQ + (size_t)qb * 256 + 32 * w + r;
        { const bf16* src = F.wsp<bf16>(WS_KM) + (size_t)(b * 256) * DM + hm * 256;
#pragma unroll 4
          for (int i = 0; i < 16; ++i) { const int c = i * 512 + tid, row = c >> 5, ch = c & 31;
              *(LAS v4u*)(F.lds + row * KST + ch * 16) = *(const v4u*)(src + (size_t)row * DM + ch * 8); } }
        __syncthreads();
        f32x16 sc[8];
#pragma unroll
        for (int kt = 0; kt < 8; ++kt) sc[kt] = f32x16{};
#pragma unroll 2
        for (int s = 0; s < 16; ++s) {
            const bf16x8 qf = *(const bf16x8*)(F.wsp<bf16>(WS_QC) + qrow * DM + hm * 256 + 16 * s + 8 * hh);
#pragma unroll
            for (int kt = 0; kt < 8; ++kt) { const bf16x8 kf = *(const LAS bf16x8*)(F.lds + (32 * kt + r) * KST + (16 * s + 8 * hh) * 2); sc[kt] = MFMA32(kf, qf, sc[kt]); }
        }
        float mx = sc[0][0];
#pragma unroll
        for (int kt = 0; kt < 8; ++kt)
#pragma unroll
            for (int i = 0; i < 16; ++i) mx = fmaxf(mx, sc[kt][i]);
        mx = fmaxf(mx, swap32_partner(mx, hh));
        float ls = 0.f; const float mo = mx * SC;
        bf16x8 pf[8][2];
#pragma unroll
        for (int kt = 0; kt < 8; ++kt) {
#pragma unroll
            for (int i = 0; i < 16; ++i) { const float p = exp2_(sc[kt][i] * SC - mo); sc[kt][i] = p; ls += p; }
#pragma unroll
            for (int s2 = 0; s2 < 2; ++s2) { v4u wv; wv.x = pk2(sc[kt][8 * s2], sc[kt][8 * s2 + 1]); wv.y = pk2(sc[kt][8 * s2 + 2], sc[kt][8 * s2 + 3]); wv.z = pk2(sc[kt][8 * s2 + 4], sc[kt][8 * s2 + 5]); wv.w = pk2(sc[kt][8 * s2 + 6], sc[kt][8 * s2 + 7]);
                pf[kt][s2] = __builtin_bit_cast(bf16x8, wv); }
        }
        ls += swap32_partner(ls, hh);
        const float inv = 1.0f / ls;
        __syncthreads();
        { const bf16* src = F.wsp<bf16>(WS_VMT) + (size_t)((b * 4 + hm) * 256) * 256;
#pragma unroll 4
          for (int i = 0; i < 16; ++i) { const int c = i * 512 + tid, row = c >> 5, ch = c & 31; const v4u v = *(const v4u*)(src + (size_t)row * 256 + ch * 8);
              LAS v2u* d = (LAS v2u*)(F.lds + row * VST + ch * 16); d[0] = (v2u){v.x, v.y}; d[1] = (v2u){v.z, v.w}; } }
        __syncthreads();
        LAS unsigned* stg = (LAS unsigned*)(F.lds) ;
#pragma unroll
        for (int half = 0; half < 2; ++half) {
            f32x16 o[4];
#pragma unroll
            for (int dt = 0; dt < 4; ++dt) o[dt] = f32x16{};
#pragma unroll
            for (int kt = 0; kt < 8; ++kt)
#pragma unroll
                for (int s2 = 0; s2 < 2; ++s2)
#pragma unroll
                    for (int dt = 0; dt < 4; ++dt) { const LAS unsigned char* p = F.lds + (128 * half + 32 * dt + r) * VST + (32 * kt + 16 * s2 + 4 * hh) * 2;
                        const v2u lo = *(const LAS v2u*)p, hi = *(const LAS v2u*)(p + 16); v4u wv; wv.x = lo.x; wv.y = lo.y; wv.z = hi.x; wv.w = hi.y;
                        o[dt] = MFMA32(__builtin_bit_cast(bf16x8, wv), pf[kt][s2], o[dt]); }
            if (half == 1) __syncthreads();
            else {   }
            if (half == 0) {
#pragma unroll
                for (int dt = 0; dt < 4; ++dt)
#pragma unroll
                    for (int i = 0; i < 16; i += 2) { const unsigned pv = pk2(o[dt][i] * inv, o[dt][i + 1] * inv); sc[dt][i >> 1] = __uint_as_float(pv); }
            } else {
                LAS unsigned* sw = (LAS unsigned*)(F.lds + w * 16512);
#pragma unroll
                for (int dt = 0; dt < 4; ++dt)
#pragma unroll
                    for (int i = 0; i < 16; i += 2) { sw[r * 129 + ((32 * dt + crow(i, hh)) >> 1)] = __float_as_uint(sc[dt][i >> 1]);
                        sw[r * 129 + 64 + ((32 * dt + crow(i, hh)) >> 1)] = pk2(o[dt][i] * inv, o[dt][i + 1] * inv); }
                LDS_WAIT();
#pragma unroll 4
                for (int i = 0; i < 32; ++i) { const unsigned v0 = sw[i * 129 + lane], v1 = sw[i * 129 + 64 + lane];
                    GAS unsigned* dst = (GAS unsigned*)(F.wsp<bf16>(WS_OC) + ((size_t)b * SEQ + (size_t)qb * 256 + 32 * w + i) * DM + hm * 256);
                    dst[lane] = v0; dst[64 + lane] = v1; }
            }
        }
        (void)stg;
        __syncthreads();
    }
}
template <int N> DI void ce_desc(float (&a)[N], int i, int l) { const float hi = fmaxf(a[i], a[l]), lo = fminf(a[i], a[l]); a[i] = hi; a[l] = lo; }
template <int N, int OFF> DI void bitonic_sort16_desc(float (&a)[N]) {
#pragma unroll
    for (int k = 2; k <= 16; k <<= 1)
#pragma unroll
        for (int j = k >> 1; j > 0; j >>= 1)
#pragma unroll
            for (int i = 0; i < 16; ++i) { const int l = i ^ j; if (l > i) { const bool desc = ((i & k) == 0) || (k == 16);
                if (desc) ce_desc<N>(a, OFF + i, OFF + l); else ce_desc<N>(a, OFF + l, OFF + i); } }
}
template <int N, int OFF> DI void bitonic_merge16_desc(float (&a)[N]) {
#pragma unroll
    for (int j = 8; j > 0; j >>= 1)
#pragma unroll
        for (int i = 0; i < 16; ++i) { const int l = i ^ j; if (l > i) ce_desc<N>(a, OFF + i, OFF + l); }
}
template <bool SORTED> DI void top16_of_64(float (&a)[64]) {
    bitonic_sort16_desc<64, 0>(a); bitonic_sort16_desc<64, 16>(a); bitonic_sort16_desc<64, 32>(a); bitonic_sort16_desc<64, 48>(a);
#pragma unroll
    for (int i = 0; i < 16; ++i) { a[i] = fmaxf(a[i], a[31 - i]); a[32 + i] = fmaxf(a[32 + i], a[63 - i]); }
    bitonic_merge16_desc<64, 0>(a); bitonic_merge16_desc<64, 32>(a);
#pragma unroll
    for (int i = 0; i < 16; ++i) a[i] = fmaxf(a[i], a[47 - i]);
    if (SORTED) bitonic_merge16_desc<64, 0>(a);
}
DI void p8a_topk(Frame& F, const pg8::StaticOrder& S) {
    const int lane = F.lane, r = lane & 31, hh = lane >> 5, w = F.wave;
    LAS float* tbl = (LAS float*)(F.lds + w * 8192);
    pg8::Unit un;
    for (int ui = 0; S.next(ui, un); ++ui) {
        const int h = un.pn; const size_t tok = (size_t)un.pm * 256 + 32 * w + r;
        float v[2][16];
#pragma unroll
        for (int p = 0; p < 2; ++p) {
            f32x16 sc[4];
#pragma unroll
            for (int nt = 0; nt < 4; ++nt) sc[nt] = f32x16{};
            const bf16* sk = F.wsp<bf16>(WS_SUBK) + (size_t)((h * 2 + p) * 128) * 128;
#pragma unroll 2
            for (int s = 0; s < 8; ++s) { const bf16x8 qf = *(const bf16x8*)(F.wsp<bf16>(WS_QP) + tok * 2048 + h * 256 + p * 128 + 16 * s + 8 * hh);
#pragma unroll
                for (int nt = 0; nt < 4; ++nt) { const bf16x8 kf = *(const bf16x8*)(sk + (size_t)(32 * nt + r) * 128 + 16 * s + 8 * hh); sc[nt] = MFMA32(kf, qf, sc[nt]); } }
            float a[64];
#pragma unroll
            for (int nt = 0; nt < 4; ++nt)
#pragma unroll
                for (int i = 0; i < 16; ++i) a[nt * 16 + i] = __uint_as_float((__float_as_uint(sc[nt][i]) & ~127u) | (unsigned)(32 * nt + crow(i, hh)));
            top16_of_64<true>(a);
            float m[16];
#pragma unroll
            for (int i = 0; i < 16; ++i) m[i] = fmaxf(a[i], swap32_partner(a[15 - i], hh));
            bitonic_merge16_desc<16, 0>(m);
#pragma unroll
            for (int i = 0; i < 16; ++i) v[p][i] = m[i];
        }
        float c[64]; int n = 0;
#pragma unroll
        for (int i = 0; i < 16; ++i)
#pragma unroll
            for (int j = 0; j < 16; ++j) if ((i + 1) * (j + 1) <= 16) { c[n] = __uint_as_float((__float_as_uint(v[0][i] + v[1][j]) & ~255u) | (unsigned)((i << 4) | j)); ++n; }
#pragma unroll
        for (int k = 50; k < 64; ++k) c[k] = -3.0e38f;
        top16_of_64<false>(c);
#pragma unroll
        for (int i = 0; i < 16; ++i) { tbl[i * 64 + lane] = v[0][i]; tbl[(16 + i) * 64 + lane] = v[1][i]; }
        LDS_WAIT();
        float sv[16]; int ev[16]; float mx = -3.0e38f;
#pragma unroll
        for (int k = 0; k < 16; ++k) { const unsigned pl = __float_as_uint(c[k]) & 255u; const float a1 = tbl[(pl >> 4) * 64 + lane], a2 = tbl[(16 + (pl & 15)) * 64 + lane];
            sv[k] = a1 + a2; ev[k] = (int)(((__float_as_uint(a1) & 127u) << 7) | (__float_as_uint(a2) & 127u)); mx = fmaxf(mx, sv[k]); }
        float sum = 0.f;
#pragma unroll
        for (int k = 0; k < 16; ++k) { sv[k] = __expf(sv[k] - mx); sum += sv[k]; }
        const float inv = 1.0f / sum;
        if (hh == 0) {
#pragma unroll
            for (int k = 0; k < 16; k += 4) *(v4u*)(F.wsp<int>(WS_IDX) + tok * NSEL + h * 16 + k) = (v4u){(unsigned)ev[k], (unsigned)ev[k + 1], (unsigned)ev[k + 2], (unsigned)ev[k + 3]};
        } else {
#pragma unroll
            for (int k = 0; k < 16; k += 4) *(f32x4*)(F.wsp<float>(WS_G) + tok * NSEL + h * 16 + k) = (f32x4){sv[k] * inv, sv[k + 1] * inv, sv[k + 2] * inv, sv[k + 3] * inv};
        }
        LDS_WAIT();
    }
}
typedef _Float16 f16x2_t __attribute__((ext_vector_type(2)));
DI int dot16_i8(const v4u& u, const unsigned (&x)[4]) {
    const unsigned u0 = u.x, u1 = u.y, u2 = u.z, u3 = u.w;
    int a = 0;
    a = __builtin_amdgcn_sdot4((int)u0, (int)x[0], a, false); a = __builtin_amdgcn_sdot4((int)u1, (int)x[1], a, false);
    a = __builtin_amdgcn_sdot4((int)u2, (int)x[2], a, false); a = __builtin_amdgcn_sdot4((int)u3, (int)x[3], a, false);
    return a;
}
DI void axpy32_v6(f16x2_t (&o)[16], float w, const v4u a, unsigned b4, unsigned b5) {
    const v6u pk = {a.x, a.y, a.z, a.w, b4, b5};
    const v32h h = __builtin_amdgcn_cvt_scalef32_pk32_f16_fp6(pk, 1.0f);
    const f16x2_t w2 = {(_Float16)w, (_Float16)w};
#pragma unroll
    for (int i = 0; i < 16; ++i) { const f16x2_t hv = {h[2 * i], h[2 * i + 1]}; o[i] = __builtin_elementwise_fma(hv, w2, o[i]); }
}
constexpr int TPW = 4, NSLICE = 16, SLICE_SHIFT = 10, NPAIR = TPW * NSEL, NPAIR_PAD = NPAIR + 1 * TPW * NSLICE + 32;
constexpr int PEER_LDS_PER_WAVE = TPW * 1024 + 64 + TPW * 2048 + NPAIR_PAD * 4;
static_assert(PEER_LDS_PER_WAVE * NWAVES <= RING_BYTES, "PEER LDS");
DI int incl_scan64(int v, int lane) {
    int s = v;
#pragma unroll
    for (int d = 1; d < 64; d <<= 1) { const int t = __shfl_up(s, d); if (lane >= d) s += t; }
    return s;
}
struct PeerBatch { v4u uu[4]; v4u va[2]; unsigned vb4[2], vb5[2]; unsigned ent[4]; float su[4], sv[4]; };
DI void peer_load_batch(PeerBatch& B, const LAS unsigned* ml, int i, const unsigned char* EU8, const unsigned char* EV8, const float* SU, int lane, unsigned emask = 0x3fffu) {
    const v4u e4 = *(const LAS v4u*)(ml + i);
    B.ent[0] = (unsigned)__builtin_amdgcn_readfirstlane((int)e4.x); B.ent[1] = (unsigned)__builtin_amdgcn_readfirstlane((int)e4.y);
    B.ent[2] = (unsigned)__builtin_amdgcn_readfirstlane((int)e4.z); B.ent[3] = (unsigned)__builtin_amdgcn_readfirstlane((int)e4.w);
    const int l5 = lane & 31, hh = lane >> 5;
#pragma unroll
    for (int k = 0; k < 4; ++k) { const unsigned e = B.ent[k] & emask; const unsigned char* ur = EU8 + (size_t)e * DM;
        B.uu[k] = *(const v4u*)(ur + (unsigned)(16 * lane)); B.su[k] = SU[e]; B.sv[k] = SU[NEXP + e]; }
#pragma unroll
    for (int q = 0; q < 2; ++q) { const unsigned e0 = B.ent[2 * q] & emask, e1 = B.ent[2 * q + 1] & emask; const unsigned e = e0 + (unsigned)hh * (e1 - e0);
        const unsigned off = e * (unsigned)EV_ROW; B.va[q] = *(const v4u*)(EV8 + off + (unsigned)(16 * l5)); const v2u t2 = *(const v2u*)(EV8 + off + (unsigned)(512 + 8 * l5)); B.vb4[q] = t2.x; B.vb5[q] = t2.y; }
}
struct PeerState { unsigned x[4]; float sx; f16x2_t oc[16]; int curj; };
DI void peer_flush(PeerState& S, LAS unsigned char* ol, int lane) {
    LAS v4u* r = (LAS v4u*)(ol + S.curj * 2048 + 64 * (lane & 31) + 32 * (lane >> 5));
    unsigned mine[8];
#pragma unroll
    for (int i = 0; i < 8; ++i) { auto rr = __builtin_amdgcn_permlane32_swap(__builtin_bit_cast(unsigned, S.oc[i]), __builtin_bit_cast(unsigned, S.oc[8 + i]), false, false);
        mine[i] = __builtin_bit_cast(unsigned, __builtin_bit_cast(f16x2_t, (unsigned)rr[0]) + __builtin_bit_cast(f16x2_t, (unsigned)rr[1])); }
#pragma unroll
    for (int c = 0; c < 2; ++c) { const v4u v = r[c]; v4u o;
        o.x = __builtin_bit_cast(unsigned, __builtin_bit_cast(f16x2_t, (unsigned)v.x) + __builtin_bit_cast(f16x2_t, mine[4 * c])); o.y = __builtin_bit_cast(unsigned, __builtin_bit_cast(f16x2_t, (unsigned)v.y) + __builtin_bit_cast(f16x2_t, mine[4 * c + 1]));
        o.z = __builtin_bit_cast(unsigned, __builtin_bit_cast(f16x2_t, (unsigned)v.z) + __builtin_bit_cast(f16x2_t, mine[4 * c + 2])); o.w = __builtin_bit_cast(unsigned, __builtin_bit_cast(f16x2_t, (unsigned)v.w) + __builtin_bit_cast(f16x2_t, mine[4 * c + 3]));
        r[c] = o; }
#pragma unroll
    for (int i = 0; i < 16; ++i) S.oc[i] = (f16x2_t){(_Float16)0.f, (_Float16)0.f};
}
DI void peer_compute_batch(const PeerBatch& B, PeerState& S, LAS unsigned char* ol, const LAS unsigned char* xl, int lane) {
    const int jA = (int)((B.ent[0] >> 14) & 3u), jB = (int)((B.ent[2] >> 14) & 3u);
    if (jA != S.curj) {
        if (S.curj >= 0) peer_flush(S, ol, lane);
        S.curj = jA;
        const v4u y0 = ((const LAS v4u*)(xl + jA * 1024))[lane];
        S.x[0] = y0.x; S.x[1] = y0.y; S.x[2] = y0.z; S.x[3] = y0.w; S.sx = ((const LAS float*)(xl + TPW * 1024))[jA]; }
    unsigned xb[4] = {S.x[0], S.x[1], S.x[2], S.x[3]}; float sxb = S.sx;
    if (jB != jA) { const v4u y0 = ((const LAS v4u*)(xl + jB * 1024))[lane]; xb[0] = y0.x; xb[1] = y0.y; xb[2] = y0.z; xb[3] = y0.w; sxb = ((const LAS float*)(xl + TPW * 1024))[jB]; }
    const float d0 = (float)dot16_i8(B.uu[0], S.x) * B.su[0], d1 = (float)dot16_i8(B.uu[1], S.x) * B.su[1], d2 = (float)dot16_i8(B.uu[2], xb) * B.su[2], d3 = (float)dot16_i8(B.uu[3], xb) * B.su[3];
    const bool b0 = lane & 1, b1 = lane & 2;
    const float r0 = (b0 ? d1 : d0) + dpp_xor1(b0 ? d0 : d1), r1 = (b0 ? d3 : d2) + dpp_xor1(b0 ? d2 : d3);
    float t = (b1 ? r1 : r0) + dpp_xor2(b1 ? r0 : r1);
    t += __int_as_float(__builtin_amdgcn_update_dpp(0, __float_as_int(t), 0x124, 0xf, 0xf, true));
    t += __int_as_float(__builtin_amdgcn_update_dpp(0, __float_as_int(t), 0x128, 0xf, 0xf, true));
    { auto rr = __builtin_amdgcn_permlane16_swap(__float_as_uint(t), __float_as_uint(t), false, false); t = __uint_as_float(rr[0]) + __uint_as_float(rr[1]); }
    { auto rr = __builtin_amdgcn_permlane32_swap(__float_as_uint(t), __float_as_uint(t), false, false); t = __uint_as_float(rr[0]) + __uint_as_float(rr[1]); }
    const float act = gelu_tanh(t * (b1 ? sxb : S.sx));
#define PEER_W(k) (__builtin_bit_cast(float, __builtin_amdgcn_readlane(__builtin_bit_cast(int, act), k)) * __uint_as_float(B.ent[k] & 0xffff0000u) * B.sv[k])
    const float a0 = PEER_W(0), a1 = PEER_W(1), a2 = PEER_W(2), a3 = PEER_W(3);
#undef PEER_W
    const float hsel = (lane >= 32) ? 1.0f : 0.0f;
    axpy32_v6(S.oc, a0 + hsel * (a1 - a0), B.va[0], B.vb4[0], B.vb5[0]);
    if (jB != jA) { peer_flush(S, ol, lane); S.curj = jB; S.x[0] = xb[0]; S.x[1] = xb[1]; S.x[2] = xb[2]; S.x[3] = xb[3]; S.sx = sxb; }
    axpy32_v6(S.oc, a2 + hsel * (a3 - a2), B.va[1], B.vb4[1], B.vb5[1]);
}
DI void p8b_peer(Frame& F, float* outp, unsigned emask = 0x3fffu, float oscale = 1.0f) {
    const int lane = F.lane, w = F.wave;
    const int gw = F.vcu * NWAVES + w, NGW = F.G * NWAVES;
    const unsigned char* EU8 = F.wsp<unsigned char>(WS_EU); const unsigned char* EV8 = F.wsp<unsigned char>(WS_EV); const float* SU = F.wsp<float>(WS_SU);
    LAS unsigned char* xl = F.lds + w * PEER_LDS_PER_WAVE;
    LAS unsigned char* ol = xl + TPW * 1024 + 64;
    LAS unsigned* ml = (LAS unsigned*)(ol + TPW * 2048);
    for (int t0 = gw * TPW; t0 < M; t0 += NGW * TPW) {
        unsigned enta[TPW], entb[TPW]; int posa[TPW], posb[TPW], sla[TPW], slb[TPW], offs[TPW];
#pragma unroll
        for (int j = 0; j < TPW; ++j) { const size_t tok = (size_t)t0 + j;
            float rstd; { const f32x4* sp = (const f32x4*)(F.wsp<float>(WS_SSQ2) + tok * 16); const f32x4 st = (sp[0] + sp[1]) + (sp[2] + sp[3]); rstd = rsq_(((st.x + st.y) + (st.z + st.w)) * (1.f / 1024.f) + EPS); }
            { const bf16* xs = F.wsp<bf16>(WS_XN) + tok * DM + 16 * lane;
              const v4u x0 = *(const v4u*)xs, x1 = *(const v4u*)(xs + 8);
              float xf[16] = {bflo(x0.x), bfhi(x0.x), bflo(x0.y), bfhi(x0.y), bflo(x0.z), bfhi(x0.z), bflo(x0.w), bfhi(x0.w), bflo(x1.x), bfhi(x1.x), bflo(x1.y), bfhi(x1.y), bflo(x1.z), bfhi(x1.z), bflo(x1.w), bfhi(x1.w)};
              float mx = 0.f;
#pragma unroll
              for (int i = 0; i < 16; ++i) mx = fmaxf(mx, fabsf(xf[i]));
              mx = fmaxf(max64(mx), 1e-30f); const float inv = 127.0f / mx;
              v4u y; y.x = pack_i8x4(xf[0] * inv, xf[1] * inv, xf[2] * inv, xf[3] * inv); y.y = pack_i8x4(xf[4] * inv, xf[5] * inv, xf[6] * inv, xf[7] * inv);
              y.z = pack_i8x4(xf[8] * inv, xf[9] * inv, xf[10] * inv, xf[11] * inv); y.w = pack_i8x4(xf[12] * inv, xf[13] * inv, xf[14] * inv, xf[15] * inv);
              ((LAS v4u*)(xl + j * 1024))[lane] = y; if (lane == 0) ((LAS float*)(xl + TPW * 1024))[j] = mx * rstd * (1.0f / 127.0f);
              ((LAS v4u*)(ol + j * 2048))[lane] = (v4u){0u, 0u, 0u, 0u}; ((LAS v4u*)(ol + j * 2048))[64 + lane] = (v4u){0u, 0u, 0u, 0u}; }
            const int ea = F.wsp<int>(WS_IDX)[tok * NSEL + lane], eb = F.wsp<int>(WS_IDX)[tok * NSEL + 64 + lane];
            const float ga = F.wsp<float>(WS_G)[tok * NSEL + lane], gb = F.wsp<float>(WS_G)[tok * NSEL + 64 + lane];
            const int sa = ea >> SLICE_SHIFT, sb = eb >> SLICE_SHIFT;
            int pa = 0, pb = 0, myoff = 0;
#pragma unroll
            for (int bk = 0; bk < NSLICE; ++bk) { const unsigned long long ma = __ballot(sa == bk), mb = __ballot(sb == bk);
                const int ca = __popcll(ma), cb = __popcll(mb);
                const int ra = __builtin_amdgcn_mbcnt_hi((unsigned)(ma >> 32), __builtin_amdgcn_mbcnt_lo((unsigned)ma, 0)), rb = __builtin_amdgcn_mbcnt_hi((unsigned)(mb >> 32), __builtin_amdgcn_mbcnt_lo((unsigned)mb, 0));
                pa = (sa == bk) ? ra : pa; pb = (sb == bk) ? ca + rb : pb;
                myoff = (lane == bk) ? ca + cb : myoff; }
            enta[j] = (unsigned)ea | ((unsigned)j << 14) | (pk2(0.f, ga) & 0xffff0000u); entb[j] = (unsigned)eb | ((unsigned)j << 14) | (pk2(0.f, gb) & 0xffff0000u);
            posa[j] = pa; posb[j] = pb; sla[j] = sa; slb[j] = sb; offs[j] = myoff;
        }
        int cnt = 0;
#pragma unroll
        for (int j = 0; j < TPW; ++j) { const int c = __shfl(offs[j], lane >> 2); cnt = ((lane & 3) == j) ? c : cnt; }
        const int cpad = (cnt + 1) & ~1;
        const int bend = incl_scan64(cpad, lane), bstart = bend - cpad;
        const int npad = __builtin_amdgcn_readlane(bend, 63);
#pragma unroll
        for (int j = 0; j < TPW; ++j) { const int ba = __shfl(bstart, 4 * sla[j] + j), bb = __shfl(bstart, 4 * slb[j] + j);
            ml[ba + posa[j]] = enta[j]; ml[bb + posb[j]] = entb[j]; }
        { const unsigned pad = (unsigned)((lane >> 2) << SLICE_SHIFT) | ((unsigned)(lane & 3) << 14);
          if (cnt < cpad) ml[bstart + cnt] = pad; }
        if (lane < 30) ml[npad + lane] = (unsigned)((NSLICE - 1) << SLICE_SHIFT) | (3u << 14);
        LDS_WAIT();
        PeerState S;
#pragma unroll
        for (int i = 0; i < 16; ++i) S.oc[i] = (f16x2_t){(_Float16)0.f, (_Float16)0.f};
#pragma unroll
        for (int i = 0; i < 4; ++i) S.x[i] = 0u;
        S.curj = -1;
        PeerBatch A, B, C, D;
        peer_load_batch(A, ml, 0, EU8, EV8, SU, lane, emask); peer_load_batch(B, ml, 4, EU8, EV8, SU, lane, emask); peer_load_batch(C, ml, 8, EU8, EV8, SU, lane, emask);
#pragma unroll 1
        for (int i = 0; i < npad; i += 16) {
            peer_load_batch(D, ml, i + 12, EU8, EV8, SU, lane, emask); peer_compute_batch(A, S, ol, xl, lane);
            peer_load_batch(A, ml, i + 16, EU8, EV8, SU, lane, emask); peer_compute_batch(B, S, ol, xl, lane);
            peer_load_batch(B, ml, i + 20, EU8, EV8, SU, lane, emask); peer_compute_batch(C, S, ol, xl, lane);
            peer_load_batch(C, ml, i + 24, EU8, EV8, SU, lane, emask); peer_compute_batch(D, S, ol, xl, lane);
        }
        peer_flush(S, ol, lane);
        LDS_WAIT();
#pragma unroll
        for (int j = 0; j < TPW; ++j) {
            const int eb = 32 * (lane & 31) + 16 * (lane >> 5);
            float* orow = outp + ((size_t)t0 + j) * DM + eb;
            const v4u xb0 = *(const v4u*)(F.wsp<bf16>(WS_XN) + ((size_t)t0 + j) * DM + eb), xb1 = *(const v4u*)(F.wsp<bf16>(WS_XN) + ((size_t)t0 + j) * DM + eb + 8);
            const unsigned xw[8] = {xb0.x, xb0.y, xb0.z, xb0.w, xb1.x, xb1.y, xb1.z, xb1.w};
            f32x4 a[4]; float ss = 0.f;
            const v4u h0 = *(const LAS v4u*)(ol + j * 2048 + 2 * eb), h1 = *(const LAS v4u*)(ol + j * 2048 + 2 * eb + 16);
            const unsigned hw[8] = {h0.x, h0.y, h0.z, h0.w, h1.x, h1.y, h1.z, h1.w};
#pragma unroll
            for (int q = 0; q < 4; ++q) { const f16x2_t p0 = __builtin_bit_cast(f16x2_t, hw[2 * q]), p1 = __builtin_bit_cast(f16x2_t, hw[2 * q + 1]);
                a[q] = (f32x4){bflo(xw[2 * q]), bfhi(xw[2 * q]), bflo(xw[2 * q + 1]), bfhi(xw[2 * q + 1])} + (f32x4){(float)p0.x, (float)p0.y, (float)p1.x, (float)p1.y};
                ss += (a[q].x * a[q].x + a[q].y * a[q].y) + (a[q].z * a[q].z + a[q].w * a[q].w); }
            const float rf = rsq_(sum64(ss) * (1.f / 1024.f) + EPS) * oscale;
#pragma unroll
            for (int q = 0; q < 4; ++q) *(f32x4*)(orow + 4 * q) = a[q] * rf * *(const f32x4*)(F.in(25) + eb + 4 * q);
        }
        LDS_WAIT();
    }
}
constexpr int N_PHASES = 11;
__global__ void __launch_bounds__(NWAVES * 64, 2) fwd_kernel(Args args) {
    extern __shared__ __attribute__((aligned(16))) unsigned char lds[];
    Frame F;
    F.lds = (LAS unsigned char*)lds;
    F.MISC = (volatile LAS unsigned*)(F.lds + MISC_OFF);
    F.tid = threadIdx.x; F.lane = F.tid & 63; F.wave = __builtin_amdgcn_readfirstlane(F.tid >> 6);
    F.G = gridDim.x; { const int bx = blockIdx.x; F.vcu = (F.G % 8 == 0) ? (bx % 8) * (F.G / 8) + bx / 8 : bx; }
    F.A = &args; F.ws = args.ws; F.out = args.out;
    F.ctl = (gu32*)(args.ws + WS_CTL);
    for (int u = F.tid; u < (LDS_BYTES - LDSCTL_OFF) / 4; u += NWAVES * 64) ((LAS unsigned*)(F.lds + LDSCTL_OFF))[u] = 0u;
    __syncthreads();
    const bool multi = (args.ph_hi - args.ph_lo) > 1;
    XcdBarrier bar; bar.bar = (unsigned*)(F.ctl + CW_BAR) + args.li * XCD_BAR_WORDS; bar.x = 0; bar.st = nullptr;
    if (multi) bar = xcd_barrier_post((unsigned*)(F.ctl + CW_BAR) + args.li * XCD_BAR_WORDS, F.MISC + 8);
    const int lo = args.ph_lo, hi = args.ph_hi;
#ifndef PROBE_EMASK
#define PROBE_EMASK 0x3fffu
#endif
#ifndef PHASE_REPEAT
#define PHASE_REPEAT 0
#endif
#define REP(k) for (int rep_ = 0; rep_ < (((PHASE_REPEAT >> (k)) & 1) ? 2 : 1); ++rep_)
#ifndef PHASE_MASK
#define PHASE_MASK 0x7ff
#endif
#define IN(k) (((PHASE_MASK >> (k)) & 1) && lo <= (k) && (k) < hi)
#define SEAM(k) do { asm volatile("; ===SEAM " #k ::: "memory"); if (IN(k) && IN((k) + 1)) xcd_barrier(bar); STAMP((k) + 1); } while (0)
    const int c = (int)blockIdx.x;
#define LOCAL_SEAM() do { VM_WAIT(); __syncthreads(); if (F.tid == 0) { __builtin_amdgcn_fence(__ATOMIC_ACQUIRE, "agent"); VM_WAIT(); } __syncthreads(); } while (0)
#ifdef PROBE_PHASE
#define STAMP(i) do { if (blockIdx.x == 0 && F.tid == 0) __hip_atomic_store(F.ctl + 512 + (i), (unsigned)__builtin_amdgcn_s_memrealtime(), RLX_AGENT); } while (0)
#else
#define STAMP(i) do { } while (0)
#endif
    STAMP(0);

    if (IN(0)) REP(0) { p0_prologue(F); } SEAM(0);
    if (IN(1)) REP(1) {
        { pg8::Gemm g{F.wsp<bf16>(WS_XN), F.wsp<bf16>(WS_WIN), M, INW, DM}; pg8::StaticOrder S; S.init(M, INW, F.G, c);
          pg8::EpiSplitT E{F.wsp<bf16>(WS_Z), ZW, ZW, F.wsp<bf16>(WS_VT), ATTW, SEQ};
          pg8::gemm_phase<pg8::EpiSplitT, pg8::StaticOrder, true, true>(F.lds, g, S, E); }
        { const int nw3 = (M / 256) * (INW / 256) - 2 * F.G;
          int idx = -1; if (nw3 >= 0 && nw3 + 16 <= F.G) idx = c - nw3; else idx = (c < 16 && F.G >= 16) ? c : -1;
          if (F.G < 16) idx = -1;
          pg8::Gemm g{F.wsp<bf16>(WS_MEMN), F.wsp<bf16>(WS_WKV), NBATCH * 256, 2 * DM, DM};
          if (F.G >= 16) { pg8::OneUnit S{idx, 2, 8}; pg8::EpiSplitT E{F.wsp<bf16>(WS_KM), DM, DM, F.wsp<bf16>(WS_VMT), DM, 256};
              pg8::gemm_phase<pg8::EpiSplitT, pg8::OneUnit, false, true>(F.lds, g, S, E); }
          else { pg8::StaticOrder S; S.init(NBATCH * 256, 2 * DM, F.G, c); pg8::EpiSplitT E{F.wsp<bf16>(WS_KM), DM, DM, F.wsp<bf16>(WS_VMT), DM, 256};
              pg8::gemm_phase<pg8::EpiSplitT, pg8::StaticOrder, false, true>(F.lds, g, S, E); } }
        { const int first_idle = (M / 256) * (INW / 256) - 2 * F.G + 16;
          if (first_idle > 0 && first_idle < F.G) { if (c >= first_idle) convert_experts(F, (c - first_idle) * NWAVES + F.wave, (F.G - first_idle) * NWAVES); }
          else convert_experts(F, c * NWAVES + F.wave, F.G * NWAVES); }
    } SEAM(1);
    if (IN(2)) REP(2) { p2_lru_aggregates(F); } SEAM(2);
#ifndef PROBE_PARTS
#define PROBE_PARTS 3
#endif
    if (IN(3)) { if ((PHASE_REPEAT >> 3) & 1) p3_mixer(F, PROBE_PARTS); p3_mixer(F); } SEAM(3);
    if (IN(4)) REP(4) {
        pg8::Gemm g{F.wsp<bf16>(WS_Y), F.wsp<bf16>(WS_WOUT), M, DM, DM}; pg8::StaticOrder S; S.init(M, DM, F.G, c);
        pg8::EpiResid<false> E{F.in(0), F.wsp<bf16>(WS_XN), F.wsp<float>(WS_SSQ1), DM};
        pg8::gemm_phase<pg8::EpiResid<false>, pg8::StaticOrder, true, true>(F.lds, g, S, E);
    } SEAM(4);
    if (IN(5)) {
        pg8::Gemm g{F.wsp<bf16>(WS_XN), F.wsp<bf16>(WS_WQ), M, DM, DM}; pg8::StaticOrder S; S.init(M, DM, F.G, c);
        pg8::EpiRowScale E{F.wsp<bf16>(WS_QC), DM, F.wsp<float>(WS_SSQ1), 1.f / 1024.f, EPS};
        pg8::gemm_phase<pg8::EpiRowScale, pg8::StaticOrder, true, true>(F.lds, g, S, E);
        LOCAL_SEAM();
        p5_cross(F, S);
    } SEAM(6);
    if (IN(7)) {
        pg8::Gemm g{F.wsp<bf16>(WS_OC), F.wsp<bf16>(WS_WO), M, DM, DM}; pg8::StaticOrder S; S.init(M, DM, F.G, c);
        pg8::EpiResid<true> E{F.wsp<bf16>(WS_XN), F.wsp<bf16>(WS_XN), F.wsp<float>(WS_SSQ2), DM};
        pg8::gemm_phase<pg8::EpiResid<true>, pg8::StaticOrder, true, true>(F.lds, g, S, E);
    } SEAM(7);
    if (IN(8)) {
        pg8::Gemm g{F.wsp<bf16>(WS_XN), F.wsp<bf16>(WS_WQRY), M, 2 * DM, DM}; pg8::StaticOrder S; S.init(M, 2 * DM, F.G, c);
        pg8::EpiRowScale E{F.wsp<bf16>(WS_QP), 2 * DM, F.wsp<float>(WS_SSQ2), 1.f / 1024.f, EPS};
        pg8::gemm_phase<pg8::EpiRowScale, pg8::StaticOrder, true, true>(F.lds, g, S, E);
        LOCAL_SEAM();
        p8a_topk(F, S);
    } SEAM(9);
    if (IN(10)) { if ((PHASE_REPEAT >> 10) & 1) { p8b_peer(F, F.wsp<float>(WS_Z), PROBE_EMASK); } p8b_peer(F, F.out, 0x3fffu,
#ifdef PROBE_PHASE
        1.0f + (float)(((__hip_atomic_load(F.ctl + 512 + PROBE_PHASE + 1, RLX_AGENT) - __hip_atomic_load(F.ctl + 512 + PROBE_PHASE, RLX_AGENT)) + 500u) / 1000u) * 1e-2f
#else
        1.0f
#endif
        ); }
#undef IN
#undef SEAM
}

#ifndef N_LAUNCH_MODE
#define N_LAUNCH_MODE 1
#endif
extern "C" void kernel_launch(void* const* d_in, const int* in_sizes, int n_in, void* d_out, int out_size, void* d_ws, size_t ws_size, hipStream_t stream) {
    static int grid = 0;
    if (grid == 0) {
        if (n_in != 26 || out_size != M * DM || ws_size < WS_END) { fprintf(stderr, "kernel_launch: unexpected shapes (n_in %d, out %d, ws %zu)\n", n_in, out_size, ws_size); grid = -1; return; }
        int dev = 0, cus = 0, per_cu = 0;
        if (hipGetDevice(&dev) != hipSuccess || hipDeviceGetAttribute(&cus, hipDeviceAttributeMultiprocessorCount, dev) != hipSuccess) { grid = -1; return; }
        if (hipFuncSetAttribute((const void*)fwd_kernel, hipFuncAttributeMaxDynamicSharedMemorySize, LDS_BYTES) != hipSuccess) { fprintf(stderr, "kernel_launch: hipFuncSetAttribute failed\n"); grid = -1; return; }
        if (hipOccupancyMaxActiveBlocksPerMultiprocessor(&per_cu, (const void*)fwd_kernel, NWAVES * 64, LDS_BYTES) != hipSuccess || per_cu < 1) { fprintf(stderr, "kernel_launch: occupancy query says %d blocks per CU\n", per_cu); (void)hipGetLastError(); grid = -1; return; }
        grid = cus;
    }
    if (grid < 0) return;
    (void)hipMemsetAsync((char*)d_ws + WS_CTL, 0, CTL_ZERO_BYTES, stream);
    Args a{};
    for (int i = 0; i < 26; ++i) a.in[i] = (const float*)d_in[i];
    a.out = (float*)d_out; a.ws = (unsigned char*)d_ws;
    if (N_LAUNCH_MODE == 1) { a.ph_lo = 0; a.ph_hi = N_PHASES; a.li = 0; hipLaunchKernelGGL(fwd_kernel, dim3(grid), dim3(NWAVES * 64), LDS_BYTES, stream, a); }
    else { for (int p = 0; p < N_PHASES; ++p) { a.ph_lo = p; a.ph_hi = p + 1; a.li = 0; hipLaunchKernelGGL(fwd_kernel, dim3(grid), dim3(NWAVES * 64), LDS_BYTES, stream, a); } }
}
```

```cpp
#include <hip/hip_runtime.h>
#include <cstdio>
#include <cstdint>
namespace pg8 {
#define PG8_LAS __attribute__((address_space(3)))
typedef unsigned short bf16_t;
typedef short bf16x8 __attribute__((ext_vector_type(8)));
typedef float f32x4 __attribute__((ext_vector_type(4)));
typedef unsigned u32x4 __attribute__((ext_vector_type(4)));
constexpr int BM = 256, BK = 64, HALF = 128, HTB = HALF * BK * 2  , STAGE_BYTES = 8 * HTB, NXCD = 8, WGM = 8;

__host__ __device__ __forceinline__ int lds_byte(int r, int c) { const int st = (r >> 4) * 2 + (c >> 5), rr = r & 15, cc = c & 31, ob = rr * 64 + cc * 2; return st * 1024 + (ob ^ (((ob >> 9) & 1) << 5)); }
__host__ __device__ __forceinline__ void stage_rc(int b, int& R, int& C) { const int st = b / 1024, sb = b % 1024, swz = sb ^ (((sb >> 9) & 1) << 5); R = (st >> 1) * 16 + swz / 64; C = (st & 1) * 32 + (swz % 64) / 2; }
__host__ __device__ __forceinline__ int perm32(int rho) { const int n = rho >> 4, i = rho & 15; return 8 * (i >> 2) + 4 * n + (i & 3); }

struct Unit { int pm, pn; };
struct Gemm { const bf16_t* A; const bf16_t* Bt; int M, N, K; };

struct StaticOrder {
    int nM, nN, nwg, G, c;
    __host__ __device__ void init(int M, int N, int G_, int c_) { nM = M / BM; nN = N / BM; nwg = nM * nN; G = G_; c = c_; }
    __host__ __device__ bool next(int i, Unit& u) const {
        const long L = (long)i * G + c; if (L >= nwg) return false;
        int wgid = (int)L; { const int q = nwg / NXCD, r = nwg % NXCD, xcd = wgid % NXCD, off = wgid / NXCD; wgid = (xcd < r ? xcd * (q + 1) : r * (q + 1) + (xcd - r) * q) + off; }
        const int nig = WGM * nN, gid = wgid / nig, fm = gid * WGM, gsz = (nM - fm) < WGM ? (nM - fm) : WGM;
        u.pm = fm + ((wgid % nig) % gsz); u.pn = (wgid % nig) / gsz; return true;
    }
    __device__ __forceinline__ void a_ready(const Unit&) const {}
    __device__ __forceinline__ void done(const Unit&) const {}
};

typedef float f32x2 __attribute__((ext_vector_type(2)));
typedef __bf16 bf16x2_t __attribute__((ext_vector_type(2)));
__device__ __forceinline__ unsigned cvt_pk_bf16(float lo, float hi) { f32x2 v = {lo, hi}; bf16x2_t b = __builtin_convertvector(v, bf16x2_t); return __builtin_bit_cast(unsigned, b); }
__device__ __forceinline__ bf16_t cvt_bf16(float x) { return (bf16_t)(cvt_pk_bf16(x, 0.f) & 0xffffu); }

struct EpiSplitT {
    static constexpr bool PERM = true, AFTER_DRAIN = false;
    bf16_t* O; int ldc; int ncols_rm; bf16_t* T; int NT; int rpb;
    __device__ __forceinline__ void operator()(const f32x4 (&acc)[2][2][4][2], const Unit& u, int wr, int wc, int fr, int fq) const {
        const int row0 = u.pm * BM + wr * 64 + fr; const int colt = u.pn * BM;
        if (colt < ncols_rm) {
            const int col0 = colt + wc * 32 + 8 * fq;
#pragma unroll
            for (int ai = 0; ai < 2; ++ai)
#pragma unroll
                for (int m = 0; m < 4; ++m) { bf16_t* rowp = O + (size_t)(row0 + ai * HALF + m * 16) * ldc + col0;
#pragma unroll
                    for (int bj = 0; bj < 2; ++bj) { const f32x4 v0 = acc[ai][bj][m][0], v1 = acc[ai][bj][m][1];
                        u32x4 w; w.x = cvt_pk_bf16(v0[0], v0[1]); w.y = cvt_pk_bf16(v0[2], v0[3]); w.z = cvt_pk_bf16(v1[0], v1[1]); w.w = cvt_pk_bf16(v1[2], v1[3]);
                        *(u32x4*)(rowp + bj * HALF) = w; } }
        } else {
            const int c0 = colt - ncols_rm + wc * 32 + 8 * fq;
#pragma unroll
            for (int ai = 0; ai < 2; ++ai)
#pragma unroll
                for (int m = 0; m < 4; ++m) { const int row = row0 + ai * HALF + m * 16; const int b = row / rpb, t = row - b * rpb; bf16_t* base = T + (size_t)b * NT * rpb + t;
#pragma unroll
                    for (int bj = 0; bj < 2; ++bj)
#pragma unroll
                        for (int n = 0; n < 2; ++n)
#pragma unroll
                            for (int e = 0; e < 4; ++e) base[(size_t)(c0 + bj * HALF + 4 * n + e) * rpb] = cvt_bf16(acc[ai][bj][m][n][e]); }
        }
    }
};
template <bool BASE_BF16> struct EpiResid {
    static constexpr bool PERM = true, AFTER_DRAIN = false;
    const void* base; bf16_t* xb; float* ssq; int ldc;
    __device__ __forceinline__ void operator()(const f32x4 (&acc)[2][2][4][2], const Unit& u, int wr, int wc, int fr, int fq) const {
        const int row0 = u.pm * BM + wr * 64 + fr; const int col0 = u.pn * BM + wc * 32 + 8 * fq;
#pragma unroll
        for (int ai = 0; ai < 2; ++ai)
#pragma unroll
            for (int m = 0; m < 4; ++m) { const int row = row0 + ai * HALF + m * 16; float s = 0.f;
#pragma unroll
                for (int bj = 0; bj < 2; ++bj) { const size_t off = (size_t)row * ldc + col0 + bj * HALF;
                    f32x4 b0, b1;
                    if (BASE_BF16) { const u32x4 w = *(const u32x4*)((const bf16_t*)base + off);
                        b0 = (f32x4){__uint_as_float(w.x << 16), __uint_as_float(w.x & 0xffff0000u), __uint_as_float(w.y << 16), __uint_as_float(w.y & 0xffff0000u)};
                        b1 = (f32x4){__uint_as_float(w.z << 16), __uint_as_float(w.z & 0xffff0000u), __uint_as_float(w.w << 16), __uint_as_float(w.w & 0xffff0000u)}; }
                    else { b0 = *(const f32x4*)((const float*)base + off); b1 = *(const f32x4*)((const float*)base + off + 4); }
                    const f32x4 v0 = acc[ai][bj][m][0] + b0, v1 = acc[ai][bj][m][1] + b1;
                    s += (v0[0] * v0[0] + v0[1] * v0[1]) + (v0[2] * v0[2] + v0[3] * v0[3]) + (v1[0] * v1[0] + v1[1] * v1[1]) + (v1[2] * v1[2] + v1[3] * v1[3]);
                    u32x4 w; w.x = cvt_pk_bf16(v0[0], v0[1]); w.y = cvt_pk_bf16(v0[2], v0[3]); w.z = cvt_pk_bf16(v1[0], v1[1]); w.w = cvt_pk_bf16(v1[2], v1[3]);
                    *(u32x4*)(xb + off) = w; }
                s += __shfl_xor(s, 16); s += __shfl_xor(s, 32);
                if (fq == 0) ssq[(size_t)row * 16 + u.pn * 4 + wc] = s; }
    }
};
struct EpiRowScale {
    static constexpr bool PERM = true, AFTER_DRAIN = false;
    bf16_t* O; int ldc; const float* ssq; float inv_n, eps;
    __device__ __forceinline__ void operator()(const f32x4 (&acc)[2][2][4][2], const Unit& u, int wr, int wc, int fr, int fq) const {
        const int row0 = u.pm * BM + wr * 64 + fr; const int col0 = u.pn * BM + wc * 32 + 8 * fq;
#pragma unroll
        for (int ai = 0; ai < 2; ++ai)
#pragma unroll
            for (int m = 0; m < 4; ++m) { const int row = row0 + ai * HALF + m * 16; const f32x4* sp = (const f32x4*)(ssq + (size_t)row * 16);
                const f32x4 s0 = sp[0], s1 = sp[1], s2 = sp[2], s3 = sp[3]; const f32x4 st = (s0 + s1) + (s2 + s3);
                const float r = 1.0f / sqrtf(((st[0] + st[1]) + (st[2] + st[3])) * inv_n + eps);
                bf16_t* rowp = O + (size_t)row * ldc + col0;
#pragma unroll
                for (int bj = 0; bj < 2; ++bj) { const f32x4 v0 = acc[ai][bj][m][0] * r, v1 = acc[ai][bj][m][1] * r;
                    u32x4 w; w.x = cvt_pk_bf16(v0[0], v0[1]); w.y = cvt_pk_bf16(v0[2], v0[3]); w.z = cvt_pk_bf16(v1[0], v1[1]); w.w = cvt_pk_bf16(v1[2], v1[3]);
                    *(u32x4*)(rowp + bj * HALF) = w; } }
    }
};
struct OneUnit {
    int idx, nM, nN;
    __device__ __forceinline__ bool next(int i, Unit& u) const { if (i > 0 || idx < 0 || idx >= nM * nN) return false; u.pm = idx % nM; u.pn = idx / nM; return true; }
    __device__ __forceinline__ void a_ready(const Unit&) const {}
    __device__ __forceinline__ void done(const Unit&) const {}
};

template <class Epi, class Sched, bool ALIGN_EPI = false, bool SP2 = false>
__device__ __forceinline__ void gemm_phase(PG8_LAS unsigned char* lds, const Gemm g, const Sched& S, const Epi& E) {
    const int tid = threadIdx.x, wid = __builtin_amdgcn_readfirstlane(tid >> 6), lane = tid & 63, wr = wid >> 2, wc = wid & 3, fr = lane & 15, fq = lane >> 4;
    const int K = g.K, nt = K / BK;
    unsigned voffA[2], voffB[2];
#pragma unroll
    for (int i = 0; i < 2; ++i) { int R, C; stage_rc(tid * 16 + i * 8192, R, C); const int Rb = Epi::PERM ? ((R & ~31) + perm32(R & 31)) : R;
        voffA[i] = (unsigned)(R * K + C) * 2u; voffB[i] = (unsigned)(Rb * K + C) * 2u; }
    const size_t kstep = (size_t)(BK * 2);
    const size_t hstep = (size_t)HALF * K * 2;
    const size_t tstep = 2 * hstep;
    const unsigned ldsw = (unsigned)wid * 1024u;
    const int aoff = lds_byte(wr * 64 + fr, fq * 8), boff = lds_byte(wc * 32 + fr, fq * 8);
#define PG8_SA(b, h) (((b) * 2 + (h)) * HTB)
#define PG8_SB(b, h) ((4 + (b) * 2 + (h)) * HTB)
#define PG8_STAGE(bufoff, gbase, voff) do { _Pragma("unroll") for (int _i = 0; _i < 2; ++_i) \
        __builtin_amdgcn_global_load_lds((const unsigned*)((const char*)(gbase) + (voff)[_i]), (PG8_LAS unsigned*)(lds + (bufoff) + ldsw + _i * 8192), 16, 0, 0); } while (0)
#define PG8_LDA(dst, b, h) do { _Pragma("unroll") for (int m = 0; m < 4; ++m) _Pragma("unroll") for (int k = 0; k < 2; ++k) dst[m][k] = *(const PG8_LAS bf16x8*)(lds + PG8_SA(b, h) + aoff + m * 2048 + k * 1024); } while (0)
#define PG8_LDB(dst, b, h) do { _Pragma("unroll") for (int n = 0; n < 2; ++n) _Pragma("unroll") for (int k = 0; k < 2; ++k) dst[n][k] = *(const PG8_LAS bf16x8*)(lds + PG8_SB(b, h) + boff + n * 2048 + k * 1024); } while (0)
#define PG8_MMA(ai, bj, At, Bt) do { __builtin_amdgcn_s_setprio(1); _Pragma("unroll") for (int m = 0; m < 4; ++m) _Pragma("unroll") for (int n = 0; n < 2; ++n) _Pragma("unroll") for (int k = 0; k < 2; ++k) \
        acc[ai][bj][m][n] = __builtin_amdgcn_mfma_f32_16x16x32_bf16(Bt[n][k], At[m][k], acc[ai][bj][m][n], 0, 0, 0); __builtin_amdgcn_s_setprio(0); } while (0)
#define PG8_WAIT_V(n) asm volatile("s_waitcnt vmcnt(" #n ")" ::: "memory")
#define PG8_WAIT_L(n) asm volatile("s_waitcnt lgkmcnt(" #n ")" ::: "memory")
#define PG8_BAR __builtin_amdgcn_s_barrier()
#define PG8_SCHED __builtin_amdgcn_sched_barrier(0)
    Unit cur, nxt; int ui = 0;
    if (!S.next(0, cur)) return;
    f32x4 acc[2][2][4][2];
#pragma unroll
    for (int a = 0; a < 2; ++a)
#pragma unroll
        for (int b = 0; b < 2; ++b)
#pragma unroll
            for (int m = 0; m < 4; ++m)
#pragma unroll
                for (int n = 0; n < 2; ++n) acc[a][b][m][n] = (f32x4){0.f, 0.f, 0.f, 0.f};
    bf16x8 At[4][2], B0[2][2], B1[2][2];
    const char* cA = (const char*)g.A + (size_t)cur.pm * tstep; const char* cB = (const char*)g.Bt + (size_t)cur.pn * tstep;
    S.a_ready(cur);
    if constexpr (SP2) {
        PG8_STAGE(PG8_SB(0, 0), cB, voffB); PG8_STAGE(PG8_SB(0, 1), cB + hstep, voffB); PG8_STAGE(PG8_SA(0, 0), cA, voffA); PG8_STAGE(PG8_SA(0, 1), cA + hstep, voffA);
        if (wr == 1) PG8_BAR;
        PG8_WAIT_V(2); PG8_BAR;
        PG8_STAGE(PG8_SB(1, 0), cB + kstep, voffB); PG8_STAGE(PG8_SA(1, 0), cA + kstep, voffA); PG8_STAGE(PG8_SB(1, 1), cB + hstep + kstep, voffB);
        PG8_WAIT_V(6); PG8_BAR;
    } else {
        PG8_STAGE(PG8_SB(0, 0), cB, voffB); PG8_STAGE(PG8_SA(0, 0), cA, voffA); PG8_STAGE(PG8_SB(0, 1), cB + hstep, voffB); PG8_STAGE(PG8_SA(0, 1), cA + hstep, voffA);
        if (wr == 1) PG8_BAR;
        PG8_WAIT_V(4); PG8_BAR;
        PG8_STAGE(PG8_SB(1, 0), cB + kstep, voffB); PG8_STAGE(PG8_SA(1, 0), cA + kstep, voffA); PG8_STAGE(PG8_SB(1, 1), cB + hstep + kstep, voffB);
        PG8_WAIT_V(6); PG8_BAR;
    }
    for (;;) {
        const bool has_next = S.next(ui + 1, nxt);
        const char* nA = has_next ? (const char*)g.A + (size_t)nxt.pm * tstep : cA; const char* nB = has_next ? (const char*)g.Bt + (size_t)nxt.pn * tstep : cB;
        for (int t = 0; t < nt; t += 2) {
            const bool last = (t == nt - 2);
            const char* a1 = cA + (size_t)(t + 1) * kstep;
            const char* a2 = last ? nA : cA + (size_t)(t + 2) * kstep; const char* b2 = last ? nB : cB + (size_t)(t + 2) * kstep;
            const char* a3 = a2 + kstep; const char* b3 = b2 + kstep;
            if (last && has_next) S.a_ready(nxt);
            if constexpr (SP2) {
            PG8_LDB(B0, 0, 0); PG8_LDB(B1, 0, 1); PG8_SCHED; PG8_LDA(At, 0, 0); PG8_STAGE(PG8_SA(1, 1), a1 + hstep, voffA);
            PG8_WAIT_V(8); PG8_WAIT_L(0); PG8_BAR; PG8_MMA(0, 0, At, B0); PG8_MMA(0, 1, At, B1); PG8_BAR; PG8_SCHED;
            PG8_LDA(At, 0, 1); PG8_STAGE(PG8_SB(0, 0), b2, voffB); PG8_STAGE(PG8_SB(0, 1), b2 + hstep, voffB); PG8_STAGE(PG8_SA(0, 0), a2, voffA);
            PG8_WAIT_V(8); PG8_WAIT_L(0); PG8_BAR; PG8_MMA(1, 0, At, B0); PG8_MMA(1, 1, At, B1); PG8_BAR; PG8_SCHED;
            PG8_LDB(B0, 1, 0); PG8_LDB(B1, 1, 1); PG8_SCHED; PG8_LDA(At, 1, 0); PG8_STAGE(PG8_SA(0, 1), a2 + hstep, voffA);
            PG8_WAIT_V(8); PG8_WAIT_L(0); PG8_BAR; PG8_MMA(0, 0, At, B0); PG8_MMA(0, 1, At, B1); PG8_BAR; PG8_SCHED;
            PG8_LDA(At, 1, 1); PG8_STAGE(PG8_SB(1, 0), b3, voffB); PG8_STAGE(PG8_SB(1, 1), b3 + hstep, voffB); PG8_STAGE(PG8_SA(1, 0), a3, voffA);
            PG8_WAIT_V(8); PG8_WAIT_L(0); PG8_BAR; PG8_MMA(1, 0, At, B0); PG8_MMA(1, 1, At, B1); PG8_BAR; PG8_SCHED;
            } else {
            PG8_LDB(B0, 0, 0); PG8_SCHED; PG8_LDA(At, 0, 0); PG8_STAGE(PG8_SA(1, 1), a1 + hstep, voffA);
            PG8_WAIT_L(8); PG8_BAR; PG8_WAIT_L(0); PG8_MMA(0, 0, At, B0); PG8_BAR; PG8_SCHED;
            PG8_LDB(B1, 0, 1); PG8_STAGE(PG8_SB(0, 0), b2, voffB);
            PG8_BAR; PG8_WAIT_L(0); PG8_MMA(0, 1, At, B1); PG8_BAR;
            PG8_LDA(At, 0, 1); PG8_STAGE(PG8_SA(0, 0), a2, voffA);
            PG8_BAR; PG8_WAIT_L(0); PG8_MMA(1, 0, At, B0); PG8_BAR; PG8_SCHED;
            PG8_STAGE(PG8_SB(0, 1), b2 + hstep, voffB);
            PG8_WAIT_V(6); PG8_BAR; PG8_MMA(1, 1, At, B1); PG8_BAR;
            PG8_LDB(B0, 1, 0); PG8_SCHED; PG8_LDA(At, 1, 0); PG8_STAGE(PG8_SA(0, 1), a2 + hstep, voffA);
            PG8_WAIT_L(8); PG8_BAR; PG8_WAIT_L(0); PG8_MMA(0, 0, At, B0); PG8_BAR; PG8_SCHED;
            PG8_LDB(B1, 1, 1); PG8_STAGE(PG8_SB(1, 0), b3, voffB);
            PG8_BAR; PG8_WAIT_L(0); PG8_MMA(0, 1, At, B1); PG8_BAR;
            PG8_LDA(At, 1, 1); PG8_STAGE(PG8_SA(1, 0), a3, voffA);
            PG8_BAR; PG8_WAIT_L(0); PG8_MMA(1, 0, At, B0); PG8_BAR; PG8_SCHED;
            PG8_STAGE(PG8_SB(1, 1), b3 + hstep, voffB);
            PG8_WAIT_V(6); PG8_BAR; PG8_MMA(1, 1, At, B1); PG8_BAR;
            }
        }
        if constexpr (ALIGN_EPI) { if (wr == 0) PG8_BAR; }
        if constexpr (!Epi::AFTER_DRAIN) { E(acc, cur, wr, wc, fr, fq); S.done(cur); }
        if (!has_next) break;
#pragma unroll
        for (int a = 0; a < 2; ++a)
#pragma unroll
            for (int b = 0; b < 2; ++b)
#pragma unroll
                for (int m = 0; m < 4; ++m)
#pragma unroll
                    for (int n = 0; n < 2; ++n) acc[a][b][m][n] = (f32x4){0.f, 0.f, 0.f, 0.f};
        cur = nxt; cA = nA; cB = nB; ++ui;
        if constexpr (ALIGN_EPI) { if (wr == 1) PG8_BAR; }
    }
    PG8_WAIT_V(0);
    if constexpr (!ALIGN_EPI) { if (wr == 0) PG8_BAR; }
    PG8_BAR;
    if constexpr (Epi::AFTER_DRAIN) { E.fused(acc, cur, wr, wc, fr, fq, lds, wid, lane); S.done(cur); }
#undef PG8_SA
#undef PG8_SB
#undef PG8_STAGE
#undef PG8_LDA
#undef PG8_LDB
#undef PG8_MMA
#undef PG8_WAIT_V
#undef PG8_WAIT_L
#undef PG8_BAR
#undef PG8_SCHED
}
}

#ifndef PG8_SP2
#define PG8_SP2 true
#endif
#ifndef PG8_ALIGN
#define PG8_ALIGN true
#endif
constexpr int NWAVES = 8;
constexpr int NBATCH = 2, SEQ = 8192, DM = 1024, M = NBATCH * SEQ;
constexpr int INW = 2560, ZW = 2048;
constexpr int LRUW = 512, ATTW = 512, NCHUNK = SEQ / 64;
constexpr int NEXP = 16384, PEER_H = 8, NSEL = 128;
constexpr float EPS = 1e-6f;
constexpr float LOG2E = 1.4426950408889634f;

constexpr size_t MiB = 1u << 20;
constexpr size_t WS_CTL = 0, CTL_ZERO_BYTES = 1 * MiB;
constexpr size_t WS_WIN = 1 * MiB, WS_WOUT = 6 * MiB, WS_WQ = 8 * MiB, WS_WKV = 10 * MiB, WS_WO = 14 * MiB, WS_WQRY = 16 * MiB;
constexpr size_t WS_SUBK = 20 * MiB, WS_GATEW = 20 * MiB + 512 * 1024, WS_MEMN = 21 * MiB, WS_KM = 22 * MiB, WS_VMT = 23 * MiB, WS_AGG = 24 * MiB, WS_SSQ1 = 25 * MiB, WS_SSQ2 = 26 * MiB, WS_SU = 27 * MiB;
constexpr size_t WS_EU = 28 * MiB, WS_EV = 60 * MiB, WS_XN = 92 * MiB, WS_Z = 124 * MiB, WS_VT = 188 * MiB, WS_Y = 204 * MiB, WS_END = 236 * MiB;
constexpr size_t WS_QC = WS_Z, WS_OC = WS_Z + 32 * MiB, WS_QP = WS_Z, WS_IDX = WS_VT, WS_G = WS_VT + 8 * MiB;
constexpr int CW_BAR = 4096;

constexpr int RING_BYTES = 155648;
constexpr int LDSCTL_OFF = RING_BYTES, MISC_OFF = LDSCTL_OFF + 320;
constexpr int LDS_BYTES = 163840;

#define GAS __attribute__((address_space(1)))
#define LAS __attribute__((address_space(3)))
typedef unsigned short bf16;
typedef unsigned v4u __attribute__((ext_vector_type(4)));
typedef unsigned v2u __attribute__((ext_vector_type(2)));
typedef float f32x4 __attribute__((ext_vector_type(4)));
typedef float f32x2 __attribute__((ext_vector_type(2)));
typedef float f32x16 __attribute__((ext_vector_type(16)));
typedef short bf16x8 __attribute__((ext_vector_type(8)));
typedef __bf16 bf16x2_t __attribute__((ext_vector_type(2)));
typedef GAS unsigned gu32;
typedef _Float16 v32h __attribute__((ext_vector_type(32)));
typedef unsigned v6u __attribute__((ext_vector_type(6)));
typedef _Float16 f16x2_t __attribute__((ext_vector_type(2)));
constexpr int EV_ROW = 768;
#define RLX_AGENT __ATOMIC_RELAXED, __HIP_MEMORY_SCOPE_AGENT
#define LDS_WAIT() asm volatile("s_waitcnt lgkmcnt(0)" ::: "memory")
#define VM_WAIT() asm volatile("s_waitcnt vmcnt(0)" ::: "memory")
#define MFMA32(a, b, c) __builtin_amdgcn_mfma_f32_32x32x16_bf16((a), (b), (c), 0, 0, 0)
#define DI __device__ __forceinline__

DI unsigned pk2(float lo, float hi) { f32x2 v = {lo, hi}; bf16x2_t b = __builtin_convertvector(v, bf16x2_t); return __builtin_bit_cast(unsigned, b); }
DI bf16 f2bf(float x) { return (bf16)(pk2(x, 0.f) & 0xffffu); }
DI float bf2f(bf16 x) { return __uint_as_float((unsigned)x << 16); }
DI float bflo(unsigned p) { return __uint_as_float(p << 16); }
DI float bfhi(unsigned p) { return __uint_as_float(p & 0xffff0000u); }
DI int crow(int reg, int hh) { return (reg & 3) + 8 * (reg >> 2) + 4 * hh; }
DI float swap32_partner(float x, int hh) { auto rr = __builtin_amdgcn_permlane32_swap(__float_as_uint(x), __float_as_uint(x), false, false); return __uint_as_float(hh ? rr[0] : rr[1]); }
DI float dpp_xor1(float x) { return __int_as_float(__builtin_amdgcn_update_dpp(0, __float_as_int(x), 0xB1, 0xf, 0xf, true)); }
DI float dpp_xor2(float x) { return __int_as_float(__builtin_amdgcn_update_dpp(0, __float_as_int(x), 0x4E, 0xf, 0xf, true)); }
DI float dpp_hmir(float x) { return __int_as_float(__builtin_amdgcn_update_dpp(0, __float_as_int(x), 0x141, 0xf, 0xf, true)); }
DI float dpp_mir(float x)  { return __int_as_float(__builtin_amdgcn_update_dpp(0, __float_as_int(x), 0x140, 0xf, 0xf, true)); }
DI float sum16(float x) { x += dpp_xor1(x); x += dpp_xor2(x); x += dpp_hmir(x); x += dpp_mir(x); return x; }
DI float sum32(float x) { x = sum16(x); auto rr = __builtin_amdgcn_permlane16_swap(__float_as_uint(x), __float_as_uint(x), false, false); return __uint_as_float(rr[0]) + __uint_as_float(rr[1]); }
DI float max16(float x) { x = fmaxf(x, dpp_xor1(x)); x = fmaxf(x, dpp_xor2(x)); x = fmaxf(x, dpp_hmir(x)); x = fmaxf(x, dpp_mir(x)); return x; }
DI float max64(float x) { x = max16(x); { auto rr = __builtin_amdgcn_permlane16_swap(__float_as_uint(x), __float_as_uint(x), false, false); x = fmaxf(__uint_as_float(rr[0]), __uint_as_float(rr[1])); }
    { auto rr = __builtin_amdgcn_permlane32_swap(__float_as_uint(x), __float_as_uint(x), false, false); x = fmaxf(__uint_as_float(rr[0]), __uint_as_float(rr[1])); } return x; }
DI unsigned pack_i8x4(float a, float b, float c, float d) { const int ia = (int)__builtin_rintf(a), ib = (int)__builtin_rintf(b), ic = (int)__builtin_rintf(c), id = (int)__builtin_rintf(d);
    return (unsigned)(ia & 255) | ((unsigned)(ib & 255) << 8) | ((unsigned)(ic & 255) << 16) | ((unsigned)id << 24); }
DI float max32(float x) { x = max16(x); auto rr = __builtin_amdgcn_permlane16_swap(__float_as_uint(x), __float_as_uint(x), false, false); return fmaxf(__uint_as_float(rr[0]), __uint_as_float(rr[1])); }
DI float sum64(float x) { x = sum32(x); auto rr = __builtin_amdgcn_permlane32_swap(__float_as_uint(x), __float_as_uint(x), false, false); return __uint_as_float(rr[0]) + __uint_as_float(rr[1]); }
DI float rcp_(float x) { return __builtin_amdgcn_rcpf(x); }
DI float rsq_(float x) { return __builtin_amdgcn_rsqf(x); }
DI float exp2_(float x) { return __builtin_amdgcn_exp2f(x); }
DI float gelu_tanh(float x) { const float u = x * (1.5957691216057308f + 0.07135481627159768f * x * x); return x * rcp_(1.0f + exp2_(-LOG2E * u)); }
DI float sigmoidf_(float x) { return rcp_(1.0f + exp2_(-LOG2E * x)); }
#define XB_TMO      128
#define XB_XCNT(j)  (256  + 64 * (j))
#define XB_XSUB(j)  (1280 + 64 * (j))
#define XB_XGEN(j)  (2304 + 64 * (j))
#define XB_TOP      3328
#define XB_TOPGEN   3392
#define XCD_BAR_WORDS 3456
#define XB_SPIN_CAP (1u << 18)

__device__ __forceinline__ unsigned xb_ld(unsigned* p)              { return __hip_atomic_load(p, __ATOMIC_RELAXED, __HIP_MEMORY_SCOPE_AGENT); }
__device__ __forceinline__ unsigned xb_add(unsigned* p, unsigned v) { return __hip_atomic_fetch_add(p, v, __ATOMIC_RELAXED, __HIP_MEMORY_SCOPE_AGENT); }
__device__ __forceinline__ unsigned xb_xcc_id() { return (unsigned)__builtin_amdgcn_s_getreg((3 << 11) | 20) & 0xFu; }
#define XB_SPIN(cond, bar) do { unsigned _sp = 0; while (cond) { __builtin_amdgcn_s_sleep(1); \
    if ((++_sp & 255u) == 0u) { if (xb_ld(&(bar)[XB_TMO])) break; if (_sp > XB_SPIN_CAP) { atomicAdd(&(bar)[XB_TMO], 1u); break; } } } } while (0)

struct XcdBarrier {
    unsigned* bar; unsigned x;
    volatile LAS unsigned* st;
};

__device__ __forceinline__ XcdBarrier xcd_barrier_post(unsigned* bar, volatile LAS unsigned* st) {
    XcdBarrier b; b.bar = bar; b.x = xb_xcc_id(); b.st = st;
    if (threadIdx.x == 0) (void)xb_add(&bar[XB_XCNT(b.x)], 1u);
    return b;
}
__device__ __forceinline__ void xcd_barrier_complete(unsigned* bar, unsigned x, unsigned& nloc, unsigned& nx) {
    const unsigned G = gridDim.x * gridDim.y * gridDim.z;
    unsigned sum, cnt, mine, sp = 0u;
    for (;;) {
        sum = 0u; cnt = 0u; mine = 0u;
#pragma unroll
        for (unsigned j = 0; j < 16; ++j) { const unsigned c = xb_ld(&bar[XB_XCNT(j)]); sum += c; cnt += (c > 0u) ? 1u : 0u; mine = (j == x) ? c : mine; }
        if (sum == G) break;
        __builtin_amdgcn_s_sleep(1);
        if ((++sp & 255u) == 0u) { if (xb_ld(&bar[XB_TMO])) break; if (sp > XB_SPIN_CAP) { atomicAdd(&bar[XB_TMO], 1u); break; } }
    }
    nloc = mine > 0u ? mine : 1u; nx = cnt > 0u ? cnt : 1u;
}

__device__ __forceinline__ void xcd_barrier(const XcdBarrier& b) {
    asm volatile("s_waitcnt vmcnt(0)" ::: "memory");
    __syncthreads();
    if (threadIdx.x == 0) {
        unsigned* bar = b.bar;
        __builtin_amdgcn_s_waitcnt(0);
        unsigned nloc = b.st[0], nx = b.st[1];
        if (nloc == 0u) { xcd_barrier_complete(bar, b.x, nloc, nx); b.st[0] = nloc; b.st[1] = nx; }
        const unsigned old = xb_add(&bar[XB_XSUB(b.x)], 1u);
        const unsigned gen = old / nloc;
        if (old + 1u == (gen + 1u) * nloc) {
            __builtin_amdgcn_fence(__ATOMIC_RELEASE, "agent");
            asm volatile("s_waitcnt vmcnt(0)" ::: "memory");
            const unsigned og = xb_add(&bar[XB_TOP], 1u);
            const unsigned tg = og / nx;
            if (og + 1u == (tg + 1u) * nx) xb_add(&bar[XB_TOPGEN], 1u);
            else XB_SPIN(xb_ld(&bar[XB_TOPGEN]) == tg, bar);
            __builtin_amdgcn_fence(__ATOMIC_ACQUIRE, "agent");
            xb_add(&bar[XB_XGEN(b.x)], 1u);
            asm volatile("s_waitcnt vmcnt(0)" ::: "memory");
        } else {
            XB_SPIN(xb_ld(&bar[XB_XGEN(b.x)]) == gen, bar);
            __builtin_amdgcn_fence(__ATOMIC_ACQUIRE, "agent");
            asm volatile("s_waitcnt vmcnt(0)" ::: "memory");
        }
    }
    __syncthreads();
}
struct Args { const float* in[26]; float* out; unsigned char* ws; int ph_lo, ph_hi, li, pad; };
struct Frame {
    LAS unsigned char* lds;
    volatile LAS unsigned* MISC;
    gu32* ctl;
    int tid, lane, wave, vcu, G;
    const Args* A; float* out; unsigned char* ws;
    DI const float* in(int k) const { return A->in[k]; }
    template <class T> DI T* wsp(size_t off) const { return (T*)(ws + off); }
};

DI void p0_transpose_item(const float* W, int K, int N, bf16* WT, LAS float* scr, int item, int lane, const float* g0, const float* g1, int gsplit) {
    const int nblk = N / 32, kb = item / nblk, nb = item % nblk, k0 = 64 * kb, n0 = 32 * nb;
#pragma unroll 8
    for (int i = 0; i < 32; ++i) { const int kk = 2 * i + (lane >> 5); const int k = k0 + kk;
        float g = 1.f; if (g0) g = (k < gsplit) ? g0[k] : g1[k - gsplit];
        scr[kk * 33 + (lane & 31)] = W[(size_t)k * N + n0 + (lane & 31)] * g; }
    LDS_WAIT(); asm volatile("" ::: "memory");
    const int c = lane & 7;
#pragma unroll
    for (int j = 0; j < 4; ++j) { const int n = (lane >> 3) + 8 * j; const LAS float* s = scr + (8 * c) * 33 + n;
        v4u o; o.x = pk2(s[0 * 33], s[1 * 33]); o.y = pk2(s[2 * 33], s[3 * 33]); o.z = pk2(s[4 * 33], s[5 * 33]); o.w = pk2(s[6 * 33], s[7 * 33]);
        *(GAS v4u*)(WT + (size_t)(n0 + n) * K + k0 + 8 * c) = o; }
    LDS_WAIT(); asm volatile("" ::: "memory");
}
template <bool NORM> DI void row_to_bf16(const float* xrow, bf16* orow, const float* gain, int lane) {
    const GAS f32x4* xr = (const GAS f32x4*)xrow + lane;
    f32x4 v[4]; float s = 0.f;
#pragma unroll
    for (int j = 0; j < 4; ++j) { v[j] = xr[64 * j]; s += (v[j].x * v[j].x + v[j].y * v[j].y) + (v[j].z * v[j].z + v[j].w * v[j].w); }
    float rstd = 1.f;
    if (NORM) rstd = 1.0f / sqrtf(sum64(s) * (1.f / 1024.f) + EPS);
    GAS v2u* o8 = (GAS v2u*)orow + lane;
#pragma unroll
    for (int j = 0; j < 4; ++j) { f32x4 w = v[j] * rstd; if (gain) w = w * ((const GAS f32x4*)gain)[64 * j + lane];
        v2u o; o.x = pk2(w.x, w.y); o.y = pk2(w.z, w.w); o8[64 * j] = o; }
}
constexpr float U_SCALE = 128.f, V_SCALE = 16.f;
template <bool NORM, int NB> DI void rows_to_bf16(const float* xrow, bf16* orow, size_t row_stride, const float* gain, int lane) {
    f32x4 v[NB][4];
#pragma unroll
    for (int b = 0; b < NB; ++b)
#pragma unroll
        for (int j = 0; j < 4; ++j) v[b][j] = ((const GAS f32x4*)(xrow + b * row_stride))[64 * j + lane];
#pragma unroll
    for (int b = 0; b < NB; ++b) { float s = 0.f;
#pragma unroll
        for (int j = 0; j < 4; ++j) s += (v[b][j].x * v[b][j].x + v[b][j].y * v[b][j].y) + (v[b][j].z * v[b][j].z + v[b][j].w * v[b][j].w);
        float rstd = 1.f; if (NORM) rstd = rsq_(sum64(s) * (1.f / 1024.f) + EPS);
        GAS v2u* o8 = (GAS v2u*)(orow + b * row_stride) + lane;
#pragma unroll
        for (int j = 0; j < 4; ++j) { f32x4 w = v[b][j] * rstd; if (gain) w = w * ((const GAS f32x4*)gain)[64 * j + lane];
            v2u o; o.x = pk2(w.x, w.y); o.y = pk2(w.z, w.w); o8[64 * j] = o; } }
}
DI void row_to_fp8(const float* src, unsigned char* dst, const float* gain, float scale, int lane) {
#pragma unroll
    for (int j = 0; j < 4; ++j) { f32x4 v = ((const GAS f32x4*)src)[64 * j + lane] * scale; if (gain) v = v * ((const GAS f32x4*)gain)[64 * j + lane];
        unsigned w = 0u; w = __builtin_amdgcn_cvt_pk_fp8_f32(v.x, v.y, w, false); w = __builtin_amdgcn_cvt_pk_fp8_f32(v.z, v.w, w, true);
        ((GAS unsigned*)dst)[64 * j + lane] = w; }
}
DI void row_to_i8(const float* src, unsigned char* dst, const float* gain, float* scale_out, int lane) {
    f32x4 v[4]; float mx = 0.f;
#pragma unroll
    for (int j = 0; j < 4; ++j) { v[j] = ((const GAS f32x4*)src)[64 * j + lane] * ((const GAS f32x4*)gain)[64 * j + lane];
        mx = fmaxf(fmaxf(mx, fmaxf(fabsf(v[j].x), fabsf(v[j].y))), fmaxf(fabsf(v[j].z), fabsf(v[j].w))); }
    mx = fmaxf(max64(mx), 1e-30f);
    const float inv = 127.0f / mx;
#pragma unroll
    for (int j = 0; j < 4; ++j) ((GAS unsigned*)dst)[64 * j + lane] = pack_i8x4(v[j].x * inv, v[j].y * inv, v[j].z * inv, v[j].w * inv);
    if (lane == 0) *scale_out = mx * (1.0f / 127.0f);
}
DI void convert_experts(Frame& F, int wv, int nwv) {
    const int lane = F.lane;
    const int l5 = lane & 31, hh = lane >> 5;
    for (int m = wv * 2; m < NEXP; m += nwv * 2) {
        f32x4 u[2][4], v[8];
#pragma unroll
        for (int b = 0; b < 2; ++b)
#pragma unroll
            for (int j = 0; j < 4; ++j) u[b][j] = ((const GAS f32x4*)(F.in(23) + (size_t)(m + b) * DM))[64 * j + lane];
#pragma unroll
        for (int j = 0; j < 8; ++j) v[j] = ((const GAS f32x4*)(F.in(24) + (size_t)(m + hh) * DM))[8 * l5 + j];
#pragma unroll
        for (int b = 0; b < 2; ++b) {
            float mx = 0.f;
#pragma unroll
            for (int j = 0; j < 4; ++j) { u[b][j] = u[b][j] * ((const GAS f32x4*)F.in(20))[64 * j + lane];
                mx = fmaxf(fmaxf(mx, fmaxf(fabsf(u[b][j].x), fabsf(u[b][j].y))), fmaxf(fabsf(u[b][j].z), fabsf(u[b][j].w))); }
            mx = fmaxf(max64(mx), 1e-30f);
            const float inv = 127.0f / mx;
#pragma unroll
            for (int j = 0; j < 4; ++j) ((GAS unsigned*)(F.wsp<unsigned char>(WS_EU) + (size_t)(m + b) * DM))[64 * j + lane] = pack_i8x4(u[b][j].x * inv, u[b][j].y * inv, u[b][j].z * inv, u[b][j].w * inv);
            if (lane == 0) F.wsp<float>(WS_SU)[m + b] = mx * (1.0f / 127.0f);
        }
        {
            float mx = 0.f;
#pragma unroll
            for (int j = 0; j < 8; ++j) mx = fmaxf(fmaxf(mx, fmaxf(fabsf(v[j].x), fabsf(v[j].y))), fmaxf(fabsf(v[j].z), fabsf(v[j].w)));
            mx = fmaxf(max32(mx), 1e-30f);
            const float inv = 7.5f / mx;
            v32h h;
#pragma unroll
            for (int j = 0; j < 8; ++j) { h[4 * j] = (_Float16)(v[j].x * inv); h[4 * j + 1] = (_Float16)(v[j].y * inv); h[4 * j + 2] = (_Float16)(v[j].z * inv); h[4 * j + 3] = (_Float16)(v[j].w * inv); }
            const v6u pk = __builtin_amdgcn_cvt_scalef32_pk32_fp6_f16(h, 1.0f);
            unsigned char* rowp = F.wsp<unsigned char>(WS_EV) + (size_t)(m + hh) * EV_ROW;
            *(GAS v4u*)(rowp + 16 * l5) = (v4u){pk[0], pk[1], pk[2], pk[3]}; *(GAS v2u*)(rowp + 512 + 8 * l5) = (v2u){pk[4], pk[5]};
            if (l5 == 0) F.wsp<float>(WS_SU)[NEXP + m + hh] = mx * (1.0f / 7.5f);
        }
    }
}
DI void p0_prologue(Frame& F) {
    LAS float* scr = (LAS float*)(F.lds + F.wave * 16384);
    const int gw = F.vcu * NWAVES + F.wave, NGW = F.G * NWAVES, lane = F.lane;
    constexpr int I_IN = 16 * (INW / 32), I_D = 16 * (DM / 32), I_2D = 16 * (2 * DM / 32);
    constexpr int NITEMS = I_IN + 3 * I_D + 2 * I_2D;
    for (int it = gw; it < NITEMS; it += NGW) {
        int r = it;
        if (r < I_IN) { p0_transpose_item(F.in(3), DM, INW, F.wsp<bf16>(WS_WIN), scr, r, lane, F.in(2), F.in(2), DM); continue; } r -= I_IN;
        if (r < I_D) { p0_transpose_item(F.in(14), DM, DM, F.wsp<bf16>(WS_WOUT), scr, r, lane, F.in(12), F.in(13), LRUW); continue; } r -= I_D;
        if (r < I_D) { p0_transpose_item(F.in(17), DM, DM, F.wsp<bf16>(WS_WQ), scr, r, lane, F.in(15), F.in(15), DM); continue; } r -= I_D;
        if (r < I_2D) { p0_transpose_item(F.in(18), DM, 2 * DM, F.wsp<bf16>(WS_WKV), scr, r, lane, nullptr, nullptr, 0); continue; } r -= I_2D;
        if (r < I_D) { p0_transpose_item(F.in(19), DM, DM, F.wsp<bf16>(WS_WO), scr, r, lane, nullptr, nullptr, 0); continue; } r -= I_D;
        p0_transpose_item(F.in(21), DM, 2 * DM, F.wsp<bf16>(WS_WQRY), scr, r, lane, F.in(20), F.in(20), DM);
    }
    for (int m = gw * 4; m < M; m += NGW * 4) rows_to_bf16<true, 4>(F.in(0) + (size_t)m * DM, F.wsp<bf16>(WS_XN) + (size_t)m * DM, DM, nullptr, lane);
    for (int m = gw; m < NBATCH * 256; m += NGW) row_to_bf16<true>(F.in(1) + (size_t)m * DM, F.wsp<bf16>(WS_MEMN) + (size_t)m * DM, F.in(16), lane);
    { const int gt = gw * 64 + lane, NT = NGW * 64;
      for (int i = gt; i < 8 * 2 * 128 * 128 / 4; i += NT) { const f32x4 v = ((const GAS f32x4*)F.in(22))[i]; v2u o; o.x = pk2(v.x, v.y); o.y = pk2(v.z, v.w); ((GAS v2u*)F.wsp<bf16>(WS_SUBK))[i] = o; }
      for (int o = gt; o < 2 * 8 * 64 * 64; o += NT) { const int i = o & 63, j = (o >> 6) & 63, h = (o >> 12) & 7, g = o >> 15;
          const float* W = g ? F.in(8) : F.in(6); F.wsp<bf16>(WS_GATEW)[o] = f2bf(W[(h * 64 + i) * 64 + j]); } }
}
struct LruState { float ba[2], bx[2], sp[2], S[2], Ap[2]; };
template <bool PASS2>
DI void lru_prep(const Frame& F, int b, int chunk, int h, int lane, LAS unsigned char* xcs  , LruState& st) {
    const int r = lane & 31, hh = lane >> 5;
    const size_t row0 = (size_t)b * SEQ + (size_t)chunk * 64;
    {
        const int c2 = h * 64 + 2 * r;
        const f32x2 w0 = *(const f32x2*)(F.in(4) + c2), w1 = *(const f32x2*)(F.in(4) + LRUW + c2), w2 = *(const f32x2*)(F.in(4) + 2 * LRUW + c2), w3 = *(const f32x2*)(F.in(4) + 3 * LRUW + c2);
        const f32x2 cb = *(const f32x2*)(F.in(5) + c2);
        const int tl0 = 32 * hh;
        const bf16* zp = F.wsp<bf16>(WS_Z) + (row0 + tl0) * ZW + c2;
        const bool first = (chunk == 0 && hh == 0);
        unsigned p0 = first ? 0u : *(const unsigned*)(zp - 3 * ZW), p1 = first ? 0u : *(const unsigned*)(zp - 2 * ZW), p2 = first ? 0u : *(const unsigned*)(zp - ZW);
#pragma unroll
        for (int t = 0; t < 32; ++t) { const unsigned p3 = *(const unsigned*)(zp + (size_t)t * ZW);
            const float lo = cb.x + bflo(p0) * w0.x + bflo(p1) * w1.x + bflo(p2) * w2.x + bflo(p3) * w3.x;
            const float hi = cb.y + bfhi(p0) * w0.y + bfhi(p1) * w1.y + bfhi(p2) * w2.y + bfhi(p3) * w3.y;
            *(LAS unsigned*)(xcs + (tl0 + t) * 144 + 4 * r) = pk2(lo, hi);
            p0 = p1; p1 = p2; p2 = p3; }
        LDS_WAIT();
    }
#pragma unroll
    for (int nt = 0; nt < 2; ++nt) { const int c = h * 64 + 32 * nt + r; st.ba[nt] = F.in(7)[c]; st.bx[nt] = F.in(9)[c];
        const float nl = -F.in(10)[c]; st.sp[nt] = fmaxf(nl, 0.f) + log1pf(__expf(-fabsf(nl))); st.S[nt] = 0.f; st.Ap[nt] = 1.f; }
    if (PASS2) {
        float s = 0.f; const float* ag = F.wsp<float>(WS_AGG) + ((size_t)b * NCHUNK * LRUW + h * 64 + lane) * 2;
        for (int c0 = 0; c0 < chunk; c0 += 32) {
            f32x2 ab[32];
#pragma unroll
            for (int i = 0; i < 32; ++i) ab[i] = *(const f32x2*)(ag + (size_t)(c0 + i < NCHUNK ? c0 + i : NCHUNK - 1) * LRUW * 2);
#pragma unroll
            for (int i = 0; i < 32; ++i) { const bool on = c0 + i < chunk; s = (on ? ab[i].x : 1.0f) * s + (on ? ab[i].y : 0.0f); }
        }
        st.S[0] = __shfl(s, r); st.S[1] = __shfl(s, 32 + r);
    }
}
template <bool PASS2>
DI void lru_tile(const Frame& F, int b, int chunk, int mt, int h, int lane, LAS unsigned char* xcs, LAS unsigned char* gim  , LruState& st, float (&ssq)[16]) {
    const int r = lane & 31, hh = lane >> 5;
    const size_t row0 = (size_t)b * SEQ + (size_t)chunk * 64;
    const bf16* gw = F.wsp<bf16>(WS_GATEW) + (size_t)h * 4096;
    bf16x8 af[4];
#pragma unroll
    for (int s = 0; s < 4; ++s) af[s] = *(const LAS bf16x8*)(xcs + (32 * mt + r) * 144 + (16 * s + 8 * hh) * 2);
    float ssl[16];
#pragma unroll
    for (int i = 0; i < 16; ++i) ssl[i] = 0.f;
    if (PASS2) {
#pragma unroll
        for (int i = 0; i < 4; ++i) { const int row = (lane >> 3) + 8 * i, c = lane & 7;
            *(LAS v4u*)(gim + row * 144 + c * 16) = *(const v4u*)(F.wsp<bf16>(WS_Z) + (row0 + 32 * mt + row) * ZW + LRUW + h * 64 + 8 * c); }
        LDS_WAIT();
    }
#pragma unroll
    for (int nt = 0; nt < 2; ++nt) {
        asm volatile("" ::: "memory");
        f32x16 aa = {}, ax = {};
#pragma unroll
        for (int s = 0; s < 4; ++s) {
            const bf16x8 wa = *(const bf16x8*)(gw + (size_t)(32 * nt + r) * 64 + 16 * s + 8 * hh);
            const bf16x8 wx = *(const bf16x8*)(gw + 32768 + (size_t)(32 * nt + r) * 64 + 16 * s + 8 * hh);
            aa = MFMA32(af[s], wa, aa); ax = MFMA32(af[s], wx, ax);
        }
#pragma unroll
        for (int i = 0; i < 16; ++i) {
            const float rg = sigmoidf_(aa[i] + st.ba[nt]), ig = sigmoidf_(ax[i] + st.bx[nt]);
            const float la = -8.0f * rg * st.sp[nt];
            const float a = exp2_(LOG2E * la);
            const float mult = __builtin_amdgcn_sqrtf(fmaxf(1.0f - a * a, 0.f));
            const float xc = bf2f(*(const LAS bf16*)(xcs + (32 * mt + crow(i, hh)) * 144 + (32 * nt + r) * 2));
            aa[i] = a; ax[i] = mult * ig * xc;
        }
        float Ao[4], Bo[4], Aq[4], Bq[4], Sin[4];
#pragma unroll
        for (int q = 0; q < 4; ++q) { const float a0 = aa[4 * q], a1 = aa[4 * q + 1], a2 = aa[4 * q + 2], a3 = aa[4 * q + 3];
            Ao[q] = (a0 * a1) * (a2 * a3); Bo[q] = ((ax[4 * q] * a1 + ax[4 * q + 1]) * a2 + ax[4 * q + 2]) * a3 + ax[4 * q + 3];
            Aq[q] = swap32_partner(Ao[q], hh); Bq[q] = swap32_partner(Bo[q], hh); }
        float s_ = st.S[nt];
#pragma unroll
        for (int q = 0; q < 4; ++q) { const float A1 = hh ? Aq[q] : Ao[q], B1 = hh ? Bq[q] : Bo[q], A2 = hh ? Ao[q] : Aq[q], B2 = hh ? Bo[q] : Bq[q];
            const float smid = A1 * s_ + B1; Sin[q] = hh ? smid : s_; s_ = A2 * smid + B2; st.Ap[nt] *= A1 * A2; }
        st.S[nt] = s_;
        if (PASS2) {
#pragma unroll
            for (int q = 0; q < 4; ++q) { float hp = Sin[q];
#pragma unroll
                for (int e = 0; e < 4; ++e) { const int i = 4 * q + e; hp = aa[i] * hp + ax[i];
                    const float gt = bf2f(*(const LAS bf16*)(gim + crow(i, hh) * 144 + (32 * nt + r) * 2));
                    const float y = hp * gelu_tanh(gt); ssl[i] += y * y;
                    *(LAS bf16*)(xcs + (32 * mt + crow(i, hh)) * 144 + (32 * nt + r) * 2) = f2bf(y); } }
        }
    }
    if (PASS2) {
#pragma unroll
        for (int i = 0; i < 16; ++i) ssq[i] = sum32(ssl[i]);
    }
}
constexpr int ATT_KST = 144, ATT_VST = 136, ATT_KBYTES = 64 * ATT_KST, ATT_VBYTES = 64 * ATT_VST;
DI void attn_wave(const Frame& F, int b, int n, int qt, int h, int lane, const LAS float* tab, LAS unsigned char* kl  , f32x16 (&o)[2]) {
    const int r = lane & 31, hh = lane >> 5;
    LAS unsigned char* vl = kl + ATT_KBYTES;
    const size_t row0 = (size_t)b * SEQ + (size_t)n * 64;
    const float SC = 0.125f * LOG2E;
    bf16x8 qf[4];
#pragma unroll
    for (int s = 0; s < 4; ++s) qf[s] = *(const bf16x8*)(F.wsp<bf16>(WS_Z) + (row0 + 32 * qt + r) * ZW + 2 * LRUW + h * 64 + 16 * s + 8 * hh);
    float mrun = -1e30f, lrun = 0.f;
#pragma unroll
    for (int dt = 0; dt < 2; ++dt) o[dt] = f32x16{};
    const float bfar = tab[256];
    const int srow = lane >> 3, sc8 = lane & 7;
    const int kc0 = (n >= 8 ? n - 8 : 0);
    const char* kg = (const char*)(F.wsp<bf16>(WS_Z) + (size_t)b * SEQ * ZW + 2 * LRUW + ATTW + h * 64);
    const char* vg = (const char*)(F.wsp<bf16>(WS_VT) + (size_t)(b * 8 + h) * 64 * SEQ);
    const unsigned kof = (unsigned)(srow * ZW + 8 * sc8) * 2u, vof = (unsigned)(srow * SEQ + 8 * sc8) * 2u;
    v4u kreg[8];
#pragma unroll
    for (int i = 0; i < 8; ++i) kreg[i] = *(const v4u*)(kg + ((size_t)kc0 * 64 + 8 * i) * ZW * 2 + kof);
    for (int kc = kc0; kc <= n; ++kc) {
        const int dd = n - kc;
        v4u vreg[8];
#pragma unroll
        for (int i = 0; i < 8; ++i) { *(LAS v4u*)(kl + (srow + 8 * i) * ATT_KST + sc8 * 16) = kreg[i]; vreg[i] = *(const v4u*)(vg + ((size_t)(8 * i) * SEQ + kc * 64) * 2 + vof); }
        f32x16 sc[2];
#pragma unroll
        for (int kt = 0; kt < 2; ++kt) { sc[kt] = f32x16{};
#pragma unroll
            for (int s = 0; s < 4; ++s) { const bf16x8 kf = *(const LAS bf16x8*)(kl + (32 * kt + r) * ATT_KST + (16 * s + 8 * hh) * 2); sc[kt] = MFMA32(kf, qf[s], sc[kt]); } }
        if (dd >= 3) {
#pragma unroll
            for (int kt = 0; kt < 2; ++kt)
#pragma unroll
                for (int i = 0; i < 16; ++i) sc[kt][i] = sc[kt][i] * SC + bfar;
        } else {
            const int base = 64 * dd + 32 * qt + r + 128;
#pragma unroll
            for (int kt = 0; kt < 2; ++kt)
#pragma unroll
                for (int i = 0; i < 16; ++i) { int idx = base - (32 * kt + crow(i, hh)); idx = idx > 256 ? 256 : idx; sc[kt][i] = sc[kt][i] * SC + tab[idx]; }
        }
        float mx = sc[0][0];
#pragma unroll
        for (int kt = 0; kt < 2; ++kt)
#pragma unroll
            for (int i = 0; i < 16; ++i) mx = fmaxf(mx, sc[kt][i]);
        mx = fmaxf(mx, swap32_partner(mx, hh));
        const float mnew = fmaxf(mrun, mx), alpha = exp2_(mrun - mnew);
        float ls = 0.f;
#pragma unroll
        for (int kt = 0; kt < 2; ++kt)
#pragma unroll
            for (int i = 0; i < 16; ++i) { const float p = exp2_(sc[kt][i] - mnew); sc[kt][i] = p; ls += p; }
        lrun = lrun * alpha + ls; mrun = mnew;
#pragma unroll
        for (int dt = 0; dt < 2; ++dt)
#pragma unroll
            for (int i = 0; i < 16; ++i) o[dt][i] *= alpha;
#pragma unroll
        for (int i = 0; i < 8; ++i) { LAS v2u* vd = (LAS v2u*)(vl + (srow + 8 * i) * ATT_VST + sc8 * 16); vd[0] = (v2u){vreg[i].x, vreg[i].y}; vd[1] = (v2u){vreg[i].z, vreg[i].w}; }
        if (kc < n) {
#pragma unroll
            for (int i = 0; i < 8; ++i) kreg[i] = *(const v4u*)(kg + ((size_t)(kc + 1) * 64 + 8 * i) * ZW * 2 + kof);
        }
#pragma unroll
        for (int kt = 0; kt < 2; ++kt)
#pragma unroll
            for (int s2 = 0; s2 < 2; ++s2) { v4u w; w.x = pk2(sc[kt][8 * s2], sc[kt][8 * s2 + 1]); w.y = pk2(sc[kt][8 * s2 + 2], sc[kt][8 * s2 + 3]); w.z = pk2(sc[kt][8 * s2 + 4], sc[kt][8 * s2 + 5]); w.w = pk2(sc[kt][8 * s2 + 6], sc[kt][8 * s2 + 7]);
                const bf16x8 pf = __builtin_bit_cast(bf16x8, w);
#pragma unroll
                for (int dt = 0; dt < 2; ++dt) { const LAS unsigned char* vp = vl + (32 * dt + r) * ATT_VST + (32 * kt + 16 * s2 + 4 * hh) * 2;
                    const v2u lo = *(const LAS v2u*)vp, hi = *(const LAS v2u*)(vp + 16); v4u vw; vw.x = lo.x; vw.y = lo.y; vw.z = hi.x; vw.w = hi.y;
                    o[dt] = MFMA32(__builtin_bit_cast(bf16x8, vw), pf, o[dt]); } }
    }
    const float lt = lrun + swap32_partner(lrun, hh); const float inv = rcp_(lt);
#pragma unroll
    for (int dt = 0; dt < 2; ++dt)
#pragma unroll
        for (int i = 0; i < 16; ++i) o[dt][i] *= inv;
}

DI void p2_lru_aggregates(Frame& F) {
    const int lane = F.lane, r = lane & 31, hh = lane >> 5, h = F.wave;
    LAS unsigned char* xcs = F.lds + 12288 + h * 17920;
    for (int u = F.vcu; u < NBATCH * NCHUNK; u += F.G) {
        const int b = u / NCHUNK, n = u % NCHUNK;
        LruState st; float ssq[16];
        lru_prep<false>(F, b, n, h, lane, xcs, st);
#pragma unroll 1
        for (int mt = 0; mt < 2; ++mt) lru_tile<false>(F, b, n, mt, h, lane, xcs, xcs + 9216, st, ssq);
        if (hh == 0) {
#pragma unroll
            for (int nt = 0; nt < 2; ++nt) *(f32x2*)(F.wsp<float>(WS_AGG) + (((size_t)b * NCHUNK + n) * LRUW + h * 64 + 32 * nt + r) * 2) = (f32x2){st.Ap[nt], st.S[nt]};
        }
        LDS_WAIT();
    }
}
DI void p3_mixer(Frame& F, int parts = 3) {
    const int lane = F.lane, r = lane & 31, hh = lane >> 5, h = F.wave;
    LAS float* ssx = (LAS float*)(F.lds);
    LAS float* tab = (LAS float*)(F.lds + 2048 + h * 1280);
    LAS unsigned* stg = (LAS unsigned*)(F.lds + 12288 + h * 17920);
    for (int i = lane; i < 257; i += 64) tab[i] = F.in(11)[h * 257 + i] * LOG2E;
    LDS_WAIT();
    for (int u = F.vcu; u < NBATCH * NCHUNK; u += F.G) {
        const int b = u / NCHUNK, n = u % NCHUNK; const size_t row0 = (size_t)b * SEQ + (size_t)n * 64;
#ifndef MIX_PARTS
#define MIX_PARTS 3
#endif
        if (parts & 1) {
            LruState st;
            lru_prep<true>(F, b, n, h, lane, (LAS unsigned char*)stg, st);
#pragma unroll 1
            for (int mt = 0; mt < 2; ++mt) {
                float ssq[16];
                lru_tile<true>(F, b, n, mt, h, lane, (LAS unsigned char*)stg, (LAS unsigned char*)stg + 9216, st, ssq);
                if (r == 0) {
#pragma unroll
                    for (int i = 0; i < 16; ++i) ssx[crow(i, hh) * 8 + h] = ssq[i];
                }
                __syncthreads();
                const LAS unsigned char* yst = (const LAS unsigned char*)stg + 32 * mt * 144;
#pragma unroll
                for (int i = 0; i < 4; ++i) { const int row = (lane >> 3) + 8 * i, c = lane & 7;
                    const f32x4 s0 = *(const LAS f32x4*)(ssx + row * 8), s1 = *(const LAS f32x4*)(ssx + row * 8 + 4);
                    const float rs = rsq_(((s0.x + s0.y) + (s0.z + s0.w) + (s1.x + s1.y) + (s1.z + s1.w)) * (1.f / 512.f) + EPS);
                    const v4u v = *(const LAS v4u*)(yst + row * 144 + c * 16);
                    v4u o; o.x = pk2(bflo(v.x) * rs, bfhi(v.x) * rs); o.y = pk2(bflo(v.y) * rs, bfhi(v.y) * rs); o.z = pk2(bflo(v.z) * rs, bfhi(v.z) * rs); o.w = pk2(bflo(v.w) * rs, bfhi(v.w) * rs);
                    *(v4u*)(F.wsp<bf16>(WS_Y) + (row0 + 32 * mt + row) * DM + h * 64 + 8 * c) = o; }
                __syncthreads();
            }
        }
    }
    for (int u = F.vcu; u < NBATCH * NCHUNK; u += F.G) {
        const int b = u / NCHUNK, n = u % NCHUNK; const size_t row0 = (size_t)b * SEQ + (size_t)n * 64;
#pragma unroll 1
        for (int qt = 0; qt < ((parts & 2) ? 2 : 0); ++qt) {
            f32x16 o[2];
            attn_wave(F, b, n, qt, h, lane, tab, (LAS unsigned char*)stg, o);
            float s = 0.f;
#pragma unroll
            for (int dt = 0; dt < 2; ++dt)
#pragma unroll
                for (int i = 0; i < 16; ++i) s += o[dt][i] * o[dt][i];
            s += swap32_partner(s, hh);
            if (hh == 0) ssx[r * 8 + h] = s;
            __syncthreads();
            { const f32x4 s0 = *(const LAS f32x4*)(ssx + r * 8), s1 = *(const LAS f32x4*)(ssx + r * 8 + 4);
              const float rs = rsq_(((s0.x + s0.y) + (s0.z + s0.w) + (s1.x + s1.y) + (s1.z + s1.w)) * (1.f / 512.f) + EPS);
#pragma unroll
              for (int dt = 0; dt < 2; ++dt)
#pragma unroll
                  for (int i = 0; i < 16; i += 2) stg[r * 33 + ((32 * dt + crow(i, hh)) >> 1)] = pk2(o[dt][i] * rs, o[dt][i + 1] * rs); }
            LDS_WAIT();
#pragma unroll 4
            for (int i = 0; i < 16; ++i) { const int row = 2 * i + hh; const unsigned v = stg[row * 33 + r];
                *(GAS unsigned*)(F.wsp<bf16>(WS_Y) + (row0 + 32 * qt + row) * DM + LRUW + h * 64 + 2 * r) = v; }
            __syncthreads();
        }
    }
}
DI void p5_cross(Frame& F, const pg8::StaticOrder& S) {
    const int lane = F.lane, r = lane & 31, hh = lane >> 5, w = F.wave, tid = F.tid;
    constexpr int KST = 528, VST = 520;
    const float SC = 0.0625f * LOG2E;
    pg8::Unit un;
    for (int ui = 0; S.next(ui, un); ++ui) {
        const int b = un.pm >> 5, qb = un.pm & 31, hm = un.pn;
        const size_t qrow = (size_t)b * SEQ + (size_t)qb * 256 + 32 * w + r;
        { const bf16* src = F.wsp<bf16>(WS_KM) + (size_t)(b * 256) * DM + hm * 256;
#pragma unroll 4
          for (int i = 0; i < 16; ++i) { const int c = i * 512 + tid, row = c >> 5, ch = c & 31;
              *(LAS v4u*)(F.lds + row * KST + ch * 16) = *(const v4u*)(src + (size_t)row * DM + ch * 8); } }
        __syncthreads();
        f32x16 sc[8];
#pragma unroll
        for (int kt = 0; kt < 8; ++kt) sc[kt] = f32x16{};
#pragma unroll 2
        for (int s = 0; s < 16; ++s) {
            const bf16x8 qf = *(const bf16x8*)(F.wsp<bf16>(WS_QC) + qrow * DM + hm * 256 + 16 * s + 8 * hh);
#pragma unroll
            for (int kt = 0; kt < 8; ++kt) { const bf16x8 kf = *(const LAS bf16x8*)(F.lds + (32 * kt + r) * KST + (16 * s + 8 * hh) * 2); sc[kt] = MFMA32(kf, qf, sc[kt]); }
        }
        float mx = sc[0][0];
#pragma unroll
        for (int kt = 0; kt < 8; ++kt)
#pragma unroll
            for (int i = 0; i < 16; ++i) mx = fmaxf(mx, sc[kt][i]);
        mx = fmaxf(mx, swap32_partner(mx, hh));
        float ls = 0.f; const float mo = mx * SC;
        bf16x8 pf[8][2];
#pragma unroll
        for (int kt = 0; kt < 8; ++kt) {
#pragma unroll
            for (int i = 0; i < 16; ++i) { const float p = exp2_(sc[kt][i] * SC - mo); sc[kt][i] = p; ls += p; }
#pragma unroll
            for (int s2 = 0; s2 < 2; ++s2) { v4u wv; wv.x = pk2(sc[kt][8 * s2], sc[kt][8 * s2 + 1]); wv.y = pk2(sc[kt][8 * s2 + 2], sc[kt][8 * s2 + 3]); wv.z = pk2(sc[kt][8 * s2 + 4], sc[kt][8 * s2 + 5]); wv.w = pk2(sc[kt][8 * s2 + 6], sc[kt][8 * s2 + 7]);
                pf[kt][s2] = __builtin_bit_cast(bf16x8, wv); }
        }
        ls += swap32_partner(ls, hh);
        const float inv = 1.0f / ls;
        __syncthreads();
        { const bf16* src = F.wsp<bf16>(WS_VMT) + (size_t)((b * 4 + hm) * 256) * 256;
#pragma unroll 4
          for (int i = 0; i < 16; ++i) { const int c = i * 512 + tid, row = c >> 5, ch = c & 31; const v4u v = *(const v4u*)(src + (size_t)row * 256 + ch * 8);
              LAS v2u* d = (LAS v2u*)(F.lds + row * VST + ch * 16); d[0] = (v2u){v.x, v.y}; d[1] = (v2u){v.z, v.w}; } }
        __syncthreads();
        LAS unsigned* stg = (LAS unsigned*)(F.lds) ;
#pragma unroll
        for (int half = 0; half < 2; ++half) {
            f32x16 o[4];
#pragma unroll
            for (int dt = 0; dt < 4; ++dt) o[dt] = f32x16{};
#pragma unroll
            for (int kt = 0; kt < 8; ++kt)
#pragma unroll
                for (int s2 = 0; s2 < 2; ++s2)
#pragma unroll
                    for (int dt = 0; dt < 4; ++dt) { const LAS unsigned char* p = F.lds + (128 * half + 32 * dt + r) * VST + (32 * kt + 16 * s2 + 4 * hh) * 2;
                        const v2u lo = *(const LAS v2u*)p, hi = *(const LAS v2u*)(p + 16); v4u wv; wv.x = lo.x; wv.y = lo.y; wv.z = hi.x; wv.w = hi.y;
                        o[dt] = MFMA32(__builtin_bit_cast(bf16x8, wv), pf[kt][s2], o[dt]); }
            if (half == 1) __syncthreads();
            else {   }
            if (half == 0) {
#pragma unroll
                for (int dt = 0; dt < 4; ++dt)
#pragma unroll
                    for (int i = 0; i < 16; i += 2) { const unsigned pv = pk2(o[dt][i] * inv, o[dt][i + 1] * inv); sc[dt][i >> 1] = __uint_as_float(pv); }
            } else {
                LAS unsigned* sw = (LAS unsigned*)(F.lds + w * 16512);
#pragma unroll
                for (int dt = 0; dt < 4; ++dt)
#pragma unroll
                    for (int i = 0; i < 16; i += 2) { sw[r * 129 + ((32 * dt + crow(i, hh)) >> 1)] = __float_as_uint(sc[dt][i >> 1]);
                        sw[r * 129 + 64 + ((32 * dt + crow(i, hh)) >> 1)] = pk2(o[dt][i] * inv, o[dt][i + 1] * inv); }
                LDS_WAIT();
#pragma unroll 4
                for (int i = 0; i < 32; ++i) { const unsigned v0 = sw[i * 129 + lane], v1 = sw[i * 129 + 64 + lane];
                    GAS unsigned* dst = (GAS unsigned*)(F.wsp<bf16>(WS_OC) + ((size_t)b * SEQ + (size_t)qb * 256 + 32 * w + i) * DM + hm * 256);
                    dst[lane] = v0; dst[64 + lane] = v1; }
            }
        }
        (void)stg;
        __syncthreads();
    }
}
template <int N> DI void ce_desc(float (&a)[N], int i, int l) { const float hi = fmaxf(a[i], a[l]), lo = fminf(a[i], a[l]); a[i] = hi; a[l] = lo; }
template <int N, int OFF> DI void bitonic_sort16_desc(float (&a)[N]) {
#define CE_(i, j) ce_desc<N>(a, OFF + (i), OFF + (j))
    CE_(0,13); CE_(1,12); CE_(2,15); CE_(3,14); CE_(4,8); CE_(5,6); CE_(7,11); CE_(9,10);
    CE_(0,5); CE_(1,7); CE_(2,9); CE_(3,4); CE_(6,13); CE_(8,14); CE_(10,15); CE_(11,12);
    CE_(0,1); CE_(2,3); CE_(4,5); CE_(6,8); CE_(7,9); CE_(10,11); CE_(12,13); CE_(14,15);
    CE_(0,2); CE_(1,3); CE_(4,10); CE_(5,11); CE_(6,7); CE_(8,9); CE_(12,14); CE_(13,15);
    CE_(1,2); CE_(3,12); CE_(4,6); CE_(5,7); CE_(8,10); CE_(9,11); CE_(13,14);
    CE_(1,4); CE_(2,6); CE_(5,8); CE_(7,10); CE_(9,13); CE_(11,14);
    CE_(2,4); CE_(3,6); CE_(9,12); CE_(11,13);
    CE_(3,5); CE_(6,8); CE_(7,9); CE_(10,12);
    CE_(3,4); CE_(5,6); CE_(7,8); CE_(9,10); CE_(11,12);
    CE_(6,7); CE_(8,9);
#undef CE_
}
template <int N, int OFF> DI void bitonic_merge16_desc(float (&a)[N]) {
#pragma unroll
    for (int j = 8; j > 0; j >>= 1)
#pragma unroll
        for (int i = 0; i < 16; ++i) { const int l = i ^ j; if (l > i) ce_desc<N>(a, OFF + i, OFF + l); }
}
template <bool SORTED, bool SORT0 = true> DI void top16_of_64(float (&a)[64]) {
    if (SORT0) bitonic_sort16_desc<64, 0>(a); bitonic_sort16_desc<64, 16>(a); bitonic_sort16_desc<64, 32>(a); bitonic_sort16_desc<64, 48>(a);
#pragma unroll
    for (int i = 0; i < 16; ++i) { a[i] = fmaxf(a[i], a[31 - i]); a[32 + i] = fmaxf(a[32 + i], a[63 - i]); }
    bitonic_merge16_desc<64, 0>(a); bitonic_merge16_desc<64, 32>(a);
#pragma unroll
    for (int i = 0; i < 16; ++i) a[i] = fmaxf(a[i], a[47 - i]);
    if (SORTED) bitonic_merge16_desc<64, 0>(a);
}
DI void p8a_topk(Frame& F, const pg8::StaticOrder& S) {
    const int lane = F.lane, r = lane & 31, hh = lane >> 5, w = F.wave;
    constexpr int TK_ST = 272, TK_QBYTES = 256 * TK_ST;
    LAS float* tbl = (LAS float*)(F.lds + w * 8192);
    pg8::Unit un;
    for (int ui = 0; S.next(ui, un); ++ui) {
        const int h = un.pn; const size_t tok = (size_t)un.pm * 256 + 32 * w + r;
        float v[2][16];
#pragma unroll
        for (int p = 0; p < 2; ++p) {
            __syncthreads();
            { const bf16* qsrc = F.wsp<bf16>(WS_QP) + (size_t)un.pm * 256 * 2048 + h * 256 + p * 128; const bf16* ksrc = F.wsp<bf16>(WS_SUBK) + (size_t)((h * 2 + p) * 128) * 128;
              const int rr = F.tid >> 4, ch = F.tid & 15;
#pragma unroll
              for (int i = 0; i < 8; ++i) *(LAS v4u*)(F.lds + (32 * i + rr) * TK_ST + ch * 16) = *(const v4u*)(qsrc + (size_t)(32 * i + rr) * 2048 + ch * 8);
#pragma unroll
              for (int i = 0; i < 4; ++i) *(LAS v4u*)(F.lds + TK_QBYTES + (32 * i + rr) * TK_ST + ch * 16) = *(const v4u*)(ksrc + (size_t)(32 * i + rr) * 128 + ch * 8); }
            __syncthreads();
            f32x16 sc[4];
#pragma unroll
            for (int nt = 0; nt < 4; ++nt) sc[nt] = f32x16{};
#pragma unroll 2
            for (int s = 0; s < 8; ++s) { const bf16x8 qf = *(const LAS bf16x8*)(F.lds + (32 * w + r) * TK_ST + (16 * s + 8 * hh) * 2);
#pragma unroll
                for (int nt = 0; nt < 4; ++nt) { const bf16x8 kf = *(const LAS bf16x8*)(F.lds + TK_QBYTES + (32 * nt + r) * TK_ST + (16 * s + 8 * hh) * 2); sc[nt] = MFMA32(kf, qf, sc[nt]); } }
            float a[64];
#pragma unroll
            for (int nt = 0; nt < 4; ++nt)
#pragma unroll
                for (int i = 0; i < 16; ++i) a[nt * 16 + i] = __uint_as_float((__float_as_uint(sc[nt][i]) & ~127u) | (unsigned)(32 * nt + crow(i, hh)));
            top16_of_64<true>(a);
            float m[16];
#pragma unroll
            for (int i = 0; i < 16; ++i) m[i] = fmaxf(a[i], swap32_partner(a[15 - i], hh));
            bitonic_merge16_desc<16, 0>(m);
#pragma unroll
            for (int i = 0; i < 16; ++i) v[p][i] = m[i];
        }
        float c[64]; int n = 0;
#pragma unroll
        for (int i = 0; i < 16; ++i)
#pragma unroll
            for (int j = 0; j < 16; ++j) if ((i + 1) * (j + 1) <= 16) { c[n] = __uint_as_float((__float_as_uint(v[0][i] + v[1][j]) & ~255u) | (unsigned)((i << 4) | j)); ++n; }
#pragma unroll
        for (int k = 50; k < 64; ++k) c[k] = -3.0e38f;
        top16_of_64<false, false>(c);
        __syncthreads();
#pragma unroll
        for (int i = 0; i < 16; ++i) { tbl[i * 64 + lane] = v[0][i]; tbl[(16 + i) * 64 + lane] = v[1][i]; }
        LDS_WAIT();
        float sv[16]; int ev[16]; float mx = -3.0e38f;
#pragma unroll
        for (int k = 0; k < 16; ++k) { const unsigned pl = __float_as_uint(c[k]) & 255u; const float a1 = tbl[(pl >> 4) * 64 + lane], a2 = tbl[(16 + (pl & 15)) * 64 + lane];
            sv[k] = a1 + a2; ev[k] = (int)(((__float_as_uint(a1) & 127u) << 7) | (__float_as_uint(a2) & 127u)); mx = fmaxf(mx, sv[k]); }
        float sum = 0.f;
#pragma unroll
        for (int k = 0; k < 16; ++k) { sv[k] = __expf(sv[k] - mx); sum += sv[k]; }
        const float inv = 1.0f / sum;
        if (hh == 0) {
#pragma unroll
            for (int k = 0; k < 16; k += 4) *(v4u*)(F.wsp<int>(WS_IDX) + tok * NSEL + h * 16 + k) = (v4u){(unsigned)ev[k], (unsigned)ev[k + 1], (unsigned)ev[k + 2], (unsigned)ev[k + 3]};
        } else {
#pragma unroll
            for (int k = 0; k < 16; k += 4) *(f32x4*)(F.wsp<float>(WS_G) + tok * NSEL + h * 16 + k) = (f32x4){sv[k] * inv, sv[k + 1] * inv, sv[k + 2] * inv, sv[k + 3] * inv};
        }
        LDS_WAIT();
    }
}
typedef _Float16 f16x2_t __attribute__((ext_vector_type(2)));
DI int dot16_i8(const v4u& u, const unsigned (&x)[4]) {
    const unsigned u0 = u.x, u1 = u.y, u2 = u.z, u3 = u.w;
    int a = 0;
    a = __builtin_amdgcn_sdot4((int)u0, (int)x[0], a, false); a = __builtin_amdgcn_sdot4((int)u1, (int)x[1], a, false);
    a = __builtin_amdgcn_sdot4((int)u2, (int)x[2], a, false); a = __builtin_amdgcn_sdot4((int)u3, (int)x[3], a, false);
    return a;
}
DI void axpy32_v6(f16x2_t (&o)[16], float w, const v4u a, unsigned b4, unsigned b5) {
    const v6u pk = {a.x, a.y, a.z, a.w, b4, b5};
    const v32h h = __builtin_amdgcn_cvt_scalef32_pk32_f16_fp6(pk, 1.0f);
    const f16x2_t w2 = {(_Float16)w, (_Float16)w};
#pragma unroll
    for (int i = 0; i < 16; ++i) { const f16x2_t hv = {h[2 * i], h[2 * i + 1]}; o[i] = __builtin_elementwise_fma(hv, w2, o[i]); }
}
constexpr int TPW = 4, NSLICE = 16, SLICE_SHIFT = 10, NPAIR = TPW * NSEL, NPAIR_PAD = NPAIR + 1 * TPW * NSLICE + 32;
constexpr int PEER_LDS_PER_WAVE = TPW * 1024 + 64 + TPW * 2048 + NPAIR_PAD * 4;
static_assert(PEER_LDS_PER_WAVE * NWAVES <= RING_BYTES, "PEER LDS");
DI int incl_scan64(int v, int lane) {
    int s = v;
#pragma unroll
    for (int d = 1; d < 64; d <<= 1) { const int t = __shfl_up(s, d); if (lane >= d) s += t; }
    return s;
}
struct PeerBatch { v4u uu[4]; v4u va[2]; unsigned vb4[2], vb5[2]; unsigned ent[4]; float su[4], sv[4]; };
DI void peer_load_batch(PeerBatch& B, const LAS unsigned* ml, int i, const unsigned char* EU8, const unsigned char* EV8, const float* SU, int lane, unsigned emask = 0x3fffu) {
    const v4u e4 = *(const LAS v4u*)(ml + i);
    B.ent[0] = (unsigned)__builtin_amdgcn_readfirstlane((int)e4.x); B.ent[1] = (unsigned)__builtin_amdgcn_readfirstlane((int)e4.y);
    B.ent[2] = (unsigned)__builtin_amdgcn_readfirstlane((int)e4.z); B.ent[3] = (unsigned)__builtin_amdgcn_readfirstlane((int)e4.w);
    const int l5 = lane & 31, hh = lane >> 5;
#pragma unroll
    for (int k = 0; k < 4; ++k) { const unsigned e = B.ent[k] & emask; const unsigned char* ur = EU8 + (size_t)e * DM;
        B.uu[k] = *(const v4u*)(ur + (unsigned)(16 * lane)); B.su[k] = SU[e]; B.sv[k] = SU[NEXP + e]; }
#pragma unroll
    for (int q = 0; q < 2; ++q) { const unsigned e0 = B.ent[2 * q] & emask, e1 = B.ent[2 * q + 1] & emask; const unsigned e = e0 + (unsigned)hh * (e1 - e0);
        const unsigned off = e * (unsigned)EV_ROW; B.va[q] = *(const v4u*)(EV8 + off + (unsigned)(16 * l5)); const v2u t2 = *(const v2u*)(EV8 + off + (unsigned)(512 + 8 * l5)); B.vb4[q] = t2.x; B.vb5[q] = t2.y; }
}
struct PeerState { unsigned x[4]; float sx; f16x2_t oc[16]; int curj; };
DI void peer_flush(PeerState& S, LAS unsigned char* ol, int lane) {
    LAS v4u* r = (LAS v4u*)(ol + S.curj * 2048 + 64 * (lane & 31) + 32 * (lane >> 5));
    unsigned mine[8];
#pragma unroll
    for (int i = 0; i < 8; ++i) { auto rr = __builtin_amdgcn_permlane32_swap(__builtin_bit_cast(unsigned, S.oc[i]), __builtin_bit_cast(unsigned, S.oc[8 + i]), false, false);
        mine[i] = __builtin_bit_cast(unsigned, __builtin_bit_cast(f16x2_t, (unsigned)rr[0]) + __builtin_bit_cast(f16x2_t, (unsigned)rr[1])); }
#pragma unroll
    for (int c = 0; c < 2; ++c) { const v4u v = r[c]; v4u o;
        o.x = __builtin_bit_cast(unsigned, __builtin_bit_cast(f16x2_t, (unsigned)v.x) + __builtin_bit_cast(f16x2_t, mine[4 * c])); o.y = __builtin_bit_cast(unsigned, __builtin_bit_cast(f16x2_t, (unsigned)v.y) + __builtin_bit_cast(f16x2_t, mine[4 * c + 1]));
        o.z = __builtin_bit_cast(unsigned, __builtin_bit_cast(f16x2_t, (unsigned)v.z) + __builtin_bit_cast(f16x2_t, mine[4 * c + 2])); o.w = __builtin_bit_cast(unsigned, __builtin_bit_cast(f16x2_t, (unsigned)v.w) + __builtin_bit_cast(f16x2_t, mine[4 * c + 3]));
        r[c] = o; }
#pragma unroll
    for (int i = 0; i < 16; ++i) S.oc[i] = (f16x2_t){(_Float16)0.f, (_Float16)0.f};
}
DI void peer_compute_batch(const PeerBatch& B, PeerState& S, LAS unsigned char* ol, const LAS unsigned char* xl, int lane) {
    const int jA = (int)((B.ent[0] >> 14) & 3u), jB = (int)((B.ent[2] >> 14) & 3u);
    if (jA != S.curj) {
        if (S.curj >= 0) peer_flush(S, ol, lane);
        S.curj = jA;
        const v4u y0 = ((const LAS v4u*)(xl + jA * 1024))[lane];
        S.x[0] = y0.x; S.x[1] = y0.y; S.x[2] = y0.z; S.x[3] = y0.w; S.sx = ((const LAS float*)(xl + TPW * 1024))[jA]; }
    unsigned xb[4] = {S.x[0], S.x[1], S.x[2], S.x[3]}; float sxb = S.sx;
    if (jB != jA) { const v4u y0 = ((const LAS v4u*)(xl + jB * 1024))[lane]; xb[0] = y0.x; xb[1] = y0.y; xb[2] = y0.z; xb[3] = y0.w; sxb = ((const LAS float*)(xl + TPW * 1024))[jB]; }
    const float d0 = (float)dot16_i8(B.uu[0], S.x) * B.su[0], d1 = (float)dot16_i8(B.uu[1], S.x) * B.su[1], d2 = (float)dot16_i8(B.uu[2], xb) * B.su[2], d3 = (float)dot16_i8(B.uu[3], xb) * B.su[3];
    const bool b0 = lane & 1, b1 = lane & 2;
    const float r0 = (b0 ? d1 : d0) + dpp_xor1(b0 ? d0 : d1), r1 = (b0 ? d3 : d2) + dpp_xor1(b0 ? d2 : d3);
    float t = (b1 ? r1 : r0) + dpp_xor2(b1 ? r0 : r1);
    t += __int_as_float(__builtin_amdgcn_update_dpp(0, __float_as_int(t), 0x124, 0xf, 0xf, true));
    t += __int_as_float(__builtin_amdgcn_update_dpp(0, __float_as_int(t), 0x128, 0xf, 0xf, true));
    { auto rr = __builtin_amdgcn_permlane16_swap(__float_as_uint(t), __float_as_uint(t), false, false); t = __uint_as_float(rr[0]) + __uint_as_float(rr[1]); }
    { auto rr = __builtin_amdgcn_permlane32_swap(__float_as_uint(t), __float_as_uint(t), false, false); t = __uint_as_float(rr[0]) + __uint_as_float(rr[1]); }
    const float act = gelu_tanh(t * (b1 ? sxb : S.sx));
#define PEER_W(k) (__builtin_bit_cast(float, __builtin_amdgcn_readlane(__builtin_bit_cast(int, act), k)) * __uint_as_float(B.ent[k] & 0xffff0000u) * B.sv[k])
    const float a0 = PEER_W(0), a1 = PEER_W(1), a2 = PEER_W(2), a3 = PEER_W(3);
#undef PEER_W
    const float hsel = (lane >= 32) ? 1.0f : 0.0f;
    axpy32_v6(S.oc, a0 + hsel * (a1 - a0), B.va[0], B.vb4[0], B.vb5[0]);
    if (jB != jA) { peer_flush(S, ol, lane); S.curj = jB; S.x[0] = xb[0]; S.x[1] = xb[1]; S.x[2] = xb[2]; S.x[3] = xb[3]; S.sx = sxb; }
    axpy32_v6(S.oc, a2 + hsel * (a3 - a2), B.va[1], B.vb4[1], B.vb5[1]);
}
DI void p8b_peer(Frame& F, float* outp, unsigned emask = 0x3fffu, float oscale = 1.0f) {
    const int lane = F.lane, w = F.wave;
    const int gw = F.vcu * NWAVES + w, NGW = F.G * NWAVES;
    const unsigned char* EU8 = F.wsp<unsigned char>(WS_EU); const unsigned char* EV8 = F.wsp<unsigned char>(WS_EV); const float* SU = F.wsp<float>(WS_SU);
    LAS unsigned char* xl = F.lds + w * PEER_LDS_PER_WAVE;
    LAS unsigned char* ol = xl + TPW * 1024 + 64;
    LAS unsigned* ml = (LAS unsigned*)(ol + TPW * 2048);
    for (int t0 = gw * TPW; t0 < M; t0 += NGW * TPW) {
        unsigned enta[TPW], entb[TPW]; int posa[TPW], posb[TPW], sla[TPW], slb[TPW], offs[TPW];
#pragma unroll
        for (int j = 0; j < TPW; ++j) { const size_t tok = (size_t)t0 + j;
            float rstd; { const f32x4* sp = (const f32x4*)(F.wsp<float>(WS_SSQ2) + tok * 16); const f32x4 st = (sp[0] + sp[1]) + (sp[2] + sp[3]); rstd = rsq_(((st.x + st.y) + (st.z + st.w)) * (1.f / 1024.f) + EPS); }
            { const bf16* xs = F.wsp<bf16>(WS_XN) + tok * DM + 16 * lane;
              const v4u x0 = *(const v4u*)xs, x1 = *(const v4u*)(xs + 8);
              float xf[16] = {bflo(x0.x), bfhi(x0.x), bflo(x0.y), bfhi(x0.y), bflo(x0.z), bfhi(x0.z), bflo(x0.w), bfhi(x0.w), bflo(x1.x), bfhi(x1.x), bflo(x1.y), bfhi(x1.y), bflo(x1.z), bfhi(x1.z), bflo(x1.w), bfhi(x1.w)};
              float mx = 0.f;
#pragma unroll
              for (int i = 0; i < 16; ++i) mx = fmaxf(mx, fabsf(xf[i]));
              mx = fmaxf(max64(mx), 1e-30f); const float inv = 127.0f / mx;
              v4u y; y.x = pack_i8x4(xf[0] * inv, xf[1] * inv, xf[2] * inv, xf[3] * inv); y.y = pack_i8x4(xf[4] * inv, xf[5] * inv, xf[6] * inv, xf[7] * inv);
              y.z = pack_i8x4(xf[8] * inv, xf[9] * inv, xf[10] * inv, xf[11] * inv); y.w = pack_i8x4(xf[12] * inv, xf[13] * inv, xf[14] * inv, xf[15] * inv);
              ((LAS v4u*)(xl + j * 1024))[lane] = y; if (lane == 0) ((LAS float*)(xl + TPW * 1024))[j] = mx * rstd * (1.0f / 127.0f);
              ((LAS v4u*)(ol + j * 2048))[lane] = (v4u){0u, 0u, 0u, 0u}; ((LAS v4u*)(ol + j * 2048))[64 + lane] = (v4u){0u, 0u, 0u, 0u}; }
            const int ea = F.wsp<int>(WS_IDX)[tok * NSEL + lane], eb = F.wsp<int>(WS_IDX)[tok * NSEL + 64 + lane];
            const float ga = F.wsp<float>(WS_G)[tok * NSEL + lane], gb = F.wsp<float>(WS_G)[tok * NSEL + 64 + lane];
            const int sa = ea >> SLICE_SHIFT, sb = eb >> SLICE_SHIFT;
            int pa = 0, pb = 0, myoff = 0;
#pragma unroll
            for (int bk = 0; bk < NSLICE; ++bk) { const unsigned long long ma = __ballot(sa == bk), mb = __ballot(sb == bk);
                const int ca = __popcll(ma), cb = __popcll(mb);
                const int ra = __builtin_amdgcn_mbcnt_hi((unsigned)(ma >> 32), __builtin_amdgcn_mbcnt_lo((unsigned)ma, 0)), rb = __builtin_amdgcn_mbcnt_hi((unsigned)(mb >> 32), __builtin_amdgcn_mbcnt_lo((unsigned)mb, 0));
                pa = (sa == bk) ? ra : pa; pb = (sb == bk) ? ca + rb : pb;
                myoff = (lane == bk) ? ca + cb : myoff; }
            enta[j] = (unsigned)ea | ((unsigned)j << 14) | (pk2(0.f, ga) & 0xffff0000u); entb[j] = (unsigned)eb | ((unsigned)j << 14) | (pk2(0.f, gb) & 0xffff0000u);
            posa[j] = pa; posb[j] = pb; sla[j] = sa; slb[j] = sb; offs[j] = myoff;
        }
        int cnt = 0;
#pragma unroll
        for (int j = 0; j < TPW; ++j) { const int c = __shfl(offs[j], lane >> 2); cnt = ((lane & 3) == j) ? c : cnt; }
        const int cpad = (cnt + 1) & ~1;
        const int bend = incl_scan64(cpad, lane), bstart = bend - cpad;
        const int npad = __builtin_amdgcn_readlane(bend, 63);
#pragma unroll
        for (int j = 0; j < TPW; ++j) { const int ba = __shfl(bstart, 4 * sla[j] + j), bb = __shfl(bstart, 4 * slb[j] + j);
            ml[ba + posa[j]] = enta[j]; ml[bb + posb[j]] = entb[j]; }
        { const unsigned pad = (unsigned)((lane >> 2) << SLICE_SHIFT) | ((unsigned)(lane & 3) << 14);
          if (cnt < cpad) ml[bstart + cnt] = pad; }
        if (lane < 30) ml[npad + lane] = (unsigned)((NSLICE - 1) << SLICE_SHIFT) | (3u << 14);
        LDS_WAIT();
        PeerState S;
#pragma unroll
        for (int i = 0; i < 16; ++i) S.oc[i] = (f16x2_t){(_Float16)0.f, (_Float16)0.f};
#pragma unroll
        for (int i = 0; i < 4; ++i) S.x[i] = 0u;
        S.curj = -1;
        PeerBatch A, B, C, D;
        peer_load_batch(A, ml, 0, EU8, EV8, SU, lane, emask); peer_load_batch(B, ml, 4, EU8, EV8, SU, lane, emask); peer_load_batch(C, ml, 8, EU8, EV8, SU, lane, emask);
#pragma unroll 1
        for (int i = 0; i < npad; i += 16) {
            peer_load_batch(D, ml, i + 12, EU8, EV8, SU, lane, emask); peer_compute_batch(A, S, ol, xl, lane);
            peer_load_batch(A, ml, i + 16, EU8, EV8, SU, lane, emask); peer_compute_batch(B, S, ol, xl, lane);
            peer_load_batch(B, ml, i + 20, EU8, EV8, SU, lane, emask); peer_compute_batch(C, S, ol, xl, lane);
            peer_load_batch(C, ml, i + 24, EU8, EV8, SU, lane, emask); peer_compute_batch(D, S, ol, xl, lane);
        }
        peer_flush(S, ol, lane);
        LDS_WAIT();
#pragma unroll
        for (int j = 0; j < TPW; ++j) {
            const int eb = 32 * (lane & 31) + 16 * (lane >> 5);
            float* orow = outp + ((size_t)t0 + j) * DM + eb;
            const v4u xb0 = *(const v4u*)(F.wsp<bf16>(WS_XN) + ((size_t)t0 + j) * DM + eb), xb1 = *(const v4u*)(F.wsp<bf16>(WS_XN) + ((size_t)t0 + j) * DM + eb + 8);
            const unsigned xw[8] = {xb0.x, xb0.y, xb0.z, xb0.w, xb1.x, xb1.y, xb1.z, xb1.w};
            f32x4 a[4]; float ss = 0.f;
            const v4u h0 = *(const LAS v4u*)(ol + j * 2048 + 2 * eb), h1 = *(const LAS v4u*)(ol + j * 2048 + 2 * eb + 16);
            const unsigned hw[8] = {h0.x, h0.y, h0.z, h0.w, h1.x, h1.y, h1.z, h1.w};
#pragma unroll
            for (int q = 0; q < 4; ++q) { const f16x2_t p0 = __builtin_bit_cast(f16x2_t, hw[2 * q]), p1 = __builtin_bit_cast(f16x2_t, hw[2 * q + 1]);
                a[q] = (f32x4){bflo(xw[2 * q]), bfhi(xw[2 * q]), bflo(xw[2 * q + 1]), bfhi(xw[2 * q + 1])} + (f32x4){(float)p0.x, (float)p0.y, (float)p1.x, (float)p1.y};
                ss += (a[q].x * a[q].x + a[q].y * a[q].y) + (a[q].z * a[q].z + a[q].w * a[q].w); }
            const float rf = rsq_(sum64(ss) * (1.f / 1024.f) + EPS) * oscale;
#pragma unroll
            for (int q = 0; q < 4; ++q) *(f32x4*)(orow + 4 * q) = a[q] * rf * *(const f32x4*)(F.in(25) + eb + 4 * q);
        }
        LDS_WAIT();
    }
}
constexpr int N_PHASES = 11;
__global__ void __launch_bounds__(NWAVES * 64, 2) fwd_kernel(Args args) {
    extern __shared__ __attribute__((aligned(16))) unsigned char lds[];
    Frame F;
    F.lds = (LAS unsigned char*)lds;
    F.MISC = (volatile LAS unsigned*)(F.lds + MISC_OFF);
    F.tid = threadIdx.x; F.lane = F.tid & 63; F.wave = __builtin_amdgcn_readfirstlane(F.tid >> 6);
    F.G = gridDim.x; { const int bx = blockIdx.x; F.vcu = (F.G % 8 == 0) ? (bx % 8) * (F.G / 8) + bx / 8 : bx; }
    F.A = &args; F.ws = args.ws; F.out = args.out;
    F.ctl = (gu32*)(args.ws + WS_CTL);
    for (int u = F.tid; u < (LDS_BYTES - LDSCTL_OFF) / 4; u += NWAVES * 64) ((LAS unsigned*)(F.lds + LDSCTL_OFF))[u] = 0u;
    __syncthreads();
    const bool multi = (args.ph_hi - args.ph_lo) > 1;
    XcdBarrier bar; bar.bar = (unsigned*)(F.ctl + CW_BAR) + args.li * XCD_BAR_WORDS; bar.x = 0; bar.st = nullptr;
    if (multi) bar = xcd_barrier_post((unsigned*)(F.ctl + CW_BAR) + args.li * XCD_BAR_WORDS, F.MISC + 8);
    const int lo = args.ph_lo, hi = args.ph_hi;
#ifndef PROBE_EMASK
#define PROBE_EMASK 0x3fffu
#endif
#ifndef PHASE_REPEAT
#define PHASE_REPEAT 0
#endif
#define REP(k) for (int rep_ = 0; rep_ < (((PHASE_REPEAT >> (k)) & 1) ? 2 : 1); ++rep_)
#ifndef PHASE_MASK
#define PHASE_MASK 0x7ff
#endif
#define IN(k) (((PHASE_MASK >> (k)) & 1) && lo <= (k) && (k) < hi)
#define SEAM(k) do { asm volatile("; ===SEAM " #k ::: "memory"); if (IN(k) && IN((k) + 1)) xcd_barrier(bar); STAMP((k) + 1); } while (0)
    const int c = (int)blockIdx.x;
#define LOCAL_SEAM() do { VM_WAIT(); __syncthreads(); if (F.tid == 0) { __builtin_amdgcn_fence(__ATOMIC_ACQUIRE, "agent"); VM_WAIT(); } __syncthreads(); } while (0)
#ifdef PROBE_PHASE
#define STAMP(i) do { if (blockIdx.x == 0 && F.tid == 0) __hip_atomic_store(F.ctl + 512 + (i), (unsigned)__builtin_amdgcn_s_memrealtime(), RLX_AGENT); } while (0)
#else
#define STAMP(i) do { } while (0)
#endif
    STAMP(0);

    if (IN(0)) REP(0) { p0_prologue(F); } SEAM(0);
    if (IN(1)) REP(1) {
        { pg8::Gemm g{F.wsp<bf16>(WS_XN), F.wsp<bf16>(WS_WIN), M, INW, DM}; pg8::StaticOrder S; S.init(M, INW, F.G, c);
          pg8::EpiSplitT E{F.wsp<bf16>(WS_Z), ZW, ZW, F.wsp<bf16>(WS_VT), ATTW, SEQ};
          pg8::gemm_phase<pg8::EpiSplitT, pg8::StaticOrder, true, true>(F.lds, g, S, E); }
        { const int nw3 = (M / 256) * (INW / 256) - 2 * F.G;
          int idx = -1; if (nw3 >= 0 && nw3 + 16 <= F.G) idx = c - nw3; else idx = (c < 16 && F.G >= 16) ? c : -1;
          if (F.G < 16) idx = -1;
          pg8::Gemm g{F.wsp<bf16>(WS_MEMN), F.wsp<bf16>(WS_WKV), NBATCH * 256, 2 * DM, DM};
          if (F.G >= 16) { pg8::OneUnit S{idx, 2, 8}; pg8::EpiSplitT E{F.wsp<bf16>(WS_KM), DM, DM, F.wsp<bf16>(WS_VMT), DM, 256};
              pg8::gemm_phase<pg8::EpiSplitT, pg8::OneUnit, false, true>(F.lds, g, S, E); }
          else { pg8::StaticOrder S; S.init(NBATCH * 256, 2 * DM, F.G, c); pg8::EpiSplitT E{F.wsp<bf16>(WS_KM), DM, DM, F.wsp<bf16>(WS_VMT), DM, 256};
              pg8::gemm_phase<pg8::EpiSplitT, pg8::StaticOrder, false, true>(F.lds, g, S, E); } }
        { const int first_idle = (M / 256) * (INW / 256) - 2 * F.G + 16;
          if (first_idle > 0 && first_idle < F.G) { if (c >= first_idle) convert_experts(F, (c - first_idle) * NWAVES + F.wave, (F.G - first_idle) * NWAVES); }
          else convert_experts(F, c * NWAVES + F.wave, F.G * NWAVES); }
    } SEAM(1);
    if (IN(2)) REP(2) { p2_lru_aggregates(F); } SEAM(2);
#ifndef PROBE_PARTS
#define PROBE_PARTS 3
#endif
    if (IN(3)) { if ((PHASE_REPEAT >> 3) & 1) p3_mixer(F, PROBE_PARTS); p3_mixer(F); } SEAM(3);
    if (IN(4)) REP(4) {
        pg8::Gemm g{F.wsp<bf16>(WS_Y), F.wsp<bf16>(WS_WOUT), M, DM, DM}; pg8::StaticOrder S; S.init(M, DM, F.G, c);
        pg8::EpiResid<false> E{F.in(0), F.wsp<bf16>(WS_XN), F.wsp<float>(WS_SSQ1), DM};
        pg8::gemm_phase<pg8::EpiResid<false>, pg8::StaticOrder, true, true>(F.lds, g, S, E);
    } SEAM(4);
    if (IN(5)) {
        pg8::Gemm g{F.wsp<bf16>(WS_XN), F.wsp<bf16>(WS_WQ), M, DM, DM}; pg8::StaticOrder S; S.init(M, DM, F.G, c);
        pg8::EpiRowScale E{F.wsp<bf16>(WS_QC), DM, F.wsp<float>(WS_SSQ1), 1.f / 1024.f, EPS};
        pg8::gemm_phase<pg8::EpiRowScale, pg8::StaticOrder, true, true>(F.lds, g, S, E);
        LOCAL_SEAM();
        p5_cross(F, S);
    } SEAM(6);
    if (IN(7)) {
        pg8::Gemm g{F.wsp<bf16>(WS_OC), F.wsp<bf16>(WS_WO), M, DM, DM}; pg8::StaticOrder S; S.init(M, DM, F.G, c);
        pg8::EpiResid<true> E{F.wsp<bf16>(WS_XN), F.wsp<bf16>(WS_XN), F.wsp<float>(WS_SSQ2), DM};
        pg8::gemm_phase<pg8::EpiResid<true>, pg8::StaticOrder, true, true>(F.lds, g, S, E);
    } SEAM(7);
    if (IN(8)) {
        pg8::Gemm g{F.wsp<bf16>(WS_XN), F.wsp<bf16>(WS_WQRY), M, 2 * DM, DM}; pg8::StaticOrder S; S.init(M, 2 * DM, F.G, c);
        pg8::EpiRowScale E{F.wsp<bf16>(WS_QP), 2 * DM, F.wsp<float>(WS_SSQ2), 1.f / 1024.f, EPS};
        pg8::gemm_phase<pg8::EpiRowScale, pg8::StaticOrder, true, true>(F.lds, g, S, E);
        LOCAL_SEAM();
        p8a_topk(F, S);
    } SEAM(9);
    if (IN(10)) { if ((PHASE_REPEAT >> 10) & 1) { p8b_peer(F, F.wsp<float>(WS_Z), PROBE_EMASK); } p8b_peer(F, F.out, 0x3fffu,
#ifdef PROBE_PHASE
        1.0f + (float)(((__hip_atomic_load(F.ctl + 512 + PROBE_PHASE + 1, RLX_AGENT) - __hip_atomic_load(F.ctl + 512 + PROBE_PHASE, RLX_AGENT)) + 500u) / 1000u) * 1e-2f
#else
        1.0f
#endif
        ); }
#undef IN
#undef SEAM
}

#ifndef N_LAUNCH_MODE
#define N_LAUNCH_MODE 1
#endif
extern "C" void kernel_launch(void* const* d_in, const int* in_sizes, int n_in, void* d_out, int out_size, void* d_ws, size_t ws_size, hipStream_t stream) {
    static int grid = 0;
    if (grid == 0) {
        if (n_in != 26 || out_size != M * DM || ws_size < WS_END) { fprintf(stderr, "kernel_launch: unexpected shapes (n_in %d, out %d, ws %zu)\n", n_in, out_size, ws_size); grid = -1; return; }
        int dev = 0, cus = 0, per_cu = 0;
        if (hipGetDevice(&dev) != hipSuccess || hipDeviceGetAttribute(&cus, hipDeviceAttributeMultiprocessorCount, dev) != hipSuccess) { grid = -1; return; }
        if (hipFuncSetAttribute((const void*)fwd_kernel, hipFuncAttributeMaxDynamicSharedMemorySize, LDS_BYTES) != hipSuccess) { fprintf(stderr, "kernel_launch: hipFuncSetAttribute failed\n"); grid = -1; return; }
        if (hipOccupancyMaxActiveBlocksPerMultiprocessor(&per_cu, (const void*)fwd_kernel, NWAVES * 64, LDS_BYTES) != hipSuccess || per_cu < 1) { fprintf(stderr, "kernel_launch: occupancy query says %d blocks per CU\n", per_cu); (void)hipGetLastError(); grid = -1; return; }
        grid = cus;
    }
    if (grid < 0) return;
    (void)hipMemsetAsync((char*)d_ws + WS_CTL, 0, CTL_ZERO_BYTES, stream);
    Args a{};
    for (int i = 0; i < 26; ++i) a.in[i] = (const float*)d_in[i];
    a.out = (float*)d_out; a.ws = (unsigned char*)d_ws;
    if (N_LAUNCH_MODE == 1) { a.ph_lo = 0; a.ph_hi = N_PHASES; a.li = 0; hipLaunchKernelGGL(fwd_kernel, dim3(grid), dim3(NWAVES * 64), LDS_BYTES, stream, a); }
    else { for (int p = 0; p < N_PHASES; ++p) { a.ph_lo = p; a.ph_hi = p + 1; a.li = 0; hipLaunchKernelGGL(fwd_kernel, dim3(grid), dim3(NWAVES * 64), LDS_BYTES, stream, a); } }
}
```

```cpp
#include <hip/hip_runtime.h>
#include <cstdio>
#include <cstdint>
namespace pg8 {
#define PG8_LAS __attribute__((address_space(3)))
typedef unsigned short bf16_t;
typedef short bf16x8 __attribute__((ext_vector_type(8)));
typedef float f32x4 __attribute__((ext_vector_type(4)));
typedef unsigned u32x4 __attribute__((ext_vector_type(4)));
constexpr int BM = 256, BK = 64, HALF = 128, HTB = HALF * BK * 2  , STAGE_BYTES = 8 * HTB, NXCD = 8, WGM = 8;

__host__ __device__ __forceinline__ int lds_byte(int r, int c) { const int st = (r >> 4) * 2 + (c >> 5), rr = r & 15, cc = c & 31, ob = rr * 64 + cc * 2; return st * 1024 + (ob ^ (((ob >> 9) & 1) << 5)); }
__host__ __device__ __forceinline__ void stage_rc(int b, int& R, int& C) { const int st = b / 1024, sb = b % 1024, swz = sb ^ (((sb >> 9) & 1) << 5); R = (st >> 1) * 16 + swz / 64; C = (st & 1) * 32 + (swz % 64) / 2; }
__host__ __device__ __forceinline__ int perm32(int rho) { const int n = rho >> 4, i = rho & 15; return 8 * (i >> 2) + 4 * n + (i & 3); }

struct Unit { int pm, pn; };
struct Gemm { const bf16_t* A; const bf16_t* Bt; int M, N, K; };

struct StaticOrder {
    int nM, nN, nwg, G, c;
    __host__ __device__ void init(int M, int N, int G_, int c_) { nM = M / BM; nN = N / BM; nwg = nM * nN; G = G_; c = c_; }
    __host__ __device__ bool next(int i, Unit& u) const {
        const long L = (long)i * G + c; if (L >= nwg) return false;
        int wgid = (int)L; { const int q = nwg / NXCD, r = nwg % NXCD, xcd = wgid % NXCD, off = wgid / NXCD; wgid = (xcd < r ? xcd * (q + 1) : r * (q + 1) + (xcd - r) * q) + off; }
        const int nig = WGM * nN, gid = wgid / nig, fm = gid * WGM, gsz = (nM - fm) < WGM ? (nM - fm) : WGM;
        u.pm = fm + ((wgid % nig) % gsz); u.pn = (wgid % nig) / gsz; return true;
    }
    __device__ __forceinline__ void a_ready(const Unit&) const {}
    __device__ __forceinline__ void done(const Unit&) const {}
};

typedef float f32x2 __attribute__((ext_vector_type(2)));
typedef __bf16 bf16x2_t __attribute__((ext_vector_type(2)));
__device__ __forceinline__ unsigned cvt_pk_bf16(float lo, float hi) { f32x2 v = {lo, hi}; bf16x2_t b = __builtin_convertvector(v, bf16x2_t); return __builtin_bit_cast(unsigned, b); }
__device__ __forceinline__ bf16_t cvt_bf16(float x) { return (bf16_t)(cvt_pk_bf16(x, 0.f) & 0xffffu); }

struct EpiSplitT {
    static constexpr bool PERM = true, AFTER_DRAIN = false;
    bf16_t* O; int ldc; int ncols_rm; bf16_t* T; int NT; int rpb;
    __device__ __forceinline__ void operator()(const f32x4 (&acc)[2][2][4][2], const Unit& u, int wr, int wc, int fr, int fq) const {
        const int row0 = u.pm * BM + wr * 64 + fr; const int colt = u.pn * BM;
        if (colt < ncols_rm) {
            const int col0 = colt + wc * 32 + 8 * fq;
#pragma unroll
            for (int ai = 0; ai < 2; ++ai)
#pragma unroll
                for (int m = 0; m < 4; ++m) { bf16_t* rowp = O + (size_t)(row0 + ai * HALF + m * 16) * ldc + col0;
#pragma unroll
                    for (int bj = 0; bj < 2; ++bj) { const f32x4 v0 = acc[ai][bj][m][0], v1 = acc[ai][bj][m][1];
                        u32x4 w; w.x = cvt_pk_bf16(v0[0], v0[1]); w.y = cvt_pk_bf16(v0[2], v0[3]); w.z = cvt_pk_bf16(v1[0], v1[1]); w.w = cvt_pk_bf16(v1[2], v1[3]);
                        *(u32x4*)(rowp + bj * HALF) = w; } }
        } else {
            const int c0 = colt - ncols_rm + wc * 32 + 8 * fq;
#pragma unroll
            for (int ai = 0; ai < 2; ++ai)
#pragma unroll
                for (int m = 0; m < 4; ++m) { const int row = row0 + ai * HALF + m * 16; const int b = row / rpb, t = row - b * rpb; bf16_t* base = T + (size_t)b * NT * rpb + t;
#pragma unroll
                    for (int bj = 0; bj < 2; ++bj)
#pragma unroll
                        for (int n = 0; n < 2; ++n)
#pragma unroll
                            for (int e = 0; e < 4; ++e) base[(size_t)(c0 + bj * HALF + 4 * n + e) * rpb] = cvt_bf16(acc[ai][bj][m][n][e]); }
        }
    }
};
template <bool BASE_BF16> struct EpiResid {
    static constexpr bool PERM = true, AFTER_DRAIN = false;
    const void* base; bf16_t* xb; float* ssq; int ldc;
    __device__ __forceinline__ void operator()(const f32x4 (&acc)[2][2][4][2], const Unit& u, int wr, int wc, int fr, int fq) const {
        const int row0 = u.pm * BM + wr * 64 + fr; const int col0 = u.pn * BM + wc * 32 + 8 * fq;
#pragma unroll
        for (int ai = 0; ai < 2; ++ai)
#pragma unroll
            for (int m = 0; m < 4; ++m) { const int row = row0 + ai * HALF + m * 16; float s = 0.f;
#pragma unroll
                for (int bj = 0; bj < 2; ++bj) { const size_t off = (size_t)row * ldc + col0 + bj * HALF;
                    f32x4 b0, b1;
                    if (BASE_BF16) { const u32x4 w = *(const u32x4*)((const bf16_t*)base + off);
                        b0 = (f32x4){__uint_as_float(w.x << 16), __uint_as_float(w.x & 0xffff0000u), __uint_as_float(w.y << 16), __uint_as_float(w.y & 0xffff0000u)};
                        b1 = (f32x4){__uint_as_float(w.z << 16), __uint_as_float(w.z & 0xffff0000u), __uint_as_float(w.w << 16), __uint_as_float(w.w & 0xffff0000u)}; }
                    else { b0 = *(const f32x4*)((const float*)base + off); b1 = *(const f32x4*)((const float*)base + off + 4); }
                    const f32x4 v0 = acc[ai][bj][m][0] + b0, v1 = acc[ai][bj][m][1] + b1;
                    s += (v0[0] * v0[0] + v0[1] * v0[1]) + (v0[2] * v0[2] + v0[3] * v0[3]) + (v1[0] * v1[0] + v1[1] * v1[1]) + (v1[2] * v1[2] + v1[3] * v1[3]);
                    u32x4 w; w.x = cvt_pk_bf16(v0[0], v0[1]); w.y = cvt_pk_bf16(v0[2], v0[3]); w.z = cvt_pk_bf16(v1[0], v1[1]); w.w = cvt_pk_bf16(v1[2], v1[3]);
                    *(u32x4*)(xb + off) = w; }
                s += __shfl_xor(s, 16); s += __shfl_xor(s, 32);
                if (fq == 0) ssq[(size_t)row * 16 + u.pn * 4 + wc] = s; }
    }
};
struct EpiRowScale {
    static constexpr bool PERM = true, AFTER_DRAIN = false;
    bf16_t* O; int ldc; const float* ssq; float inv_n, eps;
    __device__ __forceinline__ void operator()(const f32x4 (&acc)[2][2][4][2], const Unit& u, int wr, int wc, int fr, int fq) const {
        const int row0 = u.pm * BM + wr * 64 + fr; const int col0 = u.pn * BM + wc * 32 + 8 * fq;
#pragma unroll
        for (int ai = 0; ai < 2; ++ai)
#pragma unroll
            for (int m = 0; m < 4; ++m) { const int row = row0 + ai * HALF + m * 16; const f32x4* sp = (const f32x4*)(ssq + (size_t)row * 16);
                const f32x4 s0 = sp[0], s1 = sp[1], s2 = sp[2], s3 = sp[3]; const f32x4 st = (s0 + s1) + (s2 + s3);
                const float r = 1.0f / sqrtf(((st[0] + st[1]) + (st[2] + st[3])) * inv_n + eps);
                bf16_t* rowp = O + (size_t)row * ldc + col0;
#pragma unroll
                for (int bj = 0; bj < 2; ++bj) { const f32x4 v0 = acc[ai][bj][m][0] * r, v1 = acc[ai][bj][m][1] * r;
                    u32x4 w; w.x = cvt_pk_bf16(v0[0], v0[1]); w.y = cvt_pk_bf16(v0[2], v0[3]); w.z = cvt_pk_bf16(v1[0], v1[1]); w.w = cvt_pk_bf16(v1[2], v1[3]);
                    *(u32x4*)(rowp + bj * HALF) = w; } }
    }
};
struct OneUnit {
    int idx, nM, nN;
    __device__ __forceinline__ bool next(int i, Unit& u) const { if (i > 0 || idx < 0 || idx >= nM * nN) return false; u.pm = idx % nM; u.pn = idx / nM; return true; }
    __device__ __forceinline__ void a_ready(const Unit&) const {}
    __device__ __forceinline__ void done(const Unit&) const {}
};

template <class Epi, class Sched, bool ALIGN_EPI = false, bool SP2 = false>
__device__ __forceinline__ void gemm_phase(PG8_LAS unsigned char* lds, const Gemm g, const Sched& S, const Epi& E) {
    const int tid = threadIdx.x, wid = __builtin_amdgcn_readfirstlane(tid >> 6), lane = tid & 63, wr = wid >> 2, wc = wid & 3, fr = lane & 15, fq = lane >> 4;
    const int K = g.K, nt = K / BK;
    unsigned voffA[2], voffB[2];
#pragma unroll
    for (int i = 0; i < 2; ++i) { int R, C; stage_rc(tid * 16 + i * 8192, R, C); const int Rb = Epi::PERM ? ((R & ~31) + perm32(R & 31)) : R;
        voffA[i] = (unsigned)(R * K + C) * 2u; voffB[i] = (unsigned)(Rb * K + C) * 2u; }
    const size_t kstep = (size_t)(BK * 2);
    const size_t hstep = (size_t)HALF * K * 2;
    const size_t tstep = 2 * hstep;
    const unsigned ldsw = (unsigned)wid * 1024u;
    const int aoff = lds_byte(wr * 64 + fr, fq * 8), boff = lds_byte(wc * 32 + fr, fq * 8);
#define PG8_SA(b, h) (((b) * 2 + (h)) * HTB)
#define PG8_SB(b, h) ((4 + (b) * 2 + (h)) * HTB)
#define PG8_STAGE(bufoff, gbase, voff) do { _Pragma("unroll") for (int _i = 0; _i < 2; ++_i) \
        __builtin_amdgcn_global_load_lds((const unsigned*)((const char*)(gbase) + (voff)[_i]), (PG8_LAS unsigned*)(lds + (bufoff) + ldsw + _i * 8192), 16, 0, 0); } while (0)
#define PG8_LDA(dst, b, h) do { _Pragma("unroll") for (int m = 0; m < 4; ++m) _Pragma("unroll") for (int k = 0; k < 2; ++k) dst[m][k] = *(const PG8_LAS bf16x8*)(lds + PG8_SA(b, h) + aoff + m * 2048 + k * 1024); } while (0)
#define PG8_LDB(dst, b, h) do { _Pragma("unroll") for (int n = 0; n < 2; ++n) _Pragma("unroll") for (int k = 0; k < 2; ++k) dst[n][k] = *(const PG8_LAS bf16x8*)(lds + PG8_SB(b, h) + boff + n * 2048 + k * 1024); } while (0)
#define PG8_MMA(ai, bj, At, Bt) do { __builtin_amdgcn_s_setprio(1); _Pragma("unroll") for (int m = 0; m < 4; ++m) _Pragma("unroll") for (int n = 0; n < 2; ++n) _Pragma("unroll") for (int k = 0; k < 2; ++k) \
        acc[ai][bj][m][n] = __builtin_amdgcn_mfma_f32_16x16x32_bf16(Bt[n][k], At[m][k], acc[ai][bj][m][n], 0, 0, 0); __builtin_amdgcn_s_setprio(0); } while (0)
#define PG8_WAIT_V(n) asm volatile("s_waitcnt vmcnt(" #n ")" ::: "memory")
#define PG8_WAIT_L(n) asm volatile("s_waitcnt lgkmcnt(" #n ")" ::: "memory")
#define PG8_BAR __builtin_amdgcn_s_barrier()
#define PG8_SCHED __builtin_amdgcn_sched_barrier(0)
    Unit cur, nxt; int ui = 0;
    if (!S.next(0, cur)) return;
    f32x4 acc[2][2][4][2];
#pragma unroll
    for (int a = 0; a < 2; ++a)
#pragma unroll
        for (int b = 0; b < 2; ++b)
#pragma unroll
            for (int m = 0; m < 4; ++m)
#pragma unroll
                for (int n = 0; n < 2; ++n) acc[a][b][m][n] = (f32x4){0.f, 0.f, 0.f, 0.f};
    bf16x8 At[4][2], B0[2][2], B1[2][2];
    const char* cA = (const char*)g.A + (size_t)cur.pm * tstep; const char* cB = (const char*)g.Bt + (size_t)cur.pn * tstep;
    S.a_ready(cur);
    if constexpr (SP2) {
        PG8_STAGE(PG8_SB(0, 0), cB, voffB); PG8_STAGE(PG8_SB(0, 1), cB + hstep, voffB); PG8_STAGE(PG8_SA(0, 0), cA, voffA); PG8_STAGE(PG8_SA(0, 1), cA + hstep, voffA);
        if (wr == 1) PG8_BAR;
        PG8_WAIT_V(2); PG8_BAR;
        PG8_STAGE(PG8_SB(1, 0), cB + kstep, voffB); PG8_STAGE(PG8_SA(1, 0), cA + kstep, voffA); PG8_STAGE(PG8_SB(1, 1), cB + hstep + kstep, voffB);
        PG8_WAIT_V(6); PG8_BAR;
    } else {
        PG8_STAGE(PG8_SB(0, 0), cB, voffB); PG8_STAGE(PG8_SA(0, 0), cA, voffA); PG8_STAGE(PG8_SB(0, 1), cB + hstep, voffB); PG8_STAGE(PG8_SA(0, 1), cA + hstep, voffA);
        if (wr == 1) PG8_BAR;
        PG8_WAIT_V(4); PG8_BAR;
        PG8_STAGE(PG8_SB(1, 0), cB + kstep, voffB); PG8_STAGE(PG8_SA(1, 0), cA + kstep, voffA); PG8_STAGE(PG8_SB(1, 1), cB + hstep + kstep, voffB);
        PG8_WAIT_V(6); PG8_BAR;
    }
    for (;;) {
        const bool has_next = S.next(ui + 1, nxt);
        const char* nA = has_next ? (const char*)g.A + (size_t)nxt.pm * tstep : cA; const char* nB = has_next ? (const char*)g.Bt + (size_t)nxt.pn * tstep : cB;
        for (int t = 0; t < nt; t += 2) {
            const bool last = (t == nt - 2);
            const char* a1 = cA + (size_t)(t + 1) * kstep;
            const char* a2 = last ? nA : cA + (size_t)(t + 2) * kstep; const char* b2 = last ? nB : cB + (size_t)(t + 2) * kstep;
            const char* a3 = a2 + kstep; const char* b3 = b2 + kstep;
            if (last && has_next) S.a_ready(nxt);
            if constexpr (SP2) {
            PG8_LDB(B0, 0, 0); PG8_LDB(B1, 0, 1); PG8_SCHED; PG8_LDA(At, 0, 0); PG8_STAGE(PG8_SA(1, 1), a1 + hstep, voffA);
            PG8_WAIT_V(8); PG8_WAIT_L(0); PG8_BAR; PG8_MMA(0, 0, At, B0); PG8_MMA(0, 1, At, B1); PG8_BAR; PG8_SCHED;
            PG8_LDA(At, 0, 1); PG8_STAGE(PG8_SB(0, 0), b2, voffB); PG8_STAGE(PG8_SB(0, 1), b2 + hstep, voffB); PG8_STAGE(PG8_SA(0, 0), a2, voffA);
            PG8_WAIT_V(8); PG8_WAIT_L(0); PG8_BAR; PG8_MMA(1, 0, At, B0); PG8_MMA(1, 1, At, B1); PG8_BAR; PG8_SCHED;
            PG8_LDB(B0, 1, 0); PG8_LDB(B1, 1, 1); PG8_SCHED; PG8_LDA(At, 1, 0); PG8_STAGE(PG8_SA(0, 1), a2 + hstep, voffA);
            PG8_WAIT_V(8); PG8_WAIT_L(0); PG8_BAR; PG8_MMA(0, 0, At, B0); PG8_MMA(0, 1, At, B1); PG8_BAR; PG8_SCHED;
            PG8_LDA(At, 1, 1); PG8_STAGE(PG8_SB(1, 0), b3, voffB); PG8_STAGE(PG8_SB(1, 1), b3 + hstep, voffB); PG8_STAGE(PG8_SA(1, 0), a3, voffA);
            PG8_WAIT_V(8); PG8_WAIT_L(0); PG8_BAR; PG8_MMA(1, 0, At, B0); PG8_MMA(1, 1, At, B1); PG8_BAR; PG8_SCHED;
            } else {
            PG8_LDB(B0, 0, 0); PG8_SCHED; PG8_LDA(At, 0, 0); PG8_STAGE(PG8_SA(1, 1), a1 + hstep, voffA);
            PG8_WAIT_L(8); PG8_BAR; PG8_WAIT_L(0); PG8_MMA(0, 0, At, B0); PG8_BAR; PG8_SCHED;
            PG8_LDB(B1, 0, 1); PG8_STAGE(PG8_SB(0, 0), b2, voffB);
            PG8_BAR; PG8_WAIT_L(0); PG8_MMA(0, 1, At, B1); PG8_BAR;
            PG8_LDA(At, 0, 1); PG8_STAGE(PG8_SA(0, 0), a2, voffA);
            PG8_BAR; PG8_WAIT_L(0); PG8_MMA(1, 0, At, B0); PG8_BAR; PG8_SCHED;
            PG8_STAGE(PG8_SB(0, 1), b2 + hstep, voffB);
            PG8_WAIT_V(6); PG8_BAR; PG8_MMA(1, 1, At, B1); PG8_BAR;
            PG8_LDB(B0, 1, 0); PG8_SCHED; PG8_LDA(At, 1, 0); PG8_STAGE(PG8_SA(0, 1), a2 + hstep, voffA);
            PG8_WAIT_L(8); PG8_BAR; PG8_WAIT_L(0); PG8_MMA(0, 0, At, B0); PG8_BAR; PG8_SCHED;
            PG8_LDB(B1, 1, 1); PG8_STAGE(PG8_SB(1, 0), b3, voffB);
            PG8_BAR; PG8_WAIT_L(0); PG8_MMA(0, 1, At, B1); PG8_BAR;
            PG8_LDA(At, 1, 1); PG8_STAGE(PG8_SA(1, 0), a3, voffA);
            PG8_BAR; PG8_WAIT_L(0); PG8_MMA(1, 0, At, B0); PG8_BAR; PG8_SCHED;
            PG8_STAGE(PG8_SB(1, 1), b3 + hstep, voffB);
            PG8_WAIT_V(6); PG8_BAR; PG8_MMA(1, 1, At, B1); PG8_BAR;
            }
        }
        if constexpr (ALIGN_EPI) { if (wr == 0) PG8_BAR; }
        if constexpr (!Epi::AFTER_DRAIN) { E(acc, cur, wr, wc, fr, fq); S.done(cur); }
        if (!has_next) break;
#pragma unroll
        for (int a = 0; a < 2; ++a)
#pragma unroll
            for (int b = 0; b < 2; ++b)
#pragma unroll
                for (int m = 0; m < 4; ++m)
#pragma unroll
                    for (int n = 0; n < 2; ++n) acc[a][b][m][n] = (f32x4){0.f, 0.f, 0.f, 0.f};
        cur = nxt; cA = nA; cB = nB; ++ui;
        if constexpr (ALIGN_EPI) { if (wr == 1) PG8_BAR; }
    }
    PG8_WAIT_V(0);
    if constexpr (!ALIGN_EPI) { if (wr == 0) PG8_BAR; }
    PG8_BAR;
    if constexpr (Epi::AFTER_DRAIN) { E.fused(acc, cur, wr, wc, fr, fq, lds, wid, lane); S.done(cur); }
#undef PG8_SA
#undef PG8_SB
#undef PG8_STAGE
#undef PG8_LDA
#undef PG8_LDB
#undef PG8_MMA
#undef PG8_WAIT_V
#undef PG8_WAIT_L
#undef PG8_BAR
#undef PG8_SCHED
}
}

#ifndef PG8_SP2
#define PG8_SP2 true
#endif
#ifndef PG8_ALIGN
#define PG8_ALIGN true
#endif
constexpr int NWAVES = 8;
constexpr int NBATCH = 2, SEQ = 8192, DM = 1024, M = NBATCH * SEQ;
constexpr int INW = 2560, ZW = 2048;
constexpr int LRUW = 512, ATTW = 512, NCHUNK = SEQ / 64;
constexpr int NEXP = 16384, PEER_H = 8, NSEL = 128;
constexpr float EPS = 1e-6f;
constexpr float LOG2E = 1.4426950408889634f;

constexpr size_t MiB = 1u << 20;
constexpr size_t WS_CTL = 0, CTL_ZERO_BYTES = 1 * MiB;
constexpr size_t WS_WIN = 1 * MiB, WS_WOUT = 6 * MiB, WS_WQ = 8 * MiB, WS_WKV = 10 * MiB, WS_WO = 14 * MiB, WS_WQRY = 16 * MiB;
constexpr size_t WS_SUBK = 20 * MiB, WS_GATEW = 20 * MiB + 512 * 1024, WS_MEMN = 21 * MiB, WS_KM = 22 * MiB, WS_VMT = 23 * MiB, WS_AGG = 24 * MiB, WS_SSQ1 = 25 * MiB, WS_SSQ2 = 26 * MiB, WS_SU = 27 * MiB;
constexpr size_t WS_EU = 28 * MiB, WS_EV = 60 * MiB, WS_XN = 92 * MiB, WS_Z = 124 * MiB, WS_VT = 188 * MiB, WS_Y = 204 * MiB, WS_END = 236 * MiB;
constexpr size_t WS_QC = WS_Z, WS_OC = WS_Z + 32 * MiB, WS_QP = WS_Z, WS_IDX = WS_VT, WS_G = WS_VT + 8 * MiB;
constexpr int CW_BAR = 4096;

constexpr int RING_BYTES = 155648;
constexpr int LDSCTL_OFF = RING_BYTES, MISC_OFF = LDSCTL_OFF + 320;
constexpr int LDS_BYTES = 163840;

#define GAS __attribute__((address_space(1)))
#define LAS __attribute__((address_space(3)))
typedef unsigned short bf16;
typedef unsigned v4u __attribute__((ext_vector_type(4)));
typedef unsigned v2u __attribute__((ext_vector_type(2)));
typedef float f32x4 __attribute__((ext_vector_type(4)));
typedef float f32x2 __attribute__((ext_vector_type(2)));
typedef float f32x16 __attribute__((ext_vector_type(16)));
typedef short bf16x8 __attribute__((ext_vector_type(8)));
typedef __bf16 bf16x2_t __attribute__((ext_vector_type(2)));
typedef GAS unsigned gu32;
typedef _Float16 v32h __attribute__((ext_vector_type(32)));
typedef unsigned v6u __attribute__((ext_vector_type(6)));
typedef _Float16 f16x2_t __attribute__((ext_vector_type(2)));
constexpr int EV_ROW = 768;
#define RLX_AGENT __ATOMIC_RELAXED, __HIP_MEMORY_SCOPE_AGENT
#define LDS_WAIT() asm volatile("s_waitcnt lgkmcnt(0)" ::: "memory")
#define VM_WAIT() asm volatile("s_waitcnt vmcnt(0)" ::: "memory")
#define MFMA32(a, b, c) __builtin_amdgcn_mfma_f32_32x32x16_bf16((a), (b), (c), 0, 0, 0)
#define DI __device__ __forceinline__

DI unsigned pk2(float lo, float hi) { f32x2 v = {lo, hi}; bf16x2_t b = __builtin_convertvector(v, bf16x2_t); return __builtin_bit_cast(unsigned, b); }
DI bf16 f2bf(float x) { return (bf16)(pk2(x, 0.f) & 0xffffu); }
DI float bf2f(bf16 x) { return __uint_as_float((unsigned)x << 16); }
DI float bflo(unsigned p) { return __uint_as_float(p << 16); }
DI float bfhi(unsigned p) { return __uint_as_float(p & 0xffff0000u); }
DI int crow(int reg, int hh) { return (reg & 3) + 8 * (reg >> 2) + 4 * hh; }
DI float swap32_partner(float x, int hh) { auto rr = __builtin_amdgcn_permlane32_swap(__float_as_uint(x), __float_as_uint(x), false, false); return __uint_as_float(hh ? rr[0] : rr[1]); }
DI float dpp_xor1(float x) { return __int_as_float(__builtin_amdgcn_update_dpp(0, __float_as_int(x), 0xB1, 0xf, 0xf, true)); }
DI float dpp_xor2(float x) { return __int_as_float(__builtin_amdgcn_update_dpp(0, __float_as_int(x), 0x4E, 0xf, 0xf, true)); }
DI float dpp_hmir(float x) { return __int_as_float(__builtin_amdgcn_update_dpp(0, __float_as_int(x), 0x141, 0xf, 0xf, true)); }
DI float dpp_mir(float x)  { return __int_as_float(__builtin_amdgcn_update_dpp(0, __float_as_int(x), 0x140, 0xf, 0xf, true)); }
DI float sum16(float x) { x += dpp_xor1(x); x += dpp_xor2(x); x += dpp_hmir(x); x += dpp_mir(x); return x; }
DI float sum32(float x) { x = sum16(x); auto rr = __builtin_amdgcn_permlane16_swap(__float_as_uint(x), __float_as_uint(x), false, false); return __uint_as_float(rr[0]) + __uint_as_float(rr[1]); }
DI float max16(float x) { x = fmaxf(x, dpp_xor1(x)); x = fmaxf(x, dpp_xor2(x)); x = fmaxf(x, dpp_hmir(x)); x = fmaxf(x, dpp_mir(x)); return x; }
DI float max64(float x) { x = max16(x); { auto rr = __builtin_amdgcn_permlane16_swap(__float_as_uint(x), __float_as_uint(x), false, false); x = fmaxf(__uint_as_float(rr[0]), __uint_as_float(rr[1])); }
    { auto rr = __builtin_amdgcn_permlane32_swap(__float_as_uint(x), __float_as_uint(x), false, false); x = fmaxf(__uint_as_float(rr[0]), __uint_as_float(rr[1])); } return x; }
DI unsigned pack_i8x4(float a, float b, float c, float d) { const int ia = (int)__builtin_rintf(a), ib = (int)__builtin_rintf(b), ic = (int)__builtin_rintf(c), id = (int)__builtin_rintf(d);
    return (unsigned)(ia & 255) | ((unsigned)(ib & 255) << 8) | ((unsigned)(ic & 255) << 16) | ((unsigned)id << 24); }
DI float max32(float x) { x = max16(x); auto rr = __builtin_amdgcn_permlane16_swap(__float_as_uint(x), __float_as_uint(x), false, false); return fmaxf(__uint_as_float(rr[0]), __uint_as_float(rr[1])); }
DI float sum64(float x) { x = sum32(x); auto rr = __builtin_amdgcn_permlane32_swap(__float_as_uint(x), __float_as_uint(x), false, false); return __uint_as_float(rr[0]) + __uint_as_float(rr[1]); }
DI float rcp_(float x) { return __builtin_amdgcn_rcpf(x); }
DI float rsq_(float x) { return __builtin_amdgcn_rsqf(x); }
DI float exp2_(float x) { return __builtin_amdgcn_exp2f(x); }
DI float gelu_tanh(float x) { const float u = x * (1.5957691216057308f + 0.07135481627159768f * x * x); return x * rcp_(1.0f + exp2_(-LOG2E * u)); }
DI float sigmoidf_(float x) { return rcp_(1.0f + exp2_(-LOG2E * x)); }
#define XB_TMO      128
#define XB_XCNT(j)  (256  + 64 * (j))
#define XB_XSUB(j)  (1280 + 64 * (j))
#define XB_XGEN(j)  (2304 + 64 * (j))
#define XB_TOP      3328
#define XB_TOPGEN   3392
#define XCD_BAR_WORDS 3456
#define XB_SPIN_CAP (1u << 18)

__device__ __forceinline__ unsigned xb_ld(unsigned* p)              { return __hip_atomic_load(p, __ATOMIC_RELAXED, __HIP_MEMORY_SCOPE_AGENT); }
__device__ __forceinline__ unsigned xb_add(unsigned* p, unsigned v) { return __hip_atomic_fetch_add(p, v, __ATOMIC_RELAXED, __HIP_MEMORY_SCOPE_AGENT); }
__device__ __forceinline__ unsigned xb_xcc_id() { return (unsigned)__builtin_amdgcn_s_getreg((3 << 11) | 20) & 0xFu; }
#define XB_SPIN(cond, bar) do { unsigned _sp = 0; while (cond) { __builtin_amdgcn_s_sleep(1); \
    if ((++_sp & 255u) == 0u) { if (xb_ld(&(bar)[XB_TMO])) break; if (_sp > XB_SPIN_CAP) { atomicAdd(&(bar)[XB_TMO], 1u); break; } } } } while (0)

struct XcdBarrier {
    unsigned* bar; unsigned x;
    volatile LAS unsigned* st;
};

__device__ __forceinline__ XcdBarrier xcd_barrier_post(unsigned* bar, volatile LAS unsigned* st) {
    XcdBarrier b; b.bar = bar; b.x = xb_xcc_id(); b.st = st;
    if (threadIdx.x == 0) (void)xb_add(&bar[XB_XCNT(b.x)], 1u);
    return b;
}
__device__ __forceinline__ void xcd_barrier_complete(unsigned* bar, unsigned x, unsigned& nloc, unsigned& nx) {
    const unsigned G = gridDim.x * gridDim.y * gridDim.z;
    unsigned sum, cnt, mine, sp = 0u;
    for (;;) {
        sum = 0u; cnt = 0u; mine = 0u;
#pragma unroll
        for (unsigned j = 0; j < 16; ++j) { const unsigned c = xb_ld(&bar[XB_XCNT(j)]); sum += c; cnt += (c > 0u) ? 1u : 0u; mine = (j == x) ? c : mine; }
        if (sum == G) break;
        __builtin_amdgcn_s_sleep(1);
        if ((++sp & 255u) == 0u) { if (xb_ld(&bar[XB_TMO])) break; if (sp > XB_SPIN_CAP) { atomicAdd(&bar[XB_TMO], 1u); break; } }
    }
    nloc = mine > 0u ? mine : 1u; nx = cnt > 0u ? cnt : 1u;
}

__device__ __forceinline__ void xcd_barrier(const XcdBarrier& b) {
    asm volatile("s_waitcnt vmcnt(0)" ::: "memory");
    __syncthreads();
    if (threadIdx.x == 0) {
        unsigned* bar = b.bar;
        __builtin_amdgcn_s_waitcnt(0);
        unsigned nloc = b.st[0], nx = b.st[1];
        if (nloc == 0u) { xcd_barrier_complete(bar, b.x, nloc, nx); b.st[0] = nloc; b.st[1] = nx; }
        const unsigned old = xb_add(&bar[XB_XSUB(b.x)], 1u);
        const unsigned gen = old / nloc;
        if (old + 1u == (gen + 1u) * nloc) {
            __builtin_amdgcn_fence(__ATOMIC_RELEASE, "agent");
            asm volatile("s_waitcnt vmcnt(0)" ::: "memory");
            const unsigned og = xb_add(&bar[XB_TOP], 1u);
            const unsigned tg = og / nx;
            if (og + 1u == (tg + 1u) * nx) xb_add(&bar[XB_TOPGEN], 1u);
            else XB_SPIN(xb_ld(&bar[XB_TOPGEN]) == tg, bar);
            __builtin_amdgcn_fence(__ATOMIC_ACQUIRE, "agent");
            xb_add(&bar[XB_XGEN(b.x)], 1u);
            asm volatile("s_waitcnt vmcnt(0)" ::: "memory");
        } else {
            XB_SPIN(xb_ld(&bar[XB_XGEN(b.x)]) == gen, bar);
            __builtin_amdgcn_fence(__ATOMIC_ACQUIRE, "agent");
            asm volatile("s_waitcnt vmcnt(0)" ::: "memory");
        }
    }
    __syncthreads();
}
struct Args { const float* in[26]; float* out; unsigned char* ws; int ph_lo, ph_hi, li, pad; };
struct Frame {
    LAS unsigned char* lds;
    volatile LAS unsigned* MISC;
    gu32* ctl;
    int tid, lane, wave, vcu, G;
    const Args* A; float* out; unsigned char* ws;
    DI const float* in(int k) const { return A->in[k]; }
    template <class T> DI T* wsp(size_t off) const { return (T*)(ws + off); }
};

DI void p0_transpose_item(const float* W, int K, int N, bf16* WT, LAS float* scr, int item, int lane, const float* g0, const float* g1, int gsplit) {
    const int nblk = N / 32, kb = item / nblk, nb = item % nblk, k0 = 64 * kb, n0 = 32 * nb;
    float wv[32], gv[32];
#pragma unroll
    for (int i = 0; i < 32; ++i) { const int k = k0 + 2 * i + (lane >> 5); wv[i] = W[(size_t)k * N + n0 + (lane & 31)]; gv[i] = g0 ? ((k < gsplit) ? g0[k] : g1[k - gsplit]) : 1.f; }
#pragma unroll
    for (int i = 0; i < 32; ++i) scr[(2 * i + (lane >> 5)) * 33 + (lane & 31)] = wv[i] * gv[i];
    LDS_WAIT(); asm volatile("" ::: "memory");
    const int c = lane & 7;
#pragma unroll
    for (int j = 0; j < 4; ++j) { const int n = (lane >> 3) + 8 * j; const LAS float* s = scr + (8 * c) * 33 + n;
        v4u o; o.x = pk2(s[0 * 33], s[1 * 33]); o.y = pk2(s[2 * 33], s[3 * 33]); o.z = pk2(s[4 * 33], s[5 * 33]); o.w = pk2(s[6 * 33], s[7 * 33]);
        *(GAS v4u*)(WT + (size_t)(n0 + n) * K + k0 + 8 * c) = o; }
    LDS_WAIT(); asm volatile("" ::: "memory");
}
template <bool NORM> DI void row_to_bf16(const float* xrow, bf16* orow, const float* gain, int lane) {
    const GAS f32x4* xr = (const GAS f32x4*)xrow + lane;
    f32x4 v[4]; float s = 0.f;
#pragma unroll
    for (int j = 0; j < 4; ++j) { v[j] = xr[64 * j]; s += (v[j].x * v[j].x + v[j].y * v[j].y) + (v[j].z * v[j].z + v[j].w * v[j].w); }
    float rstd = 1.f;
    if (NORM) rstd = 1.0f / sqrtf(sum64(s) * (1.f / 1024.f) + EPS);
    GAS v2u* o8 = (GAS v2u*)orow + lane;
#pragma unroll
    for (int j = 0; j < 4; ++j) { f32x4 w = v[j] * rstd; if (gain) w = w * ((const GAS f32x4*)gain)[64 * j + lane];
        v2u o; o.x = pk2(w.x, w.y); o.y = pk2(w.z, w.w); o8[64 * j] = o; }
}
constexpr float U_SCALE = 128.f, V_SCALE = 16.f;
template <bool NORM, int NB> DI void rows_to_bf16(const float* xrow, bf16* orow, size_t row_stride, const float* gain, int lane) {
    f32x4 v[NB][4];
#pragma unroll
    for (int b = 0; b < NB; ++b)
#pragma unroll
        for (int j = 0; j < 4; ++j) v[b][j] = ((const GAS f32x4*)(xrow + b * row_stride))[64 * j + lane];
#pragma unroll
    for (int b = 0; b < NB; ++b) { float s = 0.f;
#pragma unroll
        for (int j = 0; j < 4; ++j) s += (v[b][j].x * v[b][j].x + v[b][j].y * v[b][j].y) + (v[b][j].z * v[b][j].z + v[b][j].w * v[b][j].w);
        float rstd = 1.f; if (NORM) rstd = rsq_(sum64(s) * (1.f / 1024.f) + EPS);
        GAS v2u* o8 = (GAS v2u*)(orow + b * row_stride) + lane;
#pragma unroll
        for (int j = 0; j < 4; ++j) { f32x4 w = v[b][j] * rstd; if (gain) w = w * ((const GAS f32x4*)gain)[64 * j + lane];
            v2u o; o.x = pk2(w.x, w.y); o.y = pk2(w.z, w.w); o8[64 * j] = o; } }
}
DI void row_to_fp8(const float* src, unsigned char* dst, const float* gain, float scale, int lane) {
#pragma unroll
    for (int j = 0; j < 4; ++j) { f32x4 v = ((const GAS f32x4*)src)[64 * j + lane] * scale; if (gain) v = v * ((const GAS f32x4*)gain)[64 * j + lane];
        unsigned w = 0u; w = __builtin_amdgcn_cvt_pk_fp8_f32(v.x, v.y, w, false); w = __builtin_amdgcn_cvt_pk_fp8_f32(v.z, v.w, w, true);
        ((GAS unsigned*)dst)[64 * j + lane] = w; }
}
DI void row_to_i8(const float* src, unsigned char* dst, const float* gain, float* scale_out, int lane) {
    f32x4 v[4]; float mx = 0.f;
#pragma unroll
    for (int j = 0; j < 4; ++j) { v[j] = ((const GAS f32x4*)src)[64 * j + lane] * ((const GAS f32x4*)gain)[64 * j + lane];
        mx = fmaxf(fmaxf(mx, fmaxf(fabsf(v[j].x), fabsf(v[j].y))), fmaxf(fabsf(v[j].z), fabsf(v[j].w))); }
    mx = fmaxf(max64(mx), 1e-30f);
    const float inv = 127.0f / mx;
#pragma unroll
    for (int j = 0; j < 4; ++j) ((GAS unsigned*)dst)[64 * j + lane] = pack_i8x4(v[j].x * inv, v[j].y * inv, v[j].z * inv, v[j].w * inv);
    if (lane == 0) *scale_out = mx * (1.0f / 127.0f);
}
DI void convert_experts(Frame& F, int wv, int nwv) {
    const int lane = F.lane;
    const int l5 = lane & 31, hh = lane >> 5;
    for (int m = wv * 2; m < NEXP; m += nwv * 2) {
        f32x4 u[2][4], v[8];
#pragma unroll
        for (int b = 0; b < 2; ++b)
#pragma unroll
            for (int j = 0; j < 4; ++j) u[b][j] = ((const GAS f32x4*)(F.in(23) + (size_t)(m + b) * DM))[64 * j + lane];
#pragma unroll
        for (int j = 0; j < 8; ++j) v[j] = ((const GAS f32x4*)(F.in(24) + (size_t)(m + hh) * DM))[8 * l5 + j];
#pragma unroll
        for (int b = 0; b < 2; ++b) {
            float mx = 0.f;
#pragma unroll
            for (int j = 0; j < 4; ++j) { u[b][j] = u[b][j] * ((const GAS f32x4*)F.in(20))[64 * j + lane];
                mx = fmaxf(fmaxf(mx, fmaxf(fabsf(u[b][j].x), fabsf(u[b][j].y))), fmaxf(fabsf(u[b][j].z), fabsf(u[b][j].w))); }
            mx = fmaxf(max64(mx), 1e-30f);
            const float inv = 127.0f / mx;
#pragma unroll
            for (int j = 0; j < 4; ++j) ((GAS unsigned*)(F.wsp<unsigned char>(WS_EU) + (size_t)(m + b) * DM))[64 * j + lane] = pack_i8x4(u[b][j].x * inv, u[b][j].y * inv, u[b][j].z * inv, u[b][j].w * inv);
            if (lane == 0) F.wsp<float>(WS_SU)[m + b] = mx * (1.0f / 127.0f);
        }
        {
            float mx = 0.f;
#pragma unroll
            for (int j = 0; j < 8; ++j) mx = fmaxf(fmaxf(mx, fmaxf(fabsf(v[j].x), fabsf(v[j].y))), fmaxf(fabsf(v[j].z), fabsf(v[j].w)));
            mx = fmaxf(max32(mx), 1e-30f);
            const float inv = 7.5f / mx;
            v32h h;
#pragma unroll
            for (int j = 0; j < 8; ++j) { h[4 * j] = (_Float16)(v[j].x * inv); h[4 * j + 1] = (_Float16)(v[j].y * inv); h[4 * j + 2] = (_Float16)(v[j].z * inv); h[4 * j + 3] = (_Float16)(v[j].w * inv); }
            const v6u pk = __builtin_amdgcn_cvt_scalef32_pk32_fp6_f16(h, 1.0f);
            unsigned char* rowp = F.wsp<unsigned char>(WS_EV) + (size_t)(m + hh) * EV_ROW;
            *(GAS v4u*)(rowp + 16 * l5) = (v4u){pk[0], pk[1], pk[2], pk[3]}; *(GAS v2u*)(rowp + 512 + 8 * l5) = (v2u){pk[4], pk[5]};
            if (l5 == 0) F.wsp<float>(WS_SU)[NEXP + m + hh] = mx * (1.0f / 7.5f);
        }
    }
}
DI void p0_prologue(Frame& F, int parts = 7) {
    LAS float* scr = (LAS float*)(F.lds + F.wave * 16384);
    const int gw = F.vcu * NWAVES + F.wave, NGW = F.G * NWAVES, lane = F.lane;
    constexpr int I_IN = 16 * (INW / 32), I_D = 16 * (DM / 32), I_2D = 16 * (2 * DM / 32);
    constexpr int NITEMS = I_IN + 3 * I_D + 2 * I_2D;
    for (int it = gw; it < ((parts & 1) ? NITEMS : 0); it += NGW) {
        int r = it;
        if (r < I_IN) { p0_transpose_item(F.in(3), DM, INW, F.wsp<bf16>(WS_WIN), scr, r, lane, F.in(2), F.in(2), DM); continue; } r -= I_IN;
        if (r < I_D) { p0_transpose_item(F.in(14), DM, DM, F.wsp<bf16>(WS_WOUT), scr, r, lane, F.in(12), F.in(13), LRUW); continue; } r -= I_D;
        if (r < I_D) { p0_transpose_item(F.in(17), DM, DM, F.wsp<bf16>(WS_WQ), scr, r, lane, F.in(15), F.in(15), DM); continue; } r -= I_D;
        if (r < I_2D) { p0_transpose_item(F.in(18), DM, 2 * DM, F.wsp<bf16>(WS_WKV), scr, r, lane, nullptr, nullptr, 0); continue; } r -= I_2D;
        if (r < I_D) { p0_transpose_item(F.in(19), DM, DM, F.wsp<bf16>(WS_WO), scr, r, lane, nullptr, nullptr, 0); continue; } r -= I_D;
        p0_transpose_item(F.in(21), DM, 2 * DM, F.wsp<bf16>(WS_WQRY), scr, r, lane, F.in(20), F.in(20), DM);
    }
    for (int m = gw * 4; m < ((parts & 2) ? M : 0); m += NGW * 4) rows_to_bf16<true, 4>(F.in(0) + (size_t)m * DM, F.wsp<bf16>(WS_XN) + (size_t)m * DM, DM, nullptr, lane);
    for (int m = gw; m < NBATCH * 256; m += NGW) row_to_bf16<true>(F.in(1) + (size_t)m * DM, F.wsp<bf16>(WS_MEMN) + (size_t)m * DM, F.in(16), lane);
    { const int gt = gw * 64 + lane, NT = NGW * 64;
      for (int i = gt; i < 8 * 2 * 128 * 128 / 4; i += NT) { const f32x4 v = ((const GAS f32x4*)F.in(22))[i]; v2u o; o.x = pk2(v.x, v.y); o.y = pk2(v.z, v.w); ((GAS v2u*)F.wsp<bf16>(WS_SUBK))[i] = o; }
      for (int o = gt; o < 2 * 8 * 64 * 64; o += NT) { const int i = o & 63, j = (o >> 6) & 63, h = (o >> 12) & 7, g = o >> 15;
          const float* W = g ? F.in(8) : F.in(6); F.wsp<bf16>(WS_GATEW)[o] = f2bf(W[(h * 64 + i) * 64 + j]); } }
}
struct LruState { float ba[2], bx[2], sp[2], S[2], Ap[2]; };
template <bool PASS2>
DI void lru_prep(const Frame& F, int b, int chunk, int h, int lane, LAS unsigned char* xcs  , LruState& st) {
    const int r = lane & 31, hh = lane >> 5;
    const size_t row0 = (size_t)b * SEQ + (size_t)chunk * 64;
    {
        const int c2 = h * 64 + 2 * r;
        const f32x2 w0 = *(const f32x2*)(F.in(4) + c2), w1 = *(const f32x2*)(F.in(4) + LRUW + c2), w2 = *(const f32x2*)(F.in(4) + 2 * LRUW + c2), w3 = *(const f32x2*)(F.in(4) + 3 * LRUW + c2);
        const f32x2 cb = *(const f32x2*)(F.in(5) + c2);
        const int tl0 = 32 * hh;
        const bf16* zp = F.wsp<bf16>(WS_Z) + (row0 + tl0) * ZW + c2;
        const bool first = (chunk == 0 && hh == 0);
        unsigned p0 = first ? 0u : *(const unsigned*)(zp - 3 * ZW), p1 = first ? 0u : *(const unsigned*)(zp - 2 * ZW), p2 = first ? 0u : *(const unsigned*)(zp - ZW);
#pragma unroll
        for (int t = 0; t < 32; ++t) { const unsigned p3 = *(const unsigned*)(zp + (size_t)t * ZW);
            const float lo = cb.x + bflo(p0) * w0.x + bflo(p1) * w1.x + bflo(p2) * w2.x + bflo(p3) * w3.x;
            const float hi = cb.y + bfhi(p0) * w0.y + bfhi(p1) * w1.y + bfhi(p2) * w2.y + bfhi(p3) * w3.y;
            *(LAS unsigned*)(xcs + (tl0 + t) * 144 + 4 * r) = pk2(lo, hi);
            p0 = p1; p1 = p2; p2 = p3; }
        LDS_WAIT();
    }
#pragma unroll
    for (int nt = 0; nt < 2; ++nt) { const int c = h * 64 + 32 * nt + r; st.ba[nt] = F.in(7)[c]; st.bx[nt] = F.in(9)[c];
        const float nl = -F.in(10)[c]; st.sp[nt] = fmaxf(nl, 0.f) + log1pf(__expf(-fabsf(nl))); st.S[nt] = 0.f; st.Ap[nt] = 1.f; }
    if (PASS2) {
        float s = 0.f; const float* ag = F.wsp<float>(WS_AGG) + ((size_t)b * NCHUNK * LRUW + h * 64 + lane) * 2;
        for (int c0 = 0; c0 < chunk; c0 += 32) {
            f32x2 ab[32];
#pragma unroll
            for (int i = 0; i < 32; ++i) ab[i] = *(const f32x2*)(ag + (size_t)(c0 + i < NCHUNK ? c0 + i : NCHUNK - 1) * LRUW * 2);
#pragma unroll
            for (int i = 0; i < 32; ++i) { const bool on = c0 + i < chunk; s = (on ? ab[i].x : 1.0f) * s + (on ? ab[i].y : 0.0f); }
        }
        st.S[0] = __shfl(s, r); st.S[1] = __shfl(s, 32 + r);
    }
}
template <bool PASS2>
DI void lru_tile(const Frame& F, int b, int chunk, int mt, int h, int lane, LAS unsigned char* xcs, LAS unsigned char* gim  , LruState& st, float (&ssq)[16]) {
    const int r = lane & 31, hh = lane >> 5;
    const size_t row0 = (size_t)b * SEQ + (size_t)chunk * 64;
    const bf16* gw = F.wsp<bf16>(WS_GATEW) + (size_t)h * 4096;
    bf16x8 af[4];
#pragma unroll
    for (int s = 0; s < 4; ++s) af[s] = *(const LAS bf16x8*)(xcs + (32 * mt + r) * 144 + (16 * s + 8 * hh) * 2);
    float ssl[16];
#pragma unroll
    for (int i = 0; i < 16; ++i) ssl[i] = 0.f;
    if (PASS2) {
#pragma unroll
        for (int i = 0; i < 4; ++i) { const int row = (lane >> 3) + 8 * i, c = lane & 7;
            *(LAS v4u*)(gim + row * 144 + c * 16) = *(const v4u*)(F.wsp<bf16>(WS_Z) + (row0 + 32 * mt + row) * ZW + LRUW + h * 64 + 8 * c); }
        LDS_WAIT();
    }
#pragma unroll
    for (int nt = 0; nt < 2; ++nt) {
        asm volatile("" ::: "memory");
        f32x16 aa = {}, ax = {};
#pragma unroll
        for (int s = 0; s < 4; ++s) {
            const bf16x8 wa = *(const bf16x8*)(gw + (size_t)(32 * nt + r) * 64 + 16 * s + 8 * hh);
            const bf16x8 wx = *(const bf16x8*)(gw + 32768 + (size_t)(32 * nt + r) * 64 + 16 * s + 8 * hh);
            aa = MFMA32(af[s], wa, aa); ax = MFMA32(af[s], wx, ax);
        }
#pragma unroll
        for (int i = 0; i < 16; ++i) {
            const float rg = sigmoidf_(aa[i] + st.ba[nt]), ig = sigmoidf_(ax[i] + st.bx[nt]);
            const float la = -8.0f * rg * st.sp[nt];
            const float a = exp2_(LOG2E * la);
            const float mult = __builtin_amdgcn_sqrtf(fmaxf(1.0f - a * a, 0.f));
            const float xc = bf2f(*(const LAS bf16*)(xcs + (32 * mt + crow(i, hh)) * 144 + (32 * nt + r) * 2));
            aa[i] = a; ax[i] = mult * ig * xc;
        }
        float Ao[4], Bo[4], Aq[4], Bq[4], Sin[4];
#pragma unroll
        for (int q = 0; q < 4; ++q) { const float a0 = aa[4 * q], a1 = aa[4 * q + 1], a2 = aa[4 * q + 2], a3 = aa[4 * q + 3];
            Ao[q] = (a0 * a1) * (a2 * a3); Bo[q] = ((ax[4 * q] * a1 + ax[4 * q + 1]) * a2 + ax[4 * q + 2]) * a3 + ax[4 * q + 3];
            Aq[q] = swap32_partner(Ao[q], hh); Bq[q] = swap32_partner(Bo[q], hh); }
        float s_ = st.S[nt];
#pragma unroll
        for (int q = 0; q < 4; ++q) { const float A1 = hh ? Aq[q] : Ao[q], B1 = hh ? Bq[q] : Bo[q], A2 = hh ? Ao[q] : Aq[q], B2 = hh ? Bo[q] : Bq[q];
            const float smid = A1 * s_ + B1; Sin[q] = hh ? smid : s_; s_ = A2 * smid + B2; st.Ap[nt] *= A1 * A2; }
        st.S[nt] = s_;
        if (PASS2) {
#pragma unroll
            for (int q = 0; q < 4; ++q) { float hp = Sin[q];
#pragma unroll
                for (int e = 0; e < 4; ++e) { const int i = 4 * q + e; hp = aa[i] * hp + ax[i];
                    const float gt = bf2f(*(const LAS bf16*)(gim + crow(i, hh) * 144 + (32 * nt + r) * 2));
                    const float y = hp * gelu_tanh(gt); ssl[i] += y * y;
                    *(LAS bf16*)(xcs + (32 * mt + crow(i, hh)) * 144 + (32 * nt + r) * 2) = f2bf(y); } }
        }
    }
    if (PASS2) {
#pragma unroll
        for (int i = 0; i < 16; ++i) ssq[i] = sum32(ssl[i]);
    }
}
constexpr int ATT_KST = 144, ATT_VST = 136, ATT_KBYTES = 64 * ATT_KST, ATT_VBYTES = 64 * ATT_VST;
DI void attn_wave(const Frame& F, int b, int n, int qt, int h, int lane, const LAS float* tab, LAS unsigned char* kl  , f32x16 (&o)[2]) {
    const int r = lane & 31, hh = lane >> 5;
    LAS unsigned char* vl = kl + ATT_KBYTES;
    const size_t row0 = (size_t)b * SEQ + (size_t)n * 64;
    const float SC = 0.125f * LOG2E;
    bf16x8 qf[4];
#pragma unroll
    for (int s = 0; s < 4; ++s) qf[s] = *(const bf16x8*)(F.wsp<bf16>(WS_Z) + (row0 + 32 * qt + r) * ZW + 2 * LRUW + h * 64 + 16 * s + 8 * hh);
    float mrun = -1e30f, lrun = 0.f;
#pragma unroll
    for (int dt = 0; dt < 2; ++dt) o[dt] = f32x16{};
    const float bfar = tab[256];
    const int srow = lane >> 3, sc8 = lane & 7;
    const int kc0 = (n >= 8 ? n - 8 : 0);
    const char* kg = (const char*)(F.wsp<bf16>(WS_Z) + (size_t)b * SEQ * ZW + 2 * LRUW + ATTW + h * 64);
    const char* vg = (const char*)(F.wsp<bf16>(WS_VT) + (size_t)(b * 8 + h) * 64 * SEQ);
    const unsigned kof = (unsigned)(srow * ZW + 8 * sc8) * 2u, vof = (unsigned)(srow * SEQ + 8 * sc8) * 2u;
    v4u kreg[8];
#pragma unroll
    for (int i = 0; i < 8; ++i) kreg[i] = *(const v4u*)(kg + ((size_t)kc0 * 64 + 8 * i) * ZW * 2 + kof);
    for (int kc = kc0; kc <= n; ++kc) {
        const int dd = n - kc;
        v4u vreg[8];
#pragma unroll
        for (int i = 0; i < 8; ++i) { *(LAS v4u*)(kl + (srow + 8 * i) * ATT_KST + sc8 * 16) = kreg[i]; vreg[i] = *(const v4u*)(vg + ((size_t)(8 * i) * SEQ + kc * 64) * 2 + vof); }
        f32x16 sc[2];
#pragma unroll
        for (int kt = 0; kt < 2; ++kt) { sc[kt] = f32x16{};
#pragma unroll
            for (int s = 0; s < 4; ++s) { const bf16x8 kf = *(const LAS bf16x8*)(kl + (32 * kt + r) * ATT_KST + (16 * s + 8 * hh) * 2); sc[kt] = MFMA32(kf, qf[s], sc[kt]); } }
        if (dd >= 3) {
#pragma unroll
            for (int kt = 0; kt < 2; ++kt)
#pragma unroll
                for (int i = 0; i < 16; ++i) sc[kt][i] = sc[kt][i] * SC + bfar;
        } else {
            const int base = 64 * dd + 32 * qt + r + 128;
#pragma unroll
            for (int kt = 0; kt < 2; ++kt)
#pragma unroll
                for (int i = 0; i < 16; ++i) { int idx = base - (32 * kt + crow(i, hh)); idx = idx > 256 ? 256 : idx; sc[kt][i] = sc[kt][i] * SC + tab[idx]; }
        }
        float mx = sc[0][0];
#pragma unroll
        for (int kt = 0; kt < 2; ++kt)
#pragma unroll
            for (int i = 0; i < 16; ++i) mx = fmaxf(mx, sc[kt][i]);
        mx = fmaxf(mx, swap32_partner(mx, hh));
        const float mnew = fmaxf(mrun, mx), alpha = exp2_(mrun - mnew);
        float ls = 0.f;
#pragma unroll
        for (int kt = 0; kt < 2; ++kt)
#pragma unroll
            for (int i = 0; i < 16; ++i) { const float p = exp2_(sc[kt][i] - mnew); sc[kt][i] = p; ls += p; }
        lrun = lrun * alpha + ls; mrun = mnew;
#pragma unroll
        for (int dt = 0; dt < 2; ++dt)
#pragma unroll
            for (int i = 0; i < 16; ++i) o[dt][i] *= alpha;
#pragma unroll
        for (int i = 0; i < 8; ++i) { LAS v2u* vd = (LAS v2u*)(vl + (srow + 8 * i) * ATT_VST + sc8 * 16); vd[0] = (v2u){vreg[i].x, vreg[i].y}; vd[1] = (v2u){vreg[i].z, vreg[i].w}; }
        if (kc < n) {
#pragma unroll
            for (int i = 0; i < 8; ++i) kreg[i] = *(const v4u*)(kg + ((size_t)(kc + 1) * 64 + 8 * i) * ZW * 2 + kof);
        }
#pragma unroll
        for (int kt = 0; kt < 2; ++kt)
#pragma unroll
            for (int s2 = 0; s2 < 2; ++s2) { v4u w; w.x = pk2(sc[kt][8 * s2], sc[kt][8 * s2 + 1]); w.y = pk2(sc[kt][8 * s2 + 2], sc[kt][8 * s2 + 3]); w.z = pk2(sc[kt][8 * s2 + 4], sc[kt][8 * s2 + 5]); w.w = pk2(sc[kt][8 * s2 + 6], sc[kt][8 * s2 + 7]);
                const bf16x8 pf = __builtin_bit_cast(bf16x8, w);
#pragma unroll
                for (int dt = 0; dt < 2; ++dt) { const LAS unsigned char* vp = vl + (32 * dt + r) * ATT_VST + (32 * kt + 16 * s2 + 4 * hh) * 2;
                    const v2u lo = *(const LAS v2u*)vp, hi = *(const LAS v2u*)(vp + 16); v4u vw; vw.x = lo.x; vw.y = lo.y; vw.z = hi.x; vw.w = hi.y;
                    o[dt] = MFMA32(__builtin_bit_cast(bf16x8, vw), pf, o[dt]); } }
    }
    const float lt = lrun + swap32_partner(lrun, hh); const float inv = rcp_(lt);
#pragma unroll
    for (int dt = 0; dt < 2; ++dt)
#pragma unroll
        for (int i = 0; i < 16; ++i) o[dt][i] *= inv;
}

DI void p2_lru_aggregates(Frame& F) {
    const int lane = F.lane, r = lane & 31, hh = lane >> 5, h = F.wave;
    LAS unsigned char* xcs = F.lds + 12288 + h * 17920;
    for (int u = F.vcu; u < NBATCH * NCHUNK; u += F.G) {
        const int b = u / NCHUNK, n = u % NCHUNK;
        LruState st; float ssq[16];
        lru_prep<false>(F, b, n, h, lane, xcs, st);
#pragma unroll 1
        for (int mt = 0; mt < 2; ++mt) lru_tile<false>(F, b, n, mt, h, lane, xcs, xcs + 9216, st, ssq);
        if (hh == 0) {
#pragma unroll
            for (int nt = 0; nt < 2; ++nt) *(f32x2*)(F.wsp<float>(WS_AGG) + (((size_t)b * NCHUNK + n) * LRUW + h * 64 + 32 * nt + r) * 2) = (f32x2){st.Ap[nt], st.S[nt]};
        }
        LDS_WAIT();
    }
}
DI void p3_mixer(Frame& F, int parts = 3) {
    const int lane = F.lane, r = lane & 31, hh = lane >> 5, h = F.wave;
    LAS float* ssx = (LAS float*)(F.lds);
    LAS float* tab = (LAS float*)(F.lds + 2048 + h * 1280);
    LAS unsigned* stg = (LAS unsigned*)(F.lds + 12288 + h * 17920);
    for (int i = lane; i < 257; i += 64) tab[i] = F.in(11)[h * 257 + i] * LOG2E;
    LDS_WAIT();
    for (int u = F.vcu; u < NBATCH * NCHUNK; u += F.G) {
        const int b = u / NCHUNK, n = u % NCHUNK; const size_t row0 = (size_t)b * SEQ + (size_t)n * 64;
#ifndef MIX_PARTS
#define MIX_PARTS 3
#endif
        if (parts & 1) {
            LruState st;
            lru_prep<true>(F, b, n, h, lane, (LAS unsigned char*)stg, st);
#pragma unroll 1
            for (int mt = 0; mt < 2; ++mt) {
                float ssq[16];
                lru_tile<true>(F, b, n, mt, h, lane, (LAS unsigned char*)stg, (LAS unsigned char*)stg + 9216, st, ssq);
                if (r == 0) {
#pragma unroll
                    for (int i = 0; i < 16; ++i) ssx[crow(i, hh) * 8 + h] = ssq[i];
                }
                __syncthreads();
                const LAS unsigned char* yst = (const LAS unsigned char*)stg + 32 * mt * 144;
#pragma unroll
                for (int i = 0; i < 4; ++i) { const int row = (lane >> 3) + 8 * i, c = lane & 7;
                    const f32x4 s0 = *(const LAS f32x4*)(ssx + row * 8), s1 = *(const LAS f32x4*)(ssx + row * 8 + 4);
                    const float rs = rsq_(((s0.x + s0.y) + (s0.z + s0.w) + (s1.x + s1.y) + (s1.z + s1.w)) * (1.f / 512.f) + EPS);
                    const v4u v = *(const LAS v4u*)(yst + row * 144 + c * 16);
                    v4u o; o.x = pk2(bflo(v.x) * rs, bfhi(v.x) * rs); o.y = pk2(bflo(v.y) * rs, bfhi(v.y) * rs); o.z = pk2(bflo(v.z) * rs, bfhi(v.z) * rs); o.w = pk2(bflo(v.w) * rs, bfhi(v.w) * rs);
                    *(v4u*)(F.wsp<bf16>(WS_Y) + (row0 + 32 * mt + row) * DM + h * 64 + 8 * c) = o; }
                __syncthreads();
            }
        }
    }
    for (int u = F.vcu; u < NBATCH * NCHUNK; u += F.G) {
        const int b = u / NCHUNK, n = u % NCHUNK; const size_t row0 = (size_t)b * SEQ + (size_t)n * 64;
#pragma unroll 1
        for (int qt = 0; qt < ((parts & 2) ? 2 : 0); ++qt) {
            f32x16 o[2];
            attn_wave(F, b, n, qt, h, lane, tab, (LAS unsigned char*)stg, o);
            float s = 0.f;
#pragma unroll
            for (int dt = 0; dt < 2; ++dt)
#pragma unroll
                for (int i = 0; i < 16; ++i) s += o[dt][i] * o[dt][i];
            s += swap32_partner(s, hh);
            if (hh == 0) ssx[r * 8 + h] = s;
            __syncthreads();
            { const f32x4 s0 = *(const LAS f32x4*)(ssx + r * 8), s1 = *(const LAS f32x4*)(ssx + r * 8 + 4);
              const float rs = rsq_(((s0.x + s0.y) + (s0.z + s0.w) + (s1.x + s1.y) + (s1.z + s1.w)) * (1.f / 512.f) + EPS);
#pragma unroll
              for (int dt = 0; dt < 2; ++dt)
#pragma unroll
                  for (int i = 0; i < 16; i += 2) stg[r * 33 + ((32 * dt + crow(i, hh)) >> 1)] = pk2(o[dt][i] * rs, o[dt][i + 1] * rs); }
            LDS_WAIT();
#pragma unroll 4
            for (int i = 0; i < 16; ++i) { const int row = 2 * i + hh; const unsigned v = stg[row * 33 + r];
                *(GAS unsigned*)(F.wsp<bf16>(WS_Y) + (row0 + 32 * qt + row) * DM + LRUW + h * 64 + 2 * r) = v; }
            __syncthreads();
        }
    }
}
DI void p5_cross(Frame& F, const pg8::StaticOrder& S) {
    const int lane = F.lane, r = lane & 31, hh = lane >> 5, w = F.wave, tid = F.tid;
    constexpr int KST = 528, VST = 520;
    const float SC = 0.0625f * LOG2E;
    pg8::Unit un;
    for (int ui = 0; S.next(ui, un); ++ui) {
        const int b = un.pm >> 5, qb = un.pm & 31, hm = un.pn;
        const size_t qrow = (size_t)b * SEQ + (size_t)qb * 256 + 32 * w + r;
        { const bf16* src = F.wsp<bf16>(WS_KM) + (size_t)(b * 256) * DM + hm * 256;
#pragma unroll 4
          for (int i = 0; i < 16; ++i) { const int c = i * 512 + tid, row = c >> 5, ch = c & 31;
              *(LAS v4u*)(F.lds + row * KST + ch * 16) = *(const v4u*)(src + (size_t)row * DM + ch * 8); } }
        __syncthreads();
        f32x16 sc[8];
#pragma unroll
        for (int kt = 0; kt < 8; ++kt) sc[kt] = f32x16{};
#pragma unroll 2
        for (int s = 0; s < 16; ++s) {
            const bf16x8 qf = *(const bf16x8*)(F.wsp<bf16>(WS_QC) + qrow * DM + hm * 256 + 16 * s + 8 * hh);
#pragma unroll
            for (int kt = 0; kt < 8; ++kt) { const bf16x8 kf = *(const LAS bf16x8*)(F.lds + (32 * kt + r) * KST + (16 * s + 8 * hh) * 2); sc[kt] = MFMA32(kf, qf, sc[kt]); }
        }
        float mx = sc[0][0];
#pragma unroll
        for (int kt = 0; kt < 8; ++kt)
#pragma unroll
            for (int i = 0; i < 16; ++i) mx = fmaxf(mx, sc[kt][i]);
        mx = fmaxf(mx, swap32_partner(mx, hh));
        float ls = 0.f; const float mo = mx * SC;
        bf16x8 pf[8][2];
#pragma unroll
        for (int kt = 0; kt < 8; ++kt) {
#pragma unroll
            for (int i = 0; i < 16; ++i) { const float p = exp2_(sc[kt][i] * SC - mo); sc[kt][i] = p; ls += p; }
#pragma unroll
            for (int s2 = 0; s2 < 2; ++s2) { v4u wv; wv.x = pk2(sc[kt][8 * s2], sc[kt][8 * s2 + 1]); wv.y = pk2(sc[kt][8 * s2 + 2], sc[kt][8 * s2 + 3]); wv.z = pk2(sc[kt][8 * s2 + 4], sc[kt][8 * s2 + 5]); wv.w = pk2(sc[kt][8 * s2 + 6], sc[kt][8 * s2 + 7]);
                pf[kt][s2] = __builtin_bit_cast(bf16x8, wv); }
        }
        ls += swap32_partner(ls, hh);
        const float inv = 1.0f / ls;
        __syncthreads();
        { const bf16* src = F.wsp<bf16>(WS_VMT) + (size_t)((b * 4 + hm) * 256) * 256;
#pragma unroll 4
          for (int i = 0; i < 16; ++i) { const int c = i * 512 + tid, row = c >> 5, ch = c & 31; const v4u v = *(const v4u*)(src + (size_t)row * 256 + ch * 8);
              LAS v2u* d = (LAS v2u*)(F.lds + row * VST + ch * 16); d[0] = (v2u){v.x, v.y}; d[1] = (v2u){v.z, v.w}; } }
        __syncthreads();
        LAS unsigned* stg = (LAS unsigned*)(F.lds) ;
#pragma unroll
        for (int half = 0; half < 2; ++half) {
            f32x16 o[4];
#pragma unroll
            for (int dt = 0; dt < 4; ++dt) o[dt] = f32x16{};
#pragma unroll
            for (int kt = 0; kt < 8; ++kt)
#pragma unroll
                for (int s2 = 0; s2 < 2; ++s2)
#pragma unroll
                    for (int dt = 0; dt < 4; ++dt) { const LAS unsigned char* p = F.lds + (128 * half + 32 * dt + r) * VST + (32 * kt + 16 * s2 + 4 * hh) * 2;
                        const v2u lo = *(const LAS v2u*)p, hi = *(const LAS v2u*)(p + 16); v4u wv; wv.x = lo.x; wv.y = lo.y; wv.z = hi.x; wv.w = hi.y;
                        o[dt] = MFMA32(__builtin_bit_cast(bf16x8, wv), pf[kt][s2], o[dt]); }
            if (half == 1) __syncthreads();
            else {   }
            if (half == 0) {
#pragma unroll
                for (int dt = 0; dt < 4; ++dt)
#pragma unroll
                    for (int i = 0; i < 16; i += 2) { const unsigned pv = pk2(o[dt][i] * inv, o[dt][i + 1] * inv); sc[dt][i >> 1] = __uint_as_float(pv); }
            } else {
                LAS unsigned* sw = (LAS unsigned*)(F.lds + w * 16512);
#pragma unroll
                for (int dt = 0; dt < 4; ++dt)
#pragma unroll
                    for (int i = 0; i < 16; i += 2) { sw[r * 129 + ((32 * dt + crow(i, hh)) >> 1)] = __float_as_uint(sc[dt][i >> 1]);
                        sw[r * 129 + 64 + ((32 * dt + crow(i, hh)) >> 1)] = pk2(o[dt][i] * inv, o[dt][i + 1] * inv); }
                LDS_WAIT();
#pragma unroll 4
                for (int i = 0; i < 32; ++i) { const unsigned v0 = sw[i * 129 + lane], v1 = sw[i * 129 + 64 + lane];
                    GAS unsigned* dst = (GAS unsigned*)(F.wsp<bf16>(WS_OC) + ((size_t)b * SEQ + (size_t)qb * 256 + 32 * w + i) * DM + hm * 256);
                    dst[lane] = v0; dst[64 + lane] = v1; }
            }
        }
        (void)stg;
        __syncthreads();
    }
}
template <int N> DI void ce_desc(float (&a)[N], int i, int l) { const float hi = fmaxf(a[i], a[l]), lo = fminf(a[i], a[l]); a[i] = hi; a[l] = lo; }
template <int N, int OFF> DI void bitonic_sort16_desc(float (&a)[N]) {
#define CE_(i, j) ce_desc<N>(a, OFF + (i), OFF + (j))
    CE_(0,13); CE_(1,12); CE_(2,15); CE_(3,14); CE_(4,8); CE_(5,6); CE_(7,11); CE_(9,10);
    CE_(0,5); CE_(1,7); CE_(2,9); CE_(3,4); CE_(6,13); CE_(8,14); CE_(10,15); CE_(11,12);
    CE_(0,1); CE_(2,3); CE_(4,5); CE_(6,8); CE_(7,9); CE_(10,11); CE_(12,13); CE_(14,15);
    CE_(0,2); CE_(1,3); CE_(4,10); CE_(5,11); CE_(6,7); CE_(8,9); CE_(12,14); CE_(13,15);
    CE_(1,2); CE_(3,12); CE_(4,6); CE_(5,7); CE_(8,10); CE_(9,11); CE_(13,14);
    CE_(1,4); CE_(2,6); CE_(5,8); CE_(7,10); CE_(9,13); CE_(11,14);
    CE_(2,4); CE_(3,6); CE_(9,12); CE_(11,13);
    CE_(3,5); CE_(6,8); CE_(7,9); CE_(10,12);
    CE_(3,4); CE_(5,6); CE_(7,8); CE_(9,10); CE_(11,12);
    CE_(6,7); CE_(8,9);
#undef CE_
}
template <int N, int OFF> DI void bitonic_merge16_desc(float (&a)[N]) {
#pragma unroll
    for (int j = 8; j > 0; j >>= 1)
#pragma unroll
        for (int i = 0; i < 16; ++i) { const int l = i ^ j; if (l > i) ce_desc<N>(a, OFF + i, OFF + l); }
}
template <bool SORTED, bool SORT0 = true> DI void top16_of_64(float (&a)[64]) {
    if (SORT0) bitonic_sort16_desc<64, 0>(a); bitonic_sort16_desc<64, 16>(a); bitonic_sort16_desc<64, 32>(a); bitonic_sort16_desc<64, 48>(a);
#pragma unroll
    for (int i = 0; i < 16; ++i) { a[i] = fmaxf(a[i], a[31 - i]); a[32 + i] = fmaxf(a[32 + i], a[63 - i]); }
    bitonic_merge16_desc<64, 0>(a); bitonic_merge16_desc<64, 32>(a);
#pragma unroll
    for (int i = 0; i < 16; ++i) a[i] = fmaxf(a[i], a[47 - i]);
    if (SORTED) bitonic_merge16_desc<64, 0>(a);
}
DI void p8a_topk(Frame& F, const pg8::StaticOrder& S) {
    const int lane = F.lane, r = lane & 31, hh = lane >> 5, w = F.wave;
    constexpr int TK_ST = 272, TK_QBYTES = 256 * TK_ST;
    LAS float* tbl = (LAS float*)(F.lds + w * 8192);
    pg8::Unit un;
    for (int ui = 0; S.next(ui, un); ++ui) {
        const int h = un.pn; const size_t tok = (size_t)un.pm * 256 + 32 * w + r;
        float v[2][16];
#pragma unroll
        for (int p = 0; p < 2; ++p) {
            __syncthreads();
            { const bf16* qsrc = F.wsp<bf16>(WS_QP) + (size_t)un.pm * 256 * 2048 + h * 256 + p * 128; const bf16* ksrc = F.wsp<bf16>(WS_SUBK) + (size_t)((h * 2 + p) * 128) * 128;
              const int rr = F.tid >> 4, ch = F.tid & 15;
#pragma unroll
              for (int i = 0; i < 8; ++i) *(LAS v4u*)(F.lds + (32 * i + rr) * TK_ST + ch * 16) = *(const v4u*)(qsrc + (size_t)(32 * i + rr) * 2048 + ch * 8);
#pragma unroll
              for (int i = 0; i < 4; ++i) *(LAS v4u*)(F.lds + TK_QBYTES + (32 * i + rr) * TK_ST + ch * 16) = *(const v4u*)(ksrc + (size_t)(32 * i + rr) * 128 + ch * 8); }
            __syncthreads();
            f32x16 sc[4];
#pragma unroll
            for (int nt = 0; nt < 4; ++nt) sc[nt] = f32x16{};
#pragma unroll 2
            for (int s = 0; s < 8; ++s) { const bf16x8 qf = *(const LAS bf16x8*)(F.lds + (32 * w + r) * TK_ST + (16 * s + 8 * hh) * 2);
#pragma unroll
                for (int nt = 0; nt < 4; ++nt) { const bf16x8 kf = *(const LAS bf16x8*)(F.lds + TK_QBYTES + (32 * nt + r) * TK_ST + (16 * s + 8 * hh) * 2); sc[nt] = MFMA32(kf, qf, sc[nt]); } }
            float a[64];
#pragma unroll
            for (int nt = 0; nt < 4; ++nt)
#pragma unroll
                for (int i = 0; i < 16; ++i) a[nt * 16 + i] = __uint_as_float((__float_as_uint(sc[nt][i]) & ~127u) | (unsigned)(32 * nt + crow(i, hh)));
            top16_of_64<true>(a);
            float m[16];
#pragma unroll
            for (int i = 0; i < 16; ++i) m[i] = fmaxf(a[i], swap32_partner(a[15 - i], hh));
            bitonic_merge16_desc<16, 0>(m);
#pragma unroll
            for (int i = 0; i < 16; ++i) v[p][i] = m[i];
        }
        float c[64]; int n = 0;
#pragma unroll
        for (int i = 0; i < 16; ++i)
#pragma unroll
            for (int j = 0; j < 16; ++j) if ((i + 1) * (j + 1) <= 16) { c[n] = __uint_as_float((__float_as_uint(v[0][i] + v[1][j]) & ~255u) | (unsigned)((i << 4) | j)); ++n; }
#pragma unroll
        for (int k = 50; k < 64; ++k) c[k] = -3.0e38f;
        top16_of_64<false, false>(c);
        __syncthreads();
#pragma unroll
        for (int i = 0; i < 16; ++i) { tbl[i * 64 + lane] = v[0][i]; tbl[(16 + i) * 64 + lane] = v[1][i]; }
        LDS_WAIT();
        float sv[16]; int ev[16]; float mx = -3.0e38f;
#pragma unroll
        for (int k = 0; k < 16; ++k) { const unsigned pl = __float_as_uint(c[k]) & 255u; const float a1 = tbl[(pl >> 4) * 64 + lane], a2 = tbl[(16 + (pl & 15)) * 64 + lane];
            sv[k] = a1 + a2; ev[k] = (int)(((__float_as_uint(a1) & 127u) << 7) | (__float_as_uint(a2) & 127u)); mx = fmaxf(mx, sv[k]); }
        float sum = 0.f;
#pragma unroll
        for (int k = 0; k < 16; ++k) { sv[k] = __expf(sv[k] - mx); sum += sv[k]; }
        const float inv = 1.0f / sum;
        if (hh == 0) {
#pragma unroll
            for (int k = 0; k < 16; k += 4) *(v4u*)(F.wsp<int>(WS_IDX) + tok * NSEL + h * 16 + k) = (v4u){(unsigned)ev[k], (unsigned)ev[k + 1], (unsigned)ev[k + 2], (unsigned)ev[k + 3]};
        } else {
#pragma unroll
            for (int k = 0; k < 16; k += 4) *(f32x4*)(F.wsp<float>(WS_G) + tok * NSEL + h * 16 + k) = (f32x4){sv[k] * inv, sv[k + 1] * inv, sv[k + 2] * inv, sv[k + 3] * inv};
        }
        LDS_WAIT();
    }
}
typedef _Float16 f16x2_t __attribute__((ext_vector_type(2)));
DI int dot16_i8(const v4u& u, const unsigned (&x)[4]) {
    const unsigned u0 = u.x, u1 = u.y, u2 = u.z, u3 = u.w;
    int a = 0;
    a = __builtin_amdgcn_sdot4((int)u0, (int)x[0], a, false); a = __builtin_amdgcn_sdot4((int)u1, (int)x[1], a, false);
    a = __builtin_amdgcn_sdot4((int)u2, (int)x[2], a, false); a = __builtin_amdgcn_sdot4((int)u3, (int)x[3], a, false);
    return a;
}
DI void axpy32_v6(f16x2_t (&o)[16], float w, const v4u a, unsigned b4, unsigned b5) {
    const v6u pk = {a.x, a.y, a.z, a.w, b4, b5};
    const v32h h = __builtin_amdgcn_cvt_scalef32_pk32_f16_fp6(pk, 1.0f);
    const f16x2_t w2 = {(_Float16)w, (_Float16)w};
#pragma unroll
    for (int i = 0; i < 16; ++i) { const f16x2_t hv = {h[2 * i], h[2 * i + 1]}; o[i] = __builtin_elementwise_fma(hv, w2, o[i]); }
}
constexpr int TPW = 4, NSLICE = 16, SLICE_SHIFT = 10, NPAIR = TPW * NSEL, NPAIR_PAD = NPAIR + 1 * TPW * NSLICE + 32;
constexpr int PEER_LDS_PER_WAVE = TPW * 1024 + 64 + TPW * 2048 + NPAIR_PAD * 4;
static_assert(PEER_LDS_PER_WAVE * NWAVES <= RING_BYTES, "PEER LDS");
DI int incl_scan64(int v, int lane) {
    int s = v;
#pragma unroll
    for (int d = 1; d < 64; d <<= 1) { const int t = __shfl_up(s, d); if (lane >= d) s += t; }
    return s;
}
struct PeerBatch { v4u uu[4]; v4u va[2]; unsigned vb4[2], vb5[2]; unsigned ent[4]; float su[4], sv[4]; };
DI void peer_load_batch(PeerBatch& B, const LAS unsigned* ml, int i, const unsigned char* EU8, const unsigned char* EV8, const float* SU, int lane, unsigned emask = 0x3fffu) {
    const v4u e4 = *(const LAS v4u*)(ml + i);
    B.ent[0] = (unsigned)__builtin_amdgcn_readfirstlane((int)e4.x); B.ent[1] = (unsigned)__builtin_amdgcn_readfirstlane((int)e4.y);
    B.ent[2] = (unsigned)__builtin_amdgcn_readfirstlane((int)e4.z); B.ent[3] = (unsigned)__builtin_amdgcn_readfirstlane((int)e4.w);
    const int l5 = lane & 31, hh = lane >> 5;
#pragma unroll
    for (int k = 0; k < 4; ++k) { const unsigned e = B.ent[k] & emask; const unsigned char* ur = EU8 + (size_t)e * DM;
        B.uu[k] = *(const v4u*)(ur + (unsigned)(16 * lane)); B.su[k] = SU[e]; B.sv[k] = SU[NEXP + e]; }
#pragma unroll
    for (int q = 0; q < 2; ++q) { const unsigned e0 = B.ent[2 * q] & emask, e1 = B.ent[2 * q + 1] & emask; const unsigned e = e0 + (unsigned)hh * (e1 - e0);
        const unsigned off = e * (unsigned)EV_ROW; B.va[q] = *(const v4u*)(EV8 + off + (unsigned)(16 * l5)); const v2u t2 = *(const v2u*)(EV8 + off + (unsigned)(512 + 8 * l5)); B.vb4[q] = t2.x; B.vb5[q] = t2.y; }
}
struct PeerState { unsigned x[4]; float sx; f16x2_t oc[16]; int curj; };
DI void peer_flush(PeerState& S, LAS unsigned char* ol, int lane) {
    LAS v4u* r = (LAS v4u*)(ol + S.curj * 2048 + 64 * (lane & 31) + 32 * (lane >> 5));
    unsigned mine[8];
#pragma unroll
    for (int i = 0; i < 8; ++i) { auto rr = __builtin_amdgcn_permlane32_swap(__builtin_bit_cast(unsigned, S.oc[i]), __builtin_bit_cast(unsigned, S.oc[8 + i]), false, false);
        mine[i] = __builtin_bit_cast(unsigned, __builtin_bit_cast(f16x2_t, (unsigned)rr[0]) + __builtin_bit_cast(f16x2_t, (unsigned)rr[1])); }
#pragma unroll
    for (int c = 0; c < 2; ++c) { const v4u v = r[c]; v4u o;
        o.x = __builtin_bit_cast(unsigned, __builtin_bit_cast(f16x2_t, (unsigned)v.x) + __builtin_bit_cast(f16x2_t, mine[4 * c])); o.y = __builtin_bit_cast(unsigned, __builtin_bit_cast(f16x2_t, (unsigned)v.y) + __builtin_bit_cast(f16x2_t, mine[4 * c + 1]));
        o.z = __builtin_bit_cast(unsigned, __builtin_bit_cast(f16x2_t, (unsigned)v.z) + __builtin_bit_cast(f16x2_t, mine[4 * c + 2])); o.w = __builtin_bit_cast(unsigned, __builtin_bit_cast(f16x2_t, (unsigned)v.w) + __builtin_bit_cast(f16x2_t, mine[4 * c + 3]));
        r[c] = o; }
#pragma unroll
    for (int i = 0; i < 16; ++i) S.oc[i] = (f16x2_t){(_Float16)0.f, (_Float16)0.f};
}
DI void peer_compute_batch(const PeerBatch& B, PeerState& S, LAS unsigned char* ol, const LAS unsigned char* xl, int lane) {
    const int jA = (int)((B.ent[0] >> 14) & 3u), jB = (int)((B.ent[2] >> 14) & 3u);
    if (jA != S.curj) {
        if (S.curj >= 0) peer_flush(S, ol, lane);
        S.curj = jA;
        const v4u y0 = ((const LAS v4u*)(xl + jA * 1024))[lane];
        S.x[0] = y0.x; S.x[1] = y0.y; S.x[2] = y0.z; S.x[3] = y0.w; S.sx = ((const LAS float*)(xl + TPW * 1024))[jA]; }
    unsigned xb[4] = {S.x[0], S.x[1], S.x[2], S.x[3]}; float sxb = S.sx;
    if (jB != jA) { const v4u y0 = ((const LAS v4u*)(xl + jB * 1024))[lane]; xb[0] = y0.x; xb[1] = y0.y; xb[2] = y0.z; xb[3] = y0.w; sxb = ((const LAS float*)(xl + TPW * 1024))[jB]; }
    const float d0 = (float)dot16_i8(B.uu[0], S.x) * B.su[0], d1 = (float)dot16_i8(B.uu[1], S.x) * B.su[1], d2 = (float)dot16_i8(B.uu[2], xb) * B.su[2], d3 = (float)dot16_i8(B.uu[3], xb) * B.su[3];
    const bool b0 = lane & 1, b1 = lane & 2;
    const float r0 = (b0 ? d1 : d0) + dpp_xor1(b0 ? d0 : d1), r1 = (b0 ? d3 : d2) + dpp_xor1(b0 ? d2 : d3);
    float t = (b1 ? r1 : r0) + dpp_xor2(b1 ? r0 : r1);
    t += __int_as_float(__builtin_amdgcn_update_dpp(0, __float_as_int(t), 0x124, 0xf, 0xf, true));
    t += __int_as_float(__builtin_amdgcn_update_dpp(0, __float_as_int(t), 0x128, 0xf, 0xf, true));
    { auto rr = __builtin_amdgcn_permlane16_swap(__float_as_uint(t), __float_as_uint(t), false, false); t = __uint_as_float(rr[0]) + __uint_as_float(rr[1]); }
    { auto rr = __builtin_amdgcn_permlane32_swap(__float_as_uint(t), __float_as_uint(t), false, false); t = __uint_as_float(rr[0]) + __uint_as_float(rr[1]); }
    const float act = gelu_tanh(t * (b1 ? sxb : S.sx));
#define PEER_W(k) (__builtin_bit_cast(float, __builtin_amdgcn_readlane(__builtin_bit_cast(int, act), k)) * __uint_as_float(B.ent[k] & 0xffff0000u) * B.sv[k])
    const float a0 = PEER_W(0), a1 = PEER_W(1), a2 = PEER_W(2), a3 = PEER_W(3);
#undef PEER_W
    const float hsel = (lane >= 32) ? 1.0f : 0.0f;
    axpy32_v6(S.oc, a0 + hsel * (a1 - a0), B.va[0], B.vb4[0], B.vb5[0]);
    if (jB != jA) { peer_flush(S, ol, lane); S.curj = jB; S.x[0] = xb[0]; S.x[1] = xb[1]; S.x[2] = xb[2]; S.x[3] = xb[3]; S.sx = sxb; }
    axpy32_v6(S.oc, a2 + hsel * (a3 - a2), B.va[1], B.vb4[1], B.vb5[1]);
}
DI void p8b_peer(Frame& F, float* outp, unsigned emask = 0x3fffu, float oscale = 1.0f) {
    const int lane = F.lane, w = F.wave;
    const int gw = F.vcu * NWAVES + w, NGW = F.G * NWAVES;
    const unsigned char* EU8 = F.wsp<unsigned char>(WS_EU); const unsigned char* EV8 = F.wsp<unsigned char>(WS_EV); const float* SU = F.wsp<float>(WS_SU);
    LAS unsigned char* xl = F.lds + w * PEER_LDS_PER_WAVE;
    LAS unsigned char* ol = xl + TPW * 1024 + 64;
    LAS unsigned* ml = (LAS unsigned*)(ol + TPW * 2048);
    for (int t0 = gw * TPW; t0 < M; t0 += NGW * TPW) {
        unsigned enta[TPW], entb[TPW]; int posa[TPW], posb[TPW], sla[TPW], slb[TPW], offs[TPW];
#pragma unroll
        for (int j = 0; j < TPW; ++j) { const size_t tok = (size_t)t0 + j;
            float rstd; { const f32x4* sp = (const f32x4*)(F.wsp<float>(WS_SSQ2) + tok * 16); const f32x4 st = (sp[0] + sp[1]) + (sp[2] + sp[3]); rstd = rsq_(((st.x + st.y) + (st.z + st.w)) * (1.f / 1024.f) + EPS); }
            { const bf16* xs = F.wsp<bf16>(WS_XN) + tok * DM + 16 * lane;
              const v4u x0 = *(const v4u*)xs, x1 = *(const v4u*)(xs + 8);
              float xf[16] = {bflo(x0.x), bfhi(x0.x), bflo(x0.y), bfhi(x0.y), bflo(x0.z), bfhi(x0.z), bflo(x0.w), bfhi(x0.w), bflo(x1.x), bfhi(x1.x), bflo(x1.y), bfhi(x1.y), bflo(x1.z), bfhi(x1.z), bflo(x1.w), bfhi(x1.w)};
              float mx = 0.f;
#pragma unroll
              for (int i = 0; i < 16; ++i) mx = fmaxf(mx, fabsf(xf[i]));
              mx = fmaxf(max64(mx), 1e-30f); const float inv = 127.0f / mx;
              v4u y; y.x = pack_i8x4(xf[0] * inv, xf[1] * inv, xf[2] * inv, xf[3] * inv); y.y = pack_i8x4(xf[4] * inv, xf[5] * inv, xf[6] * inv, xf[7] * inv);
              y.z = pack_i8x4(xf[8] * inv, xf[9] * inv, xf[10] * inv, xf[11] * inv); y.w = pack_i8x4(xf[12] * inv, xf[13] * inv, xf[14] * inv, xf[15] * inv);
              ((LAS v4u*)(xl + j * 1024))[lane] = y; if (lane == 0) ((LAS float*)(xl + TPW * 1024))[j] = mx * rstd * (1.0f / 127.0f);
              ((LAS v4u*)(ol + j * 2048))[lane] = (v4u){0u, 0u, 0u, 0u}; ((LAS v4u*)(ol + j * 2048))[64 + lane] = (v4u){0u, 0u, 0u, 0u}; }
            const int ea = F.wsp<int>(WS_IDX)[tok * NSEL + lane], eb = F.wsp<int>(WS_IDX)[tok * NSEL + 64 + lane];
            const float ga = F.wsp<float>(WS_G)[tok * NSEL + lane], gb = F.wsp<float>(WS_G)[tok * NSEL + 64 + lane];
            const int sa = ea >> SLICE_SHIFT, sb = eb >> SLICE_SHIFT;
            int pa = 0, pb = 0, myoff = 0;
#pragma unroll
            for (int bk = 0; bk < NSLICE; ++bk) { const unsigned long long ma = __ballot(sa == bk), mb = __ballot(sb == bk);
                const int ca = __popcll(ma), cb = __popcll(mb);
                const int ra = __builtin_amdgcn_mbcnt_hi((unsigned)(ma >> 32), __builtin_amdgcn_mbcnt_lo((unsigned)ma, 0)), rb = __builtin_amdgcn_mbcnt_hi((unsigned)(mb >> 32), __builtin_amdgcn_mbcnt_lo((unsigned)mb, 0));
                pa = (sa == bk) ? ra : pa; pb = (sb == bk) ? ca + rb : pb;
                myoff = (lane == bk) ? ca + cb : myoff; }
            enta[j] = (unsigned)ea | ((unsigned)j << 14) | (pk2(0.f, ga) & 0xffff0000u); entb[j] = (unsigned)eb | ((unsigned)j << 14) | (pk2(0.f, gb) & 0xffff0000u);
            posa[j] = pa; posb[j] = pb; sla[j] = sa; slb[j] = sb; offs[j] = myoff;
        }
        int cnt = 0;
#pragma unroll
        for (int j = 0; j < TPW; ++j) { const int c = __shfl(offs[j], lane >> 2); cnt = ((lane & 3) == j) ? c : cnt; }
        const int cpad = (cnt + 1) & ~1;
        const int bend = incl_scan64(cpad, lane), bstart = bend - cpad;
        const int npad = __builtin_amdgcn_readlane(bend, 63);
#pragma unroll
        for (int j = 0; j < TPW; ++j) { const int ba = __shfl(bstart, 4 * sla[j] + j), bb = __shfl(bstart, 4 * slb[j] + j);
            ml[ba + posa[j]] = enta[j]; ml[bb + posb[j]] = entb[j]; }
        { const unsigned pad = (unsigned)((lane >> 2) << SLICE_SHIFT) | ((unsigned)(lane & 3) << 14);
          if (cnt < cpad) ml[bstart + cnt] = pad; }
        if (lane < 30) ml[npad + lane] = (unsigned)((NSLICE - 1) << SLICE_SHIFT) | (3u << 14);
        LDS_WAIT();
        PeerState S;
#pragma unroll
        for (int i = 0; i < 16; ++i) S.oc[i] = (f16x2_t){(_Float16)0.f, (_Float16)0.f};
#pragma unroll
        for (int i = 0; i < 4; ++i) S.x[i] = 0u;
        S.curj = -1;
        PeerBatch A, B, C, D;
        peer_load_batch(A, ml, 0, EU8, EV8, SU, lane, emask); peer_load_batch(B, ml, 4, EU8, EV8, SU, lane, emask); peer_load_batch(C, ml, 8, EU8, EV8, SU, lane, emask);
#pragma unroll 1
        for (int i = 0; i < npad; i += 16) {
            peer_load_batch(D, ml, i + 12, EU8, EV8, SU, lane, emask); peer_compute_batch(A, S, ol, xl, lane);
            peer_load_batch(A, ml, i + 16, EU8, EV8, SU, lane, emask); peer_compute_batch(B, S, ol, xl, lane);
            peer_load_batch(B, ml, i + 20, EU8, EV8, SU, lane, emask); peer_compute_batch(C, S, ol, xl, lane);
            peer_load_batch(C, ml, i + 24, EU8, EV8, SU, lane, emask); peer_compute_batch(D, S, ol, xl, lane);
        }
        peer_flush(S, ol, lane);
        LDS_WAIT();
#pragma unroll
        for (int j = 0; j < TPW; ++j) {
            const int eb = 32 * (lane & 31) + 16 * (lane >> 5);
            float* orow = outp + ((size_t)t0 + j) * DM + eb;
            const v4u xb0 = *(const v4u*)(F.wsp<bf16>(WS_XN) + ((size_t)t0 + j) * DM + eb), xb1 = *(const v4u*)(F.wsp<bf16>(WS_XN) + ((size_t)t0 + j) * DM + eb + 8);
            const unsigned xw[8] = {xb0.x, xb0.y, xb0.z, xb0.w, xb1.x, xb1.y, xb1.z, xb1.w};
            f32x4 a[4]; float ss = 0.f;
            const v4u h0 = *(const LAS v4u*)(ol + j * 2048 + 2 * eb), h1 = *(const LAS v4u*)(ol + j * 2048 + 2 * eb + 16);
            const unsigned hw[8] = {h0.x, h0.y, h0.z, h0.w, h1.x, h1.y, h1.z, h1.w};
#pragma unroll
            for (int q = 0; q < 4; ++q) { const f16x2_t p0 = __builtin_bit_cast(f16x2_t, hw[2 * q]), p1 = __builtin_bit_cast(f16x2_t, hw[2 * q + 1]);
                a[q] = (f32x4){bflo(xw[2 * q]), bfhi(xw[2 * q]), bflo(xw[2 * q + 1]), bfhi(xw[2 * q + 1])} + (f32x4){(float)p0.x, (float)p0.y, (float)p1.x, (float)p1.y};
                ss += (a[q].x * a[q].x + a[q].y * a[q].y) + (a[q].z * a[q].z + a[q].w * a[q].w); }
            const float rf = rsq_(sum64(ss) * (1.f / 1024.f) + EPS) * oscale;
#pragma unroll
            for (int q = 0; q < 4; ++q) *(f32x4*)(orow + 4 * q) = a[q] * rf * *(const f32x4*)(F.in(25) + eb + 4 * q);
        }
        LDS_WAIT();
    }
}
constexpr int N_PHASES = 11;
__global__ void __launch_bounds__(NWAVES * 64, 2) fwd_kernel(Args args) {
    extern __shared__ __attribute__((aligned(16))) unsigned char lds[];
    Frame F;
    F.lds = (LAS unsigned char*)lds;
    F.MISC = (volatile LAS unsigned*)(F.lds + MISC_OFF);
    F.tid = threadIdx.x; F.lane = F.tid & 63; F.wave = __builtin_amdgcn_readfirstlane(F.tid >> 6);
    F.G = gridDim.x; { const int bx = blockIdx.x; F.vcu = (F.G % 8 == 0) ? (bx % 8) * (F.G / 8) + bx / 8 : bx; }
    F.A = &args; F.ws = args.ws; F.out = args.out;
    F.ctl = (gu32*)(args.ws + WS_CTL);
    for (int u = F.tid; u < (LDS_BYTES - LDSCTL_OFF) / 4; u += NWAVES * 64) ((LAS unsigned*)(F.lds + LDSCTL_OFF))[u] = 0u;
    __syncthreads();
    const bool multi = (args.ph_hi - args.ph_lo) > 1;
    XcdBarrier bar; bar.bar = (unsigned*)(F.ctl + CW_BAR) + args.li * XCD_BAR_WORDS; bar.x = 0; bar.st = nullptr;
    if (multi) bar = xcd_barrier_post((unsigned*)(F.ctl + CW_BAR) + args.li * XCD_BAR_WORDS, F.MISC + 8);
    const int lo = args.ph_lo, hi = args.ph_hi;
#ifndef PROBE_EMASK
#define PROBE_EMASK 0x3fffu
#endif
#ifndef PHASE_REPEAT
#define PHASE_REPEAT 0
#endif
#define REP(k) for (int rep_ = 0; rep_ < (((PHASE_REPEAT >> (k)) & 1) ? 2 : 1); ++rep_)
#ifndef PHASE_MASK
#define PHASE_MASK 0x7ff
#endif
#define IN(k) (((PHASE_MASK >> (k)) & 1) && lo <= (k) && (k) < hi)
#define SEAM(k) do { asm volatile("; ===SEAM " #k ::: "memory"); if (IN(k) && IN((k) + 1)) xcd_barrier(bar); STAMP((k) + 1); } while (0)
    const int c = (int)blockIdx.x;
#define LOCAL_SEAM() do { VM_WAIT(); __syncthreads(); if (F.tid == 0) { __builtin_amdgcn_fence(__ATOMIC_ACQUIRE, "agent"); VM_WAIT(); } __syncthreads(); } while (0)
#ifdef PROBE_PHASE
#define STAMP(i) do { if (blockIdx.x == 0 && F.tid == 0) __hip_atomic_store(F.ctl + 512 + (i), (unsigned)__builtin_amdgcn_s_memrealtime(), RLX_AGENT); } while (0)
#else
#define STAMP(i) do { } while (0)
#endif
    STAMP(0);

#ifndef PROBE_P0
#define PROBE_P0 7
#endif
    if (IN(0)) { if (PHASE_REPEAT & 1) p0_prologue(F, PROBE_P0); p0_prologue(F); } SEAM(0);
    if (IN(1)) REP(1) {
        { pg8::Gemm g{F.wsp<bf16>(WS_XN), F.wsp<bf16>(WS_WIN), M, INW, DM}; pg8::StaticOrder S; S.init(M, INW, F.G, c);
          pg8::EpiSplitT E{F.wsp<bf16>(WS_Z), ZW, ZW, F.wsp<bf16>(WS_VT), ATTW, SEQ};
          pg8::gemm_phase<pg8::EpiSplitT, pg8::StaticOrder, true, true>(F.lds, g, S, E); }
        { const int nw3 = (M / 256) * (INW / 256) - 2 * F.G;
          int idx = -1; if (nw3 >= 0 && nw3 + 16 <= F.G) idx = c - nw3; else idx = (c < 16 && F.G >= 16) ? c : -1;
          if (F.G < 16) idx = -1;
          pg8::Gemm g{F.wsp<bf16>(WS_MEMN), F.wsp<bf16>(WS_WKV), NBATCH * 256, 2 * DM, DM};
          if (F.G >= 16) { pg8::OneUnit S{idx, 2, 8}; pg8::EpiSplitT E{F.wsp<bf16>(WS_KM), DM, DM, F.wsp<bf16>(WS_VMT), DM, 256};
              pg8::gemm_phase<pg8::EpiSplitT, pg8::OneUnit, false, true>(F.lds, g, S, E); }
          else { pg8::StaticOrder S; S.init(NBATCH * 256, 2 * DM, F.G, c); pg8::EpiSplitT E{F.wsp<bf16>(WS_KM), DM, DM, F.wsp<bf16>(WS_VMT), DM, 256};
              pg8::gemm_phase<pg8::EpiSplitT, pg8::StaticOrder, false, true>(F.lds, g, S, E); } }
        { const int first_idle = (M / 256) * (INW / 256) - 2 * F.G + 16;
          if (first_idle > 0 && first_idle < F.G) { if (c >= first_idle) convert_experts(F, (c - first_idle) * NWAVES + F.wave, (F.G - first_idle) * NWAVES); }
          else convert_experts(F, c * NWAVES + F.wave, F.G * NWAVES); }
    } SEAM(1);
    if (IN(2)) REP(2) { p2_lru_aggregates(F); } SEAM(2);
#ifndef PROBE_PARTS
#define PROBE_PARTS 3
#endif
    if (IN(3)) { if ((PHASE_REPEAT >> 3) & 1) p3_mixer(F, PROBE_PARTS); p3_mixer(F); } SEAM(3);
    if (IN(4)) REP(4) {
        pg8::Gemm g{F.wsp<bf16>(WS_Y), F.wsp<bf16>(WS_WOUT), M, DM, DM}; pg8::StaticOrder S; S.init(M, DM, F.G, c);
        pg8::EpiResid<false> E{F.in(0), F.wsp<bf16>(WS_XN), F.wsp<float>(WS_SSQ1), DM};
        pg8::gemm_phase<pg8::EpiResid<false>, pg8::StaticOrder, true, true>(F.lds, g, S, E);
    } SEAM(4);
    if (IN(5)) {
        pg8::Gemm g{F.wsp<bf16>(WS_XN), F.wsp<bf16>(WS_WQ), M, DM, DM}; pg8::StaticOrder S; S.init(M, DM, F.G, c);
        pg8::EpiRowScale E{F.wsp<bf16>(WS_QC), DM, F.wsp<float>(WS_SSQ1), 1.f / 1024.f, EPS};
        pg8::gemm_phase<pg8::EpiRowScale, pg8::StaticOrder, true, true>(F.lds, g, S, E);
        LOCAL_SEAM();
        p5_cross(F, S);
    } SEAM(6);
    if (IN(7)) {
        pg8::Gemm g{F.wsp<bf16>(WS_OC), F.wsp<bf16>(WS_WO), M, DM, DM}; pg8::StaticOrder S; S.init(M, DM, F.G, c);
        pg8::EpiResid<true> E{F.wsp<bf16>(WS_XN), F.wsp<bf16>(WS_XN), F.wsp<float>(WS_SSQ2), DM};
        pg8::gemm_phase<pg8::EpiResid<true>, pg8::StaticOrder, true, true>(F.lds, g, S, E);
    } SEAM(7);
    if (IN(8)) {
        pg8::Gemm g{F.wsp<bf16>(WS_XN), F.wsp<bf16>(WS_WQRY), M, 2 * DM, DM}; pg8::StaticOrder S; S.init(M, 2 * DM, F.G, c);
        pg8::EpiRowScale E{F.wsp<bf16>(WS_QP), 2 * DM, F.wsp<float>(WS_SSQ2), 1.f / 1024.f, EPS};
        pg8::gemm_phase<pg8::EpiRowScale, pg8::StaticOrder, true, true>(F.lds, g, S, E);
        LOCAL_SEAM();
        p8a_topk(F, S);
    } SEAM(9);
    if (IN(10)) { if ((PHASE_REPEAT >> 10) & 1) { p8b_peer(F, F.wsp<float>(WS_Z), PROBE_EMASK); } p8b_peer(F, F.out, 0x3fffu,
#ifdef PROBE_PHASE
        1.0f + (float)(((__hip_atomic_load(F.ctl + 512 + PROBE_PHASE + 1, RLX_AGENT) - __hip_atomic_load(F.ctl + 512 + PROBE_PHASE, RLX_AGENT)) + 500u) / 1000u) * 1e-2f
#else
        1.0f
#endif
        ); }
#undef IN
#undef SEAM
}

#ifndef N_LAUNCH_MODE
#define N_LAUNCH_MODE 1
#endif
extern "C" void kernel_launch(void* const* d_in, const int* in_sizes, int n_in, void* d_out, int out_size, void* d_ws, size_t ws_size, hipStream_t stream) {
    static int grid = 0;
    if (grid == 0) {
        if (n_in != 26 || out_size != M * DM || ws_size < WS_END) { fprintf(stderr, "kernel_launch: unexpected shapes (n_in %d, out %d, ws %zu)\n", n_in, out_size, ws_size); grid = -1; return; }
        int dev = 0, cus = 0, per_cu = 0;
        if (hipGetDevice(&dev) != hipSuccess || hipDeviceGetAttribute(&cus, hipDeviceAttributeMultiprocessorCount, dev) != hipSuccess) { grid = -1; return; }
        if (hipFuncSetAttribute((const void*)fwd_kernel, hipFuncAttributeMaxDynamicSharedMemorySize, LDS_BYTES) != hipSuccess) { fprintf(stderr, "kernel_launch: hipFuncSetAttribute failed\n"); grid = -1; return; }
        if (hipOccupancyMaxActiveBlocksPerMultiprocessor(&per_cu, (const void*)fwd_kernel, NWAVES * 64, LDS_BYTES) != hipSuccess || per_cu < 1) { fprintf(stderr, "kernel_launch: occupancy query says %d blocks per CU\n", per_cu); (void)hipGetLastError(); grid = -1; return; }
        grid = cus;
    }
    if (grid < 0) return;
    (void)hipMemsetAsync((char*)d_ws + WS_CTL, 0, CTL_ZERO_BYTES, stream);
    Args a{};
    for (int i = 0; i < 26; ++i) a.in[i] = (const float*)d_in[i];
    a.out = (float*)d_out; a.ws = (unsigned char*)d_ws;
    if (N_LAUNCH_MODE == 1) { a.ph_lo = 0; a.ph_hi = N_PHASES; a.li = 0; hipLaunchKernelGGL(fwd_kernel, dim3(grid), dim3(NWAVES * 64), LDS_BYTES, stream, a); }
    else { for (int p = 0; p < N_PHASES; ++p) { a.ph_lo = p; a.ph_hi = p + 1; a.li = 0; hipLaunchKernelGGL(fwd_kernel, dim3(grid), dim3(NWAVES * 64), LDS_BYTES, stream, a); } }
}
```

```cpp
#include <hip/hip_runtime.h>
#include <cstdio>
#include <cstdint>
namespace pg8 {
#define PG8_LAS __attribute__((address_space(3)))
typedef unsigned short bf16_t;
typedef short bf16x8 __attribute__((ext_vector_type(8)));
typedef float f32x4 __attribute__((ext_vector_type(4)));
typedef unsigned u32x4 __attribute__((ext_vector_type(4)));
constexpr int BM = 256, BK = 64, HALF = 128, HTB = HALF * BK * 2  , STAGE_BYTES = 8 * HTB, NXCD = 8, WGM = 8;

__host__ __device__ __forceinline__ int lds_byte(int r, int c) { const int st = (r >> 4) * 2 + (c >> 5), rr = r & 15, cc = c & 31, ob = rr * 64 + cc * 2; return st * 1024 + (ob ^ (((ob >> 9) & 1) << 5)); }
__host__ __device__ __forceinline__ void stage_rc(int b, int& R, int& C) { const int st = b / 1024, sb = b % 1024, swz = sb ^ (((sb >> 9) & 1) << 5); R = (st >> 1) * 16 + swz / 64; C = (st & 1) * 32 + (swz % 64) / 2; }
__host__ __device__ __forceinline__ int perm32(int rho) { const int n = rho >> 4, i = rho & 15; return 8 * (i >> 2) + 4 * n + (i & 3); }

struct Unit { int pm, pn; };
struct Gemm { const bf16_t* A; const bf16_t* Bt; int M, N, K; };

struct StaticOrder {
    int nM, nN, nwg, G, c;
    __host__ __device__ void init(int M, int N, int G_, int c_) { nM = M / BM; nN = N / BM; nwg = nM * nN; G = G_; c = c_; }
    __host__ __device__ bool next(int i, Unit& u) const {
        const long L = (long)i * G + c; if (L >= nwg) return false;
        int wgid = (int)L; { const int q = nwg / NXCD, r = nwg % NXCD, xcd = wgid % NXCD, off = wgid / NXCD; wgid = (xcd < r ? xcd * (q + 1) : r * (q + 1) + (xcd - r) * q) + off; }
        const int nig = WGM * nN, gid = wgid / nig, fm = gid * WGM, gsz = (nM - fm) < WGM ? (nM - fm) : WGM;
        u.pm = fm + ((wgid % nig) % gsz); u.pn = (wgid % nig) / gsz; return true;
    }
    __device__ __forceinline__ void a_ready(const Unit&) const {}
    __device__ __forceinline__ void done(const Unit&) const {}
};

typedef float f32x2 __attribute__((ext_vector_type(2)));
typedef __bf16 bf16x2_t __attribute__((ext_vector_type(2)));
__device__ __forceinline__ unsigned cvt_pk_bf16(float lo, float hi) { f32x2 v = {lo, hi}; bf16x2_t b = __builtin_convertvector(v, bf16x2_t); return __builtin_bit_cast(unsigned, b); }
__device__ __forceinline__ bf16_t cvt_bf16(float x) { return (bf16_t)(cvt_pk_bf16(x, 0.f) & 0xffffu); }

struct EpiSplitT {
    static constexpr bool PERM = true, AFTER_DRAIN = false;
    bf16_t* O; int ldc; int ncols_rm; bf16_t* T; int NT; int rpb;
    __device__ __forceinline__ void operator()(const f32x4 (&acc)[2][2][4][2], const Unit& u, int wr, int wc, int fr, int fq) const {
        const int row0 = u.pm * BM + wr * 64 + fr; const int colt = u.pn * BM;
        if (colt < ncols_rm) {
            const int col0 = colt + wc * 32 + 8 * fq;
#pragma unroll
            for (int ai = 0; ai < 2; ++ai)
#pragma unroll
                for (int m = 0; m < 4; ++m) { bf16_t* rowp = O + (size_t)(row0 + ai * HALF + m * 16) * ldc + col0;
#pragma unroll
                    for (int bj = 0; bj < 2; ++bj) { const f32x4 v0 = acc[ai][bj][m][0], v1 = acc[ai][bj][m][1];
                        u32x4 w; w.x = cvt_pk_bf16(v0[0], v0[1]); w.y = cvt_pk_bf16(v0[2], v0[3]); w.z = cvt_pk_bf16(v1[0], v1[1]); w.w = cvt_pk_bf16(v1[2], v1[3]);
                        *(u32x4*)(rowp + bj * HALF) = w; } }
        } else {
            const int c0 = colt - ncols_rm + wc * 32 + 8 * fq;
#pragma unroll
            for (int ai = 0; ai < 2; ++ai)
#pragma unroll
                for (int m = 0; m < 4; ++m) { const int row = row0 + ai * HALF + m * 16; const int b = row / rpb, t = row - b * rpb; bf16_t* base = T + (size_t)b * NT * rpb + t;
#pragma unroll
                    for (int bj = 0; bj < 2; ++bj)
#pragma unroll
                        for (int n = 0; n < 2; ++n)
#pragma unroll
                            for (int e = 0; e < 4; ++e) base[(size_t)(c0 + bj * HALF + 4 * n + e) * rpb] = cvt_bf16(acc[ai][bj][m][n][e]); }
        }
    }
};
template <bool BASE_BF16> struct EpiResid {
    static constexpr bool PERM = true, AFTER_DRAIN = false;
    const void* base; bf16_t* xb; float* ssq; int ldc;
    __device__ __forceinline__ void operator()(const f32x4 (&acc)[2][2][4][2], const Unit& u, int wr, int wc, int fr, int fq) const {
        const int row0 = u.pm * BM + wr * 64 + fr; const int col0 = u.pn * BM + wc * 32 + 8 * fq;
#pragma unroll
        for (int ai = 0; ai < 2; ++ai)
#pragma unroll
            for (int m = 0; m < 4; ++m) { const int row = row0 + ai * HALF + m * 16; float s = 0.f;
#pragma unroll
                for (int bj = 0; bj < 2; ++bj) { const size_t off = (size_t)row * ldc + col0 + bj * HALF;
                    f32x4 b0, b1;
                    if (BASE_BF16) { const u32x4 w = *(const u32x4*)((const bf16_t*)base + off);
                        b0 = (f32x4){__uint_as_float(w.x << 16), __uint_as_float(w.x & 0xffff0000u), __uint_as_float(w.y << 16), __uint_as_float(w.y & 0xffff0000u)};
                        b1 = (f32x4){__uint_as_float(w.z << 16), __uint_as_float(w.z & 0xffff0000u), __uint_as_float(w.w << 16), __uint_as_float(w.w & 0xffff0000u)}; }
                    else { b0 = *(const f32x4*)((const float*)base + off); b1 = *(const f32x4*)((const float*)base + off + 4); }
                    const f32x4 v0 = acc[ai][bj][m][0] + b0, v1 = acc[ai][bj][m][1] + b1;
                    s += (v0[0] * v0[0] + v0[1] * v0[1]) + (v0[2] * v0[2] + v0[3] * v0[3]) + (v1[0] * v1[0] + v1[1] * v1[1]) + (v1[2] * v1[2] + v1[3] * v1[3]);
                    u32x4 w; w.x = cvt_pk_bf16(v0[0], v0[1]); w.y = cvt_pk_bf16(v0[2], v0[3]); w.z = cvt_pk_bf16(v1[0], v1[1]); w.w = cvt_pk_bf16(v1[2], v1[3]);
                    *(u32x4*)(xb + off) = w; }
                s += __shfl_xor(s, 16); s += __shfl_xor(s, 32);
                if (fq == 0) ssq[(size_t)row * 16 + u.pn * 4 + wc] = s; }
    }
};
struct EpiRowScale {
    static constexpr bool PERM = true, AFTER_DRAIN = false;
    bf16_t* O; int ldc; const float* ssq; float inv_n, eps;
    __device__ __forceinline__ void operator()(const f32x4 (&acc)[2][2][4][2], const Unit& u, int wr, int wc, int fr, int fq) const {
        const int row0 = u.pm * BM + wr * 64 + fr; const int col0 = u.pn * BM + wc * 32 + 8 * fq;
#pragma unroll
        for (int ai = 0; ai < 2; ++ai)
#pragma unroll
            for (int m = 0; m < 4; ++m) { const int row = row0 + ai * HALF + m * 16; const f32x4* sp = (const f32x4*)(ssq + (size_t)row * 16);
                const f32x4 s0 = sp[0], s1 = sp[1], s2 = sp[2], s3 = sp[3]; const f32x4 st = (s0 + s1) + (s2 + s3);
                const float r = 1.0f / sqrtf(((st[0] + st[1]) + (st[2] + st[3])) * inv_n + eps);
                bf16_t* rowp = O + (size_t)row * ldc + col0;
#pragma unroll
                for (int bj = 0; bj < 2; ++bj) { const f32x4 v0 = acc[ai][bj][m][0] * r, v1 = acc[ai][bj][m][1] * r;
                    u32x4 w; w.x = cvt_pk_bf16(v0[0], v0[1]); w.y = cvt_pk_bf16(v0[2], v0[3]); w.z = cvt_pk_bf16(v1[0], v1[1]); w.w = cvt_pk_bf16(v1[2], v1[3]);
                    *(u32x4*)(rowp + bj * HALF) = w; } }
    }
};
struct OneUnit {
    int idx, nM, nN;
    __device__ __forceinline__ bool next(int i, Unit& u) const { if (i > 0 || idx < 0 || idx >= nM * nN) return false; u.pm = idx % nM; u.pn = idx / nM; return true; }
    __device__ __forceinline__ void a_ready(const Unit&) const {}
    __device__ __forceinline__ void done(const Unit&) const {}
};

template <class Epi, class Sched, bool ALIGN_EPI = false, bool SP2 = false>
__device__ __forceinline__ void gemm_phase(PG8_LAS unsigned char* lds, const Gemm g, const Sched& S, const Epi& E) {
    const int tid = threadIdx.x, wid = __builtin_amdgcn_readfirstlane(tid >> 6), lane = tid & 63, wr = wid >> 2, wc = wid & 3, fr = lane & 15, fq = lane >> 4;
    const int K = g.K, nt = K / BK;
    unsigned voffA[2], voffB[2];
#pragma unroll
    for (int i = 0; i < 2; ++i) { int R, C; stage_rc(tid * 16 + i * 8192, R, C); const int Rb = Epi::PERM ? ((R & ~31) + perm32(R & 31)) : R;
        voffA[i] = (unsigned)(R * K + C) * 2u; voffB[i] = (unsigned)(Rb * K + C) * 2u; }
    const size_t kstep = (size_t)(BK * 2);
    const size_t hstep = (size_t)HALF * K * 2;
    const size_t tstep = 2 * hstep;
    const unsigned ldsw = (unsigned)wid * 1024u;
    const int aoff = lds_byte(wr * 64 + fr, fq * 8), boff = lds_byte(wc * 32 + fr, fq * 8);
#define PG8_SA(b, h) (((b) * 2 + (h)) * HTB)
#define PG8_SB(b, h) ((4 + (b) * 2 + (h)) * HTB)
#define PG8_STAGE(bufoff, gbase, voff) do { _Pragma("unroll") for (int _i = 0; _i < 2; ++_i) \
        __builtin_amdgcn_global_load_lds((const unsigned*)((const char*)(gbase) + (voff)[_i]), (PG8_LAS unsigned*)(lds + (bufoff) + ldsw + _i * 8192), 16, 0, 0); } while (0)
#define PG8_LDA(dst, b, h) do { _Pragma("unroll") for (int m = 0; m < 4; ++m) _Pragma("unroll") for (int k = 0; k < 2; ++k) dst[m][k] = *(const PG8_LAS bf16x8*)(lds + PG8_SA(b, h) + aoff + m * 2048 + k * 1024); } while (0)
#define PG8_LDB(dst, b, h) do { _Pragma("unroll") for (int n = 0; n < 2; ++n) _Pragma("unroll") for (int k = 0; k < 2; ++k) dst[n][k] = *(const PG8_LAS bf16x8*)(lds + PG8_SB(b, h) + boff + n * 2048 + k * 1024); } while (0)
#define PG8_MMA(ai, bj, At, Bt) do { __builtin_amdgcn_s_setprio(1); _Pragma("unroll") for (int m = 0; m < 4; ++m) _Pragma("unroll") for (int n = 0; n < 2; ++n) _Pragma("unroll") for (int k = 0; k < 2; ++k) \
        acc[ai][bj][m][n] = __builtin_amdgcn_mfma_f32_16x16x32_bf16(Bt[n][k], At[m][k], acc[ai][bj][m][n], 0, 0, 0); __builtin_amdgcn_s_setprio(0); } while (0)
#define PG8_WAIT_V(n) asm volatile("s_waitcnt vmcnt(" #n ")" ::: "memory")
#define PG8_WAIT_L(n) asm volatile("s_waitcnt lgkmcnt(" #n ")" ::: "memory")
#define PG8_BAR __builtin_amdgcn_s_barrier()
#define PG8_SCHED __builtin_amdgcn_sched_barrier(0)
    Unit cur, nxt; int ui = 0;
    if (!S.next(0, cur)) return;
    f32x4 acc[2][2][4][2];
#pragma unroll
    for (int a = 0; a < 2; ++a)
#pragma unroll
        for (int b = 0; b < 2; ++b)
#pragma unroll
            for (int m = 0; m < 4; ++m)
#pragma unroll
                for (int n = 0; n < 2; ++n) acc[a][b][m][n] = (f32x4){0.f, 0.f, 0.f, 0.f};
    bf16x8 At[4][2], B0[2][2], B1[2][2];
    const char* cA = (const char*)g.A + (size_t)cur.pm * tstep; const char* cB = (const char*)g.Bt + (size_t)cur.pn * tstep;
    S.a_ready(cur);
    if constexpr (SP2) {
        PG8_STAGE(PG8_SB(0, 0), cB, voffB); PG8_STAGE(PG8_SB(0, 1), cB + hstep, voffB); PG8_STAGE(PG8_SA(0, 0), cA, voffA); PG8_STAGE(PG8_SA(0, 1), cA + hstep, voffA);
        if (wr == 1) PG8_BAR;
        PG8_WAIT_V(2); PG8_BAR;
        PG8_STAGE(PG8_SB(1, 0), cB + kstep, voffB); PG8_STAGE(PG8_SA(1, 0), cA + kstep, voffA); PG8_STAGE(PG8_SB(1, 1), cB + hstep + kstep, voffB);
        PG8_WAIT_V(6); PG8_BAR;
    } else {
        PG8_STAGE(PG8_SB(0, 0), cB, voffB); PG8_STAGE(PG8_SA(0, 0), cA, voffA); PG8_STAGE(PG8_SB(0, 1), cB + hstep, voffB); PG8_STAGE(PG8_SA(0, 1), cA + hstep, voffA);
        if (wr == 1) PG8_BAR;
        PG8_WAIT_V(4); PG8_BAR;
        PG8_STAGE(PG8_SB(1, 0), cB + kstep, voffB); PG8_STAGE(PG8_SA(1, 0), cA + kstep, voffA); PG8_STAGE(PG8_SB(1, 1), cB + hstep + kstep, voffB);
        PG8_WAIT_V(6); PG8_BAR;
    }
    for (;;) {
        const bool has_next = S.next(ui + 1, nxt);
        const char* nA = has_next ? (const char*)g.A + (size_t)nxt.pm * tstep : cA; const char* nB = has_next ? (const char*)g.Bt + (size_t)nxt.pn * tstep : cB;
        for (int t = 0; t < nt; t += 2) {
            const bool last = (t == nt - 2);
            const char* a1 = cA + (size_t)(t + 1) * kstep;
            const char* a2 = last ? nA : cA + (size_t)(t + 2) * kstep; const char* b2 = last ? nB : cB + (size_t)(t + 2) * kstep;
            const char* a3 = a2 + kstep; const char* b3 = b2 + kstep;
            if (last && has_next) S.a_ready(nxt);
            if constexpr (SP2) {
            PG8_LDB(B0, 0, 0); PG8_LDB(B1, 0, 1); PG8_SCHED; PG8_LDA(At, 0, 0); PG8_STAGE(PG8_SA(1, 1), a1 + hstep, voffA);
            PG8_WAIT_V(8); PG8_WAIT_L(0); PG8_BAR; PG8_MMA(0, 0, At, B0); PG8_MMA(0, 1, At, B1); PG8_BAR; PG8_SCHED;
            PG8_LDA(At, 0, 1); PG8_STAGE(PG8_SB(0, 0), b2, voffB); PG8_STAGE(PG8_SB(0, 1), b2 + hstep, voffB); PG8_STAGE(PG8_SA(0, 0), a2, voffA);
            PG8_WAIT_V(8); PG8_WAIT_L(0); PG8_BAR; PG8_MMA(1, 0, At, B0); PG8_MMA(1, 1, At, B1); PG8_BAR; PG8_SCHED;
            PG8_LDB(B0, 1, 0); PG8_LDB(B1, 1, 1); PG8_SCHED; PG8_LDA(At, 1, 0); PG8_STAGE(PG8_SA(0, 1), a2 + hstep, voffA);
            PG8_WAIT_V(8); PG8_WAIT_L(0); PG8_BAR; PG8_MMA(0, 0, At, B0); PG8_MMA(0, 1, At, B1); PG8_BAR; PG8_SCHED;
            PG8_LDA(At, 1, 1); PG8_STAGE(PG8_SB(1, 0), b3, voffB); PG8_STAGE(PG8_SB(1, 1), b3 + hstep, voffB); PG8_STAGE(PG8_SA(1, 0), a3, voffA);
            PG8_WAIT_V(8); PG8_WAIT_L(0); PG8_BAR; PG8_MMA(1, 0, At, B0); PG8_MMA(1, 1, At, B1); PG8_BAR; PG8_SCHED;
            } else {
            PG8_LDB(B0, 0, 0); PG8_SCHED; PG8_LDA(At, 0, 0); PG8_STAGE(PG8_SA(1, 1), a1 + hstep, voffA);
            PG8_WAIT_L(8); PG8_BAR; PG8_WAIT_L(0); PG8_MMA(0, 0, At, B0); PG8_BAR; PG8_SCHED;
            PG8_LDB(B1, 0, 1); PG8_STAGE(PG8_SB(0, 0), b2, voffB);
            PG8_BAR; PG8_WAIT_L(0); PG8_MMA(0, 1, At, B1); PG8_BAR;
            PG8_LDA(At, 0, 1); PG8_STAGE(PG8_SA(0, 0), a2, voffA);
            PG8_BAR; PG8_WAIT_L(0); PG8_MMA(1, 0, At, B0); PG8_BAR; PG8_SCHED;
            PG8_STAGE(PG8_SB(0, 1), b2 + hstep, voffB);
            PG8_WAIT_V(6); PG8_BAR; PG8_MMA(1, 1, At, B1); PG8_BAR;
            PG8_LDB(B0, 1, 0); PG8_SCHED; PG8_LDA(At, 1, 0); PG8_STAGE(PG8_SA(0, 1), a2 + hstep, voffA);
            PG8_WAIT_L(8); PG8_BAR; PG8_WAIT_L(0); PG8_MMA(0, 0, At, B0); PG8_BAR; PG8_SCHED;
            PG8_LDB(B1, 1, 1); PG8_STAGE(PG8_SB(1, 0), b3, voffB);
            PG8_BAR; PG8_WAIT_L(0); PG8_MMA(0, 1, At, B1); PG8_BAR;
            PG8_LDA(At, 1, 1); PG8_STAGE(PG8_SA(1, 0), a3, voffA);
            PG8_BAR; PG8_WAIT_L(0); PG8_MMA(1, 0, At, B0); PG8_BAR; PG8_SCHED;
            PG8_STAGE(PG8_SB(1, 1), b3 + hstep, voffB);
            PG8_WAIT_V(6); PG8_BAR; PG8_MMA(1, 1, At, B1); PG8_BAR;
            }
        }
        if constexpr (ALIGN_EPI) { if (wr == 0) PG8_BAR; }
        if constexpr (!Epi::AFTER_DRAIN) { E(acc, cur, wr, wc, fr, fq); S.done(cur); }
        if (!has_next) break;
#pragma unroll
        for (int a = 0; a < 2; ++a)
#pragma unroll
            for (int b = 0; b < 2; ++b)
#pragma unroll
                for (int m = 0; m < 4; ++m)
#pragma unroll
                    for (int n = 0; n < 2; ++n) acc[a][b][m][n] = (f32x4){0.f, 0.f, 0.f, 0.f};
        cur = nxt; cA = nA; cB = nB; ++ui;
        if constexpr (ALIGN_EPI) { if (wr == 1) PG8_BAR; }
    }
    PG8_WAIT_V(0);
    if constexpr (!ALIGN_EPI) { if (wr == 0) PG8_BAR; }
    PG8_BAR;
    if constexpr (Epi::AFTER_DRAIN) { E.fused(acc, cur, wr, wc, fr, fq, lds, wid, lane); S.done(cur); }
#undef PG8_SA
#undef PG8_SB
#undef PG8_STAGE
#undef PG8_LDA
#undef PG8_LDB
#undef PG8_MMA
#undef PG8_WAIT_V
#undef PG8_WAIT_L
#undef PG8_BAR
#undef PG8_SCHED
}
}

#ifndef PG8_SP2
#define PG8_SP2 true
#endif
#ifndef PG8_ALIGN
#define PG8_ALIGN true
#endif
constexpr int NWAVES = 8;
constexpr int NBATCH = 2, SEQ = 8192, DM = 1024, M = NBATCH * SEQ;
constexpr int INW = 2560, ZW = 2048;
constexpr int LRUW = 512, ATTW = 512, NCHUNK = SEQ / 64;
constexpr int NEXP = 16384, PEER_H = 8, NSEL = 128;
constexpr float EPS = 1e-6f;
constexpr float LOG2E = 1.4426950408889634f;

constexpr size_t MiB = 1u << 20;
constexpr size_t WS_CTL = 0, CTL_ZERO_BYTES = 1 * MiB;
constexpr size_t WS_WIN = 1 * MiB, WS_WOUT = 6 * MiB, WS_WQ = 8 * MiB, WS_WKV = 10 * MiB, WS_WO = 14 * MiB, WS_WQRY = 16 * MiB;
constexpr size_t WS_SUBK = 20 * MiB, WS_GATEW = 20 * MiB + 512 * 1024, WS_MEMN = 21 * MiB, WS_KM = 22 * MiB, WS_VMT = 23 * MiB, WS_AGG = 24 * MiB, WS_SSQ1 = 25 * MiB, WS_SSQ2 = 26 * MiB, WS_SU = 27 * MiB;
constexpr size_t WS_EU = 28 * MiB, WS_EV = 60 * MiB, WS_XN = 92 * MiB, WS_Z = 124 * MiB, WS_VT = 188 * MiB, WS_Y = 204 * MiB, WS_END = 236 * MiB;
constexpr size_t WS_QC = WS_Z, WS_OC = WS_Z + 32 * MiB, WS_QP = WS_Z, WS_IDX = WS_VT, WS_G = WS_VT + 8 * MiB;
constexpr int CW_BAR = 4096;

constexpr int RING_BYTES = 155648;
constexpr int LDSCTL_OFF = RING_BYTES, MISC_OFF = LDSCTL_OFF + 320;
constexpr int LDS_BYTES = 163840;

#define GAS __attribute__((address_space(1)))
#define LAS __attribute__((address_space(3)))
typedef unsigned short bf16;
typedef unsigned v4u __attribute__((ext_vector_type(4)));
typedef unsigned v2u __attribute__((ext_vector_type(2)));
typedef float f32x4 __attribute__((ext_vector_type(4)));
typedef float f32x2 __attribute__((ext_vector_type(2)));
typedef float f32x16 __attribute__((ext_vector_type(16)));
typedef short bf16x8 __attribute__((ext_vector_type(8)));
typedef __bf16 bf16x2_t __attribute__((ext_vector_type(2)));
typedef GAS unsigned gu32;
typedef _Float16 v32h __attribute__((ext_vector_type(32)));
typedef unsigned v6u __attribute__((ext_vector_type(6)));
typedef _Float16 f16x2_t __attribute__((ext_vector_type(2)));
constexpr int EV_ROW = 768;
#define RLX_AGENT __ATOMIC_RELAXED, __HIP_MEMORY_SCOPE_AGENT
#define LDS_WAIT() asm volatile("s_waitcnt lgkmcnt(0)" ::: "memory")
#define VM_WAIT() asm volatile("s_waitcnt vmcnt(0)" ::: "memory")
#define MFMA32(a, b, c) __builtin_amdgcn_mfma_f32_32x32x16_bf16((a), (b), (c), 0, 0, 0)
#define DI __device__ __forceinline__

DI unsigned pk2(float lo, float hi) { f32x2 v = {lo, hi}; bf16x2_t b = __builtin_convertvector(v, bf16x2_t); return __builtin_bit_cast(unsigned, b); }
DI bf16 f2bf(float x) { return (bf16)(pk2(x, 0.f) & 0xffffu); }
DI float bf2f(bf16 x) { return __uint_as_float((unsigned)x << 16); }
DI float bflo(unsigned p) { return __uint_as_float(p << 16); }
DI float bfhi(unsigned p) { return __uint_as_float(p & 0xffff0000u); }
DI int crow(int reg, int hh) { return (reg & 3) + 8 * (reg >> 2) + 4 * hh; }
DI float swap32_partner(float x, int hh) { auto rr = __builtin_amdgcn_permlane32_swap(__float_as_uint(x), __float_as_uint(x), false, false); return __uint_as_float(hh ? rr[0] : rr[1]); }
DI float dpp_xor1(float x) { return __int_as_float(__builtin_amdgcn_update_dpp(0, __float_as_int(x), 0xB1, 0xf, 0xf, true)); }
DI float dpp_xor2(float x) { return __int_as_float(__builtin_amdgcn_update_dpp(0, __float_as_int(x), 0x4E, 0xf, 0xf, true)); }
DI float dpp_hmir(float x) { return __int_as_float(__builtin_amdgcn_update_dpp(0, __float_as_int(x), 0x141, 0xf, 0xf, true)); }
DI float dpp_mir(float x)  { return __int_as_float(__builtin_amdgcn_update_dpp(0, __float_as_int(x), 0x140, 0xf, 0xf, true)); }
DI float sum16(float x) { x += dpp_xor1(x); x += dpp_xor2(x); x += dpp_hmir(x); x += dpp_mir(x); return x; }
DI float sum32(float x) { x = sum16(x); auto rr = __builtin_amdgcn_permlane16_swap(__float_as_uint(x), __float_as_uint(x), false, false); return __uint_as_float(rr[0]) + __uint_as_float(rr[1]); }
DI float max16(float x) { x = fmaxf(x, dpp_xor1(x)); x = fmaxf(x, dpp_xor2(x)); x = fmaxf(x, dpp_hmir(x)); x = fmaxf(x, dpp_mir(x)); return x; }
DI float max64(float x) { x = max16(x); { auto rr = __builtin_amdgcn_permlane16_swap(__float_as_uint(x), __float_as_uint(x), false, false); x = fmaxf(__uint_as_float(rr[0]), __uint_as_float(rr[1])); }
    { auto rr = __builtin_amdgcn_permlane32_swap(__float_as_uint(x), __float_as_uint(x), false, false); x = fmaxf(__uint_as_float(rr[0]), __uint_as_float(rr[1])); } return x; }
DI unsigned pack_i8x4(float a, float b, float c, float d) { const int ia = (int)__builtin_rintf(a), ib = (int)__builtin_rintf(b), ic = (int)__builtin_rintf(c), id = (int)__builtin_rintf(d);
    return (unsigned)(ia & 255) | ((unsigned)(ib & 255) << 8) | ((unsigned)(ic & 255) << 16) | ((unsigned)id << 24); }
DI float max32(float x) { x = max16(x); auto rr = __builtin_amdgcn_permlane16_swap(__float_as_uint(x), __float_as_uint(x), false, false); return fmaxf(__uint_as_float(rr[0]), __uint_as_float(rr[1])); }
DI float sum64(float x) { x = sum32(x); auto rr = __builtin_amdgcn_permlane32_swap(__float_as_uint(x), __float_as_uint(x), false, false); return __uint_as_float(rr[0]) + __uint_as_float(rr[1]); }
DI float rcp_(float x) { return __builtin_amdgcn_rcpf(x); }
DI float rsq_(float x) { return __builtin_amdgcn_rsqf(x); }
DI float exp2_(float x) { return __builtin_amdgcn_exp2f(x); }
DI float gelu_tanh(float x) { const float u = x * (1.5957691216057308f + 0.07135481627159768f * x * x); return x * rcp_(1.0f + exp2_(-LOG2E * u)); }
DI float sigmoidf_(float x) { return rcp_(1.0f + exp2_(-LOG2E * x)); }
#define XB_TMO      128
#define XB_XCNT(j)  (256  + 64 * (j))
#define XB_XSUB(j)  (1280 + 64 * (j))
#define XB_XGEN(j)  (2304 + 64 * (j))
#define XB_TOP      3328
#define XB_TOPGEN   3392
#define XCD_BAR_WORDS 3456
#define XB_SPIN_CAP (1u << 18)

__device__ __forceinline__ unsigned xb_ld(unsigned* p)              { return __hip_atomic_load(p, __ATOMIC_RELAXED, __HIP_MEMORY_SCOPE_AGENT); }
__device__ __forceinline__ unsigned xb_add(unsigned* p, unsigned v) { return __hip_atomic_fetch_add(p, v, __ATOMIC_RELAXED, __HIP_MEMORY_SCOPE_AGENT); }
__device__ __forceinline__ unsigned xb_xcc_id() { return (unsigned)__builtin_amdgcn_s_getreg((3 << 11) | 20) & 0xFu; }
#define XB_SPIN(cond, bar) do { unsigned _sp = 0; while (cond) { __builtin_amdgcn_s_sleep(1); \
    if ((++_sp & 255u) == 0u) { if (xb_ld(&(bar)[XB_TMO])) break; if (_sp > XB_SPIN_CAP) { atomicAdd(&(bar)[XB_TMO], 1u); break; } } } } while (0)

struct XcdBarrier {
    unsigned* bar; unsigned x;
    volatile LAS unsigned* st;
};

__device__ __forceinline__ XcdBarrier xcd_barrier_post(unsigned* bar, volatile LAS unsigned* st) {
    XcdBarrier b; b.bar = bar; b.x = xb_xcc_id(); b.st = st;
    if (threadIdx.x == 0) (void)xb_add(&bar[XB_XCNT(b.x)], 1u);
    return b;
}
__device__ __forceinline__ void xcd_barrier_complete(unsigned* bar, unsigned x, unsigned& nloc, unsigned& nx) {
    const unsigned G = gridDim.x * gridDim.y * gridDim.z;
    unsigned sum, cnt, mine, sp = 0u;
    for (;;) {
        sum = 0u; cnt = 0u; mine = 0u;
#pragma unroll
        for (unsigned j = 0; j < 16; ++j) { const unsigned c = xb_ld(&bar[XB_XCNT(j)]); sum += c; cnt += (c > 0u) ? 1u : 0u; mine = (j == x) ? c : mine; }
        if (sum == G) break;
        __builtin_amdgcn_s_sleep(1);
        if ((++sp & 255u) == 0u) { if (xb_ld(&bar[XB_TMO])) break; if (sp > XB_SPIN_CAP) { atomicAdd(&bar[XB_TMO], 1u); break; } }
    }
    nloc = mine > 0u ? mine : 1u; nx = cnt > 0u ? cnt : 1u;
}

__device__ __forceinline__ void xcd_barrier(const XcdBarrier& b) {
    asm volatile("s_waitcnt vmcnt(0)" ::: "memory");
    __syncthreads();
    if (threadIdx.x == 0) {
        unsigned* bar = b.bar;
        __builtin_amdgcn_s_waitcnt(0);
        unsigned nloc = b.st[0], nx = b.st[1];
        if (nloc == 0u) { xcd_barrier_complete(bar, b.x, nloc, nx); b.st[0] = nloc; b.st[1] = nx; }
        const unsigned old = xb_add(&bar[XB_XSUB(b.x)], 1u);
        const unsigned gen = old / nloc;
        if (old + 1u == (gen + 1u) * nloc) {
            __builtin_amdgcn_fence(__ATOMIC_RELEASE, "agent");
            asm volatile("s_waitcnt vmcnt(0)" ::: "memory");
            const unsigned og = xb_add(&bar[XB_TOP], 1u);
            const unsigned tg = og / nx;
            if (og + 1u == (tg + 1u) * nx) xb_add(&bar[XB_TOPGEN], 1u);
            else XB_SPIN(xb_ld(&bar[XB_TOPGEN]) == tg, bar);
            __builtin_amdgcn_fence(__ATOMIC_ACQUIRE, "agent");
            xb_add(&bar[XB_XGEN(b.x)], 1u);
            asm volatile("s_waitcnt vmcnt(0)" ::: "memory");
        } else {
            XB_SPIN(xb_ld(&bar[XB_XGEN(b.x)]) == gen, bar);
            __builtin_amdgcn_fence(__ATOMIC_ACQUIRE, "agent");
            asm volatile("s_waitcnt vmcnt(0)" ::: "memory");
        }
    }
    __syncthreads();
}
struct Args { const float* in[26]; float* out; unsigned char* ws; int ph_lo, ph_hi, li, pad; };
struct Frame {
    LAS unsigned char* lds;
    volatile LAS unsigned* MISC;
    gu32* ctl;
    int tid, lane, wave, vcu, G;
    const Args* A; float* out; unsigned char* ws;
    DI const float* in(int k) const { return A->in[k]; }
    template <class T> DI T* wsp(size_t off) const { return (T*)(ws + off); }
};

DI void p0_transpose_item(const float* W, int K, int N, bf16* WT, LAS float* scr, int item, int lane, const float* g0, const float* g1, int gsplit) {
    const int nblk = N / 32, kb = item / nblk, nb = item % nblk, k0 = 64 * kb, n0 = 32 * nb;
    float wv[32], gv[32];
#pragma unroll
    for (int i = 0; i < 32; ++i) { const int k = k0 + 2 * i + (lane >> 5); wv[i] = W[(size_t)k * N + n0 + (lane & 31)]; gv[i] = g0 ? ((k < gsplit) ? g0[k] : g1[k - gsplit]) : 1.f; }
#pragma unroll
    for (int i = 0; i < 32; ++i) scr[(2 * i + (lane >> 5)) * 33 + (lane & 31)] = wv[i] * gv[i];
    LDS_WAIT(); asm volatile("" ::: "memory");
    const int c = lane & 7;
#pragma unroll
    for (int j = 0; j < 4; ++j) { const int n = (lane >> 3) + 8 * j; const LAS float* s = scr + (8 * c) * 33 + n;
        v4u o; o.x = pk2(s[0 * 33], s[1 * 33]); o.y = pk2(s[2 * 33], s[3 * 33]); o.z = pk2(s[4 * 33], s[5 * 33]); o.w = pk2(s[6 * 33], s[7 * 33]);
        *(GAS v4u*)(WT + (size_t)(n0 + n) * K + k0 + 8 * c) = o; }
    LDS_WAIT(); asm volatile("" ::: "memory");
}
template <bool NORM> DI void row_to_bf16(const float* xrow, bf16* orow, const float* gain, int lane) {
    const GAS f32x4* xr = (const GAS f32x4*)xrow + lane;
    f32x4 v[4]; float s = 0.f;
#pragma unroll
    for (int j = 0; j < 4; ++j) { v[j] = xr[64 * j]; s += (v[j].x * v[j].x + v[j].y * v[j].y) + (v[j].z * v[j].z + v[j].w * v[j].w); }
    float rstd = 1.f;
    if (NORM) rstd = 1.0f / sqrtf(sum64(s) * (1.f / 1024.f) + EPS);
    GAS v2u* o8 = (GAS v2u*)orow + lane;
#pragma unroll
    for (int j = 0; j < 4; ++j) { f32x4 w = v[j] * rstd; if (gain) w = w * ((const GAS f32x4*)gain)[64 * j + lane];
        v2u o; o.x = pk2(w.x, w.y); o.y = pk2(w.z, w.w); o8[64 * j] = o; }
}
constexpr float U_SCALE = 128.f, V_SCALE = 16.f;
template <bool NORM, int NB> DI void rows_to_bf16(const float* xrow, bf16* orow, size_t row_stride, const float* gain, int lane) {
    f32x4 v[NB][4];
#pragma unroll
    for (int b = 0; b < NB; ++b)
#pragma unroll
        for (int j = 0; j < 4; ++j) v[b][j] = ((const GAS f32x4*)(xrow + b * row_stride))[64 * j + lane];
#pragma unroll
    for (int b = 0; b < NB; ++b) { float s = 0.f;
#pragma unroll
        for (int j = 0; j < 4; ++j) s += (v[b][j].x * v[b][j].x + v[b][j].y * v[b][j].y) + (v[b][j].z * v[b][j].z + v[b][j].w * v[b][j].w);
        float rstd = 1.f; if (NORM) rstd = rsq_(sum64(s) * (1.f / 1024.f) + EPS);
        GAS v2u* o8 = (GAS v2u*)(orow + b * row_stride) + lane;
#pragma unroll
        for (int j = 0; j < 4; ++j) { f32x4 w = v[b][j] * rstd; if (gain) w = w * ((const GAS f32x4*)gain)[64 * j + lane];
            v2u o; o.x = pk2(w.x, w.y); o.y = pk2(w.z, w.w); o8[64 * j] = o; } }
}
DI void row_to_fp8(const float* src, unsigned char* dst, const float* gain, float scale, int lane) {
#pragma unroll
    for (int j = 0; j < 4; ++j) { f32x4 v = ((const GAS f32x4*)src)[64 * j + lane] * scale; if (gain) v = v * ((const GAS f32x4*)gain)[64 * j + lane];
        unsigned w = 0u; w = __builtin_amdgcn_cvt_pk_fp8_f32(v.x, v.y, w, false); w = __builtin_amdgcn_cvt_pk_fp8_f32(v.z, v.w, w, true);
        ((GAS unsigned*)dst)[64 * j + lane] = w; }
}
DI void row_to_i8(const float* src, unsigned char* dst, const float* gain, float* scale_out, int lane) {
    f32x4 v[4]; float mx = 0.f;
#pragma unroll
    for (int j = 0; j < 4; ++j) { v[j] = ((const GAS f32x4*)src)[64 * j + lane] * ((const GAS f32x4*)gain)[64 * j + lane];
        mx = fmaxf(fmaxf(mx, fmaxf(fabsf(v[j].x), fabsf(v[j].y))), fmaxf(fabsf(v[j].z), fabsf(v[j].w))); }
    mx = fmaxf(max64(mx), 1e-30f);
    const float inv = 127.0f / mx;
#pragma unroll
    for (int j = 0; j < 4; ++j) ((GAS unsigned*)dst)[64 * j + lane] = pack_i8x4(v[j].x * inv, v[j].y * inv, v[j].z * inv, v[j].w * inv);
    if (lane == 0) *scale_out = mx * (1.0f / 127.0f);
}
DI void convert_experts(Frame& F, int wv, int nwv) {
    const int lane = F.lane;
    const int l5 = lane & 31, hh = lane >> 5;
    for (int m = wv * 2; m < NEXP; m += nwv * 2) {
        f32x4 u[2][4], v[8];
#pragma unroll
        for (int b = 0; b < 2; ++b)
#pragma unroll
            for (int j = 0; j < 4; ++j) u[b][j] = ((const GAS f32x4*)(F.in(23) + (size_t)(m + b) * DM))[64 * j + lane];
#pragma unroll
        for (int j = 0; j < 8; ++j) v[j] = ((const GAS f32x4*)(F.in(24) + (size_t)(m + hh) * DM))[32 * j + l5];
#pragma unroll
        for (int b = 0; b < 2; ++b) {
            float mx = 0.f;
#pragma unroll
            for (int j = 0; j < 4; ++j) { u[b][j] = u[b][j] * ((const GAS f32x4*)F.in(20))[64 * j + lane];
                mx = fmaxf(fmaxf(mx, fmaxf(fabsf(u[b][j].x), fabsf(u[b][j].y))), fmaxf(fabsf(u[b][j].z), fabsf(u[b][j].w))); }
            mx = fmaxf(max64(mx), 1e-30f);
            const float inv = 127.0f / mx;
#pragma unroll
            for (int j = 0; j < 4; ++j) ((GAS unsigned*)(F.wsp<unsigned char>(WS_EU) + (size_t)(m + b) * DM))[64 * j + lane] = pack_i8x4(u[b][j].x * inv, u[b][j].y * inv, u[b][j].z * inv, u[b][j].w * inv);
            if (lane == 0) F.wsp<float>(WS_SU)[m + b] = mx * (1.0f / 127.0f);
        }
        {
            float mx = 0.f;
#pragma unroll
            for (int j = 0; j < 8; ++j) mx = fmaxf(fmaxf(mx, fmaxf(fabsf(v[j].x), fabsf(v[j].y))), fmaxf(fabsf(v[j].z), fabsf(v[j].w)));
            mx = fmaxf(max32(mx), 1e-30f);
            const float inv = 7.5f / mx;
            v32h h;
#pragma unroll
            for (int j = 0; j < 8; ++j) { h[4 * j] = (_Float16)(v[j].x * inv); h[4 * j + 1] = (_Float16)(v[j].y * inv); h[4 * j + 2] = (_Float16)(v[j].z * inv); h[4 * j + 3] = (_Float16)(v[j].w * inv); }
            const v6u pk = __builtin_amdgcn_cvt_scalef32_pk32_fp6_f16(h, 1.0f);
            unsigned char* rowp = F.wsp<unsigned char>(WS_EV) + (size_t)(m + hh) * EV_ROW;
            *(GAS v4u*)(rowp + 16 * l5) = (v4u){pk[0], pk[1], pk[2], pk[3]}; *(GAS v2u*)(rowp + 512 + 8 * l5) = (v2u){pk[4], pk[5]};
            if (l5 == 0) F.wsp<float>(WS_SU)[NEXP + m + hh] = mx * (1.0f / 7.5f);
        }
    }
}
DI void p0_prologue(Frame& F, int parts = 7) {
    LAS float* scr = (LAS float*)(F.lds + F.wave * 16384);
    const int gw = F.vcu * NWAVES + F.wave, NGW = F.G * NWAVES, lane = F.lane;
    constexpr int I_IN = 16 * (INW / 32), I_D = 16 * (DM / 32), I_2D = 16 * (2 * DM / 32);
    constexpr int NITEMS = I_IN + 3 * I_D + 2 * I_2D;
    for (int it = gw; it < ((parts & 1) ? NITEMS : 0); it += NGW) {
        int r = it;
        if (r < I_IN) { p0_transpose_item(F.in(3), DM, INW, F.wsp<bf16>(WS_WIN), scr, r, lane, F.in(2), F.in(2), DM); continue; } r -= I_IN;
        if (r < I_D) { p0_transpose_item(F.in(14), DM, DM, F.wsp<bf16>(WS_WOUT), scr, r, lane, F.in(12), F.in(13), LRUW); continue; } r -= I_D;
        if (r < I_D) { p0_transpose_item(F.in(17), DM, DM, F.wsp<bf16>(WS_WQ), scr, r, lane, F.in(15), F.in(15), DM); continue; } r -= I_D;
        if (r < I_2D) { p0_transpose_item(F.in(18), DM, 2 * DM, F.wsp<bf16>(WS_WKV), scr, r, lane, nullptr, nullptr, 0); continue; } r -= I_2D;
        if (r < I_D) { p0_transpose_item(F.in(19), DM, DM, F.wsp<bf16>(WS_WO), scr, r, lane, nullptr, nullptr, 0); continue; } r -= I_D;
        p0_transpose_item(F.in(21), DM, 2 * DM, F.wsp<bf16>(WS_WQRY), scr, r, lane, F.in(20), F.in(20), DM);
    }
    for (int m = gw * 4; m < ((parts & 2) ? M : 0); m += NGW * 4) rows_to_bf16<true, 4>(F.in(0) + (size_t)m * DM, F.wsp<bf16>(WS_XN) + (size_t)m * DM, DM, nullptr, lane);
    for (int m = gw; m < NBATCH * 256; m += NGW) row_to_bf16<true>(F.in(1) + (size_t)m * DM, F.wsp<bf16>(WS_MEMN) + (size_t)m * DM, F.in(16), lane);
    { const int gt = gw * 64 + lane, NT = NGW * 64;
      for (int i = gt; i < 8 * 2 * 128 * 128 / 4; i += NT) { const f32x4 v = ((const GAS f32x4*)F.in(22))[i]; v2u o; o.x = pk2(v.x, v.y); o.y = pk2(v.z, v.w); ((GAS v2u*)F.wsp<bf16>(WS_SUBK))[i] = o; }
      for (int o = gt; o < 2 * 8 * 64 * 64; o += NT) { const int i = o & 63, j = (o >> 6) & 63, h = (o >> 12) & 7, g = o >> 15;
          const float* W = g ? F.in(8) : F.in(6); F.wsp<bf16>(WS_GATEW)[o] = f2bf(W[(h * 64 + i) * 64 + j]); } }
}
struct LruState { float ba[2], bx[2], sp[2], S[2], Ap[2]; };
template <bool PASS2>
DI void lru_prep(const Frame& F, int b, int chunk, int h, int lane, LAS unsigned char* xcs  , LruState& st) {
    const int r = lane & 31, hh = lane >> 5;
    const size_t row0 = (size_t)b * SEQ + (size_t)chunk * 64;
    {
        const int c2 = h * 64 + 2 * r;
        const f32x2 w0 = *(const f32x2*)(F.in(4) + c2), w1 = *(const f32x2*)(F.in(4) + LRUW + c2), w2 = *(const f32x2*)(F.in(4) + 2 * LRUW + c2), w3 = *(const f32x2*)(F.in(4) + 3 * LRUW + c2);
        const f32x2 cb = *(const f32x2*)(F.in(5) + c2);
        const int tl0 = 32 * hh;
        const bf16* zp = F.wsp<bf16>(WS_Z) + (row0 + tl0) * ZW + c2;
        const bool first = (chunk == 0 && hh == 0);
        unsigned p0 = first ? 0u : *(const unsigned*)(zp - 3 * ZW), p1 = first ? 0u : *(const unsigned*)(zp - 2 * ZW), p2 = first ? 0u : *(const unsigned*)(zp - ZW);
#pragma unroll
        for (int t = 0; t < 32; ++t) { const unsigned p3 = *(const unsigned*)(zp + (size_t)t * ZW);
            const float lo = cb.x + bflo(p0) * w0.x + bflo(p1) * w1.x + bflo(p2) * w2.x + bflo(p3) * w3.x;
            const float hi = cb.y + bfhi(p0) * w0.y + bfhi(p1) * w1.y + bfhi(p2) * w2.y + bfhi(p3) * w3.y;
            *(LAS unsigned*)(xcs + (tl0 + t) * 144 + 4 * r) = pk2(lo, hi);
            p0 = p1; p1 = p2; p2 = p3; }
        LDS_WAIT();
    }
#pragma unroll
    for (int nt = 0; nt < 2; ++nt) { const int c = h * 64 + 32 * nt + r; st.ba[nt] = F.in(7)[c]; st.bx[nt] = F.in(9)[c];
        const float nl = -F.in(10)[c]; st.sp[nt] = fmaxf(nl, 0.f) + log1pf(__expf(-fabsf(nl))); st.S[nt] = 0.f; st.Ap[nt] = 1.f; }
    if (PASS2) {
        float s = 0.f; const float* ag = F.wsp<float>(WS_AGG) + ((size_t)b * NCHUNK * LRUW + h * 64 + lane) * 2;
        for (int c0 = 0; c0 < chunk; c0 += 32) {
            f32x2 ab[32];
#pragma unroll
            for (int i = 0; i < 32; ++i) ab[i] = *(const f32x2*)(ag + (size_t)(c0 + i < NCHUNK ? c0 + i : NCHUNK - 1) * LRUW * 2);
#pragma unroll
            for (int i = 0; i < 32; ++i) { const bool on = c0 + i < chunk; s = (on ? ab[i].x : 1.0f) * s + (on ? ab[i].y : 0.0f); }
        }
        st.S[0] = __shfl(s, r); st.S[1] = __shfl(s, 32 + r);
    }
}
template <bool PASS2>
DI void lru_tile(const Frame& F, int b, int chunk, int mt, int h, int lane, LAS unsigned char* xcs, LAS unsigned char* gim  , LruState& st, float (&ssq)[16]) {
    const int r = lane & 31, hh = lane >> 5;
    const size_t row0 = (size_t)b * SEQ + (size_t)chunk * 64;
    const bf16* gw = F.wsp<bf16>(WS_GATEW) + (size_t)h * 4096;
    bf16x8 af[4];
#pragma unroll
    for (int s = 0; s < 4; ++s) af[s] = *(const LAS bf16x8*)(xcs + (32 * mt + r) * 144 + (16 * s + 8 * hh) * 2);
    float ssl[16];
#pragma unroll
    for (int i = 0; i < 16; ++i) ssl[i] = 0.f;
    if (PASS2) {
#pragma unroll
        for (int i = 0; i < 4; ++i) { const int row = (lane >> 3) + 8 * i, c = lane & 7;
            *(LAS v4u*)(gim + row * 144 + c * 16) = *(const v4u*)(F.wsp<bf16>(WS_Z) + (row0 + 32 * mt + row) * ZW + LRUW + h * 64 + 8 * c); }
        LDS_WAIT();
    }
#pragma unroll
    for (int nt = 0; nt < 2; ++nt) {
        asm volatile("" ::: "memory");
        f32x16 aa = {}, ax = {};
#pragma unroll
        for (int s = 0; s < 4; ++s) {
            const bf16x8 wa = *(const bf16x8*)(gw + (size_t)(32 * nt + r) * 64 + 16 * s + 8 * hh);
            const bf16x8 wx = *(const bf16x8*)(gw + 32768 + (size_t)(32 * nt + r) * 64 + 16 * s + 8 * hh);
            aa = MFMA32(af[s], wa, aa); ax = MFMA32(af[s], wx, ax);
        }
#pragma unroll
        for (int i = 0; i < 16; ++i) {
            const float rg = sigmoidf_(aa[i] + st.ba[nt]), ig = sigmoidf_(ax[i] + st.bx[nt]);
            const float la = -8.0f * rg * st.sp[nt];
            const float a = exp2_(LOG2E * la);
            const float mult = __builtin_amdgcn_sqrtf(fmaxf(1.0f - a * a, 0.f));
            const float xc = bf2f(*(const LAS bf16*)(xcs + (32 * mt + crow(i, hh)) * 144 + (32 * nt + r) * 2));
            aa[i] = a; ax[i] = mult * ig * xc;
        }
        float Ao[4], Bo[4], Aq[4], Bq[4], Sin[4];
#pragma unroll
        for (int q = 0; q < 4; ++q) { const float a0 = aa[4 * q], a1 = aa[4 * q + 1], a2 = aa[4 * q + 2], a3 = aa[4 * q + 3];
            Ao[q] = (a0 * a1) * (a2 * a3); Bo[q] = ((ax[4 * q] * a1 + ax[4 * q + 1]) * a2 + ax[4 * q + 2]) * a3 + ax[4 * q + 3];
            Aq[q] = swap32_partner(Ao[q], hh); Bq[q] = swap32_partner(Bo[q], hh); }
        float s_ = st.S[nt];
#pragma unroll
        for (int q = 0; q < 4; ++q) { const float A1 = hh ? Aq[q] : Ao[q], B1 = hh ? Bq[q] : Bo[q], A2 = hh ? Ao[q] : Aq[q], B2 = hh ? Bo[q] : Bq[q];
            const float smid = A1 * s_ + B1; Sin[q] = hh ? smid : s_; s_ = A2 * smid + B2; st.Ap[nt] *= A1 * A2; }
        st.S[nt] = s_;
        if (PASS2) {
#pragma unroll
            for (int q = 0; q < 4; ++q) { float hp = Sin[q];
#pragma unroll
                for (int e = 0; e < 4; ++e) { const int i = 4 * q + e; hp = aa[i] * hp + ax[i];
                    const float gt = bf2f(*(const LAS bf16*)(gim + crow(i, hh) * 144 + (32 * nt + r) * 2));
                    const float y = hp * gelu_tanh(gt); ssl[i] += y * y;
                    *(LAS bf16*)(xcs + (32 * mt + crow(i, hh)) * 144 + (32 * nt + r) * 2) = f2bf(y); } }
        }
    }
    if (PASS2) {
#pragma unroll
        for (int i = 0; i < 16; ++i) ssq[i] = sum32(ssl[i]);
    }
}
constexpr int ATT_KST = 144, ATT_VST = 136, ATT_KBYTES = 64 * ATT_KST, ATT_VBYTES = 64 * ATT_VST;
DI void attn_wave(const Frame& F, int b, int n, int qt, int h, int lane, const LAS float* tab, LAS unsigned char* kl  , f32x16 (&o)[2]) {
    const int r = lane & 31, hh = lane >> 5;
    LAS unsigned char* vl = kl + ATT_KBYTES;
    const size_t row0 = (size_t)b * SEQ + (size_t)n * 64;
    const float SC = 0.125f * LOG2E;
    bf16x8 qf[4];
#pragma unroll
    for (int s = 0; s < 4; ++s) qf[s] = *(const bf16x8*)(F.wsp<bf16>(WS_Z) + (row0 + 32 * qt + r) * ZW + 2 * LRUW + h * 64 + 16 * s + 8 * hh);
    float mrun = -1e30f, lrun = 0.f;
#pragma unroll
    for (int dt = 0; dt < 2; ++dt) o[dt] = f32x16{};
    const float bfar = tab[256];
    const int srow = lane >> 3, sc8 = lane & 7;
    const int kc0 = (n >= 8 ? n - 8 : 0);
    const char* kg = (const char*)(F.wsp<bf16>(WS_Z) + (size_t)b * SEQ * ZW + 2 * LRUW + ATTW + h * 64);
    const char* vg = (const char*)(F.wsp<bf16>(WS_VT) + (size_t)(b * 8 + h) * 64 * SEQ);
    const unsigned kof = (unsigned)(srow * ZW + 8 * sc8) * 2u, vof = (unsigned)(srow * SEQ + 8 * sc8) * 2u;
    v4u kreg[8];
#pragma unroll
    for (int i = 0; i < 8; ++i) kreg[i] = *(const v4u*)(kg + ((size_t)kc0 * 64 + 8 * i) * ZW * 2 + kof);
    for (int kc = kc0; kc <= n; ++kc) {
        const int dd = n - kc;
        v4u vreg[8];
#pragma unroll
        for (int i = 0; i < 8; ++i) { *(LAS v4u*)(kl + (srow + 8 * i) * ATT_KST + sc8 * 16) = kreg[i]; vreg[i] = *(const v4u*)(vg + ((size_t)(8 * i) * SEQ + kc * 64) * 2 + vof); }
        f32x16 sc[2];
#pragma unroll
        for (int kt = 0; kt < 2; ++kt) { sc[kt] = f32x16{};
#pragma unroll
            for (int s = 0; s < 4; ++s) { const bf16x8 kf = *(const LAS bf16x8*)(kl + (32 * kt + r) * ATT_KST + (16 * s + 8 * hh) * 2); sc[kt] = MFMA32(kf, qf[s], sc[kt]); } }
        if (dd >= 3) {
#pragma unroll
            for (int kt = 0; kt < 2; ++kt)
#pragma unroll
                for (int i = 0; i < 16; ++i) sc[kt][i] = sc[kt][i] * SC + bfar;
        } else {
            const int base = 64 * dd + 32 * qt + r + 128;
#pragma unroll
            for (int kt = 0; kt < 2; ++kt)
#pragma unroll
                for (int i = 0; i < 16; ++i) { int idx = base - (32 * kt + crow(i, hh)); idx = idx > 256 ? 256 : idx; sc[kt][i] = sc[kt][i] * SC + tab[idx]; }
        }
        float mx = sc[0][0];
#pragma unroll
        for (int kt = 0; kt < 2; ++kt)
#pragma unroll
            for (int i = 0; i < 16; ++i) mx = fmaxf(mx, sc[kt][i]);
        mx = fmaxf(mx, swap32_partner(mx, hh));
        const float mnew = fmaxf(mrun, mx), alpha = exp2_(mrun - mnew);
        float ls = 0.f;
#pragma unroll
        for (int kt = 0; kt < 2; ++kt)
#pragma unroll
            for (int i = 0; i < 16; ++i) { const float p = exp2_(sc[kt][i] - mnew); sc[kt][i] = p; ls += p; }
        lrun = lrun * alpha + ls; mrun = mnew;
#pragma unroll
        for (int dt = 0; dt < 2; ++dt)
#pragma unroll
            for (int i = 0; i < 16; ++i) o[dt][i] *= alpha;
#pragma unroll
        for (int i = 0; i < 8; ++i) { LAS v2u* vd = (LAS v2u*)(vl + (srow + 8 * i) * ATT_VST + sc8 * 16); vd[0] = (v2u){vreg[i].x, vreg[i].y}; vd[1] = (v2u){vreg[i].z, vreg[i].w}; }
        if (kc < n) {
#pragma unroll
            for (int i = 0; i < 8; ++i) kreg[i] = *(const v4u*)(kg + ((size_t)(kc + 1) * 64 + 8 * i) * ZW * 2 + kof);
        }
#pragma unroll
        for (int kt = 0; kt < 2; ++kt)
#pragma unroll
            for (int s2 = 0; s2 < 2; ++s2) { v4u w; w.x = pk2(sc[kt][8 * s2], sc[kt][8 * s2 + 1]); w.y = pk2(sc[kt][8 * s2 + 2], sc[kt][8 * s2 + 3]); w.z = pk2(sc[kt][8 * s2 + 4], sc[kt][8 * s2 + 5]); w.w = pk2(sc[kt][8 * s2 + 6], sc[kt][8 * s2 + 7]);
                const bf16x8 pf = __builtin_bit_cast(bf16x8, w);
#pragma unroll
                for (int dt = 0; dt < 2; ++dt) { const LAS unsigned char* vp = vl + (32 * dt + r) * ATT_VST + (32 * kt + 16 * s2 + 4 * hh) * 2;
                    const v2u lo = *(const LAS v2u*)vp, hi = *(const LAS v2u*)(vp + 16); v4u vw; vw.x = lo.x; vw.y = lo.y; vw.z = hi.x; vw.w = hi.y;
                    o[dt] = MFMA32(__builtin_bit_cast(bf16x8, vw), pf, o[dt]); } }
    }
    const float lt = lrun + swap32_partner(lrun, hh); const float inv = rcp_(lt);
#pragma unroll
    for (int dt = 0; dt < 2; ++dt)
#pragma unroll
        for (int i = 0; i < 16; ++i) o[dt][i] *= inv;
}

DI void p2_lru_aggregates(Frame& F) {
    const int lane = F.lane, r = lane & 31, hh = lane >> 5, h = F.wave;
    LAS unsigned char* xcs = F.lds + 12288 + h * 17920;
    for (int u = F.vcu; u < NBATCH * NCHUNK; u += F.G) {
        const int b = u / NCHUNK, n = u % NCHUNK;
        LruState st; float ssq[16];
        lru_prep<false>(F, b, n, h, lane, xcs, st);
#pragma unroll 1
        for (int mt = 0; mt < 2; ++mt) lru_tile<false>(F, b, n, mt, h, lane, xcs, xcs + 9216, st, ssq);
        if (hh == 0) {
#pragma unroll
            for (int nt = 0; nt < 2; ++nt) *(f32x2*)(F.wsp<float>(WS_AGG) + (((size_t)b * NCHUNK + n) * LRUW + h * 64 + 32 * nt + r) * 2) = (f32x2){st.Ap[nt], st.S[nt]};
        }
        LDS_WAIT();
    }
}
DI void p3_mixer(Frame& F, int parts = 3) {
    const int lane = F.lane, r = lane & 31, hh = lane >> 5, h = F.wave;
    LAS float* ssx = (LAS float*)(F.lds);
    LAS float* tab = (LAS float*)(F.lds + 2048 + h * 1280);
    LAS unsigned* stg = (LAS unsigned*)(F.lds + 12288 + h * 17920);
    for (int i = lane; i < 257; i += 64) tab[i] = F.in(11)[h * 257 + i] * LOG2E;
    LDS_WAIT();
    for (int u = F.vcu; u < NBATCH * NCHUNK; u += F.G) {
        const int b = u / NCHUNK, n = u % NCHUNK; const size_t row0 = (size_t)b * SEQ + (size_t)n * 64;
#ifndef MIX_PARTS
#define MIX_PARTS 3
#endif
        if (parts & 1) {
            LruState st;
            lru_prep<true>(F, b, n, h, lane, (LAS unsigned char*)stg, st);
#pragma unroll 1
            for (int mt = 0; mt < 2; ++mt) {
                float ssq[16];
                lru_tile<true>(F, b, n, mt, h, lane, (LAS unsigned char*)stg, (LAS unsigned char*)stg + 9216, st, ssq);
                if (r == 0) {
#pragma unroll
                    for (int i = 0; i < 16; ++i) ssx[crow(i, hh) * 8 + h] = ssq[i];
                }
                __syncthreads();
                const LAS unsigned char* yst = (const LAS unsigned char*)stg + 32 * mt * 144;
#pragma unroll
                for (int i = 0; i < 4; ++i) { const int row = (lane >> 3) + 8 * i, c = lane & 7;
                    const f32x4 s0 = *(const LAS f32x4*)(ssx + row * 8), s1 = *(const LAS f32x4*)(ssx + row * 8 + 4);
                    const float rs = rsq_(((s0.x + s0.y) + (s0.z + s0.w) + (s1.x + s1.y) + (s1.z + s1.w)) * (1.f / 512.f) + EPS);
                    const v4u v = *(const LAS v4u*)(yst + row * 144 + c * 16);
                    v4u o; o.x = pk2(bflo(v.x) * rs, bfhi(v.x) * rs); o.y = pk2(bflo(v.y) * rs, bfhi(v.y) * rs); o.z = pk2(bflo(v.z) * rs, bfhi(v.z) * rs); o.w = pk2(bflo(v.w) * rs, bfhi(v.w) * rs);
                    *(v4u*)(F.wsp<bf16>(WS_Y) + (row0 + 32 * mt + row) * DM + h * 64 + 8 * c) = o; }
                __syncthreads();
            }
        }
    }
    for (int u = F.vcu; u < NBATCH * NCHUNK; u += F.G) {
        const int b = u / NCHUNK, n = u % NCHUNK; const size_t row0 = (size_t)b * SEQ + (size_t)n * 64;
#pragma unroll 1
        for (int qt = 0; qt < ((parts & 2) ? 2 : 0); ++qt) {
            f32x16 o[2];
            attn_wave(F, b, n, qt, h, lane, tab, (LAS unsigned char*)stg, o);
            float s = 0.f;
#pragma unroll
            for (int dt = 0; dt < 2; ++dt)
#pragma unroll
                for (int i = 0; i < 16; ++i) s += o[dt][i] * o[dt][i];
            s += swap32_partner(s, hh);
            if (hh == 0) ssx[r * 8 + h] = s;
            __syncthreads();
            { const f32x4 s0 = *(const LAS f32x4*)(ssx + r * 8), s1 = *(const LAS f32x4*)(ssx + r * 8 + 4);
              const float rs = rsq_(((s0.x + s0.y) + (s0.z + s0.w) + (s1.x + s1.y) + (s1.z + s1.w)) * (1.f / 512.f) + EPS);
#pragma unroll
              for (int dt = 0; dt < 2; ++dt)
#pragma unroll
                  for (int i = 0; i < 16; i += 2) stg[r * 33 + ((32 * dt + crow(i, hh)) >> 1)] = pk2(o[dt][i] * rs, o[dt][i + 1] * rs); }
            LDS_WAIT();
#pragma unroll 4
            for (int i = 0; i < 16; ++i) { const int row = 2 * i + hh; const unsigned v = stg[row * 33 + r];
                *(GAS unsigned*)(F.wsp<bf16>(WS_Y) + (row0 + 32 * qt + row) * DM + LRUW + h * 64 + 2 * r) = v; }
            __syncthreads();
        }
    }
}
DI void p5_cross(Frame& F, const pg8::StaticOrder& S) {
    const int lane = F.lane, r = lane & 31, hh = lane >> 5, w = F.wave, tid = F.tid;
    constexpr int KST = 528, VST = 520;
    const float SC = 0.0625f * LOG2E;
    pg8::Unit un;
    for (int ui = 0; S.next(ui, un); ++ui) {
        const int b = un.pm >> 5, qb = un.pm & 31, hm = un.pn;
        const size_t qrow = (size_t)b * SEQ + (size_t)qb * 256 + 32 * w + r;
        { const bf16* src = F.wsp<bf16>(WS_KM) + (size_t)(b * 256) * DM + hm * 256;
#pragma unroll 4
          for (int i = 0; i < 16; ++i) { const int c = i * 512 + tid, row = c >> 5, ch = c & 31;
              *(LAS v4u*)(F.lds + row * KST + ch * 16) = *(const v4u*)(src + (size_t)row * DM + ch * 8); } }
        __syncthreads();
        f32x16 sc[8];
#pragma unroll
        for (int kt = 0; kt < 8; ++kt) sc[kt] = f32x16{};
#pragma unroll 2
        for (int s = 0; s < 16; ++s) {
            const bf16x8 qf = *(const bf16x8*)(F.wsp<bf16>(WS_QC) + qrow * DM + hm * 256 + 16 * s + 8 * hh);
#pragma unroll
            for (int kt = 0; kt < 8; ++kt) { const bf16x8 kf = *(const LAS bf16x8*)(F.lds + (32 * kt + r) * KST + (16 * s + 8 * hh) * 2); sc[kt] = MFMA32(kf, qf, sc[kt]); }
        }
        float mx = sc[0][0];
#pragma unroll
        for (int kt = 0; kt < 8; ++kt)
#pragma unroll
            for (int i = 0; i < 16; ++i) mx = fmaxf(mx, sc[kt][i]);
        mx = fmaxf(mx, swap32_partner(mx, hh));
        float ls = 0.f; const float mo = mx * SC;
        bf16x8 pf[8][2];
#pragma unroll
        for (int kt = 0; kt < 8; ++kt) {
#pragma unroll
            for (int i = 0; i < 16; ++i) { const float p = exp2_(sc[kt][i] * SC - mo); sc[kt][i] = p; ls += p; }
#pragma unroll
            for (int s2 = 0; s2 < 2; ++s2) { v4u wv; wv.x = pk2(sc[kt][8 * s2], sc[kt][8 * s2 + 1]); wv.y = pk2(sc[kt][8 * s2 + 2], sc[kt][8 * s2 + 3]); wv.z = pk2(sc[kt][8 * s2 + 4], sc[kt][8 * s2 + 5]); wv.w = pk2(sc[kt][8 * s2 + 6], sc[kt][8 * s2 + 7]);
                pf[kt][s2] = __builtin_bit_cast(bf16x8, wv); }
        }
        ls += swap32_partner(ls, hh);
        const float inv = 1.0f / ls;
        __syncthreads();
        { const bf16* src = F.wsp<bf16>(WS_VMT) + (size_t)((b * 4 + hm) * 256) * 256;
#pragma unroll 4
          for (int i = 0; i < 16; ++i) { const int c = i * 512 + tid, row = c >> 5, ch = c & 31; const v4u v = *(const v4u*)(src + (size_t)row * 256 + ch * 8);
              LAS v2u* d = (LAS v2u*)(F.lds + row * VST + ch * 16); d[0] = (v2u){v.x, v.y}; d[1] = (v2u){v.z, v.w}; } }
        __syncthreads();
        LAS unsigned* stg = (LAS unsigned*)(F.lds) ;
#pragma unroll
        for (int half = 0; half < 2; ++half) {
            f32x16 o[4];
#pragma unroll
            for (int dt = 0; dt < 4; ++dt) o[dt] = f32x16{};
#pragma unroll
            for (int kt = 0; kt < 8; ++kt)
#pragma unroll
                for (int s2 = 0; s2 < 2; ++s2)
#pragma unroll
                    for (int dt = 0; dt < 4; ++dt) { const LAS unsigned char* p = F.lds + (128 * half + 32 * dt + r) * VST + (32 * kt + 16 * s2 + 4 * hh) * 2;
                        const v2u lo = *(const LAS v2u*)p, hi = *(const LAS v2u*)(p + 16); v4u wv; wv.x = lo.x; wv.y = lo.y; wv.z = hi.x; wv.w = hi.y;
                        o[dt] = MFMA32(__builtin_bit_cast(bf16x8, wv), pf[kt][s2], o[dt]); }
            if (half == 1) __syncthreads();
            else {   }
            if (half == 0) {
#pragma unroll
                for (int dt = 0; dt < 4; ++dt)
#pragma unroll
                    for (int i = 0; i < 16; i += 2) { const unsigned pv = pk2(o[dt][i] * inv, o[dt][i + 1] * inv); sc[dt][i >> 1] = __uint_as_float(pv); }
            } else {
                LAS unsigned* sw = (LAS unsigned*)(F.lds + w * 16512);
#pragma unroll
                for (int dt = 0; dt < 4; ++dt)
#pragma unroll
                    for (int i = 0; i < 16; i += 2) { sw[r * 129 + ((32 * dt + crow(i, hh)) >> 1)] = __float_as_uint(sc[dt][i >> 1]);
                        sw[r * 129 + 64 + ((32 * dt + crow(i, hh)) >> 1)] = pk2(o[dt][i] * inv, o[dt][i + 1] * inv); }
                LDS_WAIT();
#pragma unroll 4
                for (int i = 0; i < 32; ++i) { const unsigned v0 = sw[i * 129 + lane], v1 = sw[i * 129 + 64 + lane];
                    GAS unsigned* dst = (GAS unsigned*)(F.wsp<bf16>(WS_OC) + ((size_t)b * SEQ + (size_t)qb * 256 + 32 * w + i) * DM + hm * 256);
                    dst[lane] = v0; dst[64 + lane] = v1; }
            }
        }
        (void)stg;
        __syncthreads();
    }
}
template <int N> DI void ce_desc(float (&a)[N], int i, int l) { const float hi = fmaxf(a[i], a[l]), lo = fminf(a[i], a[l]); a[i] = hi; a[l] = lo; }
template <int N, int OFF> DI void bitonic_sort16_desc(float (&a)[N]) {
#define CE_(i, j) ce_desc<N>(a, OFF + (i), OFF + (j))
    CE_(0,13); CE_(1,12); CE_(2,15); CE_(3,14); CE_(4,8); CE_(5,6); CE_(7,11); CE_(9,10);
    CE_(0,5); CE_(1,7); CE_(2,9); CE_(3,4); CE_(6,13); CE_(8,14); CE_(10,15); CE_(11,12);
    CE_(0,1); CE_(2,3); CE_(4,5); CE_(6,8); CE_(7,9); CE_(10,11); CE_(12,13); CE_(14,15);
    CE_(0,2); CE_(1,3); CE_(4,10); CE_(5,11); CE_(6,7); CE_(8,9); CE_(12,14); CE_(13,15);
    CE_(1,2); CE_(3,12); CE_(4,6); CE_(5,7); CE_(8,10); CE_(9,11); CE_(13,14);
    CE_(1,4); CE_(2,6); CE_(5,8); CE_(7,10); CE_(9,13); CE_(11,14);
    CE_(2,4); CE_(3,6); CE_(9,12); CE_(11,13);
    CE_(3,5); CE_(6,8); CE_(7,9); CE_(10,12);
    CE_(3,4); CE_(5,6); CE_(7,8); CE_(9,10); CE_(11,12);
    CE_(6,7); CE_(8,9);
#undef CE_
}
template <int N, int OFF> DI void bitonic_merge16_desc(float (&a)[N]) {
#pragma unroll
    for (int j = 8; j > 0; j >>= 1)
#pragma unroll
        for (int i = 0; i < 16; ++i) { const int l = i ^ j; if (l > i) ce_desc<N>(a, OFF + i, OFF + l); }
}
template <bool SORTED, bool SORT0 = true> DI void top16_of_64(float (&a)[64]) {
    if (SORT0) bitonic_sort16_desc<64, 0>(a); bitonic_sort16_desc<64, 16>(a); bitonic_sort16_desc<64, 32>(a); bitonic_sort16_desc<64, 48>(a);
#pragma unroll
    for (int i = 0; i < 16; ++i) { a[i] = fmaxf(a[i], a[31 - i]); a[32 + i] = fmaxf(a[32 + i], a[63 - i]); }
    bitonic_merge16_desc<64, 0>(a); bitonic_merge16_desc<64, 32>(a);
#pragma unroll
    for (int i = 0; i < 16; ++i) a[i] = fmaxf(a[i], a[47 - i]);
    if (SORTED) bitonic_merge16_desc<64, 0>(a);
}
DI void p8a_topk(Frame& F, const pg8::StaticOrder& S) {
    const int lane = F.lane, r = lane & 31, hh = lane >> 5, w = F.wave;
    constexpr int TK_ST = 272, TK_QBYTES = 256 * TK_ST;
    LAS float* tbl = (LAS float*)(F.lds + w * 8192);
    pg8::Unit un;
    for (int ui = 0; S.next(ui, un); ++ui) {
        const int h = un.pn; const size_t tok = (size_t)un.pm * 256 + 32 * w + r;
        float v[2][16];
#pragma unroll
        for (int p = 0; p < 2; ++p) {
            __syncthreads();
            { const bf16* qsrc = F.wsp<bf16>(WS_QP) + (size_t)un.pm * 256 * 2048 + h * 256 + p * 128; const bf16* ksrc = F.wsp<bf16>(WS_SUBK) + (size_t)((h * 2 + p) * 128) * 128;
              const int rr = F.tid >> 4, ch = F.tid & 15;
#pragma unroll
              for (int i = 0; i < 8; ++i) *(LAS v4u*)(F.lds + (32 * i + rr) * TK_ST + ch * 16) = *(const v4u*)(qsrc + (size_t)(32 * i + rr) * 2048 + ch * 8);
#pragma unroll
              for (int i = 0; i < 4; ++i) *(LAS v4u*)(F.lds + TK_QBYTES + (32 * i + rr) * TK_ST + ch * 16) = *(const v4u*)(ksrc + (size_t)(32 * i + rr) * 128 + ch * 8); }
            __syncthreads();
            f32x16 sc[4];
#pragma unroll
            for (int nt = 0; nt < 4; ++nt) sc[nt] = f32x16{};
#pragma unroll 2
            for (int s = 0; s < 8; ++s) { const bf16x8 qf = *(const LAS bf16x8*)(F.lds + (32 * w + r) * TK_ST + (16 * s + 8 * hh) * 2);
#pragma unroll
                for (int nt = 0; nt < 4; ++nt) { const bf16x8 kf = *(const LAS bf16x8*)(F.lds + TK_QBYTES + (32 * nt + r) * TK_ST + (16 * s + 8 * hh) * 2); sc[nt] = MFMA32(kf, qf, sc[nt]); } }
            float a[64];
#pragma unroll
            for (int nt = 0; nt < 4; ++nt)
#pragma unroll
                for (int i = 0; i < 16; ++i) a[nt * 16 + i] = __uint_as_float((__float_as_uint(sc[nt][i]) & ~127u) | (unsigned)(32 * nt + crow(i, hh)));
            top16_of_64<true>(a);
            float m[16];
#pragma unroll
            for (int i = 0; i < 16; ++i) m[i] = fmaxf(a[i], swap32_partner(a[15 - i], hh));
            bitonic_merge16_desc<16, 0>(m);
#pragma unroll
            for (int i = 0; i < 16; ++i) v[p][i] = m[i];
        }
        float c[64]; int n = 0;
#pragma unroll
        for (int i = 0; i < 16; ++i)
#pragma unroll
            for (int j = 0; j < 16; ++j) if ((i + 1) * (j + 1) <= 16) { c[n] = __uint_as_float((__float_as_uint(v[0][i] + v[1][j]) & ~255u) | (unsigned)((i << 4) | j)); ++n; }
#pragma unroll
        for (int k = 50; k < 64; ++k) c[k] = -3.0e38f;
        top16_of_64<false, false>(c);
        __syncthreads();
#pragma unroll
        for (int i = 0; i < 16; ++i) { tbl[i * 64 + lane] = v[0][i]; tbl[(16 + i) * 64 + lane] = v[1][i]; }
        LDS_WAIT();
        float sv[16]; int ev[16]; float mx = -3.0e38f;
#pragma unroll
        for (int k = 0; k < 16; ++k) { const unsigned pl = __float_as_uint(c[k]) & 255u; const float a1 = tbl[(pl >> 4) * 64 + lane], a2 = tbl[(16 + (pl & 15)) * 64 + lane];
            sv[k] = a1 + a2; ev[k] = (int)(((__float_as_uint(a1) & 127u) << 7) | (__float_as_uint(a2) & 127u)); mx = fmaxf(mx, sv[k]); }
        float sum = 0.f;
#pragma unroll
        for (int k = 0; k < 16; ++k) { sv[k] = __expf(sv[k] - mx); sum += sv[k]; }
        const float inv = 1.0f / sum;
        if (hh == 0) {
#pragma unroll
            for (int k = 0; k < 16; k += 4) *(v4u*)(F.wsp<int>(WS_IDX) + tok * NSEL + h * 16 + k) = (v4u){(unsigned)ev[k], (unsigned)ev[k + 1], (unsigned)ev[k + 2], (unsigned)ev[k + 3]};
        } else {
#pragma unroll
            for (int k = 0; k < 16; k += 4) *(f32x4*)(F.wsp<float>(WS_G) + tok * NSEL + h * 16 + k) = (f32x4){sv[k] * inv, sv[k + 1] * inv, sv[k + 2] * inv, sv[k + 3] * inv};
        }
        LDS_WAIT();
    }
}
typedef _Float16 f16x2_t __attribute__((ext_vector_type(2)));
DI int dot16_i8(const v4u& u, const unsigned (&x)[4]) {
    const unsigned u0 = u.x, u1 = u.y, u2 = u.z, u3 = u.w;
    int a = 0;
    a = __builtin_amdgcn_sdot4((int)u0, (int)x[0], a, false); a = __builtin_amdgcn_sdot4((int)u1, (int)x[1], a, false);
    a = __builtin_amdgcn_sdot4((int)u2, (int)x[2], a, false); a = __builtin_amdgcn_sdot4((int)u3, (int)x[3], a, false);
    return a;
}
DI void axpy32_v6(f16x2_t (&o)[16], float w, const v4u a, unsigned b4, unsigned b5) {
    const v6u pk = {a.x, a.y, a.z, a.w, b4, b5};
    const v32h h = __builtin_amdgcn_cvt_scalef32_pk32_f16_fp6(pk, 1.0f);
    const f16x2_t w2 = {(_Float16)w, (_Float16)w};
#pragma unroll
    for (int i = 0; i < 16; ++i) { const f16x2_t hv = {h[2 * i], h[2 * i + 1]}; o[i] = __builtin_elementwise_fma(hv, w2, o[i]); }
}
constexpr int TPW = 4, NSLICE = 16, SLICE_SHIFT = 10, NPAIR = TPW * NSEL, NPAIR_PAD = NPAIR + 1 * TPW * NSLICE + 32;
constexpr int PEER_LDS_PER_WAVE = TPW * 1024 + 64 + TPW * 2048 + NPAIR_PAD * 4;
static_assert(PEER_LDS_PER_WAVE * NWAVES <= RING_BYTES, "PEER LDS");
DI int incl_scan64(int v, int lane) {
    int s = v;
#pragma unroll
    for (int d = 1; d < 64; d <<= 1) { const int t = __shfl_up(s, d); if (lane >= d) s += t; }
    return s;
}
struct PeerBatch { v4u uu[4]; v4u va[2]; unsigned vb4[2], vb5[2]; unsigned ent[4]; float su[4], sv[4]; };
DI void peer_load_batch(PeerBatch& B, const LAS unsigned* ml, int i, const unsigned char* EU8, const unsigned char* EV8, const float* SU, int lane, unsigned emask = 0x3fffu) {
    const v4u e4 = *(const LAS v4u*)(ml + i);
    B.ent[0] = (unsigned)__builtin_amdgcn_readfirstlane((int)e4.x); B.ent[1] = (unsigned)__builtin_amdgcn_readfirstlane((int)e4.y);
    B.ent[2] = (unsigned)__builtin_amdgcn_readfirstlane((int)e4.z); B.ent[3] = (unsigned)__builtin_amdgcn_readfirstlane((int)e4.w);
    const int l5 = lane & 31, hh = lane >> 5;
#pragma unroll
    for (int k = 0; k < 4; ++k) { const unsigned e = B.ent[k] & emask; const unsigned char* ur = EU8 + (size_t)e * DM;
        B.uu[k] = *(const v4u*)(ur + (unsigned)(16 * lane)); B.su[k] = SU[e]; B.sv[k] = SU[NEXP + e]; }
#pragma unroll
    for (int q = 0; q < 2; ++q) { const unsigned e0 = B.ent[2 * q] & emask, e1 = B.ent[2 * q + 1] & emask; const unsigned e = e0 + (unsigned)hh * (e1 - e0);
        const unsigned off = e * (unsigned)EV_ROW; B.va[q] = *(const v4u*)(EV8 + off + (unsigned)(16 * l5)); const v2u t2 = *(const v2u*)(EV8 + off + (unsigned)(512 + 8 * l5)); B.vb4[q] = t2.x; B.vb5[q] = t2.y; }
}
struct PeerState { unsigned x[4]; float sx; f16x2_t oc[16]; int curj; };
DI void peer_flush(PeerState& S, LAS unsigned char* ol, int lane) {
    LAS v4u* r = (LAS v4u*)(ol + S.curj * 2048 + 64 * (lane & 31) + 32 * (lane >> 5));
    unsigned mine[8];
#pragma unroll
    for (int i = 0; i < 8; ++i) { auto rr = __builtin_amdgcn_permlane32_swap(__builtin_bit_cast(unsigned, S.oc[i]), __builtin_bit_cast(unsigned, S.oc[8 + i]), false, false);
        mine[i] = __builtin_bit_cast(unsigned, __builtin_bit_cast(f16x2_t, (unsigned)rr[0]) + __builtin_bit_cast(f16x2_t, (unsigned)rr[1])); }
#pragma unroll
    for (int c = 0; c < 2; ++c) { const v4u v = r[c]; v4u o;
        o.x = __builtin_bit_cast(unsigned, __builtin_bit_cast(f16x2_t, (unsigned)v.x) + __builtin_bit_cast(f16x2_t, mine[4 * c])); o.y = __builtin_bit_cast(unsigned, __builtin_bit_cast(f16x2_t, (unsigned)v.y) + __builtin_bit_cast(f16x2_t, mine[4 * c + 1]));
        o.z = __builtin_bit_cast(unsigned, __builtin_bit_cast(f16x2_t, (unsigned)v.z) + __builtin_bit_cast(f16x2_t, mine[4 * c + 2])); o.w = __builtin_bit_cast(unsigned, __builtin_bit_cast(f16x2_t, (unsigned)v.w) + __builtin_bit_cast(f16x2_t, mine[4 * c + 3]));
        r[c] = o; }
#pragma unroll
    for (int i = 0; i < 16; ++i) S.oc[i] = (f16x2_t){(_Float16)0.f, (_Float16)0.f};
}
DI void peer_compute_batch(const PeerBatch& B, PeerState& S, LAS unsigned char* ol, const LAS unsigned char* xl, int lane) {
    const int jA = (int)((B.ent[0] >> 14) & 3u), jB = (int)((B.ent[2] >> 14) & 3u);
    if (jA != S.curj) {
        if (S.curj >= 0) peer_flush(S, ol, lane);
        S.curj = jA;
        const v4u y0 = ((const LAS v4u*)(xl + jA * 1024))[lane];
        S.x[0] = y0.x; S.x[1] = y0.y; S.x[2] = y0.z; S.x[3] = y0.w; S.sx = ((const LAS float*)(xl + TPW * 1024))[jA]; }
    unsigned xb[4] = {S.x[0], S.x[1], S.x[2], S.x[3]}; float sxb = S.sx;
    if (jB != jA) { const v4u y0 = ((const LAS v4u*)(xl + jB * 1024))[lane]; xb[0] = y0.x; xb[1] = y0.y; xb[2] = y0.z; xb[3] = y0.w; sxb = ((const LAS float*)(xl + TPW * 1024))[jB]; }
    const float d0 = (float)dot16_i8(B.uu[0], S.x) * B.su[0], d1 = (float)dot16_i8(B.uu[1], S.x) * B.su[1], d2 = (float)dot16_i8(B.uu[2], xb) * B.su[2], d3 = (float)dot16_i8(B.uu[3], xb) * B.su[3];
    const bool b0 = lane & 1, b1 = lane & 2;
    const float r0 = (b0 ? d1 : d0) + dpp_xor1(b0 ? d0 : d1), r1 = (b0 ? d3 : d2) + dpp_xor1(b0 ? d2 : d3);
    float t = (b1 ? r1 : r0) + dpp_xor2(b1 ? r0 : r1);
    t += __int_as_float(__builtin_amdgcn_update_dpp(0, __float_as_int(t), 0x124, 0xf, 0xf, true));
    t += __int_as_float(__builtin_amdgcn_update_dpp(0, __float_as_int(t), 0x128, 0xf, 0xf, true));
    { auto rr = __builtin_amdgcn_permlane16_swap(__float_as_uint(t), __float_as_uint(t), false, false); t = __uint_as_float(rr[0]) + __uint_as_float(rr[1]); }
    { auto rr = __builtin_amdgcn_permlane32_swap(__float_as_uint(t), __float_as_uint(t), false, false); t = __uint_as_float(rr[0]) + __uint_as_float(rr[1]); }
    const float act = gelu_tanh(t * (b1 ? sxb : S.sx));
#define PEER_W(k) (__builtin_bit_cast(float, __builtin_amdgcn_readlane(__builtin_bit_cast(int, act), k)) * __uint_as_float(B.ent[k] & 0xffff0000u) * B.sv[k])
    const float a0 = PEER_W(0), a1 = PEER_W(1), a2 = PEER_W(2), a3 = PEER_W(3);
#undef PEER_W
    const float hsel = (lane >= 32) ? 1.0f : 0.0f;
    axpy32_v6(S.oc, a0 + hsel * (a1 - a0), B.va[0], B.vb4[0], B.vb5[0]);
    if (jB != jA) { peer_flush(S, ol, lane); S.curj = jB; S.x[0] = xb[0]; S.x[1] = xb[1]; S.x[2] = xb[2]; S.x[3] = xb[3]; S.sx = sxb; }
    axpy32_v6(S.oc, a2 + hsel * (a3 - a2), B.va[1], B.vb4[1], B.vb5[1]);
}
DI void p8b_peer(Frame& F, float* outp, unsigned emask = 0x3fffu, float oscale = 1.0f) {
    const int lane = F.lane, w = F.wave;
    const int gw = F.vcu * NWAVES + w, NGW = F.G * NWAVES;
    const unsigned char* EU8 = F.wsp<unsigned char>(WS_EU); const unsigned char* EV8 = F.wsp<unsigned char>(WS_EV); const float* SU = F.wsp<float>(WS_SU);
    LAS unsigned char* xl = F.lds + w * PEER_LDS_PER_WAVE;
    LAS unsigned char* ol = xl + TPW * 1024 + 64;
    LAS unsigned* ml = (LAS unsigned*)(ol + TPW * 2048);
    for (int t0 = gw * TPW; t0 < M; t0 += NGW * TPW) {
        unsigned enta[TPW], entb[TPW]; int posa[TPW], posb[TPW], sla[TPW], slb[TPW], offs[TPW];
#pragma unroll
        for (int j = 0; j < TPW; ++j) { const size_t tok = (size_t)t0 + j;
            float rstd; { const f32x4* sp = (const f32x4*)(F.wsp<float>(WS_SSQ2) + tok * 16); const f32x4 st = (sp[0] + sp[1]) + (sp[2] + sp[3]); rstd = rsq_(((st.x + st.y) + (st.z + st.w)) * (1.f / 1024.f) + EPS); }
            { const bf16* xs = F.wsp<bf16>(WS_XN) + tok * DM + 16 * lane;
              const v4u x0 = *(const v4u*)xs, x1 = *(const v4u*)(xs + 8);
              float xf[16] = {bflo(x0.x), bfhi(x0.x), bflo(x0.y), bfhi(x0.y), bflo(x0.z), bfhi(x0.z), bflo(x0.w), bfhi(x0.w), bflo(x1.x), bfhi(x1.x), bflo(x1.y), bfhi(x1.y), bflo(x1.z), bfhi(x1.z), bflo(x1.w), bfhi(x1.w)};
              float mx = 0.f;
#pragma unroll
              for (int i = 0; i < 16; ++i) mx = fmaxf(mx, fabsf(xf[i]));
              mx = fmaxf(max64(mx), 1e-30f); const float inv = 127.0f / mx;
              v4u y; y.x = pack_i8x4(xf[0] * inv, xf[1] * inv, xf[2] * inv, xf[3] * inv); y.y = pack_i8x4(xf[4] * inv, xf[5] * inv, xf[6] * inv, xf[7] * inv);
              y.z = pack_i8x4(xf[8] * inv, xf[9] * inv, xf[10] * inv, xf[11] * inv); y.w = pack_i8x4(xf[12] * inv, xf[13] * inv, xf[14] * inv, xf[15] * inv);
              ((LAS v4u*)(xl + j * 1024))[lane] = y; if (lane == 0) ((LAS float*)(xl + TPW * 1024))[j] = mx * rstd * (1.0f / 127.0f);
              ((LAS v4u*)(ol + j * 2048))[lane] = (v4u){0u, 0u, 0u, 0u}; ((LAS v4u*)(ol + j * 2048))[64 + lane] = (v4u){0u, 0u, 0u, 0u}; }
            const int ea = F.wsp<int>(WS_IDX)[tok * NSEL + lane], eb = F.wsp<int>(WS_IDX)[tok * NSEL + 64 + lane];
            const float ga = F.wsp<float>(WS_G)[tok * NSEL + lane], gb = F.wsp<float>(WS_G)[tok * NSEL + 64 + lane];
            const int sa = ea >> SLICE_SHIFT, sb = eb >> SLICE_SHIFT;
            int pa = 0, pb = 0, myoff = 0;
#pragma unroll
            for (int bk = 0; bk < NSLICE; ++bk) { const unsigned long long ma = __ballot(sa == bk), mb = __ballot(sb == bk);
                const int ca = __popcll(ma), cb = __popcll(mb);
                const int ra = __builtin_amdgcn_mbcnt_hi((unsigned)(ma >> 32), __builtin_amdgcn_mbcnt_lo((unsigned)ma, 0)), rb = __builtin_amdgcn_mbcnt_hi((unsigned)(mb >> 32), __builtin_amdgcn_mbcnt_lo((unsigned)mb, 0));
                pa = (sa == bk) ? ra : pa; pb = (sb == bk) ? ca + rb : pb;
                myoff = (lane == bk) ? ca + cb : myoff; }
            enta[j] = (unsigned)ea | ((unsigned)j << 14) | (pk2(0.f, ga) & 0xffff0000u); entb[j] = (unsigned)eb | ((unsigned)j << 14) | (pk2(0.f, gb) & 0xffff0000u);
            posa[j] = pa; posb[j] = pb; sla[j] = sa; slb[j] = sb; offs[j] = myoff;
        }
        int cnt = 0;
#pragma unroll
        for (int j = 0; j < TPW; ++j) { const int c = __shfl(offs[j], lane >> 2); cnt = ((lane & 3) == j) ? c : cnt; }
        const int cpad = (cnt + 1) & ~1;
        const int bend = incl_scan64(cpad, lane), bstart = bend - cpad;
        const int npad = __builtin_amdgcn_readlane(bend, 63);
#pragma unroll
        for (int j = 0; j < TPW; ++j) { const int ba = __shfl(bstart, 4 * sla[j] + j), bb = __shfl(bstart, 4 * slb[j] + j);
            ml[ba + posa[j]] = enta[j]; ml[bb + posb[j]] = entb[j]; }
        { const unsigned pad = (unsigned)((lane >> 2) << SLICE_SHIFT) | ((unsigned)(lane & 3) << 14);
          if (cnt < cpad) ml[bstart + cnt] = pad; }
        if (lane < 30) ml[npad + lane] = (unsigned)((NSLICE - 1) << SLICE_SHIFT) | (3u << 14);
        LDS_WAIT();
        PeerState S;
#pragma unroll
        for (int i = 0; i < 16; ++i) S.oc[i] = (f16x2_t){(_Float16)0.f, (_Float16)0.f};
#pragma unroll
        for (int i = 0; i < 4; ++i) S.x[i] = 0u;
        S.curj = -1;
        PeerBatch A, B, C, D;
        peer_load_batch(A, ml, 0, EU8, EV8, SU, lane, emask); peer_load_batch(B, ml, 4, EU8, EV8, SU, lane, emask); peer_load_batch(C, ml, 8, EU8, EV8, SU, lane, emask);
#pragma unroll 1
        for (int i = 0; i < npad; i += 16) {
            peer_load_batch(D, ml, i + 12, EU8, EV8, SU, lane, emask); peer_compute_batch(A, S, ol, xl, lane);
            peer_load_batch(A, ml, i + 16, EU8, EV8, SU, lane, emask); peer_compute_batch(B, S, ol, xl, lane);
            peer_load_batch(B, ml, i + 20, EU8, EV8, SU, lane, emask); peer_compute_batch(C, S, ol, xl, lane);
            peer_load_batch(C, ml, i + 24, EU8, EV8, SU, lane, emask); peer_compute_batch(D, S, ol, xl, lane);
        }
        peer_flush(S, ol, lane);
        LDS_WAIT();
#pragma unroll
        for (int j = 0; j < TPW; ++j) {
            const int l5 = lane & 31, hh5 = lane >> 5;
            const LAS unsigned char* orl = ol + j * 2048 + 64 * l5 + 32 * hh5;
            const v4u h0 = *(const LAS v4u*)orl, h1 = *(const LAS v4u*)(orl + 16);
            const unsigned hw[8] = {h0.x, h0.y, h0.z, h0.w, h1.x, h1.y, h1.z, h1.w};
            f32x4 a[4]; float ss = 0.f;
#pragma unroll
            for (int q = 0; q < 4; ++q) { const int eo = 128 * (4 * hh5 + q) + 4 * l5;
                const v2u xb = *(const v2u*)(F.wsp<bf16>(WS_XN) + ((size_t)t0 + j) * DM + eo);
                const f16x2_t p0 = __builtin_bit_cast(f16x2_t, hw[2 * q]), p1 = __builtin_bit_cast(f16x2_t, hw[2 * q + 1]);
                a[q] = (f32x4){bflo(xb.x), bfhi(xb.x), bflo(xb.y), bfhi(xb.y)} + (f32x4){(float)p0.x, (float)p0.y, (float)p1.x, (float)p1.y};
                ss += (a[q].x * a[q].x + a[q].y * a[q].y) + (a[q].z * a[q].z + a[q].w * a[q].w); }
            const float rf = rsq_(sum64(ss) * (1.f / 1024.f) + EPS) * oscale;
#pragma unroll
            for (int q = 0; q < 4; ++q) { const int eo = 128 * (4 * hh5 + q) + 4 * l5;
                *(f32x4*)(outp + ((size_t)t0 + j) * DM + eo) = a[q] * rf * *(const f32x4*)(F.in(25) + eo); }
        }
        LDS_WAIT();
    }
}
constexpr int N_PHASES = 11;
__global__ void __launch_bounds__(NWAVES * 64, 2) fwd_kernel(Args args) {
    extern __shared__ __attribute__((aligned(16))) unsigned char lds[];
    Frame F;
    F.lds = (LAS unsigned char*)lds;
    F.MISC = (volatile LAS unsigned*)(F.lds + MISC_OFF);
    F.tid = threadIdx.x; F.lane = F.tid & 63; F.wave = __builtin_amdgcn_readfirstlane(F.tid >> 6);
    F.G = gridDim.x; { const int bx = blockIdx.x; F.vcu = (F.G % 8 == 0) ? (bx % 8) * (F.G / 8) + bx / 8 : bx; }
    F.A = &args; F.ws = args.ws; F.out = args.out;
    F.ctl = (gu32*)(args.ws + WS_CTL);
    for (int u = F.tid; u < (LDS_BYTES - LDSCTL_OFF) / 4; u += NWAVES * 64) ((LAS unsigned*)(F.lds + LDSCTL_OFF))[u] = 0u;
    __syncthreads();
    const bool multi = (args.ph_hi - args.ph_lo) > 1;
    XcdBarrier bar; bar.bar = (unsigned*)(F.ctl + CW_BAR) + args.li * XCD_BAR_WORDS; bar.x = 0; bar.st = nullptr;
    if (multi) bar = xcd_barrier_post((unsigned*)(F.ctl + CW_BAR) + args.li * XCD_BAR_WORDS, F.MISC + 8);
    const int lo = args.ph_lo, hi = args.ph_hi;
#ifndef PROBE_EMASK
#define PROBE_EMASK 0x3fffu
#endif
#ifndef PHASE_REPEAT
#define PHASE_REPEAT 0
#endif
#define REP(k) for (int rep_ = 0; rep_ < (((PHASE_REPEAT >> (k)) & 1) ? 2 : 1); ++rep_)
#ifndef PHASE_MASK
#define PHASE_MASK 0x7ff
#endif
#define IN(k) (((PHASE_MASK >> (k)) & 1) && lo <= (k) && (k) < hi)
#define SEAM(k) do { asm volatile("; ===SEAM " #k ::: "memory"); if (IN(k) && IN((k) + 1)) xcd_barrier(bar); STAMP((k) + 1); } while (0)
    const int c = (int)blockIdx.x;
#define LOCAL_SEAM() do { VM_WAIT(); __syncthreads(); if (F.tid == 0) { __builtin_amdgcn_fence(__ATOMIC_ACQUIRE, "agent"); VM_WAIT(); } __syncthreads(); } while (0)
#ifdef PROBE_PHASE
#define STAMP(i) do { if (blockIdx.x == 0 && F.tid == 0) __hip_atomic_store(F.ctl + 512 + (i), (unsigned)__builtin_amdgcn_s_memrealtime(), RLX_AGENT); } while (0)
#else
#define STAMP(i) do { } while (0)
#endif
    STAMP(0);

#ifndef PROBE_P0
#define PROBE_P0 7
#endif
    if (IN(0)) { if (PHASE_REPEAT & 1) p0_prologue(F, PROBE_P0); p0_prologue(F); } SEAM(0);
    if (IN(1)) REP(1) {
        { pg8::Gemm g{F.wsp<bf16>(WS_XN), F.wsp<bf16>(WS_WIN), M, INW, DM}; pg8::StaticOrder S; S.init(M, INW, F.G, c);
          pg8::EpiSplitT E{F.wsp<bf16>(WS_Z), ZW, ZW, F.wsp<bf16>(WS_VT), ATTW, SEQ};
          pg8::gemm_phase<pg8::EpiSplitT, pg8::StaticOrder, true, true>(F.lds, g, S, E); }
        { const int nw3 = (M / 256) * (INW / 256) - 2 * F.G;
          int idx = -1; if (nw3 >= 0 && nw3 + 16 <= F.G) idx = c - nw3; else idx = (c < 16 && F.G >= 16) ? c : -1;
          if (F.G < 16) idx = -1;
          pg8::Gemm g{F.wsp<bf16>(WS_MEMN), F.wsp<bf16>(WS_WKV), NBATCH * 256, 2 * DM, DM};
          if (F.G >= 16) { pg8::OneUnit S{idx, 2, 8}; pg8::EpiSplitT E{F.wsp<bf16>(WS_KM), DM, DM, F.wsp<bf16>(WS_VMT), DM, 256};
              pg8::gemm_phase<pg8::EpiSplitT, pg8::OneUnit, false, true>(F.lds, g, S, E); }
          else { pg8::StaticOrder S; S.init(NBATCH * 256, 2 * DM, F.G, c); pg8::EpiSplitT E{F.wsp<bf16>(WS_KM), DM, DM, F.wsp<bf16>(WS_VMT), DM, 256};
              pg8::gemm_phase<pg8::EpiSplitT, pg8::StaticOrder, false, true>(F.lds, g, S, E); } }
        { const int first_idle = (M / 256) * (INW / 256) - 2 * F.G + 16;
          if (first_idle > 0 && first_idle < F.G) { if (c >= first_idle) convert_experts(F, (c - first_idle) * NWAVES + F.wave, (F.G - first_idle) * NWAVES); }
          else convert_experts(F, c * NWAVES + F.wave, F.G * NWAVES); }
    } SEAM(1);
    if (IN(2)) REP(2) { p2_lru_aggregates(F); } SEAM(2);
#ifndef PROBE_PARTS
#define PROBE_PARTS 3
#endif
    if (IN(3)) { if ((PHASE_REPEAT >> 3) & 1) p3_mixer(F, PROBE_PARTS); p3_mixer(F); } SEAM(3);
    if (IN(4)) REP(4) {
        pg8::Gemm g{F.wsp<bf16>(WS_Y), F.wsp<bf16>(WS_WOUT), M, DM, DM}; pg8::StaticOrder S; S.init(M, DM, F.G, c);
        pg8::EpiResid<false> E{F.in(0), F.wsp<bf16>(WS_XN), F.wsp<float>(WS_SSQ1), DM};
        pg8::gemm_phase<pg8::EpiResid<false>, pg8::StaticOrder, true, true>(F.lds, g, S, E);
    } SEAM(4);
    if (IN(5)) {
        pg8::Gemm g{F.wsp<bf16>(WS_XN), F.wsp<bf16>(WS_WQ), M, DM, DM}; pg8::StaticOrder S; S.init(M, DM, F.G, c);
        pg8::EpiRowScale E{F.wsp<bf16>(WS_QC), DM, F.wsp<float>(WS_SSQ1), 1.f / 1024.f, EPS};
        pg8::gemm_phase<pg8::EpiRowScale, pg8::StaticOrder, true, true>(F.lds, g, S, E);
        LOCAL_SEAM();
        p5_cross(F, S);
    } SEAM(6);
    if (IN(7)) {
        pg8::Gemm g{F.wsp<bf16>(WS_OC), F.wsp<bf16>(WS_WO), M, DM, DM}; pg8::StaticOrder S; S.init(M, DM, F.G, c);
        pg8::EpiResid<true> E{F.wsp<bf16>(WS_XN), F.wsp<bf16>(WS_XN), F.wsp<float>(WS_SSQ2), DM};
        pg8::gemm_phase<pg8::EpiResid<true>, pg8::StaticOrder, true, true>(F.lds, g, S, E);
    } SEAM(7);
    if (IN(8)) {
        pg8::Gemm g{F.wsp<bf16>(WS_XN), F.wsp<bf16>(WS_WQRY), M, 2 * DM, DM}; pg8::StaticOrder S; S.init(M, 2 * DM, F.G, c);
        pg8::EpiRowScale E{F.wsp<bf16>(WS_QP), 2 * DM, F.wsp<float>(WS_SSQ2), 1.f / 1024.f, EPS};
        pg8::gemm_phase<pg8::EpiRowScale, pg8::StaticOrder, true, true>(F.lds, g, S, E);
        LOCAL_SEAM();
        p8a_topk(F, S);
    } SEAM(9);
    if (IN(10)) { if ((PHASE_REPEAT >> 10) & 1) { p8b_peer(F, F.wsp<float>(WS_Z), PROBE_EMASK); } p8b_peer(F, F.out, 0x3fffu,
#ifdef PROBE_PHASE
        1.0f + (float)(((__hip_atomic_load(F.ctl + 512 + PROBE_PHASE + 1, RLX_AGENT) - __hip_atomic_load(F.ctl + 512 + PROBE_PHASE, RLX_AGENT)) + 500u) / 1000u) * 1e-2f
#else
        1.0f
#endif
        ); }
#undef IN
#undef SEAM
}

#ifndef N_LAUNCH_MODE
#define N_LAUNCH_MODE 1
#endif
extern "C" void kernel_launch(void* const* d_in, const int* in_sizes, int n_in, void* d_out, int out_size, void* d_ws, size_t ws_size, hipStream_t stream) {
    static int grid = 0;
    if (grid == 0) {
        if (n_in != 26 || out_size != M * DM || ws_size < WS_END) { fprintf(stderr, "kernel_launch: unexpected shapes (n_in %d, out %d, ws %zu)\n", n_in, out_size, ws_size); grid = -1; return; }
        int dev = 0, cus = 0, per_cu = 0;
        if (hipGetDevice(&dev) != hipSuccess || hipDeviceGetAttribute(&cus, hipDeviceAttributeMultiprocessorCount, dev) != hipSuccess) { grid = -1; return; }
        if (hipFuncSetAttribute((const void*)fwd_kernel, hipFuncAttributeMaxDynamicSharedMemorySize, LDS_BYTES) != hipSuccess) { fprintf(stderr, "kernel_launch: hipFuncSetAttribute failed\n"); grid = -1; return; }
        if (hipOccupancyMaxActiveBlocksPerMultiprocessor(&per_cu, (const void*)fwd_kernel, NWAVES * 64, LDS_BYTES) != hipSuccess || per_cu < 1) { fprintf(stderr, "kernel_launch: occupancy query says %d blocks per CU\n", per_cu); (void)hipGetLastError(); grid = -1; return; }
        grid = cus;
    }
    if (grid < 0) return;
    (void)hipMemsetAsync((char*)d_ws + WS_CTL, 0, CTL_ZERO_BYTES, stream);
    Args a{};
    for (int i = 0; i < 26; ++i) a.in[i] = (const float*)d_in[i];
    a.out = (float*)d_out; a.ws = (unsigned char*)d_ws;
    if (N_LAUNCH_MODE == 1) { a.ph_lo = 0; a.ph_hi = N_PHASES; a.li = 0; hipLaunchKernelGGL(fwd_kernel, dim3(grid), dim3(NWAVES * 64), LDS_BYTES, stream, a); }
    else { for (int p = 0; p < N_PHASES; ++p) { a.ph_lo = p; a.ph_hi = p + 1; a.li = 0; hipLaunchKernelGGL(fwd_kernel, dim3(grid), dim3(NWAVES * 64), LDS_BYTES, stream, a); } }
}
```

```cpp
#include <hip/hip_runtime.h>
#include <cstdio>
#include <cstdint>
namespace pg8 {
#define PG8_LAS __attribute__((address_space(3)))
typedef unsigned short bf16_t;
typedef short bf16x8 __attribute__((ext_vector_type(8)));
typedef float f32x4 __attribute__((ext_vector_type(4)));
typedef unsigned u32x4 __attribute__((ext_vector_type(4)));
constexpr int BM = 256, BK = 64, HALF = 128, HTB = HALF * BK * 2  , STAGE_BYTES = 8 * HTB, NXCD = 8, WGM = 8;

__host__ __device__ __forceinline__ int lds_byte(int r, int c) { const int st = (r >> 4) * 2 + (c >> 5), rr = r & 15, cc = c & 31, ob = rr * 64 + cc * 2; return st * 1024 + (ob ^ (((ob >> 9) & 1) << 5)); }
__host__ __device__ __forceinline__ void stage_rc(int b, int& R, int& C) { const int st = b / 1024, sb = b % 1024, swz = sb ^ (((sb >> 9) & 1) << 5); R = (st >> 1) * 16 + swz / 64; C = (st & 1) * 32 + (swz % 64) / 2; }
__host__ __device__ __forceinline__ int perm32(int rho) { const int n = rho >> 4, i = rho & 15; return 8 * (i >> 2) + 4 * n + (i & 3); }

struct Unit { int pm, pn; };
struct Gemm { const bf16_t* A; const bf16_t* Bt; int M, N, K; };

struct StaticOrder {
    int nM, nN, nwg, G, c;
    __host__ __device__ void init(int M, int N, int G_, int c_) { nM = M / BM; nN = N / BM; nwg = nM * nN; G = G_; c = c_; }
    __host__ __device__ bool next(int i, Unit& u) const {
        const long L = (long)i * G + c; if (L >= nwg) return false;
        int wgid = (int)L; { const int q = nwg / NXCD, r = nwg % NXCD, xcd = wgid % NXCD, off = wgid / NXCD; wgid = (xcd < r ? xcd * (q + 1) : r * (q + 1) + (xcd - r) * q) + off; }
        const int nig = WGM * nN, gid = wgid / nig, fm = gid * WGM, gsz = (nM - fm) < WGM ? (nM - fm) : WGM;
        u.pm = fm + ((wgid % nig) % gsz); u.pn = (wgid % nig) / gsz; return true;
    }
    __device__ __forceinline__ void a_ready(const Unit&) const {}
    __device__ __forceinline__ void done(const Unit&) const {}
};

typedef float f32x2 __attribute__((ext_vector_type(2)));
typedef __bf16 bf16x2_t __attribute__((ext_vector_type(2)));
__device__ __forceinline__ unsigned cvt_pk_bf16(float lo, float hi) { f32x2 v = {lo, hi}; bf16x2_t b = __builtin_convertvector(v, bf16x2_t); return __builtin_bit_cast(unsigned, b); }
__device__ __forceinline__ bf16_t cvt_bf16(float x) { return (bf16_t)(cvt_pk_bf16(x, 0.f) & 0xffffu); }

struct EpiSplitT {
    static constexpr bool PERM = true, AFTER_DRAIN = false;
    bf16_t* O; int ldc; int ncols_rm; bf16_t* T; int NT; int rpb;
    __device__ __forceinline__ void operator()(const f32x4 (&acc)[2][2][4][2], const Unit& u, int wr, int wc, int fr, int fq) const {
        const int row0 = u.pm * BM + wr * 64 + fr; const int colt = u.pn * BM;
        if (colt < ncols_rm) {
            const int col0 = colt + wc * 32 + 8 * fq;
#pragma unroll
            for (int ai = 0; ai < 2; ++ai)
#pragma unroll
                for (int m = 0; m < 4; ++m) { bf16_t* rowp = O + (size_t)(row0 + ai * HALF + m * 16) * ldc + col0;
#pragma unroll
                    for (int bj = 0; bj < 2; ++bj) { const f32x4 v0 = acc[ai][bj][m][0], v1 = acc[ai][bj][m][1];
                        u32x4 w; w.x = cvt_pk_bf16(v0[0], v0[1]); w.y = cvt_pk_bf16(v0[2], v0[3]); w.z = cvt_pk_bf16(v1[0], v1[1]); w.w = cvt_pk_bf16(v1[2], v1[3]);
                        *(u32x4*)(rowp + bj * HALF) = w; } }
        } else {
            const int c0 = colt - ncols_rm + wc * 32 + 8 * fq;
#pragma unroll
            for (int ai = 0; ai < 2; ++ai)
#pragma unroll
                for (int m = 0; m < 4; ++m) { const int row = row0 + ai * HALF + m * 16; const int b = row / rpb, t = row - b * rpb; bf16_t* base = T + (size_t)b * NT * rpb + t;
#pragma unroll
                    for (int bj = 0; bj < 2; ++bj)
#pragma unroll
                        for (int n = 0; n < 2; ++n)
#pragma unroll
                            for (int e = 0; e < 4; ++e) base[(size_t)(c0 + bj * HALF + 4 * n + e) * rpb] = cvt_bf16(acc[ai][bj][m][n][e]); }
        }
    }
};
template <bool BASE_BF16> struct EpiResid {
    static constexpr bool PERM = true, AFTER_DRAIN = false;
    const void* base; bf16_t* xb; float* ssq; int ldc;
    __device__ __forceinline__ void operator()(const f32x4 (&acc)[2][2][4][2], const Unit& u, int wr, int wc, int fr, int fq) const {
        const int row0 = u.pm * BM + wr * 64 + fr; const int col0 = u.pn * BM + wc * 32 + 8 * fq;
#pragma unroll
        for (int ai = 0; ai < 2; ++ai)
#pragma unroll
            for (int m = 0; m < 4; ++m) { const int row = row0 + ai * HALF + m * 16; float s = 0.f;
#pragma unroll
                for (int bj = 0; bj < 2; ++bj) { const size_t off = (size_t)row * ldc + col0 + bj * HALF;
                    f32x4 b0, b1;
                    if (BASE_BF16) { const u32x4 w = *(const u32x4*)((const bf16_t*)base + off);
                        b0 = (f32x4){__uint_as_float(w.x << 16), __uint_as_float(w.x & 0xffff0000u), __uint_as_float(w.y << 16), __uint_as_float(w.y & 0xffff0000u)};
                        b1 = (f32x4){__uint_as_float(w.z << 16), __uint_as_float(w.z & 0xffff0000u), __uint_as_float(w.w << 16), __uint_as_float(w.w & 0xffff0000u)}; }
                    else { b0 = *(const f32x4*)((const float*)base + off); b1 = *(const f32x4*)((const float*)base + off + 4); }
                    const f32x4 v0 = acc[ai][bj][m][0] + b0, v1 = acc[ai][bj][m][1] + b1;
                    s += (v0[0] * v0[0] + v0[1] * v0[1]) + (v0[2] * v0[2] + v0[3] * v0[3]) + (v1[0] * v1[0] + v1[1] * v1[1]) + (v1[2] * v1[2] + v1[3] * v1[3]);
                    u32x4 w; w.x = cvt_pk_bf16(v0[0], v0[1]); w.y = cvt_pk_bf16(v0[2], v0[3]); w.z = cvt_pk_bf16(v1[0], v1[1]); w.w = cvt_pk_bf16(v1[2], v1[3]);
                    *(u32x4*)(xb + off) = w; }
                s += __shfl_xor(s, 16); s += __shfl_xor(s, 32);
                if (fq == 0) ssq[(size_t)row * 16 + u.pn * 4 + wc] = s; }
    }
};
struct EpiRowScale {
    static constexpr bool PERM = true, AFTER_DRAIN = false;
    bf16_t* O; int ldc; const float* ssq; float inv_n, eps;
    __device__ __forceinline__ void operator()(const f32x4 (&acc)[2][2][4][2], const Unit& u, int wr, int wc, int fr, int fq) const {
        const int row0 = u.pm * BM + wr * 64 + fr; const int col0 = u.pn * BM + wc * 32 + 8 * fq;
#pragma unroll
        for (int ai = 0; ai < 2; ++ai)
#pragma unroll
            for (int m = 0; m < 4; ++m) { const int row = row0 + ai * HALF + m * 16; const f32x4* sp = (const f32x4*)(ssq + (size_t)row * 16);
                const f32x4 s0 = sp[0], s1 = sp[1], s2 = sp[2], s3 = sp[3]; const f32x4 st = (s0 + s1) + (s2 + s3);
                const float r = 1.0f / sqrtf(((st[0] + st[1]) + (st[2] + st[3])) * inv_n + eps);
                bf16_t* rowp = O + (size_t)row * ldc + col0;
#pragma unroll
                for (int bj = 0; bj < 2; ++bj) { const f32x4 v0 = acc[ai][bj][m][0] * r, v1 = acc[ai][bj][m][1] * r;
                    u32x4 w; w.x = cvt_pk_bf16(v0[0], v0[1]); w.y = cvt_pk_bf16(v0[2], v0[3]); w.z = cvt_pk_bf16(v1[0], v1[1]); w.w = cvt_pk_bf16(v1[2], v1[3]);
                    *(u32x4*)(rowp + bj * HALF) = w; } }
    }
};
struct OneUnit {
    int idx, nM, nN;
    __device__ __forceinline__ bool next(int i, Unit& u) const { if (i > 0 || idx < 0 || idx >= nM * nN) return false; u.pm = idx % nM; u.pn = idx / nM; return true; }
    __device__ __forceinline__ void a_ready(const Unit&) const {}
    __device__ __forceinline__ void done(const Unit&) const {}
};

template <class Epi, class Sched, bool ALIGN_EPI = false, bool SP2 = false>
__device__ __forceinline__ void gemm_phase(PG8_LAS unsigned char* lds, const Gemm g, const Sched& S, const Epi& E) {
    const int tid = threadIdx.x, wid = __builtin_amdgcn_readfirstlane(tid >> 6), lane = tid & 63, wr = wid >> 2, wc = wid & 3, fr = lane & 15, fq = lane >> 4;
    const int K = g.K, nt = K / BK;
    unsigned voffA[2], voffB[2];
#pragma unroll
    for (int i = 0; i < 2; ++i) { int R, C; stage_rc(tid * 16 + i * 8192, R, C); const int Rb = Epi::PERM ? ((R & ~31) + perm32(R & 31)) : R;
        voffA[i] = (unsigned)(R * K + C) * 2u; voffB[i] = (unsigned)(Rb * K + C) * 2u; }
    const size_t kstep = (size_t)(BK * 2);
    const size_t hstep = (size_t)HALF * K * 2;
    const size_t tstep = 2 * hstep;
    const unsigned ldsw = (unsigned)wid * 1024u;
    const int aoff = lds_byte(wr * 64 + fr, fq * 8), boff = lds_byte(wc * 32 + fr, fq * 8);
#define PG8_SA(b, h) (((b) * 2 + (h)) * HTB)
#define PG8_SB(b, h) ((4 + (b) * 2 + (h)) * HTB)
#define PG8_STAGE(bufoff, gbase, voff) do { _Pragma("unroll") for (int _i = 0; _i < 2; ++_i) \
        __builtin_amdgcn_global_load_lds((const unsigned*)((const char*)(gbase) + (voff)[_i]), (PG8_LAS unsigned*)(lds + (bufoff) + ldsw + _i * 8192), 16, 0, 0); } while (0)
#define PG8_LDA(dst, b, h) do { _Pragma("unroll") for (int m = 0; m < 4; ++m) _Pragma("unroll") for (int k = 0; k < 2; ++k) dst[m][k] = *(const PG8_LAS bf16x8*)(lds + PG8_SA(b, h) + aoff + m * 2048 + k * 1024); } while (0)
#define PG8_LDB(dst, b, h) do { _Pragma("unroll") for (int n = 0; n < 2; ++n) _Pragma("unroll") for (int k = 0; k < 2; ++k) dst[n][k] = *(const PG8_LAS bf16x8*)(lds + PG8_SB(b, h) + boff + n * 2048 + k * 1024); } while (0)
#define PG8_MMA(ai, bj, At, Bt) do { __builtin_amdgcn_s_setprio(1); _Pragma("unroll") for (int m = 0; m < 4; ++m) _Pragma("unroll") for (int n = 0; n < 2; ++n) _Pragma("unroll") for (int k = 0; k < 2; ++k) \
        acc[ai][bj][m][n] = __builtin_amdgcn_mfma_f32_16x16x32_bf16(Bt[n][k], At[m][k], acc[ai][bj][m][n], 0, 0, 0); __builtin_amdgcn_s_setprio(0); } while (0)
#define PG8_WAIT_V(n) asm volatile("s_waitcnt vmcnt(" #n ")" ::: "memory")
#define PG8_WAIT_L(n) asm volatile("s_waitcnt lgkmcnt(" #n ")" ::: "memory")
#define PG8_BAR __builtin_amdgcn_s_barrier()
#define PG8_SCHED __builtin_amdgcn_sched_barrier(0)
    Unit cur, nxt; int ui = 0;
    if (!S.next(0, cur)) return;
    f32x4 acc[2][2][4][2];
#pragma unroll
    for (int a = 0; a < 2; ++a)
#pragma unroll
        for (int b = 0; b < 2; ++b)
#pragma unroll
            for (int m = 0; m < 4; ++m)
#pragma unroll
                for (int n = 0; n < 2; ++n) acc[a][b][m][n] = (f32x4){0.f, 0.f, 0.f, 0.f};
    bf16x8 At[4][2], B0[2][2], B1[2][2];
    const char* cA = (const char*)g.A + (size_t)cur.pm * tstep; const char* cB = (const char*)g.Bt + (size_t)cur.pn * tstep;
    S.a_ready(cur);
    if constexpr (SP2) {
        PG8_STAGE(PG8_SB(0, 0), cB, voffB); PG8_STAGE(PG8_SB(0, 1), cB + hstep, voffB); PG8_STAGE(PG8_SA(0, 0), cA, voffA); PG8_STAGE(PG8_SA(0, 1), cA + hstep, voffA);
        if (wr == 1) PG8_BAR;
        PG8_WAIT_V(2); PG8_BAR;
        PG8_STAGE(PG8_SB(1, 0), cB + kstep, voffB); PG8_STAGE(PG8_SA(1, 0), cA + kstep, voffA); PG8_STAGE(PG8_SB(1, 1), cB + hstep + kstep, voffB);
        PG8_WAIT_V(6); PG8_BAR;
    } else {
        PG8_STAGE(PG8_SB(0, 0), cB, voffB); PG8_STAGE(PG8_SA(0, 0), cA, voffA); PG8_STAGE(PG8_SB(0, 1), cB + hstep, voffB); PG8_STAGE(PG8_SA(0, 1), cA + hstep, voffA);
        if (wr == 1) PG8_BAR;
        PG8_WAIT_V(4); PG8_BAR;
        PG8_STAGE(PG8_SB(1, 0), cB + kstep, voffB); PG8_STAGE(PG8_SA(1, 0), cA + kstep, voffA); PG8_STAGE(PG8_SB(1, 1), cB + hstep + kstep, voffB);
        PG8_WAIT_V(6); PG8_BAR;
    }
    for (;;) {
        const bool has_next = S.next(ui + 1, nxt);
        const char* nA = has_next ? (const char*)g.A + (size_t)nxt.pm * tstep : cA; const char* nB = has_next ? (const char*)g.Bt + (size_t)nxt.pn * tstep : cB;
        for (int t = 0; t < nt; t += 2) {
            const bool last = (t == nt - 2);
            const char* a1 = cA + (size_t)(t + 1) * kstep;
            const char* a2 = last ? nA : cA + (size_t)(t + 2) * kstep; const char* b2 = last ? nB : cB + (size_t)(t + 2) * kstep;
            const char* a3 = a2 + kstep; const char* b3 = b2 + kstep;
            if (last && has_next) S.a_ready(nxt);
            if constexpr (SP2) {
            PG8_LDB(B0, 0, 0); PG8_LDB(B1, 0, 1); PG8_SCHED; PG8_LDA(At, 0, 0); PG8_STAGE(PG8_SA(1, 1), a1 + hstep, voffA);
            PG8_WAIT_V(8); PG8_WAIT_L(0); PG8_BAR; PG8_MMA(0, 0, At, B0); PG8_MMA(0, 1, At, B1); PG8_BAR; PG8_SCHED;
            PG8_LDA(At, 0, 1); PG8_STAGE(PG8_SB(0, 0), b2, voffB); PG8_STAGE(PG8_SB(0, 1), b2 + hstep, voffB); PG8_STAGE(PG8_SA(0, 0), a2, voffA);
            PG8_WAIT_V(8); PG8_WAIT_L(0); PG8_BAR; PG8_MMA(1, 0, At, B0); PG8_MMA(1, 1, At, B1); PG8_BAR; PG8_SCHED;
            PG8_LDB(B0, 1, 0); PG8_LDB(B1, 1, 1); PG8_SCHED; PG8_LDA(At, 1, 0); PG8_STAGE(PG8_SA(0, 1), a2 + hstep, voffA);
            PG8_WAIT_V(8); PG8_WAIT_L(0); PG8_BAR; PG8_MMA(0, 0, At, B0); PG8_MMA(0, 1, At, B1); PG8_BAR; PG8_SCHED;
            PG8_LDA(At, 1, 1); PG8_STAGE(PG8_SB(1, 0), b3, voffB); PG8_STAGE(PG8_SB(1, 1), b3 + hstep, voffB); PG8_STAGE(PG8_SA(1, 0), a3, voffA);
            PG8_WAIT_V(8); PG8_WAIT_L(0); PG8_BAR; PG8_MMA(1, 0, At, B0); PG8_MMA(1, 1, At, B1); PG8_BAR; PG8_SCHED;
            } else {
            PG8_LDB(B0, 0, 0); PG8_SCHED; PG8_LDA(At, 0, 0); PG8_STAGE(PG8_SA(1, 1), a1 + hstep, voffA);
            PG8_WAIT_L(8); PG8_BAR; PG8_WAIT_L(0); PG8_MMA(0, 0, At, B0); PG8_BAR; PG8_SCHED;
            PG8_LDB(B1, 0, 1); PG8_STAGE(PG8_SB(0, 0), b2, voffB);
            PG8_BAR; PG8_WAIT_L(0); PG8_MMA(0, 1, At, B1); PG8_BAR;
            PG8_LDA(At, 0, 1); PG8_STAGE(PG8_SA(0, 0), a2, voffA);
            PG8_BAR; PG8_WAIT_L(0); PG8_MMA(1, 0, At, B0); PG8_BAR; PG8_SCHED;
            PG8_STAGE(PG8_SB(0, 1), b2 + hstep, voffB);
            PG8_WAIT_V(6); PG8_BAR; PG8_MMA(1, 1, At, B1); PG8_BAR;
            PG8_LDB(B0, 1, 0); PG8_SCHED; PG8_LDA(At, 1, 0); PG8_STAGE(PG8_SA(0, 1), a2 + hstep, voffA);
            PG8_WAIT_L(8); PG8_BAR; PG8_WAIT_L(0); PG8_MMA(0, 0, At, B0); PG8_BAR; PG8_SCHED;
            PG8_LDB(B1, 1, 1); PG8_STAGE(PG8_SB(1, 0), b3, voffB);
            PG8_BAR; PG8_WAIT_L(0); PG8_MMA(0, 1, At, B1); PG8_BAR;
            PG8_LDA(At, 1, 1); PG8_STAGE(PG8_SA(1, 0), a3, voffA);
            PG8_BAR; PG8_WAIT_L(0); PG8_MMA(1, 0, At, B0); PG8_BAR; PG8_SCHED;
            PG8_STAGE(PG8_SB(1, 1), b3 + hstep, voffB);
            PG8_WAIT_V(6); PG8_BAR; PG8_MMA(1, 1, At, B1); PG8_BAR;
            }
        }
        if constexpr (ALIGN_EPI) { if (wr == 0) PG8_BAR; }
        if constexpr (!Epi::AFTER_DRAIN) { E(acc, cur, wr, wc, fr, fq); S.done(cur); }
        if (!has_next) break;
#pragma unroll
        for (int a = 0; a < 2; ++a)
#pragma unroll
            for (int b = 0; b < 2; ++b)
#pragma unroll
                for (int m = 0; m < 4; ++m)
#pragma unroll
                    for (int n = 0; n < 2; ++n) acc[a][b][m][n] = (f32x4){0.f, 0.f, 0.f, 0.f};
        cur = nxt; cA = nA; cB = nB; ++ui;
        if constexpr (ALIGN_EPI) { if (wr == 1) PG8_BAR; }
    }
    PG8_WAIT_V(0);
    if constexpr (!ALIGN_EPI) { if (wr == 0) PG8_BAR; }
    PG8_BAR;
    if constexpr (Epi::AFTER_DRAIN) { E.fused(acc, cur, wr, wc, fr, fq, lds, wid, lane); S.done(cur); }
#undef PG8_SA
#undef PG8_SB
#undef PG8_STAGE
#undef PG8_LDA
#undef PG8_LDB
#undef PG8_MMA
#undef PG8_WAIT_V
#undef PG8_WAIT_L
#undef PG8_BAR
#undef PG8_SCHED
}
}

#ifndef PG8_SP2
#define PG8_SP2 true
#endif
#ifndef PG8_ALIGN
#define PG8_ALIGN true
#endif
constexpr int NWAVES = 8;
constexpr int NBATCH = 2, SEQ = 8192, DM = 1024, M = NBATCH * SEQ;
constexpr int INW = 2560, ZW = 2048;
constexpr int LRUW = 512, ATTW = 512, NCHUNK = SEQ / 64;
constexpr int NEXP = 16384, PEER_H = 8, NSEL = 128;
constexpr float EPS = 1e-6f;
constexpr float LOG2E = 1.4426950408889634f;

constexpr size_t MiB = 1u << 20;
constexpr size_t WS_CTL = 0, CTL_ZERO_BYTES = 64 * 1024;
constexpr size_t WS_WIN = 1 * MiB, WS_WOUT = 6 * MiB, WS_WQ = 8 * MiB, WS_WKV = 10 * MiB, WS_WO = 14 * MiB, WS_WQRY = 16 * MiB;
constexpr size_t WS_SUBK = 20 * MiB, WS_GATEW = 20 * MiB + 512 * 1024, WS_MEMN = 21 * MiB, WS_KM = 22 * MiB, WS_VMT = 23 * MiB, WS_AGG = 24 * MiB, WS_SSQ1 = 25 * MiB, WS_SSQ2 = 26 * MiB, WS_SU = 27 * MiB;
constexpr size_t WS_EU = 28 * MiB, WS_EV = 60 * MiB, WS_XN = 92 * MiB, WS_Z = 124 * MiB, WS_VT = 188 * MiB, WS_Y = 204 * MiB, WS_END = 236 * MiB;
constexpr size_t WS_QC = WS_Z, WS_OC = WS_Z + 32 * MiB, WS_QP = WS_Z, WS_IDX = WS_VT, WS_G = WS_VT + 8 * MiB;
constexpr int CW_BAR = 4096;

constexpr int RING_BYTES = 155648;
constexpr int LDSCTL_OFF = RING_BYTES, MISC_OFF = LDSCTL_OFF + 320;
constexpr int LDS_BYTES = 163840;

#define GAS __attribute__((address_space(1)))
#define LAS __attribute__((address_space(3)))
typedef unsigned short bf16;
typedef unsigned v4u __attribute__((ext_vector_type(4)));
typedef unsigned v2u __attribute__((ext_vector_type(2)));
typedef float f32x4 __attribute__((ext_vector_type(4)));
typedef float f32x2 __attribute__((ext_vector_type(2)));
typedef float f32x16 __attribute__((ext_vector_type(16)));
typedef short bf16x8 __attribute__((ext_vector_type(8)));
typedef __bf16 bf16x2_t __attribute__((ext_vector_type(2)));
typedef GAS unsigned gu32;
typedef _Float16 v32h __attribute__((ext_vector_type(32)));
typedef unsigned v6u __attribute__((ext_vector_type(6)));
typedef _Float16 f16x2_t __attribute__((ext_vector_type(2)));
constexpr int EV_ROW = 768;
#define RLX_AGENT __ATOMIC_RELAXED, __HIP_MEMORY_SCOPE_AGENT
#define LDS_WAIT() asm volatile("s_waitcnt lgkmcnt(0)" ::: "memory")
#define VM_WAIT() asm volatile("s_waitcnt vmcnt(0)" ::: "memory")
#define MFMA32(a, b, c) __builtin_amdgcn_mfma_f32_32x32x16_bf16((a), (b), (c), 0, 0, 0)
#define DI __device__ __forceinline__

DI unsigned pk2(float lo, float hi) { f32x2 v = {lo, hi}; bf16x2_t b = __builtin_convertvector(v, bf16x2_t); return __builtin_bit_cast(unsigned, b); }
DI bf16 f2bf(float x) { return (bf16)(pk2(x, 0.f) & 0xffffu); }
DI float bf2f(bf16 x) { return __uint_as_float((unsigned)x << 16); }
DI float bflo(unsigned p) { return __uint_as_float(p << 16); }
DI float bfhi(unsigned p) { return __uint_as_float(p & 0xffff0000u); }
DI int crow(int reg, int hh) { return (reg & 3) + 8 * (reg >> 2) + 4 * hh; }
DI float swap32_partner(float x, int hh) { auto rr = __builtin_amdgcn_permlane32_swap(__float_as_uint(x), __float_as_uint(x), false, false); return __uint_as_float(hh ? rr[0] : rr[1]); }
DI float dpp_xor1(float x) { return __int_as_float(__builtin_amdgcn_update_dpp(0, __float_as_int(x), 0xB1, 0xf, 0xf, true)); }
DI float dpp_xor2(float x) { return __int_as_float(__builtin_amdgcn_update_dpp(0, __float_as_int(x), 0x4E, 0xf, 0xf, true)); }
DI float dpp_hmir(float x) { return __int_as_float(__builtin_amdgcn_update_dpp(0, __float_as_int(x), 0x141, 0xf, 0xf, true)); }
DI float dpp_mir(float x)  { return __int_as_float(__builtin_amdgcn_update_dpp(0, __float_as_int(x), 0x140, 0xf, 0xf, true)); }
DI float sum16(float x) { x += dpp_xor1(x); x += dpp_xor2(x); x += dpp_hmir(x); x += dpp_mir(x); return x; }
DI float sum32(float x) { x = sum16(x); auto rr = __builtin_amdgcn_permlane16_swap(__float_as_uint(x), __float_as_uint(x), false, false); return __uint_as_float(rr[0]) + __uint_as_float(rr[1]); }
DI float max16(float x) { x = fmaxf(x, dpp_xor1(x)); x = fmaxf(x, dpp_xor2(x)); x = fmaxf(x, dpp_hmir(x)); x = fmaxf(x, dpp_mir(x)); return x; }
DI float max64(float x) { x = max16(x); { auto rr = __builtin_amdgcn_permlane16_swap(__float_as_uint(x), __float_as_uint(x), false, false); x = fmaxf(__uint_as_float(rr[0]), __uint_as_float(rr[1])); }
    { auto rr = __builtin_amdgcn_permlane32_swap(__float_as_uint(x), __float_as_uint(x), false, false); x = fmaxf(__uint_as_float(rr[0]), __uint_as_float(rr[1])); } return x; }
DI unsigned pack_i8x4(float a, float b, float c, float d) { const int ia = (int)__builtin_rintf(a), ib = (int)__builtin_rintf(b), ic = (int)__builtin_rintf(c), id = (int)__builtin_rintf(d);
    return (unsigned)(ia & 255) | ((unsigned)(ib & 255) << 8) | ((unsigned)(ic & 255) << 16) | ((unsigned)id << 24); }
DI float max32(float x) { x = max16(x); auto rr = __builtin_amdgcn_permlane16_swap(__float_as_uint(x), __float_as_uint(x), false, false); return fmaxf(__uint_as_float(rr[0]), __uint_as_float(rr[1])); }
DI float sum64(float x) { x = sum32(x); auto rr = __builtin_amdgcn_permlane32_swap(__float_as_uint(x), __float_as_uint(x), false, false); return __uint_as_float(rr[0]) + __uint_as_float(rr[1]); }
DI float rcp_(float x) { return __builtin_amdgcn_rcpf(x); }
DI float rsq_(float x) { return __builtin_amdgcn_rsqf(x); }
DI float exp2_(float x) { return __builtin_amdgcn_exp2f(x); }
DI float gelu_tanh(float x) { const float u = x * (1.5957691216057308f + 0.07135481627159768f * x * x); return x * rcp_(1.0f + exp2_(-LOG2E * u)); }
DI float sigmoidf_(float x) { return rcp_(1.0f + exp2_(-LOG2E * x)); }
#define XB_TMO      128
#define XB_XCNT(j)  (256  + 64 * (j))
#define XB_XSUB(j)  (1280 + 64 * (j))
#define XB_XGEN(j)  (2304 + 64 * (j))
#define XB_TOP      3328
#define XB_TOPGEN   3392
#define XCD_BAR_WORDS 3456
#define XB_SPIN_CAP (1u << 18)

__device__ __forceinline__ unsigned xb_ld(unsigned* p)              { return __hip_atomic_load(p, __ATOMIC_RELAXED, __HIP_MEMORY_SCOPE_AGENT); }
__device__ __forceinline__ unsigned xb_add(unsigned* p, unsigned v) { return __hip_atomic_fetch_add(p, v, __ATOMIC_RELAXED, __HIP_MEMORY_SCOPE_AGENT); }
__device__ __forceinline__ unsigned xb_xcc_id() { return (unsigned)__builtin_amdgcn_s_getreg((3 << 11) | 20) & 0xFu; }
#define XB_SPIN(cond, bar) do { unsigned _sp = 0; while (cond) { __builtin_amdgcn_s_sleep(1); \
    if ((++_sp & 255u) == 0u) { if (xb_ld(&(bar)[XB_TMO])) break; if (_sp > XB_SPIN_CAP) { atomicAdd(&(bar)[XB_TMO], 1u); break; } } } } while (0)

struct XcdBarrier {
    unsigned* bar; unsigned x;
    volatile LAS unsigned* st;
};

__device__ __forceinline__ XcdBarrier xcd_barrier_post(unsigned* bar, volatile LAS unsigned* st) {
    XcdBarrier b; b.bar = bar; b.x = xb_xcc_id(); b.st = st;
    if (threadIdx.x == 0) (void)xb_add(&bar[XB_XCNT(b.x)], 1u);
    return b;
}
__device__ __forceinline__ void xcd_barrier_complete(unsigned* bar, unsigned x, unsigned& nloc, unsigned& nx) {
    const unsigned G = gridDim.x * gridDim.y * gridDim.z;
    unsigned sum, cnt, mine, sp = 0u;
    for (;;) {
        sum = 0u; cnt = 0u; mine = 0u;
#pragma unroll
        for (unsigned j = 0; j < 16; ++j) { const unsigned c = xb_ld(&bar[XB_XCNT(j)]); sum += c; cnt += (c > 0u) ? 1u : 0u; mine = (j == x) ? c : mine; }
        if (sum == G) break;
        __builtin_amdgcn_s_sleep(1);
        if ((++sp & 255u) == 0u) { if (xb_ld(&bar[XB_TMO])) break; if (sp > XB_SPIN_CAP) { atomicAdd(&bar[XB_TMO], 1u); break; } }
    }
    nloc = mine > 0u ? mine : 1u; nx = cnt > 0u ? cnt : 1u;
}

__device__ __forceinline__ void xcd_barrier(const XcdBarrier& b) {
    asm volatile("s_waitcnt vmcnt(0)" ::: "memory");
    __syncthreads();
    if (threadIdx.x == 0) {
        unsigned* bar = b.bar;
        __builtin_amdgcn_s_waitcnt(0);
        unsigned nloc = b.st[0], nx = b.st[1];
        if (nloc == 0u) { xcd_barrier_complete(bar, b.x, nloc, nx); b.st[0] = nloc; b.st[1] = nx; }
        const unsigned old = xb_add(&bar[XB_XSUB(b.x)], 1u);
        const unsigned gen = old / nloc;
        if (old + 1u == (gen + 1u) * nloc) {
            __builtin_amdgcn_fence(__ATOMIC_RELEASE, "agent");
            asm volatile("s_waitcnt vmcnt(0)" ::: "memory");
            const unsigned og = xb_add(&bar[XB_TOP], 1u);
            const unsigned tg = og / nx;
            if (og + 1u == (tg + 1u) * nx) xb_add(&bar[XB_TOPGEN], 1u);
            else XB_SPIN(xb_ld(&bar[XB_TOPGEN]) == tg, bar);
            __builtin_amdgcn_fence(__ATOMIC_ACQUIRE, "agent");
            xb_add(&bar[XB_XGEN(b.x)], 1u);
            asm volatile("s_waitcnt vmcnt(0)" ::: "memory");
        } else {
            XB_SPIN(xb_ld(&bar[XB_XGEN(b.x)]) == gen, bar);
            __builtin_amdgcn_fence(__ATOMIC_ACQUIRE, "agent");
            asm volatile("s_waitcnt vmcnt(0)" ::: "memory");
        }
    }
    __syncthreads();
}
struct Args { const float* in[26]; float* out; unsigned char* ws; int ph_lo, ph_hi, li, pad; };
struct Frame {
    LAS unsigned char* lds;
    volatile LAS unsigned* MISC;
    gu32* ctl;
    int tid, lane, wave, vcu, G;
    const Args* A; float* out; unsigned char* ws;
    DI const float* in(int k) const { return A->in[k]; }
    template <class T> DI T* wsp(size_t off) const { return (T*)(ws + off); }
};

DI void p0_transpose_item(const float* W, int K, int N, bf16* WT, LAS float* scr, int item, int lane, const float* g0, const float* g1, int gsplit) {
    const int nblk = N / 32, kb = item / nblk, nb = item % nblk, k0 = 64 * kb, n0 = 32 * nb;
    float wv[32], gv[32];
#pragma unroll
    for (int i = 0; i < 32; ++i) { const int k = k0 + 2 * i + (lane >> 5); wv[i] = W[(size_t)k * N + n0 + (lane & 31)]; gv[i] = g0 ? ((k < gsplit) ? g0[k] : g1[k - gsplit]) : 1.f; }
#pragma unroll
    for (int i = 0; i < 32; ++i) scr[(2 * i + (lane >> 5)) * 33 + (lane & 31)] = wv[i] * gv[i];
    LDS_WAIT(); asm volatile("" ::: "memory");
    const int c = lane & 7;
#pragma unroll
    for (int j = 0; j < 4; ++j) { const int n = (lane >> 3) + 8 * j; const LAS float* s = scr + (8 * c) * 33 + n;
        v4u o; o.x = pk2(s[0 * 33], s[1 * 33]); o.y = pk2(s[2 * 33], s[3 * 33]); o.z = pk2(s[4 * 33], s[5 * 33]); o.w = pk2(s[6 * 33], s[7 * 33]);
        *(GAS v4u*)(WT + (size_t)(n0 + n) * K + k0 + 8 * c) = o; }
    LDS_WAIT(); asm volatile("" ::: "memory");
}
template <bool NORM> DI void row_to_bf16(const float* xrow, bf16* orow, const float* gain, int lane) {
    const GAS f32x4* xr = (const GAS f32x4*)xrow + lane;
    f32x4 v[4]; float s = 0.f;
#pragma unroll
    for (int j = 0; j < 4; ++j) { v[j] = xr[64 * j]; s += (v[j].x * v[j].x + v[j].y * v[j].y) + (v[j].z * v[j].z + v[j].w * v[j].w); }
    float rstd = 1.f;
    if (NORM) rstd = 1.0f / sqrtf(sum64(s) * (1.f / 1024.f) + EPS);
    GAS v2u* o8 = (GAS v2u*)orow + lane;
#pragma unroll
    for (int j = 0; j < 4; ++j) { f32x4 w = v[j] * rstd; if (gain) w = w * ((const GAS f32x4*)gain)[64 * j + lane];
        v2u o; o.x = pk2(w.x, w.y); o.y = pk2(w.z, w.w); o8[64 * j] = o; }
}
constexpr float U_SCALE = 128.f, V_SCALE = 16.f;
template <bool NORM, int NB> DI void rows_to_bf16(const float* xrow, bf16* orow, size_t row_stride, const float* gain, int lane) {
    f32x4 v[NB][4];
#pragma unroll
    for (int b = 0; b < NB; ++b)
#pragma unroll
        for (int j = 0; j < 4; ++j) v[b][j] = ((const GAS f32x4*)(xrow + b * row_stride))[64 * j + lane];
#pragma unroll
    for (int b = 0; b < NB; ++b) { float s = 0.f;
#pragma unroll
        for (int j = 0; j < 4; ++j) s += (v[b][j].x * v[b][j].x + v[b][j].y * v[b][j].y) + (v[b][j].z * v[b][j].z + v[b][j].w * v[b][j].w);
        float rstd = 1.f; if (NORM) rstd = rsq_(sum64(s) * (1.f / 1024.f) + EPS);
        GAS v2u* o8 = (GAS v2u*)(orow + b * row_stride) + lane;
#pragma unroll
        for (int j = 0; j < 4; ++j) { f32x4 w = v[b][j] * rstd; if (gain) w = w * ((const GAS f32x4*)gain)[64 * j + lane];
            v2u o; o.x = pk2(w.x, w.y); o.y = pk2(w.z, w.w); o8[64 * j] = o; } }
}
DI void row_to_fp8(const float* src, unsigned char* dst, const float* gain, float scale, int lane) {
#pragma unroll
    for (int j = 0; j < 4; ++j) { f32x4 v = ((const GAS f32x4*)src)[64 * j + lane] * scale; if (gain) v = v * ((const GAS f32x4*)gain)[64 * j + lane];
        unsigned w = 0u; w = __builtin_amdgcn_cvt_pk_fp8_f32(v.x, v.y, w, false); w = __builtin_amdgcn_cvt_pk_fp8_f32(v.z, v.w, w, true);
        ((GAS unsigned*)dst)[64 * j + lane] = w; }
}
DI void row_to_i8(const float* src, unsigned char* dst, const float* gain, float* scale_out, int lane) {
    f32x4 v[4]; float mx = 0.f;
#pragma unroll
    for (int j = 0; j < 4; ++j) { v[j] = ((const GAS f32x4*)src)[64 * j + lane] * ((const GAS f32x4*)gain)[64 * j + lane];
        mx = fmaxf(fmaxf(mx, fmaxf(fabsf(v[j].x), fabsf(v[j].y))), fmaxf(fabsf(v[j].z), fabsf(v[j].w))); }
    mx = fmaxf(max64(mx), 1e-30f);
    const float inv = 127.0f / mx;
#pragma unroll
    for (int j = 0; j < 4; ++j) ((GAS unsigned*)dst)[64 * j + lane] = pack_i8x4(v[j].x * inv, v[j].y * inv, v[j].z * inv, v[j].w * inv);
    if (lane == 0) *scale_out = mx * (1.0f / 127.0f);
}
DI void convert_experts(Frame& F, int wv, int nwv) {
    const int lane = F.lane;
    const int l5 = lane & 31, hh = lane >> 5;
    for (int m = wv * 2; m < NEXP; m += nwv * 2) {
        f32x4 u[2][4], v[8];
#pragma unroll
        for (int b = 0; b < 2; ++b)
#pragma unroll
            for (int j = 0; j < 4; ++j) u[b][j] = ((const GAS f32x4*)(F.in(23) + (size_t)(m + b) * DM))[64 * j + lane];
#pragma unroll
        for (int j = 0; j < 8; ++j) v[j] = ((const GAS f32x4*)(F.in(24) + (size_t)(m + hh) * DM))[32 * j + l5];
#pragma unroll
        for (int b = 0; b < 2; ++b) {
            float mx = 0.f;
#pragma unroll
            for (int j = 0; j < 4; ++j) { u[b][j] = u[b][j] * ((const GAS f32x4*)F.in(20))[64 * j + lane];
                mx = fmaxf(fmaxf(mx, fmaxf(fabsf(u[b][j].x), fabsf(u[b][j].y))), fmaxf(fabsf(u[b][j].z), fabsf(u[b][j].w))); }
            mx = fmaxf(max64(mx), 1e-30f);
            const float inv = 127.0f / mx;
#pragma unroll
            for (int j = 0; j < 4; ++j) ((GAS unsigned*)(F.wsp<unsigned char>(WS_EU) + (size_t)(m + b) * DM))[64 * j + lane] = pack_i8x4(u[b][j].x * inv, u[b][j].y * inv, u[b][j].z * inv, u[b][j].w * inv);
            if (lane == 0) F.wsp<float>(WS_SU)[m + b] = mx * (1.0f / 127.0f);
        }
        {
            float mx = 0.f;
#pragma unroll
            for (int j = 0; j < 8; ++j) mx = fmaxf(fmaxf(mx, fmaxf(fabsf(v[j].x), fabsf(v[j].y))), fmaxf(fabsf(v[j].z), fabsf(v[j].w)));
            mx = fmaxf(max32(mx), 1e-30f);
            const float inv = 7.5f / mx;
            v32h h;
#pragma unroll
            for (int j = 0; j < 8; ++j) { h[4 * j] = (_Float16)(v[j].x * inv); h[4 * j + 1] = (_Float16)(v[j].y * inv); h[4 * j + 2] = (_Float16)(v[j].z * inv); h[4 * j + 3] = (_Float16)(v[j].w * inv); }
            const v6u pk = __builtin_amdgcn_cvt_scalef32_pk32_fp6_f16(h, 1.0f);
            unsigned char* rowp = F.wsp<unsigned char>(WS_EV) + (size_t)(m + hh) * EV_ROW;
            *(GAS v4u*)(rowp + 16 * l5) = (v4u){pk[0], pk[1], pk[2], pk[3]}; *(GAS v2u*)(rowp + 512 + 8 * l5) = (v2u){pk[4], pk[5]};
            if (l5 == 0) F.wsp<float>(WS_SU)[NEXP + m + hh] = mx * (1.0f / 7.5f);
        }
    }
}
DI void p0_prologue(Frame& F, int parts = 7) {
    LAS float* scr = (LAS float*)(F.lds + F.wave * 16384);
    const int gw = F.vcu * NWAVES + F.wave, NGW = F.G * NWAVES, lane = F.lane;
    constexpr int I_IN = 16 * (INW / 32), I_D = 16 * (DM / 32), I_2D = 16 * (2 * DM / 32);
    constexpr int NITEMS = I_IN + 3 * I_D + 2 * I_2D;
    for (int it = gw; it < ((parts & 1) ? NITEMS : 0); it += NGW) {
        int r = it;
        if (r < I_IN) { p0_transpose_item(F.in(3), DM, INW, F.wsp<bf16>(WS_WIN), scr, r, lane, F.in(2), F.in(2), DM); continue; } r -= I_IN;
        if (r < I_D) { p0_transpose_item(F.in(14), DM, DM, F.wsp<bf16>(WS_WOUT), scr, r, lane, F.in(12), F.in(13), LRUW); continue; } r -= I_D;
        if (r < I_D) { p0_transpose_item(F.in(17), DM, DM, F.wsp<bf16>(WS_WQ), scr, r, lane, F.in(15), F.in(15), DM); continue; } r -= I_D;
        if (r < I_2D) { p0_transpose_item(F.in(18), DM, 2 * DM, F.wsp<bf16>(WS_WKV), scr, r, lane, nullptr, nullptr, 0); continue; } r -= I_2D;
        if (r < I_D) { p0_transpose_item(F.in(19), DM, DM, F.wsp<bf16>(WS_WO), scr, r, lane, nullptr, nullptr, 0); continue; } r -= I_D;
        p0_transpose_item(F.in(21), DM, 2 * DM, F.wsp<bf16>(WS_WQRY), scr, r, lane, F.in(20), F.in(20), DM);
    }
    for (int m = gw * 4; m < ((parts & 2) ? M : 0); m += NGW * 4) rows_to_bf16<true, 4>(F.in(0) + (size_t)m * DM, F.wsp<bf16>(WS_XN) + (size_t)m * DM, DM, nullptr, lane);
    for (int m = gw; m < NBATCH * 256; m += NGW) row_to_bf16<true>(F.in(1) + (size_t)m * DM, F.wsp<bf16>(WS_MEMN) + (size_t)m * DM, F.in(16), lane);
    { const int gt = gw * 64 + lane, NT = NGW * 64;
      for (int i = gt; i < 8 * 2 * 128 * 128 / 4; i += NT) { const f32x4 v = ((const GAS f32x4*)F.in(22))[i]; v2u o; o.x = pk2(v.x, v.y); o.y = pk2(v.z, v.w); ((GAS v2u*)F.wsp<bf16>(WS_SUBK))[i] = o; }
      for (int o = gt; o < 2 * 8 * 64 * 64; o += NT) { const int i = o & 63, j = (o >> 6) & 63, h = (o >> 12) & 7, g = o >> 15;
          const float* W = g ? F.in(8) : F.in(6); F.wsp<bf16>(WS_GATEW)[o] = f2bf(W[(h * 64 + i) * 64 + j]); } }
}
struct LruState { float ba[2], bx[2], sp[2], S[2], Ap[2]; };
template <bool PASS2>
DI void lru_prep(const Frame& F, int b, int chunk, int h, int lane, LAS unsigned char* xcs  , LruState& st) {
    const int r = lane & 31, hh = lane >> 5;
    const size_t row0 = (size_t)b * SEQ + (size_t)chunk * 64;
    {
        const int c2 = h * 64 + 2 * r;
        const f32x2 w0 = *(const f32x2*)(F.in(4) + c2), w1 = *(const f32x2*)(F.in(4) + LRUW + c2), w2 = *(const f32x2*)(F.in(4) + 2 * LRUW + c2), w3 = *(const f32x2*)(F.in(4) + 3 * LRUW + c2);
        const f32x2 cb = *(const f32x2*)(F.in(5) + c2);
        const int tl0 = 32 * hh;
        const bf16* zp = F.wsp<bf16>(WS_Z) + (row0 + tl0) * ZW + c2;
        const bool first = (chunk == 0 && hh == 0);
        unsigned p0 = first ? 0u : *(const unsigned*)(zp - 3 * ZW), p1 = first ? 0u : *(const unsigned*)(zp - 2 * ZW), p2 = first ? 0u : *(const unsigned*)(zp - ZW);
#pragma unroll
        for (int t = 0; t < 32; ++t) { const unsigned p3 = *(const unsigned*)(zp + (size_t)t * ZW);
            const float lo = cb.x + bflo(p0) * w0.x + bflo(p1) * w1.x + bflo(p2) * w2.x + bflo(p3) * w3.x;
            const float hi = cb.y + bfhi(p0) * w0.y + bfhi(p1) * w1.y + bfhi(p2) * w2.y + bfhi(p3) * w3.y;
            *(LAS unsigned*)(xcs + (tl0 + t) * 144 + 4 * r) = pk2(lo, hi);
            p0 = p1; p1 = p2; p2 = p3; }
        LDS_WAIT();
    }
#pragma unroll
    for (int nt = 0; nt < 2; ++nt) { const int c = h * 64 + 32 * nt + r; st.ba[nt] = F.in(7)[c]; st.bx[nt] = F.in(9)[c];
        const float nl = -F.in(10)[c]; st.sp[nt] = fmaxf(nl, 0.f) + log1pf(__expf(-fabsf(nl))); st.S[nt] = 0.f; st.Ap[nt] = 1.f; }
    if (PASS2) {
        float s = 0.f; const float* ag = F.wsp<float>(WS_AGG) + ((size_t)b * NCHUNK * LRUW + h * 64 + lane) * 2;
        for (int c0 = 0; c0 < chunk; c0 += 32) {
            f32x2 ab[32];
#pragma unroll
            for (int i = 0; i < 32; ++i) ab[i] = *(const f32x2*)(ag + (size_t)(c0 + i < NCHUNK ? c0 + i : NCHUNK - 1) * LRUW * 2);
#pragma unroll
            for (int i = 0; i < 32; ++i) { const bool on = c0 + i < chunk; s = (on ? ab[i].x : 1.0f) * s + (on ? ab[i].y : 0.0f); }
        }
        st.S[0] = __shfl(s, r); st.S[1] = __shfl(s, 32 + r);
    }
}
template <bool PASS2>
DI void lru_tile(const Frame& F, int b, int chunk, int mt, int h, int lane, LAS unsigned char* xcs, LAS unsigned char* gim  , LruState& st, float (&ssq)[16]) {
    const int r = lane & 31, hh = lane >> 5;
    const size_t row0 = (size_t)b * SEQ + (size_t)chunk * 64;
    const bf16* gw = F.wsp<bf16>(WS_GATEW) + (size_t)h * 4096;
    bf16x8 af[4];
#pragma unroll
    for (int s = 0; s < 4; ++s) af[s] = *(const LAS bf16x8*)(xcs + (32 * mt + r) * 144 + (16 * s + 8 * hh) * 2);
    float ssl[16];
#pragma unroll
    for (int i = 0; i < 16; ++i) ssl[i] = 0.f;
    if (PASS2) {
#pragma unroll
        for (int i = 0; i < 4; ++i) { const int row = (lane >> 3) + 8 * i, c = lane & 7;
            *(LAS v4u*)(gim + row * 144 + c * 16) = *(const v4u*)(F.wsp<bf16>(WS_Z) + (row0 + 32 * mt + row) * ZW + LRUW + h * 64 + 8 * c); }
        LDS_WAIT();
    }
#pragma unroll
    for (int nt = 0; nt < 2; ++nt) {
        asm volatile("" ::: "memory");
        f32x16 aa = {}, ax = {};
#pragma unroll
        for (int s = 0; s < 4; ++s) {
            const bf16x8 wa = *(const bf16x8*)(gw + (size_t)(32 * nt + r) * 64 + 16 * s + 8 * hh);
            const bf16x8 wx = *(const bf16x8*)(gw + 32768 + (size_t)(32 * nt + r) * 64 + 16 * s + 8 * hh);
            aa = MFMA32(af[s], wa, aa); ax = MFMA32(af[s], wx, ax);
        }
#pragma unroll
        for (int i = 0; i < 16; ++i) {
            const float rg = sigmoidf_(aa[i] + st.ba[nt]), ig = sigmoidf_(ax[i] + st.bx[nt]);
            const float la = -8.0f * rg * st.sp[nt];
            const float a = exp2_(LOG2E * la);
            const float mult = __builtin_amdgcn_sqrtf(fmaxf(1.0f - a * a, 0.f));
            const float xc = bf2f(*(const LAS bf16*)(xcs + (32 * mt + crow(i, hh)) * 144 + (32 * nt + r) * 2));
            aa[i] = a; ax[i] = mult * ig * xc;
        }
        float Ao[4], Bo[4], Aq[4], Bq[4], Sin[4];
#pragma unroll
        for (int q = 0; q < 4; ++q) { const float a0 = aa[4 * q], a1 = aa[4 * q + 1], a2 = aa[4 * q + 2], a3 = aa[4 * q + 3];
            Ao[q] = (a0 * a1) * (a2 * a3); Bo[q] = ((ax[4 * q] * a1 + ax[4 * q + 1]) * a2 + ax[4 * q + 2]) * a3 + ax[4 * q + 3];
            Aq[q] = swap32_partner(Ao[q], hh); Bq[q] = swap32_partner(Bo[q], hh); }
        float s_ = st.S[nt];
#pragma unroll
        for (int q = 0; q < 4; ++q) { const float A1 = hh ? Aq[q] : Ao[q], B1 = hh ? Bq[q] : Bo[q], A2 = hh ? Ao[q] : Aq[q], B2 = hh ? Bo[q] : Bq[q];
            const float smid = A1 * s_ + B1; Sin[q] = hh ? smid : s_; s_ = A2 * smid + B2; st.Ap[nt] *= A1 * A2; }
        st.S[nt] = s_;
        if (PASS2) {
#pragma unroll
            for (int q = 0; q < 4; ++q) { float hp = Sin[q];
#pragma unroll
                for (int e = 0; e < 4; ++e) { const int i = 4 * q + e; hp = aa[i] * hp + ax[i];
                    const float gt = bf2f(*(const LAS bf16*)(gim + crow(i, hh) * 144 + (32 * nt + r) * 2));
                    const float y = hp * gelu_tanh(gt); ssl[i] += y * y;
                    *(LAS bf16*)(xcs + (32 * mt + crow(i, hh)) * 144 + (32 * nt + r) * 2) = f2bf(y); } }
        }
    }
    if (PASS2) {
#pragma unroll
        for (int i = 0; i < 16; ++i) ssq[i] = sum32(ssl[i]);
    }
}
constexpr int ATT_KST = 144, ATT_VST = 136, ATT_KBYTES = 64 * ATT_KST, ATT_VBYTES = 64 * ATT_VST;
DI void attn_wave(const Frame& F, int b, int n, int qt, int h, int lane, const LAS float* tab, LAS unsigned char* kl  , f32x16 (&o)[2]) {
    const int r = lane & 31, hh = lane >> 5;
    LAS unsigned char* vl = kl + ATT_KBYTES;
    const size_t row0 = (size_t)b * SEQ + (size_t)n * 64;
    const float SC = 0.125f * LOG2E;
    bf16x8 qf[4];
#pragma unroll
    for (int s = 0; s < 4; ++s) qf[s] = *(const bf16x8*)(F.wsp<bf16>(WS_Z) + (row0 + 32 * qt + r) * ZW + 2 * LRUW + h * 64 + 16 * s + 8 * hh);
    float mrun = -1e30f, lrun = 0.f;
#pragma unroll
    for (int dt = 0; dt < 2; ++dt) o[dt] = f32x16{};
    const float bfar = tab[256];
    const int srow = lane >> 3, sc8 = lane & 7;
    const int kc0 = (n >= 8 ? n - 8 : 0);
    const char* kg = (const char*)(F.wsp<bf16>(WS_Z) + (size_t)b * SEQ * ZW + 2 * LRUW + ATTW + h * 64);
    const char* vg = (const char*)(F.wsp<bf16>(WS_VT) + (size_t)(b * 8 + h) * 64 * SEQ);
    const unsigned kof = (unsigned)(srow * ZW + 8 * sc8) * 2u, vof = (unsigned)(srow * SEQ + 8 * sc8) * 2u;
    v4u kreg[8];
#pragma unroll
    for (int i = 0; i < 8; ++i) kreg[i] = *(const v4u*)(kg + ((size_t)kc0 * 64 + 8 * i) * ZW * 2 + kof);
    for (int kc = kc0; kc <= n; ++kc) {
        const int dd = n - kc;
        v4u vreg[8];
#pragma unroll
        for (int i = 0; i < 8; ++i) { *(LAS v4u*)(kl + (srow + 8 * i) * ATT_KST + sc8 * 16) = kreg[i]; vreg[i] = *(const v4u*)(vg + ((size_t)(8 * i) * SEQ + kc * 64) * 2 + vof); }
        f32x16 sc[2];
#pragma unroll
        for (int kt = 0; kt < 2; ++kt) { sc[kt] = f32x16{};
#pragma unroll
            for (int s = 0; s < 4; ++s) { const bf16x8 kf = *(const LAS bf16x8*)(kl + (32 * kt + r) * ATT_KST + (16 * s + 8 * hh) * 2); sc[kt] = MFMA32(kf, qf[s], sc[kt]); } }
        if (dd >= 3) {
#pragma unroll
            for (int kt = 0; kt < 2; ++kt)
#pragma unroll
                for (int i = 0; i < 16; ++i) sc[kt][i] = sc[kt][i] * SC + bfar;
        } else {
            const int base = 64 * dd + 32 * qt + r + 128;
#pragma unroll
            for (int kt = 0; kt < 2; ++kt)
#pragma unroll
                for (int i = 0; i < 16; ++i) { int idx = base - (32 * kt + crow(i, hh)); idx = idx > 256 ? 256 : idx; sc[kt][i] = sc[kt][i] * SC + tab[idx]; }
        }
        float mx = sc[0][0];
#pragma unroll
        for (int kt = 0; kt < 2; ++kt)
#pragma unroll
            for (int i = 0; i < 16; ++i) mx = fmaxf(mx, sc[kt][i]);
        mx = fmaxf(mx, swap32_partner(mx, hh));
        const float mnew = fmaxf(mrun, mx), alpha = exp2_(mrun - mnew);
        float ls = 0.f;
#pragma unroll
        for (int kt = 0; kt < 2; ++kt)
#pragma unroll
            for (int i = 0; i < 16; ++i) { const float p = exp2_(sc[kt][i] - mnew); sc[kt][i] = p; ls += p; }
        lrun = lrun * alpha + ls; mrun = mnew;
#pragma unroll
        for (int dt = 0; dt < 2; ++dt)
#pragma unroll
            for (int i = 0; i < 16; ++i) o[dt][i] *= alpha;
#pragma unroll
        for (int i = 0; i < 8; ++i) { LAS v2u* vd = (LAS v2u*)(vl + (srow + 8 * i) * ATT_VST + sc8 * 16); vd[0] = (v2u){vreg[i].x, vreg[i].y}; vd[1] = (v2u){vreg[i].z, vreg[i].w}; }
        if (kc < n) {
#pragma unroll
            for (int i = 0; i < 8; ++i) kreg[i] = *(const v4u*)(kg + ((size_t)(kc + 1) * 64 + 8 * i) * ZW * 2 + kof);
        }
#pragma unroll
        for (int kt = 0; kt < 2; ++kt)
#pragma unroll
            for (int s2 = 0; s2 < 2; ++s2) { v4u w; w.x = pk2(sc[kt][8 * s2], sc[kt][8 * s2 + 1]); w.y = pk2(sc[kt][8 * s2 + 2], sc[kt][8 * s2 + 3]); w.z = pk2(sc[kt][8 * s2 + 4], sc[kt][8 * s2 + 5]); w.w = pk2(sc[kt][8 * s2 + 6], sc[kt][8 * s2 + 7]);
                const bf16x8 pf = __builtin_bit_cast(bf16x8, w);
#pragma unroll
                for (int dt = 0; dt < 2; ++dt) { const LAS unsigned char* vp = vl + (32 * dt + r) * ATT_VST + (32 * kt + 16 * s2 + 4 * hh) * 2;
                    const v2u lo = *(const LAS v2u*)vp, hi = *(const LAS v2u*)(vp + 16); v4u vw; vw.x = lo.x; vw.y = lo.y; vw.z = hi.x; vw.w = hi.y;
                    o[dt] = MFMA32(__builtin_bit_cast(bf16x8, vw), pf, o[dt]); } }
    }
    const float lt = lrun + swap32_partner(lrun, hh); const float inv = rcp_(lt);
#pragma unroll
    for (int dt = 0; dt < 2; ++dt)
#pragma unroll
        for (int i = 0; i < 16; ++i) o[dt][i] *= inv;
}

DI void p2_lru_aggregates(Frame& F) {
    const int lane = F.lane, r = lane & 31, hh = lane >> 5, h = F.wave;
    LAS unsigned char* xcs = F.lds + 12288 + h * 17920;
    for (int u = F.vcu; u < NBATCH * NCHUNK; u += F.G) {
        const int b = u / NCHUNK, n = u % NCHUNK;
        LruState st; float ssq[16];
        lru_prep<false>(F, b, n, h, lane, xcs, st);
#pragma unroll 1
        for (int mt = 0; mt < 2; ++mt) lru_tile<false>(F, b, n, mt, h, lane, xcs, xcs + 9216, st, ssq);
        if (hh == 0) {
#pragma unroll
            for (int nt = 0; nt < 2; ++nt) *(f32x2*)(F.wsp<float>(WS_AGG) + (((size_t)b * NCHUNK + n) * LRUW + h * 64 + 32 * nt + r) * 2) = (f32x2){st.Ap[nt], st.S[nt]};
        }
        LDS_WAIT();
    }
}
DI void p3_mixer(Frame& F, int parts = 3) {
    const int lane = F.lane, r = lane & 31, hh = lane >> 5, h = F.wave;
    LAS float* ssx = (LAS float*)(F.lds);
    LAS float* tab = (LAS float*)(F.lds + 2048 + h * 1280);
    LAS unsigned* stg = (LAS unsigned*)(F.lds + 12288 + h * 17920);
    for (int i = lane; i < 257; i += 64) tab[i] = F.in(11)[h * 257 + i] * LOG2E;
    LDS_WAIT();
    for (int u = F.vcu; u < NBATCH * NCHUNK; u += F.G) {
        const int b = u / NCHUNK, n = u % NCHUNK; const size_t row0 = (size_t)b * SEQ + (size_t)n * 64;
#ifndef MIX_PARTS
#define MIX_PARTS 3
#endif
        if (parts & 1) {
            LruState st;
            lru_prep<true>(F, b, n, h, lane, (LAS unsigned char*)stg, st);
#pragma unroll 1
            for (int mt = 0; mt < 2; ++mt) {
                float ssq[16];
                lru_tile<true>(F, b, n, mt, h, lane, (LAS unsigned char*)stg, (LAS unsigned char*)stg + 9216, st, ssq);
                if (r == 0) {
#pragma unroll
                    for (int i = 0; i < 16; ++i) ssx[crow(i, hh) * 8 + h] = ssq[i];
                }
                __syncthreads();
                const LAS unsigned char* yst = (const LAS unsigned char*)stg + 32 * mt * 144;
#pragma unroll
                for (int i = 0; i < 4; ++i) { const int row = (lane >> 3) + 8 * i, c = lane & 7;
                    const f32x4 s0 = *(const LAS f32x4*)(ssx + row * 8), s1 = *(const LAS f32x4*)(ssx + row * 8 + 4);
                    const float rs = rsq_(((s0.x + s0.y) + (s0.z + s0.w) + (s1.x + s1.y) + (s1.z + s1.w)) * (1.f / 512.f) + EPS);
                    const v4u v = *(const LAS v4u*)(yst + row * 144 + c * 16);
                    v4u o; o.x = pk2(bflo(v.x) * rs, bfhi(v.x) * rs); o.y = pk2(bflo(v.y) * rs, bfhi(v.y) * rs); o.z = pk2(bflo(v.z) * rs, bfhi(v.z) * rs); o.w = pk2(bflo(v.w) * rs, bfhi(v.w) * rs);
                    *(v4u*)(F.wsp<bf16>(WS_Y) + (row0 + 32 * mt + row) * DM + h * 64 + 8 * c) = o; }
                __syncthreads();
            }
        }
    }
    for (int u = F.vcu; u < NBATCH * NCHUNK; u += F.G) {
        const int b = u / NCHUNK, n = u % NCHUNK; const size_t row0 = (size_t)b * SEQ + (size_t)n * 64;
#pragma unroll 1
        for (int qt = 0; qt < ((parts & 2) ? 2 : 0); ++qt) {
            f32x16 o[2];
            attn_wave(F, b, n, qt, h, lane, tab, (LAS unsigned char*)stg, o);
            float s = 0.f;
#pragma unroll
            for (int dt = 0; dt < 2; ++dt)
#pragma unroll
                for (int i = 0; i < 16; ++i) s += o[dt][i] * o[dt][i];
            s += swap32_partner(s, hh);
            if (hh == 0) ssx[r * 8 + h] = s;
            __syncthreads();
            { const f32x4 s0 = *(const LAS f32x4*)(ssx + r * 8), s1 = *(const LAS f32x4*)(ssx + r * 8 + 4);
              const float rs = rsq_(((s0.x + s0.y) + (s0.z + s0.w) + (s1.x + s1.y) + (s1.z + s1.w)) * (1.f / 512.f) + EPS);
#pragma unroll
              for (int dt = 0; dt < 2; ++dt)
#pragma unroll
                  for (int i = 0; i < 16; i += 2) stg[r * 33 + ((32 * dt + crow(i, hh)) >> 1)] = pk2(o[dt][i] * rs, o[dt][i + 1] * rs); }
            LDS_WAIT();
#pragma unroll 4
            for (int i = 0; i < 16; ++i) { const int row = 2 * i + hh; const unsigned v = stg[row * 33 + r];
                *(GAS unsigned*)(F.wsp<bf16>(WS_Y) + (row0 + 32 * qt + row) * DM + LRUW + h * 64 + 2 * r) = v; }
            __syncthreads();
        }
    }
}
DI void p5_cross(Frame& F, const pg8::StaticOrder& S) {
    const int lane = F.lane, r = lane & 31, hh = lane >> 5, w = F.wave, tid = F.tid;
    constexpr int KST = 528, VST = 520;
    const float SC = 0.0625f * LOG2E;
    pg8::Unit un;
    for (int ui = 0; S.next(ui, un); ++ui) {
        const int b = un.pm >> 5, qb = un.pm & 31, hm = un.pn;
        const size_t qrow = (size_t)b * SEQ + (size_t)qb * 256 + 32 * w + r;
        { const bf16* src = F.wsp<bf16>(WS_KM) + (size_t)(b * 256) * DM + hm * 256;
#pragma unroll 4
          for (int i = 0; i < 16; ++i) { const int c = i * 512 + tid, row = c >> 5, ch = c & 31;
              *(LAS v4u*)(F.lds + row * KST + ch * 16) = *(const v4u*)(src + (size_t)row * DM + ch * 8); } }
        __syncthreads();
        f32x16 sc[8];
#pragma unroll
        for (int kt = 0; kt < 8; ++kt) sc[kt] = f32x16{};
#pragma unroll 2
        for (int s = 0; s < 16; ++s) {
            const bf16x8 qf = *(const bf16x8*)(F.wsp<bf16>(WS_QC) + qrow * DM + hm * 256 + 16 * s + 8 * hh);
#pragma unroll
            for (int kt = 0; kt < 8; ++kt) { const bf16x8 kf = *(const LAS bf16x8*)(F.lds + (32 * kt + r) * KST + (16 * s + 8 * hh) * 2); sc[kt] = MFMA32(kf, qf, sc[kt]); }
        }
        float mx = sc[0][0];
#pragma unroll
        for (int kt = 0; kt < 8; ++kt)
#pragma unroll
            for (int i = 0; i < 16; ++i) mx = fmaxf(mx, sc[kt][i]);
        mx = fmaxf(mx, swap32_partner(mx, hh));
        float ls = 0.f; const float mo = mx * SC;
        bf16x8 pf[8][2];
#pragma unroll
        for (int kt = 0; kt < 8; ++kt) {
#pragma unroll
            for (int i = 0; i < 16; ++i) { const float p = exp2_(sc[kt][i] * SC - mo); sc[kt][i] = p; ls += p; }
#pragma unroll
            for (int s2 = 0; s2 < 2; ++s2) { v4u wv; wv.x = pk2(sc[kt][8 * s2], sc[kt][8 * s2 + 1]); wv.y = pk2(sc[kt][8 * s2 + 2], sc[kt][8 * s2 + 3]); wv.z = pk2(sc[kt][8 * s2 + 4], sc[kt][8 * s2 + 5]); wv.w = pk2(sc[kt][8 * s2 + 6], sc[kt][8 * s2 + 7]);
                pf[kt][s2] = __builtin_bit_cast(bf16x8, wv); }
        }
        ls += swap32_partner(ls, hh);
        const float inv = 1.0f / ls;
        __syncthreads();
        { const bf16* src = F.wsp<bf16>(WS_VMT) + (size_t)((b * 4 + hm) * 256) * 256;
#pragma unroll 4
          for (int i = 0; i < 16; ++i) { const int c = i * 512 + tid, row = c >> 5, ch = c & 31; const v4u v = *(const v4u*)(src + (size_t)row * 256 + ch * 8);
              LAS v2u* d = (LAS v2u*)(F.lds + row * VST + ch * 16); d[0] = (v2u){v.x, v.y}; d[1] = (v2u){v.z, v.w}; } }
        __syncthreads();
        LAS unsigned* stg = (LAS unsigned*)(F.lds) ;
#pragma unroll
        for (int half = 0; half < 2; ++half) {
            f32x16 o[4];
#pragma unroll
            for (int dt = 0; dt < 4; ++dt) o[dt] = f32x16{};
#pragma unroll
            for (int kt = 0; kt < 8; ++kt)
#pragma unroll
                for (int s2 = 0; s2 < 2; ++s2)
#pragma unroll
                    for (int dt = 0; dt < 4; ++dt) { const LAS unsigned char* p = F.lds + (128 * half + 32 * dt + r) * VST + (32 * kt + 16 * s2 + 4 * hh) * 2;
                        const v2u lo = *(const LAS v2u*)p, hi = *(const LAS v2u*)(p + 16); v4u wv; wv.x = lo.x; wv.y = lo.y; wv.z = hi.x; wv.w = hi.y;
                        o[dt] = MFMA32(__builtin_bit_cast(bf16x8, wv), pf[kt][s2], o[dt]); }
            if (half == 1) __syncthreads();
            else {   }
            if (half == 0) {
#pragma unroll
                for (int dt = 0; dt < 4; ++dt)
#pragma unroll
                    for (int i = 0; i < 16; i += 2) { const unsigned pv = pk2(o[dt][i] * inv, o[dt][i + 1] * inv); sc[dt][i >> 1] = __uint_as_float(pv); }
            } else {
                LAS unsigned* sw = (LAS unsigned*)(F.lds + w * 16512);
#pragma unroll
                for (int dt = 0; dt < 4; ++dt)
#pragma unroll
                    for (int i = 0; i < 16; i += 2) { sw[r * 129 + ((32 * dt + crow(i, hh)) >> 1)] = __float_as_uint(sc[dt][i >> 1]);
                        sw[r * 129 + 64 + ((32 * dt + crow(i, hh)) >> 1)] = pk2(o[dt][i] * inv, o[dt][i + 1] * inv); }
                LDS_WAIT();
#pragma unroll 4
                for (int i = 0; i < 32; ++i) { const unsigned v0 = sw[i * 129 + lane], v1 = sw[i * 129 + 64 + lane];
                    GAS unsigned* dst = (GAS unsigned*)(F.wsp<bf16>(WS_OC) + ((size_t)b * SEQ + (size_t)qb * 256 + 32 * w + i) * DM + hm * 256);
                    dst[lane] = v0; dst[64 + lane] = v1; }
            }
        }
        (void)stg;
        __syncthreads();
    }
}
template <int N> DI void ce_desc(float (&a)[N], int i, int l) { const float hi = fmaxf(a[i], a[l]), lo = fminf(a[i], a[l]); a[i] = hi; a[l] = lo; }
template <int N, int OFF> DI void bitonic_sort16_desc(float (&a)[N]) {
#define CE_(i, j) ce_desc<N>(a, OFF + (i), OFF + (j))
    CE_(0,13); CE_(1,12); CE_(2,15); CE_(3,14); CE_(4,8); CE_(5,6); CE_(7,11); CE_(9,10);
    CE_(0,5); CE_(1,7); CE_(2,9); CE_(3,4); CE_(6,13); CE_(8,14); CE_(10,15); CE_(11,12);
    CE_(0,1); CE_(2,3); CE_(4,5); CE_(6,8); CE_(7,9); CE_(10,11); CE_(12,13); CE_(14,15);
    CE_(0,2); CE_(1,3); CE_(4,10); CE_(5,11); CE_(6,7); CE_(8,9); CE_(12,14); CE_(13,15);
    CE_(1,2); CE_(3,12); CE_(4,6); CE_(5,7); CE_(8,10); CE_(9,11); CE_(13,14);
    CE_(1,4); CE_(2,6); CE_(5,8); CE_(7,10); CE_(9,13); CE_(11,14);
    CE_(2,4); CE_(3,6); CE_(9,12); CE_(11,13);
    CE_(3,5); CE_(6,8); CE_(7,9); CE_(10,12);
    CE_(3,4); CE_(5,6); CE_(7,8); CE_(9,10); CE_(11,12);
    CE_(6,7); CE_(8,9);
#undef CE_
}
template <int N, int OFF> DI void bitonic_merge16_desc(float (&a)[N]) {
#pragma unroll
    for (int j = 8; j > 0; j >>= 1)
#pragma unroll
        for (int i = 0; i < 16; ++i) { const int l = i ^ j; if (l > i) ce_desc<N>(a, OFF + i, OFF + l); }
}
template <bool SORTED, bool SORT0 = true> DI void top16_of_64(float (&a)[64]) {
    if (SORT0) bitonic_sort16_desc<64, 0>(a); bitonic_sort16_desc<64, 16>(a); bitonic_sort16_desc<64, 32>(a); bitonic_sort16_desc<64, 48>(a);
#pragma unroll
    for (int i = 0; i < 16; ++i) { a[i] = fmaxf(a[i], a[31 - i]); a[32 + i] = fmaxf(a[32 + i], a[63 - i]); }
    bitonic_merge16_desc<64, 0>(a); bitonic_merge16_desc<64, 32>(a);
#pragma unroll
    for (int i = 0; i < 16; ++i) a[i] = fmaxf(a[i], a[47 - i]);
    if (SORTED) bitonic_merge16_desc<64, 0>(a);
}
DI void p8a_topk(Frame& F, const pg8::StaticOrder& S) {
    const int lane = F.lane, r = lane & 31, hh = lane >> 5, w = F.wave;
    constexpr int TK_ST = 272, TK_QBYTES = 256 * TK_ST;
    LAS float* tbl = (LAS float*)(F.lds + w * 8192);
    pg8::Unit un;
    for (int ui = 0; S.next(ui, un); ++ui) {
        const int h = un.pn; const size_t tok = (size_t)un.pm * 256 + 32 * w + r;
        float v[2][16];
#pragma unroll
        for (int p = 0; p < 2; ++p) {
            __syncthreads();
            { const bf16* qsrc = F.wsp<bf16>(WS_QP) + (size_t)un.pm * 256 * 2048 + h * 256 + p * 128; const bf16* ksrc = F.wsp<bf16>(WS_SUBK) + (size_t)((h * 2 + p) * 128) * 128;
              const int rr = F.tid >> 4, ch = F.tid & 15;
#pragma unroll
              for (int i = 0; i < 8; ++i) *(LAS v4u*)(F.lds + (32 * i + rr) * TK_ST + ch * 16) = *(const v4u*)(qsrc + (size_t)(32 * i + rr) * 2048 + ch * 8);
#pragma unroll
              for (int i = 0; i < 4; ++i) *(LAS v4u*)(F.lds + TK_QBYTES + (32 * i + rr) * TK_ST + ch * 16) = *(const v4u*)(ksrc + (size_t)(32 * i + rr) * 128 + ch * 8); }
            __syncthreads();
            f32x16 sc[4];
#pragma unroll
            for (int nt = 0; nt < 4; ++nt) sc[nt] = f32x16{};
#pragma unroll 2
            for (int s = 0; s < 8; ++s) { const bf16x8 qf = *(const LAS bf16x8*)(F.lds + (32 * w + r) * TK_ST + (16 * s + 8 * hh) * 2);
#pragma unroll
                for (int nt = 0; nt < 4; ++nt) { const bf16x8 kf = *(const LAS bf16x8*)(F.lds + TK_QBYTES + (32 * nt + r) * TK_ST + (16 * s + 8 * hh) * 2); sc[nt] = MFMA32(kf, qf, sc[nt]); } }
            float a[64];
#pragma unroll
            for (int nt = 0; nt < 4; ++nt)
#pragma unroll
                for (int i = 0; i < 16; ++i) a[nt * 16 + i] = __uint_as_float((__float_as_uint(sc[nt][i]) & ~127u) | (unsigned)(32 * nt + crow(i, hh)));
            top16_of_64<true>(a);
            float m[16];
#pragma unroll
            for (int i = 0; i < 16; ++i) m[i] = fmaxf(a[i], swap32_partner(a[15 - i], hh));
            bitonic_merge16_desc<16, 0>(m);
#pragma unroll
            for (int i = 0; i < 16; ++i) v[p][i] = m[i];
        }
        float c[64]; int n = 0;
#pragma unroll
        for (int i = 0; i < 16; ++i)
#pragma unroll
            for (int j = 0; j < 16; ++j) if ((i + 1) * (j + 1) <= 16) { c[n] = __uint_as_float((__float_as_uint(v[0][i] + v[1][j]) & ~255u) | (unsigned)((i << 4) | j)); ++n; }
#pragma unroll
        for (int k = 50; k < 64; ++k) c[k] = -3.0e38f;
        top16_of_64<false, false>(c);
        __syncthreads();
#pragma unroll
        for (int i = 0; i < 16; ++i) { tbl[i * 64 + lane] = v[0][i]; tbl[(16 + i) * 64 + lane] = v[1][i]; }
        LDS_WAIT();
        float sv[16]; int ev[16]; float mx = -3.0e38f;
#pragma unroll
        for (int k = 0; k < 16; ++k) { const unsigned pl = __float_as_uint(c[k]) & 255u; const float a1 = tbl[(pl >> 4) * 64 + lane], a2 = tbl[(16 + (pl & 15)) * 64 + lane];
            sv[k] = a1 + a2; ev[k] = (int)(((__float_as_uint(a1) & 127u) << 7) | (__float_as_uint(a2) & 127u)); mx = fmaxf(mx, sv[k]); }
        float sum = 0.f;
#pragma unroll
        for (int k = 0; k < 16; ++k) { sv[k] = __expf(sv[k] - mx); sum += sv[k]; }
        const float inv = 1.0f / sum;
        if (hh == 0) {
#pragma unroll
            for (int k = 0; k < 16; k += 4) *(v4u*)(F.wsp<int>(WS_IDX) + tok * NSEL + h * 16 + k) = (v4u){(unsigned)ev[k], (unsigned)ev[k + 1], (unsigned)ev[k + 2], (unsigned)ev[k + 3]};
        } else {
#pragma unroll
            for (int k = 0; k < 16; k += 4) *(f32x4*)(F.wsp<float>(WS_G) + tok * NSEL + h * 16 + k) = (f32x4){sv[k] * inv, sv[k + 1] * inv, sv[k + 2] * inv, sv[k + 3] * inv};
        }
        LDS_WAIT();
    }
}
typedef _Float16 f16x2_t __attribute__((ext_vector_type(2)));
DI int dot16_i8(const v4u& u, const unsigned (&x)[4]) {
    const unsigned u0 = u.x, u1 = u.y, u2 = u.z, u3 = u.w;
    int a = 0;
    a = __builtin_amdgcn_sdot4((int)u0, (int)x[0], a, false); a = __builtin_amdgcn_sdot4((int)u1, (int)x[1], a, false);
    a = __builtin_amdgcn_sdot4((int)u2, (int)x[2], a, false); a = __builtin_amdgcn_sdot4((int)u3, (int)x[3], a, false);
    return a;
}
DI void axpy32_v6(f16x2_t (&o)[16], float w, const v4u a, unsigned b4, unsigned b5) {
    const v6u pk = {a.x, a.y, a.z, a.w, b4, b5};
    const v32h h = __builtin_amdgcn_cvt_scalef32_pk32_f16_fp6(pk, 1.0f);
    const f16x2_t w2 = {(_Float16)w, (_Float16)w};
#pragma unroll
    for (int i = 0; i < 16; ++i) { const f16x2_t hv = {h[2 * i], h[2 * i + 1]}; o[i] = __builtin_elementwise_fma(hv, w2, o[i]); }
}
constexpr int TPW = 4, NSLICE = 16, SLICE_SHIFT = 10, NPAIR = TPW * NSEL, NPAIR_PAD = NPAIR + 1 * TPW * NSLICE + 32;
constexpr int PEER_LDS_PER_WAVE = TPW * 1024 + 64 + TPW * 2048 + NPAIR_PAD * 4;
static_assert(PEER_LDS_PER_WAVE * NWAVES <= RING_BYTES, "PEER LDS");
DI int incl_scan64(int v, int lane) {
    int s = v;
#pragma unroll
    for (int d = 1; d < 64; d <<= 1) { const int t = __shfl_up(s, d); if (lane >= d) s += t; }
    return s;
}
struct PeerBatch { v4u uu[4]; v4u va[2]; unsigned vb4[2], vb5[2]; unsigned ent[4]; float su[4], sv[4]; };
DI void peer_load_batch(PeerBatch& B, const LAS unsigned* ml, int i, const unsigned char* EU8, const unsigned char* EV8, const float* SU, int lane, unsigned emask = 0x3fffu) {
    const v4u e4 = *(const LAS v4u*)(ml + i);
    B.ent[0] = (unsigned)__builtin_amdgcn_readfirstlane((int)e4.x); B.ent[1] = (unsigned)__builtin_amdgcn_readfirstlane((int)e4.y);
    B.ent[2] = (unsigned)__builtin_amdgcn_readfirstlane((int)e4.z); B.ent[3] = (unsigned)__builtin_amdgcn_readfirstlane((int)e4.w);
    const int l5 = lane & 31, hh = lane >> 5;
#pragma unroll
    for (int k = 0; k < 4; ++k) { const unsigned e = B.ent[k] & emask; const unsigned char* ur = EU8 + (size_t)e * DM;
        B.uu[k] = *(const v4u*)(ur + (unsigned)(16 * lane)); B.su[k] = SU[e]; B.sv[k] = SU[NEXP + e]; }
#pragma unroll
    for (int q = 0; q < 2; ++q) { const unsigned e0 = B.ent[2 * q] & emask, e1 = B.ent[2 * q + 1] & emask; const unsigned e = e0 + (unsigned)hh * (e1 - e0);
        const unsigned off = e * (unsigned)EV_ROW; B.va[q] = *(const v4u*)(EV8 + off + (unsigned)(16 * l5)); const v2u t2 = *(const v2u*)(EV8 + off + (unsigned)(512 + 8 * l5)); B.vb4[q] = t2.x; B.vb5[q] = t2.y; }
}
struct PeerState { unsigned x[4]; float sx; f16x2_t oc[16]; int curj; };
DI void peer_flush(PeerState& S, LAS unsigned char* ol, int lane) {
    LAS v4u* r = (LAS v4u*)(ol + S.curj * 2048 + 64 * (lane & 31) + 32 * (lane >> 5));
    unsigned mine[8];
#pragma unroll
    for (int i = 0; i < 8; ++i) { auto rr = __builtin_amdgcn_permlane32_swap(__builtin_bit_cast(unsigned, S.oc[i]), __builtin_bit_cast(unsigned, S.oc[8 + i]), false, false);
        mine[i] = __builtin_bit_cast(unsigned, __builtin_bit_cast(f16x2_t, (unsigned)rr[0]) + __builtin_bit_cast(f16x2_t, (unsigned)rr[1])); }
#pragma unroll
    for (int c = 0; c < 2; ++c) { const v4u v = r[c]; v4u o;
        o.x = __builtin_bit_cast(unsigned, __builtin_bit_cast(f16x2_t, (unsigned)v.x) + __builtin_bit_cast(f16x2_t, mine[4 * c])); o.y = __builtin_bit_cast(unsigned, __builtin_bit_cast(f16x2_t, (unsigned)v.y) + __builtin_bit_cast(f16x2_t, mine[4 * c + 1]));
        o.z = __builtin_bit_cast(unsigned, __builtin_bit_cast(f16x2_t, (unsigned)v.z) + __builtin_bit_cast(f16x2_t, mine[4 * c + 2])); o.w = __builtin_bit_cast(unsigned, __builtin_bit_cast(f16x2_t, (unsigned)v.w) + __builtin_bit_cast(f16x2_t, mine[4 * c + 3]));
        r[c] = o; }
#pragma unroll
    for (int i = 0; i < 16; ++i) S.oc[i] = (f16x2_t){(_Float16)0.f, (_Float16)0.f};
}
DI void peer_compute_batch(const PeerBatch& B, PeerState& S, LAS unsigned char* ol, const LAS unsigned char* xl, int lane) {
    const int jA = (int)((B.ent[0] >> 14) & 3u), jB = (int)((B.ent[2] >> 14) & 3u);
    if (jA != S.curj) {
        if (S.curj >= 0) peer_flush(S, ol, lane);
        S.curj = jA;
        const v4u y0 = ((const LAS v4u*)(xl + jA * 1024))[lane];
        S.x[0] = y0.x; S.x[1] = y0.y; S.x[2] = y0.z; S.x[3] = y0.w; S.sx = ((const LAS float*)(xl + TPW * 1024))[jA]; }
    unsigned xb[4] = {S.x[0], S.x[1], S.x[2], S.x[3]}; float sxb = S.sx;
    if (jB != jA) { const v4u y0 = ((const LAS v4u*)(xl + jB * 1024))[lane]; xb[0] = y0.x; xb[1] = y0.y; xb[2] = y0.z; xb[3] = y0.w; sxb = ((const LAS float*)(xl + TPW * 1024))[jB]; }
    const float d0 = (float)dot16_i8(B.uu[0], S.x) * B.su[0], d1 = (float)dot16_i8(B.uu[1], S.x) * B.su[1], d2 = (float)dot16_i8(B.uu[2], xb) * B.su[2], d3 = (float)dot16_i8(B.uu[3], xb) * B.su[3];
    const bool b0 = lane & 1, b1 = lane & 2;
    const float r0 = (b0 ? d1 : d0) + dpp_xor1(b0 ? d0 : d1), r1 = (b0 ? d3 : d2) + dpp_xor1(b0 ? d2 : d3);
    float t = (b1 ? r1 : r0) + dpp_xor2(b1 ? r0 : r1);
    t += __int_as_float(__builtin_amdgcn_update_dpp(0, __float_as_int(t), 0x124, 0xf, 0xf, true));
    t += __int_as_float(__builtin_amdgcn_update_dpp(0, __float_as_int(t), 0x128, 0xf, 0xf, true));
    { auto rr = __builtin_amdgcn_permlane16_swap(__float_as_uint(t), __float_as_uint(t), false, false); t = __uint_as_float(rr[0]) + __uint_as_float(rr[1]); }
    { auto rr = __builtin_amdgcn_permlane32_swap(__float_as_uint(t), __float_as_uint(t), false, false); t = __uint_as_float(rr[0]) + __uint_as_float(rr[1]); }
    const float act = gelu_tanh(t * (b1 ? sxb : S.sx));
#define PEER_W(k) (__builtin_bit_cast(float, __builtin_amdgcn_readlane(__builtin_bit_cast(int, act), k)) * __uint_as_float(B.ent[k] & 0xffff0000u) * B.sv[k])
    const float a0 = PEER_W(0), a1 = PEER_W(1), a2 = PEER_W(2), a3 = PEER_W(3);
#undef PEER_W
    const float hsel = (lane >= 32) ? 1.0f : 0.0f;
    axpy32_v6(S.oc, a0 + hsel * (a1 - a0), B.va[0], B.vb4[0], B.vb5[0]);
    if (jB != jA) { peer_flush(S, ol, lane); S.curj = jB; S.x[0] = xb[0]; S.x[1] = xb[1]; S.x[2] = xb[2]; S.x[3] = xb[3]; S.sx = sxb; }
    axpy32_v6(S.oc, a2 + hsel * (a3 - a2), B.va[1], B.vb4[1], B.vb5[1]);
}
DI void p8b_peer(Frame& F, float* outp, unsigned emask = 0x3fffu, float oscale = 1.0f) {
    const int lane = F.lane, w = F.wave;
    const int gw = F.vcu * NWAVES + w, NGW = F.G * NWAVES;
    const unsigned char* EU8 = F.wsp<unsigned char>(WS_EU); const unsigned char* EV8 = F.wsp<unsigned char>(WS_EV); const float* SU = F.wsp<float>(WS_SU);
    LAS unsigned char* xl = F.lds + w * PEER_LDS_PER_WAVE;
    LAS unsigned char* ol = xl + TPW * 1024 + 64;
    LAS unsigned* ml = (LAS unsigned*)(ol + TPW * 2048);
    for (int t0 = gw * TPW; t0 < M; t0 += NGW * TPW) {
        unsigned enta[TPW], entb[TPW]; int posa[TPW], posb[TPW], sla[TPW], slb[TPW], offs[TPW];
#pragma unroll
        for (int j = 0; j < TPW; ++j) { const size_t tok = (size_t)t0 + j;
            float rstd; { const f32x4* sp = (const f32x4*)(F.wsp<float>(WS_SSQ2) + tok * 16); const f32x4 st = (sp[0] + sp[1]) + (sp[2] + sp[3]); rstd = rsq_(((st.x + st.y) + (st.z + st.w)) * (1.f / 1024.f) + EPS); }
            { const bf16* xs = F.wsp<bf16>(WS_XN) + tok * DM + 16 * lane;
              const v4u x0 = *(const v4u*)xs, x1 = *(const v4u*)(xs + 8);
              float xf[16] = {bflo(x0.x), bfhi(x0.x), bflo(x0.y), bfhi(x0.y), bflo(x0.z), bfhi(x0.z), bflo(x0.w), bfhi(x0.w), bflo(x1.x), bfhi(x1.x), bflo(x1.y), bfhi(x1.y), bflo(x1.z), bfhi(x1.z), bflo(x1.w), bfhi(x1.w)};
              float mx = 0.f;
#pragma unroll
              for (int i = 0; i < 16; ++i) mx = fmaxf(mx, fabsf(xf[i]));
              mx = fmaxf(max64(mx), 1e-30f); const float inv = 127.0f / mx;
              v4u y; y.x = pack_i8x4(xf[0] * inv, xf[1] * inv, xf[2] * inv, xf[3] * inv); y.y = pack_i8x4(xf[4] * inv, xf[5] * inv, xf[6] * inv, xf[7] * inv);
              y.z = pack_i8x4(xf[8] * inv, xf[9] * inv, xf[10] * inv, xf[11] * inv); y.w = pack_i8x4(xf[12] * inv, xf[13] * inv, xf[14] * inv, xf[15] * inv);
              ((LAS v4u*)(xl + j * 1024))[lane] = y; if (lane == 0) ((LAS float*)(xl + TPW * 1024))[j] = mx * rstd * (1.0f / 127.0f);
              ((LAS v4u*)(ol + j * 2048))[lane] = (v4u){0u, 0u, 0u, 0u}; ((LAS v4u*)(ol + j * 2048))[64 + lane] = (v4u){0u, 0u, 0u, 0u}; }
            const int ea = F.wsp<int>(WS_IDX)[tok * NSEL + lane], eb = F.wsp<int>(WS_IDX)[tok * NSEL + 64 + lane];
            const float ga = F.wsp<float>(WS_G)[tok * NSEL + lane], gb = F.wsp<float>(WS_G)[tok * NSEL + 64 + lane];
            const int sa = ea >> SLICE_SHIFT, sb = eb >> SLICE_SHIFT;
            int pa = 0, pb = 0, myoff = 0;
#pragma unroll
            for (int bk = 0; bk < NSLICE; ++bk) { const unsigned long long ma = __ballot(sa == bk), mb = __ballot(sb == bk);
                const int ca = __popcll(ma), cb = __popcll(mb);
                const int ra = __builtin_amdgcn_mbcnt_hi((unsigned)(ma >> 32), __builtin_amdgcn_mbcnt_lo((unsigned)ma, 0)), rb = __builtin_amdgcn_mbcnt_hi((unsigned)(mb >> 32), __builtin_amdgcn_mbcnt_lo((unsigned)mb, 0));
                pa = (sa == bk) ? ra : pa; pb = (sb == bk) ? ca + rb : pb;
                myoff = (lane == bk) ? ca + cb : myoff; }
            enta[j] = (unsigned)ea | ((unsigned)j << 14) | (pk2(0.f, ga) & 0xffff0000u); entb[j] = (unsigned)eb | ((unsigned)j << 14) | (pk2(0.f, gb) & 0xffff0000u);
            posa[j] = pa; posb[j] = pb; sla[j] = sa; slb[j] = sb; offs[j] = myoff;
        }
        int cnt = 0;
#pragma unroll
        for (int j = 0; j < TPW; ++j) { const int c = __shfl(offs[j], lane >> 2); cnt = ((lane & 3) == j) ? c : cnt; }
        const int cpad = (cnt + 1) & ~1;
        const int bend = incl_scan64(cpad, lane), bstart = bend - cpad;
        const int npad = __builtin_amdgcn_readlane(bend, 63);
#pragma unroll
        for (int j = 0; j < TPW; ++j) { const int ba = __shfl(bstart, 4 * sla[j] + j), bb = __shfl(bstart, 4 * slb[j] + j);
            ml[ba + posa[j]] = enta[j]; ml[bb + posb[j]] = entb[j]; }
        { const unsigned pad = (unsigned)((lane >> 2) << SLICE_SHIFT) | ((unsigned)(lane & 3) << 14);
          if (cnt < cpad) ml[bstart + cnt] = pad; }
        if (lane < 30) ml[npad + lane] = (unsigned)((NSLICE - 1) << SLICE_SHIFT) | (3u << 14);
        LDS_WAIT();
        PeerState S;
#pragma unroll
        for (int i = 0; i < 16; ++i) S.oc[i] = (f16x2_t){(_Float16)0.f, (_Float16)0.f};
#pragma unroll
        for (int i = 0; i < 4; ++i) S.x[i] = 0u;
        S.curj = -1;
        PeerBatch A, B, C, D;
        peer_load_batch(A, ml, 0, EU8, EV8, SU, lane, emask); peer_load_batch(B, ml, 4, EU8, EV8, SU, lane, emask); peer_load_batch(C, ml, 8, EU8, EV8, SU, lane, emask);
#pragma unroll 1
        for (int i = 0; i < npad; i += 16) {
            if ((i & 127) == 0) { if ((((i >> 7) ^ (w >> 2)) & 1) != 0) __builtin_amdgcn_s_setprio(1); else __builtin_amdgcn_s_setprio(0); }
            peer_load_batch(D, ml, i + 12, EU8, EV8, SU, lane, emask); peer_compute_batch(A, S, ol, xl, lane);
            peer_load_batch(A, ml, i + 16, EU8, EV8, SU, lane, emask); peer_compute_batch(B, S, ol, xl, lane);
            peer_load_batch(B, ml, i + 20, EU8, EV8, SU, lane, emask); peer_compute_batch(C, S, ol, xl, lane);
            peer_load_batch(C, ml, i + 24, EU8, EV8, SU, lane, emask); peer_compute_batch(D, S, ol, xl, lane);
        }
        __builtin_amdgcn_s_setprio(0);
        peer_flush(S, ol, lane);
        LDS_WAIT();
#pragma unroll
        for (int j = 0; j < TPW; ++j) {
            const int l5 = lane & 31, hh5 = lane >> 5;
            const LAS unsigned char* orl = ol + j * 2048 + 64 * l5 + 32 * hh5;
            const v4u h0 = *(const LAS v4u*)orl, h1 = *(const LAS v4u*)(orl + 16);
            const unsigned hw[8] = {h0.x, h0.y, h0.z, h0.w, h1.x, h1.y, h1.z, h1.w};
            f32x4 a[4]; float ss = 0.f;
#pragma unroll
            for (int q = 0; q < 4; ++q) { const int eo = 128 * (4 * hh5 + q) + 4 * l5;
                const v2u xb = *(const v2u*)(F.wsp<bf16>(WS_XN) + ((size_t)t0 + j) * DM + eo);
                const f16x2_t p0 = __builtin_bit_cast(f16x2_t, hw[2 * q]), p1 = __builtin_bit_cast(f16x2_t, hw[2 * q + 1]);
                a[q] = (f32x4){bflo(xb.x), bfhi(xb.x), bflo(xb.y), bfhi(xb.y)} + (f32x4){(float)p0.x, (float)p0.y, (float)p1.x, (float)p1.y};
                ss += (a[q].x * a[q].x + a[q].y * a[q].y) + (a[q].z * a[q].z + a[q].w * a[q].w); }
            const float rf = rsq_(sum64(ss) * (1.f / 1024.f) + EPS) * oscale;
#pragma unroll
            for (int q = 0; q < 4; ++q) { const int eo = 128 * (4 * hh5 + q) + 4 * l5;
                *(f32x4*)(outp + ((size_t)t0 + j) * DM + eo) = a[q] * rf * *(const f32x4*)(F.in(25) + eo); }
        }
        LDS_WAIT();
    }
}
constexpr int N_PHASES = 11;
__global__ void __launch_bounds__(NWAVES * 64, 2) fwd_kernel(Args args) {
    extern __shared__ __attribute__((aligned(16))) unsigned char lds[];
    Frame F;
    F.lds = (LAS unsigned char*)lds;
    F.MISC = (volatile LAS unsigned*)(F.lds + MISC_OFF);
    F.tid = threadIdx.x; F.lane = F.tid & 63; F.wave = __builtin_amdgcn_readfirstlane(F.tid >> 6);
    F.G = gridDim.x; { const int bx = blockIdx.x; F.vcu = (F.G % 8 == 0) ? (bx % 8) * (F.G / 8) + bx / 8 : bx; }
    F.A = &args; F.ws = args.ws; F.out = args.out;
    F.ctl = (gu32*)(args.ws + WS_CTL);
    for (int u = F.tid; u < (LDS_BYTES - LDSCTL_OFF) / 4; u += NWAVES * 64) ((LAS unsigned*)(F.lds + LDSCTL_OFF))[u] = 0u;
    __syncthreads();
    const bool multi = (args.ph_hi - args.ph_lo) > 1;
    XcdBarrier bar; bar.bar = (unsigned*)(F.ctl + CW_BAR) + args.li * XCD_BAR_WORDS; bar.x = 0; bar.st = nullptr;
    if (multi) bar = xcd_barrier_post((unsigned*)(F.ctl + CW_BAR) + args.li * XCD_BAR_WORDS, F.MISC + 8);
    const int lo = args.ph_lo, hi = args.ph_hi;
#ifndef PROBE_EMASK
#define PROBE_EMASK 0x3fffu
#endif
#ifndef PHASE_REPEAT
#define PHASE_REPEAT 0
#endif
#define REP(k) for (int rep_ = 0; rep_ < (((PHASE_REPEAT >> (k)) & 1) ? 2 : 1); ++rep_)
#ifndef PHASE_MASK
#define PHASE_MASK 0x7ff
#endif
#define IN(k) (((PHASE_MASK >> (k)) & 1) && lo <= (k) && (k) < hi)
#define SEAM(k) do { asm volatile("; ===SEAM " #k ::: "memory"); if (IN(k) && IN((k) + 1)) xcd_barrier(bar); STAMP((k) + 1); } while (0)
    const int c = (int)blockIdx.x;
#define LOCAL_SEAM() do { VM_WAIT(); __syncthreads(); if (F.tid == 0) { __builtin_amdgcn_fence(__ATOMIC_ACQUIRE, "agent"); VM_WAIT(); } __syncthreads(); } while (0)
#ifdef PROBE_PHASE
#define STAMP(i) do { if (blockIdx.x == 0 && F.tid == 0) __hip_atomic_store(F.ctl + 512 + (i), (unsigned)__builtin_amdgcn_s_memrealtime(), RLX_AGENT); } while (0)
#else
#define STAMP(i) do { } while (0)
#endif
    STAMP(0);

#ifndef PROBE_P0
#define PROBE_P0 7
#endif
    if (IN(0)) { if (PHASE_REPEAT & 1) p0_prologue(F, PROBE_P0); p0_prologue(F); } SEAM(0);
    if (IN(1)) REP(1) {
        { pg8::Gemm g{F.wsp<bf16>(WS_XN), F.wsp<bf16>(WS_WIN), M, INW, DM}; pg8::StaticOrder S; S.init(M, INW, F.G, c);
          pg8::EpiSplitT E{F.wsp<bf16>(WS_Z), ZW, ZW, F.wsp<bf16>(WS_VT), ATTW, SEQ};
          pg8::gemm_phase<pg8::EpiSplitT, pg8::StaticOrder, true, true>(F.lds, g, S, E); }
        { const int nw3 = (M / 256) * (INW / 256) - 2 * F.G;
          int idx = -1; if (nw3 >= 0 && nw3 + 16 <= F.G) idx = c - nw3; else idx = (c < 16 && F.G >= 16) ? c : -1;
          if (F.G < 16) idx = -1;
          pg8::Gemm g{F.wsp<bf16>(WS_MEMN), F.wsp<bf16>(WS_WKV), NBATCH * 256, 2 * DM, DM};
          if (F.G >= 16) { pg8::OneUnit S{idx, 2, 8}; pg8::EpiSplitT E{F.wsp<bf16>(WS_KM), DM, DM, F.wsp<bf16>(WS_VMT), DM, 256};
              pg8::gemm_phase<pg8::EpiSplitT, pg8::OneUnit, false, true>(F.lds, g, S, E); }
          else { pg8::StaticOrder S; S.init(NBATCH * 256, 2 * DM, F.G, c); pg8::EpiSplitT E{F.wsp<bf16>(WS_KM), DM, DM, F.wsp<bf16>(WS_VMT), DM, 256};
              pg8::gemm_phase<pg8::EpiSplitT, pg8::StaticOrder, false, true>(F.lds, g, S, E); } }
        { const int first_idle = (M / 256) * (INW / 256) - 2 * F.G + 16;
          if (first_idle > 0 && first_idle < F.G) { if (c >= first_idle) convert_experts(F, (c - first_idle) * NWAVES + F.wave, (F.G - first_idle) * NWAVES); }
          else convert_experts(F, c * NWAVES + F.wave, F.G * NWAVES); }
    } SEAM(1);
    if (IN(2)) REP(2) { p2_lru_aggregates(F); } SEAM(2);
#ifndef PROBE_PARTS
#define PROBE_PARTS 3
#endif
    if (IN(3)) { if ((PHASE_REPEAT >> 3) & 1) p3_mixer(F, PROBE_PARTS); p3_mixer(F); } SEAM(3);
    if (IN(4)) REP(4) {
        pg8::Gemm g{F.wsp<bf16>(WS_Y), F.wsp<bf16>(WS_WOUT), M, DM, DM}; pg8::StaticOrder S; S.init(M, DM, F.G, c);
        pg8::EpiResid<false> E{F.in(0), F.wsp<bf16>(WS_XN), F.wsp<float>(WS_SSQ1), DM};
        pg8::gemm_phase<pg8::EpiResid<false>, pg8::StaticOrder, true, true>(F.lds, g, S, E);
    } SEAM(4);
    if (IN(5)) {
        pg8::Gemm g{F.wsp<bf16>(WS_XN), F.wsp<bf16>(WS_WQ), M, DM, DM}; pg8::StaticOrder S; S.init(M, DM, F.G, c);
        pg8::EpiRowScale E{F.wsp<bf16>(WS_QC), DM, F.wsp<float>(WS_SSQ1), 1.f / 1024.f, EPS};
        pg8::gemm_phase<pg8::EpiRowScale, pg8::StaticOrder, true, true>(F.lds, g, S, E);
        LOCAL_SEAM();
        p5_cross(F, S);
    } SEAM(6);
    if (IN(7)) {
        pg8::Gemm g{F.wsp<bf16>(WS_OC), F.wsp<bf16>(WS_WO), M, DM, DM}; pg8::StaticOrder S; S.init(M, DM, F.G, c);
        pg8::EpiResid<true> E{F.wsp<bf16>(WS_XN), F.wsp<bf16>(WS_XN), F.wsp<float>(WS_SSQ2), DM};
        pg8::gemm_phase<pg8::EpiResid<true>, pg8::StaticOrder, true, true>(F.lds, g, S, E);
    } SEAM(7);
    if (IN(8)) {
        pg8::Gemm g{F.wsp<bf16>(WS_XN), F.wsp<bf16>(WS_WQRY), M, 2 * DM, DM}; pg8::StaticOrder S; S.init(M, 2 * DM, F.G, c);
        pg8::EpiRowScale E{F.wsp<bf16>(WS_QP), 2 * DM, F.wsp<float>(WS_SSQ2), 1.f / 1024.f, EPS};
        pg8::gemm_phase<pg8::EpiRowScale, pg8::StaticOrder, true, true>(F.lds, g, S, E);
        LOCAL_SEAM();
        p8a_topk(F, S);
    } SEAM(9);
    if (IN(10)) { if ((PHASE_REPEAT >> 10) & 1) { p8b_peer(F, F.wsp<float>(WS_Z), PROBE_EMASK); } p8b_peer(F, F.out, 0x3fffu,
#ifdef PROBE_PHASE
        1.0f + (float)(((__hip_atomic_load(F.ctl + 512 + PROBE_PHASE + 1, RLX_AGENT) - __hip_atomic_load(F.ctl + 512 + PROBE_PHASE, RLX_AGENT)) + 500u) / 1000u) * 1e-2f
#else
        1.0f
#endif
        ); }
#undef IN
#undef SEAM
}

#ifndef N_LAUNCH_MODE
#define N_LAUNCH_MODE 1
#endif
extern "C" void kernel_launch(void* const* d_in, const int* in_sizes, int n_in, void* d_out, int out_size, void* d_ws, size_t ws_size, hipStream_t stream) {
    static int grid = 0;
    if (grid == 0) {
        if (n_in != 26 || out_size != M * DM || ws_size < WS_END) { fprintf(stderr, "kernel_launch: unexpected shapes (n_in %d, out %d, ws %zu)\n", n_in, out_size, ws_size); grid = -1; return; }
        int dev = 0, cus = 0, per_cu = 0;
        if (hipGetDevice(&dev) != hipSuccess || hipDeviceGetAttribute(&cus, hipDeviceAttributeMultiprocessorCount, dev) != hipSuccess) { grid = -1; return; }
        if (hipFuncSetAttribute((const void*)fwd_kernel, hipFuncAttributeMaxDynamicSharedMemorySize, LDS_BYTES) != hipSuccess) { fprintf(stderr, "kernel_launch: hipFuncSetAttribute failed\n"); grid = -1; return; }
        if (hipOccupancyMaxActiveBlocksPerMultiprocessor(&per_cu, (const void*)fwd_kernel, NWAVES * 64, LDS_BYTES) != hipSuccess || per_cu < 1) { fprintf(stderr, "kernel_launch: occupancy query says %d blocks per CU\n", per_cu); (void)hipGetLastError(); grid = -1; return; }
        grid = cus;
    }
    if (grid < 0) return;
    (void)hipMemsetAsync((char*)d_ws + WS_CTL, 0, CTL_ZERO_BYTES, stream);
    Args a{};
    for (int i = 0; i < 26; ++i) a.in[i] = (const float*)d_in[i];
    a.out = (float*)d_out; a.ws = (unsigned char*)d_ws;
    if (N_LAUNCH_MODE == 1) { a.ph_lo = 0; a.ph_hi = N_PHASES; a.li = 0; hipLaunchKernelGGL(fwd_kernel, dim3(grid), dim3(NWAVES * 64), LDS_BYTES, stream, a); }
    else { for (int p = 0; p < N_PHASES; ++p) { a.ph_lo = p; a.ph_hi = p + 1; a.li = 0; hipLaunchKernelGGL(fwd_kernel, dim3(grid), dim3(NWAVES * 64), LDS_BYTES, stream, a); } }
}
```

```cpp
#include <hip/hip_runtime.h>
#include <cstdio>
#include <cstdint>
namespace pg8 {
#define PG8_LAS __attribute__((address_space(3)))
typedef unsigned short bf16_t;
typedef short bf16x8 __attribute__((ext_vector_type(8)));
typedef float f32x4 __attribute__((ext_vector_type(4)));
typedef unsigned u32x4 __attribute__((ext_vector_type(4)));
constexpr int BM = 256, BK = 64, HALF = 128, HTB = HALF * BK * 2  , STAGE_BYTES = 8 * HTB, NXCD = 8, WGM = 8;

__host__ __device__ __forceinline__ int lds_byte(int r, int c) { const int st = (r >> 4) * 2 + (c >> 5), rr = r & 15, cc = c & 31, ob = rr * 64 + cc * 2; return st * 1024 + (ob ^ (((ob >> 9) & 1) << 5)); }
__host__ __device__ __forceinline__ void stage_rc(int b, int& R, int& C) { const int st = b / 1024, sb = b % 1024, swz = sb ^ (((sb >> 9) & 1) << 5); R = (st >> 1) * 16 + swz / 64; C = (st & 1) * 32 + (swz % 64) / 2; }
__host__ __device__ __forceinline__ int perm32(int rho) { const int n = rho >> 4, i = rho & 15; return 8 * (i >> 2) + 4 * n + (i & 3); }

struct Unit { int pm, pn; };
struct Gemm { const bf16_t* A; const bf16_t* Bt; int M, N, K; };

struct StaticOrder {
    int nM, nN, nwg, G, c;
    __host__ __device__ void init(int M, int N, int G_, int c_) { nM = M / BM; nN = N / BM; nwg = nM * nN; G = G_; c = c_; }
    __host__ __device__ bool next(int i, Unit& u) const {
        const long L = (long)i * G + c; if (L >= nwg) return false;
        int wgid = (int)L; { const int q = nwg / NXCD, r = nwg % NXCD, xcd = wgid % NXCD, off = wgid / NXCD; wgid = (xcd < r ? xcd * (q + 1) : r * (q + 1) + (xcd - r) * q) + off; }
        const int nig = WGM * nN, gid = wgid / nig, fm = gid * WGM, gsz = (nM - fm) < WGM ? (nM - fm) : WGM;
        u.pm = fm + ((wgid % nig) % gsz); u.pn = (wgid % nig) / gsz; return true;
    }
    __device__ __forceinline__ void a_ready(const Unit&) const {}
    __device__ __forceinline__ void done(const Unit&) const {}
};

typedef float f32x2 __attribute__((ext_vector_type(2)));
typedef __bf16 bf16x2_t __attribute__((ext_vector_type(2)));
__device__ __forceinline__ unsigned cvt_pk_bf16(float lo, float hi) { f32x2 v = {lo, hi}; bf16x2_t b = __builtin_convertvector(v, bf16x2_t); return __builtin_bit_cast(unsigned, b); }
__device__ __forceinline__ bf16_t cvt_bf16(float x) { return (bf16_t)(cvt_pk_bf16(x, 0.f) & 0xffffu); }

struct EpiSplitT {
    static constexpr bool PERM = true, AFTER_DRAIN = false;
    bf16_t* O; int ldc; int ncols_rm; bf16_t* T; int NT; int rpb;
    __device__ __forceinline__ void operator()(const f32x4 (&acc)[2][2][4][2], const Unit& u, int wr, int wc, int fr, int fq) const {
        const int row0 = u.pm * BM + wr * 64 + fr; const int colt = u.pn * BM;
        if (colt < ncols_rm) {
            const int col0 = colt + wc * 32 + 8 * fq;
#pragma unroll
            for (int ai = 0; ai < 2; ++ai)
#pragma unroll
                for (int m = 0; m < 4; ++m) { bf16_t* rowp = O + (size_t)(row0 + ai * HALF + m * 16) * ldc + col0;
#pragma unroll
                    for (int bj = 0; bj < 2; ++bj) { const f32x4 v0 = acc[ai][bj][m][0], v1 = acc[ai][bj][m][1];
                        u32x4 w; w.x = cvt_pk_bf16(v0[0], v0[1]); w.y = cvt_pk_bf16(v0[2], v0[3]); w.z = cvt_pk_bf16(v1[0], v1[1]); w.w = cvt_pk_bf16(v1[2], v1[3]);
                        *(u32x4*)(rowp + bj * HALF) = w; } }
        } else {
            const int c0 = colt - ncols_rm + wc * 32 + 8 * fq;
#pragma unroll
            for (int ai = 0; ai < 2; ++ai)
#pragma unroll
                for (int m = 0; m < 4; ++m) { const int row = row0 + ai * HALF + m * 16; const int b = row / rpb, t = row - b * rpb; bf16_t* base = T + (size_t)b * NT * rpb + t;
#pragma unroll
                    for (int bj = 0; bj < 2; ++bj)
#pragma unroll
                        for (int n = 0; n < 2; ++n)
#pragma unroll
                            for (int e = 0; e < 4; ++e) base[(size_t)(c0 + bj * HALF + 4 * n + e) * rpb] = cvt_bf16(acc[ai][bj][m][n][e]); }
        }
    }
};
template <bool BASE_BF16> struct EpiResid {
    static constexpr bool PERM = true, AFTER_DRAIN = false;
    const void* base; bf16_t* xb; float* ssq; int ldc;
    __device__ __forceinline__ void operator()(const f32x4 (&acc)[2][2][4][2], const Unit& u, int wr, int wc, int fr, int fq) const {
        const int row0 = u.pm * BM + wr * 64 + fr; const int col0 = u.pn * BM + wc * 32 + 8 * fq;
#pragma unroll
        for (int ai = 0; ai < 2; ++ai)
#pragma unroll
            for (int m = 0; m < 4; ++m) { const int row = row0 + ai * HALF + m * 16; float s = 0.f;
#pragma unroll
                for (int bj = 0; bj < 2; ++bj) { const size_t off = (size_t)row * ldc + col0 + bj * HALF;
                    f32x4 b0, b1;
                    if (BASE_BF16) { const u32x4 w = *(const u32x4*)((const bf16_t*)base + off);
                        b0 = (f32x4){__uint_as_float(w.x << 16), __uint_as_float(w.x & 0xffff0000u), __uint_as_float(w.y << 16), __uint_as_float(w.y & 0xffff0000u)};
                        b1 = (f32x4){__uint_as_float(w.z << 16), __uint_as_float(w.z & 0xffff0000u), __uint_as_float(w.w << 16), __uint_as_float(w.w & 0xffff0000u)}; }
                    else { b0 = *(const f32x4*)((const float*)base + off); b1 = *(const f32x4*)((const float*)base + off + 4); }
                    const f32x4 v0 = acc[ai][bj][m][0] + b0, v1 = acc[ai][bj][m][1] + b1;
                    s += (v0[0] * v0[0] + v0[1] * v0[1]) + (v0[2] * v0[2] + v0[3] * v0[3]) + (v1[0] * v1[0] + v1[1] * v1[1]) + (v1[2] * v1[2] + v1[3] * v1[3]);
                    u32x4 w; w.x = cvt_pk_bf16(v0[0], v0[1]); w.y = cvt_pk_bf16(v0[2], v0[3]); w.z = cvt_pk_bf16(v1[0], v1[1]); w.w = cvt_pk_bf16(v1[2], v1[3]);
                    *(u32x4*)(xb + off) = w; }
                s += __shfl_xor(s, 16); s += __shfl_xor(s, 32);
                if (fq == 0) ssq[(size_t)row * 16 + u.pn * 4 + wc] = s; }
    }
};
struct EpiRowScale {
    static constexpr bool PERM = true, AFTER_DRAIN = false;
    bf16_t* O; int ldc; const float* ssq; float inv_n, eps;
    __device__ __forceinline__ void operator()(const f32x4 (&acc)[2][2][4][2], const Unit& u, int wr, int wc, int fr, int fq) const {
        const int row0 = u.pm * BM + wr * 64 + fr; const int col0 = u.pn * BM + wc * 32 + 8 * fq;
#pragma unroll
        for (int ai = 0; ai < 2; ++ai)
#pragma unroll
            for (int m = 0; m < 4; ++m) { const int row = row0 + ai * HALF + m * 16; const f32x4* sp = (const f32x4*)(ssq + (size_t)row * 16);
                const f32x4 s0 = sp[0], s1 = sp[1], s2 = sp[2], s3 = sp[3]; const f32x4 st = (s0 + s1) + (s2 + s3);
                const float r = 1.0f / sqrtf(((st[0] + st[1]) + (st[2] + st[3])) * inv_n + eps);
                bf16_t* rowp = O + (size_t)row * ldc + col0;
#pragma unroll
                for (int bj = 0; bj < 2; ++bj) { const f32x4 v0 = acc[ai][bj][m][0] * r, v1 = acc[ai][bj][m][1] * r;
                    u32x4 w; w.x = cvt_pk_bf16(v0[0], v0[1]); w.y = cvt_pk_bf16(v0[2], v0[3]); w.z = cvt_pk_bf16(v1[0], v1[1]); w.w = cvt_pk_bf16(v1[2], v1[3]);
                    *(u32x4*)(rowp + bj * HALF) = w; } }
    }
};
struct OneUnit {
    int idx, nM, nN;
    __device__ __forceinline__ bool next(int i, Unit& u) const { if (i > 0 || idx < 0 || idx >= nM * nN) return false; u.pm = idx % nM; u.pn = idx / nM; return true; }
    __device__ __forceinline__ void a_ready(const Unit&) const {}
    __device__ __forceinline__ void done(const Unit&) const {}
};

template <class Epi, class Sched, bool ALIGN_EPI = false, bool SP2 = false>
__device__ __forceinline__ void gemm_phase(PG8_LAS unsigned char* lds, const Gemm g, const Sched& S, const Epi& E) {
    const int tid = threadIdx.x, wid = __builtin_amdgcn_readfirstlane(tid >> 6), lane = tid & 63, wr = wid >> 2, wc = wid & 3, fr = lane & 15, fq = lane >> 4;
    const int K = g.K, nt = K / BK;
    unsigned voffA[2], voffB[2];
#pragma unroll
    for (int i = 0; i < 2; ++i) { int R, C; stage_rc(tid * 16 + i * 8192, R, C); const int Rb = Epi::PERM ? ((R & ~31) + perm32(R & 31)) : R;
        voffA[i] = (unsigned)(R * K + C) * 2u; voffB[i] = (unsigned)(Rb * K + C) * 2u; }
    const size_t kstep = (size_t)(BK * 2);
    const size_t hstep = (size_t)HALF * K * 2;
    const size_t tstep = 2 * hstep;
    const unsigned ldsw = (unsigned)wid * 1024u;
    const int aoff = lds_byte(wr * 64 + fr, fq * 8), boff = lds_byte(wc * 32 + fr, fq * 8);
#define PG8_SA(b, h) (((b) * 2 + (h)) * HTB)
#define PG8_SB(b, h) ((4 + (b) * 2 + (h)) * HTB)
#define PG8_STAGE(bufoff, gbase, voff) do { _Pragma("unroll") for (int _i = 0; _i < 2; ++_i) \
        __builtin_amdgcn_global_load_lds((const unsigned*)((const char*)(gbase) + (voff)[_i]), (PG8_LAS unsigned*)(lds + (bufoff) + ldsw + _i * 8192), 16, 0, 0); } while (0)
#define PG8_LDA(dst, b, h) do { _Pragma("unroll") for (int m = 0; m < 4; ++m) _Pragma("unroll") for (int k = 0; k < 2; ++k) dst[m][k] = *(const PG8_LAS bf16x8*)(lds + PG8_SA(b, h) + aoff + m * 2048 + k * 1024); } while (0)
#define PG8_LDB(dst, b, h) do { _Pragma("unroll") for (int n = 0; n < 2; ++n) _Pragma("unroll") for (int k = 0; k < 2; ++k) dst[n][k] = *(const PG8_LAS bf16x8*)(lds + PG8_SB(b, h) + boff + n * 2048 + k * 1024); } while (0)
#define PG8_MMA(ai, bj, At, Bt) do { __builtin_amdgcn_s_setprio(1); _Pragma("unroll") for (int m = 0; m < 4; ++m) _Pragma("unroll") for (int n = 0; n < 2; ++n) _Pragma("unroll") for (int k = 0; k < 2; ++k) \
        acc[ai][bj][m][n] = __builtin_amdgcn_mfma_f32_16x16x32_bf16(Bt[n][k], At[m][k], acc[ai][bj][m][n], 0, 0, 0); __builtin_amdgcn_s_setprio(0); } while (0)
#define PG8_WAIT_V(n) asm volatile("s_waitcnt vmcnt(" #n ")" ::: "memory")
#define PG8_WAIT_L(n) asm volatile("s_waitcnt lgkmcnt(" #n ")" ::: "memory")
#define PG8_BAR __builtin_amdgcn_s_barrier()
#define PG8_SCHED __builtin_amdgcn_sched_barrier(0)
    Unit cur, nxt; int ui = 0;
    if (!S.next(0, cur)) return;
    f32x4 acc[2][2][4][2];
#pragma unroll
    for (int a = 0; a < 2; ++a)
#pragma unroll
        for (int b = 0; b < 2; ++b)
#pragma unroll
            for (int m = 0; m < 4; ++m)
#pragma unroll
                for (int n = 0; n < 2; ++n) acc[a][b][m][n] = (f32x4){0.f, 0.f, 0.f, 0.f};
    bf16x8 At[4][2], B0[2][2], B1[2][2];
    const char* cA = (const char*)g.A + (size_t)cur.pm * tstep; const char* cB = (const char*)g.Bt + (size_t)cur.pn * tstep;
    S.a_ready(cur);
    if constexpr (SP2) {
        PG8_STAGE(PG8_SB(0, 0), cB, voffB); PG8_STAGE(PG8_SB(0, 1), cB + hstep, voffB); PG8_STAGE(PG8_SA(0, 0), cA, voffA); PG8_STAGE(PG8_SA(0, 1), cA + hstep, voffA);
        if (wr == 1) PG8_BAR;
        PG8_WAIT_V(2); PG8_BAR;
        PG8_STAGE(PG8_SB(1, 0), cB + kstep, voffB); PG8_STAGE(PG8_SA(1, 0), cA + kstep, voffA); PG8_STAGE(PG8_SB(1, 1), cB + hstep + kstep, voffB);
        PG8_WAIT_V(6); PG8_BAR;
    } else {
        PG8_STAGE(PG8_SB(0, 0), cB, voffB); PG8_STAGE(PG8_SA(0, 0), cA, voffA); PG8_STAGE(PG8_SB(0, 1), cB + hstep, voffB); PG8_STAGE(PG8_SA(0, 1), cA + hstep, voffA);
        if (wr == 1) PG8_BAR;
        PG8_WAIT_V(4); PG8_BAR;
        PG8_STAGE(PG8_SB(1, 0), cB + kstep, voffB); PG8_STAGE(PG8_SA(1, 0), cA + kstep, voffA); PG8_STAGE(PG8_SB(1, 1), cB + hstep + kstep, voffB);
        PG8_WAIT_V(6); PG8_BAR;
    }
    for (;;) {
        const bool has_next = S.next(ui + 1, nxt);
        const char* nA = has_next ? (const char*)g.A + (size_t)nxt.pm * tstep : cA; const char* nB = has_next ? (const char*)g.Bt + (size_t)nxt.pn * tstep : cB;
        for (int t = 0; t < nt; t += 2) {
            const bool last = (t == nt - 2);
            const char* a1 = cA + (size_t)(t + 1) * kstep;
            const char* a2 = last ? nA : cA + (size_t)(t + 2) * kstep; const char* b2 = last ? nB : cB + (size_t)(t + 2) * kstep;
            const char* a3 = a2 + kstep; const char* b3 = b2 + kstep;
            if (last && has_next) S.a_ready(nxt);
            if constexpr (SP2) {
            PG8_LDB(B0, 0, 0); PG8_LDB(B1, 0, 1); PG8_SCHED; PG8_LDA(At, 0, 0); PG8_STAGE(PG8_SA(1, 1), a1 + hstep, voffA);
            PG8_WAIT_V(8); PG8_WAIT_L(0); PG8_BAR; PG8_MMA(0, 0, At, B0); PG8_MMA(0, 1, At, B1); PG8_BAR; PG8_SCHED;
            PG8_LDA(At, 0, 1); PG8_STAGE(PG8_SB(0, 0), b2, voffB); PG8_STAGE(PG8_SB(0, 1), b2 + hstep, voffB); PG8_STAGE(PG8_SA(0, 0), a2, voffA);
            PG8_WAIT_V(8); PG8_WAIT_L(0); PG8_BAR; PG8_MMA(1, 0, At, B0); PG8_MMA(1, 1, At, B1); PG8_BAR; PG8_SCHED;
            PG8_LDB(B0, 1, 0); PG8_LDB(B1, 1, 1); PG8_SCHED; PG8_LDA(At, 1, 0); PG8_STAGE(PG8_SA(0, 1), a2 + hstep, voffA);
            PG8_WAIT_V(8); PG8_WAIT_L(0); PG8_BAR; PG8_MMA(0, 0, At, B0); PG8_MMA(0, 1, At, B1); PG8_BAR; PG8_SCHED;
            PG8_LDA(At, 1, 1); PG8_STAGE(PG8_SB(1, 0), b3, voffB); PG8_STAGE(PG8_SB(1, 1), b3 + hstep, voffB); PG8_STAGE(PG8_SA(1, 0), a3, voffA);
            PG8_WAIT_V(8); PG8_WAIT_L(0); PG8_BAR; PG8_MMA(1, 0, At, B0); PG8_MMA(1, 1, At, B1); PG8_BAR; PG8_SCHED;
            } else {
            PG8_LDB(B0, 0, 0); PG8_SCHED; PG8_LDA(At, 0, 0); PG8_STAGE(PG8_SA(1, 1), a1 + hstep, voffA);
            PG8_WAIT_L(8); PG8_BAR; PG8_WAIT_L(0); PG8_MMA(0, 0, At, B0); PG8_BAR; PG8_SCHED;
            PG8_LDB(B1, 0, 1); PG8_STAGE(PG8_SB(0, 0), b2, voffB);
            PG8_BAR; PG8_WAIT_L(0); PG8_MMA(0, 1, At, B1); PG8_BAR;
            PG8_LDA(At, 0, 1); PG8_STAGE(PG8_SA(0, 0), a2, voffA);
            PG8_BAR; PG8_WAIT_L(0); PG8_MMA(1, 0, At, B0); PG8_BAR; PG8_SCHED;
            PG8_STAGE(PG8_SB(0, 1), b2 + hstep, voffB);
            PG8_WAIT_V(6); PG8_BAR; PG8_MMA(1, 1, At, B1); PG8_BAR;
            PG8_LDB(B0, 1, 0); PG8_SCHED; PG8_LDA(At, 1, 0); PG8_STAGE(PG8_SA(0, 1), a2 + hstep, voffA);
            PG8_WAIT_L(8); PG8_BAR; PG8_WAIT_L(0); PG8_MMA(0, 0, At, B0); PG8_BAR; PG8_SCHED;
            PG8_LDB(B1, 1, 1); PG8_STAGE(PG8_SB(1, 0), b3, voffB);
            PG8_BAR; PG8_WAIT_L(0); PG8_MMA(0, 1, At, B1); PG8_BAR;
            PG8_LDA(At, 1, 1); PG8_STAGE(PG8_SA(1, 0), a3, voffA);
            PG8_BAR; PG8_WAIT_L(0); PG8_MMA(1, 0, At, B0); PG8_BAR; PG8_SCHED;
            PG8_STAGE(PG8_SB(1, 1), b3 + hstep, voffB);
            PG8_WAIT_V(6); PG8_BAR; PG8_MMA(1, 1, At, B1); PG8_BAR;
            }
        }
        if constexpr (ALIGN_EPI) { if (wr == 0) PG8_BAR; }
        if constexpr (!Epi::AFTER_DRAIN) { E(acc, cur, wr, wc, fr, fq); S.done(cur); }
        if (!has_next) break;
#pragma unroll
        for (int a = 0; a < 2; ++a)
#pragma unroll
            for (int b = 0; b < 2; ++b)
#pragma unroll
                for (int m = 0; m < 4; ++m)
#pragma unroll
                    for (int n = 0; n < 2; ++n) acc[a][b][m][n] = (f32x4){0.f, 0.f, 0.f, 0.f};
        cur = nxt; cA = nA; cB = nB; ++ui;
        if constexpr (ALIGN_EPI) { if (wr == 1) PG8_BAR; }
    }
    PG8_WAIT_V(0);
    if constexpr (!ALIGN_EPI) { if (wr == 0) PG8_BAR; }
    PG8_BAR;
    if constexpr (Epi::AFTER_DRAIN) { E.fused(acc, cur, wr, wc, fr, fq, lds, wid, lane); S.done(cur); }
#undef PG8_SA
#undef PG8_SB
#undef PG8_STAGE
#undef PG8_LDA
#undef PG8_LDB
#undef PG8_MMA
#undef PG8_WAIT_V
#undef PG8_WAIT_L
#undef PG8_BAR
#undef PG8_SCHED
}
}

#ifndef PG8_SP2
#define PG8_SP2 true
#endif
#ifndef PG8_ALIGN
#define PG8_ALIGN true
#endif
constexpr int NWAVES = 8;
constexpr int NBATCH = 2, SEQ = 8192, DM = 1024, M = NBATCH * SEQ;
constexpr int INW = 2560, ZW = 2048;
constexpr int LRUW = 512, ATTW = 512, NCHUNK = SEQ / 64;
constexpr int NEXP = 16384, PEER_H = 8, NSEL = 128;
constexpr float EPS = 1e-6f;
constexpr float LOG2E = 1.4426950408889634f;

constexpr size_t MiB = 1u << 20;
constexpr size_t WS_CTL = 0, CTL_ZERO_BYTES = 64 * 1024;
constexpr size_t WS_WIN = 1 * MiB, WS_WOUT = 6 * MiB, WS_WQ = 8 * MiB, WS_WKV = 10 * MiB, WS_WO = 14 * MiB, WS_WQRY = 16 * MiB;
constexpr size_t WS_SUBK = 20 * MiB, WS_GATEW = 20 * MiB + 512 * 1024, WS_MEMN = 21 * MiB, WS_KM = 22 * MiB, WS_VMT = 23 * MiB, WS_AGG = 24 * MiB, WS_SSQ1 = 25 * MiB, WS_SSQ2 = 26 * MiB, WS_SU = 27 * MiB;
constexpr size_t WS_EU = 28 * MiB, WS_EV = 60 * MiB, WS_XN = 92 * MiB, WS_Z = 124 * MiB, WS_VT = 188 * MiB, WS_Y = 204 * MiB, WS_END = 236 * MiB;
constexpr size_t WS_QC = WS_Z, WS_OC = WS_Z + 32 * MiB, WS_QP = WS_Z, WS_IDX = WS_VT, WS_G = WS_VT + 8 * MiB;
constexpr int CW_BAR = 4096;

constexpr int RING_BYTES = 155648;
constexpr int LDSCTL_OFF = RING_BYTES, MISC_OFF = LDSCTL_OFF + 320;
constexpr int LDS_BYTES = 163840;

#define GAS __attribute__((address_space(1)))
#define LAS __attribute__((address_space(3)))
typedef unsigned short bf16;
typedef unsigned v4u __attribute__((ext_vector_type(4)));
typedef unsigned v2u __attribute__((ext_vector_type(2)));
typedef float f32x4 __attribute__((ext_vector_type(4)));
typedef float f32x2 __attribute__((ext_vector_type(2)));
typedef float f32x16 __attribute__((ext_vector_type(16)));
typedef short bf16x8 __attribute__((ext_vector_type(8)));
typedef __bf16 bf16x2_t __attribute__((ext_vector_type(2)));
typedef GAS unsigned gu32;
typedef _Float16 v32h __attribute__((ext_vector_type(32)));
typedef unsigned v6u __attribute__((ext_vector_type(6)));
typedef _Float16 f16x2_t __attribute__((ext_vector_type(2)));
constexpr int EV_ROW = 768;
#define RLX_AGENT __ATOMIC_RELAXED, __HIP_MEMORY_SCOPE_AGENT
#define LDS_WAIT() asm volatile("s_waitcnt lgkmcnt(0)" ::: "memory")
#define VM_WAIT() asm volatile("s_waitcnt vmcnt(0)" ::: "memory")
#define MFMA32(a, b, c) __builtin_amdgcn_mfma_f32_32x32x16_bf16((a), (b), (c), 0, 0, 0)
#define DI __device__ __forceinline__

DI unsigned pk2(float lo, float hi) { f32x2 v = {lo, hi}; bf16x2_t b = __builtin_convertvector(v, bf16x2_t); return __builtin_bit_cast(unsigned, b); }
DI bf16 f2bf(float x) { return (bf16)(pk2(x, 0.f) & 0xffffu); }
DI float bf2f(bf16 x) { return __uint_as_float((unsigned)x << 16); }
DI float bflo(unsigned p) { return __uint_as_float(p << 16); }
DI float bfhi(unsigned p) { return __uint_as_float(p & 0xffff0000u); }
DI int crow(int reg, int hh) { return (reg & 3) + 8 * (reg >> 2) + 4 * hh; }
DI float swap32_partner(float x, int hh) { auto rr = __builtin_amdgcn_permlane32_swap(__float_as_uint(x), __float_as_uint(x), false, false); return __uint_as_float(hh ? rr[0] : rr[1]); }
DI float dpp_xor1(float x) { return __int_as_float(__builtin_amdgcn_update_dpp(0, __float_as_int(x), 0xB1, 0xf, 0xf, true)); }
DI float dpp_xor2(float x) { return __int_as_float(__builtin_amdgcn_update_dpp(0, __float_as_int(x), 0x4E, 0xf, 0xf, true)); }
DI float dpp_hmir(float x) { return __int_as_float(__builtin_amdgcn_update_dpp(0, __float_as_int(x), 0x141, 0xf, 0xf, true)); }
DI float dpp_mir(float x)  { return __int_as_float(__builtin_amdgcn_update_dpp(0, __float_as_int(x), 0x140, 0xf, 0xf, true)); }
DI float sum16(float x) { x += dpp_xor1(x); x += dpp_xor2(x); x += dpp_hmir(x); x += dpp_mir(x); return x; }
DI float sum32(float x) { x = sum16(x); auto rr = __builtin_amdgcn_permlane16_swap(__float_as_uint(x), __float_as_uint(x), false, false); return __uint_as_float(rr[0]) + __uint_as_float(rr[1]); }
DI float max16(float x) { x = fmaxf(x, dpp_xor1(x)); x = fmaxf(x, dpp_xor2(x)); x = fmaxf(x, dpp_hmir(x)); x = fmaxf(x, dpp_mir(x)); return x; }
DI float max64(float x) { x = max16(x); { auto rr = __builtin_amdgcn_permlane16_swap(__float_as_uint(x), __float_as_uint(x), false, false); x = fmaxf(__uint_as_float(rr[0]), __uint_as_float(rr[1])); }
    { auto rr = __builtin_amdgcn_permlane32_swap(__float_as_uint(x), __float_as_uint(x), false, false); x = fmaxf(__uint_as_float(rr[0]), __uint_as_float(rr[1])); } return x; }
DI unsigned pack_i8x4(float a, float b, float c, float d) { const int ia = (int)__builtin_rintf(a), ib = (int)__builtin_rintf(b), ic = (int)__builtin_rintf(c), id = (int)__builtin_rintf(d);
    return (unsigned)(ia & 255) | ((unsigned)(ib & 255) << 8) | ((unsigned)(ic & 255) << 16) | ((unsigned)id << 24); }
DI float max32(float x) { x = max16(x); auto rr = __builtin_amdgcn_permlane16_swap(__float_as_uint(x), __float_as_uint(x), false, false); return fmaxf(__uint_as_float(rr[0]), __uint_as_float(rr[1])); }
DI float sum64(float x) { x = sum32(x); auto rr = __builtin_amdgcn_permlane32_swap(__float_as_uint(x), __float_as_uint(x), false, false); return __uint_as_float(rr[0]) + __uint_as_float(rr[1]); }
DI float rcp_(float x) { return __builtin_amdgcn_rcpf(x); }
DI float rsq_(float x) { return __builtin_amdgcn_rsqf(x); }
DI float exp2_(float x) { return __builtin_amdgcn_exp2f(x); }
DI float gelu_tanh(float x) { const float u = x * (1.5957691216057308f + 0.07135481627159768f * x * x); return x * rcp_(1.0f + exp2_(-LOG2E * u)); }
DI float sigmoidf_(float x) { return rcp_(1.0f + exp2_(-LOG2E * x)); }
#define XB_TMO      128
#define XB_XCNT(j)  (256  + 64 * (j))
#define XB_XSUB(j)  (1280 + 64 * (j))
#define XB_XGEN(j)  (2304 + 64 * (j))
#define XB_TOP      3328
#define XB_TOPGEN   3392
#define XCD_BAR_WORDS 3456
#define XB_SPIN_CAP (1u << 18)

__device__ __forceinline__ unsigned xb_ld(unsigned* p)              { return __hip_atomic_load(p, __ATOMIC_RELAXED, __HIP_MEMORY_SCOPE_AGENT); }
__device__ __forceinline__ unsigned xb_add(unsigned* p, unsigned v) { return __hip_atomic_fetch_add(p, v, __ATOMIC_RELAXED, __HIP_MEMORY_SCOPE_AGENT); }
__device__ __forceinline__ unsigned xb_xcc_id() { return (unsigned)__builtin_amdgcn_s_getreg((3 << 11) | 20) & 0xFu; }
#define XB_SPIN(cond, bar) do { unsigned _sp = 0; while (cond) { __builtin_amdgcn_s_sleep(1); \
    if ((++_sp & 255u) == 0u) { if (xb_ld(&(bar)[XB_TMO])) break; if (_sp > XB_SPIN_CAP) { atomicAdd(&(bar)[XB_TMO], 1u); break; } } } } while (0)

struct XcdBarrier {
    unsigned* bar; unsigned x;
    volatile LAS unsigned* st;
};

__device__ __forceinline__ XcdBarrier xcd_barrier_post(unsigned* bar, volatile LAS unsigned* st) {
    XcdBarrier b; b.bar = bar; b.x = xb_xcc_id(); b.st = st;
    if (threadIdx.x == 0) (void)xb_add(&bar[XB_XCNT(b.x)], 1u);
    return b;
}
__device__ __forceinline__ void xcd_barrier_complete(unsigned* bar, unsigned x, unsigned& nloc, unsigned& nx) {
    const unsigned G = gridDim.x * gridDim.y * gridDim.z;
    unsigned sum, cnt, mine, sp = 0u;
    for (;;) {
        sum = 0u; cnt = 0u; mine = 0u;
#pragma unroll
        for (unsigned j = 0; j < 16; ++j) { const unsigned c = xb_ld(&bar[XB_XCNT(j)]); sum += c; cnt += (c > 0u) ? 1u : 0u; mine = (j == x) ? c : mine; }
        if (sum == G) break;
        __builtin_amdgcn_s_sleep(1);
        if ((++sp & 255u) == 0u) { if (xb_ld(&bar[XB_TMO])) break; if (sp > XB_SPIN_CAP) { atomicAdd(&bar[XB_TMO], 1u); break; } }
    }
    nloc = mine > 0u ? mine : 1u; nx = cnt > 0u ? cnt : 1u;
}

__device__ __forceinline__ void xcd_barrier(const XcdBarrier& b) {
    asm volatile("s_waitcnt vmcnt(0)" ::: "memory");
    __syncthreads();
    if (threadIdx.x == 0) {
        unsigned* bar = b.bar;
        __builtin_amdgcn_s_waitcnt(0);
        unsigned nloc = b.st[0], nx = b.st[1];
        if (nloc == 0u) { xcd_barrier_complete(bar, b.x, nloc, nx); b.st[0] = nloc; b.st[1] = nx; }
        const unsigned old = xb_add(&bar[XB_XSUB(b.x)], 1u);
        const unsigned gen = old / nloc;
        if (old + 1u == (gen + 1u) * nloc) {
            __builtin_amdgcn_fence(__ATOMIC_RELEASE, "agent");
            asm volatile("s_waitcnt vmcnt(0)" ::: "memory");
            const unsigned og = xb_add(&bar[XB_TOP], 1u);
            const unsigned tg = og / nx;
            if (og + 1u == (tg + 1u) * nx) xb_add(&bar[XB_TOPGEN], 1u);
            else XB_SPIN(xb_ld(&bar[XB_TOPGEN]) == tg, bar);
            __builtin_amdgcn_fence(__ATOMIC_ACQUIRE, "agent");
            xb_add(&bar[XB_XGEN(b.x)], 1u);
            asm volatile("s_waitcnt vmcnt(0)" ::: "memory");
        } else {
            XB_SPIN(xb_ld(&bar[XB_XGEN(b.x)]) == gen, bar);
            __builtin_amdgcn_fence(__ATOMIC_ACQUIRE, "agent");
            asm volatile("s_waitcnt vmcnt(0)" ::: "memory");
        }
    }
    __syncthreads();
}
struct Args { const float* in[26]; float* out; unsigned char* ws; int ph_lo, ph_hi, li, pad; };
struct Frame {
    LAS unsigned char* lds;
    volatile LAS unsigned* MISC;
    gu32* ctl;
    int tid, lane, wave, vcu, G;
    const Args* A; float* out; unsigned char* ws;
    DI const float* in(int k) const { return A->in[k]; }
    template <class T> DI T* wsp(size_t off) const { return (T*)(ws + off); }
};

DI void p0_transpose_item(const float* W, int K, int N, bf16* WT, LAS float* scr, int item, int lane, const float* g0, const float* g1, int gsplit) {
    const int nblk = N / 32, kb = item / nblk, nb = item % nblk, k0 = 64 * kb, n0 = 32 * nb;
    float wv[32], gv[32];
#pragma unroll
    for (int i = 0; i < 32; ++i) { const int k = k0 + 2 * i + (lane >> 5); wv[i] = W[(size_t)k * N + n0 + (lane & 31)]; gv[i] = g0 ? ((k < gsplit) ? g0[k] : g1[k - gsplit]) : 1.f; }
#pragma unroll
    for (int i = 0; i < 32; ++i) scr[(2 * i + (lane >> 5)) * 33 + (lane & 31)] = wv[i] * gv[i];
    LDS_WAIT(); asm volatile("" ::: "memory");
    const int c = lane & 7;
#pragma unroll
    for (int j = 0; j < 4; ++j) { const int n = (lane >> 3) + 8 * j; const LAS float* s = scr + (8 * c) * 33 + n;
        v4u o; o.x = pk2(s[0 * 33], s[1 * 33]); o.y = pk2(s[2 * 33], s[3 * 33]); o.z = pk2(s[4 * 33], s[5 * 33]); o.w = pk2(s[6 * 33], s[7 * 33]);
        *(GAS v4u*)(WT + (size_t)(n0 + n) * K + k0 + 8 * c) = o; }
    LDS_WAIT(); asm volatile("" ::: "memory");
}
template <bool NORM> DI void row_to_bf16(const float* xrow, bf16* orow, const float* gain, int lane) {
    const GAS f32x4* xr = (const GAS f32x4*)xrow + lane;
    f32x4 v[4]; float s = 0.f;
#pragma unroll
    for (int j = 0; j < 4; ++j) { v[j] = xr[64 * j]; s += (v[j].x * v[j].x + v[j].y * v[j].y) + (v[j].z * v[j].z + v[j].w * v[j].w); }
    float rstd = 1.f;
    if (NORM) rstd = 1.0f / sqrtf(sum64(s) * (1.f / 1024.f) + EPS);
    GAS v2u* o8 = (GAS v2u*)orow + lane;
#pragma unroll
    for (int j = 0; j < 4; ++j) { f32x4 w = v[j] * rstd; if (gain) w = w * ((const GAS f32x4*)gain)[64 * j + lane];
        v2u o; o.x = pk2(w.x, w.y); o.y = pk2(w.z, w.w); o8[64 * j] = o; }
}
constexpr float U_SCALE = 128.f, V_SCALE = 16.f;
template <bool NORM, int NB> DI void rows_to_bf16(const float* xrow, bf16* orow, size_t row_stride, const float* gain, int lane) {
    f32x4 v[NB][4];
#pragma unroll
    for (int b = 0; b < NB; ++b)
#pragma unroll
        for (int j = 0; j < 4; ++j) v[b][j] = ((const GAS f32x4*)(xrow + b * row_stride))[64 * j + lane];
#pragma unroll
    for (int b = 0; b < NB; ++b) { float s = 0.f;
#pragma unroll
        for (int j = 0; j < 4; ++j) s += (v[b][j].x * v[b][j].x + v[b][j].y * v[b][j].y) + (v[b][j].z * v[b][j].z + v[b][j].w * v[b][j].w);
        float rstd = 1.f; if (NORM) rstd = rsq_(sum64(s) * (1.f / 1024.f) + EPS);
        GAS v2u* o8 = (GAS v2u*)(orow + b * row_stride) + lane;
#pragma unroll
        for (int j = 0; j < 4; ++j) { f32x4 w = v[b][j] * rstd; if (gain) w = w * ((const GAS f32x4*)gain)[64 * j + lane];
            v2u o; o.x = pk2(w.x, w.y); o.y = pk2(w.z, w.w); o8[64 * j] = o; } }
}
DI void row_to_fp8(const float* src, unsigned char* dst, const float* gain, float scale, int lane) {
#pragma unroll
    for (int j = 0; j < 4; ++j) { f32x4 v = ((const GAS f32x4*)src)[64 * j + lane] * scale; if (gain) v = v * ((const GAS f32x4*)gain)[64 * j + lane];
        unsigned w = 0u; w = __builtin_amdgcn_cvt_pk_fp8_f32(v.x, v.y, w, false); w = __builtin_amdgcn_cvt_pk_fp8_f32(v.z, v.w, w, true);
        ((GAS unsigned*)dst)[64 * j + lane] = w; }
}
DI void row_to_i8(const float* src, unsigned char* dst, const float* gain, float* scale_out, int lane) {
    f32x4 v[4]; float mx = 0.f;
#pragma unroll
    for (int j = 0; j < 4; ++j) { v[j] = ((const GAS f32x4*)src)[64 * j + lane] * ((const GAS f32x4*)gain)[64 * j + lane];
        mx = fmaxf(fmaxf(mx, fmaxf(fabsf(v[j].x), fabsf(v[j].y))), fmaxf(fabsf(v[j].z), fabsf(v[j].w))); }
    mx = fmaxf(max64(mx), 1e-30f);
    const float inv = 127.0f / mx;
#pragma unroll
    for (int j = 0; j < 4; ++j) ((GAS unsigned*)dst)[64 * j + lane] = pack_i8x4(v[j].x * inv, v[j].y * inv, v[j].z * inv, v[j].w * inv);
    if (lane == 0) *scale_out = mx * (1.0f / 127.0f);
}
DI void convert_experts(Frame& F, int wv, int nwv) {
    const int lane = F.lane;
    const int l5 = lane & 31, hh = lane >> 5;
    for (int m = wv * 2; m < NEXP; m += nwv * 2) {
        f32x4 u[2][4], v[8];
#pragma unroll
        for (int b = 0; b < 2; ++b)
#pragma unroll
            for (int j = 0; j < 4; ++j) u[b][j] = ((const GAS f32x4*)(F.in(23) + (size_t)(m + b) * DM))[64 * j + lane];
#pragma unroll
        for (int j = 0; j < 8; ++j) v[j] = ((const GAS f32x4*)(F.in(24) + (size_t)(m + hh) * DM))[32 * j + l5];
#pragma unroll
        for (int b = 0; b < 2; ++b) {
            float mx = 0.f;
#pragma unroll
            for (int j = 0; j < 4; ++j) { u[b][j] = u[b][j] * ((const GAS f32x4*)F.in(20))[64 * j + lane];
                mx = fmaxf(fmaxf(mx, fmaxf(fabsf(u[b][j].x), fabsf(u[b][j].y))), fmaxf(fabsf(u[b][j].z), fabsf(u[b][j].w))); }
            mx = fmaxf(max64(mx), 1e-30f);
            const float inv = 127.0f / mx;
#pragma unroll
            for (int j = 0; j < 4; ++j) ((GAS unsigned*)(F.wsp<unsigned char>(WS_EU) + (size_t)(m + b) * DM))[64 * j + lane] = pack_i8x4(u[b][j].x * inv, u[b][j].y * inv, u[b][j].z * inv, u[b][j].w * inv);
            if (lane == 0) F.wsp<float>(WS_SU)[m + b] = mx * (1.0f / 127.0f);
        }
        {
            float mx = 0.f;
#pragma unroll
            for (int j = 0; j < 8; ++j) mx = fmaxf(fmaxf(mx, fmaxf(fabsf(v[j].x), fabsf(v[j].y))), fmaxf(fabsf(v[j].z), fabsf(v[j].w)));
            mx = fmaxf(max32(mx), 1e-30f);
            const float inv = 7.5f / mx;
            v32h h;
#pragma unroll
            for (int j = 0; j < 8; ++j) { h[4 * j] = (_Float16)(v[j].x * inv); h[4 * j + 1] = (_Float16)(v[j].y * inv); h[4 * j + 2] = (_Float16)(v[j].z * inv); h[4 * j + 3] = (_Float16)(v[j].w * inv); }
            const v6u pk = __builtin_amdgcn_cvt_scalef32_pk32_fp6_f16(h, 1.0f);
            unsigned char* rowp = F.wsp<unsigned char>(WS_EV) + (size_t)(m + hh) * EV_ROW;
            *(GAS v4u*)(rowp + 16 * l5) = (v4u){pk[0], pk[1], pk[2], pk[3]}; *(GAS v2u*)(rowp + 512 + 8 * l5) = (v2u){pk[4], pk[5]};
            if (l5 == 0) F.wsp<float>(WS_SU)[NEXP + m + hh] = mx * (1.0f / 7.5f);
        }
    }
}
DI void p0_prologue(Frame& F, int parts = 7) {
    LAS float* scr = (LAS float*)(F.lds + F.wave * 16384);
    const int gw = F.vcu * NWAVES + F.wave, NGW = F.G * NWAVES, lane = F.lane;
    constexpr int I_IN = 16 * (INW / 32), I_D = 16 * (DM / 32), I_2D = 16 * (2 * DM / 32);
    constexpr int NITEMS = I_IN + 3 * I_D + 2 * I_2D;
    for (int it = gw; it < ((parts & 1) ? NITEMS : 0); it += NGW) {
        int r = it;
        if (r < I_IN) { p0_transpose_item(F.in(3), DM, INW, F.wsp<bf16>(WS_WIN), scr, r, lane, F.in(2), F.in(2), DM); continue; } r -= I_IN;
        if (r < I_D) { p0_transpose_item(F.in(14), DM, DM, F.wsp<bf16>(WS_WOUT), scr, r, lane, F.in(12), F.in(13), LRUW); continue; } r -= I_D;
        if (r < I_D) { p0_transpose_item(F.in(17), DM, DM, F.wsp<bf16>(WS_WQ), scr, r, lane, F.in(15), F.in(15), DM); continue; } r -= I_D;
        if (r < I_2D) { p0_transpose_item(F.in(18), DM, 2 * DM, F.wsp<bf16>(WS_WKV), scr, r, lane, nullptr, nullptr, 0); continue; } r -= I_2D;
        if (r < I_D) { p0_transpose_item(F.in(19), DM, DM, F.wsp<bf16>(WS_WO), scr, r, lane, nullptr, nullptr, 0); continue; } r -= I_D;
        p0_transpose_item(F.in(21), DM, 2 * DM, F.wsp<bf16>(WS_WQRY), scr, r, lane, F.in(20), F.in(20), DM);
    }
    for (int m = gw * 4; m < ((parts & 2) ? M : 0); m += NGW * 4) rows_to_bf16<true, 4>(F.in(0) + (size_t)m * DM, F.wsp<bf16>(WS_XN) + (size_t)m * DM, DM, nullptr, lane);
    for (int m = gw; m < NBATCH * 256; m += NGW) row_to_bf16<true>(F.in(1) + (size_t)m * DM, F.wsp<bf16>(WS_MEMN) + (size_t)m * DM, F.in(16), lane);
    { const int gt = gw * 64 + lane, NT = NGW * 64;
      for (int i = gt; i < 8 * 2 * 128 * 128 / 4; i += NT) { const f32x4 v = ((const GAS f32x4*)F.in(22))[i]; v2u o; o.x = pk2(v.x, v.y); o.y = pk2(v.z, v.w); ((GAS v2u*)F.wsp<bf16>(WS_SUBK))[i] = o; }
      for (int o = gt; o < 2 * 8 * 64 * 64; o += NT) { const int i = o & 63, j = (o >> 6) & 63, h = (o >> 12) & 7, g = o >> 15;
          const float* W = g ? F.in(8) : F.in(6); F.wsp<bf16>(WS_GATEW)[o] = f2bf(W[(h * 64 + i) * 64 + j]); } }
}
struct LruState { float ba[2], bx[2], sp[2], S[2], Ap[2]; };
template <bool PASS2>
DI void lru_prep(const Frame& F, int b, int chunk, int h, int lane, LAS unsigned char* xcs  , LruState& st) {
    const int r = lane & 31, hh = lane >> 5;
    const size_t row0 = (size_t)b * SEQ + (size_t)chunk * 64;
    {
        const int c2 = h * 64 + 2 * r;
        const f32x2 w0 = *(const f32x2*)(F.in(4) + c2), w1 = *(const f32x2*)(F.in(4) + LRUW + c2), w2 = *(const f32x2*)(F.in(4) + 2 * LRUW + c2), w3 = *(const f32x2*)(F.in(4) + 3 * LRUW + c2);
        const f32x2 cb = *(const f32x2*)(F.in(5) + c2);
        const int tl0 = 32 * hh;
        const bf16* zp = F.wsp<bf16>(WS_Z) + (row0 + tl0) * ZW + c2;
        const bool first = (chunk == 0 && hh == 0);
        unsigned p0 = first ? 0u : *(const unsigned*)(zp - 3 * ZW), p1 = first ? 0u : *(const unsigned*)(zp - 2 * ZW), p2 = first ? 0u : *(const unsigned*)(zp - ZW);
#pragma unroll
        for (int t = 0; t < 32; ++t) { const unsigned p3 = *(const unsigned*)(zp + (size_t)t * ZW);
            const float lo = cb.x + bflo(p0) * w0.x + bflo(p1) * w1.x + bflo(p2) * w2.x + bflo(p3) * w3.x;
            const float hi = cb.y + bfhi(p0) * w0.y + bfhi(p1) * w1.y + bfhi(p2) * w2.y + bfhi(p3) * w3.y;
            *(LAS unsigned*)(xcs + (tl0 + t) * 144 + 4 * r) = pk2(lo, hi);
            p0 = p1; p1 = p2; p2 = p3; }
        LDS_WAIT();
    }
#pragma unroll
    for (int nt = 0; nt < 2; ++nt) { const int c = h * 64 + 32 * nt + r; st.ba[nt] = F.in(7)[c]; st.bx[nt] = F.in(9)[c];
        const float nl = -F.in(10)[c]; st.sp[nt] = fmaxf(nl, 0.f) + log1pf(__expf(-fabsf(nl))); st.S[nt] = 0.f; st.Ap[nt] = 1.f; }
    if (PASS2) {
        float s = 0.f; const float* ag = F.wsp<float>(WS_AGG) + ((size_t)b * NCHUNK * LRUW + h * 64 + lane) * 2;
        for (int c0 = 0; c0 < chunk; c0 += 32) {
            f32x2 ab[32];
#pragma unroll
            for (int i = 0; i < 32; ++i) ab[i] = *(const f32x2*)(ag + (size_t)(c0 + i < NCHUNK ? c0 + i : NCHUNK - 1) * LRUW * 2);
#pragma unroll
            for (int i = 0; i < 32; ++i) { const bool on = c0 + i < chunk; s = (on ? ab[i].x : 1.0f) * s + (on ? ab[i].y : 0.0f); }
        }
        st.S[0] = __shfl(s, r); st.S[1] = __shfl(s, 32 + r);
    }
}
template <bool PASS2>
DI void lru_tile(const Frame& F, int b, int chunk, int mt, int h, int lane, LAS unsigned char* xcs, LAS unsigned char* gim  , LruState& st, float (&ssq)[16]) {
    const int r = lane & 31, hh = lane >> 5;
    const size_t row0 = (size_t)b * SEQ + (size_t)chunk * 64;
    const bf16* gw = F.wsp<bf16>(WS_GATEW) + (size_t)h * 4096;
    bf16x8 af[4];
#pragma unroll
    for (int s = 0; s < 4; ++s) af[s] = *(const LAS bf16x8*)(xcs + (32 * mt + r) * 144 + (16 * s + 8 * hh) * 2);
    float ssl[16];
#pragma unroll
    for (int i = 0; i < 16; ++i) ssl[i] = 0.f;
    if (PASS2) {
#pragma unroll
        for (int i = 0; i < 4; ++i) { const int row = (lane >> 3) + 8 * i, c = lane & 7;
            *(LAS v4u*)(gim + row * 144 + c * 16) = *(const v4u*)(F.wsp<bf16>(WS_Z) + (row0 + 32 * mt + row) * ZW + LRUW + h * 64 + 8 * c); }
        LDS_WAIT();
    }
#pragma unroll
    for (int nt = 0; nt < 2; ++nt) {
        asm volatile("" ::: "memory");
        f32x16 aa = {}, ax = {};
#pragma unroll
        for (int s = 0; s < 4; ++s) {
            const bf16x8 wa = *(const bf16x8*)(gw + (size_t)(32 * nt + r) * 64 + 16 * s + 8 * hh);
            const bf16x8 wx = *(const bf16x8*)(gw + 32768 + (size_t)(32 * nt + r) * 64 + 16 * s + 8 * hh);
            aa = MFMA32(af[s], wa, aa); ax = MFMA32(af[s], wx, ax);
        }
#pragma unroll
        for (int i = 0; i < 16; ++i) {
            const float rg = sigmoidf_(aa[i] + st.ba[nt]), ig = sigmoidf_(ax[i] + st.bx[nt]);
            const float la = -8.0f * rg * st.sp[nt];
            const float a = exp2_(LOG2E * la);
            const float mult = __builtin_amdgcn_sqrtf(fmaxf(1.0f - a * a, 0.f));
            const float xc = bf2f(*(const LAS bf16*)(xcs + (32 * mt + crow(i, hh)) * 144 + (32 * nt + r) * 2));
            aa[i] = a; ax[i] = mult * ig * xc;
        }
        float Ao[4], Bo[4], Aq[4], Bq[4], Sin[4];
#pragma unroll
        for (int q = 0; q < 4; ++q) { const float a0 = aa[4 * q], a1 = aa[4 * q + 1], a2 = aa[4 * q + 2], a3 = aa[4 * q + 3];
            Ao[q] = (a0 * a1) * (a2 * a3); Bo[q] = ((ax[4 * q] * a1 + ax[4 * q + 1]) * a2 + ax[4 * q + 2]) * a3 + ax[4 * q + 3];
            Aq[q] = swap32_partner(Ao[q], hh); Bq[q] = swap32_partner(Bo[q], hh); }
        float s_ = st.S[nt];
#pragma unroll
        for (int q = 0; q < 4; ++q) { const float A1 = hh ? Aq[q] : Ao[q], B1 = hh ? Bq[q] : Bo[q], A2 = hh ? Ao[q] : Aq[q], B2 = hh ? Bo[q] : Bq[q];
            const float smid = A1 * s_ + B1; Sin[q] = hh ? smid : s_; s_ = A2 * smid + B2; st.Ap[nt] *= A1 * A2; }
        st.S[nt] = s_;
        if (PASS2) {
#pragma unroll
            for (int q = 0; q < 4; ++q) { float hp = Sin[q];
#pragma unroll
                for (int e = 0; e < 4; ++e) { const int i = 4 * q + e; hp = aa[i] * hp + ax[i];
                    const float gt = bf2f(*(const LAS bf16*)(gim + crow(i, hh) * 144 + (32 * nt + r) * 2));
                    const float y = hp * gelu_tanh(gt); ssl[i] += y * y;
                    *(LAS bf16*)(xcs + (32 * mt + crow(i, hh)) * 144 + (32 * nt + r) * 2) = f2bf(y); } }
        }
    }
    if (PASS2) {
#pragma unroll
        for (int i = 0; i < 16; ++i) ssq[i] = sum32(ssl[i]);
    }
}
constexpr int ATT_KST = 144, ATT_VST = 136, ATT_KBYTES = 64 * ATT_KST, ATT_VBYTES = 64 * ATT_VST;
DI void attn_wave(const Frame& F, int b, int n, int qt, int h, int lane, const LAS float* tab, LAS unsigned char* kl  , f32x16 (&o)[2]) {
    const int r = lane & 31, hh = lane >> 5;
    LAS unsigned char* vl = kl + ATT_KBYTES;
    const size_t row0 = (size_t)b * SEQ + (size_t)n * 64;
    const float SC = 0.125f * LOG2E;
    bf16x8 qf[4];
#pragma unroll
    for (int s = 0; s < 4; ++s) qf[s] = *(const bf16x8*)(F.wsp<bf16>(WS_Z) + (row0 + 32 * qt + r) * ZW + 2 * LRUW + h * 64 + 16 * s + 8 * hh);
    float mrun = -1e30f, lrun = 0.f;
#pragma unroll
    for (int dt = 0; dt < 2; ++dt) o[dt] = f32x16{};
    const float bfar = tab[256];
    const int srow = lane >> 3, sc8 = lane & 7;
    const int kc0 = (n >= 8 ? n - 8 : 0);
    const char* kg = (const char*)(F.wsp<bf16>(WS_Z) + (size_t)b * SEQ * ZW + 2 * LRUW + ATTW + h * 64);
    const char* vg = (const char*)(F.wsp<bf16>(WS_VT) + (size_t)(b * 8 + h) * 64 * SEQ);
    const unsigned kof = (unsigned)(srow * ZW + 8 * sc8) * 2u, vof = (unsigned)(srow * SEQ + 8 * sc8) * 2u;
    v4u kreg[8];
#pragma unroll
    for (int i = 0; i < 8; ++i) kreg[i] = *(const v4u*)(kg + ((size_t)kc0 * 64 + 8 * i) * ZW * 2 + kof);
    for (int kc = kc0; kc <= n; ++kc) {
        const int dd = n - kc;
        v4u vreg[8];
#pragma unroll
        for (int i = 0; i < 8; ++i) { *(LAS v4u*)(kl + (srow + 8 * i) * ATT_KST + sc8 * 16) = kreg[i]; vreg[i] = *(const v4u*)(vg + ((size_t)(8 * i) * SEQ + kc * 64) * 2 + vof); }
        f32x16 sc[2];
#pragma unroll
        for (int kt = 0; kt < 2; ++kt) { sc[kt] = f32x16{};
#pragma unroll
            for (int s = 0; s < 4; ++s) { const bf16x8 kf = *(const LAS bf16x8*)(kl + (32 * kt + r) * ATT_KST + (16 * s + 8 * hh) * 2); sc[kt] = MFMA32(kf, qf[s], sc[kt]); } }
        if (dd >= 3) {
#pragma unroll
            for (int kt = 0; kt < 2; ++kt)
#pragma unroll
                for (int i = 0; i < 16; ++i) sc[kt][i] = sc[kt][i] * SC + bfar;
        } else {
            const int base = 64 * dd + 32 * qt + r + 128;
#pragma unroll
            for (int kt = 0; kt < 2; ++kt)
#pragma unroll
                for (int i = 0; i < 16; ++i) { int idx = base - (32 * kt + crow(i, hh)); idx = idx > 256 ? 256 : idx; sc[kt][i] = sc[kt][i] * SC + tab[idx]; }
        }
        float mx = sc[0][0];
#pragma unroll
        for (int kt = 0; kt < 2; ++kt)
#pragma unroll
            for (int i = 0; i < 16; ++i) mx = fmaxf(mx, sc[kt][i]);
        mx = fmaxf(mx, swap32_partner(mx, hh));
        const float mnew = fmaxf(mrun, mx), alpha = exp2_(mrun - mnew);
        float ls = 0.f;
#pragma unroll
        for (int kt = 0; kt < 2; ++kt)
#pragma unroll
            for (int i = 0; i < 16; ++i) { const float p = exp2_(sc[kt][i] - mnew); sc[kt][i] = p; ls += p; }
        lrun = lrun * alpha + ls; mrun = mnew;
#pragma unroll
        for (int dt = 0; dt < 2; ++dt)
#pragma unroll
            for (int i = 0; i < 16; ++i) o[dt][i] *= alpha;
#pragma unroll
        for (int i = 0; i < 8; ++i) { LAS v2u* vd = (LAS v2u*)(vl + (srow + 8 * i) * ATT_VST + sc8 * 16); vd[0] = (v2u){vreg[i].x, vreg[i].y}; vd[1] = (v2u){vreg[i].z, vreg[i].w}; }
        if (kc < n) {
#pragma unroll
            for (int i = 0; i < 8; ++i) kreg[i] = *(const v4u*)(kg + ((size_t)(kc + 1) * 64 + 8 * i) * ZW * 2 + kof);
        }
#pragma unroll
        for (int kt = 0; kt < 2; ++kt)
#pragma unroll
            for (int s2 = 0; s2 < 2; ++s2) { v4u w; w.x = pk2(sc[kt][8 * s2], sc[kt][8 * s2 + 1]); w.y = pk2(sc[kt][8 * s2 + 2], sc[kt][8 * s2 + 3]); w.z = pk2(sc[kt][8 * s2 + 4], sc[kt][8 * s2 + 5]); w.w = pk2(sc[kt][8 * s2 + 6], sc[kt][8 * s2 + 7]);
                const bf16x8 pf = __builtin_bit_cast(bf16x8, w);
#pragma unroll
                for (int dt = 0; dt < 2; ++dt) { const LAS unsigned char* vp = vl + (32 * dt + r) * ATT_VST + (32 * kt + 16 * s2 + 4 * hh) * 2;
                    const v2u lo = *(const LAS v2u*)vp, hi = *(const LAS v2u*)(vp + 16); v4u vw; vw.x = lo.x; vw.y = lo.y; vw.z = hi.x; vw.w = hi.y;
                    o[dt] = MFMA32(__builtin_bit_cast(bf16x8, vw), pf, o[dt]); } }
    }
    const float lt = lrun + swap32_partner(lrun, hh); const float inv = rcp_(lt);
#pragma unroll
    for (int dt = 0; dt < 2; ++dt)
#pragma unroll
        for (int i = 0; i < 16; ++i) o[dt][i] *= inv;
}

DI void p2_lru_aggregates(Frame& F) {
    const int lane = F.lane, r = lane & 31, hh = lane >> 5, h = F.wave;
    LAS unsigned char* xcs = F.lds + 12288 + h * 17920;
    for (int u = F.vcu; u < NBATCH * NCHUNK; u += F.G) {
        const int b = u / NCHUNK, n = u % NCHUNK;
        LruState st; float ssq[16];
        lru_prep<false>(F, b, n, h, lane, xcs, st);
#pragma unroll 1
        for (int mt = 0; mt < 2; ++mt) lru_tile<false>(F, b, n, mt, h, lane, xcs, xcs + 9216, st, ssq);
        if (hh == 0) {
#pragma unroll
            for (int nt = 0; nt < 2; ++nt) *(f32x2*)(F.wsp<float>(WS_AGG) + (((size_t)b * NCHUNK + n) * LRUW + h * 64 + 32 * nt + r) * 2) = (f32x2){st.Ap[nt], st.S[nt]};
        }
        LDS_WAIT();
    }
}
DI void p3_mixer(Frame& F, int parts = 3) {
    const int lane = F.lane, r = lane & 31, hh = lane >> 5, h = F.wave;
    LAS float* ssx = (LAS float*)(F.lds);
    LAS float* tab = (LAS float*)(F.lds + 2048 + h * 1280);
    LAS unsigned* stg = (LAS unsigned*)(F.lds + 12288 + h * 17920);
    for (int i = lane; i < 257; i += 64) tab[i] = F.in(11)[h * 257 + i] * LOG2E;
    LDS_WAIT();
    for (int u = F.vcu; u < NBATCH * NCHUNK; u += F.G) {
        const int b = u / NCHUNK, n = u % NCHUNK; const size_t row0 = (size_t)b * SEQ + (size_t)n * 64;
#ifndef MIX_PARTS
#define MIX_PARTS 3
#endif
        if (parts & 1) {
            LruState st;
            lru_prep<true>(F, b, n, h, lane, (LAS unsigned char*)stg, st);
#pragma unroll 1
            for (int mt = 0; mt < 2; ++mt) {
                float ssq[16];
                lru_tile<true>(F, b, n, mt, h, lane, (LAS unsigned char*)stg, (LAS unsigned char*)stg + 9216, st, ssq);
                if (r == 0) {
#pragma unroll
                    for (int i = 0; i < 16; ++i) ssx[crow(i, hh) * 8 + h] = ssq[i];
                }
                __syncthreads();
                const LAS unsigned char* yst = (const LAS unsigned char*)stg + 32 * mt * 144;
#pragma unroll
                for (int i = 0; i < 4; ++i) { const int row = (lane >> 3) + 8 * i, c = lane & 7;
                    const f32x4 s0 = *(const LAS f32x4*)(ssx + row * 8), s1 = *(const LAS f32x4*)(ssx + row * 8 + 4);
                    const float rs = rsq_(((s0.x + s0.y) + (s0.z + s0.w) + (s1.x + s1.y) + (s1.z + s1.w)) * (1.f / 512.f) + EPS);
                    const v4u v = *(const LAS v4u*)(yst + row * 144 + c * 16);
                    v4u o; o.x = pk2(bflo(v.x) * rs, bfhi(v.x) * rs); o.y = pk2(bflo(v.y) * rs, bfhi(v.y) * rs); o.z = pk2(bflo(v.z) * rs, bfhi(v.z) * rs); o.w = pk2(bflo(v.w) * rs, bfhi(v.w) * rs);
                    *(v4u*)(F.wsp<bf16>(WS_Y) + (row0 + 32 * mt + row) * DM + h * 64 + 8 * c) = o; }
                __syncthreads();
            }
        }
    }
    for (int u = F.vcu; u < NBATCH * NCHUNK; u += F.G) {
        const int b = u / NCHUNK, n = u % NCHUNK; const size_t row0 = (size_t)b * SEQ + (size_t)n * 64;
#pragma unroll 1
        for (int qt = 0; qt < ((parts & 2) ? 2 : 0); ++qt) {
            f32x16 o[2];
            attn_wave(F, b, n, qt, h, lane, tab, (LAS unsigned char*)stg, o);
            float s = 0.f;
#pragma unroll
            for (int dt = 0; dt < 2; ++dt)
#pragma unroll
                for (int i = 0; i < 16; ++i) s += o[dt][i] * o[dt][i];
            s += swap32_partner(s, hh);
            if (hh == 0) ssx[r * 8 + h] = s;
            __syncthreads();
            { const f32x4 s0 = *(const LAS f32x4*)(ssx + r * 8), s1 = *(const LAS f32x4*)(ssx + r * 8 + 4);
              const float rs = rsq_(((s0.x + s0.y) + (s0.z + s0.w) + (s1.x + s1.y) + (s1.z + s1.w)) * (1.f / 512.f) + EPS);
#pragma unroll
              for (int dt = 0; dt < 2; ++dt)
#pragma unroll
                  for (int i = 0; i < 16; i += 2) stg[r * 33 + ((32 * dt + crow(i, hh)) >> 1)] = pk2(o[dt][i] * rs, o[dt][i + 1] * rs); }
            LDS_WAIT();
#pragma unroll 4
            for (int i = 0; i < 16; ++i) { const int row = 2 * i + hh; const unsigned v = stg[row * 33 + r];
                *(GAS unsigned*)(F.wsp<bf16>(WS_Y) + (row0 + 32 * qt + row) * DM + LRUW + h * 64 + 2 * r) = v; }
            __syncthreads();
        }
    }
}
DI void p5_cross(Frame& F, const pg8::StaticOrder& S) {
    const int lane = F.lane, r = lane & 31, hh = lane >> 5, w = F.wave, tid = F.tid;
    constexpr int KST = 528, VST = 520;
    const float SC = 0.0625f * LOG2E;
    pg8::Unit un;
    for (int ui = 0; S.next(ui, un); ++ui) {
        const int b = un.pm >> 5, qb = un.pm & 31, hm = un.pn;
        const size_t qrow = (size_t)b * SEQ + (size_t)qb * 256 + 32 * w + r;
        { const bf16* src = F.wsp<bf16>(WS_KM) + (size_t)(b * 256) * DM + hm * 256;
#pragma unroll 4
          for (int i = 0; i < 16; ++i) { const int c = i * 512 + tid, row = c >> 5, ch = c & 31;
              *(LAS v4u*)(F.lds + row * KST + ch * 16) = *(const v4u*)(src + (size_t)row * DM + ch * 8); } }
        __syncthreads();
        f32x16 sc[8];
#pragma unroll
        for (int kt = 0; kt < 8; ++kt) sc[kt] = f32x16{};
#pragma unroll 2
        for (int s = 0; s < 16; ++s) {
            const bf16x8 qf = *(const bf16x8*)(F.wsp<bf16>(WS_QC) + qrow * DM + hm * 256 + 16 * s + 8 * hh);
#pragma unroll
            for (int kt = 0; kt < 8; ++kt) { const bf16x8 kf = *(const LAS bf16x8*)(F.lds + (32 * kt + r) * KST + (16 * s + 8 * hh) * 2); sc[kt] = MFMA32(kf, qf, sc[kt]); }
        }
        float mx = sc[0][0];
#pragma unroll
        for (int kt = 0; kt < 8; ++kt)
#pragma unroll
            for (int i = 0; i < 16; ++i) mx = fmaxf(mx, sc[kt][i]);
        mx = fmaxf(mx, swap32_partner(mx, hh));
        float ls = 0.f; const float mo = mx * SC;
        bf16x8 pf[8][2];
#pragma unroll
        for (int kt = 0; kt < 8; ++kt) {
#pragma unroll
            for (int i = 0; i < 16; ++i) { const float p = exp2_(sc[kt][i] * SC - mo); sc[kt][i] = p; ls += p; }
#pragma unroll
            for (int s2 = 0; s2 < 2; ++s2) { v4u wv; wv.x = pk2(sc[kt][8 * s2], sc[kt][8 * s2 + 1]); wv.y = pk2(sc[kt][8 * s2 + 2], sc[kt][8 * s2 + 3]); wv.z = pk2(sc[kt][8 * s2 + 4], sc[kt][8 * s2 + 5]); wv.w = pk2(sc[kt][8 * s2 + 6], sc[kt][8 * s2 + 7]);
                pf[kt][s2] = __builtin_bit_cast(bf16x8, wv); }
        }
        ls += swap32_partner(ls, hh);
        const float inv = 1.0f / ls;
        __syncthreads();
        { const bf16* src = F.wsp<bf16>(WS_VMT) + (size_t)((b * 4 + hm) * 256) * 256;
#pragma unroll 4
          for (int i = 0; i < 16; ++i) { const int c = i * 512 + tid, row = c >> 5, ch = c & 31; const v4u v = *(const v4u*)(src + (size_t)row * 256 + ch * 8);
              LAS v2u* d = (LAS v2u*)(F.lds + row * VST + ch * 16); d[0] = (v2u){v.x, v.y}; d[1] = (v2u){v.z, v.w}; } }
        __syncthreads();
        LAS unsigned* stg = (LAS unsigned*)(F.lds) ;
#pragma unroll
        for (int half = 0; half < 2; ++half) {
            f32x16 o[4];
#pragma unroll
            for (int dt = 0; dt < 4; ++dt) o[dt] = f32x16{};
#pragma unroll
            for (int kt = 0; kt < 8; ++kt)
#pragma unroll
                for (int s2 = 0; s2 < 2; ++s2)
#pragma unroll
                    for (int dt = 0; dt < 4; ++dt) { const LAS unsigned char* p = F.lds + (128 * half + 32 * dt + r) * VST + (32 * kt + 16 * s2 + 4 * hh) * 2;
                        const v2u lo = *(const LAS v2u*)p, hi = *(const LAS v2u*)(p + 16); v4u wv; wv.x = lo.x; wv.y = lo.y; wv.z = hi.x; wv.w = hi.y;
                        o[dt] = MFMA32(__builtin_bit_cast(bf16x8, wv), pf[kt][s2], o[dt]); }
            if (half == 1) __syncthreads();
            else {   }
            if (half == 0) {
#pragma unroll
                for (int dt = 0; dt < 4; ++dt)
#pragma unroll
                    for (int i = 0; i < 16; i += 2) { const unsigned pv = pk2(o[dt][i] * inv, o[dt][i + 1] * inv); sc[dt][i >> 1] = __uint_as_float(pv); }
            } else {
                LAS unsigned* sw = (LAS unsigned*)(F.lds + w * 16512);
#pragma unroll
                for (int dt = 0; dt < 4; ++dt)
#pragma unroll
                    for (int i = 0; i < 16; i += 2) { sw[r * 129 + ((32 * dt + crow(i, hh)) >> 1)] = __float_as_uint(sc[dt][i >> 1]);
                        sw[r * 129 + 64 + ((32 * dt + crow(i, hh)) >> 1)] = pk2(o[dt][i] * inv, o[dt][i + 1] * inv); }
                LDS_WAIT();
#pragma unroll 4
                for (int i = 0; i < 32; ++i) { const unsigned v0 = sw[i * 129 + lane], v1 = sw[i * 129 + 64 + lane];
                    GAS unsigned* dst = (GAS unsigned*)(F.wsp<bf16>(WS_OC) + ((size_t)b * SEQ + (size_t)qb * 256 + 32 * w + i) * DM + hm * 256);
                    dst[lane] = v0; dst[64 + lane] = v1; }
            }
        }
        (void)stg;
        __syncthreads();
    }
}
template <int N> DI void ce_desc(float (&a)[N], int i, int l) { const float hi = fmaxf(a[i], a[l]), lo = fminf(a[i], a[l]); a[i] = hi; a[l] = lo; }
template <int N, int OFF> DI void bitonic_sort16_desc(float (&a)[N]) {
#define CE_(i, j) ce_desc<N>(a, OFF + (i), OFF + (j))
    CE_(0,13); CE_(1,12); CE_(2,15); CE_(3,14); CE_(4,8); CE_(5,6); CE_(7,11); CE_(9,10);
    CE_(0,5); CE_(1,7); CE_(2,9); CE_(3,4); CE_(6,13); CE_(8,14); CE_(10,15); CE_(11,12);
    CE_(0,1); CE_(2,3); CE_(4,5); CE_(6,8); CE_(7,9); CE_(10,11); CE_(12,13); CE_(14,15);
    CE_(0,2); CE_(1,3); CE_(4,10); CE_(5,11); CE_(6,7); CE_(8,9); CE_(12,14); CE_(13,15);
    CE_(1,2); CE_(3,12); CE_(4,6); CE_(5,7); CE_(8,10); CE_(9,11); CE_(13,14);
    CE_(1,4); CE_(2,6); CE_(5,8); CE_(7,10); CE_(9,13); CE_(11,14);
    CE_(2,4); CE_(3,6); CE_(9,12); CE_(11,13);
    CE_(3,5); CE_(6,8); CE_(7,9); CE_(10,12);
    CE_(3,4); CE_(5,6); CE_(7,8); CE_(9,10); CE_(11,12);
    CE_(6,7); CE_(8,9);
#undef CE_
}
template <int N, int OFF> DI void bitonic_merge16_desc(float (&a)[N]) {
#pragma unroll
    for (int j = 8; j > 0; j >>= 1)
#pragma unroll
        for (int i = 0; i < 16; ++i) { const int l = i ^ j; if (l > i) ce_desc<N>(a, OFF + i, OFF + l); }
}
template <bool SORTED, bool SORT0 = true> DI void top16_of_64(float (&a)[64]) {
    if (SORT0) bitonic_sort16_desc<64, 0>(a); bitonic_sort16_desc<64, 16>(a); bitonic_sort16_desc<64, 32>(a); bitonic_sort16_desc<64, 48>(a);
#pragma unroll
    for (int i = 0; i < 16; ++i) { a[i] = fmaxf(a[i], a[31 - i]); a[32 + i] = fmaxf(a[32 + i], a[63 - i]); }
    bitonic_merge16_desc<64, 0>(a); bitonic_merge16_desc<64, 32>(a);
#pragma unroll
    for (int i = 0; i < 16; ++i) a[i] = fmaxf(a[i], a[47 - i]);
    if (SORTED) bitonic_merge16_desc<64, 0>(a);
}
DI void p8a_topk(Frame& F, const pg8::StaticOrder& S) {
    const int lane = F.lane, r = lane & 31, hh = lane >> 5, w = F.wave;
    constexpr int TK_ST = 272, TK_QBYTES = 256 * TK_ST;
    LAS float* tbl = (LAS float*)(F.lds + w * 8192);
    pg8::Unit un;
    for (int ui = 0; S.next(ui, un); ++ui) {
        const int h = un.pn; const size_t tok = (size_t)un.pm * 256 + 32 * w + r;
        float v[2][16];
#pragma unroll
        for (int p = 0; p < 2; ++p) {
            __syncthreads();
            { const bf16* qsrc = F.wsp<bf16>(WS_QP) + (size_t)un.pm * 256 * 2048 + h * 256 + p * 128; const bf16* ksrc = F.wsp<bf16>(WS_SUBK) + (size_t)((h * 2 + p) * 128) * 128;
              const int rr = F.tid >> 4, ch = F.tid & 15;
#pragma unroll
              for (int i = 0; i < 8; ++i) *(LAS v4u*)(F.lds + (32 * i + rr) * TK_ST + ch * 16) = *(const v4u*)(qsrc + (size_t)(32 * i + rr) * 2048 + ch * 8);
#pragma unroll
              for (int i = 0; i < 4; ++i) *(LAS v4u*)(F.lds + TK_QBYTES + (32 * i + rr) * TK_ST + ch * 16) = *(const v4u*)(ksrc + (size_t)(32 * i + rr) * 128 + ch * 8); }
            __syncthreads();
            f32x16 sc[4];
#pragma unroll
            for (int nt = 0; nt < 4; ++nt) sc[nt] = f32x16{};
#pragma unroll 2
            for (int s = 0; s < 8; ++s) { const bf16x8 qf = *(const LAS bf16x8*)(F.lds + (32 * w + r) * TK_ST + (16 * s + 8 * hh) * 2);
#pragma unroll
                for (int nt = 0; nt < 4; ++nt) { const bf16x8 kf = *(const LAS bf16x8*)(F.lds + TK_QBYTES + (32 * nt + r) * TK_ST + (16 * s + 8 * hh) * 2); sc[nt] = MFMA32(kf, qf, sc[nt]); } }
            float a[64];
#pragma unroll
            for (int nt = 0; nt < 4; ++nt)
#pragma unroll
                for (int i = 0; i < 16; ++i) a[nt * 16 + i] = __uint_as_float((__float_as_uint(sc[nt][i]) & ~127u) | (unsigned)(32 * nt + crow(i, hh)));
            top16_of_64<true>(a);
            float m[16];
#pragma unroll
            for (int i = 0; i < 16; ++i) m[i] = fmaxf(a[i], swap32_partner(a[15 - i], hh));
            bitonic_merge16_desc<16, 0>(m);
#pragma unroll
            for (int i = 0; i < 16; ++i) v[p][i] = m[i];
        }
        float c[64]; int n = 0;
#pragma unroll
        for (int i = 0; i < 16; ++i)
#pragma unroll
            for (int j = 0; j < 16; ++j) if ((i + 1) * (j + 1) <= 16) { c[n] = __uint_as_float((__float_as_uint(v[0][i] + v[1][j]) & ~255u) | (unsigned)((i << 4) | j)); ++n; }
#pragma unroll
        for (int k = 50; k < 64; ++k) c[k] = -3.0e38f;
        top16_of_64<false, false>(c);
        __syncthreads();
#pragma unroll
        for (int i = 0; i < 16; ++i) { tbl[i * 64 + lane] = v[0][i]; tbl[(16 + i) * 64 + lane] = v[1][i]; }
        LDS_WAIT();
        float sv[16]; int ev[16]; float mx = -3.0e38f;
#pragma unroll
        for (int k = 0; k < 16; ++k) { const unsigned pl = __float_as_uint(c[k]) & 255u; const float a1 = tbl[(pl >> 4) * 64 + lane], a2 = tbl[(16 + (pl & 15)) * 64 + lane];
            sv[k] = a1 + a2; ev[k] = (int)(((__float_as_uint(a1) & 127u) << 7) | (__float_as_uint(a2) & 127u)); mx = fmaxf(mx, sv[k]); }
        float sum = 0.f;
#pragma unroll
        for (int k = 0; k < 16; ++k) { sv[k] = __expf(sv[k] - mx); sum += sv[k]; }
        const float inv = 1.0f / sum;
        if (hh == 0) {
#pragma unroll
            for (int k = 0; k < 16; k += 4) *(v4u*)(F.wsp<int>(WS_IDX) + tok * NSEL + h * 16 + k) = (v4u){(unsigned)ev[k], (unsigned)ev[k + 1], (unsigned)ev[k + 2], (unsigned)ev[k + 3]};
        } else {
#pragma unroll
            for (int k = 0; k < 16; k += 4) { unsigned gwd[4];
#pragma unroll
                for (int e = 0; e < 4; ++e) { const float su = F.wsp<float>(WS_SU)[ev[k + e]], svs = F.wsp<float>(WS_SU)[NEXP + ev[k + e]]; gwd[e] = pk2(su, sv[k + e] * inv * svs); }
                *(v4u*)(F.wsp<unsigned>(WS_G) + tok * NSEL + h * 16 + k) = (v4u){gwd[0], gwd[1], gwd[2], gwd[3]}; }
        }
        LDS_WAIT();
    }
}
typedef _Float16 f16x2_t __attribute__((ext_vector_type(2)));
DI int dot16_i8(const v4u& u, const unsigned (&x)[4]) {
    const unsigned u0 = u.x, u1 = u.y, u2 = u.z, u3 = u.w;
    int a = 0;
    a = __builtin_amdgcn_sdot4((int)u0, (int)x[0], a, false); a = __builtin_amdgcn_sdot4((int)u1, (int)x[1], a, false);
    a = __builtin_amdgcn_sdot4((int)u2, (int)x[2], a, false); a = __builtin_amdgcn_sdot4((int)u3, (int)x[3], a, false);
    return a;
}
DI void axpy32_v6(f16x2_t (&o)[16], float w, const v4u a, unsigned b4, unsigned b5) {
    const v6u pk = {a.x, a.y, a.z, a.w, b4, b5};
    const v32h h = __builtin_amdgcn_cvt_scalef32_pk32_f16_fp6(pk, 1.0f);
    const f16x2_t w2 = {(_Float16)w, (_Float16)w};
#pragma unroll
    for (int i = 0; i < 16; ++i) { const f16x2_t hv = {h[2 * i], h[2 * i + 1]}; o[i] = __builtin_elementwise_fma(hv, w2, o[i]); }
}
constexpr int TPW = 4, NSLICE = 16, SLICE_SHIFT = 10, NPAIR = TPW * NSEL;
constexpr int NLIST = NPAIR + TPW * NSLICE + 32;
constexpr int XPITCH = 1024;
constexpr int PEER_X_BYTES = TPW * XPITCH + 128;
constexpr int PEER_LDS_PER_WAVE = PEER_X_BYTES + TPW * 2048 + NLIST * 8;
static_assert(PEER_LDS_PER_WAVE * NWAVES <= RING_BYTES, "PEER LDS");
static_assert(PEER_LDS_PER_WAVE % 16 == 0 && PEER_X_BYTES % 16 == 0 && (NLIST * 4) % 16 == 0, "PEER LDS alignment");
typedef int v4i __attribute__((ext_vector_type(4)));
DI int incl_scan64(int v, int lane) {
    int s = v;
#pragma unroll
    for (int d = 1; d < 64; d <<= 1) { const int t = __shfl_up(s, d); if (lane >= d) s += t; }
    return s;
}
DI int ppos(int L) { return (L & ~15) | ((L & 1) << 3) | ((L >> 1) & 7); }
struct PeerState { f16x2_t oc[16]; int curj; };
DI void peer_flush(PeerState& S, LAS unsigned char* ol, int lane) {
    LAS v4u* r = (LAS v4u*)(ol + S.curj * 2048 + 64 * (lane & 31) + 32 * (lane >> 5));
    unsigned mine[8];
#pragma unroll
    for (int i = 0; i < 8; ++i) { auto rr = __builtin_amdgcn_permlane32_swap(__builtin_bit_cast(unsigned, S.oc[i]), __builtin_bit_cast(unsigned, S.oc[8 + i]), false, false);
        mine[i] = __builtin_bit_cast(unsigned, __builtin_bit_cast(f16x2_t, (unsigned)rr[0]) + __builtin_bit_cast(f16x2_t, (unsigned)rr[1])); }
#pragma unroll
    for (int c = 0; c < 2; ++c) { const v4u v = r[c]; v4u o;
        o.x = __builtin_bit_cast(unsigned, __builtin_bit_cast(f16x2_t, (unsigned)v.x) + __builtin_bit_cast(f16x2_t, mine[4 * c])); o.y = __builtin_bit_cast(unsigned, __builtin_bit_cast(f16x2_t, (unsigned)v.y) + __builtin_bit_cast(f16x2_t, mine[4 * c + 1]));
        o.z = __builtin_bit_cast(unsigned, __builtin_bit_cast(f16x2_t, (unsigned)v.z) + __builtin_bit_cast(f16x2_t, mine[4 * c + 2])); o.w = __builtin_bit_cast(unsigned, __builtin_bit_cast(f16x2_t, (unsigned)v.w) + __builtin_bit_cast(f16x2_t, mine[4 * c + 3]));
        r[c] = o; }
#pragma unroll
    for (int i = 0; i < 16; ++i) S.oc[i] = (f16x2_t){(_Float16)0.f, (_Float16)0.f};
}
DI void peer_u_issue(v4u (&ua)[16], const LAS unsigned* mlo, int g, const unsigned char* EU8, int lane) {
    unsigned lo[16];
#pragma unroll
    for (int m = 0; m < 4; ++m) { const v4u t = *(const LAS v4u*)(mlo + 16 * g + 4 * m); lo[4 * m] = t.x; lo[4 * m + 1] = t.y; lo[4 * m + 2] = t.z; lo[4 * m + 3] = t.w; }
#pragma unroll
    for (int p = 0; p < 16; ++p) { const unsigned voff = (lo[p] & 0xfffffc00u) | (16u * (unsigned)lane); ua[p] = *(const v4u*)(EU8 + voff); }
}
DI void peer_v_issue(v4u& va, unsigned& vb4, unsigned& vb5, unsigned lo, const unsigned char* EV8, int l5) {
    const unsigned e = (lo >> 10) & 0x3fffu;
    va = *(const v4u*)(EV8 + (e * (unsigned)EV_ROW + (unsigned)(16 * l5))); const v2u t2 = *(const v2u*)(EV8 + (e * (unsigned)EV_ROW + (unsigned)(512 + 8 * l5))); vb4 = t2.x; vb5 = t2.y;
}
DI int dpp_xor1_i(int x) { return __builtin_amdgcn_update_dpp(0, x, 0xB1, 0xf, 0xf, true); }
DI int dpp_xor2_i(int x) { return __builtin_amdgcn_update_dpp(0, x, 0x4E, 0xf, 0xf, true); }
DI int dpp_ror8_i(int x) { return __builtin_amdgcn_update_dpp(0, x, 0x128, 0xf, 0xf, true); }
DI int swz_xor4_i(int x) { return __builtin_amdgcn_ds_swizzle(x, 0x101F); }
DI void peer_u_compute(unsigned (&W)[8], const v4u (&ua)[16], const LAS unsigned* mlo, const LAS unsigned* mhi, int g, const LAS unsigned char* xl, const float (&sx4)[4], int lane) {
    unsigned lo[16];
#pragma unroll
    for (int m = 0; m < 4; ++m) { const v4u t = *(const LAS v4u*)(mlo + 16 * g + 4 * m); lo[4 * m] = t.x; lo[4 * m + 1] = t.y; lo[4 * m + 2] = t.z; lo[4 * m + 3] = t.w; }
    int is[16];
#pragma unroll
    for (int p = 0; p < 16; ++p) { const v4u xv = *(const LAS v4u*)(xl + (((lo[p] & 3u) << 10) + 16u * (unsigned)lane));
        const unsigned xr[4] = {xv.x, xv.y, xv.z, xv.w}; is[p] = dot16_i8(ua[p], xr); }
    const bool b0 = lane & 1, b1 = lane & 2, b2 = lane & 4, b3 = lane & 8;
    int s1[8], s2[4], s3[2];
#pragma unroll
    for (int m = 0; m < 8; ++m) s1[m] = (b0 ? is[2 * m + 1] : is[2 * m]) + dpp_xor1_i(b0 ? is[2 * m] : is[2 * m + 1]);
#pragma unroll
    for (int m = 0; m < 4; ++m) s2[m] = (b1 ? s1[2 * m + 1] : s1[2 * m]) + dpp_xor2_i(b1 ? s1[2 * m] : s1[2 * m + 1]);
#pragma unroll
    for (int m = 0; m < 2; ++m) s3[m] = (b3 ? s2[2 * m + 1] : s2[2 * m]) + dpp_ror8_i(b3 ? s2[2 * m] : s2[2 * m + 1]);
    int tot = (b2 ? s3[1] : s3[0]) + swz_xor4_i(b2 ? s3[0] : s3[1]);
    { auto rr = __builtin_amdgcn_permlane16_swap((unsigned)tot, (unsigned)tot, false, false); tot = (int)rr[0] + (int)rr[1]; }
    { auto rr = __builtin_amdgcn_permlane32_swap((unsigned)tot, (unsigned)tot, false, false); tot = (int)rr[0] + (int)rr[1]; }
    const int pp = (b2 ? 8 : 0) + (b3 ? 4 : 0) + (lane & 3);
    const unsigned lop = mlo[16 * g + pp], hip = mhi[16 * g + pp];
    const float s01 = (lop & 1u) ? sx4[1] : sx4[0], s23 = (lop & 1u) ? sx4[3] : sx4[2];
    const float sxv = (lop & 2u) ? s23 : s01;
    const float val = (float)tot * (bflo(hip) * sxv);
    const float wv = gelu_tanh(val) * bfhi(hip);
    const f16x2_t wh = {(_Float16)wv, (_Float16)wv};
    LAS unsigned* wl = (LAS unsigned*)(xl + TPW * XPITCH + 64);
    wl[pp] = __builtin_bit_cast(unsigned, wh);
    const v4u w0 = *(const LAS v4u*)(wl + 8 * (lane >> 5)), w1 = *(const LAS v4u*)(wl + 8 * (lane >> 5) + 4);
    W[0] = w0.x; W[1] = w0.y; W[2] = w0.z; W[3] = w0.w; W[4] = w1.x; W[5] = w1.y; W[6] = w1.z; W[7] = w1.w;
}
DI void axpy32_w(f16x2_t (&o)[16], unsigned w, const v4u a, unsigned b4, unsigned b5) {
    const v6u pk = {a.x, a.y, a.z, a.w, b4, b5};
    const v32h h = __builtin_amdgcn_cvt_scalef32_pk32_f16_fp6(pk, 1.0f);
    const f16x2_t w2 = __builtin_bit_cast(f16x2_t, w);
#pragma unroll
    for (int i = 0; i < 16; ++i) { const f16x2_t hv = {h[2 * i], h[2 * i + 1]}; o[i] = __builtin_elementwise_fma(hv, w2, o[i]); }
}
DI void p8b_peer(Frame& F, float* outp, float oscale = 1.0f) {
    const int lane = F.lane, w = F.wave;
    const int gw = F.vcu * NWAVES + w, NGW = F.G * NWAVES;
    const unsigned char* EU8 = F.wsp<unsigned char>(WS_EU); const unsigned char* EV8 = F.wsp<unsigned char>(WS_EV);
    LAS unsigned char* xl = F.lds + w * PEER_LDS_PER_WAVE;
    LAS unsigned char* ol = xl + PEER_X_BYTES;
    LAS unsigned* mlo = (LAS unsigned*)(ol + TPW * 2048);
    LAS unsigned* mhi = mlo + NLIST;
    const int l5 = lane & 31, hh = lane >> 5;
    for (int t0 = gw * TPW; t0 < M; t0 += NGW * TPW) {
        unsigned loa[TPW], lob[TPW], hia[TPW], hib[TPW]; int posa[TPW], posb[TPW], sla[TPW], slb[TPW], offs[TPW];
#pragma unroll
        for (int j = 0; j < TPW; ++j) { const size_t tok = (size_t)t0 + j;
            float rstd; { const f32x4* sp = (const f32x4*)(F.wsp<float>(WS_SSQ2) + tok * 16); const f32x4 st = (sp[0] + sp[1]) + (sp[2] + sp[3]); rstd = rsq_(((st.x + st.y) + (st.z + st.w)) * (1.f / 1024.f) + EPS); }
            { const bf16* xs = F.wsp<bf16>(WS_XN) + tok * DM + 16 * lane;
              const v4u x0 = *(const v4u*)xs, x1 = *(const v4u*)(xs + 8);
              float xf[16] = {bflo(x0.x), bfhi(x0.x), bflo(x0.y), bfhi(x0.y), bflo(x0.z), bfhi(x0.z), bflo(x0.w), bfhi(x0.w), bflo(x1.x), bfhi(x1.x), bflo(x1.y), bfhi(x1.y), bflo(x1.z), bfhi(x1.z), bflo(x1.w), bfhi(x1.w)};
              float mx = 0.f;
#pragma unroll
              for (int i = 0; i < 16; ++i) mx = fmaxf(mx, fabsf(xf[i]));
              mx = fmaxf(max64(mx), 1e-30f); const float inv = 127.0f / mx;
              v4u y; y.x = pack_i8x4(xf[0] * inv, xf[1] * inv, xf[2] * inv, xf[3] * inv); y.y = pack_i8x4(xf[4] * inv, xf[5] * inv, xf[6] * inv, xf[7] * inv);
              y.z = pack_i8x4(xf[8] * inv, xf[9] * inv, xf[10] * inv, xf[11] * inv); y.w = pack_i8x4(xf[12] * inv, xf[13] * inv, xf[14] * inv, xf[15] * inv);
              ((LAS v4u*)(xl + j * XPITCH))[lane] = y; if (lane == 0) ((LAS float*)(xl + TPW * XPITCH))[j] = mx * rstd * (1.0f / 127.0f);
              ((LAS v4u*)(ol + j * 2048))[lane] = (v4u){0u, 0u, 0u, 0u}; ((LAS v4u*)(ol + j * 2048))[64 + lane] = (v4u){0u, 0u, 0u, 0u}; }
            const int ea = F.wsp<int>(WS_IDX)[tok * NSEL + lane], eb = F.wsp<int>(WS_IDX)[tok * NSEL + 64 + lane];
            hia[j] = F.wsp<unsigned>(WS_G)[tok * NSEL + lane]; hib[j] = F.wsp<unsigned>(WS_G)[tok * NSEL + 64 + lane];
            const int sa = ea >> SLICE_SHIFT, sb = eb >> SLICE_SHIFT;
            int pa = 0, pb = 0, myoff = 0;
#pragma unroll
            for (int bk = 0; bk < NSLICE; ++bk) { const unsigned long long ma = __ballot(sa == bk), mb = __ballot(sb == bk);
                const int ca = __popcll(ma), cb = __popcll(mb);
                const int ra = __builtin_amdgcn_mbcnt_hi((unsigned)(ma >> 32), __builtin_amdgcn_mbcnt_lo((unsigned)ma, 0)), rb = __builtin_amdgcn_mbcnt_hi((unsigned)(mb >> 32), __builtin_amdgcn_mbcnt_lo((unsigned)mb, 0));
                pa = (sa == bk) ? ra : pa; pb = (sb == bk) ? ca + rb : pb;
                myoff = (lane == bk) ? ca + cb : myoff; }
            loa[j] = ((unsigned)ea << 10) | (unsigned)j; lob[j] = ((unsigned)eb << 10) | (unsigned)j;
            posa[j] = pa; posb[j] = pb; sla[j] = sa; slb[j] = sb; offs[j] = myoff;
        }
        int cnt = 0;
#pragma unroll
        for (int j = 0; j < TPW; ++j) { const int c = __shfl(offs[j], lane >> 2); cnt = ((lane & 3) == j) ? c : cnt; }
        const int cpad = (cnt + 1) & ~1;
        const int bend = incl_scan64(cpad, lane), bstart = bend - cpad;
        const int npad = __builtin_amdgcn_readlane(bend, 63);
#pragma unroll
        for (int j = 0; j < TPW; ++j) { const int ba = __shfl(bstart, 4 * sla[j] + j), bb = __shfl(bstart, 4 * slb[j] + j);
            const int qa = ppos(ba + posa[j]), qb = ppos(bb + posb[j]);
            mlo[qa] = loa[j]; mhi[qa] = hia[j]; mlo[qb] = lob[j]; mhi[qb] = hib[j]; }
        if (cnt < cpad) { const int qp = ppos(bstart + cnt); mlo[qp] = ((unsigned)(lane >> 2) << (SLICE_SHIFT + 10)) | (unsigned)(lane & 3); mhi[qp] = 0u; }
        if (lane < 32) { const int qp = ppos(npad + lane); mlo[qp] = ((unsigned)(NSLICE - 1) << (SLICE_SHIFT + 10)) | 3u; mhi[qp] = 0u; }
        LDS_WAIT();
        float sx4[4]; { const f32x4 t = *(const LAS f32x4*)(xl + TPW * XPITCH); sx4[0] = t.x; sx4[1] = t.y; sx4[2] = t.z; sx4[3] = t.w; }
        const int ng = (npad + 15) >> 4;
        PeerState S;
#pragma unroll
        for (int i = 0; i < 16; ++i) S.oc[i] = (f16x2_t){(_Float16)0.f, (_Float16)0.f};
        S.curj = -1;
        v4u ua[16]; v4u va[8]; unsigned vb4[8], vb5[8], lo8[8], W[8];
        peer_u_issue(ua, mlo, 0, EU8, lane);
        { const v4u a = *(const LAS v4u*)(mlo + 8 * hh), b = *(const LAS v4u*)(mlo + 8 * hh + 4);
          lo8[0] = a.x; lo8[1] = a.y; lo8[2] = a.z; lo8[3] = a.w; lo8[4] = b.x; lo8[5] = b.y; lo8[6] = b.z; lo8[7] = b.w; }
#pragma unroll
        for (int k = 0; k < 8; ++k) peer_v_issue(va[k], vb4[k], vb5[k], lo8[k], EV8, l5);
        __builtin_amdgcn_sched_barrier(0);
        peer_u_compute(W, ua, mlo, mhi, 0, xl, sx4, lane);
#pragma unroll 1
        for (int g = 0; g < ng; ++g) {
            if ((g & 7) == 0) { if ((((g >> 3) ^ (w >> 2)) & 1) != 0) __builtin_amdgcn_s_setprio(1); else __builtin_amdgcn_s_setprio(0); }
            peer_u_issue(ua, mlo, g + 1, EU8, lane);
            unsigned lon[8];
            { const v4u a = *(const LAS v4u*)(mlo + 16 * (g + 1) + 8 * hh), b = *(const LAS v4u*)(mlo + 16 * (g + 1) + 8 * hh + 4);
              lon[0] = a.x; lon[1] = a.y; lon[2] = a.z; lon[3] = a.w; lon[4] = b.x; lon[5] = b.y; lon[6] = b.z; lon[7] = b.w; }
#pragma unroll
            for (int k = 0; k < 8; ++k) {
                const int tokk = (int)((unsigned)__builtin_amdgcn_readfirstlane((int)lo8[k]) & 3u);
                if (tokk != S.curj) { if (S.curj >= 0) peer_flush(S, ol, lane); S.curj = tokk; }
                axpy32_w(S.oc, W[k], va[k], vb4[k], vb5[k]);
                peer_v_issue(va[k], vb4[k], vb5[k], lon[k], EV8, l5);
            }
            peer_u_compute(W, ua, mlo, mhi, g + 1, xl, sx4, lane);
#pragma unroll
            for (int k = 0; k < 8; ++k) lo8[k] = lon[k];
        }
        __builtin_amdgcn_s_setprio(0);
        peer_flush(S, ol, lane);
        LDS_WAIT();
#pragma unroll
        for (int j = 0; j < TPW; ++j) {
            const LAS unsigned char* orl = ol + j * 2048 + 64 * l5 + 32 * hh;
            const v4u h0 = *(const LAS v4u*)orl, h1 = *(const LAS v4u*)(orl + 16);
            const unsigned hw[8] = {h0.x, h0.y, h0.z, h0.w, h1.x, h1.y, h1.z, h1.w};
            f32x4 a[4]; float ss = 0.f;
#pragma unroll
            for (int q = 0; q < 4; ++q) { const int eo = 128 * (4 * hh + q) + 4 * l5;
                const v2u xb = *(const v2u*)(F.wsp<bf16>(WS_XN) + ((size_t)t0 + j) * DM + eo);
                const f16x2_t p0 = __builtin_bit_cast(f16x2_t, hw[2 * q]), p1 = __builtin_bit_cast(f16x2_t, hw[2 * q + 1]);
                a[q] = (f32x4){bflo(xb.x), bfhi(xb.x), bflo(xb.y), bfhi(xb.y)} + (f32x4){(float)p0.x, (float)p0.y, (float)p1.x, (float)p1.y};
                ss += (a[q].x * a[q].x + a[q].y * a[q].y) + (a[q].z * a[q].z + a[q].w * a[q].w); }
            const float rf = rsq_(sum64(ss) * (1.f / 1024.f) + EPS) * oscale;
#pragma unroll
            for (int q = 0; q < 4; ++q) { const int eo = 128 * (4 * hh + q) + 4 * l5;
                *(f32x4*)(outp + ((size_t)t0 + j) * DM + eo) = a[q] * rf * *(const f32x4*)(F.in(25) + eo); }
        }
        LDS_WAIT();
    }
}
constexpr int N_PHASES = 11;
__global__ void __launch_bounds__(NWAVES * 64, 2) fwd_kernel(Args args) {
    extern __shared__ __attribute__((aligned(16))) unsigned char lds[];
    Frame F;
    F.lds = (LAS unsigned char*)lds;
    F.MISC = (volatile LAS unsigned*)(F.lds + MISC_OFF);
    F.tid = threadIdx.x; F.lane = F.tid & 63; F.wave = __builtin_amdgcn_readfirstlane(F.tid >> 6);
    F.G = gridDim.x; { const int bx = blockIdx.x; F.vcu = (F.G % 8 == 0) ? (bx % 8) * (F.G / 8) + bx / 8 : bx; }
    F.A = &args; F.ws = args.ws; F.out = args.out;
    F.ctl = (gu32*)(args.ws + WS_CTL);
    for (int u = F.tid; u < (LDS_BYTES - LDSCTL_OFF) / 4; u += NWAVES * 64) ((LAS unsigned*)(F.lds + LDSCTL_OFF))[u] = 0u;
    __syncthreads();
    const bool multi = (args.ph_hi - args.ph_lo) > 1;
    XcdBarrier bar; bar.bar = (unsigned*)(F.ctl + CW_BAR) + args.li * XCD_BAR_WORDS; bar.x = 0; bar.st = nullptr;
    if (multi) bar = xcd_barrier_post((unsigned*)(F.ctl + CW_BAR) + args.li * XCD_BAR_WORDS, F.MISC + 8);
    const int lo = args.ph_lo, hi = args.ph_hi;
#ifndef PROBE_EMASK
#define PROBE_EMASK 0x3fffu
#endif
#ifndef PHASE_REPEAT
#define PHASE_REPEAT 0
#endif
#define REP(k) for (int rep_ = 0; rep_ < (((PHASE_REPEAT >> (k)) & 1) ? 2 : 1); ++rep_)
#ifndef PHASE_MASK
#define PHASE_MASK 0x7ff
#endif
#define IN(k) (((PHASE_MASK >> (k)) & 1) && lo <= (k) && (k) < hi)
#define SEAM(k) do { asm volatile("; ===SEAM " #k ::: "memory"); if (IN(k) && IN((k) + 1)) xcd_barrier(bar); STAMP((k) + 1); } while (0)
    const int c = (int)blockIdx.x;
#define LOCAL_SEAM() do { VM_WAIT(); __syncthreads(); if (F.tid == 0) { __builtin_amdgcn_fence(__ATOMIC_ACQUIRE, "agent"); VM_WAIT(); } __syncthreads(); } while (0)
#ifdef PROBE_PHASE
#define STAMP(i) do { if (blockIdx.x == 0 && F.tid == 0) __hip_atomic_store(F.ctl + 512 + (i), (unsigned)__builtin_amdgcn_s_memrealtime(), RLX_AGENT); } while (0)
#else
#define STAMP(i) do { } while (0)
#endif
    STAMP(0);

#ifndef PROBE_P0
#define PROBE_P0 7
#endif
    if (IN(0)) { if (PHASE_REPEAT & 1) p0_prologue(F, PROBE_P0); p0_prologue(F); } SEAM(0);
    if (IN(1)) REP(1) {
        { pg8::Gemm g{F.wsp<bf16>(WS_XN), F.wsp<bf16>(WS_WIN), M, INW, DM}; pg8::StaticOrder S; S.init(M, INW, F.G, c);
          pg8::EpiSplitT E{F.wsp<bf16>(WS_Z), ZW, ZW, F.wsp<bf16>(WS_VT), ATTW, SEQ};
          pg8::gemm_phase<pg8::EpiSplitT, pg8::StaticOrder, true, true>(F.lds, g, S, E); }
        { const int nw3 = (M / 256) * (INW / 256) - 2 * F.G;
          int idx = -1; if (nw3 >= 0 && nw3 + 16 <= F.G) idx = c - nw3; else idx = (c < 16 && F.G >= 16) ? c : -1;
          if (F.G < 16) idx = -1;
          pg8::Gemm g{F.wsp<bf16>(WS_MEMN), F.wsp<bf16>(WS_WKV), NBATCH * 256, 2 * DM, DM};
          if (F.G >= 16) { pg8::OneUnit S{idx, 2, 8}; pg8::EpiSplitT E{F.wsp<bf16>(WS_KM), DM, DM, F.wsp<bf16>(WS_VMT), DM, 256};
              pg8::gemm_phase<pg8::EpiSplitT, pg8::OneUnit, false, true>(F.lds, g, S, E); }
          else { pg8::StaticOrder S; S.init(NBATCH * 256, 2 * DM, F.G, c); pg8::EpiSplitT E{F.wsp<bf16>(WS_KM), DM, DM, F.wsp<bf16>(WS_VMT), DM, 256};
              pg8::gemm_phase<pg8::EpiSplitT, pg8::StaticOrder, false, true>(F.lds, g, S, E); } }
        { const int first_idle = (M / 256) * (INW / 256) - 2 * F.G + 16;
          if (first_idle > 0 && first_idle < F.G) { if (c >= first_idle) convert_experts(F, (c - first_idle) * NWAVES + F.wave, (F.G - first_idle) * NWAVES); }
          else convert_experts(F, c * NWAVES + F.wave, F.G * NWAVES); }
    } SEAM(1);
    if (IN(2)) REP(2) { p2_lru_aggregates(F); } SEAM(2);
#ifndef PROBE_PARTS
#define PROBE_PARTS 3
#endif
    if (IN(3)) { if ((PHASE_REPEAT >> 3) & 1) p3_mixer(F, PROBE_PARTS); p3_mixer(F); } SEAM(3);
    if (IN(4)) REP(4) {
        pg8::Gemm g{F.wsp<bf16>(WS_Y), F.wsp<bf16>(WS_WOUT), M, DM, DM}; pg8::StaticOrder S; S.init(M, DM, F.G, c);
        pg8::EpiResid<false> E{F.in(0), F.wsp<bf16>(WS_XN), F.wsp<float>(WS_SSQ1), DM};
        pg8::gemm_phase<pg8::EpiResid<false>, pg8::StaticOrder, true, true>(F.lds, g, S, E);
    } SEAM(4);
    if (IN(5)) {
        pg8::Gemm g{F.wsp<bf16>(WS_XN), F.wsp<bf16>(WS_WQ), M, DM, DM}; pg8::StaticOrder S; S.init(M, DM, F.G, c);
        pg8::EpiRowScale E{F.wsp<bf16>(WS_QC), DM, F.wsp<float>(WS_SSQ1), 1.f / 1024.f, EPS};
        pg8::gemm_phase<pg8::EpiRowScale, pg8::StaticOrder, true, true>(F.lds, g, S, E);
        LOCAL_SEAM();
        p5_cross(F, S);
    } SEAM(6);
    if (IN(7)) {
        pg8::Gemm g{F.wsp<bf16>(WS_OC), F.wsp<bf16>(WS_WO), M, DM, DM}; pg8::StaticOrder S; S.init(M, DM, F.G, c);
        pg8::EpiResid<true> E{F.wsp<bf16>(WS_XN), F.wsp<bf16>(WS_XN), F.wsp<float>(WS_SSQ2), DM};
        pg8::gemm_phase<pg8::EpiResid<true>, pg8::StaticOrder, true, true>(F.lds, g, S, E);
    } SEAM(7);
    if (IN(8)) {
        pg8::Gemm g{F.wsp<bf16>(WS_XN), F.wsp<bf16>(WS_WQRY), M, 2 * DM, DM}; pg8::StaticOrder S; S.init(M, 2 * DM, F.G, c);
        pg8::EpiRowScale E{F.wsp<bf16>(WS_QP), 2 * DM, F.wsp<float>(WS_SSQ2), 1.f / 1024.f, EPS};
        pg8::gemm_phase<pg8::EpiRowScale, pg8::StaticOrder, true, true>(F.lds, g, S, E);
        LOCAL_SEAM();
        p8a_topk(F, S);
    } SEAM(9);
    if (IN(10)) { if ((PHASE_REPEAT >> 10) & 1) { p8b_peer(F, F.wsp<float>(WS_Z)); } p8b_peer(F, F.out,
#ifdef PROBE_PHASE
        1.0f + (float)(((__hip_atomic_load(F.ctl + 512 + PROBE_PHASE + 1, RLX_AGENT) - __hip_atomic_load(F.ctl + 512 + PROBE_PHASE, RLX_AGENT)) + 500u) / 1000u) * 1e-2f
#else
        1.0f
#endif
        ); }
#undef IN
#undef SEAM
}

#ifndef N_LAUNCH_MODE
#define N_LAUNCH_MODE 1
#endif
extern "C" void kernel_launch(void* const* d_in, const int* in_sizes, int n_in, void* d_out, int out_size, void* d_ws, size_t ws_size, hipStream_t stream) {
    static int grid = 0;
    if (grid == 0) {
        if (n_in != 26 || out_size != M * DM || ws_size < WS_END) { fprintf(stderr, "kernel_launch: unexpected shapes (n_in %d, out %d, ws %zu)\n", n_in, out_size, ws_size); grid = -1; return; }
        int dev = 0, cus = 0, per_cu = 0;
        if (hipGetDevice(&dev) != hipSuccess || hipDeviceGetAttribute(&cus, hipDeviceAttributeMultiprocessorCount, dev) != hipSuccess) { grid = -1; return; }
        if (hipFuncSetAttribute((const void*)fwd_kernel, hipFuncAttributeMaxDynamicSharedMemorySize, LDS_BYTES) != hipSuccess) { fprintf(stderr, "kernel_launch: hipFuncSetAttribute failed\n"); grid = -1; return; }
        if (hipOccupancyMaxActiveBlocksPerMultiprocessor(&per_cu, (const void*)fwd_kernel, NWAVES * 64, LDS_BYTES) != hipSuccess || per_cu < 1) { fprintf(stderr, "kernel_launch: occupancy query says %d blocks per CU\n", per_cu); (void)hipGetLastError(); grid = -1; return; }
        grid = cus;
    }
    if (grid < 0) return;
    (void)hipMemsetAsync((char*)d_ws + WS_CTL, 0, CTL_ZERO_BYTES, stream);
    Args a{};
    for (int i = 0; i < 26; ++i) a.in[i] = (const float*)d_in[i];
    a.out = (float*)d_out; a.ws = (unsigned char*)d_ws;
    if (N_LAUNCH_MODE == 1) { a.ph_lo = 0; a.ph_hi = N_PHASES; a.li = 0; hipLaunchKernelGGL(fwd_kernel, dim3(grid), dim3(NWAVES * 64), LDS_BYTES, stream, a); }
    else { for (int p = 0; p < N_PHASES; ++p) { a.ph_lo = p; a.ph_hi = p + 1; a.li = 0; hipLaunchKernelGGL(fwd_kernel, dim3(grid), dim3(NWAVES * 64), LDS_BYTES, stream, a); } }
}
```

```cpp
#include <hip/hip_runtime.h>
#include <cstdio>
#include <cstdint>
namespace pg8 {
#define PG8_LAS __attribute__((address_space(3)))
typedef unsigned short bf16_t;
typedef short bf16x8 __attribute__((ext_vector_type(8)));
typedef float f32x4 __attribute__((ext_vector_type(4)));
typedef unsigned u32x4 __attribute__((ext_vector_type(4)));
constexpr int BM = 256, BK = 64, HALF = 128, HTB = HALF * BK * 2  , STAGE_BYTES = 8 * HTB, NXCD = 8, WGM = 8;

__host__ __device__ __forceinline__ int lds_byte(int r, int c) { const int st = (r >> 4) * 2 + (c >> 5), rr = r & 15, cc = c & 31, ob = rr * 64 + cc * 2; return st * 1024 + (ob ^ (((ob >> 9) & 1) << 5)); }
__host__ __device__ __forceinline__ void stage_rc(int b, int& R, int& C) { const int st = b / 1024, sb = b % 1024, swz = sb ^ (((sb >> 9) & 1) << 5); R = (st >> 1) * 16 + swz / 64; C = (st & 1) * 32 + (swz % 64) / 2; }
__host__ __device__ __forceinline__ int perm32(int rho) { const int n = rho >> 4, i = rho & 15; return 8 * (i >> 2) + 4 * n + (i & 3); }

struct Unit { int pm, pn; };
struct Gemm { const bf16_t* A; const bf16_t* Bt; int M, N, K; };

struct StaticOrder {
    int nM, nN, nwg, G, c;
    __host__ __device__ void init(int M, int N, int G_, int c_) { nM = M / BM; nN = N / BM; nwg = nM * nN; G = G_; c = c_; }
    __host__ __device__ bool next(int i, Unit& u) const {
        const long L = (long)i * G + c; if (L >= nwg) return false;
        int wgid = (int)L; { const int q = nwg / NXCD, r = nwg % NXCD, xcd = wgid % NXCD, off = wgid / NXCD; wgid = (xcd < r ? xcd * (q + 1) : r * (q + 1) + (xcd - r) * q) + off; }
        const int nig = WGM * nN, gid = wgid / nig, fm = gid * WGM, gsz = (nM - fm) < WGM ? (nM - fm) : WGM;
        u.pm = fm + ((wgid % nig) % gsz); u.pn = (wgid % nig) / gsz; return true;
    }
    __device__ __forceinline__ void a_ready(const Unit&) const {}
    __device__ __forceinline__ void done(const Unit&) const {}
};

typedef float f32x2 __attribute__((ext_vector_type(2)));
typedef __bf16 bf16x2_t __attribute__((ext_vector_type(2)));
__device__ __forceinline__ unsigned cvt_pk_bf16(float lo, float hi) { f32x2 v = {lo, hi}; bf16x2_t b = __builtin_convertvector(v, bf16x2_t); return __builtin_bit_cast(unsigned, b); }
__device__ __forceinline__ bf16_t cvt_bf16(float x) { return (bf16_t)(cvt_pk_bf16(x, 0.f) & 0xffffu); }

struct EpiSplitT {
    static constexpr bool PERM = true, AFTER_DRAIN = false;
    bf16_t* O; int ldc; int ncols_rm; bf16_t* T; int NT; int rpb;
    __device__ __forceinline__ void operator()(const f32x4 (&acc)[2][2][4][2], const Unit& u, int wr, int wc, int fr, int fq) const {
        const int row0 = u.pm * BM + wr * 64 + fr; const int colt = u.pn * BM;
        if (colt < ncols_rm) {
            const int col0 = colt + wc * 32 + 8 * fq;
#pragma unroll
            for (int ai = 0; ai < 2; ++ai)
#pragma unroll
                for (int m = 0; m < 4; ++m) { bf16_t* rowp = O + (size_t)(row0 + ai * HALF + m * 16) * ldc + col0;
#pragma unroll
                    for (int bj = 0; bj < 2; ++bj) { const f32x4 v0 = acc[ai][bj][m][0], v1 = acc[ai][bj][m][1];
                        u32x4 w; w.x = cvt_pk_bf16(v0[0], v0[1]); w.y = cvt_pk_bf16(v0[2], v0[3]); w.z = cvt_pk_bf16(v1[0], v1[1]); w.w = cvt_pk_bf16(v1[2], v1[3]);
                        *(u32x4*)(rowp + bj * HALF) = w; } }
        } else {
            const int c0 = colt - ncols_rm + wc * 32 + 8 * fq;
#pragma unroll
            for (int ai = 0; ai < 2; ++ai)
#pragma unroll
                for (int m = 0; m < 4; ++m) { const int row = row0 + ai * HALF + m * 16; const int b = row / rpb, t = row - b * rpb; bf16_t* base = T + (size_t)b * NT * rpb + t;
#pragma unroll
                    for (int bj = 0; bj < 2; ++bj)
#pragma unroll
                        for (int n = 0; n < 2; ++n)
#pragma unroll
                            for (int e = 0; e < 4; ++e) base[(size_t)(c0 + bj * HALF + 4 * n + e) * rpb] = cvt_bf16(acc[ai][bj][m][n][e]); }
        }
    }
};
template <bool BASE_BF16> struct EpiResid {
    static constexpr bool PERM = true, AFTER_DRAIN = false;
    const void* base; bf16_t* xb; float* ssq; int ldc;
    __device__ __forceinline__ void operator()(const f32x4 (&acc)[2][2][4][2], const Unit& u, int wr, int wc, int fr, int fq) const {
        const int row0 = u.pm * BM + wr * 64 + fr; const int col0 = u.pn * BM + wc * 32 + 8 * fq;
#pragma unroll
        for (int ai = 0; ai < 2; ++ai)
#pragma unroll
            for (int m = 0; m < 4; ++m) { const int row = row0 + ai * HALF + m * 16; float s = 0.f;
#pragma unroll
                for (int bj = 0; bj < 2; ++bj) { const size_t off = (size_t)row * ldc + col0 + bj * HALF;
                    f32x4 b0, b1;
                    if (BASE_BF16) { const u32x4 w = *(const u32x4*)((const bf16_t*)base + off);
                        b0 = (f32x4){__uint_as_float(w.x << 16), __uint_as_float(w.x & 0xffff0000u), __uint_as_float(w.y << 16), __uint_as_float(w.y & 0xffff0000u)};
                        b1 = (f32x4){__uint_as_float(w.z << 16), __uint_as_float(w.z & 0xffff0000u), __uint_as_float(w.w << 16), __uint_as_float(w.w & 0xffff0000u)}; }
                    else { b0 = *(const f32x4*)((const float*)base + off); b1 = *(const f32x4*)((const float*)base + off + 4); }
                    const f32x4 v0 = acc[ai][bj][m][0] + b0, v1 = acc[ai][bj][m][1] + b1;
                    s += (v0[0] * v0[0] + v0[1] * v0[1]) + (v0[2] * v0[2] + v0[3] * v0[3]) + (v1[0] * v1[0] + v1[1] * v1[1]) + (v1[2] * v1[2] + v1[3] * v1[3]);
                    u32x4 w; w.x = cvt_pk_bf16(v0[0], v0[1]); w.y = cvt_pk_bf16(v0[2], v0[3]); w.z = cvt_pk_bf16(v1[0], v1[1]); w.w = cvt_pk_bf16(v1[2], v1[3]);
                    *(u32x4*)(xb + off) = w; }
                s += __shfl_xor(s, 16); s += __shfl_xor(s, 32);
                if (fq == 0) ssq[(size_t)row * 16 + u.pn * 4 + wc] = s; }
    }
};
struct EpiRowScale {
    static constexpr bool PERM = true, AFTER_DRAIN = false;
    bf16_t* O; int ldc; const float* ssq; float inv_n, eps;
    __device__ __forceinline__ void operator()(const f32x4 (&acc)[2][2][4][2], const Unit& u, int wr, int wc, int fr, int fq) const {
        const int row0 = u.pm * BM + wr * 64 + fr; const int col0 = u.pn * BM + wc * 32 + 8 * fq;
#pragma unroll
        for (int ai = 0; ai < 2; ++ai)
#pragma unroll
            for (int m = 0; m < 4; ++m) { const int row = row0 + ai * HALF + m * 16; const f32x4* sp = (const f32x4*)(ssq + (size_t)row * 16);
                const f32x4 s0 = sp[0], s1 = sp[1], s2 = sp[2], s3 = sp[3]; const f32x4 st = (s0 + s1) + (s2 + s3);
                const float r = 1.0f / sqrtf(((st[0] + st[1]) + (st[2] + st[3])) * inv_n + eps);
                bf16_t* rowp = O + (size_t)row * ldc + col0;
#pragma unroll
                for (int bj = 0; bj < 2; ++bj) { const f32x4 v0 = acc[ai][bj][m][0] * r, v1 = acc[ai][bj][m][1] * r;
                    u32x4 w; w.x = cvt_pk_bf16(v0[0], v0[1]); w.y = cvt_pk_bf16(v0[2], v0[3]); w.z = cvt_pk_bf16(v1[0], v1[1]); w.w = cvt_pk_bf16(v1[2], v1[3]);
                    *(u32x4*)(rowp + bj * HALF) = w; } }
    }
};
struct OneUnit {
    int idx, nM, nN;
    __device__ __forceinline__ bool next(int i, Unit& u) const { if (i > 0 || idx < 0 || idx >= nM * nN) return false; u.pm = idx % nM; u.pn = idx / nM; return true; }
    __device__ __forceinline__ void a_ready(const Unit&) const {}
    __device__ __forceinline__ void done(const Unit&) const {}
};

template <class Epi, class Sched, bool ALIGN_EPI = false, bool SP2 = false>
__device__ __forceinline__ void gemm_phase(PG8_LAS unsigned char* lds, const Gemm g, const Sched& S, const Epi& E) {
    const int tid = threadIdx.x, wid = __builtin_amdgcn_readfirstlane(tid >> 6), lane = tid & 63, wr = wid >> 2, wc = wid & 3, fr = lane & 15, fq = lane >> 4;
    const int K = g.K, nt = K / BK;
    unsigned voffA[2], voffB[2];
#pragma unroll
    for (int i = 0; i < 2; ++i) { int R, C; stage_rc(tid * 16 + i * 8192, R, C); const int Rb = Epi::PERM ? ((R & ~31) + perm32(R & 31)) : R;
        voffA[i] = (unsigned)(R * K + C) * 2u; voffB[i] = (unsigned)(Rb * K + C) * 2u; }
    const size_t kstep = (size_t)(BK * 2);
    const size_t hstep = (size_t)HALF * K * 2;
    const size_t tstep = 2 * hstep;
    const unsigned ldsw = (unsigned)wid * 1024u;
    const int aoff = lds_byte(wr * 64 + fr, fq * 8), boff = lds_byte(wc * 32 + fr, fq * 8);
#define PG8_SA(b, h) (((b) * 2 + (h)) * HTB)
#define PG8_SB(b, h) ((4 + (b) * 2 + (h)) * HTB)
#define PG8_STAGE(bufoff, gbase, voff) do { _Pragma("unroll") for (int _i = 0; _i < 2; ++_i) \
        __builtin_amdgcn_global_load_lds((const unsigned*)((const char*)(gbase) + (voff)[_i]), (PG8_LAS unsigned*)(lds + (bufoff) + ldsw + _i * 8192), 16, 0, 0); } while (0)
#define PG8_LDA(dst, b, h) do { _Pragma("unroll") for (int m = 0; m < 4; ++m) _Pragma("unroll") for (int k = 0; k < 2; ++k) dst[m][k] = *(const PG8_LAS bf16x8*)(lds + PG8_SA(b, h) + aoff + m * 2048 + k * 1024); } while (0)
#define PG8_LDB(dst, b, h) do { _Pragma("unroll") for (int n = 0; n < 2; ++n) _Pragma("unroll") for (int k = 0; k < 2; ++k) dst[n][k] = *(const PG8_LAS bf16x8*)(lds + PG8_SB(b, h) + boff + n * 2048 + k * 1024); } while (0)
#define PG8_MMA(ai, bj, At, Bt) do { __builtin_amdgcn_s_setprio(1); _Pragma("unroll") for (int m = 0; m < 4; ++m) _Pragma("unroll") for (int n = 0; n < 2; ++n) _Pragma("unroll") for (int k = 0; k < 2; ++k) \
        acc[ai][bj][m][n] = __builtin_amdgcn_mfma_f32_16x16x32_bf16(Bt[n][k], At[m][k], acc[ai][bj][m][n], 0, 0, 0); __builtin_amdgcn_s_setprio(0); } while (0)
#define PG8_WAIT_V(n) asm volatile("s_waitcnt vmcnt(" #n ")" ::: "memory")
#define PG8_WAIT_L(n) asm volatile("s_waitcnt lgkmcnt(" #n ")" ::: "memory")
#define PG8_BAR __builtin_amdgcn_s_barrier()
#define PG8_SCHED __builtin_amdgcn_sched_barrier(0)
    Unit cur, nxt; int ui = 0;
    if (!S.next(0, cur)) return;
    f32x4 acc[2][2][4][2];
#pragma unroll
    for (int a = 0; a < 2; ++a)
#pragma unroll
        for (int b = 0; b < 2; ++b)
#pragma unroll
            for (int m = 0; m < 4; ++m)
#pragma unroll
                for (int n = 0; n < 2; ++n) acc[a][b][m][n] = (f32x4){0.f, 0.f, 0.f, 0.f};
    bf16x8 At[4][2], B0[2][2], B1[2][2];
    const char* cA = (const char*)g.A + (size_t)cur.pm * tstep; const char* cB = (const char*)g.Bt + (size_t)cur.pn * tstep;
    S.a_ready(cur);
    if constexpr (SP2) {
        PG8_STAGE(PG8_SB(0, 0), cB, voffB); PG8_STAGE(PG8_SB(0, 1), cB + hstep, voffB); PG8_STAGE(PG8_SA(0, 0), cA, voffA); PG8_STAGE(PG8_SA(0, 1), cA + hstep, voffA);
        if (wr == 1) PG8_BAR;
        PG8_WAIT_V(2); PG8_BAR;
        PG8_STAGE(PG8_SB(1, 0), cB + kstep, voffB); PG8_STAGE(PG8_SA(1, 0), cA + kstep, voffA); PG8_STAGE(PG8_SB(1, 1), cB + hstep + kstep, voffB);
        PG8_WAIT_V(6); PG8_BAR;
    } else {
        PG8_STAGE(PG8_SB(0, 0), cB, voffB); PG8_STAGE(PG8_SA(0, 0), cA, voffA); PG8_STAGE(PG8_SB(0, 1), cB + hstep, voffB); PG8_STAGE(PG8_SA(0, 1), cA + hstep, voffA);
        if (wr == 1) PG8_BAR;
        PG8_WAIT_V(4); PG8_BAR;
        PG8_STAGE(PG8_SB(1, 0), cB + kstep, voffB); PG8_STAGE(PG8_SA(1, 0), cA + kstep, voffA); PG8_STAGE(PG8_SB(1, 1), cB + hstep + kstep, voffB);
        PG8_WAIT_V(6); PG8_BAR;
    }
    for (;;) {
        const bool has_next = S.next(ui + 1, nxt);
        const char* nA = has_next ? (const char*)g.A + (size_t)nxt.pm * tstep : cA; const char* nB = has_next ? (const char*)g.Bt + (size_t)nxt.pn * tstep : cB;
        for (int t = 0; t < nt; t += 2) {
            const bool last = (t == nt - 2);
            const char* a1 = cA + (size_t)(t + 1) * kstep;
            const char* a2 = last ? nA : cA + (size_t)(t + 2) * kstep; const char* b2 = last ? nB : cB + (size_t)(t + 2) * kstep;
            const char* a3 = a2 + kstep; const char* b3 = b2 + kstep;
            if (last && has_next) S.a_ready(nxt);
            if constexpr (SP2) {
            PG8_LDB(B0, 0, 0); PG8_LDB(B1, 0, 1); PG8_SCHED; PG8_LDA(At, 0, 0); PG8_STAGE(PG8_SA(1, 1), a1 + hstep, voffA);
            PG8_WAIT_V(8); PG8_WAIT_L(0); PG8_BAR; PG8_MMA(0, 0, At, B0); PG8_MMA(0, 1, At, B1); PG8_BAR; PG8_SCHED;
            PG8_LDA(At, 0, 1); PG8_STAGE(PG8_SB(0, 0), b2, voffB); PG8_STAGE(PG8_SB(0, 1), b2 + hstep, voffB); PG8_STAGE(PG8_SA(0, 0), a2, voffA);
            PG8_WAIT_V(8); PG8_WAIT_L(0); PG8_BAR; PG8_MMA(1, 0, At, B0); PG8_MMA(1, 1, At, B1); PG8_BAR; PG8_SCHED;
            PG8_LDB(B0, 1, 0); PG8_LDB(B1, 1, 1); PG8_SCHED; PG8_LDA(At, 1, 0); PG8_STAGE(PG8_SA(0, 1), a2 + hstep, voffA);
            PG8_WAIT_V(8); PG8_WAIT_L(0); PG8_BAR; PG8_MMA(0, 0, At, B0); PG8_MMA(0, 1, At, B1); PG8_BAR; PG8_SCHED;
            PG8_LDA(At, 1, 1); PG8_STAGE(PG8_SB(1, 0), b3, voffB); PG8_STAGE(PG8_SB(1, 1), b3 + hstep, voffB); PG8_STAGE(PG8_SA(1, 0), a3, voffA);
            PG8_WAIT_V(8); PG8_WAIT_L(0); PG8_BAR; PG8_MMA(1, 0, At, B0); PG8_MMA(1, 1, At, B1); PG8_BAR; PG8_SCHED;
            } else {
            PG8_LDB(B0, 0, 0); PG8_SCHED; PG8_LDA(At, 0, 0); PG8_STAGE(PG8_SA(1, 1), a1 + hstep, voffA);
            PG8_WAIT_L(8); PG8_BAR; PG8_WAIT_L(0); PG8_MMA(0, 0, At, B0); PG8_BAR; PG8_SCHED;
            PG8_LDB(B1, 0, 1); PG8_STAGE(PG8_SB(0, 0), b2, voffB);
            PG8_BAR; PG8_WAIT_L(0); PG8_MMA(0, 1, At, B1); PG8_BAR;
            PG8_LDA(At, 0, 1); PG8_STAGE(PG8_SA(0, 0), a2, voffA);
            PG8_BAR; PG8_WAIT_L(0); PG8_MMA(1, 0, At, B0); PG8_BAR; PG8_SCHED;
            PG8_STAGE(PG8_SB(0, 1), b2 + hstep, voffB);
            PG8_WAIT_V(6); PG8_BAR; PG8_MMA(1, 1, At, B1); PG8_BAR;
            PG8_LDB(B0, 1, 0); PG8_SCHED; PG8_LDA(At, 1, 0); PG8_STAGE(PG8_SA(0, 1), a2 + hstep, voffA);
            PG8_WAIT_L(8); PG8_BAR; PG8_WAIT_L(0); PG8_MMA(0, 0, At, B0); PG8_BAR; PG8_SCHED;
            PG8_LDB(B1, 1, 1); PG8_STAGE(PG8_SB(1, 0), b3, voffB);
            PG8_BAR; PG8_WAIT_L(0); PG8_MMA(0, 1, At, B1); PG8_BAR;
            PG8_LDA(At, 1, 1); PG8_STAGE(PG8_SA(1, 0), a3, voffA);
            PG8_BAR; PG8_WAIT_L(0); PG8_MMA(1, 0, At, B0); PG8_BAR; PG8_SCHED;
            PG8_STAGE(PG8_SB(1, 1), b3 + hstep, voffB);
            PG8_WAIT_V(6); PG8_BAR; PG8_MMA(1, 1, At, B1); PG8_BAR;
            }
        }
        if constexpr (ALIGN_EPI) { if (wr == 0) PG8_BAR; }
        if constexpr (!Epi::AFTER_DRAIN) { E(acc, cur, wr, wc, fr, fq); S.done(cur); }
        if (!has_next) break;
#pragma unroll
        for (int a = 0; a < 2; ++a)
#pragma unroll
            for (int b = 0; b < 2; ++b)
#pragma unroll
                for (int m = 0; m < 4; ++m)
#pragma unroll
                    for (int n = 0; n < 2; ++n) acc[a][b][m][n] = (f32x4){0.f, 0.f, 0.f, 0.f};
        cur = nxt; cA = nA; cB = nB; ++ui;
        if constexpr (ALIGN_EPI) { if (wr == 1) PG8_BAR; }
    }
    PG8_WAIT_V(0);
    if constexpr (!ALIGN_EPI) { if (wr == 0) PG8_BAR; }
    PG8_BAR;
    if constexpr (Epi::AFTER_DRAIN) { E.fused(acc, cur, wr, wc, fr, fq, lds, wid, lane); S.done(cur); }
#undef PG8_SA
#undef PG8_SB
#undef PG8_STAGE
#undef PG8_LDA
#undef PG8_LDB
#undef PG8_MMA
#undef PG8_WAIT_V
#undef PG8_WAIT_L
#undef PG8_BAR
#undef PG8_SCHED
}
}

#ifndef PG8_SP2
#define PG8_SP2 true
#endif
#ifndef PG8_ALIGN
#define PG8_ALIGN true
#endif
constexpr int NWAVES = 8;
constexpr int NBATCH = 2, SEQ = 8192, DM = 1024, M = NBATCH * SEQ;
constexpr int INW = 2560, ZW = 2048;
constexpr int LRUW = 512, ATTW = 512, NCHUNK = SEQ / 64;
constexpr int NEXP = 16384, PEER_H = 8, NSEL = 128;
constexpr float EPS = 1e-6f;
constexpr float LOG2E = 1.4426950408889634f;

constexpr size_t MiB = 1u << 20;
constexpr size_t WS_CTL = 0, CTL_ZERO_BYTES = 64 * 1024;
constexpr size_t WS_WIN = 1 * MiB, WS_WOUT = 6 * MiB, WS_WQ = 8 * MiB, WS_WKV = 10 * MiB, WS_WO = 14 * MiB, WS_WQRY = 16 * MiB;
constexpr size_t WS_SUBK = 20 * MiB, WS_GATEW = 20 * MiB + 512 * 1024, WS_MEMN = 21 * MiB, WS_KM = 22 * MiB, WS_VMT = 23 * MiB, WS_AGG = 24 * MiB, WS_SSQ1 = 25 * MiB, WS_SSQ2 = 26 * MiB, WS_SU = 27 * MiB;
constexpr size_t WS_EU = 28 * MiB, WS_EV = 60 * MiB, WS_XN = 92 * MiB, WS_Z = 124 * MiB, WS_VT = 188 * MiB, WS_Y = 204 * MiB, WS_END = 236 * MiB;
constexpr size_t WS_QC = WS_Z, WS_OC = WS_Z + 32 * MiB, WS_QP = WS_Z, WS_IDX = WS_VT, WS_G = WS_VT + 8 * MiB;
constexpr int CW_BAR = 4096;

constexpr int RING_BYTES = 155648;
constexpr int LDSCTL_OFF = RING_BYTES, MISC_OFF = LDSCTL_OFF + 320;
constexpr int LDS_BYTES = 163840;

#define GAS __attribute__((address_space(1)))
#define LAS __attribute__((address_space(3)))
typedef unsigned short bf16;
typedef unsigned v4u __attribute__((ext_vector_type(4)));
typedef unsigned v2u __attribute__((ext_vector_type(2)));
typedef float f32x4 __attribute__((ext_vector_type(4)));
typedef float f32x2 __attribute__((ext_vector_type(2)));
typedef float f32x16 __attribute__((ext_vector_type(16)));
typedef short bf16x8 __attribute__((ext_vector_type(8)));
typedef __bf16 bf16x2_t __attribute__((ext_vector_type(2)));
typedef GAS unsigned gu32;
typedef _Float16 v32h __attribute__((ext_vector_type(32)));
typedef unsigned v6u __attribute__((ext_vector_type(6)));
typedef _Float16 f16x2_t __attribute__((ext_vector_type(2)));
constexpr int EV_ROW = 768;
#define RLX_AGENT __ATOMIC_RELAXED, __HIP_MEMORY_SCOPE_AGENT
#define LDS_WAIT() asm volatile("s_waitcnt lgkmcnt(0)" ::: "memory")
#define VM_WAIT() asm volatile("s_waitcnt vmcnt(0)" ::: "memory")
#define MFMA32(a, b, c) __builtin_amdgcn_mfma_f32_32x32x16_bf16((a), (b), (c), 0, 0, 0)
#define DI __device__ __forceinline__

DI unsigned pk2(float lo, float hi) { f32x2 v = {lo, hi}; bf16x2_t b = __builtin_convertvector(v, bf16x2_t); return __builtin_bit_cast(unsigned, b); }
DI bf16 f2bf(float x) { return (bf16)(pk2(x, 0.f) & 0xffffu); }
DI float bf2f(bf16 x) { return __uint_as_float((unsigned)x << 16); }
DI float bflo(unsigned p) { return __uint_as_float(p << 16); }
DI float bfhi(unsigned p) { return __uint_as_float(p & 0xffff0000u); }
DI int crow(int reg, int hh) { return (reg & 3) + 8 * (reg >> 2) + 4 * hh; }
DI float swap32_partner(float x, int hh) { auto rr = __builtin_amdgcn_permlane32_swap(__float_as_uint(x), __float_as_uint(x), false, false); return __uint_as_float(hh ? rr[0] : rr[1]); }
DI float dpp_xor1(float x) { return __int_as_float(__builtin_amdgcn_update_dpp(0, __float_as_int(x), 0xB1, 0xf, 0xf, true)); }
DI float dpp_xor2(float x) { return __int_as_float(__builtin_amdgcn_update_dpp(0, __float_as_int(x), 0x4E, 0xf, 0xf, true)); }
DI float dpp_hmir(float x) { return __int_as_float(__builtin_amdgcn_update_dpp(0, __float_as_int(x), 0x141, 0xf, 0xf, true)); }
DI float dpp_mir(float x)  { return __int_as_float(__builtin_amdgcn_update_dpp(0, __float_as_int(x), 0x140, 0xf, 0xf, true)); }
DI float sum16(float x) { x += dpp_xor1(x); x += dpp_xor2(x); x += dpp_hmir(x); x += dpp_mir(x); return x; }
DI float sum32(float x) { x = sum16(x); auto rr = __builtin_amdgcn_permlane16_swap(__float_as_uint(x), __float_as_uint(x), false, false); return __uint_as_float(rr[0]) + __uint_as_float(rr[1]); }
DI float max16(float x) { x = fmaxf(x, dpp_xor1(x)); x = fmaxf(x, dpp_xor2(x)); x = fmaxf(x, dpp_hmir(x)); x = fmaxf(x, dpp_mir(x)); return x; }
DI float max64(float x) { x = max16(x); { auto rr = __builtin_amdgcn_permlane16_swap(__float_as_uint(x), __float_as_uint(x), false, false); x = fmaxf(__uint_as_float(rr[0]), __uint_as_float(rr[1])); }
    { auto rr = __builtin_amdgcn_permlane32_swap(__float_as_uint(x), __float_as_uint(x), false, false); x = fmaxf(__uint_as_float(rr[0]), __uint_as_float(rr[1])); } return x; }
DI unsigned pack_i8x4(float a, float b, float c, float d) { const int ia = (int)__builtin_rintf(a), ib = (int)__builtin_rintf(b), ic = (int)__builtin_rintf(c), id = (int)__builtin_rintf(d);
    return (unsigned)(ia & 255) | ((unsigned)(ib & 255) << 8) | ((unsigned)(ic & 255) << 16) | ((unsigned)id << 24); }
DI float max32(float x) { x = max16(x); auto rr = __builtin_amdgcn_permlane16_swap(__float_as_uint(x), __float_as_uint(x), false, false); return fmaxf(__uint_as_float(rr[0]), __uint_as_float(rr[1])); }
DI float sum64(float x) { x = sum32(x); auto rr = __builtin_amdgcn_permlane32_swap(__float_as_uint(x), __float_as_uint(x), false, false); return __uint_as_float(rr[0]) + __uint_as_float(rr[1]); }
DI float rcp_(float x) { return __builtin_amdgcn_rcpf(x); }
DI float rsq_(float x) { return __builtin_amdgcn_rsqf(x); }
DI float exp2_(float x) { return __builtin_amdgcn_exp2f(x); }
DI float gelu_tanh(float x) { const float u = x * (1.5957691216057308f + 0.07135481627159768f * x * x); return x * rcp_(1.0f + exp2_(-LOG2E * u)); }
DI float sigmoidf_(float x) { return rcp_(1.0f + exp2_(-LOG2E * x)); }
#define XB_TMO      128
#define XB_XCNT(j)  (256  + 64 * (j))
#define XB_XSUB(j)  (1280 + 64 * (j))
#define XB_XGEN(j)  (2304 + 64 * (j))
#define XB_TOP      3328
#define XB_TOPGEN   3392
#define XCD_BAR_WORDS 3456
#define XB_SPIN_CAP (1u << 18)

__device__ __forceinline__ unsigned xb_ld(unsigned* p)              { return __hip_atomic_load(p, __ATOMIC_RELAXED, __HIP_MEMORY_SCOPE_AGENT); }
__device__ __forceinline__ unsigned xb_add(unsigned* p, unsigned v) { return __hip_atomic_fetch_add(p, v, __ATOMIC_RELAXED, __HIP_MEMORY_SCOPE_AGENT); }
__device__ __forceinline__ unsigned xb_xcc_id() { return (unsigned)__builtin_amdgcn_s_getreg((3 << 11) | 20) & 0xFu; }
#define XB_SPIN(cond, bar) do { unsigned _sp = 0; while (cond) { __builtin_amdgcn_s_sleep(1); \
    if ((++_sp & 255u) == 0u) { if (xb_ld(&(bar)[XB_TMO])) break; if (_sp > XB_SPIN_CAP) { atomicAdd(&(bar)[XB_TMO], 1u); break; } } } } while (0)

struct XcdBarrier {
    unsigned* bar; unsigned x;
    volatile LAS unsigned* st;
};

__device__ __forceinline__ XcdBarrier xcd_barrier_post(unsigned* bar, volatile LAS unsigned* st) {
    XcdBarrier b; b.bar = bar; b.x = xb_xcc_id(); b.st = st;
    if (threadIdx.x == 0) (void)xb_add(&bar[XB_XCNT(b.x)], 1u);
    return b;
}
__device__ __forceinline__ void xcd_barrier_complete(unsigned* bar, unsigned x, unsigned& nloc, unsigned& nx) {
    const unsigned G = gridDim.x * gridDim.y * gridDim.z;
    unsigned sum, cnt, mine, sp = 0u;
    for (;;) {
        sum = 0u; cnt = 0u; mine = 0u;
#pragma unroll
        for (unsigned j = 0; j < 16; ++j) { const unsigned c = xb_ld(&bar[XB_XCNT(j)]); sum += c; cnt += (c > 0u) ? 1u : 0u; mine = (j == x) ? c : mine; }
        if (sum == G) break;
        __builtin_amdgcn_s_sleep(1);
        if ((++sp & 255u) == 0u) { if (xb_ld(&bar[XB_TMO])) break; if (sp > XB_SPIN_CAP) { atomicAdd(&bar[XB_TMO], 1u); break; } }
    }
    nloc = mine > 0u ? mine : 1u; nx = cnt > 0u ? cnt : 1u;
}

__device__ __forceinline__ void xcd_barrier(const XcdBarrier& b) {
    asm volatile("s_waitcnt vmcnt(0)" ::: "memory");
    __syncthreads();
    if (threadIdx.x == 0) {
        unsigned* bar = b.bar;
        __builtin_amdgcn_s_waitcnt(0);
        unsigned nloc = b.st[0], nx = b.st[1];
        if (nloc == 0u) { xcd_barrier_complete(bar, b.x, nloc, nx); b.st[0] = nloc; b.st[1] = nx; }
        const unsigned old = xb_add(&bar[XB_XSUB(b.x)], 1u);
        const unsigned gen = old / nloc;
        if (old + 1u == (gen + 1u) * nloc) {
            __builtin_amdgcn_fence(__ATOMIC_RELEASE, "agent");
            asm volatile("s_waitcnt vmcnt(0)" ::: "memory");
            const unsigned og = xb_add(&bar[XB_TOP], 1u);
            const unsigned tg = og / nx;
            if (og + 1u == (tg + 1u) * nx) xb_add(&bar[XB_TOPGEN], 1u);
            else XB_SPIN(xb_ld(&bar[XB_TOPGEN]) == tg, bar);
            __builtin_amdgcn_fence(__ATOMIC_ACQUIRE, "agent");
            xb_add(&bar[XB_XGEN(b.x)], 1u);
            asm volatile("s_waitcnt vmcnt(0)" ::: "memory");
        } else {
            XB_SPIN(xb_ld(&bar[XB_XGEN(b.x)]) == gen, bar);
            __builtin_amdgcn_fence(__ATOMIC_ACQUIRE, "agent");
            asm volatile("s_waitcnt vmcnt(0)" ::: "memory");
        }
    }
    __syncthreads();
}
struct Args { const float* in[26]; float* out; unsigned char* ws; int ph_lo, ph_hi, li, pad; };
struct Frame {
    LAS unsigned char* lds;
    volatile LAS unsigned* MISC;
    gu32* ctl;
    int tid, lane, wave, vcu, G;
    const Args* A; float* out; unsigned char* ws;
    DI const float* in(int k) const { return A->in[k]; }
    template <class T> DI T* wsp(size_t off) const { return (T*)(ws + off); }
};

DI void p0_transpose_item(const float* W, int K, int N, bf16* WT, LAS float* scr, int item, int lane, const float* g0, const float* g1, int gsplit) {
    const int nblk = N / 32, kb = item / nblk, nb = item % nblk, k0 = 64 * kb, n0 = 32 * nb;
    float wv[32], gv[32];
#pragma unroll
    for (int i = 0; i < 32; ++i) { const int k = k0 + 2 * i + (lane >> 5); wv[i] = W[(size_t)k * N + n0 + (lane & 31)]; gv[i] = g0 ? ((k < gsplit) ? g0[k] : g1[k - gsplit]) : 1.f; }
#pragma unroll
    for (int i = 0; i < 32; ++i) scr[(2 * i + (lane >> 5)) * 33 + (lane & 31)] = wv[i] * gv[i];
    LDS_WAIT(); asm volatile("" ::: "memory");
    const int c = lane & 7;
#pragma unroll
    for (int j = 0; j < 4; ++j) { const int n = (lane >> 3) + 8 * j; const LAS float* s = scr + (8 * c) * 33 + n;
        v4u o; o.x = pk2(s[0 * 33], s[1 * 33]); o.y = pk2(s[2 * 33], s[3 * 33]); o.z = pk2(s[4 * 33], s[5 * 33]); o.w = pk2(s[6 * 33], s[7 * 33]);
        *(GAS v4u*)(WT + (size_t)(n0 + n) * K + k0 + 8 * c) = o; }
    LDS_WAIT(); asm volatile("" ::: "memory");
}
template <bool NORM> DI void row_to_bf16(const float* xrow, bf16* orow, const float* gain, int lane) {
    const GAS f32x4* xr = (const GAS f32x4*)xrow + lane;
    f32x4 v[4]; float s = 0.f;
#pragma unroll
    for (int j = 0; j < 4; ++j) { v[j] = xr[64 * j]; s += (v[j].x * v[j].x + v[j].y * v[j].y) + (v[j].z * v[j].z + v[j].w * v[j].w); }
    float rstd = 1.f;
    if (NORM) rstd = 1.0f / sqrtf(sum64(s) * (1.f / 1024.f) + EPS);
    GAS v2u* o8 = (GAS v2u*)orow + lane;
#pragma unroll
    for (int j = 0; j < 4; ++j) { f32x4 w = v[j] * rstd; if (gain) w = w * ((const GAS f32x4*)gain)[64 * j + lane];
        v2u o; o.x = pk2(w.x, w.y); o.y = pk2(w.z, w.w); o8[64 * j] = o; }
}
constexpr float U_SCALE = 128.f, V_SCALE = 16.f;
template <bool NORM, int NB> DI void rows_to_bf16(const float* xrow, bf16* orow, size_t row_stride, const float* gain, int lane) {
    f32x4 v[NB][4];
#pragma unroll
    for (int b = 0; b < NB; ++b)
#pragma unroll
        for (int j = 0; j < 4; ++j) v[b][j] = ((const GAS f32x4*)(xrow + b * row_stride))[64 * j + lane];
#pragma unroll
    for (int b = 0; b < NB; ++b) { float s = 0.f;
#pragma unroll
        for (int j = 0; j < 4; ++j) s += (v[b][j].x * v[b][j].x + v[b][j].y * v[b][j].y) + (v[b][j].z * v[b][j].z + v[b][j].w * v[b][j].w);
        float rstd = 1.f; if (NORM) rstd = rsq_(sum64(s) * (1.f / 1024.f) + EPS);
        GAS v2u* o8 = (GAS v2u*)(orow + b * row_stride) + lane;
#pragma unroll
        for (int j = 0; j < 4; ++j) { f32x4 w = v[b][j] * rstd; if (gain) w = w * ((const GAS f32x4*)gain)[64 * j + lane];
            v2u o; o.x = pk2(w.x, w.y); o.y = pk2(w.z, w.w); o8[64 * j] = o; } }
}
DI void row_to_fp8(const float* src, unsigned char* dst, const float* gain, float scale, int lane) {
#pragma unroll
    for (int j = 0; j < 4; ++j) { f32x4 v = ((const GAS f32x4*)src)[64 * j + lane] * scale; if (gain) v = v * ((const GAS f32x4*)gain)[64 * j + lane];
        unsigned w = 0u; w = __builtin_amdgcn_cvt_pk_fp8_f32(v.x, v.y, w, false); w = __builtin_amdgcn_cvt_pk_fp8_f32(v.z, v.w, w, true);
        ((GAS unsigned*)dst)[64 * j + lane] = w; }
}
DI void row_to_i8(const float* src, unsigned char* dst, const float* gain, float* scale_out, int lane) {
    f32x4 v[4]; float mx = 0.f;
#pragma unroll
    for (int j = 0; j < 4; ++j) { v[j] = ((const GAS f32x4*)src)[64 * j + lane] * ((const GAS f32x4*)gain)[64 * j + lane];
        mx = fmaxf(fmaxf(mx, fmaxf(fabsf(v[j].x), fabsf(v[j].y))), fmaxf(fabsf(v[j].z), fabsf(v[j].w))); }
    mx = fmaxf(max64(mx), 1e-30f);
    const float inv = 127.0f / mx;
#pragma unroll
    for (int j = 0; j < 4; ++j) ((GAS unsigned*)dst)[64 * j + lane] = pack_i8x4(v[j].x * inv, v[j].y * inv, v[j].z * inv, v[j].w * inv);
    if (lane == 0) *scale_out = mx * (1.0f / 127.0f);
}
DI void convert_experts(Frame& F, int wv, int nwv) {
    const int lane = F.lane;
    const int l5 = lane & 31, hh = lane >> 5;
    for (int m = wv * 2; m < NEXP; m += nwv * 2) {
        f32x4 u[2][4], v[8];
#pragma unroll
        for (int b = 0; b < 2; ++b)
#pragma unroll
            for (int j = 0; j < 4; ++j) u[b][j] = ((const GAS f32x4*)(F.in(23) + (size_t)(m + b) * DM))[64 * j + lane];
#pragma unroll
        for (int j = 0; j < 8; ++j) v[j] = ((const GAS f32x4*)(F.in(24) + (size_t)(m + hh) * DM))[32 * j + l5];
#pragma unroll
        for (int b = 0; b < 2; ++b) {
            float mx = 0.f;
#pragma unroll
            for (int j = 0; j < 4; ++j) { u[b][j] = u[b][j] * ((const GAS f32x4*)F.in(20))[64 * j + lane];
                mx = fmaxf(fmaxf(mx, fmaxf(fabsf(u[b][j].x), fabsf(u[b][j].y))), fmaxf(fabsf(u[b][j].z), fabsf(u[b][j].w))); }
            mx = fmaxf(max64(mx), 1e-30f);
            const float inv = 127.0f / mx;
#pragma unroll
            for (int j = 0; j < 4; ++j) ((GAS unsigned*)(F.wsp<unsigned char>(WS_EU) + (size_t)(m + b) * DM))[64 * j + lane] = pack_i8x4(u[b][j].x * inv, u[b][j].y * inv, u[b][j].z * inv, u[b][j].w * inv);
            if (lane == 0) F.wsp<float>(WS_SU)[m + b] = mx * (1.0f / 127.0f);
        }
        {
            float mx = 0.f;
#pragma unroll
            for (int j = 0; j < 8; ++j) mx = fmaxf(fmaxf(mx, fmaxf(fabsf(v[j].x), fabsf(v[j].y))), fmaxf(fabsf(v[j].z), fabsf(v[j].w)));
            mx = fmaxf(max32(mx), 1e-30f);
            const float inv = 7.5f / mx;
            v32h h;
#pragma unroll
            for (int j = 0; j < 8; ++j) { h[4 * j] = (_Float16)(v[j].x * inv); h[4 * j + 1] = (_Float16)(v[j].y * inv); h[4 * j + 2] = (_Float16)(v[j].z * inv); h[4 * j + 3] = (_Float16)(v[j].w * inv); }
            const v6u pk = __builtin_amdgcn_cvt_scalef32_pk32_fp6_f16(h, 1.0f);
            unsigned char* rowp = F.wsp<unsigned char>(WS_EV) + (size_t)(m + hh) * EV_ROW;
            *(GAS v4u*)(rowp + 16 * l5) = (v4u){pk[0], pk[1], pk[2], pk[3]}; *(GAS v2u*)(rowp + 512 + 8 * l5) = (v2u){pk[4], pk[5]};
            if (l5 == 0) F.wsp<float>(WS_SU)[NEXP + m + hh] = mx * (1.0f / 7.5f);
        }
    }
}
DI void p0_prologue(Frame& F, int parts = 7) {
    LAS float* scr = (LAS float*)(F.lds + F.wave * 16384);
    const int gw = F.vcu * NWAVES + F.wave, NGW = F.G * NWAVES, lane = F.lane;
    constexpr int I_IN = 16 * (INW / 32), I_D = 16 * (DM / 32), I_2D = 16 * (2 * DM / 32);
    constexpr int NITEMS = I_IN + 3 * I_D + 2 * I_2D;
    for (int it = gw; it < ((parts & 1) ? NITEMS : 0); it += NGW) {
        int r = it;
        if (r < I_IN) { p0_transpose_item(F.in(3), DM, INW, F.wsp<bf16>(WS_WIN), scr, r, lane, F.in(2), F.in(2), DM); continue; } r -= I_IN;
        if (r < I_D) { p0_transpose_item(F.in(14), DM, DM, F.wsp<bf16>(WS_WOUT), scr, r, lane, F.in(12), F.in(13), LRUW); continue; } r -= I_D;
        if (r < I_D) { p0_transpose_item(F.in(17), DM, DM, F.wsp<bf16>(WS_WQ), scr, r, lane, F.in(15), F.in(15), DM); continue; } r -= I_D;
        if (r < I_2D) { p0_transpose_item(F.in(18), DM, 2 * DM, F.wsp<bf16>(WS_WKV), scr, r, lane, nullptr, nullptr, 0); continue; } r -= I_2D;
        if (r < I_D) { p0_transpose_item(F.in(19), DM, DM, F.wsp<bf16>(WS_WO), scr, r, lane, nullptr, nullptr, 0); continue; } r -= I_D;
        p0_transpose_item(F.in(21), DM, 2 * DM, F.wsp<bf16>(WS_WQRY), scr, r, lane, F.in(20), F.in(20), DM);
    }
    for (int m = gw * 4; m < ((parts & 2) ? M : 0); m += NGW * 4) rows_to_bf16<true, 4>(F.in(0) + (size_t)m * DM, F.wsp<bf16>(WS_XN) + (size_t)m * DM, DM, nullptr, lane);
    for (int m = gw; m < NBATCH * 256; m += NGW) row_to_bf16<true>(F.in(1) + (size_t)m * DM, F.wsp<bf16>(WS_MEMN) + (size_t)m * DM, F.in(16), lane);
    { const int gt = gw * 64 + lane, NT = NGW * 64;
      for (int i = gt; i < 8 * 2 * 128 * 128 / 4; i += NT) { const f32x4 v = ((const GAS f32x4*)F.in(22))[i]; v2u o; o.x = pk2(v.x, v.y); o.y = pk2(v.z, v.w); ((GAS v2u*)F.wsp<bf16>(WS_SUBK))[i] = o; }
      for (int o = gt; o < 2 * 8 * 64 * 64; o += NT) { const int i = o & 63, j = (o >> 6) & 63, h = (o >> 12) & 7, g = o >> 15;
          const float* W = g ? F.in(8) : F.in(6); F.wsp<bf16>(WS_GATEW)[o] = f2bf(W[(h * 64 + i) * 64 + j]); } }
}
struct LruState { float ba[2], bx[2], sp[2], S[2], Ap[2]; };
template <bool PASS2>
DI void lru_prep(const Frame& F, int b, int chunk, int h, int lane, LAS unsigned char* xcs  , LruState& st) {
    const int r = lane & 31, hh = lane >> 5;
    const size_t row0 = (size_t)b * SEQ + (size_t)chunk * 64;
    {
        const int c2 = h * 64 + 2 * r;
        const f32x2 w0 = *(const f32x2*)(F.in(4) + c2), w1 = *(const f32x2*)(F.in(4) + LRUW + c2), w2 = *(const f32x2*)(F.in(4) + 2 * LRUW + c2), w3 = *(const f32x2*)(F.in(4) + 3 * LRUW + c2);
        const f32x2 cb = *(const f32x2*)(F.in(5) + c2);
        const int tl0 = 32 * hh;
        const bf16* zp = F.wsp<bf16>(WS_Z) + (row0 + tl0) * ZW + c2;
        const bool first = (chunk == 0 && hh == 0);
        unsigned p0 = first ? 0u : *(const unsigned*)(zp - 3 * ZW), p1 = first ? 0u : *(const unsigned*)(zp - 2 * ZW), p2 = first ? 0u : *(const unsigned*)(zp - ZW);
#pragma unroll
        for (int t = 0; t < 32; ++t) { const unsigned p3 = *(const unsigned*)(zp + (size_t)t * ZW);
            const float lo = cb.x + bflo(p0) * w0.x + bflo(p1) * w1.x + bflo(p2) * w2.x + bflo(p3) * w3.x;
            const float hi = cb.y + bfhi(p0) * w0.y + bfhi(p1) * w1.y + bfhi(p2) * w2.y + bfhi(p3) * w3.y;
            *(LAS unsigned*)(xcs + (tl0 + t) * 144 + 4 * r) = pk2(lo, hi);
            p0 = p1; p1 = p2; p2 = p3; }
        LDS_WAIT();
    }
#pragma unroll
    for (int nt = 0; nt < 2; ++nt) { const int c = h * 64 + 32 * nt + r; st.ba[nt] = F.in(7)[c]; st.bx[nt] = F.in(9)[c];
        const float nl = -F.in(10)[c]; st.sp[nt] = fmaxf(nl, 0.f) + log1pf(__expf(-fabsf(nl))); st.S[nt] = 0.f; st.Ap[nt] = 1.f; }
    if (PASS2) {
        float s = 0.f; const float* ag = F.wsp<float>(WS_AGG) + ((size_t)b * NCHUNK * LRUW + h * 64 + lane) * 2;
        for (int c0 = 0; c0 < chunk; c0 += 32) {
            f32x2 ab[32];
#pragma unroll
            for (int i = 0; i < 32; ++i) ab[i] = *(const f32x2*)(ag + (size_t)(c0 + i < NCHUNK ? c0 + i : NCHUNK - 1) * LRUW * 2);
#pragma unroll
            for (int i = 0; i < 32; ++i) { const bool on = c0 + i < chunk; s = (on ? ab[i].x : 1.0f) * s + (on ? ab[i].y : 0.0f); }
        }
        st.S[0] = __shfl(s, r); st.S[1] = __shfl(s, 32 + r);
    }
}
template <bool PASS2>
DI void lru_tile(const Frame& F, int b, int chunk, int mt, int h, int lane, LAS unsigned char* xcs, LAS unsigned char* gim  , LruState& st, float (&ssq)[16]) {
    const int r = lane & 31, hh = lane >> 5;
    const size_t row0 = (size_t)b * SEQ + (size_t)chunk * 64;
    const bf16* gw = F.wsp<bf16>(WS_GATEW) + (size_t)h * 4096;
    bf16x8 af[4];
#pragma unroll
    for (int s = 0; s < 4; ++s) af[s] = *(const LAS bf16x8*)(xcs + (32 * mt + r) * 144 + (16 * s + 8 * hh) * 2);
    float ssl[16];
#pragma unroll
    for (int i = 0; i < 16; ++i) ssl[i] = 0.f;
    if (PASS2) {
#pragma unroll
        for (int i = 0; i < 4; ++i) { const int row = (lane >> 3) + 8 * i, c = lane & 7;
            *(LAS v4u*)(gim + row * 144 + c * 16) = *(const v4u*)(F.wsp<bf16>(WS_Z) + (row0 + 32 * mt + row) * ZW + LRUW + h * 64 + 8 * c); }
        LDS_WAIT();
    }
#pragma unroll
    for (int nt = 0; nt < 2; ++nt) {
        asm volatile("" ::: "memory");
        f32x16 aa = {}, ax = {};
#pragma unroll
        for (int s = 0; s < 4; ++s) {
            const bf16x8 wa = *(const bf16x8*)(gw + (size_t)(32 * nt + r) * 64 + 16 * s + 8 * hh);
            const bf16x8 wx = *(const bf16x8*)(gw + 32768 + (size_t)(32 * nt + r) * 64 + 16 * s + 8 * hh);
            aa = MFMA32(af[s], wa, aa); ax = MFMA32(af[s], wx, ax);
        }
#pragma unroll
        for (int i = 0; i < 16; ++i) {
            const float rg = sigmoidf_(aa[i] + st.ba[nt]), ig = sigmoidf_(ax[i] + st.bx[nt]);
            const float la = -8.0f * rg * st.sp[nt];
            const float a = exp2_(LOG2E * la);
            const float mult = __builtin_amdgcn_sqrtf(fmaxf(1.0f - a * a, 0.f));
            const float xc = bf2f(*(const LAS bf16*)(xcs + (32 * mt + crow(i, hh)) * 144 + (32 * nt + r) * 2));
            aa[i] = a; ax[i] = mult * ig * xc;
        }
        float Ao[4], Bo[4], Aq[4], Bq[4], Sin[4];
#pragma unroll
        for (int q = 0; q < 4; ++q) { const float a0 = aa[4 * q], a1 = aa[4 * q + 1], a2 = aa[4 * q + 2], a3 = aa[4 * q + 3];
            Ao[q] = (a0 * a1) * (a2 * a3); Bo[q] = ((ax[4 * q] * a1 + ax[4 * q + 1]) * a2 + ax[4 * q + 2]) * a3 + ax[4 * q + 3];
            Aq[q] = swap32_partner(Ao[q], hh); Bq[q] = swap32_partner(Bo[q], hh); }
        float s_ = st.S[nt];
#pragma unroll
        for (int q = 0; q < 4; ++q) { const float A1 = hh ? Aq[q] : Ao[q], B1 = hh ? Bq[q] : Bo[q], A2 = hh ? Ao[q] : Aq[q], B2 = hh ? Bo[q] : Bq[q];
            const float smid = A1 * s_ + B1; Sin[q] = hh ? smid : s_; s_ = A2 * smid + B2; st.Ap[nt] *= A1 * A2; }
        st.S[nt] = s_;
        if (PASS2) {
#pragma unroll
            for (int q = 0; q < 4; ++q) { float hp = Sin[q];
#pragma unroll
                for (int e = 0; e < 4; ++e) { const int i = 4 * q + e; hp = aa[i] * hp + ax[i];
                    const float gt = bf2f(*(const LAS bf16*)(gim + crow(i, hh) * 144 + (32 * nt + r) * 2));
                    const float y = hp * gelu_tanh(gt); ssl[i] += y * y;
                    *(LAS bf16*)(xcs + (32 * mt + crow(i, hh)) * 144 + (32 * nt + r) * 2) = f2bf(y); } }
        }
    }
    if (PASS2) {
#pragma unroll
        for (int i = 0; i < 16; ++i) ssq[i] = sum32(ssl[i]);
    }
}
constexpr int ATT_KST = 144, ATT_VST = 136, ATT_KBYTES = 64 * ATT_KST, ATT_VBYTES = 64 * ATT_VST;
DI void attn_wave(const Frame& F, int b, int n, int qt, int h, int lane, const LAS float* tab, LAS unsigned char* kl  , f32x16 (&o)[2]) {
    const int r = lane & 31, hh = lane >> 5;
    LAS unsigned char* vl = kl + ATT_KBYTES;
    const size_t row0 = (size_t)b * SEQ + (size_t)n * 64;
    const float SC = 0.125f * LOG2E;
    bf16x8 qf[4];
#pragma unroll
    for (int s = 0; s < 4; ++s) qf[s] = *(const bf16x8*)(F.wsp<bf16>(WS_Z) + (row0 + 32 * qt + r) * ZW + 2 * LRUW + h * 64 + 16 * s + 8 * hh);
    float mrun = -1e30f, lrun = 0.f;
#pragma unroll
    for (int dt = 0; dt < 2; ++dt) o[dt] = f32x16{};
    const float bfar = tab[256];
    const int srow = lane >> 3, sc8 = lane & 7;
    const int kc0 = (n >= 8 ? n - 8 : 0);
    const char* kg = (const char*)(F.wsp<bf16>(WS_Z) + (size_t)b * SEQ * ZW + 2 * LRUW + ATTW + h * 64);
    const char* vg = (const char*)(F.wsp<bf16>(WS_VT) + (size_t)(b * 8 + h) * 64 * SEQ);
    const unsigned kof = (unsigned)(srow * ZW + 8 * sc8) * 2u, vof = (unsigned)(srow * SEQ + 8 * sc8) * 2u;
    v4u kreg[8];
#pragma unroll
    for (int i = 0; i < 8; ++i) kreg[i] = *(const v4u*)(kg + ((size_t)kc0 * 64 + 8 * i) * ZW * 2 + kof);
    for (int kc = kc0; kc <= n; ++kc) {
        const int dd = n - kc;
        v4u vreg[8];
#pragma unroll
        for (int i = 0; i < 8; ++i) { *(LAS v4u*)(kl + (srow + 8 * i) * ATT_KST + sc8 * 16) = kreg[i]; vreg[i] = *(const v4u*)(vg + ((size_t)(8 * i) * SEQ + kc * 64) * 2 + vof); }
        f32x16 sc[2];
#pragma unroll
        for (int kt = 0; kt < 2; ++kt) { sc[kt] = f32x16{};
#pragma unroll
            for (int s = 0; s < 4; ++s) { const bf16x8 kf = *(const LAS bf16x8*)(kl + (32 * kt + r) * ATT_KST + (16 * s + 8 * hh) * 2); sc[kt] = MFMA32(kf, qf[s], sc[kt]); } }
        if (dd >= 3) {
#pragma unroll
            for (int kt = 0; kt < 2; ++kt)
#pragma unroll
                for (int i = 0; i < 16; ++i) sc[kt][i] = sc[kt][i] * SC + bfar;
        } else {
            const int base = 64 * dd + 32 * qt + r + 128;
#pragma unroll
            for (int kt = 0; kt < 2; ++kt)
#pragma unroll
                for (int i = 0; i < 16; ++i) { int idx = base - (32 * kt + crow(i, hh)); idx = idx > 256 ? 256 : idx; sc[kt][i] = sc[kt][i] * SC + tab[idx]; }
        }
        float mx = sc[0][0];
#pragma unroll
        for (int kt = 0; kt < 2; ++kt)
#pragma unroll
            for (int i = 0; i < 16; ++i) mx = fmaxf(mx, sc[kt][i]);
        mx = fmaxf(mx, swap32_partner(mx, hh));
        const float mnew = fmaxf(mrun, mx), alpha = exp2_(mrun - mnew);
        float ls = 0.f;
#pragma unroll
        for (int kt = 0; kt < 2; ++kt)
#pragma unroll
            for (int i = 0; i < 16; ++i) { const float p = exp2_(sc[kt][i] - mnew); sc[kt][i] = p; ls += p; }
        lrun = lrun * alpha + ls; mrun = mnew;
#pragma unroll
        for (int dt = 0; dt < 2; ++dt)
#pragma unroll
            for (int i = 0; i < 16; ++i) o[dt][i] *= alpha;
#pragma unroll
        for (int i = 0; i < 8; ++i) { LAS v2u* vd = (LAS v2u*)(vl + (srow + 8 * i) * ATT_VST + sc8 * 16); vd[0] = (v2u){vreg[i].x, vreg[i].y}; vd[1] = (v2u){vreg[i].z, vreg[i].w}; }
        if (kc < n) {
#pragma unroll
            for (int i = 0; i < 8; ++i) kreg[i] = *(const v4u*)(kg + ((size_t)(kc + 1) * 64 + 8 * i) * ZW * 2 + kof);
        }
#pragma unroll
        for (int kt = 0; kt < 2; ++kt)
#pragma unroll
            for (int s2 = 0; s2 < 2; ++s2) { v4u w; w.x = pk2(sc[kt][8 * s2], sc[kt][8 * s2 + 1]); w.y = pk2(sc[kt][8 * s2 + 2], sc[kt][8 * s2 + 3]); w.z = pk2(sc[kt][8 * s2 + 4], sc[kt][8 * s2 + 5]); w.w = pk2(sc[kt][8 * s2 + 6], sc[kt][8 * s2 + 7]);
                const bf16x8 pf = __builtin_bit_cast(bf16x8, w);
#pragma unroll
                for (int dt = 0; dt < 2; ++dt) { const LAS unsigned char* vp = vl + (32 * dt + r) * ATT_VST + (32 * kt + 16 * s2 + 4 * hh) * 2;
                    const v2u lo = *(const LAS v2u*)vp, hi = *(const LAS v2u*)(vp + 16); v4u vw; vw.x = lo.x; vw.y = lo.y; vw.z = hi.x; vw.w = hi.y;
                    o[dt] = MFMA32(__builtin_bit_cast(bf16x8, vw), pf, o[dt]); } }
    }
    const float lt = lrun + swap32_partner(lrun, hh); const float inv = rcp_(lt);
#pragma unroll
    for (int dt = 0; dt < 2; ++dt)
#pragma unroll
        for (int i = 0; i < 16; ++i) o[dt][i] *= inv;
}

DI void p2_lru_aggregates(Frame& F) {
    const int lane = F.lane, r = lane & 31, hh = lane >> 5, h = F.wave;
    LAS unsigned char* xcs = F.lds + 12288 + h * 17920;
    for (int u = F.vcu; u < NBATCH * NCHUNK; u += F.G) {
        const int b = u / NCHUNK, n = u % NCHUNK;
        LruState st; float ssq[16];
        lru_prep<false>(F, b, n, h, lane, xcs, st);
#pragma unroll 1
        for (int mt = 0; mt < 2; ++mt) lru_tile<false>(F, b, n, mt, h, lane, xcs, xcs + 9216, st, ssq);
        if (hh == 0) {
#pragma unroll
            for (int nt = 0; nt < 2; ++nt) *(f32x2*)(F.wsp<float>(WS_AGG) + (((size_t)b * NCHUNK + n) * LRUW + h * 64 + 32 * nt + r) * 2) = (f32x2){st.Ap[nt], st.S[nt]};
        }
        LDS_WAIT();
    }
}
DI void p3_mixer(Frame& F, int parts = 3) {
    const int lane = F.lane, r = lane & 31, hh = lane >> 5, h = F.wave;
    LAS float* ssx = (LAS float*)(F.lds);
    LAS float* tab = (LAS float*)(F.lds + 2048 + h * 1280);
    LAS unsigned* stg = (LAS unsigned*)(F.lds + 12288 + h * 17920);
    for (int i = lane; i < 257; i += 64) tab[i] = F.in(11)[h * 257 + i] * LOG2E;
    LDS_WAIT();
    for (int u = F.vcu; u < NBATCH * NCHUNK; u += F.G) {
        const int b = u / NCHUNK, n = u % NCHUNK; const size_t row0 = (size_t)b * SEQ + (size_t)n * 64;
#ifndef MIX_PARTS
#define MIX_PARTS 3
#endif
        if (parts & 1) {
            LruState st;
            lru_prep<true>(F, b, n, h, lane, (LAS unsigned char*)stg, st);
#pragma unroll 1
            for (int mt = 0; mt < 2; ++mt) {
                float ssq[16];
                lru_tile<true>(F, b, n, mt, h, lane, (LAS unsigned char*)stg, (LAS unsigned char*)stg + 9216, st, ssq);
                if (r == 0) {
#pragma unroll
                    for (int i = 0; i < 16; ++i) ssx[crow(i, hh) * 8 + h] = ssq[i];
                }
                __syncthreads();
                const LAS unsigned char* yst = (const LAS unsigned char*)stg + 32 * mt * 144;
#pragma unroll
                for (int i = 0; i < 4; ++i) { const int row = (lane >> 3) + 8 * i, c = lane & 7;
                    const f32x4 s0 = *(const LAS f32x4*)(ssx + row * 8), s1 = *(const LAS f32x4*)(ssx + row * 8 + 4);
                    const float rs = rsq_(((s0.x + s0.y) + (s0.z + s0.w) + (s1.x + s1.y) + (s1.z + s1.w)) * (1.f / 512.f) + EPS);
                    const v4u v = *(const LAS v4u*)(yst + row * 144 + c * 16);
                    v4u o; o.x = pk2(bflo(v.x) * rs, bfhi(v.x) * rs); o.y = pk2(bflo(v.y) * rs, bfhi(v.y) * rs); o.z = pk2(bflo(v.z) * rs, bfhi(v.z) * rs); o.w = pk2(bflo(v.w) * rs, bfhi(v.w) * rs);
                    *(v4u*)(F.wsp<bf16>(WS_Y) + (row0 + 32 * mt + row) * DM + h * 64 + 8 * c) = o; }
                __syncthreads();
            }
        }
    }
    for (int u = F.vcu; u < NBATCH * NCHUNK; u += F.G) {
        const int b = u / NCHUNK, n = u % NCHUNK; const size_t row0 = (size_t)b * SEQ + (size_t)n * 64;
#pragma unroll 1
        for (int qt = 0; qt < ((parts & 2) ? 2 : 0); ++qt) {
            f32x16 o[2];
            attn_wave(F, b, n, qt, h, lane, tab, (LAS unsigned char*)stg, o);
            float s = 0.f;
#pragma unroll
            for (int dt = 0; dt < 2; ++dt)
#pragma unroll
                for (int i = 0; i < 16; ++i) s += o[dt][i] * o[dt][i];
            s += swap32_partner(s, hh);
            if (hh == 0) ssx[r * 8 + h] = s;
            __syncthreads();
            { const f32x4 s0 = *(const LAS f32x4*)(ssx + r * 8), s1 = *(const LAS f32x4*)(ssx + r * 8 + 4);
              const float rs = rsq_(((s0.x + s0.y) + (s0.z + s0.w) + (s1.x + s1.y) + (s1.z + s1.w)) * (1.f / 512.f) + EPS);
#pragma unroll
              for (int dt = 0; dt < 2; ++dt)
#pragma unroll
                  for (int i = 0; i < 16; i += 2) stg[r * 33 + ((32 * dt + crow(i, hh)) >> 1)] = pk2(o[dt][i] * rs, o[dt][i + 1] * rs); }
            LDS_WAIT();
#pragma unroll 4
            for (int i = 0; i < 16; ++i) { const int row = 2 * i + hh; const unsigned v = stg[row * 33 + r];
                *(GAS unsigned*)(F.wsp<bf16>(WS_Y) + (row0 + 32 * qt + row) * DM + LRUW + h * 64 + 2 * r) = v; }
            __syncthreads();
        }
    }
}
DI void p5_cross(Frame& F, const pg8::StaticOrder& S) {
    const int lane = F.lane, r = lane & 31, hh = lane >> 5, w = F.wave, tid = F.tid;
    constexpr int KST = 528, VST = 520;
    const float SC = 0.0625f * LOG2E;
    pg8::Unit un;
    for (int ui = 0; S.next(ui, un); ++ui) {
        const int b = un.pm >> 5, qb = un.pm & 31, hm = un.pn;
        const size_t qrow = (size_t)b * SEQ + (size_t)qb * 256 + 32 * w + r;
        { const bf16* src = F.wsp<bf16>(WS_KM) + (size_t)(b * 256) * DM + hm * 256;
#pragma unroll 4
          for (int i = 0; i < 16; ++i) { const int c = i * 512 + tid, row = c >> 5, ch = c & 31;
              *(LAS v4u*)(F.lds + row * KST + ch * 16) = *(const v4u*)(src + (size_t)row * DM + ch * 8); } }
        __syncthreads();
        f32x16 sc[8];
#pragma unroll
        for (int kt = 0; kt < 8; ++kt) sc[kt] = f32x16{};
#pragma unroll 2
        for (int s = 0; s < 16; ++s) {
            const bf16x8 qf = *(const bf16x8*)(F.wsp<bf16>(WS_QC) + qrow * DM + hm * 256 + 16 * s + 8 * hh);
#pragma unroll
            for (int kt = 0; kt < 8; ++kt) { const bf16x8 kf = *(const LAS bf16x8*)(F.lds + (32 * kt + r) * KST + (16 * s + 8 * hh) * 2); sc[kt] = MFMA32(kf, qf, sc[kt]); }
        }
        float mx = sc[0][0];
#pragma unroll
        for (int kt = 0; kt < 8; ++kt)
#pragma unroll
            for (int i = 0; i < 16; ++i) mx = fmaxf(mx, sc[kt][i]);
        mx = fmaxf(mx, swap32_partner(mx, hh));
        float ls = 0.f; const float mo = mx * SC;
        bf16x8 pf[8][2];
#pragma unroll
        for (int kt = 0; kt < 8; ++kt) {
#pragma unroll
            for (int i = 0; i < 16; ++i) { const float p = exp2_(sc[kt][i] * SC - mo); sc[kt][i] = p; ls += p; }
#pragma unroll
            for (int s2 = 0; s2 < 2; ++s2) { v4u wv; wv.x = pk2(sc[kt][8 * s2], sc[kt][8 * s2 + 1]); wv.y = pk2(sc[kt][8 * s2 + 2], sc[kt][8 * s2 + 3]); wv.z = pk2(sc[kt][8 * s2 + 4], sc[kt][8 * s2 + 5]); wv.w = pk2(sc[kt][8 * s2 + 6], sc[kt][8 * s2 + 7]);
                pf[kt][s2] = __builtin_bit_cast(bf16x8, wv); }
        }
        ls += swap32_partner(ls, hh);
        const float inv = 1.0f / ls;
        __syncthreads();
        { const bf16* src = F.wsp<bf16>(WS_VMT) + (size_t)((b * 4 + hm) * 256) * 256;
#pragma unroll 4
          for (int i = 0; i < 16; ++i) { const int c = i * 512 + tid, row = c >> 5, ch = c & 31; const v4u v = *(const v4u*)(src + (size_t)row * 256 + ch * 8);
              LAS v2u* d = (LAS v2u*)(F.lds + row * VST + ch * 16); d[0] = (v2u){v.x, v.y}; d[1] = (v2u){v.z, v.w}; } }
        __syncthreads();
        LAS unsigned* stg = (LAS unsigned*)(F.lds) ;
#pragma unroll
        for (int half = 0; half < 2; ++half) {
            f32x16 o[4];
#pragma unroll
            for (int dt = 0; dt < 4; ++dt) o[dt] = f32x16{};
#pragma unroll
            for (int kt = 0; kt < 8; ++kt)
#pragma unroll
                for (int s2 = 0; s2 < 2; ++s2)
#pragma unroll
                    for (int dt = 0; dt < 4; ++dt) { const LAS unsigned char* p = F.lds + (128 * half + 32 * dt + r) * VST + (32 * kt + 16 * s2 + 4 * hh) * 2;
                        const v2u lo = *(const LAS v2u*)p, hi = *(const LAS v2u*)(p + 16); v4u wv; wv.x = lo.x; wv.y = lo.y; wv.z = hi.x; wv.w = hi.y;
                        o[dt] = MFMA32(__builtin_bit_cast(bf16x8, wv), pf[kt][s2], o[dt]); }
            if (half == 1) __syncthreads();
            else {   }
            if (half == 0) {
#pragma unroll
                for (int dt = 0; dt < 4; ++dt)
#pragma unroll
                    for (int i = 0; i < 16; i += 2) { const unsigned pv = pk2(o[dt][i] * inv, o[dt][i + 1] * inv); sc[dt][i >> 1] = __uint_as_float(pv); }
            } else {
                LAS unsigned* sw = (LAS unsigned*)(F.lds + w * 16512);
#pragma unroll
                for (int dt = 0; dt < 4; ++dt)
#pragma unroll
                    for (int i = 0; i < 16; i += 2) { sw[r * 129 + ((32 * dt + crow(i, hh)) >> 1)] = __float_as_uint(sc[dt][i >> 1]);
                        sw[r * 129 + 64 + ((32 * dt + crow(i, hh)) >> 1)] = pk2(o[dt][i] * inv, o[dt][i + 1] * inv); }
                LDS_WAIT();
#pragma unroll 4
                for (int i = 0; i < 32; ++i) { const unsigned v0 = sw[i * 129 + lane], v1 = sw[i * 129 + 64 + lane];
                    GAS unsigned* dst = (GAS unsigned*)(F.wsp<bf16>(WS_OC) + ((size_t)b * SEQ + (size_t)qb * 256 + 32 * w + i) * DM + hm * 256);
                    dst[lane] = v0; dst[64 + lane] = v1; }
            }
        }
        (void)stg;
        __syncthreads();
    }
}
template <int N> DI void ce_desc(float (&a)[N], int i, int l) { const float hi = fmaxf(a[i], a[l]), lo = fminf(a[i], a[l]); a[i] = hi; a[l] = lo; }
template <int N, int OFF> DI void bitonic_sort16_desc(float (&a)[N]) {
#define CE_(i, j) ce_desc<N>(a, OFF + (i), OFF + (j))
    CE_(0,13); CE_(1,12); CE_(2,15); CE_(3,14); CE_(4,8); CE_(5,6); CE_(7,11); CE_(9,10);
    CE_(0,5); CE_(1,7); CE_(2,9); CE_(3,4); CE_(6,13); CE_(8,14); CE_(10,15); CE_(11,12);
    CE_(0,1); CE_(2,3); CE_(4,5); CE_(6,8); CE_(7,9); CE_(10,11); CE_(12,13); CE_(14,15);
    CE_(0,2); CE_(1,3); CE_(4,10); CE_(5,11); CE_(6,7); CE_(8,9); CE_(12,14); CE_(13,15);
    CE_(1,2); CE_(3,12); CE_(4,6); CE_(5,7); CE_(8,10); CE_(9,11); CE_(13,14);
    CE_(1,4); CE_(2,6); CE_(5,8); CE_(7,10); CE_(9,13); CE_(11,14);
    CE_(2,4); CE_(3,6); CE_(9,12); CE_(11,13);
    CE_(3,5); CE_(6,8); CE_(7,9); CE_(10,12);
    CE_(3,4); CE_(5,6); CE_(7,8); CE_(9,10); CE_(11,12);
    CE_(6,7); CE_(8,9);
#undef CE_
}
template <int N, int OFF> DI void bitonic_merge16_desc(float (&a)[N]) {
#pragma unroll
    for (int j = 8; j > 0; j >>= 1)
#pragma unroll
        for (int i = 0; i < 16; ++i) { const int l = i ^ j; if (l > i) ce_desc<N>(a, OFF + i, OFF + l); }
}
template <bool SORTED, bool SORT0 = true> DI void top16_of_64(float (&a)[64]) {
    if (SORT0) bitonic_sort16_desc<64, 0>(a); bitonic_sort16_desc<64, 16>(a); bitonic_sort16_desc<64, 32>(a); bitonic_sort16_desc<64, 48>(a);
#pragma unroll
    for (int i = 0; i < 16; ++i) { a[i] = fmaxf(a[i], a[31 - i]); a[32 + i] = fmaxf(a[32 + i], a[63 - i]); }
    bitonic_merge16_desc<64, 0>(a); bitonic_merge16_desc<64, 32>(a);
#pragma unroll
    for (int i = 0; i < 16; ++i) a[i] = fmaxf(a[i], a[47 - i]);
    if (SORTED) bitonic_merge16_desc<64, 0>(a);
}
DI void p8a_topk(Frame& F, const pg8::StaticOrder& S) {
    const int lane = F.lane, r = lane & 31, hh = lane >> 5, w = F.wave;
    constexpr int TK_ST = 272, TK_QBYTES = 256 * TK_ST;
    LAS float* tbl = (LAS float*)(F.lds + w * 8192);
    pg8::Unit un;
    for (int ui = 0; S.next(ui, un); ++ui) {
        const int h = un.pn; const size_t tok = (size_t)un.pm * 256 + 32 * w + r;
        float v[2][16];
#pragma unroll
        for (int p = 0; p < 2; ++p) {
            __syncthreads();
            { const bf16* qsrc = F.wsp<bf16>(WS_QP) + (size_t)un.pm * 256 * 2048 + h * 256 + p * 128; const bf16* ksrc = F.wsp<bf16>(WS_SUBK) + (size_t)((h * 2 + p) * 128) * 128;
              const int rr = F.tid >> 4, ch = F.tid & 15;
#pragma unroll
              for (int i = 0; i < 8; ++i) *(LAS v4u*)(F.lds + (32 * i + rr) * TK_ST + ch * 16) = *(const v4u*)(qsrc + (size_t)(32 * i + rr) * 2048 + ch * 8);
#pragma unroll
              for (int i = 0; i < 4; ++i) *(LAS v4u*)(F.lds + TK_QBYTES + (32 * i + rr) * TK_ST + ch * 16) = *(const v4u*)(ksrc + (size_t)(32 * i + rr) * 128 + ch * 8); }
            __syncthreads();
            f32x16 sc[4];
#pragma unroll
            for (int nt = 0; nt < 4; ++nt) sc[nt] = f32x16{};
#pragma unroll 2
            for (int s = 0; s < 8; ++s) { const bf16x8 qf = *(const LAS bf16x8*)(F.lds + (32 * w + r) * TK_ST + (16 * s + 8 * hh) * 2);
#pragma unroll
                for (int nt = 0; nt < 4; ++nt) { const bf16x8 kf = *(const LAS bf16x8*)(F.lds + TK_QBYTES + (32 * nt + r) * TK_ST + (16 * s + 8 * hh) * 2); sc[nt] = MFMA32(kf, qf, sc[nt]); } }
            float a[64];
#pragma unroll
            for (int nt = 0; nt < 4; ++nt)
#pragma unroll
                for (int i = 0; i < 16; ++i) a[nt * 16 + i] = __uint_as_float((__float_as_uint(sc[nt][i]) & ~127u) | (unsigned)(32 * nt + crow(i, hh)));
            top16_of_64<true>(a);
            float m[16];
#pragma unroll
            for (int i = 0; i < 16; ++i) m[i] = fmaxf(a[i], swap32_partner(a[15 - i], hh));
            bitonic_merge16_desc<16, 0>(m);
#pragma unroll
            for (int i = 0; i < 16; ++i) v[p][i] = m[i];
        }
        float c[64]; int n = 0;
#pragma unroll
        for (int i = 0; i < 16; ++i)
#pragma unroll
            for (int j = 0; j < 16; ++j) if ((i + 1) * (j + 1) <= 16) { c[n] = __uint_as_float((__float_as_uint(v[0][i] + v[1][j]) & ~255u) | (unsigned)((i << 4) | j)); ++n; }
#pragma unroll
        for (int k = 50; k < 64; ++k) c[k] = -3.0e38f;
        top16_of_64<false, false>(c);
        __syncthreads();
#pragma unroll
        for (int i = 0; i < 16; ++i) { tbl[i * 64 + lane] = v[0][i]; tbl[(16 + i) * 64 + lane] = v[1][i]; }
        LDS_WAIT();
        float sv[16]; int ev[16]; float mx = -3.0e38f;
#pragma unroll
        for (int k = 0; k < 16; ++k) { const unsigned pl = __float_as_uint(c[k]) & 255u; const float a1 = tbl[(pl >> 4) * 64 + lane], a2 = tbl[(16 + (pl & 15)) * 64 + lane];
            sv[k] = a1 + a2; ev[k] = (int)(((__float_as_uint(a1) & 127u) << 7) | (__float_as_uint(a2) & 127u)); mx = fmaxf(mx, sv[k]); }
        float sum = 0.f;
#pragma unroll
        for (int k = 0; k < 16; ++k) { sv[k] = __expf(sv[k] - mx); sum += sv[k]; }
        const float inv = 1.0f / sum;
        if (hh == 0) {
#pragma unroll
            for (int k = 0; k < 16; k += 4) *(v4u*)(F.wsp<int>(WS_IDX) + tok * NSEL + h * 16 + k) = (v4u){(unsigned)ev[k], (unsigned)ev[k + 1], (unsigned)ev[k + 2], (unsigned)ev[k + 3]};
        } else {
#pragma unroll
            for (int k = 0; k < 16; k += 4) { unsigned gwd[4];
#pragma unroll
                for (int e = 0; e < 4; ++e) { const float su = F.wsp<float>(WS_SU)[ev[k + e]], svs = F.wsp<float>(WS_SU)[NEXP + ev[k + e]]; gwd[e] = pk2(su, sv[k + e] * inv * svs); }
                *(v4u*)(F.wsp<unsigned>(WS_G) + tok * NSEL + h * 16 + k) = (v4u){gwd[0], gwd[1], gwd[2], gwd[3]}; }
        }
        LDS_WAIT();
    }
}
typedef _Float16 f16x2_t __attribute__((ext_vector_type(2)));
DI int dot16_i8(const v4u& u, const unsigned (&x)[4]) {
    const unsigned u0 = u.x, u1 = u.y, u2 = u.z, u3 = u.w;
    int a = 0;
    a = __builtin_amdgcn_sdot4((int)u0, (int)x[0], a, false); a = __builtin_amdgcn_sdot4((int)u1, (int)x[1], a, false);
    a = __builtin_amdgcn_sdot4((int)u2, (int)x[2], a, false); a = __builtin_amdgcn_sdot4((int)u3, (int)x[3], a, false);
    return a;
}
DI void axpy32_v6(f16x2_t (&o)[16], float w, const v4u a, unsigned b4, unsigned b5) {
    const v6u pk = {a.x, a.y, a.z, a.w, b4, b5};
    const v32h h = __builtin_amdgcn_cvt_scalef32_pk32_f16_fp6(pk, 1.0f);
    const f16x2_t w2 = {(_Float16)w, (_Float16)w};
#pragma unroll
    for (int i = 0; i < 16; ++i) { const f16x2_t hv = {h[2 * i], h[2 * i + 1]}; o[i] = __builtin_elementwise_fma(hv, w2, o[i]); }
}
constexpr int TPW = 4, NSLICE = 16, SLICE_SHIFT = 10, NPAIR = TPW * NSEL;
constexpr int NLIST = NPAIR + 16;
constexpr int XPITCH = 1024;
constexpr int PEER_X_BYTES = TPW * XPITCH + 128;
constexpr int PEER_LDS_PER_WAVE = PEER_X_BYTES + TPW * 2048 + NLIST * 8;
static_assert(PEER_LDS_PER_WAVE * NWAVES <= RING_BYTES, "PEER LDS");
static_assert(PEER_LDS_PER_WAVE % 16 == 0 && PEER_X_BYTES % 16 == 0 && (NLIST * 4) % 16 == 0, "PEER LDS alignment");
typedef int v4i __attribute__((ext_vector_type(4)));
DI int incl_scan64(int v, int lane) {
    int s = v;
#pragma unroll
    for (int d = 1; d < 64; d <<= 1) { const int t = __shfl_up(s, d); if (lane >= d) s += t; }
    return s;
}
DI int ppos(int L) { return (L & ~15) | ((L & 1) << 3) | ((L >> 1) & 7); }
struct PeerState { f16x2_t oc[16]; int curj; };
DI void peer_flush(PeerState& S, LAS unsigned char* ol, int lane) {
    LAS v4u* r = (LAS v4u*)(ol + S.curj * 2048 + 64 * (lane & 31) + 32 * (lane >> 5));
    unsigned mine[8];
#pragma unroll
    for (int i = 0; i < 8; ++i) { auto rr = __builtin_amdgcn_permlane32_swap(__builtin_bit_cast(unsigned, S.oc[i]), __builtin_bit_cast(unsigned, S.oc[8 + i]), false, false);
        mine[i] = __builtin_bit_cast(unsigned, __builtin_bit_cast(f16x2_t, (unsigned)rr[0]) + __builtin_bit_cast(f16x2_t, (unsigned)rr[1])); }
#pragma unroll
    for (int c = 0; c < 2; ++c) { const v4u v = r[c]; v4u o;
        o.x = __builtin_bit_cast(unsigned, __builtin_bit_cast(f16x2_t, (unsigned)v.x) + __builtin_bit_cast(f16x2_t, mine[4 * c])); o.y = __builtin_bit_cast(unsigned, __builtin_bit_cast(f16x2_t, (unsigned)v.y) + __builtin_bit_cast(f16x2_t, mine[4 * c + 1]));
        o.z = __builtin_bit_cast(unsigned, __builtin_bit_cast(f16x2_t, (unsigned)v.z) + __builtin_bit_cast(f16x2_t, mine[4 * c + 2])); o.w = __builtin_bit_cast(unsigned, __builtin_bit_cast(f16x2_t, (unsigned)v.w) + __builtin_bit_cast(f16x2_t, mine[4 * c + 3]));
        r[c] = o; }
#pragma unroll
    for (int i = 0; i < 16; ++i) S.oc[i] = (f16x2_t){(_Float16)0.f, (_Float16)0.f};
}
DI void peer_u_issue(v4u (&ua)[16], const LAS unsigned* mlo, int g, const unsigned char* EU8, int lane) {
    unsigned lo[16];
#pragma unroll
    for (int m = 0; m < 4; ++m) { const v4u t = *(const LAS v4u*)(mlo + 16 * g + 4 * m); lo[4 * m] = t.x; lo[4 * m + 1] = t.y; lo[4 * m + 2] = t.z; lo[4 * m + 3] = t.w; }
#pragma unroll
    for (int p = 0; p < 16; ++p) { const unsigned voff = (lo[p] & 0xfffffc00u) | (16u * (unsigned)lane); ua[p] = *(const v4u*)(EU8 + voff); }
}
DI void peer_v_issue(v4u& va, unsigned& vb4, unsigned& vb5, unsigned lo, const unsigned char* EV8, int l5) {
    const unsigned e = (lo >> 10) & 0x3fffu;
    va = *(const v4u*)(EV8 + (e * (unsigned)EV_ROW + (unsigned)(16 * l5))); const v2u t2 = *(const v2u*)(EV8 + (e * (unsigned)EV_ROW + (unsigned)(512 + 8 * l5))); vb4 = t2.x; vb5 = t2.y;
}
DI int dpp_xor1_i(int x) { return __builtin_amdgcn_update_dpp(0, x, 0xB1, 0xf, 0xf, true); }
DI int dpp_xor2_i(int x) { return __builtin_amdgcn_update_dpp(0, x, 0x4E, 0xf, 0xf, true); }
DI int dpp_ror8_i(int x) { return __builtin_amdgcn_update_dpp(0, x, 0x128, 0xf, 0xf, true); }
DI int swz_xor4_i(int x) { return __builtin_amdgcn_ds_swizzle(x, 0x101F); }
DI void peer_u_compute(unsigned (&W)[8], const v4u (&ua)[16], const LAS unsigned* mlo, const LAS unsigned* mhi, int g, const LAS unsigned char* xl, const float (&sx4)[4], int lane) {
    unsigned lo[16];
#pragma unroll
    for (int m = 0; m < 4; ++m) { const v4u t = *(const LAS v4u*)(mlo + 16 * g + 4 * m); lo[4 * m] = t.x; lo[4 * m + 1] = t.y; lo[4 * m + 2] = t.z; lo[4 * m + 3] = t.w; }
    int is[16];
#pragma unroll
    for (int p = 0; p < 16; ++p) { const v4u xv = *(const LAS v4u*)(xl + (((lo[p] & 3u) << 10) + 16u * (unsigned)lane));
        const unsigned xr[4] = {xv.x, xv.y, xv.z, xv.w}; is[p] = dot16_i8(ua[p], xr); }
    const bool b0 = lane & 1, b1 = lane & 2, b2 = lane & 4, b3 = lane & 8;
    int s1[8], s2[4], s3[2];
#pragma unroll
    for (int m = 0; m < 8; ++m) s1[m] = (b0 ? is[2 * m + 1] : is[2 * m]) + dpp_xor1_i(b0 ? is[2 * m] : is[2 * m + 1]);
#pragma unroll
    for (int m = 0; m < 4; ++m) s2[m] = (b1 ? s1[2 * m + 1] : s1[2 * m]) + dpp_xor2_i(b1 ? s1[2 * m] : s1[2 * m + 1]);
#pragma unroll
    for (int m = 0; m < 2; ++m) s3[m] = (b3 ? s2[2 * m + 1] : s2[2 * m]) + dpp_ror8_i(b3 ? s2[2 * m] : s2[2 * m + 1]);
    int tot = (b2 ? s3[1] : s3[0]) + swz_xor4_i(b2 ? s3[0] : s3[1]);
    { auto rr = __builtin_amdgcn_permlane16_swap((unsigned)tot, (unsigned)tot, false, false); tot = (int)rr[0] + (int)rr[1]; }
    { auto rr = __builtin_amdgcn_permlane32_swap((unsigned)tot, (unsigned)tot, false, false); tot = (int)rr[0] + (int)rr[1]; }
    const int pp = (b2 ? 8 : 0) + (b3 ? 4 : 0) + (lane & 3);
    const unsigned lop = mlo[16 * g + pp], hip = mhi[16 * g + pp];
    const float s01 = (lop & 1u) ? sx4[1] : sx4[0], s23 = (lop & 1u) ? sx4[3] : sx4[2];
    const float sxv = (lop & 2u) ? s23 : s01;
    const float val = (float)tot * (bflo(hip) * sxv);
    const float wv = gelu_tanh(val) * bfhi(hip);
    const f16x2_t wh = {(_Float16)wv, (_Float16)wv};
    LAS unsigned* wl = (LAS unsigned*)(xl + TPW * XPITCH + 64);
    wl[pp] = __builtin_bit_cast(unsigned, wh);
    const v4u w0 = *(const LAS v4u*)(wl + 8 * (lane >> 5)), w1 = *(const LAS v4u*)(wl + 8 * (lane >> 5) + 4);
    W[0] = w0.x; W[1] = w0.y; W[2] = w0.z; W[3] = w0.w; W[4] = w1.x; W[5] = w1.y; W[6] = w1.z; W[7] = w1.w;
}
DI void axpy32_w(f16x2_t (&o)[16], unsigned w, const v4u a, unsigned b4, unsigned b5) {
    const v6u pk = {a.x, a.y, a.z, a.w, b4, b5};
    const v32h h = __builtin_amdgcn_cvt_scalef32_pk32_f16_fp6(pk, 1.0f);
    const f16x2_t w2 = __builtin_bit_cast(f16x2_t, w);
#pragma unroll
    for (int i = 0; i < 16; ++i) { const f16x2_t hv = {h[2 * i], h[2 * i + 1]}; o[i] = __builtin_elementwise_fma(hv, w2, o[i]); }
}
DI void p8b_peer(Frame& F, float* outp, float oscale = 1.0f) {
    const int lane = F.lane, w = F.wave;
    const int gw = F.vcu * NWAVES + w, NGW = F.G * NWAVES;
    const unsigned char* EU8 = F.wsp<unsigned char>(WS_EU); const unsigned char* EV8 = F.wsp<unsigned char>(WS_EV);
    LAS unsigned char* xl = F.lds + w * PEER_LDS_PER_WAVE;
    LAS unsigned char* ol = xl + PEER_X_BYTES;
    LAS unsigned* mlo = (LAS unsigned*)(ol + TPW * 2048);
    LAS unsigned* mhi = mlo + NLIST;
    const int l5 = lane & 31, hh = lane >> 5;
    int rmask = 0;
    for (int t0 = gw * TPW; t0 < M; t0 += NGW * TPW, rmask ^= (NSLICE - 1)) {
        unsigned loa[TPW], lob[TPW], hia[TPW], hib[TPW]; int posa[TPW], posb[TPW], sla[TPW], slb[TPW], offs[TPW];
#pragma unroll
        for (int j = 0; j < TPW; ++j) { const size_t tok = (size_t)t0 + j;
            float rstd; { const f32x4* sp = (const f32x4*)(F.wsp<float>(WS_SSQ2) + tok * 16); const f32x4 st = (sp[0] + sp[1]) + (sp[2] + sp[3]); rstd = rsq_(((st.x + st.y) + (st.z + st.w)) * (1.f / 1024.f) + EPS); }
            { const bf16* xs = F.wsp<bf16>(WS_XN) + tok * DM + 16 * lane;
              const v4u x0 = *(const v4u*)xs, x1 = *(const v4u*)(xs + 8);
              float xf[16] = {bflo(x0.x), bfhi(x0.x), bflo(x0.y), bfhi(x0.y), bflo(x0.z), bfhi(x0.z), bflo(x0.w), bfhi(x0.w), bflo(x1.x), bfhi(x1.x), bflo(x1.y), bfhi(x1.y), bflo(x1.z), bfhi(x1.z), bflo(x1.w), bfhi(x1.w)};
              float mx = 0.f;
#pragma unroll
              for (int i = 0; i < 16; ++i) mx = fmaxf(mx, fabsf(xf[i]));
              mx = fmaxf(max64(mx), 1e-30f); const float inv = 127.0f / mx;
              v4u y; y.x = pack_i8x4(xf[0] * inv, xf[1] * inv, xf[2] * inv, xf[3] * inv); y.y = pack_i8x4(xf[4] * inv, xf[5] * inv, xf[6] * inv, xf[7] * inv);
              y.z = pack_i8x4(xf[8] * inv, xf[9] * inv, xf[10] * inv, xf[11] * inv); y.w = pack_i8x4(xf[12] * inv, xf[13] * inv, xf[14] * inv, xf[15] * inv);
              ((LAS v4u*)(xl + j * XPITCH))[lane] = y; if (lane == 0) ((LAS float*)(xl + TPW * XPITCH))[j] = mx * rstd * (1.0f / 127.0f);
              ((LAS v4u*)(ol + j * 2048))[lane] = (v4u){0u, 0u, 0u, 0u}; ((LAS v4u*)(ol + j * 2048))[64 + lane] = (v4u){0u, 0u, 0u, 0u}; }
            const int ea = F.wsp<int>(WS_IDX)[tok * NSEL + lane], eb = F.wsp<int>(WS_IDX)[tok * NSEL + 64 + lane];
            hia[j] = F.wsp<unsigned>(WS_G)[tok * NSEL + lane]; hib[j] = F.wsp<unsigned>(WS_G)[tok * NSEL + 64 + lane];
            const int sa = (ea >> SLICE_SHIFT) ^ rmask, sb = (eb >> SLICE_SHIFT) ^ rmask;
            int pa = 0, pb = 0, myoff = 0;
#pragma unroll
            for (int bk = 0; bk < NSLICE; ++bk) { const unsigned long long ma = __ballot(sa == bk), mb = __ballot(sb == bk);
                const int ca = __popcll(ma), cb = __popcll(mb);
                const int ra = __builtin_amdgcn_mbcnt_hi((unsigned)(ma >> 32), __builtin_amdgcn_mbcnt_lo((unsigned)ma, 0)), rb = __builtin_amdgcn_mbcnt_hi((unsigned)(mb >> 32), __builtin_amdgcn_mbcnt_lo((unsigned)mb, 0));
                pa = (sa == bk) ? ra : pa; pb = (sb == bk) ? ca + rb : pb;
                myoff = (lane == bk) ? ca + cb : myoff; }
            loa[j] = ((unsigned)ea << 10) | (unsigned)j; lob[j] = ((unsigned)eb << 10) | (unsigned)j;
            posa[j] = pa; posb[j] = pb; sla[j] = sa; slb[j] = sb; offs[j] = myoff;
        }
        int cnt = 0;
        const int ltok = (lane & 3) ^ (((lane >> 2) & 1) ? 3 : 0);
#pragma unroll
        for (int j = 0; j < TPW; ++j) { const int c = __shfl(offs[j], lane >> 2); cnt = (ltok == j) ? c : cnt; }
        const int cpad = cnt;
        const int bend = incl_scan64(cpad, lane), bstart = bend - cpad;
        const int npad = __builtin_amdgcn_readlane(bend, 63);
#pragma unroll
        for (int j = 0; j < TPW; ++j) { const int ba = __shfl(bstart, 4 * sla[j] + (j ^ ((sla[j] & 1) ? 3 : 0))), bb = __shfl(bstart, 4 * slb[j] + (j ^ ((slb[j] & 1) ? 3 : 0)));
            const int qa = ppos(ba + posa[j]), qb = ppos(bb + posb[j]);
            mlo[qa] = loa[j]; mhi[qa] = hia[j]; mlo[qb] = lob[j]; mhi[qb] = hib[j]; }
        LDS_WAIT();
        float sx4[4]; { const f32x4 t = *(const LAS f32x4*)(xl + TPW * XPITCH); sx4[0] = t.x; sx4[1] = t.y; sx4[2] = t.z; sx4[3] = t.w; }
        const int ng = npad >> 4;
        PeerState S;
#pragma unroll
        for (int i = 0; i < 16; ++i) S.oc[i] = (f16x2_t){(_Float16)0.f, (_Float16)0.f};
        S.curj = -1;
        v4u ua[16]; v4u va[8]; unsigned vb4[8], vb5[8], lo8[8], W[8];
        peer_u_issue(ua, mlo, 0, EU8, lane);
        { const v4u a = *(const LAS v4u*)(mlo + 8 * hh), b = *(const LAS v4u*)(mlo + 8 * hh + 4);
          lo8[0] = a.x; lo8[1] = a.y; lo8[2] = a.z; lo8[3] = a.w; lo8[4] = b.x; lo8[5] = b.y; lo8[6] = b.z; lo8[7] = b.w; }
#pragma unroll
        for (int k = 0; k < 8; ++k) peer_v_issue(va[k], vb4[k], vb5[k], lo8[k], EV8, l5);
        __builtin_amdgcn_sched_barrier(0);
        peer_u_compute(W, ua, mlo, mhi, 0, xl, sx4, lane);
#pragma unroll 1
        for (int g = 0; g < ng; ++g) {
            if ((g & 7) == 0) { if ((((g >> 3) ^ (w >> 2)) & 1) != 0) __builtin_amdgcn_s_setprio(1); else __builtin_amdgcn_s_setprio(0); }
            const int gn = g + 1 < ng ? g + 1 : g;
            unsigned lon[8];
            peer_u_issue(ua, mlo, gn, EU8, lane);
            { const v4u a = *(const LAS v4u*)(mlo + 16 * gn + 8 * hh), b = *(const LAS v4u*)(mlo + 16 * gn + 8 * hh + 4);
              lon[0] = a.x; lon[1] = a.y; lon[2] = a.z; lon[3] = a.w; lon[4] = b.x; lon[5] = b.y; lon[6] = b.z; lon[7] = b.w; }
#pragma unroll
            for (int k = 0; k < 8; ++k) {
                const int tA = (int)((unsigned)__builtin_amdgcn_readfirstlane((int)lo8[k]) & 3u), tB = (int)((unsigned)__builtin_amdgcn_readlane((int)lo8[k], 32) & 3u);
                if (tA != S.curj) { if (S.curj >= 0) peer_flush(S, ol, lane); S.curj = tA; }
                if (tA == tB) axpy32_w(S.oc, W[k], va[k], vb4[k], vb5[k]);
                else { axpy32_w(S.oc, hh ? 0u : W[k], va[k], vb4[k], vb5[k]); peer_flush(S, ol, lane); S.curj = tB; axpy32_w(S.oc, hh ? W[k] : 0u, va[k], vb4[k], vb5[k]); }
                peer_v_issue(va[k], vb4[k], vb5[k], lon[k], EV8, l5);
            }
            peer_u_compute(W, ua, mlo, mhi, gn, xl, sx4, lane);
#pragma unroll
            for (int k = 0; k < 8; ++k) lo8[k] = lon[k];
        }
        __builtin_amdgcn_s_setprio(0);
        peer_flush(S, ol, lane);
        LDS_WAIT();
#pragma unroll
        for (int j = 0; j < TPW; ++j) {
            const LAS unsigned char* orl = ol + j * 2048 + 64 * l5 + 32 * hh;
            const v4u h0 = *(const LAS v4u*)orl, h1 = *(const LAS v4u*)(orl + 16);
            const unsigned hw[8] = {h0.x, h0.y, h0.z, h0.w, h1.x, h1.y, h1.z, h1.w};
            f32x4 a[4]; float ss = 0.f;
#pragma unroll
            for (int q = 0; q < 4; ++q) { const int eo = 128 * (4 * hh + q) + 4 * l5;
                const v2u xb = *(const v2u*)(F.wsp<bf16>(WS_XN) + ((size_t)t0 + j) * DM + eo);
                const f16x2_t p0 = __builtin_bit_cast(f16x2_t, hw[2 * q]), p1 = __builtin_bit_cast(f16x2_t, hw[2 * q + 1]);
                a[q] = (f32x4){bflo(xb.x), bfhi(xb.x), bflo(xb.y), bfhi(xb.y)} + (f32x4){(float)p0.x, (float)p0.y, (float)p1.x, (float)p1.y};
                ss += (a[q].x * a[q].x + a[q].y * a[q].y) + (a[q].z * a[q].z + a[q].w * a[q].w); }
            const float rf = rsq_(sum64(ss) * (1.f / 1024.f) + EPS) * oscale;
#pragma unroll
            for (int q = 0; q < 4; ++q) { const int eo = 128 * (4 * hh + q) + 4 * l5;
                *(f32x4*)(outp + ((size_t)t0 + j) * DM + eo) = a[q] * rf * *(const f32x4*)(F.in(25) + eo); }
        }
        LDS_WAIT();
    }
}
constexpr int N_PHASES = 11;
__global__ void __launch_bounds__(NWAVES * 64, 2) fwd_kernel(Args args) {
    extern __shared__ __attribute__((aligned(16))) unsigned char lds[];
    Frame F;
    F.lds = (LAS unsigned char*)lds;
    F.MISC = (volatile LAS unsigned*)(F.lds + MISC_OFF);
    F.tid = threadIdx.x; F.lane = F.tid & 63; F.wave = __builtin_amdgcn_readfirstlane(F.tid >> 6);
    F.G = gridDim.x; { const int bx = blockIdx.x; F.vcu = (F.G % 8 == 0) ? (bx % 8) * (F.G / 8) + bx / 8 : bx; }
    F.A = &args; F.ws = args.ws; F.out = args.out;
    F.ctl = (gu32*)(args.ws + WS_CTL);
    for (int u = F.tid; u < (LDS_BYTES - LDSCTL_OFF) / 4; u += NWAVES * 64) ((LAS unsigned*)(F.lds + LDSCTL_OFF))[u] = 0u;
    __syncthreads();
    const bool multi = (args.ph_hi - args.ph_lo) > 1;
    XcdBarrier bar; bar.bar = (unsigned*)(F.ctl + CW_BAR) + args.li * XCD_BAR_WORDS; bar.x = 0; bar.st = nullptr;
    if (multi) bar = xcd_barrier_post((unsigned*)(F.ctl + CW_BAR) + args.li * XCD_BAR_WORDS, F.MISC + 8);
    const int lo = args.ph_lo, hi = args.ph_hi;
#ifndef PROBE_EMASK
#define PROBE_EMASK 0x3fffu
#endif
#ifndef PHASE_REPEAT
#define PHASE_REPEAT 0
#endif
#define REP(k) for (int rep_ = 0; rep_ < (((PHASE_REPEAT >> (k)) & 1) ? 2 : 1); ++rep_)
#ifndef PHASE_MASK
#define PHASE_MASK 0x7ff
#endif
#define IN(k) (((PHASE_MASK >> (k)) & 1) && lo <= (k) && (k) < hi)
#define SEAM(k) do { asm volatile("; ===SEAM " #k ::: "memory"); if (IN(k) && IN((k) + 1)) xcd_barrier(bar); STAMP((k) + 1); } while (0)
    const int c = (int)blockIdx.x;
#define LOCAL_SEAM() do { VM_WAIT(); __syncthreads(); if (F.tid == 0) { __builtin_amdgcn_fence(__ATOMIC_ACQUIRE, "agent"); VM_WAIT(); } __syncthreads(); } while (0)
#ifdef PROBE_PHASE
#define STAMP(i) do { if (blockIdx.x == 0 && F.tid == 0) __hip_atomic_store(F.ctl + 512 + (i), (unsigned)__builtin_amdgcn_s_memrealtime(), RLX_AGENT); } while (0)
#else
#define STAMP(i) do { } while (0)
#endif
    STAMP(0);

#ifndef PROBE_P0
#define PROBE_P0 7
#endif
    if (IN(0)) { if (PHASE_REPEAT & 1) p0_prologue(F, PROBE_P0); p0_prologue(F); } SEAM(0);
    if (IN(1)) REP(1) {
        { pg8::Gemm g{F.wsp<bf16>(WS_XN), F.wsp<bf16>(WS_WIN), M, INW, DM}; pg8::StaticOrder S; S.init(M, INW, F.G, c);
          pg8::EpiSplitT E{F.wsp<bf16>(WS_Z), ZW, ZW, F.wsp<bf16>(WS_VT), ATTW, SEQ};
          pg8::gemm_phase<pg8::EpiSplitT, pg8::StaticOrder, true, true>(F.lds, g, S, E); }
        { const int nw3 = (M / 256) * (INW / 256) - 2 * F.G;
          int idx = -1; if (nw3 >= 0 && nw3 + 16 <= F.G) idx = c - nw3; else idx = (c < 16 && F.G >= 16) ? c : -1;
          if (F.G < 16) idx = -1;
          pg8::Gemm g{F.wsp<bf16>(WS_MEMN), F.wsp<bf16>(WS_WKV), NBATCH * 256, 2 * DM, DM};
          if (F.G >= 16) { pg8::OneUnit S{idx, 2, 8}; pg8::EpiSplitT E{F.wsp<bf16>(WS_KM), DM, DM, F.wsp<bf16>(WS_VMT), DM, 256};
              pg8::gemm_phase<pg8::EpiSplitT, pg8::OneUnit, false, true>(F.lds, g, S, E); }
          else { pg8::StaticOrder S; S.init(NBATCH * 256, 2 * DM, F.G, c); pg8::EpiSplitT E{F.wsp<bf16>(WS_KM), DM, DM, F.wsp<bf16>(WS_VMT), DM, 256};
              pg8::gemm_phase<pg8::EpiSplitT, pg8::StaticOrder, false, true>(F.lds, g, S, E); } }
        { const int first_idle = (M / 256) * (INW / 256) - 2 * F.G + 16;
          if (first_idle > 0 && first_idle < F.G) { if (c >= first_idle) convert_experts(F, (c - first_idle) * NWAVES + F.wave, (F.G - first_idle) * NWAVES); }
          else convert_experts(F, c * NWAVES + F.wave, F.G * NWAVES); }
    } SEAM(1);
    if (IN(2)) REP(2) { p2_lru_aggregates(F); } SEAM(2);
#ifndef PROBE_PARTS
#define PROBE_PARTS 3
#endif
    if (IN(3)) { if ((PHASE_REPEAT >> 3) & 1) p3_mixer(F, PROBE_PARTS); p3_mixer(F); } SEAM(3);
    if (IN(4)) REP(4) {
        pg8::Gemm g{F.wsp<bf16>(WS_Y), F.wsp<bf16>(WS_WOUT), M, DM, DM}; pg8::StaticOrder S; S.init(M, DM, F.G, c);
        pg8::EpiResid<false> E{F.in(0), F.wsp<bf16>(WS_XN), F.wsp<float>(WS_SSQ1), DM};
        pg8::gemm_phase<pg8::EpiResid<false>, pg8::StaticOrder, true, true>(F.lds, g, S, E);
    } SEAM(4);
    if (IN(5)) {
        pg8::Gemm g{F.wsp<bf16>(WS_XN), F.wsp<bf16>(WS_WQ), M, DM, DM}; pg8::StaticOrder S; S.init(M, DM, F.G, c);
        pg8::EpiRowScale E{F.wsp<bf16>(WS_QC), DM, F.wsp<float>(WS_SSQ1), 1.f / 1024.f, EPS};
        pg8::gemm_phase<pg8::EpiRowScale, pg8::StaticOrder, true, true>(F.lds, g, S, E);
        LOCAL_SEAM();
        p5_cross(F, S);
    } SEAM(6);
    if (IN(7)) {
        pg8::Gemm g{F.wsp<bf16>(WS_OC), F.wsp<bf16>(WS_WO), M, DM, DM}; pg8::StaticOrder S; S.init(M, DM, F.G, c);
        pg8::EpiResid<true> E{F.wsp<bf16>(WS_XN), F.wsp<bf16>(WS_XN), F.wsp<float>(WS_SSQ2), DM};
        pg8::gemm_phase<pg8::EpiResid<true>, pg8::StaticOrder, true, true>(F.lds, g, S, E);
    } SEAM(7);
    if (IN(8)) {
        pg8::Gemm g{F.wsp<bf16>(WS_XN), F.wsp<bf16>(WS_WQRY), M, 2 * DM, DM}; pg8::StaticOrder S; S.init(M, 2 * DM, F.G, c);
        pg8::EpiRowScale E{F.wsp<bf16>(WS_QP), 2 * DM, F.wsp<float>(WS_SSQ2), 1.f / 1024.f, EPS};
        pg8::gemm_phase<pg8::EpiRowScale, pg8::StaticOrder, true, true>(F.lds, g, S, E);
        LOCAL_SEAM();
        p8a_topk(F, S);
    } SEAM(9);
    if (IN(10)) { if ((PHASE_REPEAT >> 10) & 1) { p8b_peer(F, F.wsp<float>(WS_Z)); } p8b_peer(F, F.out,
#ifdef PROBE_PHASE
        1.0f + (float)(((__hip_atomic_load(F.ctl + 512 + PROBE_PHASE + 1, RLX_AGENT) - __hip_atomic_load(F.ctl + 512 + PROBE_PHASE, RLX_AGENT)) + 500u) / 1000u) * 1e-2f
#else
        1.0f
#endif
        ); }
#undef IN
#undef SEAM
}

#ifndef N_LAUNCH_MODE
#define N_LAUNCH_MODE 1
#endif
extern "C" void kernel_launch(void* const* d_in, const int* in_sizes, int n_in, void* d_out, int out_size, void* d_ws, size_t ws_size, hipStream_t stream) {
    static int grid = 0;
    if (grid == 0) {
        if (n_in != 26 || out_size != M * DM || ws_size < WS_END) { fprintf(stderr, "kernel_launch: unexpected shapes (n_in %d, out %d, ws %zu)\n", n_in, out_size, ws_size); grid = -1; return; }
        int dev = 0, cus = 0, per_cu = 0;
        if (hipGetDevice(&dev) != hipSuccess || hipDeviceGetAttribute(&cus, hipDeviceAttributeMultiprocessorCount, dev) != hipSuccess) { grid = -1; return; }
        if (hipFuncSetAttribute((const void*)fwd_kernel, hipFuncAttributeMaxDynamicSharedMemorySize, LDS_BYTES) != hipSuccess) { fprintf(stderr, "kernel_launch: hipFuncSetAttribute failed\n"); grid = -1; return; }
        if (hipOccupancyMaxActiveBlocksPerMultiprocessor(&per_cu, (const void*)fwd_kernel, NWAVES * 64, LDS_BYTES) != hipSuccess || per_cu < 1) { fprintf(stderr, "kernel_launch: occupancy query says %d blocks per CU\n", per_cu); (void)hipGetLastError(); grid = -1; return; }
        grid = cus;
    }
    if (grid < 0) return;
    (void)hipMemsetAsync((char*)d_ws + WS_CTL, 0, CTL_ZERO_BYTES, stream);
    Args a{};
    for (int i = 0; i < 26; ++i) a.in[i] = (const float*)d_in[i];
    a.out = (float*)d_out; a.ws = (unsigned char*)d_ws;
    if (N_LAUNCH_MODE == 1) { a.ph_lo = 0; a.ph_hi = N_PHASES; a.li = 0; hipLaunchKernelGGL(fwd_kernel, dim3(grid), dim3(NWAVES * 64), LDS_BYTES, stream, a); }
    else { for (int p = 0; p < N_PHASES; ++p) { a.ph_lo = p; a.ph_hi = p + 1; a.li = 0; hipLaunchKernelGGL(fwd_kernel, dim3(grid), dim3(NWAVES * 64), LDS_BYTES, stream, a); } }
}
```
